# Optimizing an MI355X kernel written in HIP

```python
import jax, jax.numpy as jnp
from jax import lax
import numpy as np

D_MODEL = 1024
BATCH = 8
SEQ = 4096
DEPTH = 2

GRID_W = 64
CTX_LEN = 256
H_M = 4
DH_M = 128
M_W = H_M * DH_M
H_A = 8
H_KV = 2
DH_A = 64
A_Q = H_A * DH_A
A_KV = H_KV * DH_A
GQA_GROUP = H_A // H_KV
WINDOW = 128
WIN_BLOCK = 128
ROPE_THETA = 10000.0
AB_WIDTHS = (M_W, M_W, M_W, M_W, 4 * H_M, A_Q, A_KV, A_KV)
MIX_W = M_W + A_Q
H_C = 4
DK_C = 128
DV_C = 256
C_K = H_C * DK_C
C_V = H_C * DV_C
GATE_RANK = 16
GATE_TAU = 16.0
C_WIDTHS = (C_K, C_K, C_V, C_V, 2 * GATE_RANK)
CHUNK = 64
N_KEYS = 128
N_EXPERTS = N_KEYS * N_KEYS
PEER_HEADS = 8
PEER_TOPK = 16
PEER_KEY_DIM = 256
PEER_HALF = PEER_KEY_DIM // 2
PEER_CHUNK = 128
N_EVEN = (DEPTH + 1) // 2
N_ODD = DEPTH // 2
DEEPNORM_ALPHA = (2 * DEPTH) ** 0.25
DEEPNORM_BETA = (8 * DEPTH) ** -0.25
LN_EPS = 1e-5

kernel_name = "hybrid_mlstm_swa_gla_peer_diffusion_block"


def _layernorm(x, w, b):
    xf = x.astype(jnp.float32)
    mu = xf.mean(-1, keepdims=True)
    var = jnp.mean(jnp.square(xf - mu), -1, keepdims=True)
    return ((xf - mu) * lax.rsqrt(var + LN_EPS)).astype(x.dtype) * w + b


def _split(a, widths):
    idx = np.cumsum(widths)[:-1].tolist()
    return jnp.split(a, idx, axis=-1)


def _heads(a, h):
    b, s = a.shape[:2]
    return a.reshape(b, s, h, -1).transpose(0, 2, 1, 3)


def _head_norm(h, w):
    hf = h.astype(jnp.float32)
    hf = hf * lax.rsqrt(jnp.mean(hf * hf, -1, keepdims=True) + LN_EPS)
    b, nh, s, d = h.shape
    return hf.transpose(0, 2, 1, 3).reshape(b, s, nh * d) * w


def _to_chunks(a):
    b, h, s = a.shape[:3]
    a = a.reshape((b, h, s // CHUNK, CHUNK) + a.shape[3:])
    return jnp.moveaxis(a, 2, 0)


def _from_chunks(a):
    a = jnp.moveaxis(a, 0, 2)
    return a.reshape(a.shape[:2] + (-1,) + a.shape[4:])


def _mlstm_scan(q, k, v, log_i, log_f, state):
    causal = jnp.tril(jnp.ones((CHUNK, CHUNK), bool))

    def step(carry, inp):
        c_st, n_st, m_st = carry
        qc, kc, vc, li, lf = inp
        cum = jnp.cumsum(lf, axis=-1)
        dmat = cum[..., :, None] - cum[..., None, :] + li[..., None, :]
        dmat = jnp.where(causal, dmat, -jnp.inf)
        m_inter = cum + m_st[..., None]
        m_t = jnp.maximum(m_inter, dmat.max(-1))
        w = jnp.exp(dmat - m_t[..., None]) * jnp.einsum('bhtd,bhsd->bhts', qc, kc)
        a_inter = jnp.exp(m_inter - m_t)
        num = a_inter[..., None] * jnp.einsum('bhtd,bhde->bhte', qc, c_st) + jnp.einsum('bhts,bhse->bhte', w, vc)
        den = a_inter * jnp.einsum('bhtd,bhd->bht', qc, n_st) + w.sum(-1)
        h = num / jnp.maximum(jnp.abs(den), jnp.exp(-m_t))[..., None]
        total = cum[..., -1]
        decay_s = total[..., None] - cum + li
        m_new = jnp.maximum(total + m_st, decay_s.max(-1))
        ws = jnp.exp(decay_s - m_new[..., None])
        a_st = jnp.exp(total + m_st - m_new)
        c_st = a_st[..., None, None] * c_st + jnp.einsum('bhs,bhsd,bhse->bhde', ws, kc, vc)
        n_st = a_st[..., None] * n_st + jnp.einsum('bhs,bhsd->bhd', ws, kc)
        return (c_st, n_st, m_new), h

    state, hs = lax.scan(step, state, tuple(_to_chunks(a) for a in (q, k, v, log_i, log_f)))
    return _from_chunks(hs), state


def _gla_scan(q, k, v, log_a, state):
    causal = jnp.tril(jnp.ones((CHUNK, CHUNK), bool))

    def step(st, inp):
        qc, kc, vc, la = inp
        cum = jnp.cumsum(la, axis=2)
        rel = cum[:, :, :, None, :] - cum[:, :, None, :, :]
        rel = jnp.where(causal[:, :, None], rel, -jnp.inf)
        scores = jnp.einsum('bhtk,bhsk,bhtsk->bhts', qc, kc, jnp.exp(rel))
        out = jnp.einsum('bhtk,bhkv->bhtv', qc * jnp.exp(cum), st) + jnp.einsum('bhts,bhsv->bhtv', scores, vc)
        total = cum[:, :, -1:, :]
        st = jnp.exp(total[:, :, 0, :, None]) * st + jnp.einsum('bhsk,bhsv->bhkv', kc * jnp.exp(total - cum), vc)
        return st, out

    state, outs = lax.scan(step, state, tuple(_to_chunks(a) for a in (q, k, v, log_a)))
    return _from_chunks(outs), state


def _directional(scan_fn, ctx_seq, lat_seq, init, reverse):
    if reverse:
        ctx_seq = tuple(jnp.flip(a, 2) for a in ctx_seq)
        lat_seq = tuple(jnp.flip(a, 2) for a in lat_seq)
    h_ctx, state = scan_fn(*ctx_seq, init)
    h_lat, _ = scan_fn(*lat_seq, state)
    if reverse:
        h_ctx, h_lat = jnp.flip(h_ctx, 2), jnp.flip(h_lat, 2)
    return h_ctx, h_lat


def _axial_rope(s):
    rows = s // GRID_W
    row = jnp.repeat(jnp.arange(rows), GRID_W).astype(jnp.float32)
    col = jnp.tile(jnp.arange(GRID_W), rows).astype(jnp.float32)
    n_freq = DH_A // 4
    inv = ROPE_THETA ** (-jnp.arange(n_freq, dtype=jnp.float32) / n_freq)
    ang = jnp.concatenate([row[:, None] * inv, col[:, None] * inv], -1)
    return jnp.cos(ang), jnp.sin(ang)


def _rope(x, cos, sin):
    xf = x.astype(jnp.float32)
    x1, x2 = xf[..., 0::2], xf[..., 1::2]
    c = cos[None, :, None, :]
    sn = sin[None, :, None, :]
    return jnp.stack([x1 * c - x2 * sn, x1 * sn + x2 * c], -1).reshape(x.shape).astype(x.dtype)


def _window_attention(q, k, v, k_ctx, v_ctx, sink):
    b, s = q.shape[:2]
    nb = s // WIN_BLOCK
    lc = k_ctx.shape[1]
    qb = jnp.moveaxis(q.reshape(b, nb, WIN_BLOCK, H_KV, GQA_GROUP, DH_A), 1, 0)

    def bands(a):
        ap = jnp.pad(a, ((0, 0), (WIN_BLOCK, WIN_BLOCK), (0, 0), (0, 0))).reshape(b, nb + 2, WIN_BLOCK, H_KV, DH_A)
        return jnp.moveaxis(jnp.concatenate([ap[:, :-2], ap[:, 1:-1], ap[:, 2:]], 2), 1, 0)

    kw, vw = bands(k), bands(v)
    qi = jnp.arange(WIN_BLOCK)[:, None]
    kj = jnp.arange(3 * WIN_BLOCK)[None, :]
    key_pos = jnp.arange(nb)[:, None, None] * WIN_BLOCK + kj - WIN_BLOCK
    valid = (jnp.abs(kj - WIN_BLOCK - qi) <= WINDOW) & (key_pos >= 0) & (key_pos < s)
    scale = DH_A ** -0.5
    sink_l = sink.reshape(H_KV, GQA_GROUP).astype(jnp.float32)

    def block(args):
        qn, kn, vn, mask = args
        s_ctx = jnp.einsum('bqhgd,bchd->bhgqc', qn, k_ctx).astype(jnp.float32) * scale
        s_win = jnp.einsum('bqhgd,bkhd->bhgqk', qn, kn).astype(jnp.float32) * scale
        s_win = jnp.where(mask, s_win, -jnp.inf)
        sink_col = jnp.broadcast_to(sink_l[None, :, :, None, None], s_ctx.shape[:-1] + (1,))
        p = jax.nn.softmax(jnp.concatenate([sink_col, s_ctx, s_win], -1), -1).astype(qn.dtype)
        return (jnp.einsum('bhgqc,bchd->bqhgd', p[..., 1:1 + lc], v_ctx)
                + jnp.einsum('bhgqk,bkhd->bqhgd', p[..., 1 + lc:], vn))

    out = lax.map(block, (qb, kw, vw, valid))
    return jnp.moveaxis(out, 0, 1).reshape(b, s, H_A, DH_A)


def _context_attention(q, k, v, sink):
    b, lc = q.shape[:2]
    qg = q.reshape(b, lc, H_KV, GQA_GROUP, DH_A)
    sc = jnp.einsum('bqhgd,bkhd->bhgqk', qg, k).astype(jnp.float32) * DH_A ** -0.5
    sink_col = jnp.broadcast_to(sink.reshape(H_KV, GQA_GROUP).astype(jnp.float32)[None, :, :, None, None],
                                sc.shape[:-1] + (1,))
    p = jax.nn.softmax(jnp.concatenate([sink_col, sc], -1), -1)[..., 1:].astype(q.dtype)
    return jnp.einsum('bhgqk,bkhd->bqhgd', p, v).reshape(b, lc, H_A, DH_A)


def _ab_streams(h, w_in, gate_b):
    q_m, k_m, v_m, o_m, g_m, q_a, k_a, v_a = _split(h @ w_in, AB_WIDTHS)
    b, s = h.shape[:2]
    g = g_m.reshape(b, s, 2, 2, H_M).astype(jnp.float32) + gate_b.astype(jnp.float32)
    mlstm = (_heads(q_m, H_M).astype(jnp.float32),
             _heads(k_m, H_M).astype(jnp.float32) * DH_M ** -0.5,
             _heads(v_m, H_M).astype(jnp.float32))
    gates = [(g[:, :, d, 0].transpose(0, 2, 1), jax.nn.log_sigmoid(g[:, :, d, 1]).transpose(0, 2, 1))
             for d in range(2)]
    attn = (q_a.reshape(b, s, H_A, DH_A), k_a.reshape(b, s, H_KV, DH_A), v_a.reshape(b, s, H_KV, DH_A))
    return mlstm, gates, o_m, attn


def _merge_ab(m, o, a, norm_w, w_out):
    hm = _head_norm(m, norm_w).astype(o.dtype) * jax.nn.sigmoid(o)
    cat = jnp.concatenate([hm, a.reshape(a.shape[0], a.shape[1], A_Q)], -1)
    return cat @ w_out


def _mixer_ab(hl, hc, w_in, gate_b, norm_w, sink, w_out, ctx_out):
    ml, gl, ol, (ql, kl, vl) = _ab_streams(hl, w_in, gate_b)
    mc, gc, oc, (qc, kc, vc) = _ab_streams(hc, w_in, gate_b)
    b = hl.shape[0]
    init = (jnp.zeros((b, H_M, DH_M, DH_M), jnp.float32), jnp.zeros((b, H_M, DH_M), jnp.float32),
            jnp.zeros((b, H_M), jnp.float32))
    outs = [_directional(_mlstm_scan, mc + gc[d], ml + gl[d], init, d == 1) for d in range(2)]
    cos, sin = _axial_rope(hl.shape[1])
    a_lat = _window_attention(_rope(ql, cos, sin), _rope(kl, cos, sin), vl, kc, vc, sink)
    y_lat = _merge_ab(outs[0][1] + outs[1][1], ol, a_lat, norm_w, w_out)
    if not ctx_out:
        return y_lat, None
    y_ctx = _merge_ab(outs[0][0] + outs[1][0], oc, _context_attention(qc, kc, vc, sink), norm_w, w_out)
    return y_lat, y_ctx


def _c_streams(h, w_in, gate_up, gate_b):
    q, k, v, g, low = _split(h @ w_in, C_WIDTHS)
    b, s = h.shape[:2]
    qkv = (_heads(q, H_C).astype(jnp.float32) * DK_C ** -0.5,
           _heads(k, H_C).astype(jnp.float32),
           _heads(v, H_C).astype(jnp.float32))
    low = low.reshape(b, s, 2, GATE_RANK)
    log_a = [_heads(jax.nn.log_sigmoid((low[:, :, d] @ gate_up[d] + gate_b[d]).astype(jnp.float32)) / GATE_TAU, H_C)
             for d in range(2)]
    return qkv, log_a, g


def _merge_c(h, g, norm_w, w_out):
    return (_head_norm(h, norm_w).astype(g.dtype) * jax.nn.silu(g)) @ w_out


def _mixer_c(hl, hc, w_in, gate_up, gate_b, norm_w, w_out, ctx_out):
    sl, al, gl = _c_streams(hl, w_in, gate_up, gate_b)
    sc, ac, gc = _c_streams(hc, w_in, gate_up, gate_b)
    init = jnp.zeros((hl.shape[0], H_C, DK_C, DV_C), jnp.float32)
    outs = [_directional(_gla_scan, sc + (ac[d],), sl + (al[d],), init, d == 1) for d in range(2)]
    y_lat = _merge_c(outs[0][1] + outs[1][1], gl, norm_w, w_out)
    if not ctx_out:
        return y_lat, None
    return y_lat, _merge_c(outs[0][0] + outs[1][0], gc, norm_w, w_out)


def _peer(h, wq, keys, u, v):
    shape = h.shape
    tokens = h.reshape(-1, PEER_CHUNK, shape[-1])

    def block(hb):
        tc = hb.shape[0]
        q = (hb @ wq).reshape(tc, PEER_HEADS, 2, PEER_HALF)
        s = jnp.einsum('thpk,hpnk->thpn', q, keys)
        s_top, i_top = lax.top_k(s, PEER_TOPK)
        cand = s_top[:, :, 0, :, None] + s_top[:, :, 1, None, :]
        cid = i_top[:, :, 0, :, None] * N_KEYS + i_top[:, :, 1, None, :]
        best, pos = lax.top_k(cand.reshape(tc, PEER_HEADS, -1), PEER_TOPK)
        eid = jnp.take_along_axis(cid.reshape(tc, PEER_HEADS, -1), pos, -1)
        g = jax.nn.softmax(best.astype(jnp.float32), -1).astype(hb.dtype)
        act = jax.nn.gelu(jnp.einsum('td,thed->the', hb, u[eid]), approximate=False)
        return jnp.einsum('the,thed->td', g * act, v[eid])

    return lax.map(block, tokens).reshape(shape)


def setup_inputs(seed: int = 0) -> dict:
    key = jax.random.key(seed)
    ks = jax.random.split(key, 26)
    f32 = jnp.float32

    def nrm(k, shape, s):
        return jax.random.normal(k, shape, f32) * s

    d = D_MODEL
    f_bias = 3.0 + 3.0 * jnp.arange(H_M, dtype=f32) / (H_M - 1)
    gate_offset = jnp.stack([jnp.zeros((H_M,), f32), f_bias])[None, None]
    return {
        "x": nrm(ks[0], (BATCH, SEQ, d), 1.0),
        "c": nrm(ks[1], (BATCH, d), 1.0),
        "ctx": nrm(ks[2], (BATCH, CTX_LEN, d), 1.0),
        "c_ctx": nrm(ks[3], (d,), 1.0),
        "w_mod": nrm(ks[4], (DEPTH, d, 6 * d), 0.5 * d ** -0.5),
        "b_mod": nrm(ks[5], (DEPTH, 6 * d), 0.02),
        "ln_w": 1.0 + nrm(ks[6], (DEPTH, 2, d), 0.02),
        "ln_b": nrm(ks[7], (DEPTH, 2, d), 0.02),
        "ab_w_in": nrm(ks[8], (N_EVEN, d, sum(AB_WIDTHS)), d ** -0.5),
        "ab_gate_b": nrm(ks[9], (N_EVEN, 2, 2, H_M), 0.1) + gate_offset,
        "ab_norm_w": 1.0 + nrm(ks[10], (N_EVEN, M_W), 0.02),
        "ab_sink": nrm(ks[11], (N_EVEN, H_A), 0.5),
        "ab_w_out": nrm(ks[12], (N_EVEN, MIX_W, d), DEEPNORM_BETA * MIX_W ** -0.5),
        "gla_w_in": nrm(ks[13], (N_ODD, d, sum(C_WIDTHS)), d ** -0.5),
        "gla_gate_up": nrm(ks[14], (N_ODD, 2, GATE_RANK, C_K), GATE_RANK ** -0.5),
        "gla_gate_b": 1.0 + nrm(ks[15], (N_ODD, 2, C_K), 0.5),
        "gla_norm_w": 1.0 + nrm(ks[16], (N_ODD, C_V), 0.02),
        "gla_w_out": nrm(ks[17], (N_ODD, C_V, d), DEEPNORM_BETA * C_V ** -0.5),
        "peer_wq": nrm(ks[18], (DEPTH, d, PEER_HEADS * PEER_KEY_DIM), d ** -0.5),
        "peer_keys": nrm(ks[19], (DEPTH, PEER_HEADS, 2, N_KEYS, PEER_HALF), PEER_HALF ** -0.5),
        "peer_u": nrm(ks[20], (DEPTH, N_EXPERTS, d), d ** -0.5),
        "peer_v": nrm(ks[21], (DEPTH, N_EXPERTS, d), DEEPNORM_BETA * (PEER_HEADS * PEER_TOPK) ** -0.5),
    }


def reference(x, c, ctx, c_ctx, w_mod, b_mod, ln_w, ln_b, ab_w_in, ab_gate_b, ab_norm_w, ab_sink, ab_w_out,
              gla_w_in, gla_gate_up, gla_gate_b, gla_norm_w, gla_w_out, peer_wq, peer_keys, peer_u, peer_v):
    for layer in range(DEPTH):
        last = layer == DEPTH - 1
        j = layer // 2
        mod_l = jax.nn.silu(c) @ w_mod[layer] + b_mod[layer]
        mod_c = jax.nn.silu(c_ctx) @ w_mod[layer] + b_mod[layer]
        sh1, sc1, g1, sh2, sc2, g2 = jnp.split(mod_l[:, None, :], 6, axis=-1)
        csh1, csc1, cg1, csh2, csc2, cg2 = jnp.split(mod_c, 6)
        hl = x * (1.0 + sc1) + sh1
        hc = ctx * (1.0 + csc1) + csh1
        if layer % 2 == 0:
            y_lat, y_ctx = _mixer_ab(hl, hc, ab_w_in[j], ab_gate_b[j], ab_norm_w[j], ab_sink[j], ab_w_out[j], not last)
        else:
            y_lat, y_ctx = _mixer_c(hl, hc, gla_w_in[j], gla_gate_up[j], gla_gate_b[j], gla_norm_w[j], gla_w_out[j],
                                    not last)
        x = _layernorm(DEEPNORM_ALPHA * x + g1 * y_lat, ln_w[layer, 0], ln_b[layer, 0])
        f_lat = _peer(x * (1.0 + sc2) + sh2, peer_wq[layer], peer_keys[layer], peer_u[layer], peer_v[layer])
        x = _layernorm(DEEPNORM_ALPHA * x + g2 * f_lat, ln_w[layer, 1], ln_b[layer, 1])
        if not last:
            ctx = _layernorm(DEEPNORM_ALPHA * ctx + cg1 * y_ctx, ln_w[layer, 0], ln_b[layer, 0])
            f_ctx = _peer(ctx * (1.0 + csc2) + csh2, peer_wq[layer], peer_keys[layer], peer_u[layer], peer_v[layer])
            ctx = _layernorm(DEEPNORM_ALPHA * ctx + cg2 * f_ctx, ln_w[layer, 1], ln_b[layer, 1])
    return x
```

```cpp
#include <hip/hip_runtime.h>
#include <cstdio>
#include <cstdint>

#define GAS __attribute__((address_space(1)))
#define LAS __attribute__((address_space(3)))
typedef unsigned short bf16;
typedef unsigned v4u __attribute__((ext_vector_type(4)));
typedef unsigned v2u __attribute__((ext_vector_type(2)));
typedef float f32x4 __attribute__((ext_vector_type(4)));
typedef float f32x2 __attribute__((ext_vector_type(2)));
typedef short bf16x8 __attribute__((ext_vector_type(8)));
typedef short s16x4 __attribute__((ext_vector_type(4)));
typedef GAS unsigned gu32;
#define RLX_AGENT __ATOMIC_RELAXED, __HIP_MEMORY_SCOPE_AGENT

constexpr int NB = 8, SEQ = 4096, LC = 256, D = 1024;
constexpr int PB = LC + SEQ;
constexpr int TT = NB * PB;
constexpr int NCH = PB / 64;
constexpr int N_AB = 2816;
constexpr int N_C = 3072;
constexpr float LN_EPS = 1e-5f;
constexpr float DN_ALPHA = 1.41421356237f;
constexpr int NEXP = 16384;
__device__ __forceinline__ int map_row(int i, bool lat_only) { return lat_only ? (i >> 12) * 4352 + 256 + (i & 4095) : i; }

constexpr size_t MiB = 1u << 20;
constexpr size_t WS_CTL = 0, CTL_ZERO_BYTES = 64 * 1024;
constexpr size_t WS_MOD = 1 * MiB;
constexpr size_t WS_ROPE = 2 * MiB;
constexpr size_t WS_WG = 2 * MiB + 64 * 1024;
constexpr size_t WS_WLOW = 2 * MiB + 128 * 1024;
constexpr size_t WS_SCL = 3 * MiB;
constexpr size_t WS_BQ = 4 * MiB, WS_CQ = WS_BQ + 1200 * 1024, WS_EM = WS_CQ + 1200 * 1024, WS_AI = WS_EM + 1200 * 1024;
constexpr size_t WS_AST = WS_AI + 1200 * 1024, WS_CL = WS_AST + 32 * 1024;
constexpr size_t WS_ET = 10 * MiB;
constexpr size_t WS_GL = 13 * MiB;
constexpr size_t WS_WAB = 20 * MiB, WS_WABO = 26 * MiB, WS_WC = 28 * MiB, WS_WCO = 34 * MiB, WS_WQ0 = 36 * MiB, WS_WQ1 = 40 * MiB, WS_KEYS = 44 * MiB;
constexpr size_t WS_NST = 45 * MiB;
constexpr size_t WS_XC = 48 * MiB;
constexpr size_t WS_U = 56 * MiB, WS_V = 88 * MiB;
constexpr size_t WS_HB = 120 * MiB;
constexpr size_t WS_P = 188 * MiB;
constexpr size_t WS_ST = 392 * MiB;
constexpr size_t WS_END = 460 * MiB;

constexpr int LDS_BYTES = 163840;
constexpr int MISC_OFF = LDS_BYTES - 64;

__device__ __forceinline__ unsigned f2bf(float f) { unsigned u = __builtin_bit_cast(unsigned, f); return (u + 0x7fffu + ((u >> 16) & 1u)) >> 16; }
__device__ __forceinline__ unsigned pk2(float lo, float hi) { return f2bf(lo) | (f2bf(hi) << 16); }
__device__ __forceinline__ float bflo(unsigned w) { return __builtin_bit_cast(float, w << 16); }
__device__ __forceinline__ float bfhi(unsigned w) { return __builtin_bit_cast(float, w & 0xffff0000u); }
__device__ __forceinline__ float bf2f(bf16 b) { return __builtin_bit_cast(float, (unsigned)b << 16); }
template <int CTRL> __device__ __forceinline__ float dppmov_f(float x) { return __builtin_bit_cast(float, __builtin_amdgcn_mov_dpp(__builtin_bit_cast(int, x), CTRL, 0xf, 0xf, true)); }
__device__ __forceinline__ float wave_sum(float v) {
    v += dppmov_f<0xB1>(v); v += dppmov_f<0x4E>(v); v += dppmov_f<0x141>(v); v += dppmov_f<0x128>(v);
    v += __shfl_xor(v, 16); v += __shfl_xor(v, 32);
    return v;
}
__device__ __forceinline__ float sigmoidf_(float x) { return 1.f / (1.f + __expf(-x)); }
__device__ __forceinline__ float logsigmoidf_(float x) { return fminf(x, 0.f) - log1pf(__expf(-fabsf(x))); }
__device__ __forceinline__ float siluf_(float x) { return x / (1.f + __expf(-x)); }

namespace pg8 {
#define PG8_LAS __attribute__((address_space(3)))
typedef unsigned short bf16_t;
typedef short bf16x8 __attribute__((ext_vector_type(8)));
typedef float f32x4 __attribute__((ext_vector_type(4)));
typedef unsigned u32x4 __attribute__((ext_vector_type(4)));
constexpr int BM = 256, BK = 64, HALF = 128, HTB = HALF * BK * 2  , STAGE_BYTES = 8 * HTB, NXCD = 8, WGM = 8;

__host__ __device__ __forceinline__ int lds_byte(int r, int c) { const int st = (r >> 4) * 2 + (c >> 5), rr = r & 15, cc = c & 31, ob = rr * 64 + cc * 2; return st * 1024 + (ob ^ (((ob >> 9) & 1) << 5)); }
__host__ __device__ __forceinline__ void stage_rc(int b, int& R, int& C) { const int st = b / 1024, sb = b % 1024, swz = sb ^ (((sb >> 9) & 1) << 5); R = (st >> 1) * 16 + swz / 64; C = (st & 1) * 32 + (swz % 64) / 2; }
__host__ __device__ __forceinline__ int perm32(int rho) { const int n = rho >> 4, i = rho & 15; return 8 * (i >> 2) + 4 * n + (i & 3); }

struct Unit { int pm, pn; };
struct Gemm { const bf16_t* A; const bf16_t* Bt; int M, N, K, lda, ldb; };

struct StaticOrder {
    int nM, nN, nwg, G, c;
    __host__ __device__ void init(int M, int N, int G_, int c_) { nM = M / BM; nN = N / BM; nwg = nM * nN; G = G_; c = c_; }
    __host__ __device__ bool next(int i, Unit& u) const {
        const long L = (long)i * G + c; if (L >= nwg) return false;
        int wgid = (int)L; { const int q = nwg / NXCD, r = nwg % NXCD, xcd = wgid % NXCD, off = wgid / NXCD; wgid = (xcd < r ? xcd * (q + 1) : r * (q + 1) + (xcd - r) * q) + off; }
        const int nig = WGM * nN, gid = wgid / nig, fm = gid * WGM, gsz = (nM - fm) < WGM ? (nM - fm) : WGM;
        u.pm = fm + ((wgid % nig) % gsz); u.pn = (wgid % nig) / gsz; return true;
    }
    __device__ __forceinline__ void a_ready(const Unit&) const {}
    __device__ __forceinline__ void done(const Unit&) const {}
};

struct LatOrder : StaticOrder {
    __host__ __device__ bool next(int i, Unit& u) const { if (!StaticOrder::next(i, u)) return false; u.pm = (u.pm >> 4) * 17 + 1 + (u.pm & 15); return true; }
};
__device__ __forceinline__ unsigned cvt_pk_bf16(float lo, float hi) { unsigned r; asm volatile("v_cvt_pk_bf16_f32 %0, %1, %2" : "=v"(r) : "v"(lo), "v"(hi)); return r; }
struct EpiBf16 {
    static constexpr bool PERM = true, AFTER_DRAIN = false;
    bf16_t* O; int ldc;
    __device__ __forceinline__ void operator()(const f32x4 (&acc)[2][2][4][2], const Unit& u, int wr, int wc, int fr, int fq) const {
        const int row0 = u.pm * BM + wr * 64 + fr; const int col0 = u.pn * BM + wc * 32 + 8 * fq;
#pragma unroll
        for (int ai = 0; ai < 2; ++ai)
#pragma unroll
            for (int m = 0; m < 4; ++m) { bf16_t* rowp = O + (size_t)(row0 + ai * HALF + m * 16) * ldc + col0;
#pragma unroll
                for (int bj = 0; bj < 2; ++bj) { const f32x4 v0 = acc[ai][bj][m][0], v1 = acc[ai][bj][m][1];
                    u32x4 w; w.x = cvt_pk_bf16(v0[0], v0[1]); w.y = cvt_pk_bf16(v0[2], v0[3]); w.z = cvt_pk_bf16(v1[0], v1[1]); w.w = cvt_pk_bf16(v1[2], v1[3]);
                    *(u32x4*)(rowp + bj * HALF) = w; } }
    }
};
struct EpiResid {
    static constexpr bool PERM = false, AFTER_DRAIN = false;
    const float* src_lat; const float* src_ctx; float* dst_lat; float* dst_ctx; const float* gate; float gscale; int dry;
    __device__ __forceinline__ void operator()(const f32x4 (&acc)[2][2][4][2], const Unit& u, int wr, int wc, int fr, int fq) const {
        const int b = u.pm / 17, tb = u.pm - b * 17;
        const float* sbase; float* dbase; const float* gr;
        if (tb == 0) { sbase = src_ctx + (size_t)b * 256 * 1024; dbase = dst_ctx + (size_t)b * 256 * 1024; gr = gate + 8 * 6144; }
        else { sbase = src_lat + ((size_t)b * 4096 + (size_t)(tb - 1) * 256) * 1024; dbase = dst_lat + ((size_t)b * 4096 + (size_t)(tb - 1) * 256) * 1024; gr = gate + b * 6144; }
        const int row0 = wr * 64 + fr, col0 = u.pn * BM + wc * 32 + 4 * fq;
        f32x4 gv[2][2];
#pragma unroll
        for (int bj = 0; bj < 2; ++bj)
#pragma unroll
            for (int n = 0; n < 2; ++n) gv[bj][n] = *(const f32x4*)(gr + col0 + bj * HALF + n * 16) * gscale;
#pragma unroll
        for (int ai = 0; ai < 2; ++ai)
#pragma unroll
            for (int mp = 0; mp < 2; ++mp) {
                f32x4 sv[2][2][2];
#pragma unroll
                for (int mm = 0; mm < 2; ++mm) { const size_t off = (size_t)(row0 + ai * HALF + (2 * mp + mm) * 16) * 1024 + col0;
#pragma unroll
                    for (int bj = 0; bj < 2; ++bj)
#pragma unroll
                        for (int n = 0; n < 2; ++n) sv[mm][bj][n] = __builtin_nontemporal_load((const f32x4*)(sbase + off + bj * HALF + n * 16)); }
                asm volatile("" ::: "memory");
#pragma unroll
                for (int mm = 0; mm < 2; ++mm) { const int m = 2 * mp + mm; const size_t off = (size_t)(row0 + ai * HALF + m * 16) * 1024 + col0;
#pragma unroll
                    for (int bj = 0; bj < 2; ++bj)
#pragma unroll
                        for (int n = 0; n < 2; ++n) { const f32x4 ov = sv[mm][bj][n] * 1.41421356237f + gv[bj][n] * acc[ai][bj][m][n]; if (!dry) *(f32x4*)(dbase + off + bj * HALF + n * 16) = ov; } }
                asm volatile("" ::: "memory");
            }
    }
};

template <class Epi, class Sched>
__device__ __forceinline__ void gemm_phase(PG8_LAS unsigned char* lds, const Gemm g, const Sched& S, const Epi& E, const int tid_in) {
    const int tid = tid_in, wid = __builtin_amdgcn_readfirstlane(tid >> 6), lane = tid & 63, wr = wid >> 2, wc = wid & 3, fr = lane & 15, fq = lane >> 4;
    const int K = g.K, nt = K / BK;
    unsigned voffA[2], voffB[2];
#pragma unroll
    for (int i = 0; i < 2; ++i) { int R, C; stage_rc(tid * 16 + i * 8192, R, C); const int Rb = Epi::PERM ? ((R & ~31) + perm32(R & 31)) : R;
        voffA[i] = (unsigned)(R * g.lda + C) * 2u; voffB[i] = (unsigned)(Rb * g.ldb + C) * 2u; }
    const size_t kstep = (size_t)(BK * 2);
    const size_t hstepA = (size_t)HALF * g.lda * 2, hstepB = (size_t)HALF * g.ldb * 2;
    const size_t tstepA = 2 * hstepA, tstepB = 2 * hstepB;
    const unsigned ldsw = (unsigned)wid * 1024u;
    const int aoff = lds_byte(wr * 64 + fr, fq * 8), boff = lds_byte(wc * 32 + fr, fq * 8);
#define PG8_SA(b, h) (((b) * 2 + (h)) * HTB)
#define PG8_SB(b, h) ((4 + (b) * 2 + (h)) * HTB)
#define PG8_STAGE(bufoff, gbase, voff) do { _Pragma("unroll") for (int _i = 0; _i < 2; ++_i) \
        __builtin_amdgcn_global_load_lds((const unsigned*)((const char*)(gbase) + (voff)[_i]), (PG8_LAS unsigned*)(lds + (bufoff) + ldsw + _i * 8192), 16, 0, 0); } while (0)
#define PG8_LDA(dst, b, h) do { _Pragma("unroll") for (int m = 0; m < 4; ++m) _Pragma("unroll") for (int k = 0; k < 2; ++k) dst[m][k] = *(const PG8_LAS bf16x8*)(lds + PG8_SA(b, h) + aoff + m * 2048 + k * 1024); } while (0)
#define PG8_LDB(dst, b, h) do { _Pragma("unroll") for (int n = 0; n < 2; ++n) _Pragma("unroll") for (int k = 0; k < 2; ++k) dst[n][k] = *(const PG8_LAS bf16x8*)(lds + PG8_SB(b, h) + boff + n * 2048 + k * 1024); } while (0)
#define PG8_MMA(ai, bj, At, Bt) do { __builtin_amdgcn_s_setprio(1); _Pragma("unroll") for (int m = 0; m < 4; ++m) _Pragma("unroll") for (int n = 0; n < 2; ++n) _Pragma("unroll") for (int k = 0; k < 2; ++k) \
        acc[ai][bj][m][n] = __builtin_amdgcn_mfma_f32_16x16x32_bf16(Bt[n][k], At[m][k], acc[ai][bj][m][n], 0, 0, 0); __builtin_amdgcn_s_setprio(0); } while (0)
#define PG8_WAIT_V(n) asm volatile("s_waitcnt vmcnt(" #n ")" ::: "memory")
#define PG8_WAIT_L(n) asm volatile("s_waitcnt lgkmcnt(" #n ")" ::: "memory")
#define PG8_BAR __builtin_amdgcn_s_barrier()
#define PG8_SCHED __builtin_amdgcn_sched_barrier(0)
    Unit cur, nxt; int ui = 0;
    if (!S.next(0, cur)) return;
    f32x4 acc[2][2][4][2];
#pragma unroll
    for (int a = 0; a < 2; ++a)
#pragma unroll
        for (int b = 0; b < 2; ++b)
#pragma unroll
            for (int m = 0; m < 4; ++m)
#pragma unroll
                for (int n = 0; n < 2; ++n) acc[a][b][m][n] = (f32x4){0.f, 0.f, 0.f, 0.f};
    bf16x8 At[4][2], B0[2][2], B1[2][2];
    const char* cA = (const char*)g.A + (size_t)cur.pm * tstepA; const char* cB = (const char*)g.Bt + (size_t)cur.pn * tstepB;
    S.a_ready(cur);
    PG8_STAGE(PG8_SB(0, 0), cB, voffB); PG8_STAGE(PG8_SA(0, 0), cA, voffA); PG8_STAGE(PG8_SB(0, 1), cB + hstepB, voffB); PG8_STAGE(PG8_SA(0, 1), cA + hstepA, voffA);
    if (wr == 1) PG8_BAR;
    PG8_WAIT_V(4); PG8_BAR;
    PG8_STAGE(PG8_SB(1, 0), cB + kstep, voffB); PG8_STAGE(PG8_SA(1, 0), cA + kstep, voffA); PG8_STAGE(PG8_SB(1, 1), cB + hstepB + kstep, voffB);
    PG8_WAIT_V(6); PG8_BAR;
    for (;;) {
        const bool has_next = S.next(ui + 1, nxt);
        const char* nA = has_next ? (const char*)g.A + (size_t)nxt.pm * tstepA : cA; const char* nB = has_next ? (const char*)g.Bt + (size_t)nxt.pn * tstepB : cB;
        for (int t = 0; t < nt; t += 2) {
            const bool last = (t == nt - 2);
            const char* a1 = cA + (size_t)(t + 1) * kstep;
            const char* a2 = last ? nA : cA + (size_t)(t + 2) * kstep; const char* b2 = last ? nB : cB + (size_t)(t + 2) * kstep;
            const char* a3 = a2 + kstep; const char* b3 = b2 + kstep;
            if (last && has_next) S.a_ready(nxt);
            PG8_LDB(B0, 0, 0); PG8_SCHED; PG8_LDA(At, 0, 0); PG8_STAGE(PG8_SA(1, 1), a1 + hstepA, voffA);
            PG8_WAIT_L(8); PG8_BAR; PG8_WAIT_L(0); PG8_MMA(0, 0, At, B0); PG8_BAR; PG8_SCHED;
            PG8_LDB(B1, 0, 1); PG8_STAGE(PG8_SB(0, 0), b2, voffB);
            PG8_BAR; PG8_WAIT_L(0); PG8_MMA(0, 1, At, B1); PG8_BAR;
            PG8_LDA(At, 0, 1); PG8_STAGE(PG8_SA(0, 0), a2, voffA);
            PG8_BAR; PG8_WAIT_L(0); PG8_MMA(1, 0, At, B0); PG8_BAR; PG8_SCHED;
            PG8_STAGE(PG8_SB(0, 1), b2 + hstepB, voffB);
            PG8_WAIT_V(6); PG8_BAR; PG8_MMA(1, 1, At, B1); PG8_BAR;
            PG8_LDB(B0, 1, 0); PG8_SCHED; PG8_LDA(At, 1, 0); PG8_STAGE(PG8_SA(0, 1), a2 + hstepA, voffA);
            PG8_WAIT_L(8); PG8_BAR; PG8_WAIT_L(0); PG8_MMA(0, 0, At, B0); PG8_BAR; PG8_SCHED;
            PG8_LDB(B1, 1, 1); PG8_STAGE(PG8_SB(1, 0), b3, voffB);
            PG8_BAR; PG8_WAIT_L(0); PG8_MMA(0, 1, At, B1); PG8_BAR;
            PG8_LDA(At, 1, 1); PG8_STAGE(PG8_SA(1, 0), a3, voffA);
            PG8_BAR; PG8_WAIT_L(0); PG8_MMA(1, 0, At, B0); PG8_BAR; PG8_SCHED;
            PG8_STAGE(PG8_SB(1, 1), b3 + hstepB, voffB);
            PG8_WAIT_V(6); PG8_BAR; PG8_MMA(1, 1, At, B1); PG8_BAR;
        }
        if constexpr (!Epi::AFTER_DRAIN) { E(acc, cur, wr, wc, fr, fq); S.done(cur); }
        if (!has_next) break;
#pragma unroll
        for (int a = 0; a < 2; ++a)
#pragma unroll
            for (int b = 0; b < 2; ++b)
#pragma unroll
                for (int m = 0; m < 4; ++m)
#pragma unroll
                    for (int n = 0; n < 2; ++n) acc[a][b][m][n] = (f32x4){0.f, 0.f, 0.f, 0.f};
        cur = nxt; cA = nA; cB = nB; ++ui;
    }
    PG8_WAIT_V(0);
    if (wr == 0) PG8_BAR;
    PG8_BAR;
    if constexpr (Epi::AFTER_DRAIN) { E.fused(acc, cur, wr, wc, fr, fq, lds, wid, lane); S.done(cur); }
#undef PG8_SA
#undef PG8_SB
#undef PG8_STAGE
#undef PG8_LDA
#undef PG8_LDB
#undef PG8_MMA
#undef PG8_WAIT_V
#undef PG8_WAIT_L
#undef PG8_BAR
#undef PG8_SCHED
}
}

#define XB_TMO      128
#define XB_XCNT(j)  (256  + 64 * (j))
#define XB_XSUB(j)  (1280 + 64 * (j))
#define XB_XGEN(j)  (2304 + 64 * (j))
#define XB_TOP      3328
#define XB_TOPGEN   3392
#define XCD_BAR_WORDS 3456
#define XB_SPIN_CAP (1u << 18)

__device__ __forceinline__ unsigned xb_ld(unsigned* p)              { return __hip_atomic_load(p, __ATOMIC_RELAXED, __HIP_MEMORY_SCOPE_AGENT); }
__device__ __forceinline__ unsigned xb_add(unsigned* p, unsigned v) { return __hip_atomic_fetch_add(p, v, __ATOMIC_RELAXED, __HIP_MEMORY_SCOPE_AGENT); }
__device__ __forceinline__ unsigned xb_xcc_id() { return (unsigned)__builtin_amdgcn_s_getreg((3 << 11) | 20) & 0xFu; }
#define XB_SPIN(cond, bar) do { unsigned _sp = 0; while (cond) { __builtin_amdgcn_s_sleep(1); \
    if ((++_sp & 255u) == 0u) { if (xb_ld(&(bar)[XB_TMO])) break; if (_sp > XB_SPIN_CAP) { atomicAdd(&(bar)[XB_TMO], 1u); break; } } } } while (0)

struct XcdBarrier {
    unsigned* bar; unsigned x;
    volatile LAS unsigned* st;
};

__device__ __forceinline__ XcdBarrier xcd_barrier_post(unsigned* bar, volatile LAS unsigned* st) {
    XcdBarrier b; b.bar = bar; b.x = xb_xcc_id(); b.st = st;
    if (threadIdx.x == 0) (void)xb_add(&bar[XB_XCNT(b.x)], 1u);
    return b;
}
__device__ __forceinline__ void xcd_barrier_complete(unsigned* bar, unsigned x, unsigned& nloc, unsigned& nx) {
    const unsigned G = gridDim.x * gridDim.y * gridDim.z;
    unsigned sum, cnt, mine, sp = 0u;
    for (;;) {
        sum = 0u; cnt = 0u; mine = 0u;
#pragma unroll
        for (unsigned j = 0; j < 16; ++j) { const unsigned c = xb_ld(&bar[XB_XCNT(j)]); sum += c; cnt += (c > 0u) ? 1u : 0u; mine = (j == x) ? c : mine; }
        if (sum == G) break;
        __builtin_amdgcn_s_sleep(1);
        if ((++sp & 255u) == 0u) { if (xb_ld(&bar[XB_TMO])) break; if (sp > XB_SPIN_CAP) { atomicAdd(&bar[XB_TMO], 1u); break; } }
    }
    nloc = mine > 0u ? mine : 1u; nx = cnt > 0u ? cnt : 1u;
}

__device__ __forceinline__ void xcd_barrier(const XcdBarrier& b) {
    asm volatile("s_waitcnt vmcnt(0)" ::: "memory");
    __syncthreads();
    if (threadIdx.x == 0) {
        unsigned* bar = b.bar;
        __builtin_amdgcn_s_waitcnt(0);
        unsigned nloc = b.st[0], nx = b.st[1];
        if (nloc == 0u) { xcd_barrier_complete(bar, b.x, nloc, nx); b.st[0] = nloc; b.st[1] = nx; }
        const unsigned old = xb_add(&bar[XB_XSUB(b.x)], 1u);
        const unsigned gen = old / nloc;
        if (old + 1u == (gen + 1u) * nloc) {
            __builtin_amdgcn_fence(__ATOMIC_RELEASE, "agent");
            asm volatile("s_waitcnt vmcnt(0)" ::: "memory");
            const unsigned og = xb_add(&bar[XB_TOP], 1u);
            const unsigned tg = og / nx;
            if (og + 1u == (tg + 1u) * nx) xb_add(&bar[XB_TOPGEN], 1u);
            else XB_SPIN(xb_ld(&bar[XB_TOPGEN]) == tg, bar);
            __builtin_amdgcn_fence(__ATOMIC_ACQUIRE, "agent");
            xb_add(&bar[XB_XGEN(b.x)], 1u);
            asm volatile("s_waitcnt vmcnt(0)" ::: "memory");
        } else {
            XB_SPIN(xb_ld(&bar[XB_XGEN(b.x)]) == gen, bar);
            __builtin_amdgcn_fence(__ATOMIC_ACQUIRE, "agent");
            asm volatile("s_waitcnt vmcnt(0)" ::: "memory");
        }
    }
    __syncthreads();
}


__device__ __forceinline__ f32x4 mma(bf16x8 a, bf16x8 b, f32x4 c) { return __builtin_amdgcn_mfma_f32_16x16x32_bf16(a, b, c, 0, 0, 0); }
__device__ __forceinline__ bf16x8 frag_row(const LAS bf16* t, int ld, int r0, int c0, int lane) {
    return *(const LAS bf16x8*)(t + (r0 + (lane & 15)) * ld + c0 + 8 * (lane >> 4));
}
__device__ __forceinline__ bf16x8 frag_tr(const LAS bf16* t, int ld, int r0, int c0, int lane) {
    const int g = lane >> 4, q = (lane & 15) >> 2, p = lane & 3;
    const LAS bf16* a = t + (r0 + 8 * g + q) * ld + c0 + 4 * p;
    const s16x4 lo = __builtin_amdgcn_ds_read_tr16_b64_v4i16((LAS s16x4*)a);
    const s16x4 hi = __builtin_amdgcn_ds_read_tr16_b64_v4i16((LAS s16x4*)(a + 4 * ld));
    return (bf16x8){lo[0], lo[1], lo[2], lo[3], hi[0], hi[1], hi[2], hi[3]};
}
#define LDS_FENCE() do { asm volatile("s_waitcnt lgkmcnt(0)" ::: "memory"); __builtin_amdgcn_wave_barrier(); } while (0)

struct Args {
    const float* in[22]; float* out; unsigned char* ws;
};
enum { I_X = 0, I_C, I_CTX, I_CCTX, I_WMOD, I_BMOD, I_LNW, I_LNB, I_ABWIN, I_ABGB, I_ABNW, I_ABSINK, I_ABWOUT, I_GWIN, I_GGUP, I_GGB, I_GNW, I_GWOUT, I_PWQ, I_PKEYS, I_PU, I_PV };

__device__ __forceinline__ const float* srow_c(const float* lat, const float* ctx, int r) { const int b = r / PB, p = r - b * PB; return p < LC ? ctx + (size_t)(b * LC + p) * D : lat + (size_t)(b * SEQ + p - LC) * D; }
__device__ __forceinline__ float* srow(float* lat, float* ctx, int r) { const int b = r / PB, p = r - b * PB; return p < LC ? ctx + (size_t)(b * LC + p) * D : lat + (size_t)(b * SEQ + p - LC) * D; }

__device__ __forceinline__ void p0_transpose_item(const float* W, int K, int ldw, int c0, int ncols, bf16* WT, int row_off, LAS float* scr, int item, int lane,
                                                  int s0lo, int s0hi, float s0, int s1lo, int s1hi, float s1) {
    const int nblk = ncols / 32, kb = item / nblk, nb = item % nblk, k0 = 64 * kb, n0 = 32 * nb;
#pragma unroll 8
    for (int i = 0; i < 32; ++i) { const int kk = 2 * i + (lane >> 5); scr[kk * 33 + (lane & 31)] = W[(size_t)(k0 + kk) * ldw + c0 + n0 + (lane & 31)]; }
    asm volatile("s_waitcnt lgkmcnt(0)" ::: "memory");
    const int c = lane & 7;
#pragma unroll
    for (int j = 0; j < 4; ++j) { const int n = (lane >> 3) + 8 * j; const LAS float* s = scr + (8 * c) * 33 + n;
        const int dr = row_off + n0 + n; float sc = 1.f; if (dr >= s0lo && dr < s0hi) sc = s0; if (dr >= s1lo && dr < s1hi) sc = s1;
        v4u o; o.x = pk2(s[0 * 33] * sc, s[1 * 33] * sc); o.y = pk2(s[2 * 33] * sc, s[3 * 33] * sc); o.z = pk2(s[4 * 33] * sc, s[5 * 33] * sc); o.w = pk2(s[6 * 33] * sc, s[7 * 33] * sc);
        *(v4u*)(WT + (size_t)dr * K + k0 + 8 * c) = o; }
    asm volatile("s_waitcnt lgkmcnt(0)" ::: "memory");
}
__device__ __forceinline__ void cvt_f32_bf16(const float* src, bf16* dst, size_t n, int gtid, int gthreads) {
    const size_t nch = n / 8;
    for (size_t i = gtid; i < nch; i += gthreads) { const f32x4 a = *(const f32x4*)(src + i * 8), b = *(const f32x4*)(src + i * 8 + 4);
        v4u o; o.x = pk2(a[0], a[1]); o.y = pk2(a[2], a[3]); o.z = pk2(b[0], b[1]); o.w = pk2(b[2], b[3]); *(v4u*)(dst + i * 8) = o; }
}
__device__ __forceinline__ void cvt_rows_fp8(const float* src, unsigned char* dst, float* inv, int nrows, int gw, int NGW, int lane) {
    for (int r = gw; r < nrows; r += 2 * NGW) {
        f32x4 x[2][4]; float m[2];
#pragma unroll
        for (int u = 0; u < 2; ++u) { const float* sp = src + (size_t)(r + u * NGW) * 1024 + 4 * lane; m[u] = 0.f;
#pragma unroll
            for (int q = 0; q < 4; ++q) { x[u][q] = *(const f32x4*)(sp + 256 * q); m[u] = fmaxf(m[u], fmaxf(fmaxf(fabsf(x[u][q][0]), fabsf(x[u][q][1])), fmaxf(fabsf(x[u][q][2]), fabsf(x[u][q][3])))); } }
#pragma unroll
        for (int u = 0; u < 2; ++u) {
            m[u] = fmaxf(m[u], dppmov_f<0xB1>(m[u])); m[u] = fmaxf(m[u], dppmov_f<0x4E>(m[u])); m[u] = fmaxf(m[u], dppmov_f<0x141>(m[u])); m[u] = fmaxf(m[u], dppmov_f<0x128>(m[u]));
            m[u] = fmaxf(m[u], __shfl_xor(m[u], 16)); m[u] = fmaxf(m[u], __shfl_xor(m[u], 32));
            const float sc = m[u] > 0.f ? 224.f / m[u] : 1.f;
            unsigned char* dp = dst + (size_t)(r + u * NGW) * 1024 + 4 * lane;
#pragma unroll
            for (int q = 0; q < 4; ++q) { int w = 0; w = __builtin_amdgcn_cvt_pk_fp8_f32(x[u][q][0] * sc, x[u][q][1] * sc, w, false); w = __builtin_amdgcn_cvt_pk_fp8_f32(x[u][q][2] * sc, x[u][q][3] * sc, w, true); *(unsigned*)(dp + 256 * q) = (unsigned)w; }
            if (lane == 0) inv[r + u * NGW] = m[u] > 0.f ? m[u] / 224.f : 1.f; }
    }
}
__device__ __forceinline__ void p0_prologue(const Args& A, LAS unsigned char* lds, int vcu, int G, int wave, int lane, int tid) {
    unsigned char* ws = A.ws;
    const int gw = vcu * 8 + wave, NGW = G * 8, gtid = vcu * 512 + tid, gthreads = G * 512;
    LAS float* sil = (LAS float*)lds;
    for (int i = tid; i < 9 * 1024; i += 512) { const float v = i < 8192 ? A.in[I_C][i] : A.in[I_CCTX][i - 8192]; sil[i] = siluf_(v); }
    __syncthreads();
    float* MOD = (float*)(ws + WS_MOD);
    LAS float* part = (LAS float*)(lds + 40960);
    for (int it = vcu; it < 2 * 96; it += G) {
        const int l = it / 96, n = (it % 96) * 64 + lane; const float* wm = A.in[I_WMOD] + (size_t)l * 1024 * 6144 + (size_t)(128 * wave) * 6144 + n;
        float acc[9];
#pragma unroll
        for (int r = 0; r < 9; ++r) acc[r] = 0.f;
#pragma unroll 8
        for (int k = 0; k < 128; ++k) { const float w = wm[(size_t)k * 6144];
#pragma unroll
            for (int r = 0; r < 9; ++r) acc[r] += sil[r * 1024 + 128 * wave + k] * w; }
        __syncthreads();
#pragma unroll
        for (int r = 0; r < 9; ++r) part[(wave * 9 + r) * 64 + lane] = acc[r];
        __syncthreads();
        for (int i = tid; i < 9 * 64; i += 512) { float sum = 0.f;
#pragma unroll
            for (int w8 = 0; w8 < 8; ++w8) sum += part[w8 * 576 + i];
            const int r = i >> 6, c = (it % 96) * 64 + (i & 63); MOD[(size_t)(l * 9 + r) * 6144 + c] = sum + A.in[I_BMOD][l * 6144 + c]; }
    }
    __syncthreads();
    LAS float* scr = (LAS float*)(lds + 40960 + wave * 8704);
    constexpr int I_AB1 = 16 * 64, I_AB2 = 16 * 24, I_ABO = 16 * 32, I_C1 = 16 * 96, I_CO = 16 * 32, I_Q = 16 * 64;
    constexpr int NITEMS = I_AB1 + I_AB2 + I_ABO + I_C1 + I_CO + 2 * I_Q;
    const float rs128 = 0.08838834764831845f;
    for (int it = gw; it < NITEMS; it += NGW) {
        int r = it;
        if (r < I_AB1) { p0_transpose_item(A.in[I_ABWIN], 1024, 2832, 0, 2048, (bf16*)(ws + WS_WAB), 0, scr, r, lane, 512, 1024, rs128, 0, 0, 1.f); continue; } r -= I_AB1;
        if (r < I_AB2) { p0_transpose_item(A.in[I_ABWIN], 1024, 2832, 2064, 768, (bf16*)(ws + WS_WAB), 2048, scr, r, lane, 2048, 2560, 0.125f, 0, 0, 1.f); continue; } r -= I_AB2;
        if (r < I_ABO) { p0_transpose_item(A.in[I_ABWOUT], 1024, 1024, 0, 1024, (bf16*)(ws + WS_WABO), 0, scr, r, lane, 0, 0, 1.f, 0, 0, 1.f); continue; } r -= I_ABO;
        if (r < I_C1) { p0_transpose_item(A.in[I_GWIN], 1024, 3104, 0, 3072, (bf16*)(ws + WS_WC), 0, scr, r, lane, 0, 512, rs128, 0, 0, 1.f); continue; } r -= I_C1;
        if (r < I_CO) { p0_transpose_item(A.in[I_GWOUT], 1024, 1024, 0, 1024, (bf16*)(ws + WS_WCO), 0, scr, r, lane, 0, 0, 1.f, 0, 0, 1.f); continue; } r -= I_CO;
        if (r < I_Q) { p0_transpose_item(A.in[I_PWQ], 1024, 2048, 0, 2048, (bf16*)(ws + WS_WQ0), 0, scr, r, lane, 0, 0, 1.f, 0, 0, 1.f); continue; } r -= I_Q;
        p0_transpose_item(A.in[I_PWQ] + (size_t)1024 * 2048, 1024, 2048, 0, 2048, (bf16*)(ws + WS_WQ1), 0, scr, r, lane, 0, 0, 1.f, 0, 0, 1.f);
    }
    for (int i = gtid; i < 16 * 1024; i += gthreads) { const int g = i >> 10, k = i & 1023; ((float*)(ws + WS_WG))[i] = A.in[I_ABWIN][(size_t)k * 2832 + 2048 + g]; }
    for (int i = gtid; i < 32 * 1024; i += gthreads) { const int g = i >> 10, k = i & 1023; ((float*)(ws + WS_WLOW))[i] = A.in[I_GWIN][(size_t)k * 3104 + 3072 + g]; }
    for (int i = gtid; i < 64 * 16; i += gthreads) { const int pos = i >> 4, f = i & 15; const float inv = powf(10000.f, -(float)f / 16.f); const float ang = (float)pos * inv;
        ((float*)(ws + WS_ROPE))[2 * i] = cosf(ang); ((float*)(ws + WS_ROPE))[2 * i + 1] = sinf(ang); }
    cvt_f32_bf16(A.in[I_PKEYS], (bf16*)(ws + WS_KEYS), (size_t)2 * 8 * 2 * 128 * 128, gtid, gthreads);
    cvt_rows_fp8(A.in[I_PU], ws + WS_U, (float*)(ws + WS_SCL), 2 * NEXP, gw, NGW, lane);
    cvt_rows_fp8(A.in[I_PV], ws + WS_V, (float*)(ws + WS_SCL) + 2 * NEXP, 2 * NEXP, gw, NGW, lane);
}

__device__ __forceinline__ void split8(const float* v, bf16x8& hi, bf16x8& lo) {
#pragma unroll
    for (int j = 0; j < 8; ++j) { const unsigned h = f2bf(v[j]); const float hf = __builtin_bit_cast(float, h << 16); hi[j] = (short)h; lo[j] = (short)f2bf(v[j] - hf); }
}
template <int NG>
__device__ __forceinline__ void h_phase(const float* lat, const float* ctx, const float* mod  , bf16* HB, const float* WGT, float* GL, LAS unsigned char* lds, int vcu, int G, int wave, int lane, int tid) {
    constexpr int NT = NG / 16;
    LAS float* part = (LAS float*)lds;
    const int g = lane >> 4, c16 = lane & 15;
    bf16x8 bhi[NT][4], blo[NT][4];
#pragma unroll
    for (int nt = 0; nt < NT; ++nt)
#pragma unroll
        for (int ks = 0; ks < 4; ++ks) { const float* wp = WGT + (size_t)(16 * nt + c16) * 1024 + 128 * wave + 32 * ks + 8 * g;
            const f32x4 w0 = *(const f32x4*)wp, w1 = *(const f32x4*)(wp + 4); const float wv[8] = {w0[0], w0[1], w0[2], w0[3], w1[0], w1[1], w1[2], w1[3]}; split8(wv, bhi[nt][ks], blo[nt][ks]); }
    for (int tile = vcu; tile < TT / 16; tile += G) {
        const int r0 = tile * 16, b = r0 / PB, p0 = r0 - b * PB; const float* mr = mod + (size_t)(p0 < LC ? 8 : b) * 6144 + 128 * wave + 8 * g;
        const int row = r0 + c16; const float* xr = srow_c(lat, ctx, row) + 128 * wave + 8 * g;
        f32x4 xa[4][2], sha[4][2], sca[4][2];
#pragma unroll
        for (int ks = 0; ks < 4; ++ks)
#pragma unroll
            for (int q = 0; q < 2; ++q) { xa[ks][q] = *(const f32x4*)(xr + 32 * ks + 4 * q); sha[ks][q] = *(const f32x4*)(mr + 32 * ks + 4 * q); sca[ks][q] = *(const f32x4*)(mr + 1024 + 32 * ks + 4 * q); }
        f32x4 acc[NT];
#pragma unroll
        for (int nt = 0; nt < NT; ++nt) acc[nt] = (f32x4){0.f, 0.f, 0.f, 0.f};
#pragma unroll
        for (int ks = 0; ks < 4; ++ks) {
            float hv[8];
#pragma unroll
            for (int q = 0; q < 2; ++q)
#pragma unroll
                for (int i = 0; i < 4; ++i) hv[4 * q + i] = xa[ks][q][i] * (sca[ks][q][i] + 1.0f) + sha[ks][q][i];
            bf16x8 ahi, alo; split8(hv, ahi, alo);
            *(bf16x8*)(HB + (size_t)row * D + 128 * wave + 32 * ks + 8 * g) = ahi;
#pragma unroll
            for (int nt = 0; nt < NT; ++nt) { acc[nt] = mma(ahi, bhi[nt][ks], acc[nt]); acc[nt] = mma(ahi, blo[nt][ks], acc[nt]); acc[nt] = mma(alo, bhi[nt][ks], acc[nt]); }
        }
        __syncthreads();
#pragma unroll
        for (int nt = 0; nt < NT; ++nt)
#pragma unroll
            for (int r = 0; r < 4; ++r) part[(wave * 16 + 4 * g + r) * NG + 16 * nt + c16] = acc[nt][r];
        __syncthreads();
        for (int i = tid; i < 16 * NG; i += 512) { float sum = 0.f;
#pragma unroll
            for (int w8 = 0; w8 < 8; ++w8) sum += part[w8 * 16 * NG + i];
            GL[(size_t)r0 * NG + i] = sum; }
    }
}

__device__ __forceinline__ void ln_row(const float* sr, float* xr, const bf16* yrow, const float* mr, const float* lnw, const float* lnb, bf16* hrow, int lane, int dry, bool active) {
    f32x4 v[4]; float s = 0.f;
#pragma unroll
    for (int j = 0; j < 4; ++j) { const int c = 4 * lane + 256 * j; const f32x4 x = *(const f32x4*)(sr + c), g1 = *(const f32x4*)(mr + 2048 + c); const v2u yw = *(const v2u*)(yrow + c);
        v[j][0] = DN_ALPHA * x[0] + g1[0] * bflo(yw.x); v[j][1] = DN_ALPHA * x[1] + g1[1] * bfhi(yw.x); v[j][2] = DN_ALPHA * x[2] + g1[2] * bflo(yw.y); v[j][3] = DN_ALPHA * x[3] + g1[3] * bfhi(yw.y);
        s += (v[j][0] + v[j][1]) + (v[j][2] + v[j][3]); }
    const float mean = wave_sum(s) * (1.f / D); float s2 = 0.f;
#pragma unroll
    for (int j = 0; j < 4; ++j) { v[j] = v[j] - mean; s2 += (v[j][0] * v[j][0] + v[j][1] * v[j][1]) + (v[j][2] * v[j][2] + v[j][3] * v[j][3]); }
    const float rstd = 1.f / sqrtf(wave_sum(s2) * (1.f / D) + LN_EPS);
    if (active) {
#pragma unroll
    for (int j = 0; j < 4; ++j) { const int c = 4 * lane + 256 * j; const f32x4 w = *(const f32x4*)(lnw + c), bb = *(const f32x4*)(lnb + c);
        const f32x4 x1 = v[j] * rstd * w + bb; if (!dry) *(f32x4*)(xr + c) = x1;
        const f32x4 sh = *(const f32x4*)(mr + 3072 + c), sc = *(const f32x4*)(mr + 4096 + c); const f32x4 hp = x1 * (sc + 1.0f) + sh;
        v2u o; o.x = pk2(hp[0], hp[1]); o.y = pk2(hp[2], hp[3]); if (!dry) *(v2u*)(hrow + c) = o; }
    }
}
__device__ __forceinline__ void ln_phase(const float* slat, const float* sctx, float* lat, float* ctx, const bf16* Y, const float* mod, const float* lnw, const float* lnb, bf16* HB, int gw, int NGW, int lane, int dry, bool lat_only) {
    const int nrows = lat_only ? NB * SEQ : TT;
    for (int i0 = gw; i0 < nrows; i0 += 2 * NGW) {
        const int i1 = i0 + NGW; const bool has1 = i1 < nrows; const int r0 = map_row(i0, lat_only), r1c = map_row(has1 ? i1 : i0, lat_only);
        const int b0 = r0 / PB, p0 = r0 - b0 * PB, b1 = r1c / PB, p1 = r1c - b1 * PB;
        ln_row(srow_c(slat, sctx, r0), srow(lat, ctx, r0), Y + (size_t)r0 * D, mod + (size_t)(p0 < LC ? 8 : b0) * 6144, lnw, lnb, HB + (size_t)r0 * D, lane, dry, true);
        ln_row(srow_c(slat, sctx, r1c), srow(lat, ctx, r1c), Y + (size_t)r1c * D, mod + (size_t)(p1 < LC ? 8 : b1) * 6144, lnw, lnb, HB + (size_t)r1c * D, lane, dry, has1);
    }
}

constexpr int AT_LD = 72;
__device__ __forceinline__ bf16x8 frag_tr_perm(const LAS bf16* t, int ld, int r0, int c0, int lane) {
    const int g = lane >> 4, q = (lane & 15) >> 2, p = lane & 3;
    const LAS bf16* a = t + (r0 + 4 * g + q) * ld + c0 + 4 * p;
    const s16x4 lo = __builtin_amdgcn_ds_read_tr16_b64_v4i16((LAS s16x4*)a);
    const s16x4 hi = __builtin_amdgcn_ds_read_tr16_b64_v4i16((LAS s16x4*)(a + 16 * ld));
    return (bf16x8){lo[0], lo[1], lo[2], lo[3], hi[0], hi[1], hi[2], hi[3]};
}
__device__ __forceinline__ void attn_phase(const bf16* P, bf16* CAT, const float* sink, const float* ropetab, LAS unsigned char* lds, unsigned* qctr, int vcu, int G, int wave, int lane, int tid) {
    LAS bf16* Kt = (LAS bf16*)lds;
    LAS bf16* Vt = (LAS bf16*)(lds + 9216);
    LAS bf16* Qw = (LAS bf16*)(lds + 18432 + wave * 4608);
    const int g = lane >> 4, c16 = lane & 15;
    volatile LAS int* qslot = (volatile LAS int*)(lds + MISC_OFF) + 12;
    for (;;) {
        if (tid == 0) *qslot = (int)__hip_atomic_fetch_add(qctr, 1u, __ATOMIC_RELAXED, __HIP_MEMORY_SCOPE_AGENT);
        __syncthreads();
        const int item = *qslot;
        if (item >= 1024 + 64) break;
        const bool is_ctx = item >= 1024;
        int b, hk, nb;
        if (!is_ctx) { b = item >> 7; hk = (item >> 6) & 1; nb = item & 63; } else { const int it = item - 1024; b = it >> 3; hk = (it >> 2) & 1; nb = it & 3; }
        const int head = hk * 4 + (wave >> 1);
        const int qrow0 = b * PB + (is_ctx ? 0 : LC) + nb * 64 + (wave & 1) * 32;
        const int qlat0 = nb * 64 + (wave & 1) * 32;
        __syncthreads();
#pragma unroll
        for (int i = 0; i < 4; ++i) { const int cidx = lane + 64 * i, rr = cidx >> 3, ch = cidx & 7;
            const v4u raw = *(const v4u*)(P + (size_t)(qrow0 + rr) * N_AB + 2048 + head * 64 + ch * 8); v4u o = raw;
            if (!is_ctx) { const int tl = qlat0 + rr; const int pos = (ch < 4) ? (tl >> 6) : (tl & 63); const float* tb = ropetab + (size_t)(pos * 16 + (ch & 3) * 4) * 2;
                const unsigned wv[4] = {raw.x, raw.y, raw.z, raw.w}; unsigned ov[4];
#pragma unroll
                for (int k = 0; k < 4; ++k) { const float x1 = bflo(wv[k]), x2 = bfhi(wv[k]), c = tb[2 * k], s = tb[2 * k + 1]; ov[k] = pk2(x1 * c - x2 * s, x1 * s + x2 * c); }
                o.x = ov[0]; o.y = ov[1]; o.z = ov[2]; o.w = ov[3]; }
            *(LAS v4u*)(Qw + rr * AT_LD + ch * 8) = o; }
        LDS_FENCE();
        bf16x8 qf[2][2];
#pragma unroll
        for (int mt = 0; mt < 2; ++mt)
#pragma unroll
            for (int ks = 0; ks < 2; ++ks) qf[mt][ks] = frag_row(Qw, AT_LD, 16 * mt, 32 * ks, lane);
        LDS_FENCE();
        f32x4 o[2][4]; float mrun[2], lrun[2];
        const float sk = sink[head];
#pragma unroll
        for (int qt = 0; qt < 2; ++qt) { mrun[qt] = sk; lrun[qt] = 1.f; }
#pragma unroll
        for (int qt = 0; qt < 2; ++qt)
#pragma unroll
            for (int nt = 0; nt < 4; ++nt) o[qt][nt] = (f32x4){0.f, 0.f, 0.f, 0.f};
        const int nkt = is_ctx ? 4 : 9;
        const int srr = tid >> 3, sch = tid & 7;
        int kt = 0; f32x2 trope[4];
#pragma unroll
        for (int i = 0; i < 4; ++i) trope[i] = (f32x2){1.f, 0.f};
        v4u kraw = *(const v4u*)(P + (size_t)(b * PB + srr) * N_AB + 2560 + hk * 64 + sch * 8), vraw = *(const v4u*)(P + (size_t)(b * PB + srr) * N_AB + 2688 + hk * 64 + sch * 8);
        while (kt < nkt) {
            const int kp0 = nb * 64 - 128 + 64 * (kt - 4);
            int kn = kt + 1;
            while (kn < nkt && kn >= 4 && ((nb * 64 - 128 + 64 * (kn - 4)) < 0 || (nb * 64 - 128 + 64 * (kn - 4)) >= SEQ)) ++kn;
            __syncthreads();
            { v4u o = kraw;
              if (kt >= 4) { const unsigned wv[4] = {kraw.x, kraw.y, kraw.z, kraw.w}; unsigned ov[4];
#pragma unroll
                  for (int i = 0; i < 4; ++i) { const float x1 = bflo(wv[i]), x2 = bfhi(wv[i]), c = trope[i][0], sn = trope[i][1]; ov[i] = pk2(x1 * c - x2 * sn, x1 * sn + x2 * c); }
                  o.x = ov[0]; o.y = ov[1]; o.z = ov[2]; o.w = ov[3]; }
              *(LAS v4u*)(Kt + srr * AT_LD + sch * 8) = o; *(LAS v4u*)(Vt + srr * AT_LD + sch * 8) = vraw; }
            if (kn < nkt) { const int kpn = nb * 64 - 128 + 64 * (kn - 4); const int krn = b * PB + (kn < 4 ? 64 * kn : LC + kpn);
                kraw = *(const v4u*)(P + (size_t)(krn + srr) * N_AB + 2560 + hk * 64 + sch * 8); vraw = *(const v4u*)(P + (size_t)(krn + srr) * N_AB + 2688 + hk * 64 + sch * 8);
                if (kn >= 4) { const int tl = kpn + srr; const int pos = (sch < 4) ? (tl >> 6) : (tl & 63); const f32x2* tb = (const f32x2*)(ropetab + (size_t)(pos * 16 + (sch & 3) * 4) * 2);
#pragma unroll
                    for (int i = 0; i < 4; ++i) trope[i] = tb[i]; } }
            __syncthreads();
            const bool need_mask = (kt == 4) || (kt == 8);
            bf16x8 kf[4][2];
#pragma unroll
            for (int km = 0; km < 4; ++km)
#pragma unroll
                for (int ks = 0; ks < 2; ++ks) kf[km][ks] = frag_row(Kt, AT_LD, 16 * km, 32 * ks, lane);
            bf16x8 pa[2][2];
#pragma unroll
            for (int qt = 0; qt < 2; ++qt) {
                f32x4 st[4];
#pragma unroll
                for (int km = 0; km < 4; ++km) { st[km] = (f32x4){0.f, 0.f, 0.f, 0.f};
#pragma unroll
                    for (int ks = 0; ks < 2; ++ks) st[km] = mma(kf[km][ks], qf[qt][ks], st[km]); }
                if (need_mask) {
#pragma unroll
                    for (int km = 0; km < 4; ++km)
#pragma unroll
                        for (int r = 0; r < 4; ++r) { const int dq = (kp0 + 16 * km + 4 * g + r) - (qlat0 + 16 * qt + c16); if (dq > 128 || dq < -128) st[km][r] = -3.0e38f; } }
                float mx = fmaxf(fmaxf(fmaxf(st[0][0], st[0][1]), fmaxf(st[0][2], st[0][3])), fmaxf(fmaxf(st[1][0], st[1][1]), fmaxf(st[1][2], st[1][3])));
                mx = fmaxf(mx, fmaxf(fmaxf(fmaxf(st[2][0], st[2][1]), fmaxf(st[2][2], st[2][3])), fmaxf(fmaxf(st[3][0], st[3][1]), fmaxf(st[3][2], st[3][3]))));
                mx = fmaxf(mx, __shfl_xor(mx, 16)); mx = fmaxf(mx, __shfl_xor(mx, 32));
                const float mnew = fmaxf(mrun[qt], mx), alpha = __expf(mrun[qt] - mnew);
                float ps = 0.f;
#pragma unroll
                for (int km = 0; km < 4; ++km)
#pragma unroll
                    for (int r = 0; r < 4; ++r) { const float pv = __expf(st[km][r] - mnew); st[km][r] = pv; ps += pv; }
                ps += __shfl_xor(ps, 16); ps += __shfl_xor(ps, 32);
                lrun[qt] = lrun[qt] * alpha + ps; mrun[qt] = mnew;
#pragma unroll
                for (int ks2 = 0; ks2 < 2; ++ks2) { const unsigned w0 = pk2(st[2 * ks2][0], st[2 * ks2][1]), w1 = pk2(st[2 * ks2][2], st[2 * ks2][3]), w2 = pk2(st[2 * ks2 + 1][0], st[2 * ks2 + 1][1]), w3 = pk2(st[2 * ks2 + 1][2], st[2 * ks2 + 1][3]);
                    const v4u wv = (v4u){w0, w1, w2, w3}; pa[qt][ks2] = __builtin_bit_cast(bf16x8, wv); }
#pragma unroll
                for (int r = 0; r < 4; ++r) { const float ar = __shfl(alpha, (lane & 48) + 4 * g + r);
#pragma unroll
                    for (int nt = 0; nt < 4; ++nt) o[qt][nt][r] *= ar; }
            }
#pragma unroll
            for (int ks2 = 0; ks2 < 2; ++ks2) {
                bf16x8 vf[4];
#pragma unroll
                for (int nt = 0; nt < 4; ++nt) vf[nt] = frag_tr_perm(Vt, AT_LD, 32 * ks2, 16 * nt, lane);
#pragma unroll
                for (int qt = 0; qt < 2; ++qt)
#pragma unroll
                    for (int nt = 0; nt < 4; ++nt) o[qt][nt] = mma(pa[qt][ks2], vf[nt], o[qt][nt]); }
            LDS_FENCE();
            kt = kn;
        }
#pragma unroll
        for (int qt = 0; qt < 2; ++qt)
#pragma unroll
            for (int r = 0; r < 4; ++r) { const float inv = 1.f / __shfl(lrun[qt], (lane & 48) + 4 * g + r); bf16* orow = CAT + (size_t)(qrow0 + 16 * qt + 4 * g + r) * D + 512 + head * 64;
#pragma unroll
                for (int nt = 0; nt < 4; ++nt) orow[16 * nt + c16] = (bf16)f2bf(o[qt][nt][r] * inv); }
    }
}

__device__ __forceinline__ float wave_prefix_sum(float v) {
    v += __builtin_bit_cast(float, __builtin_amdgcn_update_dpp(0, __builtin_bit_cast(int, v), 0x111, 0xf, 0xf, true)); v += __builtin_bit_cast(float, __builtin_amdgcn_update_dpp(0, __builtin_bit_cast(int, v), 0x112, 0xf, 0xf, true));
    v += __builtin_bit_cast(float, __builtin_amdgcn_update_dpp(0, __builtin_bit_cast(int, v), 0x114, 0xf, 0xf, true)); v += __builtin_bit_cast(float, __builtin_amdgcn_update_dpp(0, __builtin_bit_cast(int, v), 0x118, 0xf, 0xf, true));
    v += __builtin_bit_cast(float, __builtin_amdgcn_update_dpp(0, __builtin_bit_cast(int, v), 0x142, 0xa, 0xf, false)); v += __builtin_bit_cast(float, __builtin_amdgcn_update_dpp(0, __builtin_bit_cast(int, v), 0x143, 0xc, 0xf, false));
    return v;
}
__device__ __forceinline__ float wave_prefix_max(float v) {
    const int ninf = (int)0xff800000u;
    v = fmaxf(v, __builtin_bit_cast(float, __builtin_amdgcn_update_dpp(ninf, __builtin_bit_cast(int, v), 0x111, 0xf, 0xf, false))); v = fmaxf(v, __builtin_bit_cast(float, __builtin_amdgcn_update_dpp(ninf, __builtin_bit_cast(int, v), 0x112, 0xf, 0xf, false)));
    v = fmaxf(v, __builtin_bit_cast(float, __builtin_amdgcn_update_dpp(ninf, __builtin_bit_cast(int, v), 0x114, 0xf, 0xf, false))); v = fmaxf(v, __builtin_bit_cast(float, __builtin_amdgcn_update_dpp(ninf, __builtin_bit_cast(int, v), 0x118, 0xf, 0xf, false)));
    v = fmaxf(v, __builtin_bit_cast(float, __builtin_amdgcn_update_dpp(ninf, __builtin_bit_cast(int, v), 0x142, 0xa, 0xf, false))); v = fmaxf(v, __builtin_bit_cast(float, __builtin_amdgcn_update_dpp(ninf, __builtin_bit_cast(int, v), 0x143, 0xc, 0xf, false)));
    return v;
}
__device__ __forceinline__ void mlstm_gate_scan(const float* GL  , const float* gate_b  , unsigned char* ws, int gw, int NGW, int lane) {
    float* BQ = (float*)(ws + WS_BQ); float* CQ = (float*)(ws + WS_CQ); float* EM = (float*)(ws + WS_EM); float* AI = (float*)(ws + WS_AI);
    float* AST = (float*)(ws + WS_AST); float* CL = (float*)(ws + WS_CL);
    for (int chain = gw; chain < 64; chain += NGW) {
        const int dir = chain >> 5, b = (chain >> 2) & 7, h = chain & 3;
        const float bi = gate_b[dir * 8 + h], bfg = gate_b[dir * 8 + 4 + h];
        float m_st = 0.f;
        float gi_n, gf_n;
        { const int j0 = dir == 0 ? 0 : 3; const int p0 = j0 * 64 + (dir == 0 ? lane : 63 - lane); const float* gr = GL + (size_t)(b * PB + p0) * 16 + dir * 8; gi_n = gr[h]; gf_n = gr[4 + h]; }
        for (int sc = 0; sc < NCH; ++sc) {
            const int j = dir == 0 ? sc : (sc < 4 ? 3 - sc : 71 - sc);
            const int p = j * 64 + (dir == 0 ? lane : 63 - lane);
            const float li = gi_n + bi, lf = logsigmoidf_(gf_n + bfg);
            if (sc + 1 < NCH) { const int sn = sc + 1; const int jn = dir == 0 ? sn : (sn < 4 ? 3 - sn : 71 - sn); const int pn = jn * 64 + (dir == 0 ? lane : 63 - lane);
                const float* gr = GL + (size_t)(b * PB + pn) * 16 + dir * 8; gi_n = gr[h]; gf_n = gr[4 + h]; }
            const float cum = wave_prefix_sum(lf);
            const float bb = li - cum; const float pm = wave_prefix_max(bb);
            const float c = fmaxf(m_st, pm);
            const size_t ti = (size_t)chain * PB + p;
            BQ[ti] = bb; CQ[ti] = c; EM[ti] = __expf(-(cum + c)); AI[ti] = __expf(m_st - c);
            const float cl = __builtin_bit_cast(float, __builtin_amdgcn_readlane(__builtin_bit_cast(int, c), 63)), tot = __builtin_bit_cast(float, __builtin_amdgcn_readlane(__builtin_bit_cast(int, cum), 63));
            if (lane == 0) { CL[chain * NCH + j] = cl; AST[chain * NCH + j] = __expf(m_st - cl); }
            m_st = tot + cl;
        }
    }
}


__device__ __forceinline__ float logsig_fast(float x) { return fminf(x, 0.f) - __logf(1.f + __expf(-fabsf(x))); }
__device__ __forceinline__ void gla_prep(bf16* P, bf16* QKR, const float* LOW  , const float* gate_up  , const float* gate_b  , unsigned char* ws,
                                         LAS unsigned char* lds, int vcu, int G, int tid, int dry) {
    float* ET = (float*)(ws + WS_ET);
    LAS float* lowt = (LAS float*)lds;
    LAS bf16* qs = (LAS bf16*)(lds + 8192);
    LAS bf16* ks = (LAS bf16*)(lds + 24576);
    LAS float* LA = (LAS float*)(lds + 40960);
    LAS float* HT = (LAS float*)(lds + 106496);
    const int dc = tid & 255, dir = dc >> 7, ch = dc & 127, half = tid >> 8;
    for (int item = vcu; item < NB * NCH * 4; item += G) {
        const int b = item / (NCH * 4), j = (item >> 2) % NCH, h = item & 3;
        const int row0 = b * PB + j * 64, c = h * 128 + ch;
        __syncthreads();
        for (int i = tid; i < 64 * 32; i += 512) lowt[i] = LOW[(size_t)row0 * 32 + i];
#pragma unroll
        for (int i = 0; i < 2; ++i) { const int cidx = tid + 512 * i, rr = cidx >> 4, c8 = cidx & 15; const bf16* src = P + (size_t)(row0 + rr) * N_C + h * 128 + c8 * 8;
            *(LAS v4u*)(qs + rr * 128 + c8 * 8) = *(const v4u*)src; *(LAS v4u*)(ks + rr * 128 + c8 * 8) = *(const v4u*)(src + 512); }
        float gu[16];
#pragma unroll
        for (int k = 0; k < 16; ++k) gu[k] = gate_up[(size_t)(dir * 16 + k) * 512 + c];
        const float gb = gate_b[dir * 512 + c];
        __syncthreads();
        float hsum = 0.f;
#pragma unroll 4
        for (int i = 0; i < 32; ++i) { const int t = half * 32 + i; float x = gb;
#pragma unroll
            for (int k = 0; k < 16; ++k) x += lowt[t * 32 + dir * 16 + k] * gu[k];
            const float la = logsig_fast(x) * (1.f / 16.f); LA[t * 256 + dc] = la; hsum += la; }
        HT[half * 256 + dc] = hsum;
        __syncthreads();
        float cum = (dir == 0) ? (half == 1 ? HT[dc] : 0.f) : (half == 0 ? HT[256 + dc] : 0.f);
#pragma unroll 4
        for (int i = 0; i < 32; ++i) { const int t = half * 32 + (dir == 0 ? i : 31 - i);
            cum += LA[t * 256 + dc];
            const float e = __expf(cum), ei = __expf(-cum);
            const size_t ro = (size_t)(row0 + t) * N_C;
            const float qv = bf2f(qs[t * 128 + ch]), kv = bf2f(ks[t * 128 + ch]);
            if (dir == 0) { if (!dry) { P[ro + c] = (bf16)f2bf(qv * e); P[ro + 512 + c] = (bf16)f2bf(kv * ei); } }
            else { QKR[(size_t)(row0 + t) * 1024 + c] = (bf16)f2bf(qv * e); QKR[(size_t)(row0 + t) * 1024 + 512 + c] = (bf16)f2bf(kv * ei); } }
        if (half == 0) ET[((size_t)((dir * 8 + b) * 4 + h) * NCH + j) * 128 + ch] = __expf(HT[dc] + HT[256 + dc]);
    }
}


__device__ __forceinline__ unsigned f2sort(float f) { const unsigned u = __builtin_bit_cast(unsigned, f); return (u & 0x80000000u) ? ~u : (u | 0x80000000u); }
__device__ __forceinline__ float sort2f(unsigned s) { const unsigned u = (s & 0x80000000u) ? (s & 0x7fffffffu) : ~s; return __builtin_bit_cast(float, u); }
template <int CTRL> __device__ __forceinline__ unsigned dppmov_u(unsigned x) { return (unsigned)__builtin_amdgcn_mov_dpp((int)x, CTRL, 0xf, 0xf, true); }
__device__ __forceinline__ unsigned gmax16(unsigned x) { unsigned y;
    y = dppmov_u<0xB1>(x); x = x > y ? x : y; y = dppmov_u<0x4E>(x); x = x > y ? x : y; y = dppmov_u<0x141>(x); x = x > y ? x : y; y = dppmov_u<0x128>(x); x = x > y ? x : y; return x; }
__device__ __forceinline__ float gsum16(float x) {
    x += __builtin_bit_cast(float, dppmov_u<0xB1>(__builtin_bit_cast(unsigned, x))); x += __builtin_bit_cast(float, dppmov_u<0x4E>(__builtin_bit_cast(unsigned, x)));
    x += __builtin_bit_cast(float, dppmov_u<0x141>(__builtin_bit_cast(unsigned, x))); x += __builtin_bit_cast(float, dppmov_u<0x128>(__builtin_bit_cast(unsigned, x))); return x; }
#define CSWAP(a, b) do { const unsigned hi_ = (a) > (b) ? (a) : (b), lo_ = (a) > (b) ? (b) : (a); (a) = hi_; (b) = lo_; } while (0)
__device__ __forceinline__ void peer_route(const bf16* Q, const bf16* KEYS, int* EID, float* GWT, int gw, int NGW, int lane, bool lat_only) {
    const int g = lane >> 4, c16 = lane & 15, gbase = lane & 48;
    const int nwi = (lat_only ? NB * SEQ / 16 : TT / 16) * 8;
    for (int wi = gw; wi < nwi; wi += NGW) {
        const int t0 = map_row((wi >> 3) * 16, lat_only), head = wi & 7;
        unsigned tops[2][4];
#pragma unroll
        for (int p = 0; p < 2; ++p) {
            const bf16* qrow = Q + (size_t)(t0 + c16) * 2048 + head * 256 + p * 128 + 8 * g;
            bf16x8 qf[4];
#pragma unroll
            for (int ks = 0; ks < 4; ++ks) qf[ks] = *(const bf16x8*)(qrow + 32 * ks);
            const bf16* kb = KEYS + (size_t)(head * 2 + p) * 128 * 128 + (size_t)c16 * 128 + 8 * g;
            unsigned key[8][4];
#pragma unroll
            for (int nt = 0; nt < 8; ++nt) { f32x4 s = (f32x4){0.f, 0.f, 0.f, 0.f};
#pragma unroll
                for (int ks = 0; ks < 4; ++ks) s = mma(qf[ks], *(const bf16x8*)(kb + (size_t)nt * 16 * 128 + 32 * ks), s);
#pragma unroll
                for (int r = 0; r < 4; ++r) key[nt][r] = (f2sort(s[r]) & ~127u) | (unsigned)(127 - (16 * nt + c16)); }
            unsigned kk[4][8];
#pragma unroll
            for (int r = 0; r < 4; ++r) {
#pragma unroll
                for (int nt = 0; nt < 8; ++nt) kk[r][nt] = key[nt][r];
                CSWAP(kk[r][0], kk[r][1]); CSWAP(kk[r][2], kk[r][3]); CSWAP(kk[r][4], kk[r][5]); CSWAP(kk[r][6], kk[r][7]); CSWAP(kk[r][0], kk[r][2]); CSWAP(kk[r][1], kk[r][3]); CSWAP(kk[r][4], kk[r][6]); CSWAP(kk[r][5], kk[r][7]);
                CSWAP(kk[r][1], kk[r][2]); CSWAP(kk[r][5], kk[r][6]); CSWAP(kk[r][0], kk[r][4]); CSWAP(kk[r][1], kk[r][5]); CSWAP(kk[r][2], kk[r][6]); CSWAP(kk[r][3], kk[r][7]); CSWAP(kk[r][2], kk[r][4]); CSWAP(kk[r][3], kk[r][5]);
                CSWAP(kk[r][1], kk[r][2]); CSWAP(kk[r][3], kk[r][4]); CSWAP(kk[r][5], kk[r][6]); }
            unsigned tt[4] = {0u, 0u, 0u, 0u};
#pragma unroll 2
            for (int rd = 0; rd < 16; ++rd) {
#pragma unroll
                for (int r = 0; r < 4; ++r) { const unsigned m = gmax16(kk[r][0]); const bool w = (kk[r][0] == m);
#pragma unroll
                    for (int q = 0; q < 7; ++q) kk[r][q] = w ? kk[r][q + 1] : kk[r][q];
                    kk[r][7] = w ? 0u : kk[r][7];
                    tt[r] = (c16 == rd) ? m : tt[r]; } }
#pragma unroll
            for (int r = 0; r < 4; ++r) tops[p][r] = tt[r];
        }
        float v0[4], s1v[4]; int ptr[4]; unsigned res[4];
#pragma unroll
        for (int r = 0; r < 4; ++r) { v0[r] = sort2f(tops[0][r] & ~127u); s1v[r] = sort2f((unsigned)__shfl((int)tops[1][r], gbase) & ~127u); ptr[r] = 0; res[r] = 0u; }
#pragma unroll 2
        for (int rd = 0; rd < 16; ++rd) {
#pragma unroll
            for (int r = 0; r < 4; ++r) {
                const unsigned ck = ptr[r] < 16 ? ((f2sort(v0[r] + s1v[r]) & ~255u) | (unsigned)((15 - c16) << 4) | (unsigned)(15 - ptr[r])) : 0u;
                const unsigned m = gmax16(ck);
                res[r] = (c16 == rd) ? m : res[r];
                if (ck == m) ++ptr[r];
                s1v[r] = sort2f((unsigned)__shfl((int)tops[1][r], gbase + (ptr[r] < 15 ? ptr[r] : 15)) & ~127u); } }
#pragma unroll
        for (int r = 0; r < 4; ++r) {
            const float val = sort2f(res[r] & ~255u); const int ii = 15 - (int)((res[r] >> 4) & 15u), jj = 15 - (int)(res[r] & 15u);
            const float mx = __shfl(val, gbase);
            const float ex = __expf(val - mx), sum = gsum16(ex);
            const unsigned i0 = 127u - ((unsigned)__shfl((int)tops[0][r], gbase + ii) & 127u), i1 = 127u - ((unsigned)__shfl((int)tops[1][r], gbase + jj) & 127u);
            const size_t o = (size_t)(t0 + 4 * g + r) * 128 + head * 16 + c16;
            EID[o] = (int)(i0 * 128u + i1); GWT[o] = ex / sum;
        }
    }
}

__device__ __forceinline__ void unpack8(const v4u w, float* o) { o[0] = bflo(w.x); o[1] = bfhi(w.x); o[2] = bflo(w.y); o[3] = bfhi(w.y); o[4] = bflo(w.z); o[5] = bfhi(w.z); o[6] = bflo(w.w); o[7] = bfhi(w.w); }
__device__ __forceinline__ void unpack16_fp8(const v4u w, float* o) {
    const unsigned ww[4] = {w.x, w.y, w.z, w.w};
#pragma unroll
    for (int i = 0; i < 4; ++i) { const f32x2 lo = __builtin_amdgcn_cvt_pk_f32_fp8((int)ww[i], false), hi = __builtin_amdgcn_cvt_pk_f32_fp8((int)ww[i], true);
        o[4 * i] = lo[0]; o[4 * i + 1] = lo[1]; o[4 * i + 2] = hi[0]; o[4 * i + 3] = hi[1]; }
}
__device__ __forceinline__ int rev3(int x) { return ((x & 1) << 2) | (x & 2) | ((x >> 2) & 1); }
__device__ __forceinline__ void peer_pass1(const bf16* HB, const int* EID, const float* GWT, const unsigned char* U8, const float* SUi, const float* SVi, float* COEF, int gw, int NGW, int lane, bool lat_only) {
    const int myslot = 8 * (lane & 7) + rev3(lane >> 3);
    const bool b5 = (lane & 32) != 0, b4 = (lane & 16) != 0, b3 = (lane & 8) != 0;
    const int nrows = lat_only ? NB * SEQ : TT;
    for (int ri = gw; ri < nrows; ri += NGW) {
        const int r = map_row(ri, lat_only);
        long hb_lo, hb_hi; float hsc_inv;
        { float h[16]; const v4u a = *(const v4u*)(HB + (size_t)r * D + 16 * lane), bq = *(const v4u*)(HB + (size_t)r * D + 16 * lane + 8); unpack8(a, h); unpack8(bq, h + 8);
          float m = 0.f;
#pragma unroll
          for (int i = 0; i < 16; ++i) m = fmaxf(m, fabsf(h[i]));
          m = fmaxf(m, dppmov_f<0xB1>(m)); m = fmaxf(m, dppmov_f<0x4E>(m)); m = fmaxf(m, dppmov_f<0x141>(m)); m = fmaxf(m, dppmov_f<0x128>(m)); m = fmaxf(m, __shfl_xor(m, 16)); m = fmaxf(m, __shfl_xor(m, 32));
          const float sc8 = m > 0.f ? 224.f / m : 1.f; hsc_inv = m > 0.f ? m / 224.f : 1.f;
          unsigned hw[4];
#pragma unroll
          for (int q = 0; q < 4; ++q) { int w = 0; w = __builtin_amdgcn_cvt_pk_fp8_f32(h[4 * q] * sc8, h[4 * q + 1] * sc8, w, false); w = __builtin_amdgcn_cvt_pk_fp8_f32(h[4 * q + 2] * sc8, h[4 * q + 3] * sc8, w, true); hw[q] = (unsigned)w; }
          hb_lo = (long)(((unsigned long long)hw[1] << 32) | hw[0]); hb_hi = (long)(((unsigned long long)hw[3] << 32) | hw[2]); }
        const bool diag = (lane >> 4) == ((lane & 15) >> 2); const int dsel = lane & 3;
        const float dw0 = (diag && dsel == 0) ? 1.f : 0.f, dw1 = (diag && dsel == 1) ? 1.f : 0.f, dw2 = (diag && dsel == 2) ? 1.f : 0.f, dw3 = (diag && dsel == 3) ? 1.f : 0.f;
#pragma unroll 1
        for (int half = 0; half < 2; ++half) {
            const int eid = EID[(size_t)r * 128 + half * 64 + myslot]; const float gwt = GWT[(size_t)r * 128 + half * 64 + myslot];
            float dotreg = 0.f;
#pragma unroll 2
            for (int gI = 0; gI < 8; ++gI) {
                v4u raw[8];
#pragma unroll
                for (int vi = 0; vi < 8; ++vi) { const int id = __builtin_amdgcn_readlane(eid, gI + 8 * rev3(vi)); raw[vi] = *(const v4u*)(U8 + (size_t)id * 1024 + 16 * lane); }
                float a[8];
#pragma unroll
                for (int vi = 0; vi < 8; ++vi) {
                    f32x4 dd4 = (f32x4){0.f, 0.f, 0.f, 0.f};
                    dd4 = __builtin_amdgcn_mfma_f32_16x16x32_fp8_fp8((long)(((unsigned long long)raw[vi].y << 32) | raw[vi].x), hb_lo, dd4, 0, 0, 0);
                    dd4 = __builtin_amdgcn_mfma_f32_16x16x32_fp8_fp8((long)(((unsigned long long)raw[vi].w << 32) | raw[vi].z), hb_hi, dd4, 0, 0, 0);
                    a[vi] = (dd4[0] * dw0 + dd4[1] * dw1) + (dd4[2] * dw2 + dd4[3] * dw3); }
                float bb[4];
#pragma unroll
                for (int k = 0; k < 4; ++k) { const float keep = b5 ? a[2 * k + 1] : a[2 * k], send = b5 ? a[2 * k] : a[2 * k + 1]; bb[k] = keep + __shfl_xor(send, 32); }
                float cc[2];
#pragma unroll
                for (int k = 0; k < 2; ++k) { const float keep = b4 ? bb[2 * k + 1] : bb[2 * k], send = b4 ? bb[2 * k] : bb[2 * k + 1]; cc[k] = keep + __shfl_xor(send, 16); }
                float dd; { const float keep = b3 ? cc[1] : cc[0], send = b3 ? cc[0] : cc[1]; dd = keep + __shfl_xor(send, 8); }
                dd += __shfl_xor(dd, 4); dd += __shfl_xor(dd, 2); dd += __shfl_xor(dd, 1);
                dotreg = ((lane & 7) == gI) ? dd : dotreg;
            }
            const float dot = dotreg * SUi[eid] * hsc_inv;
            const float coef = gwt * 0.5f * dot * (1.f + erff(dot * 0.70710678118f)) * SVi[eid];
            COEF[(size_t)r * 128 + half * 64 + myslot] = coef;
        }
    }
}
template <bool USE_PEER>
__device__ __forceinline__ void peer_expert(const float* COEF, const int* EID, const unsigned char* V8,
                                            float* lat, float* ctx, const float* mod, const float* lnw, const float* lnb, int gw, int NGW, int lane, int dry, bool lat_only) {
    const int myslot = 8 * (lane & 7) + rev3(lane >> 3);
    const int nrows = lat_only ? NB * SEQ : TT;
    for (int ri = gw; ri < nrows; ri += NGW) {
        const int r = map_row(ri, lat_only);
        const int b = r / PB, p = r - b * PB; float* xr = srow(lat, ctx, r); const float* mr = mod + (size_t)(p < LC ? 8 : b) * 6144;
        float f[16];
#pragma unroll
        for (int i = 0; i < 16; ++i) f[i] = 0.f;
        if (USE_PEER) {
#pragma unroll 1
        for (int half = 0; half < 2; ++half) {
            const int eid = EID[(size_t)r * 128 + half * 64 + myslot];
            const float coef = COEF[(size_t)r * 128 + half * 64 + myslot];
            v4u ring[8];
#pragma unroll
            for (int k = 0; k < 8; ++k) { const int id = __builtin_amdgcn_readlane(eid, k); ring[k] = *(const v4u*)(V8 + (size_t)id * 1024 + 16 * lane); }
#pragma unroll 1
            for (int e0 = 0; e0 < 64; e0 += 8) {
#pragma unroll
                for (int k = 0; k < 8; ++k) { const float c = __builtin_bit_cast(float, __builtin_amdgcn_readlane(__builtin_bit_cast(int, coef), e0 + k));
                    float w[16]; unpack16_fp8(ring[k], w);
                    const int en = (e0 + 8 + k) < 64 ? (e0 + 8 + k) : 63; const int idn = __builtin_amdgcn_readlane(eid, en);
                    ring[k] = *(const v4u*)(V8 + (size_t)idn * 1024 + 16 * lane);
#pragma unroll
                    for (int i = 0; i < 16; ++i) f[i] += c * w[i];
                    __builtin_amdgcn_sched_barrier(0); }
            }
        }
        }
        float v[16]; float s = 0.f;
#pragma unroll
        for (int q = 0; q < 4; ++q) { const int c = 16 * lane + 4 * q; const f32x4 x1 = *(const f32x4*)(xr + c), g2 = *(const f32x4*)(mr + 5120 + c);
#pragma unroll
            for (int i = 0; i < 4; ++i) { v[4 * q + i] = DN_ALPHA * x1[i] + g2[i] * f[4 * q + i]; s += v[4 * q + i]; } }
        const float mean = wave_sum(s) * (1.f / D); float s2 = 0.f;
#pragma unroll
        for (int i = 0; i < 16; ++i) { v[i] -= mean; s2 += v[i] * v[i]; }
        const float rstd = 1.f / sqrtf(wave_sum(s2) * (1.f / D) + LN_EPS);
#pragma unroll
        for (int q = 0; q < 4; ++q) { const int c = 16 * lane + 4 * q; const f32x4 w = *(const f32x4*)(lnw + c), bb2 = *(const f32x4*)(lnb + c); f32x4 o;
#pragma unroll
            for (int i = 0; i < 4; ++i) o[i] = v[4 * q + i] * rstd * w[i] + bb2[i];
            if (!dry) *(f32x4*)(xr + c) = o; }
    }
}

__device__ __forceinline__ bf16* od_row_base(unsigned char* ws, int dir, int b) {
    if (dir == 0) return (bf16*)(ws + WS_ST) + (size_t)b * SEQ * 1024;
    return b < 7 ? (bf16*)(ws + WS_ST + 64 * MiB) + (size_t)b * SEQ * 1024 : (bf16*)(ws + WS_XC);
}
__device__ __forceinline__ void gla_fused_scan(const bf16* P, const bf16* QKR, unsigned char* ws, LAS unsigned char* lds, int vcu, int G, int wave, int lane, int tid, int dry) {
    const float* ET = (const float*)(ws + WS_ET);
    LAS bf16* Qt = (LAS bf16*)lds;
    LAS bf16* Kt = (LAS bf16*)(lds + 34816);
    LAS bf16* Vt = (LAS bf16*)(lds + 69632);
    LAS bf16* SL = (LAS bf16*)(lds + 88064);
    LAS bf16* Pw = (LAS bf16*)(lds + 122880 + wave * 2304);
    const int g = lane >> 4, c16 = lane & 15, mt = wave & 3, cw = wave >> 2;
    for (int item = vcu; item < 256; item += G) {
        const int dir = item >> 7, b = (item >> 4) & 7, h = (item >> 2) & 3, eb = item & 3;
        const bf16* qsrc = dir == 0 ? P + h * 128 : QKR + h * 128; const int qld = dir == 0 ? N_C : 1024;
        const bf16* vsrc = P + 1024 + h * 256 + 64 * eb;
        const float* etp = ET + ((size_t)((dir * 8 + b) * 4 + h) * NCH) * 128 + 16 * wave + c16;
        bf16* odb = od_row_base(ws, dir, b) + h * 256 + 64 * eb;
        f32x4 acc[4];
#pragma unroll
        for (int et = 0; et < 4; ++et) acc[et] = (f32x4){0.f, 0.f, 0.f, 0.f};
        v4u qreg[2][2], kreg[2][2], vreg[2]; float etn[2];
#define GLA_JOF(sc_) (dir == 0 ? (sc_) : ((sc_) < 4 ? 3 - (sc_) : 71 - (sc_)))
#define GLA_PREFETCH(sc0_) do { _Pragma("unroll") for (int u = 0; u < 2; ++u) { const int jj = GLA_JOF((sc0_) + u); const int row0 = b * PB + jj * 64; \
            _Pragma("unroll") for (int i = 0; i < 2; ++i) { const int cidx = tid + 512 * i, rr = cidx >> 4, ch = cidx & 15; const bf16* sp = qsrc + (size_t)(row0 + rr) * qld + ch * 8; qreg[u][i] = *(const v4u*)sp; kreg[u][i] = *(const v4u*)(sp + 512); } \
            vreg[u] = *(const v4u*)(vsrc + (size_t)(row0 + (tid >> 3)) * N_C + (tid & 7) * 8); etn[u] = etp[(size_t)jj * 128]; } } while (0)
        GLA_PREFETCH(0);
        unsigned opk[8]; int ojc = -1;
#pragma unroll
        for (int i = 0; i < 8; ++i) opk[i] = 0u;
        for (int sc = 0; sc < NCH; sc += 2) {
            const int ja = GLA_JOF(sc), jb = GLA_JOF(sc + 1);
            __syncthreads();
            if (ojc >= 4 && !dry) {
#pragma unroll
                for (int nt = 0; nt < 4; ++nt) { bf16* orow = odb + (size_t)((ojc - 4) * 64 + 16 * mt + 4 * g) * 1024 + 16 * nt + c16;
#pragma unroll
                    for (int r = 0; r < 4; ++r) orow[(size_t)r * 1024] = (bf16)((opk[2 * nt + (r >> 1)] >> (16 * (r & 1))) & 0xffffu); } }
#pragma unroll
            for (int u = 0; u < 2; ++u) {
#pragma unroll
                for (int i = 0; i < 2; ++i) { const int cidx = tid + 512 * i, rr = cidx >> 4, ch = cidx & 15; *(LAS v4u*)(Qt + u * 8704 + rr * 136 + ch * 8) = qreg[u][i]; *(LAS v4u*)(Kt + u * 8704 + rr * 136 + ch * 8) = kreg[u][i]; }
                *(LAS v4u*)(Vt + u * 4608 + (tid >> 3) * 72 + (tid & 7) * 8) = vreg[u]; }
#pragma unroll
            for (int et = 0; et < 4; ++et)
#pragma unroll
                for (int r = 0; r < 4; ++r) SL[(16 * et + 4 * g + r) * 136 + 16 * wave + c16] = (bf16)f2bf(acc[et][r]);
            const float et_a = etn[0], et_b = etn[1];
            if (sc + 2 < NCH) GLA_PREFETCH(sc + 2);
            __syncthreads();
#pragma unroll
            for (int ks = 0; ks < 2; ++ks) { const bf16x8 kb = frag_tr(Kt, 136, 32 * ks, 16 * wave, lane);
#pragma unroll
                for (int et = 0; et < 4; ++et) acc[et] = mma(frag_tr(Vt, 72, 32 * ks, 16 * et, lane), kb, acc[et]); }
#pragma unroll
            for (int et = 0; et < 4; ++et) { acc[et] = acc[et] * et_a;
#pragma unroll
                for (int r = 0; r < 4; ++r) SL[8704 + (16 * et + 4 * g + r) * 136 + 16 * wave + c16] = (bf16)f2bf(acc[et][r]); }
            __syncthreads();
            const int jc = cw == 0 ? ja : jb;
            ojc = jc;
            if (jc >= 4) {
                const LAS bf16* Qc = Qt + cw * 8704; const LAS bf16* Kc = Kt + cw * 8704; const LAS bf16* Vc = Vt + cw * 4608; const LAS bf16* Sc = SL + cw * 8704;
                bf16x8 qf[4];
#pragma unroll
                for (int ks = 0; ks < 4; ++ks) qf[ks] = frag_row(Qc, 136, 16 * mt, 32 * ks, lane);
                bf16x8 pa[2];
                { f32x4 st[4];
#pragma unroll
                  for (int ns = 0; ns < 4; ++ns) { st[ns] = (f32x4){0.f, 0.f, 0.f, 0.f};
#pragma unroll
                      for (int ks = 0; ks < 4; ++ks) st[ns] = mma(frag_row(Kc, 136, 16 * ns, 32 * ks, lane), qf[ks], st[ns]);
#pragma unroll
                      for (int r = 0; r < 4; ++r) { const int sidx = 16 * ns + 4 * g + r, t = 16 * mt + c16; const bool ok = dir == 0 ? (sidx <= t) : (sidx >= t); st[ns][r] = ok ? st[ns][r] : 0.f; } }
#pragma unroll
                  for (int ks2 = 0; ks2 < 2; ++ks2) { const v4u wv = (v4u){pk2(st[2 * ks2][0], st[2 * ks2][1]), pk2(st[2 * ks2][2], st[2 * ks2][3]), pk2(st[2 * ks2 + 1][0], st[2 * ks2 + 1][1]), pk2(st[2 * ks2 + 1][2], st[2 * ks2 + 1][3])};
                      pa[ks2] = __builtin_bit_cast(bf16x8, wv); } }
#pragma unroll
                for (int nt = 0; nt < 4; ++nt) { f32x4 a = (f32x4){0.f, 0.f, 0.f, 0.f};
#pragma unroll
                    for (int ks = 0; ks < 4; ++ks) a = mma(qf[ks], frag_row(Sc, 136, 16 * nt, 32 * ks, lane), a);
                    a = mma(pa[0], frag_tr_perm(Vc, 72, 0, 16 * nt, lane), a); a = mma(pa[1], frag_tr_perm(Vc, 72, 32, 16 * nt, lane), a);
                    opk[2 * nt] = pk2(a[0], a[1]); opk[2 * nt + 1] = pk2(a[2], a[3]); }
                LDS_FENCE();
            }
#pragma unroll
            for (int ks = 0; ks < 2; ++ks) { const bf16x8 kb = frag_tr(Kt + 8704, 136, 32 * ks, 16 * wave, lane);
#pragma unroll
                for (int et = 0; et < 4; ++et) acc[et] = mma(frag_tr(Vt + 4608, 72, 32 * ks, 16 * et, lane), kb, acc[et]); }
#pragma unroll
            for (int et = 0; et < 4; ++et) acc[et] = acc[et] * et_b;
        }
        if (ojc >= 4 && !dry) {
#pragma unroll
            for (int nt = 0; nt < 4; ++nt) { bf16* orow = odb + (size_t)((ojc - 4) * 64 + 16 * mt + 4 * g) * 1024 + 16 * nt + c16;
#pragma unroll
                for (int r = 0; r < 4; ++r) orow[(size_t)r * 1024] = (bf16)((opk[2 * nt + (r >> 1)] >> (16 * (r & 1))) & 0xffffu); } }
#undef GLA_PREFETCH
#undef GLA_JOF
    }
}
__device__ __forceinline__ void gla_merge(bf16* P, const float* norm_w, unsigned char* ws, int gw, int NGW, int lane, int dry) {
    for (int i = gw; i < NB * SEQ; i += NGW) {
        const int b = i >> 12, lp = i & 4095; const size_t r = (size_t)b * PB + LC + lp;
        const bf16* of = od_row_base(ws, 0, b) + (size_t)lp * 1024 + 16 * lane; const bf16* orv = od_row_base(ws, 1, b) + (size_t)lp * 1024 + 16 * lane;
        bf16* grow = P + r * N_C + 2048 + 16 * lane;
        float x[16], y[16], gg[16];
        unpack8(*(const v4u*)of, x); unpack8(*(const v4u*)(of + 8), x + 8); unpack8(*(const v4u*)orv, y); unpack8(*(const v4u*)(orv + 8), y + 8);
        unpack8(*(const v4u*)grow, gg); unpack8(*(const v4u*)(grow + 8), gg + 8);
        float ss = 0.f;
#pragma unroll
        for (int k = 0; k < 16; ++k) { x[k] += y[k]; ss += x[k] * x[k]; }
        ss = gsum16(ss);
        const float rn = 1.f / sqrtf(ss * (1.f / 256.f) + LN_EPS);
        unsigned ow[8];
#pragma unroll
        for (int k = 0; k < 8; ++k) { const float4 dummy = make_float4(0.f, 0.f, 0.f, 0.f); (void)dummy;
            const float a = x[2 * k] * rn * norm_w[16 * lane + 2 * k] * siluf_(gg[2 * k]), c = x[2 * k + 1] * rn * norm_w[16 * lane + 2 * k + 1] * siluf_(gg[2 * k + 1]); ow[k] = pk2(a, c); }
        if (!dry) { v4u o0, o1; o0.x = ow[0]; o0.y = ow[1]; o0.z = ow[2]; o0.w = ow[3]; o1.x = ow[4]; o1.y = ow[5]; o1.z = ow[6]; o1.w = ow[7]; *(v4u*)grow = o0; *(v4u*)(grow + 8) = o1; }
    }
}

__device__ __forceinline__ void mlstm_fused_scan(const bf16* P, unsigned char* ws, LAS unsigned char* lds, int vcu, int G, int wave, int lane, int tid) {
    const float* BQ = (const float*)(ws + WS_BQ); const float* CQ = (const float*)(ws + WS_CQ); const float* EM = (const float*)(ws + WS_EM); const float* AI = (const float*)(ws + WS_AI);
    const float* AST = (const float*)(ws + WS_AST); const float* CL = (const float*)(ws + WS_CL);
    LAS bf16* Qt = (LAS bf16*)lds;
    LAS bf16* Kt = (LAS bf16*)(lds + 17408);
    LAS bf16* Vt = (LAS bf16*)(lds + 34816);
    LAS bf16* Vw = (LAS bf16*)(lds + 41984);
    LAS bf16* CT = (LAS bf16*)(lds + 49152);
    LAS bf16* Pw = (LAS bf16*)(lds + 62208 + wave * 2304);
    const int g = lane >> 4, c16 = lane & 15, mt = wave & 3, hf = wave >> 2;
    const int vrow = tid < 256 ? (tid >> 2) : ((tid - 256) & 63), vch = tid & 3;
    for (int item = vcu; item < 256; item += G) {
        const int dir = item >> 7, b = (item >> 4) & 7, h = (item >> 2) & 3, eb = item & 3;
        const int chain = dir * 32 + b * 4 + h;
        const bf16* qsrc = P + h * 128; const bf16* vsrc = P + 1024 + h * 128 + 32 * eb;
        bf16* odb = (bf16*)(ws + WS_ST) + (size_t)dir * TT * 512 + h * 128 + 32 * eb;
        f32x4 acc[3];
#pragma unroll
        for (int et = 0; et < 3; ++et) acc[et] = (f32x4){0.f, 0.f, 0.f, 0.f};
        v4u qreg[2], kreg[2], vreg; float bqr, cln, astn, cqn; f32x4 bqn[4], ain, emn;
        { const int j0 = dir == 0 ? 0 : 3; const int row0 = b * PB + j0 * 64; const size_t tb = (size_t)chain * PB + j0 * 64;
#pragma unroll
          for (int i = 0; i < 2; ++i) { const int cidx = tid + 512 * i, rr = cidx >> 4, ch = cidx & 15; const bf16* s = qsrc + (size_t)(row0 + rr) * N_AB + ch * 8; qreg[i] = *(const v4u*)s; kreg[i] = *(const v4u*)(s + 512); }
          vreg = *(const v4u*)(vsrc + (size_t)(row0 + vrow) * N_AB + vch * 8); bqr = BQ[tb + vrow]; cln = CL[chain * NCH + j0]; astn = AST[chain * NCH + j0];
#pragma unroll
          for (int k = 0; k < 4; ++k) bqn[k] = *(const f32x4*)(BQ + tb + 16 * k + 4 * g);
          cqn = CQ[tb + 16 * mt + c16]; ain = *(const f32x4*)(AI + tb + 16 * mt + 4 * g); emn = *(const f32x4*)(EM + tb + 16 * mt + 4 * g); }
        for (int sc = 0; sc < NCH; ++sc) {
            const int j = dir == 0 ? sc : (sc < 4 ? 3 - sc : 71 - sc);
            __syncthreads();
#pragma unroll
            for (int i = 0; i < 2; ++i) { const int cidx = tid + 512 * i, rr = cidx >> 4, ch = cidx & 15; *(LAS v4u*)(Qt + rr * 136 + ch * 8) = qreg[i]; *(LAS v4u*)(Kt + rr * 136 + ch * 8) = kreg[i]; }
            { const float wsv = __expf(bqr - cln);
              if (tid < 256) { const v4u raw = vreg; v4u o;
                  o.x = pk2(bflo(raw.x) * wsv, bfhi(raw.x) * wsv); o.y = pk2(bflo(raw.y) * wsv, bfhi(raw.y) * wsv); o.z = pk2(bflo(raw.z) * wsv, bfhi(raw.z) * wsv); o.w = pk2(bflo(raw.w) * wsv, bfhi(raw.w) * wsv);
                  *(LAS v4u*)(Vt + vrow * 56 + vch * 8) = raw; *(LAS v4u*)(Vw + vrow * 56 + vch * 8) = o;
              } else if (tid < 320) { v4u o; o.x = 0x3f80u; o.y = 0u; o.z = 0u; o.w = 0u; *(LAS v4u*)(Vt + vrow * 56 + 32) = o; o.x = f2bf(wsv); *(LAS v4u*)(Vw + vrow * 56 + 32) = o;
                  o.x = 0u; *(LAS v4u*)(Vt + vrow * 56 + 40) = o; *(LAS v4u*)(Vw + vrow * 56 + 40) = o; } }
#pragma unroll
            for (int et = 0; et < 3; ++et)
#pragma unroll
                for (int r = 0; r < 4; ++r) CT[(16 * et + 4 * g + r) * 136 + 16 * wave + c16] = (bf16)f2bf(acc[et][r]);
            const float ast = astn, cqt = cqn; f32x4 bq[4]; const f32x4 ai = ain, em = emn;
#pragma unroll
            for (int k = 0; k < 4; ++k) bq[k] = bqn[k];
            if (sc + 1 < NCH) { const int sn = sc + 1; const int jn = dir == 0 ? sn : (sn < 4 ? 3 - sn : 71 - sn); const int row0 = b * PB + jn * 64; const size_t tb = (size_t)chain * PB + jn * 64;
#pragma unroll
                for (int i = 0; i < 2; ++i) { const int cidx = tid + 512 * i, rr = cidx >> 4, ch = cidx & 15; const bf16* s = qsrc + (size_t)(row0 + rr) * N_AB + ch * 8; qreg[i] = *(const v4u*)s; kreg[i] = *(const v4u*)(s + 512); }
                vreg = *(const v4u*)(vsrc + (size_t)(row0 + vrow) * N_AB + vch * 8); bqr = BQ[tb + vrow]; cln = CL[chain * NCH + jn]; astn = AST[chain * NCH + jn];
#pragma unroll
                for (int k = 0; k < 4; ++k) bqn[k] = *(const f32x4*)(BQ + tb + 16 * k + 4 * g);
                cqn = CQ[tb + 16 * mt + c16]; ain = *(const f32x4*)(AI + tb + 16 * mt + 4 * g); emn = *(const f32x4*)(EM + tb + 16 * mt + 4 * g); }
            __syncthreads();
            bf16x8 qf[4];
#pragma unroll
            for (int ks = 0; ks < 4; ++ks) qf[ks] = frag_row(Qt, 136, 16 * mt, 32 * ks, lane);
            bf16x8 pa[2];
            { f32x4 st[4];
#pragma unroll
              for (int ns = 0; ns < 4; ++ns) { st[ns] = (f32x4){0.f, 0.f, 0.f, 0.f};
#pragma unroll
                  for (int ks = 0; ks < 4; ++ks) st[ns] = mma(frag_row(Kt, 136, 16 * ns, 32 * ks, lane), qf[ks], st[ns]);
#pragma unroll
                  for (int r = 0; r < 4; ++r) { const int sidx = 16 * ns + 4 * g + r, t = 16 * mt + c16; const bool ok = dir == 0 ? (sidx <= t) : (sidx >= t);
                      st[ns][r] = ok ? st[ns][r] * __expf(bq[ns][r] - cqt) : 0.f; } }
#pragma unroll
              for (int ks2 = 0; ks2 < 2; ++ks2) { const v4u wv = (v4u){pk2(st[2 * ks2][0], st[2 * ks2][1]), pk2(st[2 * ks2][2], st[2 * ks2][3]), pk2(st[2 * ks2 + 1][0], st[2 * ks2 + 1][1]), pk2(st[2 * ks2 + 1][2], st[2 * ks2 + 1][3])};
                  pa[ks2] = __builtin_bit_cast(bf16x8, wv); } }
            f32x4 av, ad;
            { f32x4 a = (f32x4){0.f, 0.f, 0.f, 0.f}, d = (f32x4){0.f, 0.f, 0.f, 0.f};
#pragma unroll
              for (int ks = 0; ks < 4; ++ks) { a = mma(qf[ks], frag_row(CT, 136, 16 * hf, 32 * ks, lane), a); d = mma(qf[ks], frag_row(CT, 136, 32, 32 * ks, lane), d); }
#pragma unroll
              for (int r = 0; r < 4; ++r) { a[r] *= ai[r]; d[r] *= ai[r]; }
#pragma unroll
              for (int ks = 0; ks < 2; ++ks) { a = mma(pa[ks], frag_tr_perm(Vt, 56, 32 * ks, 16 * hf, lane), a); d = mma(pa[ks], frag_tr_perm(Vt, 56, 32 * ks, 32, lane), d); }
              av = a; ad = d; }
            { bf16* orow = odb + (size_t)(b * PB + j * 64 + 16 * mt + 4 * g) * 512 + 16 * hf + c16;
#pragma unroll
              for (int r = 0; r < 4; ++r) { const float den = __shfl(ad[r], lane & 48); orow[(size_t)r * 512] = (bf16)f2bf(av[r] / fmaxf(fabsf(den), em[r])); } }
#pragma unroll
            for (int et = 0; et < 3; ++et) acc[et] = acc[et] * ast;
#pragma unroll
            for (int ks = 0; ks < 2; ++ks) { const bf16x8 kb = frag_tr(Kt, 136, 32 * ks, 16 * wave, lane);
#pragma unroll
                for (int et = 0; et < 3; ++et) acc[et] = mma(frag_tr(Vw, 56, 32 * ks, 16 * et, lane), kb, acc[et]); }
        }
    }
}
__device__ __forceinline__ void mlstm_merge(const bf16* P, bf16* CAT, const float* norm_w, unsigned char* ws, int gw, int NGW, int lane) {
    const bf16* OD = (const bf16*)(ws + WS_ST);
    for (int r = gw; r < TT; r += NGW) {
        float x[8], y[8], og[8];
        unpack8(*(const v4u*)(OD + (size_t)r * 512 + 8 * lane), x); unpack8(*(const v4u*)(OD + (size_t)TT * 512 + (size_t)r * 512 + 8 * lane), y);
        unpack8(*(const v4u*)(P + (size_t)r * N_AB + 1536 + 8 * lane), og);
        float ss = 0.f;
#pragma unroll
        for (int k = 0; k < 8; ++k) { x[k] += y[k]; ss += x[k] * x[k]; }
        ss = gsum16(ss);
        const float rn = 1.f / sqrtf(ss * (1.f / 128.f) + LN_EPS);
        unsigned ow[4];
#pragma unroll
        for (int k = 0; k < 4; ++k) ow[k] = pk2(x[2 * k] * rn * norm_w[8 * lane + 2 * k] * sigmoidf_(og[2 * k]), x[2 * k + 1] * rn * norm_w[8 * lane + 2 * k + 1] * sigmoidf_(og[2 * k + 1]));
        v4u o; o.x = ow[0]; o.y = ow[1]; o.z = ow[2]; o.w = ow[3]; *(v4u*)(CAT + (size_t)r * D + 8 * lane) = o;
    }
}

#ifndef PHMASK
#define PHMASK 0xffffffffu
#endif
#define PH(k) ((PHMASK >> (k)) & 1u)
#ifndef REPMASK
#define REPMASK 0u
#endif
#define REPS(k) (1 + (int)((REPMASK >> (k)) & 1u))
#if REPMASK
#define DRYV(k) ({ int d_ = (rep_ + 1 < REPS(k)) ? 1 : 0; asm volatile("" : "+s"(d_)); d_; })
#else
#define DRYV(k) 0
#endif
#ifndef DBG_LEVEL
#define DBG_LEVEL 3
#endif
typedef const __attribute__((address_space(4))) Args* KArgsP;
__device__ __forceinline__ KArgsP kargs() { KArgsP p = (KArgsP)__builtin_amdgcn_kernarg_segment_ptr(); asm volatile("" : "+s"(p)); return p; }
#define WSP(off) (ws + (off))
__global__ void __launch_bounds__(512, 2) fwd_megakernel(Args A_unused) {
    extern __shared__ __attribute__((aligned(16))) unsigned char lds_raw[];
    LAS unsigned char* lds = (LAS unsigned char*)lds_raw;
    const int tid0 = threadIdx.x;
    const int G = gridDim.x; const int bx = blockIdx.x; const int vcu = (G % 8 == 0) ? (bx % 8) * (G / 8) + bx / 8 : bx;
    const int NGW = G * 8;
    volatile LAS unsigned* MISC = (volatile LAS unsigned*)(lds + MISC_OFF);
    if (tid0 < 16) MISC[tid0] = 0u;
    __syncthreads();
    XcdBarrier bar;
    { KArgsP ap = kargs(); bar = xcd_barrier_post((unsigned*)(ap->ws + WS_CTL) + 1024, MISC + 8); }
#define GRID_BAR() xcd_barrier(bar)
#define PROLOG KArgsP ap = kargs(); unsigned char* ws = ap->ws; (void)ws; int tid = tid0; asm volatile("" : "+v"(tid)); const int lane = tid & 63, wave = __builtin_amdgcn_readfirstlane(tid >> 6), gw = vcu * 8 + wave; (void)lane; (void)wave; (void)gw;

    if (PH(0)) for (int rep_ = 0; rep_ < REPS(0); ++rep_) { int tid = tid0; asm volatile("" : "+v"(tid)); const int lane = tid & 63, wave = __builtin_amdgcn_readfirstlane(tid >> 6); Args A; { KArgsP ap = kargs();
#pragma unroll
        for (int i = 0; i < 22; ++i) A.in[i] = ap->in[i];
        A.out = ap->out; A.ws = ap->ws; }
        p0_prologue(A, lds, vcu, G, wave, lane, tid); }
    GRID_BAR();

    if (PH(1)) for (int rep_ = 0; rep_ < REPS(1); ++rep_) { PROLOG h_phase<16>(ap->in[I_X], ap->in[I_CTX], (const float*)WSP(WS_MOD), (bf16*)WSP(WS_HB), (const float*)WSP(WS_WG), (float*)WSP(WS_GL), lds, vcu, G, wave, lane, tid); }
    GRID_BAR();
    if (PH(2)) for (int rep_ = 0; rep_ < REPS(2); ++rep_) { PROLOG pg8::Gemm g{(const bf16*)WSP(WS_HB), (const bf16*)WSP(WS_WAB), TT, N_AB, 1024, 1024, 1024}; pg8::StaticOrder S; S.init(TT, N_AB, G, bx);
      pg8::EpiBf16 E{(bf16*)WSP(WS_P), N_AB}; pg8::gemm_phase<pg8::EpiBf16, pg8::StaticOrder>(lds, g, S, E, tid); }
    GRID_BAR();
#if DBG_LEVEL >= 2
    if (PH(3)) for (int rep_ = 0; rep_ < REPS(3); ++rep_) { PROLOG mlstm_gate_scan((const float*)WSP(WS_GL), ap->in[I_ABGB], ws, gw, NGW, lane); }
    if (PH(4)) for (int rep_ = 0; rep_ < REPS(4); ++rep_) { PROLOG attn_phase((const bf16*)WSP(WS_P), (bf16*)WSP(WS_HB), ap->in[I_ABSINK], (const float*)WSP(WS_ROPE), lds, (unsigned*)WSP(WS_CTL) + 6144 + 64 * rep_, vcu, G, wave, lane, tid); }
    GRID_BAR();
    if (PH(5)) for (int rep_ = 0; rep_ < REPS(5); ++rep_) { PROLOG mlstm_fused_scan((const bf16*)WSP(WS_P), ws, lds, vcu, G, wave, lane, tid); }
    GRID_BAR();
    if (PH(6)) for (int rep_ = 0; rep_ < REPS(6); ++rep_) { PROLOG mlstm_merge((const bf16*)WSP(WS_P), (bf16*)WSP(WS_HB), ap->in[I_ABNW], ws, gw, NGW, lane); }
    GRID_BAR();
#endif
    if (PH(7)) for (int rep_ = 0; rep_ < REPS(7); ++rep_) { PROLOG pg8::Gemm g{(const bf16*)WSP(WS_HB), (const bf16*)WSP(WS_WABO), TT, 1024, 1024, 1024, 1024}; pg8::StaticOrder S; S.init(TT, 1024, G, bx);
      pg8::EpiBf16 E{(bf16*)WSP(WS_P), 1024}; pg8::gemm_phase<pg8::EpiBf16, pg8::StaticOrder>(lds, g, S, E, tid); }
    GRID_BAR();
    if (PH(8)) for (int rep_ = 0; rep_ < REPS(8); ++rep_) { PROLOG ln_phase(ap->in[I_X], ap->in[I_CTX], ap->out, (float*)WSP(WS_XC), (const bf16*)WSP(WS_P), (const float*)WSP(WS_MOD), ap->in[I_LNW], ap->in[I_LNB], (bf16*)WSP(WS_HB), gw, NGW, lane, DRYV(8), false); }
    GRID_BAR();
#if DBG_LEVEL >= 3
    if (PH(9)) for (int rep_ = 0; rep_ < REPS(9); ++rep_) { PROLOG pg8::Gemm g{(const bf16*)WSP(WS_HB), (const bf16*)WSP(WS_WQ0), TT, 2048, 1024, 1024, 1024}; pg8::StaticOrder S; S.init(TT, 2048, G, bx);
      pg8::EpiBf16 E{(bf16*)WSP(WS_P), 2048}; pg8::gemm_phase<pg8::EpiBf16, pg8::StaticOrder>(lds, g, S, E, tid); }
    GRID_BAR();
    if (PH(10)) for (int rep_ = 0; rep_ < REPS(10); ++rep_) { PROLOG peer_route((const bf16*)WSP(WS_P), (const bf16*)WSP(WS_KEYS), (int*)WSP(WS_ST), (float*)WSP(WS_ST + 17 * MiB), gw, NGW, lane, false); }
    GRID_BAR();
#endif
    if (PH(11)) for (int rep_ = 0; rep_ < REPS(22); ++rep_) { PROLOG peer_pass1((const bf16*)WSP(WS_HB), (const int*)WSP(WS_ST), (const float*)WSP(WS_ST + 17 * MiB), WSP(WS_U), (const float*)WSP(WS_SCL), (const float*)WSP(WS_SCL) + 2 * NEXP, (float*)WSP(WS_ST + 34 * MiB), gw, NGW, lane, false); }
    if (PH(11)) for (int rep_ = 0; rep_ < REPS(11); ++rep_) { PROLOG peer_expert<(DBG_LEVEL >= 3)>((const float*)WSP(WS_ST + 34 * MiB), (const int*)WSP(WS_ST), WSP(WS_V),
        ap->out, (float*)WSP(WS_XC), (const float*)WSP(WS_MOD), ap->in[I_LNW] + 1024, ap->in[I_LNB] + 1024, gw, NGW, lane, DRYV(11), false); }
    GRID_BAR();

    if (PH(12)) for (int rep_ = 0; rep_ < REPS(12); ++rep_) { PROLOG h_phase<32>(ap->out, (const float*)WSP(WS_XC), (const float*)WSP(WS_MOD) + 9 * 6144, (bf16*)WSP(WS_HB), (const float*)WSP(WS_WLOW), (float*)WSP(WS_GL), lds, vcu, G, wave, lane, tid);
 }
    GRID_BAR();
    if (PH(13)) for (int rep_ = 0; rep_ < REPS(13); ++rep_) { PROLOG pg8::Gemm g{(const bf16*)WSP(WS_HB), (const bf16*)WSP(WS_WC), TT, N_C, 1024, 1024, 1024}; pg8::StaticOrder S; S.init(TT, N_C, G, bx);
      pg8::EpiBf16 E{(bf16*)WSP(WS_P), N_C}; pg8::gemm_phase<pg8::EpiBf16, pg8::StaticOrder>(lds, g, S, E, tid); }
    GRID_BAR();
#if DBG_LEVEL >= 2
    if (PH(14)) for (int rep_ = 0; rep_ < REPS(14); ++rep_) { PROLOG gla_prep((bf16*)WSP(WS_P), (bf16*)WSP(WS_HB), (const float*)WSP(WS_GL), ap->in[I_GGUP], ap->in[I_GGB], ws, lds, vcu, G, tid, DRYV(14)); }
    GRID_BAR();
    if (PH(15)) for (int rep_ = 0; rep_ < REPS(15); ++rep_) { PROLOG gla_fused_scan((const bf16*)WSP(WS_P), (const bf16*)WSP(WS_HB), ws, lds, vcu, G, wave, lane, tid, DRYV(15)); }
    GRID_BAR();
    if (PH(16)) for (int rep_ = 0; rep_ < REPS(16); ++rep_) { PROLOG gla_merge((bf16*)WSP(WS_P), ap->in[I_GNW], ws, gw, NGW, lane, DRYV(16)); }
    GRID_BAR();
#endif
    if (PH(17)) for (int rep_ = 0; rep_ < REPS(17); ++rep_) { PROLOG pg8::Gemm g{(const bf16*)WSP(WS_P) + 2048, (const bf16*)WSP(WS_WCO), TT, 1024, 1024, N_C, 1024}; pg8::LatOrder S; S.init(NB * SEQ, 1024, G, bx);
      pg8::EpiBf16 E{(bf16*)WSP(WS_HB), 1024}; pg8::gemm_phase<pg8::EpiBf16, pg8::LatOrder>(lds, g, S, E, tid); }
    GRID_BAR();
    if (PH(18)) for (int rep_ = 0; rep_ < REPS(18); ++rep_) { PROLOG ln_phase(ap->out, (const float*)WSP(WS_XC), ap->out, (float*)WSP(WS_XC), (const bf16*)WSP(WS_HB), (const float*)WSP(WS_MOD) + 9 * 6144, ap->in[I_LNW] + 2048, ap->in[I_LNB] + 2048, (bf16*)WSP(WS_HB), gw, NGW, lane, DRYV(18), true); }
    GRID_BAR();
#if DBG_LEVEL >= 3
    if (PH(19)) for (int rep_ = 0; rep_ < REPS(19); ++rep_) { PROLOG pg8::Gemm g{(const bf16*)WSP(WS_HB), (const bf16*)WSP(WS_WQ1), TT, 2048, 1024, 1024, 1024}; pg8::LatOrder S; S.init(NB * SEQ, 2048, G, bx);
      pg8::EpiBf16 E{(bf16*)WSP(WS_P), 2048}; pg8::gemm_phase<pg8::EpiBf16, pg8::LatOrder>(lds, g, S, E, tid); }
    GRID_BAR();
    if (PH(20)) for (int rep_ = 0; rep_ < REPS(20); ++rep_) { PROLOG peer_route((const bf16*)WSP(WS_P), (const bf16*)WSP(WS_KEYS) + (size_t)8 * 2 * 128 * 128, (int*)WSP(WS_ST), (float*)WSP(WS_ST + 17 * MiB), gw, NGW, lane, true); }
    GRID_BAR();
#endif
    if (PH(21)) for (int rep_ = 0; rep_ < REPS(22); ++rep_) { PROLOG peer_pass1((const bf16*)WSP(WS_HB), (const int*)WSP(WS_ST), (const float*)WSP(WS_ST + 17 * MiB), WSP(WS_U) + (size_t)NEXP * 1024, (const float*)WSP(WS_SCL) + NEXP, (const float*)WSP(WS_SCL) + 3 * NEXP, (float*)WSP(WS_ST + 34 * MiB), gw, NGW, lane, true); }
    if (PH(21)) for (int rep_ = 0; rep_ < REPS(21); ++rep_) { PROLOG peer_expert<(DBG_LEVEL >= 3)>((const float*)WSP(WS_ST + 34 * MiB), (const int*)WSP(WS_ST), WSP(WS_V) + (size_t)NEXP * 1024,
        ap->out, (float*)WSP(WS_XC), (const float*)WSP(WS_MOD) + 9 * 6144, ap->in[I_LNW] + 3072, ap->in[I_LNB] + 3072, gw, NGW, lane, DRYV(21), true); }
}

extern "C" void kernel_launch(void* const* d_in, const int* in_sizes, int n_in, void* d_out, int out_size, void* d_ws, size_t ws_size, hipStream_t stream) {
    static int grid = 0;
    if (grid == 0) {
        if (n_in != 22 || out_size != NB * SEQ * D || ws_size < 512 * MiB) { fprintf(stderr, "kernel_launch: unexpected shapes: n_in %d out %d ws %zu (need %zu)\n", n_in, out_size, ws_size, (size_t)WS_END); grid = -1; return; }
        int dev = 0, cus = 0, per_cu = 0;
        if (hipGetDevice(&dev) != hipSuccess || hipDeviceGetAttribute(&cus, hipDeviceAttributeMultiprocessorCount, dev) != hipSuccess) { grid = -1; return; }
        if (hipFuncSetAttribute((const void*)fwd_megakernel, hipFuncAttributeMaxDynamicSharedMemorySize, LDS_BYTES) != hipSuccess) { fprintf(stderr, "kernel_launch: hipFuncSetAttribute failed\n"); grid = -1; return; }
        if (hipOccupancyMaxActiveBlocksPerMultiprocessor(&per_cu, (const void*)fwd_megakernel, 512, LDS_BYTES) != hipSuccess || per_cu < 1) { fprintf(stderr, "kernel_launch: occupancy query says %d blocks per CU\n", per_cu); }
        (void)hipGetLastError();
        grid = cus;
        fprintf(stderr, "kernel_launch: grid %d, per_cu %d, ws %zu\n", grid, per_cu, ws_size);
    }
    if (grid < 0) return;
    if (hipMemsetAsync((char*)d_ws + WS_CTL, 0, CTL_ZERO_BYTES, stream) != hipSuccess) return;
    Args a{};
    for (int i = 0; i < 22; ++i) a.in[i] = (const float*)d_in[i];
    a.out = (float*)d_out; a.ws = (unsigned char*)d_ws;
    hipLaunchKernelGGL(fwd_megakernel, dim3(grid), dim3(512), LDS_BYTES, stream, a);
}
```

```cpp
#include <hip/hip_runtime.h>
#include <cstdio>
#include <cstdint>

#define GAS __attribute__((address_space(1)))
#define LAS __attribute__((address_space(3)))
typedef unsigned short bf16;
typedef unsigned v4u __attribute__((ext_vector_type(4)));
typedef unsigned v2u __attribute__((ext_vector_type(2)));
typedef float f32x4 __attribute__((ext_vector_type(4)));
typedef float f32x2 __attribute__((ext_vector_type(2)));
typedef short bf16x8 __attribute__((ext_vector_type(8)));
typedef short s16x4 __attribute__((ext_vector_type(4)));
typedef GAS unsigned gu32;
#define RLX_AGENT __ATOMIC_RELAXED, __HIP_MEMORY_SCOPE_AGENT

constexpr int NB = 8, SEQ = 4096, LC = 256, D = 1024;
constexpr int PB = LC + SEQ;
constexpr int TT = NB * PB;
constexpr int NCH = PB / 64;
constexpr int N_AB = 2816;
constexpr int N_C = 3072;
constexpr float LN_EPS = 1e-5f;
constexpr float DN_ALPHA = 1.41421356237f;
constexpr int NEXP = 16384;
__device__ __forceinline__ int map_row(int i, bool lat_only) { return lat_only ? (i >> 12) * 4352 + 256 + (i & 4095) : i; }

constexpr size_t MiB = 1u << 20;
constexpr size_t WS_CTL = 0, CTL_ZERO_BYTES = 64 * 1024;
constexpr size_t WS_MOD = 1 * MiB;
constexpr size_t WS_ROPE = 2 * MiB;
constexpr size_t WS_WG = 2 * MiB + 64 * 1024;
constexpr size_t WS_WLOW = 2 * MiB + 128 * 1024;
constexpr size_t WS_SCL = 3 * MiB;
constexpr size_t WS_BQ = 4 * MiB, WS_CQ = WS_BQ + 1200 * 1024, WS_EM = WS_CQ + 1200 * 1024, WS_AI = WS_EM + 1200 * 1024;
constexpr size_t WS_AST = WS_AI + 1200 * 1024, WS_CL = WS_AST + 32 * 1024;
constexpr size_t WS_ET = 10 * MiB;
constexpr size_t WS_GL = 13 * MiB;
constexpr size_t WS_WAB = 20 * MiB, WS_WABO = 26 * MiB, WS_WC = 28 * MiB, WS_WCO = 34 * MiB, WS_WQ0 = 36 * MiB, WS_WQ1 = 40 * MiB, WS_KEYS = 44 * MiB;
constexpr size_t WS_NST = 45 * MiB;
constexpr size_t WS_XC = 48 * MiB;
constexpr size_t WS_U = 56 * MiB, WS_V = 88 * MiB;
constexpr size_t WS_HB = 120 * MiB;
constexpr size_t WS_P = 188 * MiB;
constexpr size_t WS_ST = 392 * MiB;
constexpr size_t WS_END = 460 * MiB;

constexpr int LDS_BYTES = 163840;
constexpr int MISC_OFF = LDS_BYTES - 64;

__device__ __forceinline__ unsigned f2bf(float f) { unsigned u = __builtin_bit_cast(unsigned, f); return (u + 0x7fffu + ((u >> 16) & 1u)) >> 16; }
__device__ __forceinline__ unsigned pk2(float lo, float hi) { return f2bf(lo) | (f2bf(hi) << 16); }
__device__ __forceinline__ float bflo(unsigned w) { return __builtin_bit_cast(float, w << 16); }
__device__ __forceinline__ float bfhi(unsigned w) { return __builtin_bit_cast(float, w & 0xffff0000u); }
__device__ __forceinline__ float bf2f(bf16 b) { return __builtin_bit_cast(float, (unsigned)b << 16); }
template <int CTRL> __device__ __forceinline__ float dppmov_f(float x) { return __builtin_bit_cast(float, __builtin_amdgcn_mov_dpp(__builtin_bit_cast(int, x), CTRL, 0xf, 0xf, true)); }
__device__ __forceinline__ float wave_sum(float v) {
    v += dppmov_f<0xB1>(v); v += dppmov_f<0x4E>(v); v += dppmov_f<0x141>(v); v += dppmov_f<0x128>(v);
    v += __shfl_xor(v, 16); v += __shfl_xor(v, 32);
    return v;
}
__device__ __forceinline__ float sigmoidf_(float x) { return 1.f / (1.f + __expf(-x)); }
__device__ __forceinline__ float logsigmoidf_(float x) { return fminf(x, 0.f) - log1pf(__expf(-fabsf(x))); }
__device__ __forceinline__ float siluf_(float x) { return x / (1.f + __expf(-x)); }

namespace pg8 {
#define PG8_LAS __attribute__((address_space(3)))
typedef unsigned short bf16_t;
typedef short bf16x8 __attribute__((ext_vector_type(8)));
typedef float f32x4 __attribute__((ext_vector_type(4)));
typedef unsigned u32x4 __attribute__((ext_vector_type(4)));
constexpr int BM = 256, BK = 64, HALF = 128, HTB = HALF * BK * 2  , STAGE_BYTES = 8 * HTB, NXCD = 8, WGM = 8;

__host__ __device__ __forceinline__ int lds_byte(int r, int c) { const int st = (r >> 4) * 2 + (c >> 5), rr = r & 15, cc = c & 31, ob = rr * 64 + cc * 2; return st * 1024 + (ob ^ (((ob >> 9) & 1) << 5)); }
__host__ __device__ __forceinline__ void stage_rc(int b, int& R, int& C) { const int st = b / 1024, sb = b % 1024, swz = sb ^ (((sb >> 9) & 1) << 5); R = (st >> 1) * 16 + swz / 64; C = (st & 1) * 32 + (swz % 64) / 2; }
__host__ __device__ __forceinline__ int perm32(int rho) { const int n = rho >> 4, i = rho & 15; return 8 * (i >> 2) + 4 * n + (i & 3); }

struct Unit { int pm, pn; };
struct Gemm { const bf16_t* A; const bf16_t* Bt; int M, N, K, lda, ldb; };

struct StaticOrder {
    int nM, nN, nwg, G, c;
    __host__ __device__ void init(int M, int N, int G_, int c_) { nM = M / BM; nN = N / BM; nwg = nM * nN; G = G_; c = c_; }
    __host__ __device__ bool next(int i, Unit& u) const {
        const long L = (long)i * G + c; if (L >= nwg) return false;
        int wgid = (int)L; { const int q = nwg / NXCD, r = nwg % NXCD, xcd = wgid % NXCD, off = wgid / NXCD; wgid = (xcd < r ? xcd * (q + 1) : r * (q + 1) + (xcd - r) * q) + off; }
        const int nig = WGM * nN, gid = wgid / nig, fm = gid * WGM, gsz = (nM - fm) < WGM ? (nM - fm) : WGM;
        u.pm = fm + ((wgid % nig) % gsz); u.pn = (wgid % nig) / gsz; return true;
    }
    __device__ __forceinline__ void a_ready(const Unit&) const {}
    __device__ __forceinline__ void done(const Unit&) const {}
};

struct LatOrder : StaticOrder {
    __host__ __device__ bool next(int i, Unit& u) const { if (!StaticOrder::next(i, u)) return false; u.pm = (u.pm >> 4) * 17 + 1 + (u.pm & 15); return true; }
};
__device__ __forceinline__ unsigned cvt_pk_bf16(float lo, float hi) { unsigned r; asm volatile("v_cvt_pk_bf16_f32 %0, %1, %2" : "=v"(r) : "v"(lo), "v"(hi)); return r; }
struct EpiBf16 {
    static constexpr bool PERM = true, AFTER_DRAIN = false;
    bf16_t* O; int ldc;
    __device__ __forceinline__ void operator()(const f32x4 (&acc)[2][2][4][2], const Unit& u, int wr, int wc, int fr, int fq) const {
        const int row0 = u.pm * BM + wr * 64 + fr; const int col0 = u.pn * BM + wc * 32 + 8 * fq;
#pragma unroll
        for (int ai = 0; ai < 2; ++ai)
#pragma unroll
            for (int m = 0; m < 4; ++m) { bf16_t* rowp = O + (size_t)(row0 + ai * HALF + m * 16) * ldc + col0;
#pragma unroll
                for (int bj = 0; bj < 2; ++bj) { const f32x4 v0 = acc[ai][bj][m][0], v1 = acc[ai][bj][m][1];
                    u32x4 w; w.x = cvt_pk_bf16(v0[0], v0[1]); w.y = cvt_pk_bf16(v0[2], v0[3]); w.z = cvt_pk_bf16(v1[0], v1[1]); w.w = cvt_pk_bf16(v1[2], v1[3]);
                    *(u32x4*)(rowp + bj * HALF) = w; } }
    }
};
struct EpiResid {
    static constexpr bool PERM = false, AFTER_DRAIN = false;
    const float* src_lat; const float* src_ctx; float* dst_lat; float* dst_ctx; const float* gate; float gscale; int dry;
    __device__ __forceinline__ void operator()(const f32x4 (&acc)[2][2][4][2], const Unit& u, int wr, int wc, int fr, int fq) const {
        const int b = u.pm / 17, tb = u.pm - b * 17;
        const float* sbase; float* dbase; const float* gr;
        if (tb == 0) { sbase = src_ctx + (size_t)b * 256 * 1024; dbase = dst_ctx + (size_t)b * 256 * 1024; gr = gate + 8 * 6144; }
        else { sbase = src_lat + ((size_t)b * 4096 + (size_t)(tb - 1) * 256) * 1024; dbase = dst_lat + ((size_t)b * 4096 + (size_t)(tb - 1) * 256) * 1024; gr = gate + b * 6144; }
        const int row0 = wr * 64 + fr, col0 = u.pn * BM + wc * 32 + 4 * fq;
        f32x4 gv[2][2];
#pragma unroll
        for (int bj = 0; bj < 2; ++bj)
#pragma unroll
            for (int n = 0; n < 2; ++n) gv[bj][n] = *(const f32x4*)(gr + col0 + bj * HALF + n * 16) * gscale;
#pragma unroll
        for (int ai = 0; ai < 2; ++ai)
#pragma unroll
            for (int mp = 0; mp < 2; ++mp) {
                f32x4 sv[2][2][2];
#pragma unroll
                for (int mm = 0; mm < 2; ++mm) { const size_t off = (size_t)(row0 + ai * HALF + (2 * mp + mm) * 16) * 1024 + col0;
#pragma unroll
                    for (int bj = 0; bj < 2; ++bj)
#pragma unroll
                        for (int n = 0; n < 2; ++n) sv[mm][bj][n] = __builtin_nontemporal_load((const f32x4*)(sbase + off + bj * HALF + n * 16)); }
                asm volatile("" ::: "memory");
#pragma unroll
                for (int mm = 0; mm < 2; ++mm) { const int m = 2 * mp + mm; const size_t off = (size_t)(row0 + ai * HALF + m * 16) * 1024 + col0;
#pragma unroll
                    for (int bj = 0; bj < 2; ++bj)
#pragma unroll
                        for (int n = 0; n < 2; ++n) { const f32x4 ov = sv[mm][bj][n] * 1.41421356237f + gv[bj][n] * acc[ai][bj][m][n]; if (!dry) *(f32x4*)(dbase + off + bj * HALF + n * 16) = ov; } }
                asm volatile("" ::: "memory");
            }
    }
};

template <class Epi, class Sched>
__device__ __forceinline__ void gemm_phase(PG8_LAS unsigned char* lds, const Gemm g, const Sched& S, const Epi& E, const int tid_in) {
    const int tid = tid_in, wid = __builtin_amdgcn_readfirstlane(tid >> 6), lane = tid & 63, wr = wid >> 2, wc = wid & 3, fr = lane & 15, fq = lane >> 4;
    const int K = g.K, nt = K / BK;
    unsigned voffA[2], voffB[2];
#pragma unroll
    for (int i = 0; i < 2; ++i) { int R, C; stage_rc(tid * 16 + i * 8192, R, C); const int Rb = Epi::PERM ? ((R & ~31) + perm32(R & 31)) : R;
        voffA[i] = (unsigned)(R * g.lda + C) * 2u; voffB[i] = (unsigned)(Rb * g.ldb + C) * 2u; }
    const size_t kstep = (size_t)(BK * 2);
    const size_t hstepA = (size_t)HALF * g.lda * 2, hstepB = (size_t)HALF * g.ldb * 2;
    const size_t tstepA = 2 * hstepA, tstepB = 2 * hstepB;
    const unsigned ldsw = (unsigned)wid * 1024u;
    const int aoff = lds_byte(wr * 64 + fr, fq * 8), boff = lds_byte(wc * 32 + fr, fq * 8);
#define PG8_SA(b, h) (((b) * 2 + (h)) * HTB)
#define PG8_SB(b, h) ((4 + (b) * 2 + (h)) * HTB)
#define PG8_STAGE(bufoff, gbase, voff) do { _Pragma("unroll") for (int _i = 0; _i < 2; ++_i) \
        __builtin_amdgcn_global_load_lds((const unsigned*)((const char*)(gbase) + (voff)[_i]), (PG8_LAS unsigned*)(lds + (bufoff) + ldsw + _i * 8192), 16, 0, 0); } while (0)
#define PG8_LDA(dst, b, h) do { _Pragma("unroll") for (int m = 0; m < 4; ++m) _Pragma("unroll") for (int k = 0; k < 2; ++k) dst[m][k] = *(const PG8_LAS bf16x8*)(lds + PG8_SA(b, h) + aoff + m * 2048 + k * 1024); } while (0)
#define PG8_LDB(dst, b, h) do { _Pragma("unroll") for (int n = 0; n < 2; ++n) _Pragma("unroll") for (int k = 0; k < 2; ++k) dst[n][k] = *(const PG8_LAS bf16x8*)(lds + PG8_SB(b, h) + boff + n * 2048 + k * 1024); } while (0)
#define PG8_MMA(ai, bj, At, Bt) do { __builtin_amdgcn_s_setprio(1); _Pragma("unroll") for (int m = 0; m < 4; ++m) _Pragma("unroll") for (int n = 0; n < 2; ++n) _Pragma("unroll") for (int k = 0; k < 2; ++k) \
        acc[ai][bj][m][n] = __builtin_amdgcn_mfma_f32_16x16x32_bf16(Bt[n][k], At[m][k], acc[ai][bj][m][n], 0, 0, 0); __builtin_amdgcn_s_setprio(0); } while (0)
#define PG8_WAIT_V(n) asm volatile("s_waitcnt vmcnt(" #n ")" ::: "memory")
#define PG8_WAIT_L(n) asm volatile("s_waitcnt lgkmcnt(" #n ")" ::: "memory")
#define PG8_BAR __builtin_amdgcn_s_barrier()
#define PG8_SCHED __builtin_amdgcn_sched_barrier(0)
    Unit cur, nxt; int ui = 0;
    if (!S.next(0, cur)) return;
    f32x4 acc[2][2][4][2];
#pragma unroll
    for (int a = 0; a < 2; ++a)
#pragma unroll
        for (int b = 0; b < 2; ++b)
#pragma unroll
            for (int m = 0; m < 4; ++m)
#pragma unroll
                for (int n = 0; n < 2; ++n) acc[a][b][m][n] = (f32x4){0.f, 0.f, 0.f, 0.f};
    bf16x8 At[4][2], B0[2][2], B1[2][2];
    const char* cA = (const char*)g.A + (size_t)cur.pm * tstepA; const char* cB = (const char*)g.Bt + (size_t)cur.pn * tstepB;
    S.a_ready(cur);
    PG8_STAGE(PG8_SB(0, 0), cB, voffB); PG8_STAGE(PG8_SA(0, 0), cA, voffA); PG8_STAGE(PG8_SB(0, 1), cB + hstepB, voffB); PG8_STAGE(PG8_SA(0, 1), cA + hstepA, voffA);
    if (wr == 1) PG8_BAR;
    PG8_WAIT_V(4); PG8_BAR;
    PG8_STAGE(PG8_SB(1, 0), cB + kstep, voffB); PG8_STAGE(PG8_SA(1, 0), cA + kstep, voffA); PG8_STAGE(PG8_SB(1, 1), cB + hstepB + kstep, voffB);
    PG8_WAIT_V(6); PG8_BAR;
    for (;;) {
        const bool has_next = S.next(ui + 1, nxt);
        const char* nA = has_next ? (const char*)g.A + (size_t)nxt.pm * tstepA : cA; const char* nB = has_next ? (const char*)g.Bt + (size_t)nxt.pn * tstepB : cB;
        for (int t = 0; t < nt; t += 2) {
            const bool last = (t == nt - 2);
            const char* a1 = cA + (size_t)(t + 1) * kstep;
            const char* a2 = last ? nA : cA + (size_t)(t + 2) * kstep; const char* b2 = last ? nB : cB + (size_t)(t + 2) * kstep;
            const char* a3 = a2 + kstep; const char* b3 = b2 + kstep;
            if (last && has_next) S.a_ready(nxt);
            PG8_LDB(B0, 0, 0); PG8_SCHED; PG8_LDA(At, 0, 0); PG8_STAGE(PG8_SA(1, 1), a1 + hstepA, voffA);
            PG8_WAIT_L(8); PG8_BAR; PG8_WAIT_L(0); PG8_MMA(0, 0, At, B0); PG8_BAR; PG8_SCHED;
            PG8_LDB(B1, 0, 1); PG8_STAGE(PG8_SB(0, 0), b2, voffB);
            PG8_BAR; PG8_WAIT_L(0); PG8_MMA(0, 1, At, B1); PG8_BAR;
            PG8_LDA(At, 0, 1); PG8_STAGE(PG8_SA(0, 0), a2, voffA);
            PG8_BAR; PG8_WAIT_L(0); PG8_MMA(1, 0, At, B0); PG8_BAR; PG8_SCHED;
            PG8_STAGE(PG8_SB(0, 1), b2 + hstepB, voffB);
            PG8_WAIT_V(6); PG8_BAR; PG8_MMA(1, 1, At, B1); PG8_BAR;
            PG8_LDB(B0, 1, 0); PG8_SCHED; PG8_LDA(At, 1, 0); PG8_STAGE(PG8_SA(0, 1), a2 + hstepA, voffA);
            PG8_WAIT_L(8); PG8_BAR; PG8_WAIT_L(0); PG8_MMA(0, 0, At, B0); PG8_BAR; PG8_SCHED;
            PG8_LDB(B1, 1, 1); PG8_STAGE(PG8_SB(1, 0), b3, voffB);
            PG8_BAR; PG8_WAIT_L(0); PG8_MMA(0, 1, At, B1); PG8_BAR;
            PG8_LDA(At, 1, 1); PG8_STAGE(PG8_SA(1, 0), a3, voffA);
            PG8_BAR; PG8_WAIT_L(0); PG8_MMA(1, 0, At, B0); PG8_BAR; PG8_SCHED;
            PG8_STAGE(PG8_SB(1, 1), b3 + hstepB, voffB);
            PG8_WAIT_V(6); PG8_BAR; PG8_MMA(1, 1, At, B1); PG8_BAR;
        }
        if constexpr (!Epi::AFTER_DRAIN) { E(acc, cur, wr, wc, fr, fq); S.done(cur); }
        if (!has_next) break;
#pragma unroll
        for (int a = 0; a < 2; ++a)
#pragma unroll
            for (int b = 0; b < 2; ++b)
#pragma unroll
                for (int m = 0; m < 4; ++m)
#pragma unroll
                    for (int n = 0; n < 2; ++n) acc[a][b][m][n] = (f32x4){0.f, 0.f, 0.f, 0.f};
        cur = nxt; cA = nA; cB = nB; ++ui;
    }
    PG8_WAIT_V(0);
    if (wr == 0) PG8_BAR;
    PG8_BAR;
    if constexpr (Epi::AFTER_DRAIN) { E.fused(acc, cur, wr, wc, fr, fq, lds, wid, lane); S.done(cur); }
#undef PG8_SA
#undef PG8_SB
#undef PG8_STAGE
#undef PG8_LDA
#undef PG8_LDB
#undef PG8_MMA
#undef PG8_WAIT_V
#undef PG8_WAIT_L
#undef PG8_BAR
#undef PG8_SCHED
}
}

#define XB_TMO      128
#define XB_XCNT(j)  (256  + 64 * (j))
#define XB_XSUB(j)  (1280 + 64 * (j))
#define XB_XGEN(j)  (2304 + 64 * (j))
#define XB_TOP      3328
#define XB_TOPGEN   3392
#define XCD_BAR_WORDS 3456
#define XB_SPIN_CAP (1u << 18)

__device__ __forceinline__ unsigned xb_ld(unsigned* p)              { return __hip_atomic_load(p, __ATOMIC_RELAXED, __HIP_MEMORY_SCOPE_AGENT); }
__device__ __forceinline__ unsigned xb_add(unsigned* p, unsigned v) { return __hip_atomic_fetch_add(p, v, __ATOMIC_RELAXED, __HIP_MEMORY_SCOPE_AGENT); }
__device__ __forceinline__ unsigned xb_xcc_id() { return (unsigned)__builtin_amdgcn_s_getreg((3 << 11) | 20) & 0xFu; }
#define XB_SPIN(cond, bar) do { unsigned _sp = 0; while (cond) { __builtin_amdgcn_s_sleep(1); \
    if ((++_sp & 255u) == 0u) { if (xb_ld(&(bar)[XB_TMO])) break; if (_sp > XB_SPIN_CAP) { atomicAdd(&(bar)[XB_TMO], 1u); break; } } } } while (0)

struct XcdBarrier {
    unsigned* bar; unsigned x;
    volatile LAS unsigned* st;
};

__device__ __forceinline__ XcdBarrier xcd_barrier_post(unsigned* bar, volatile LAS unsigned* st) {
    XcdBarrier b; b.bar = bar; b.x = xb_xcc_id(); b.st = st;
    if (threadIdx.x == 0) (void)xb_add(&bar[XB_XCNT(b.x)], 1u);
    return b;
}
__device__ __forceinline__ void xcd_barrier_complete(unsigned* bar, unsigned x, unsigned& nloc, unsigned& nx) {
    const unsigned G = gridDim.x * gridDim.y * gridDim.z;
    unsigned sum, cnt, mine, sp = 0u;
    for (;;) {
        sum = 0u; cnt = 0u; mine = 0u;
#pragma unroll
        for (unsigned j = 0; j < 16; ++j) { const unsigned c = xb_ld(&bar[XB_XCNT(j)]); sum += c; cnt += (c > 0u) ? 1u : 0u; mine = (j == x) ? c : mine; }
        if (sum == G) break;
        __builtin_amdgcn_s_sleep(1);
        if ((++sp & 255u) == 0u) { if (xb_ld(&bar[XB_TMO])) break; if (sp > XB_SPIN_CAP) { atomicAdd(&bar[XB_TMO], 1u); break; } }
    }
    nloc = mine > 0u ? mine : 1u; nx = cnt > 0u ? cnt : 1u;
}

__device__ __forceinline__ void xcd_barrier(const XcdBarrier& b) {
    asm volatile("s_waitcnt vmcnt(0)" ::: "memory");
    __syncthreads();
    if (threadIdx.x == 0) {
        unsigned* bar = b.bar;
        __builtin_amdgcn_s_waitcnt(0);
        unsigned nloc = b.st[0], nx = b.st[1];
        if (nloc == 0u) { xcd_barrier_complete(bar, b.x, nloc, nx); b.st[0] = nloc; b.st[1] = nx; }
        const unsigned old = xb_add(&bar[XB_XSUB(b.x)], 1u);
        const unsigned gen = old / nloc;
        if (old + 1u == (gen + 1u) * nloc) {
            __builtin_amdgcn_fence(__ATOMIC_RELEASE, "agent");
            asm volatile("s_waitcnt vmcnt(0)" ::: "memory");
            const unsigned og = xb_add(&bar[XB_TOP], 1u);
            const unsigned tg = og / nx;
            if (og + 1u == (tg + 1u) * nx) xb_add(&bar[XB_TOPGEN], 1u);
            else XB_SPIN(xb_ld(&bar[XB_TOPGEN]) == tg, bar);
            __builtin_amdgcn_fence(__ATOMIC_ACQUIRE, "agent");
            xb_add(&bar[XB_XGEN(b.x)], 1u);
            asm volatile("s_waitcnt vmcnt(0)" ::: "memory");
        } else {
            XB_SPIN(xb_ld(&bar[XB_XGEN(b.x)]) == gen, bar);
            __builtin_amdgcn_fence(__ATOMIC_ACQUIRE, "agent");
            asm volatile("s_waitcnt vmcnt(0)" ::: "memory");
        }
    }
    __syncthreads();
}


__device__ __forceinline__ f32x4 mma(bf16x8 a, bf16x8 b, f32x4 c) { return __builtin_amdgcn_mfma_f32_16x16x32_bf16(a, b, c, 0, 0, 0); }
__device__ __forceinline__ bf16x8 frag_row(const LAS bf16* t, int ld, int r0, int c0, int lane) {
    return *(const LAS bf16x8*)(t + (r0 + (lane & 15)) * ld + c0 + 8 * (lane >> 4));
}
__device__ __forceinline__ bf16x8 frag_tr(const LAS bf16* t, int ld, int r0, int c0, int lane) {
    const int g = lane >> 4, q = (lane & 15) >> 2, p = lane & 3;
    const LAS bf16* a = t + (r0 + 8 * g + q) * ld + c0 + 4 * p;
    const s16x4 lo = __builtin_amdgcn_ds_read_tr16_b64_v4i16((LAS s16x4*)a);
    const s16x4 hi = __builtin_amdgcn_ds_read_tr16_b64_v4i16((LAS s16x4*)(a + 4 * ld));
    return (bf16x8){lo[0], lo[1], lo[2], lo[3], hi[0], hi[1], hi[2], hi[3]};
}
#define LDS_FENCE() do { asm volatile("s_waitcnt lgkmcnt(0)" ::: "memory"); __builtin_amdgcn_wave_barrier(); } while (0)

struct Args {
    const float* in[22]; float* out; unsigned char* ws;
};
enum { I_X = 0, I_C, I_CTX, I_CCTX, I_WMOD, I_BMOD, I_LNW, I_LNB, I_ABWIN, I_ABGB, I_ABNW, I_ABSINK, I_ABWOUT, I_GWIN, I_GGUP, I_GGB, I_GNW, I_GWOUT, I_PWQ, I_PKEYS, I_PU, I_PV };

__device__ __forceinline__ const float* srow_c(const float* lat, const float* ctx, int r) { const int b = r / PB, p = r - b * PB; return p < LC ? ctx + (size_t)(b * LC + p) * D : lat + (size_t)(b * SEQ + p - LC) * D; }
__device__ __forceinline__ float* srow(float* lat, float* ctx, int r) { const int b = r / PB, p = r - b * PB; return p < LC ? ctx + (size_t)(b * LC + p) * D : lat + (size_t)(b * SEQ + p - LC) * D; }

__device__ __forceinline__ void p0_transpose_item(const float* W, int K, int ldw, int c0, int ncols, bf16* WT, int row_off, LAS float* scr, int item, int lane,
                                                  int s0lo, int s0hi, float s0, int s1lo, int s1hi, float s1) {
    const int nblk = ncols / 32, kb = item / nblk, nb = item % nblk, k0 = 64 * kb, n0 = 32 * nb;
#pragma unroll 8
    for (int i = 0; i < 32; ++i) { const int kk = 2 * i + (lane >> 5); scr[kk * 33 + (lane & 31)] = W[(size_t)(k0 + kk) * ldw + c0 + n0 + (lane & 31)]; }
    asm volatile("s_waitcnt lgkmcnt(0)" ::: "memory");
    const int c = lane & 7;
#pragma unroll
    for (int j = 0; j < 4; ++j) { const int n = (lane >> 3) + 8 * j; const LAS float* s = scr + (8 * c) * 33 + n;
        const int dr = row_off + n0 + n; float sc = 1.f; if (dr >= s0lo && dr < s0hi) sc = s0; if (dr >= s1lo && dr < s1hi) sc = s1;
        v4u o; o.x = pk2(s[0 * 33] * sc, s[1 * 33] * sc); o.y = pk2(s[2 * 33] * sc, s[3 * 33] * sc); o.z = pk2(s[4 * 33] * sc, s[5 * 33] * sc); o.w = pk2(s[6 * 33] * sc, s[7 * 33] * sc);
        *(v4u*)(WT + (size_t)dr * K + k0 + 8 * c) = o; }
    asm volatile("s_waitcnt lgkmcnt(0)" ::: "memory");
}
__device__ __forceinline__ void cvt_f32_bf16(const float* src, bf16* dst, size_t n, int gtid, int gthreads) {
    const size_t nch = n / 8;
    for (size_t i = gtid; i < nch; i += gthreads) { const f32x4 a = *(const f32x4*)(src + i * 8), b = *(const f32x4*)(src + i * 8 + 4);
        v4u o; o.x = pk2(a[0], a[1]); o.y = pk2(a[2], a[3]); o.z = pk2(b[0], b[1]); o.w = pk2(b[2], b[3]); *(v4u*)(dst + i * 8) = o; }
}
__device__ __forceinline__ void cvt_rows_fp8(const float* src, unsigned char* dst, float* inv, int nrows, int gw, int NGW, int lane) {
    for (int r = gw; r < nrows; r += 2 * NGW) {
        f32x4 x[2][4]; float m[2];
#pragma unroll
        for (int u = 0; u < 2; ++u) { const float* sp = src + (size_t)(r + u * NGW) * 1024 + 4 * lane; m[u] = 0.f;
#pragma unroll
            for (int q = 0; q < 4; ++q) { x[u][q] = *(const f32x4*)(sp + 256 * q); m[u] = fmaxf(m[u], fmaxf(fmaxf(fabsf(x[u][q][0]), fabsf(x[u][q][1])), fmaxf(fabsf(x[u][q][2]), fabsf(x[u][q][3])))); } }
#pragma unroll
        for (int u = 0; u < 2; ++u) {
            m[u] = fmaxf(m[u], dppmov_f<0xB1>(m[u])); m[u] = fmaxf(m[u], dppmov_f<0x4E>(m[u])); m[u] = fmaxf(m[u], dppmov_f<0x141>(m[u])); m[u] = fmaxf(m[u], dppmov_f<0x128>(m[u]));
            m[u] = fmaxf(m[u], __shfl_xor(m[u], 16)); m[u] = fmaxf(m[u], __shfl_xor(m[u], 32));
            const float sc = m[u] > 0.f ? 224.f / m[u] : 1.f;
            unsigned char* dp = dst + (size_t)(r + u * NGW) * 1024 + 4 * lane;
#pragma unroll
            for (int q = 0; q < 4; ++q) { int w = 0; w = __builtin_amdgcn_cvt_pk_fp8_f32(x[u][q][0] * sc, x[u][q][1] * sc, w, false); w = __builtin_amdgcn_cvt_pk_fp8_f32(x[u][q][2] * sc, x[u][q][3] * sc, w, true); *(unsigned*)(dp + 256 * q) = (unsigned)w; }
            if (lane == 0) inv[r + u * NGW] = m[u] > 0.f ? m[u] / 224.f : 1.f; }
    }
}
typedef float v16f __attribute__((ext_vector_type(16)));
typedef float v32f __attribute__((ext_vector_type(32)));
typedef unsigned v6u __attribute__((ext_vector_type(6)));
typedef unsigned v3u __attribute__((ext_vector_type(3)));
__device__ __forceinline__ void cvt_rows_fp6(const float* src, unsigned char* dst, float* inv, int nrows, int gw, int NGW, int lane) {
    const int hl = lane & 31, hh = lane >> 5;
    for (int r2 = gw; r2 < nrows / 2; r2 += NGW) {
        const int r = 2 * r2 + hh; const float* sp = src + (size_t)r * 1024 + 32 * hl;
        f32x4 x[8]; float m = 0.f;
#pragma unroll
        for (int q = 0; q < 8; ++q) { x[q] = *(const f32x4*)(sp + 4 * q); m = fmaxf(m, fmaxf(fmaxf(fabsf(x[q][0]), fabsf(x[q][1])), fmaxf(fabsf(x[q][2]), fabsf(x[q][3])))); }
        m = fmaxf(m, dppmov_f<0xB1>(m)); m = fmaxf(m, dppmov_f<0x4E>(m)); m = fmaxf(m, dppmov_f<0x141>(m)); m = fmaxf(m, dppmov_f<0x128>(m)); m = fmaxf(m, __shfl_xor(m, 16));
        const float sc = m > 0.f ? 7.0f / m : 1.f;
        v16f a, b;
#pragma unroll
        for (int q = 0; q < 8; ++q) { a[2 * q] = x[q][0] * sc; b[2 * q] = x[q][1] * sc; a[2 * q + 1] = x[q][2] * sc; b[2 * q + 1] = x[q][3] * sc; }
        const v6u p = __builtin_amdgcn_cvt_scalef32_2xpk16_fp6_f32(a, b, 1.0f);
        unsigned char* dp = dst + (size_t)r * 768 + 24 * hl;
        *(v2u*)dp = (v2u){p[0], p[1]}; *(v2u*)(dp + 8) = (v2u){p[2], p[3]}; *(v2u*)(dp + 16) = (v2u){p[4], p[5]};
        if (hl == 0) inv[r] = m > 0.f ? m / 7.0f : 1.f;
    }
}
__device__ __forceinline__ void p0_prologue(const Args& A, LAS unsigned char* lds, int vcu, int G, int wave, int lane, int tid) {
    unsigned char* ws = A.ws;
    const int gw = vcu * 8 + wave, NGW = G * 8, gtid = vcu * 512 + tid, gthreads = G * 512;
    LAS float* sil = (LAS float*)lds;
    for (int i = tid; i < 9 * 1024; i += 512) { const float v = i < 8192 ? A.in[I_C][i] : A.in[I_CCTX][i - 8192]; sil[i] = siluf_(v); }
    __syncthreads();
    float* MOD = (float*)(ws + WS_MOD);
    LAS float* part = (LAS float*)(lds + 40960);
    for (int it = vcu; it < 2 * 96; it += G) {
        const int l = it / 96, n = (it % 96) * 64 + lane; const float* wm = A.in[I_WMOD] + (size_t)l * 1024 * 6144 + (size_t)(128 * wave) * 6144 + n;
        float acc[9];
#pragma unroll
        for (int r = 0; r < 9; ++r) acc[r] = 0.f;
#pragma unroll 8
        for (int k = 0; k < 128; ++k) { const float w = wm[(size_t)k * 6144];
#pragma unroll
            for (int r = 0; r < 9; ++r) acc[r] += sil[r * 1024 + 128 * wave + k] * w; }
        __syncthreads();
#pragma unroll
        for (int r = 0; r < 9; ++r) part[(wave * 9 + r) * 64 + lane] = acc[r];
        __syncthreads();
        for (int i = tid; i < 9 * 64; i += 512) { float sum = 0.f;
#pragma unroll
            for (int w8 = 0; w8 < 8; ++w8) sum += part[w8 * 576 + i];
            const int r = i >> 6, c = (it % 96) * 64 + (i & 63); MOD[(size_t)(l * 9 + r) * 6144 + c] = sum + A.in[I_BMOD][l * 6144 + c]; }
    }
    __syncthreads();
    LAS float* scr = (LAS float*)(lds + 40960 + wave * 8704);
    constexpr int I_AB1 = 16 * 64, I_AB2 = 16 * 24, I_ABO = 16 * 32, I_C1 = 16 * 96, I_CO = 16 * 32, I_Q = 16 * 64;
    constexpr int NITEMS = I_AB1 + I_AB2 + I_ABO + I_C1 + I_CO + 2 * I_Q;
    const float rs128 = 0.08838834764831845f;
    for (int it = gw; it < NITEMS; it += NGW) {
        int r = it;
        if (r < I_AB1) { p0_transpose_item(A.in[I_ABWIN], 1024, 2832, 0, 2048, (bf16*)(ws + WS_WAB), 0, scr, r, lane, 512, 1024, rs128, 0, 0, 1.f); continue; } r -= I_AB1;
        if (r < I_AB2) { p0_transpose_item(A.in[I_ABWIN], 1024, 2832, 2064, 768, (bf16*)(ws + WS_WAB), 2048, scr, r, lane, 2048, 2560, 0.125f, 0, 0, 1.f); continue; } r -= I_AB2;
        if (r < I_ABO) { p0_transpose_item(A.in[I_ABWOUT], 1024, 1024, 0, 1024, (bf16*)(ws + WS_WABO), 0, scr, r, lane, 0, 0, 1.f, 0, 0, 1.f); continue; } r -= I_ABO;
        if (r < I_C1) { p0_transpose_item(A.in[I_GWIN], 1024, 3104, 0, 3072, (bf16*)(ws + WS_WC), 0, scr, r, lane, 0, 512, rs128, 0, 0, 1.f); continue; } r -= I_C1;
        if (r < I_CO) { p0_transpose_item(A.in[I_GWOUT], 1024, 1024, 0, 1024, (bf16*)(ws + WS_WCO), 0, scr, r, lane, 0, 0, 1.f, 0, 0, 1.f); continue; } r -= I_CO;
        if (r < I_Q) { p0_transpose_item(A.in[I_PWQ], 1024, 2048, 0, 2048, (bf16*)(ws + WS_WQ0), 0, scr, r, lane, 0, 0, 1.f, 0, 0, 1.f); continue; } r -= I_Q;
        p0_transpose_item(A.in[I_PWQ] + (size_t)1024 * 2048, 1024, 2048, 0, 2048, (bf16*)(ws + WS_WQ1), 0, scr, r, lane, 0, 0, 1.f, 0, 0, 1.f);
    }
    for (int i = gtid; i < 16 * 1024; i += gthreads) { const int g = i >> 10, k = i & 1023; ((float*)(ws + WS_WG))[i] = A.in[I_ABWIN][(size_t)k * 2832 + 2048 + g]; }
    for (int i = gtid; i < 32 * 1024; i += gthreads) { const int g = i >> 10, k = i & 1023; ((float*)(ws + WS_WLOW))[i] = A.in[I_GWIN][(size_t)k * 3104 + 3072 + g]; }
    for (int i = gtid; i < 64 * 16; i += gthreads) { const int pos = i >> 4, f = i & 15; const float inv = powf(10000.f, -(float)f / 16.f); const float ang = (float)pos * inv;
        ((float*)(ws + WS_ROPE))[2 * i] = cosf(ang); ((float*)(ws + WS_ROPE))[2 * i + 1] = sinf(ang); }
    cvt_f32_bf16(A.in[I_PKEYS], (bf16*)(ws + WS_KEYS), (size_t)2 * 8 * 2 * 128 * 128, gtid, gthreads);
    cvt_rows_fp6(A.in[I_PU], ws + WS_U, (float*)(ws + WS_SCL), 2 * NEXP, gw, NGW, lane);
    cvt_rows_fp6(A.in[I_PV], ws + WS_V, (float*)(ws + WS_SCL) + 2 * NEXP, 2 * NEXP, gw, NGW, lane);
}

__device__ __forceinline__ void split8(const float* v, bf16x8& hi, bf16x8& lo) {
#pragma unroll
    for (int j = 0; j < 8; ++j) { const unsigned h = f2bf(v[j]); const float hf = __builtin_bit_cast(float, h << 16); hi[j] = (short)h; lo[j] = (short)f2bf(v[j] - hf); }
}
template <int NG>
__device__ __forceinline__ void h_phase(const float* lat, const float* ctx, const float* mod  , bf16* HB, const float* WGT, float* GL, LAS unsigned char* lds, int vcu, int G, int wave, int lane, int tid) {
    constexpr int NT = NG / 16;
    LAS float* part = (LAS float*)lds;
    const int g = lane >> 4, c16 = lane & 15;
    bf16x8 bhi[NT][4], blo[NT][4];
#pragma unroll
    for (int nt = 0; nt < NT; ++nt)
#pragma unroll
        for (int ks = 0; ks < 4; ++ks) { const float* wp = WGT + (size_t)(16 * nt + c16) * 1024 + 128 * wave + 32 * ks + 8 * g;
            const f32x4 w0 = *(const f32x4*)wp, w1 = *(const f32x4*)(wp + 4); const float wv[8] = {w0[0], w0[1], w0[2], w0[3], w1[0], w1[1], w1[2], w1[3]}; split8(wv, bhi[nt][ks], blo[nt][ks]); }
    for (int tile = vcu; tile < TT / 16; tile += G) {
        const int r0 = tile * 16, b = r0 / PB, p0 = r0 - b * PB; const float* mr = mod + (size_t)(p0 < LC ? 8 : b) * 6144 + 128 * wave + 8 * g;
        const int row = r0 + c16; const float* xr = srow_c(lat, ctx, row) + 128 * wave + 8 * g;
        f32x4 xa[4][2], sha[4][2], sca[4][2];
#pragma unroll
        for (int ks = 0; ks < 4; ++ks)
#pragma unroll
            for (int q = 0; q < 2; ++q) { xa[ks][q] = *(const f32x4*)(xr + 32 * ks + 4 * q); sha[ks][q] = *(const f32x4*)(mr + 32 * ks + 4 * q); sca[ks][q] = *(const f32x4*)(mr + 1024 + 32 * ks + 4 * q); }
        f32x4 acc[NT];
#pragma unroll
        for (int nt = 0; nt < NT; ++nt) acc[nt] = (f32x4){0.f, 0.f, 0.f, 0.f};
#pragma unroll
        for (int ks = 0; ks < 4; ++ks) {
            float hv[8];
#pragma unroll
            for (int q = 0; q < 2; ++q)
#pragma unroll
                for (int i = 0; i < 4; ++i) hv[4 * q + i] = xa[ks][q][i] * (sca[ks][q][i] + 1.0f) + sha[ks][q][i];
            bf16x8 ahi, alo; split8(hv, ahi, alo);
            *(bf16x8*)(HB + (size_t)row * D + 128 * wave + 32 * ks + 8 * g) = ahi;
#pragma unroll
            for (int nt = 0; nt < NT; ++nt) { acc[nt] = mma(ahi, bhi[nt][ks], acc[nt]); acc[nt] = mma(ahi, blo[nt][ks], acc[nt]); acc[nt] = mma(alo, bhi[nt][ks], acc[nt]); }
        }
        __syncthreads();
#pragma unroll
        for (int nt = 0; nt < NT; ++nt)
#pragma unroll
            for (int r = 0; r < 4; ++r) part[(wave * 16 + 4 * g + r) * NG + 16 * nt + c16] = acc[nt][r];
        __syncthreads();
        for (int i = tid; i < 16 * NG; i += 512) { float sum = 0.f;
#pragma unroll
            for (int w8 = 0; w8 < 8; ++w8) sum += part[w8 * 16 * NG + i];
            GL[(size_t)r0 * NG + i] = sum; }
    }
}

__device__ __forceinline__ void ln_row(const float* sr, float* xr, const bf16* yrow, const float* mr, const float* lnw, const float* lnb, bf16* hrow, int lane, int dry, bool active) {
    f32x4 v[4]; float s = 0.f;
#pragma unroll
    for (int j = 0; j < 4; ++j) { const int c = 4 * lane + 256 * j; const f32x4 x = *(const f32x4*)(sr + c), g1 = *(const f32x4*)(mr + 2048 + c); const v2u yw = *(const v2u*)(yrow + c);
        v[j][0] = DN_ALPHA * x[0] + g1[0] * bflo(yw.x); v[j][1] = DN_ALPHA * x[1] + g1[1] * bfhi(yw.x); v[j][2] = DN_ALPHA * x[2] + g1[2] * bflo(yw.y); v[j][3] = DN_ALPHA * x[3] + g1[3] * bfhi(yw.y);
        s += (v[j][0] + v[j][1]) + (v[j][2] + v[j][3]); }
    const float mean = wave_sum(s) * (1.f / D); float s2 = 0.f;
#pragma unroll
    for (int j = 0; j < 4; ++j) { v[j] = v[j] - mean; s2 += (v[j][0] * v[j][0] + v[j][1] * v[j][1]) + (v[j][2] * v[j][2] + v[j][3] * v[j][3]); }
    const float rstd = 1.f / sqrtf(wave_sum(s2) * (1.f / D) + LN_EPS);
    if (active) {
#pragma unroll
    for (int j = 0; j < 4; ++j) { const int c = 4 * lane + 256 * j; const f32x4 w = *(const f32x4*)(lnw + c), bb = *(const f32x4*)(lnb + c);
        const f32x4 x1 = v[j] * rstd * w + bb; if (!dry) *(f32x4*)(xr + c) = x1;
        const f32x4 sh = *(const f32x4*)(mr + 3072 + c), sc = *(const f32x4*)(mr + 4096 + c); const f32x4 hp = x1 * (sc + 1.0f) + sh;
        v2u o; o.x = pk2(hp[0], hp[1]); o.y = pk2(hp[2], hp[3]); if (!dry) *(v2u*)(hrow + c) = o; }
    }
}
__device__ __forceinline__ void ln_phase(const float* slat, const float* sctx, float* lat, float* ctx, const bf16* Y, const float* mod, const float* lnw, const float* lnb, bf16* HB, int gw, int NGW, int lane, int dry, bool lat_only) {
    const int nrows = lat_only ? NB * SEQ : TT;
    for (int i0 = gw; i0 < nrows; i0 += 2 * NGW) {
        const int i1 = i0 + NGW; const bool has1 = i1 < nrows; const int r0 = map_row(i0, lat_only), r1c = map_row(has1 ? i1 : i0, lat_only);
        const int b0 = r0 / PB, p0 = r0 - b0 * PB, b1 = r1c / PB, p1 = r1c - b1 * PB;
        ln_row(srow_c(slat, sctx, r0), srow(lat, ctx, r0), Y + (size_t)r0 * D, mod + (size_t)(p0 < LC ? 8 : b0) * 6144, lnw, lnb, HB + (size_t)r0 * D, lane, dry, true);
        ln_row(srow_c(slat, sctx, r1c), srow(lat, ctx, r1c), Y + (size_t)r1c * D, mod + (size_t)(p1 < LC ? 8 : b1) * 6144, lnw, lnb, HB + (size_t)r1c * D, lane, dry, has1);
    }
}

constexpr int AT_LD = 72;
__device__ __forceinline__ bf16x8 frag_tr_perm(const LAS bf16* t, int ld, int r0, int c0, int lane) {
    const int g = lane >> 4, q = (lane & 15) >> 2, p = lane & 3;
    const LAS bf16* a = t + (r0 + 4 * g + q) * ld + c0 + 4 * p;
    const s16x4 lo = __builtin_amdgcn_ds_read_tr16_b64_v4i16((LAS s16x4*)a);
    const s16x4 hi = __builtin_amdgcn_ds_read_tr16_b64_v4i16((LAS s16x4*)(a + 16 * ld));
    return (bf16x8){lo[0], lo[1], lo[2], lo[3], hi[0], hi[1], hi[2], hi[3]};
}
__device__ __forceinline__ void attn_phase(const bf16* P, bf16* CAT, const float* sink, const float* ropetab, LAS unsigned char* lds, unsigned* qctr, int vcu, int G, int wave, int lane, int tid) {
    LAS bf16* Kt = (LAS bf16*)lds;
    LAS bf16* Vt = (LAS bf16*)(lds + 9216);
    LAS bf16* Qw = (LAS bf16*)(lds + 18432 + wave * 4608);
    const int g = lane >> 4, c16 = lane & 15;
    volatile LAS int* qslot = (volatile LAS int*)(lds + MISC_OFF) + 12;
    for (;;) {
        if (tid == 0) *qslot = (int)__hip_atomic_fetch_add(qctr, 1u, __ATOMIC_RELAXED, __HIP_MEMORY_SCOPE_AGENT);
        __syncthreads();
        const int item = *qslot;
        if (item >= 1024 + 64) break;
        const bool is_ctx = item >= 1024;
        int b, hk, nb;
        if (!is_ctx) { b = item >> 7; hk = (item >> 6) & 1; nb = item & 63; } else { const int it = item - 1024; b = it >> 3; hk = (it >> 2) & 1; nb = it & 3; }
        const int head = hk * 4 + (wave >> 1);
        const int qrow0 = b * PB + (is_ctx ? 0 : LC) + nb * 64 + (wave & 1) * 32;
        const int qlat0 = nb * 64 + (wave & 1) * 32;
        __syncthreads();
#pragma unroll
        for (int i = 0; i < 4; ++i) { const int cidx = lane + 64 * i, rr = cidx >> 3, ch = cidx & 7;
            const v4u raw = *(const v4u*)(P + (size_t)(qrow0 + rr) * N_AB + 2048 + head * 64 + ch * 8); v4u o = raw;
            if (!is_ctx) { const int tl = qlat0 + rr; const int pos = (ch < 4) ? (tl >> 6) : (tl & 63); const float* tb = ropetab + (size_t)(pos * 16 + (ch & 3) * 4) * 2;
                const unsigned wv[4] = {raw.x, raw.y, raw.z, raw.w}; unsigned ov[4];
#pragma unroll
                for (int k = 0; k < 4; ++k) { const float x1 = bflo(wv[k]), x2 = bfhi(wv[k]), c = tb[2 * k], s = tb[2 * k + 1]; ov[k] = pk2(x1 * c - x2 * s, x1 * s + x2 * c); }
                o.x = ov[0]; o.y = ov[1]; o.z = ov[2]; o.w = ov[3]; }
            *(LAS v4u*)(Qw + rr * AT_LD + ch * 8) = o; }
        LDS_FENCE();
        bf16x8 qf[2][2];
#pragma unroll
        for (int mt = 0; mt < 2; ++mt)
#pragma unroll
            for (int ks = 0; ks < 2; ++ks) qf[mt][ks] = frag_row(Qw, AT_LD, 16 * mt, 32 * ks, lane);
        LDS_FENCE();
        f32x4 o[2][4]; float mrun[2], lrun[2];
        const float sk = sink[head];
#pragma unroll
        for (int qt = 0; qt < 2; ++qt) { mrun[qt] = sk; lrun[qt] = 1.f; }
#pragma unroll
        for (int qt = 0; qt < 2; ++qt)
#pragma unroll
            for (int nt = 0; nt < 4; ++nt) o[qt][nt] = (f32x4){0.f, 0.f, 0.f, 0.f};
        const int nkt = is_ctx ? 4 : 9;
        const int srr = tid >> 3, sch = tid & 7;
        int kt = 0; f32x2 trope[4];
#pragma unroll
        for (int i = 0; i < 4; ++i) trope[i] = (f32x2){1.f, 0.f};
        v4u kraw = *(const v4u*)(P + (size_t)(b * PB + srr) * N_AB + 2560 + hk * 64 + sch * 8), vraw = *(const v4u*)(P + (size_t)(b * PB + srr) * N_AB + 2688 + hk * 64 + sch * 8);
        while (kt < nkt) {
            const int kp0 = nb * 64 - 128 + 64 * (kt - 4);
            int kn = kt + 1;
            while (kn < nkt && kn >= 4 && ((nb * 64 - 128 + 64 * (kn - 4)) < 0 || (nb * 64 - 128 + 64 * (kn - 4)) >= SEQ)) ++kn;
            __syncthreads();
            { v4u o = kraw;
              if (kt >= 4) { const unsigned wv[4] = {kraw.x, kraw.y, kraw.z, kraw.w}; unsigned ov[4];
#pragma unroll
                  for (int i = 0; i < 4; ++i) { const float x1 = bflo(wv[i]), x2 = bfhi(wv[i]), c = trope[i][0], sn = trope[i][1]; ov[i] = pk2(x1 * c - x2 * sn, x1 * sn + x2 * c); }
                  o.x = ov[0]; o.y = ov[1]; o.z = ov[2]; o.w = ov[3]; }
              *(LAS v4u*)(Kt + srr * AT_LD + sch * 8) = o; *(LAS v4u*)(Vt + srr * AT_LD + sch * 8) = vraw; }
            if (kn < nkt) { const int kpn = nb * 64 - 128 + 64 * (kn - 4); const int krn = b * PB + (kn < 4 ? 64 * kn : LC + kpn);
                kraw = *(const v4u*)(P + (size_t)(krn + srr) * N_AB + 2560 + hk * 64 + sch * 8); vraw = *(const v4u*)(P + (size_t)(krn + srr) * N_AB + 2688 + hk * 64 + sch * 8);
                if (kn >= 4) { const int tl = kpn + srr; const int pos = (sch < 4) ? (tl >> 6) : (tl & 63); const f32x2* tb = (const f32x2*)(ropetab + (size_t)(pos * 16 + (sch & 3) * 4) * 2);
#pragma unroll
                    for (int i = 0; i < 4; ++i) trope[i] = tb[i]; } }
            __syncthreads();
            const bool need_mask = (kt == 4) || (kt == 8);
            bf16x8 kf[4][2];
#pragma unroll
            for (int km = 0; km < 4; ++km)
#pragma unroll
                for (int ks = 0; ks < 2; ++ks) kf[km][ks] = frag_row(Kt, AT_LD, 16 * km, 32 * ks, lane);
            bf16x8 pa[2][2];
#pragma unroll
            for (int qt = 0; qt < 2; ++qt) {
                f32x4 st[4];
#pragma unroll
                for (int km = 0; km < 4; ++km) { st[km] = (f32x4){0.f, 0.f, 0.f, 0.f};
#pragma unroll
                    for (int ks = 0; ks < 2; ++ks) st[km] = mma(kf[km][ks], qf[qt][ks], st[km]); }
                if (need_mask) {
#pragma unroll
                    for (int km = 0; km < 4; ++km)
#pragma unroll
                        for (int r = 0; r < 4; ++r) { const int dq = (kp0 + 16 * km + 4 * g + r) - (qlat0 + 16 * qt + c16); if (dq > 128 || dq < -128) st[km][r] = -3.0e38f; } }
                float mx = fmaxf(fmaxf(fmaxf(st[0][0], st[0][1]), fmaxf(st[0][2], st[0][3])), fmaxf(fmaxf(st[1][0], st[1][1]), fmaxf(st[1][2], st[1][3])));
                mx = fmaxf(mx, fmaxf(fmaxf(fmaxf(st[2][0], st[2][1]), fmaxf(st[2][2], st[2][3])), fmaxf(fmaxf(st[3][0], st[3][1]), fmaxf(st[3][2], st[3][3]))));
                mx = fmaxf(mx, __shfl_xor(mx, 16)); mx = fmaxf(mx, __shfl_xor(mx, 32));
                const float mnew = fmaxf(mrun[qt], mx), alpha = __expf(mrun[qt] - mnew);
                float ps = 0.f;
#pragma unroll
                for (int km = 0; km < 4; ++km)
#pragma unroll
                    for (int r = 0; r < 4; ++r) { const float pv = __expf(st[km][r] - mnew); st[km][r] = pv; ps += pv; }
                ps += __shfl_xor(ps, 16); ps += __shfl_xor(ps, 32);
                lrun[qt] = lrun[qt] * alpha + ps; mrun[qt] = mnew;
#pragma unroll
                for (int ks2 = 0; ks2 < 2; ++ks2) { const unsigned w0 = pk2(st[2 * ks2][0], st[2 * ks2][1]), w1 = pk2(st[2 * ks2][2], st[2 * ks2][3]), w2 = pk2(st[2 * ks2 + 1][0], st[2 * ks2 + 1][1]), w3 = pk2(st[2 * ks2 + 1][2], st[2 * ks2 + 1][3]);
                    const v4u wv = (v4u){w0, w1, w2, w3}; pa[qt][ks2] = __builtin_bit_cast(bf16x8, wv); }
#pragma unroll
                for (int r = 0; r < 4; ++r) { const float ar = __shfl(alpha, (lane & 48) + 4 * g + r);
#pragma unroll
                    for (int nt = 0; nt < 4; ++nt) o[qt][nt][r] *= ar; }
            }
#pragma unroll
            for (int ks2 = 0; ks2 < 2; ++ks2) {
                bf16x8 vf[4];
#pragma unroll
                for (int nt = 0; nt < 4; ++nt) vf[nt] = frag_tr_perm(Vt, AT_LD, 32 * ks2, 16 * nt, lane);
#pragma unroll
                for (int qt = 0; qt < 2; ++qt)
#pragma unroll
                    for (int nt = 0; nt < 4; ++nt) o[qt][nt] = mma(pa[qt][ks2], vf[nt], o[qt][nt]); }
            LDS_FENCE();
            kt = kn;
        }
#pragma unroll
        for (int qt = 0; qt < 2; ++qt)
#pragma unroll
            for (int r = 0; r < 4; ++r) { const float inv = 1.f / __shfl(lrun[qt], (lane & 48) + 4 * g + r); bf16* orow = CAT + (size_t)(qrow0 + 16 * qt + 4 * g + r) * D + 512 + head * 64;
#pragma unroll
                for (int nt = 0; nt < 4; ++nt) orow[16 * nt + c16] = (bf16)f2bf(o[qt][nt][r] * inv); }
    }
}

__device__ __forceinline__ float wave_prefix_sum(float v) {
    v += __builtin_bit_cast(float, __builtin_amdgcn_update_dpp(0, __builtin_bit_cast(int, v), 0x111, 0xf, 0xf, true)); v += __builtin_bit_cast(float, __builtin_amdgcn_update_dpp(0, __builtin_bit_cast(int, v), 0x112, 0xf, 0xf, true));
    v += __builtin_bit_cast(float, __builtin_amdgcn_update_dpp(0, __builtin_bit_cast(int, v), 0x114, 0xf, 0xf, true)); v += __builtin_bit_cast(float, __builtin_amdgcn_update_dpp(0, __builtin_bit_cast(int, v), 0x118, 0xf, 0xf, true));
    v += __builtin_bit_cast(float, __builtin_amdgcn_update_dpp(0, __builtin_bit_cast(int, v), 0x142, 0xa, 0xf, false)); v += __builtin_bit_cast(float, __builtin_amdgcn_update_dpp(0, __builtin_bit_cast(int, v), 0x143, 0xc, 0xf, false));
    return v;
}
__device__ __forceinline__ float wave_prefix_max(float v) {
    const int ninf = (int)0xff800000u;
    v = fmaxf(v, __builtin_bit_cast(float, __builtin_amdgcn_update_dpp(ninf, __builtin_bit_cast(int, v), 0x111, 0xf, 0xf, false))); v = fmaxf(v, __builtin_bit_cast(float, __builtin_amdgcn_update_dpp(ninf, __builtin_bit_cast(int, v), 0x112, 0xf, 0xf, false)));
    v = fmaxf(v, __builtin_bit_cast(float, __builtin_amdgcn_update_dpp(ninf, __builtin_bit_cast(int, v), 0x114, 0xf, 0xf, false))); v = fmaxf(v, __builtin_bit_cast(float, __builtin_amdgcn_update_dpp(ninf, __builtin_bit_cast(int, v), 0x118, 0xf, 0xf, false)));
    v = fmaxf(v, __builtin_bit_cast(float, __builtin_amdgcn_update_dpp(ninf, __builtin_bit_cast(int, v), 0x142, 0xa, 0xf, false))); v = fmaxf(v, __builtin_bit_cast(float, __builtin_amdgcn_update_dpp(ninf, __builtin_bit_cast(int, v), 0x143, 0xc, 0xf, false)));
    return v;
}
__device__ __forceinline__ void mlstm_gate_scan(const float* GL  , const float* gate_b  , unsigned char* ws, int gw, int NGW, int lane) {
    float* BQ = (float*)(ws + WS_BQ); float* CQ = (float*)(ws + WS_CQ); float* EM = (float*)(ws + WS_EM); float* AI = (float*)(ws + WS_AI);
    float* AST = (float*)(ws + WS_AST); float* CL = (float*)(ws + WS_CL);
    for (int chain = gw; chain < 64; chain += NGW) {
        const int dir = chain >> 5, b = (chain >> 2) & 7, h = chain & 3;
        const float bi = gate_b[dir * 8 + h], bfg = gate_b[dir * 8 + 4 + h];
        float m_st = 0.f;
        float gi_n, gf_n;
        { const int j0 = dir == 0 ? 0 : 3; const int p0 = j0 * 64 + (dir == 0 ? lane : 63 - lane); const float* gr = GL + (size_t)(b * PB + p0) * 16 + dir * 8; gi_n = gr[h]; gf_n = gr[4 + h]; }
        for (int sc = 0; sc < NCH; ++sc) {
            const int j = dir == 0 ? sc : (sc < 4 ? 3 - sc : 71 - sc);
            const int p = j * 64 + (dir == 0 ? lane : 63 - lane);
            const float li = gi_n + bi, lf = logsigmoidf_(gf_n + bfg);
            if (sc + 1 < NCH) { const int sn = sc + 1; const int jn = dir == 0 ? sn : (sn < 4 ? 3 - sn : 71 - sn); const int pn = jn * 64 + (dir == 0 ? lane : 63 - lane);
                const float* gr = GL + (size_t)(b * PB + pn) * 16 + dir * 8; gi_n = gr[h]; gf_n = gr[4 + h]; }
            const float cum = wave_prefix_sum(lf);
            const float bb = li - cum; const float pm = wave_prefix_max(bb);
            const float c = fmaxf(m_st, pm);
            const size_t ti = (size_t)chain * PB + p;
            BQ[ti] = bb; CQ[ti] = c; EM[ti] = __expf(-(cum + c)); AI[ti] = __expf(m_st - c);
            const float cl = __builtin_bit_cast(float, __builtin_amdgcn_readlane(__builtin_bit_cast(int, c), 63)), tot = __builtin_bit_cast(float, __builtin_amdgcn_readlane(__builtin_bit_cast(int, cum), 63));
            if (lane == 0) { CL[chain * NCH + j] = cl; AST[chain * NCH + j] = __expf(m_st - cl); }
            m_st = tot + cl;
        }
    }
}


__device__ __forceinline__ float logsig_fast(float x) { return fminf(x, 0.f) - __logf(1.f + __expf(-fabsf(x))); }
__device__ __forceinline__ void gla_prep(bf16* P, bf16* QKR, const float* LOW  , const float* gate_up  , const float* gate_b  , unsigned char* ws,
                                         LAS unsigned char* lds, int vcu, int G, int tid, int dry) {
    float* ET = (float*)(ws + WS_ET);
    LAS float* lowt = (LAS float*)lds;
    LAS bf16* qs = (LAS bf16*)(lds + 8192);
    LAS bf16* ks = (LAS bf16*)(lds + 24576);
    LAS float* LA = (LAS float*)(lds + 40960);
    LAS float* HT = (LAS float*)(lds + 106496);
    const int dc = tid & 255, dir = dc >> 7, ch = dc & 127, half = tid >> 8;
    for (int item = vcu; item < NB * NCH * 4; item += G) {
        const int b = item / (NCH * 4), j = (item >> 2) % NCH, h = item & 3;
        const int row0 = b * PB + j * 64, c = h * 128 + ch;
        __syncthreads();
        for (int i = tid; i < 64 * 32; i += 512) lowt[i] = LOW[(size_t)row0 * 32 + i];
#pragma unroll
        for (int i = 0; i < 2; ++i) { const int cidx = tid + 512 * i, rr = cidx >> 4, c8 = cidx & 15; const bf16* src = P + (size_t)(row0 + rr) * N_C + h * 128 + c8 * 8;
            *(LAS v4u*)(qs + rr * 128 + c8 * 8) = *(const v4u*)src; *(LAS v4u*)(ks + rr * 128 + c8 * 8) = *(const v4u*)(src + 512); }
        float gu[16];
#pragma unroll
        for (int k = 0; k < 16; ++k) gu[k] = gate_up[(size_t)(dir * 16 + k) * 512 + c];
        const float gb = gate_b[dir * 512 + c];
        __syncthreads();
        float hsum = 0.f;
#pragma unroll 4
        for (int i = 0; i < 32; ++i) { const int t = half * 32 + i; float x = gb;
#pragma unroll
            for (int k = 0; k < 16; ++k) x += lowt[t * 32 + dir * 16 + k] * gu[k];
            const float la = logsig_fast(x) * (1.f / 16.f); LA[t * 256 + dc] = la; hsum += la; }
        HT[half * 256 + dc] = hsum;
        __syncthreads();
        float cum = (dir == 0) ? (half == 1 ? HT[dc] : 0.f) : (half == 0 ? HT[256 + dc] : 0.f);
#pragma unroll 4
        for (int i = 0; i < 32; ++i) { const int t = half * 32 + (dir == 0 ? i : 31 - i);
            cum += LA[t * 256 + dc];
            const float e = __expf(cum), ei = __expf(-cum);
            const size_t ro = (size_t)(row0 + t) * N_C;
            const float qv = bf2f(qs[t * 128 + ch]), kv = bf2f(ks[t * 128 + ch]);
            if (dir == 0) { if (!dry) { P[ro + c] = (bf16)f2bf(qv * e); P[ro + 512 + c] = (bf16)f2bf(kv * ei); } }
            else { QKR[(size_t)(row0 + t) * 1024 + c] = (bf16)f2bf(qv * e); QKR[(size_t)(row0 + t) * 1024 + 512 + c] = (bf16)f2bf(kv * ei); } }
        if (half == 0) ET[((size_t)((dir * 8 + b) * 4 + h) * NCH + j) * 128 + ch] = __expf(HT[dc] + HT[256 + dc]);
    }
}


__device__ __forceinline__ unsigned f2sort(float f) { const unsigned u = __builtin_bit_cast(unsigned, f); return (u & 0x80000000u) ? ~u : (u | 0x80000000u); }
__device__ __forceinline__ float sort2f(unsigned s) { const unsigned u = (s & 0x80000000u) ? (s & 0x7fffffffu) : ~s; return __builtin_bit_cast(float, u); }
template <int CTRL> __device__ __forceinline__ unsigned dppmov_u(unsigned x) { return (unsigned)__builtin_amdgcn_mov_dpp((int)x, CTRL, 0xf, 0xf, true); }
__device__ __forceinline__ unsigned gmax16(unsigned x) { unsigned y;
    y = dppmov_u<0xB1>(x); x = x > y ? x : y; y = dppmov_u<0x4E>(x); x = x > y ? x : y; y = dppmov_u<0x141>(x); x = x > y ? x : y; y = dppmov_u<0x128>(x); x = x > y ? x : y; return x; }
__device__ __forceinline__ float gsum16(float x) {
    x += __builtin_bit_cast(float, dppmov_u<0xB1>(__builtin_bit_cast(unsigned, x))); x += __builtin_bit_cast(float, dppmov_u<0x4E>(__builtin_bit_cast(unsigned, x)));
    x += __builtin_bit_cast(float, dppmov_u<0x141>(__builtin_bit_cast(unsigned, x))); x += __builtin_bit_cast(float, dppmov_u<0x128>(__builtin_bit_cast(unsigned, x))); return x; }
#define CSWAP(a, b) do { const unsigned hi_ = (a) > (b) ? (a) : (b), lo_ = (a) > (b) ? (b) : (a); (a) = hi_; (b) = lo_; } while (0)
__device__ __forceinline__ void peer_route(const bf16* Q, const bf16* KEYS, int* EID, float* GWT, int gw, int NGW, int lane, bool lat_only) {
    const int g = lane >> 4, c16 = lane & 15, gbase = lane & 48;
    const int nwi = (lat_only ? NB * SEQ / 16 : TT / 16) * 8;
    for (int wi = gw; wi < nwi; wi += NGW) {
        const int t0 = map_row((wi >> 3) * 16, lat_only), head = wi & 7;
        unsigned tops[2][4];
#pragma unroll
        for (int p = 0; p < 2; ++p) {
            const bf16* qrow = Q + (size_t)(t0 + c16) * 2048 + head * 256 + p * 128 + 8 * g;
            bf16x8 qf[4];
#pragma unroll
            for (int ks = 0; ks < 4; ++ks) qf[ks] = *(const bf16x8*)(qrow + 32 * ks);
            const bf16* kb = KEYS + (size_t)(head * 2 + p) * 128 * 128 + (size_t)c16 * 128 + 8 * g;
            unsigned key[8][4];
#pragma unroll
            for (int nt = 0; nt < 8; ++nt) { f32x4 s = (f32x4){0.f, 0.f, 0.f, 0.f};
#pragma unroll
                for (int ks = 0; ks < 4; ++ks) s = mma(qf[ks], *(const bf16x8*)(kb + (size_t)nt * 16 * 128 + 32 * ks), s);
#pragma unroll
                for (int r = 0; r < 4; ++r) key[nt][r] = (f2sort(s[r]) & ~127u) | (unsigned)(127 - (16 * nt + c16)); }
            unsigned kk[4][8];
#pragma unroll
            for (int r = 0; r < 4; ++r) {
#pragma unroll
                for (int nt = 0; nt < 8; ++nt) kk[r][nt] = key[nt][r];
                CSWAP(kk[r][0], kk[r][1]); CSWAP(kk[r][2], kk[r][3]); CSWAP(kk[r][4], kk[r][5]); CSWAP(kk[r][6], kk[r][7]); CSWAP(kk[r][0], kk[r][2]); CSWAP(kk[r][1], kk[r][3]); CSWAP(kk[r][4], kk[r][6]); CSWAP(kk[r][5], kk[r][7]);
                CSWAP(kk[r][1], kk[r][2]); CSWAP(kk[r][5], kk[r][6]); CSWAP(kk[r][0], kk[r][4]); CSWAP(kk[r][1], kk[r][5]); CSWAP(kk[r][2], kk[r][6]); CSWAP(kk[r][3], kk[r][7]); CSWAP(kk[r][2], kk[r][4]); CSWAP(kk[r][3], kk[r][5]);
                CSWAP(kk[r][1], kk[r][2]); CSWAP(kk[r][3], kk[r][4]); CSWAP(kk[r][5], kk[r][6]); }
            unsigned tt[4] = {0u, 0u, 0u, 0u};
#pragma unroll 2
            for (int rd = 0; rd < 16; ++rd) {
#pragma unroll
                for (int r = 0; r < 4; ++r) { const unsigned m = gmax16(kk[r][0]); const bool w = (kk[r][0] == m);
#pragma unroll
                    for (int q = 0; q < 7; ++q) kk[r][q] = w ? kk[r][q + 1] : kk[r][q];
                    kk[r][7] = w ? 0u : kk[r][7];
                    tt[r] = (c16 == rd) ? m : tt[r]; } }
#pragma unroll
            for (int r = 0; r < 4; ++r) tops[p][r] = tt[r];
        }
        float v0[4], s1v[4]; int ptr[4]; unsigned res[4];
#pragma unroll
        for (int r = 0; r < 4; ++r) { v0[r] = sort2f(tops[0][r] & ~127u); s1v[r] = sort2f((unsigned)__shfl((int)tops[1][r], gbase) & ~127u); ptr[r] = 0; res[r] = 0u; }
#pragma unroll 2
        for (int rd = 0; rd < 16; ++rd) {
#pragma unroll
            for (int r = 0; r < 4; ++r) {
                const unsigned ck = ptr[r] < 16 ? ((f2sort(v0[r] + s1v[r]) & ~255u) | (unsigned)((15 - c16) << 4) | (unsigned)(15 - ptr[r])) : 0u;
                const unsigned m = gmax16(ck);
                res[r] = (c16 == rd) ? m : res[r];
                if (ck == m) ++ptr[r];
                s1v[r] = sort2f((unsigned)__shfl((int)tops[1][r], gbase + (ptr[r] < 15 ? ptr[r] : 15)) & ~127u); } }
#pragma unroll
        for (int r = 0; r < 4; ++r) {
            const float val = sort2f(res[r] & ~255u); const int ii = 15 - (int)((res[r] >> 4) & 15u), jj = 15 - (int)(res[r] & 15u);
            const float mx = __shfl(val, gbase);
            const float ex = __expf(val - mx), sum = gsum16(ex);
            const unsigned i0 = 127u - ((unsigned)__shfl((int)tops[0][r], gbase + ii) & 127u), i1 = 127u - ((unsigned)__shfl((int)tops[1][r], gbase + jj) & 127u);
            const size_t o = (size_t)(t0 + 4 * g + r) * 128 + head * 16 + c16;
            EID[o] = (int)(i0 * 128u + i1); GWT[o] = ex / sum;
        }
    }
}

__device__ __forceinline__ void unpack8(const v4u w, float* o) { o[0] = bflo(w.x); o[1] = bfhi(w.x); o[2] = bflo(w.y); o[3] = bfhi(w.y); o[4] = bflo(w.z); o[5] = bfhi(w.z); o[6] = bflo(w.w); o[7] = bfhi(w.w); }
__device__ __forceinline__ void unpack16_fp8(const v4u w, float* o) {
    const unsigned ww[4] = {w.x, w.y, w.z, w.w};
#pragma unroll
    for (int i = 0; i < 4; ++i) { const f32x2 lo = __builtin_amdgcn_cvt_pk_f32_fp8((int)ww[i], false), hi = __builtin_amdgcn_cvt_pk_f32_fp8((int)ww[i], true);
        o[4 * i] = lo[0]; o[4 * i + 1] = lo[1]; o[4 * i + 2] = hi[0]; o[4 * i + 3] = hi[1]; }
}
__device__ __forceinline__ int rev3(int x) { return ((x & 1) << 2) | (x & 2) | ((x >> 2) & 1); }
__device__ __forceinline__ void peer_pass1(const bf16* HB, const int* EID, const float* GWT, const unsigned char* U6, const float* SUi, const float* SVi, float* COEF, int gw, int NGW, int lane, bool lat_only) {
    const int myslot = 8 * (lane & 7) + rev3(lane >> 3);
    const bool b5 = (lane & 32) != 0, b4 = (lane & 16) != 0, b3 = (lane & 8) != 0;
    const int nrows = lat_only ? NB * SEQ : TT;
    for (int ri = gw; ri < nrows; ri += NGW) {
        const int r = map_row(ri, lat_only);
        float h[16];
        { const v4u a = *(const v4u*)(HB + (size_t)r * D + 16 * lane), bq = *(const v4u*)(HB + (size_t)r * D + 16 * lane + 8); unpack8(a, h); unpack8(bq, h + 8); }
#pragma unroll 1
        for (int half = 0; half < 2; ++half) {
            const int eid = EID[(size_t)r * 128 + half * 64 + myslot]; const float gwt = GWT[(size_t)r * 128 + half * 64 + myslot];
            float dotreg = 0.f;
            v3u raw[8];
#pragma unroll
            for (int vi = 0; vi < 8; ++vi) { const int id = __builtin_amdgcn_readlane(eid, 8 * rev3(vi)); raw[vi] = *(const v3u*)(U6 + (size_t)id * 768 + 12 * lane); }
#pragma unroll 1
            for (int gI = 0; gI < 8; ++gI) {
                const int gn = gI < 7 ? gI + 1 : 7;
                float a[8];
#pragma unroll
                for (int vi = 0; vi < 8; ++vi) { const v6u pk6 = (v6u){raw[vi].x, raw[vi].y, raw[vi].z, 0u, 0u, 0u}; const v32f w = __builtin_amdgcn_cvt_scalef32_pk32_f32_fp6(pk6, 1.0f);
                    const int idn = __builtin_amdgcn_readlane(eid, gn + 8 * rev3(vi)); raw[vi] = *(const v3u*)(U6 + (size_t)idn * 768 + 12 * lane);
                    float sacc = 0.f;
#pragma unroll
                    for (int i = 0; i < 16; ++i) sacc += h[i] * w[i];
                    a[vi] = sacc;
                    __builtin_amdgcn_sched_barrier(0); }
                float bb[4];
#pragma unroll
                for (int k = 0; k < 4; ++k) { const float keep = b5 ? a[2 * k + 1] : a[2 * k], send = b5 ? a[2 * k] : a[2 * k + 1]; bb[k] = keep + __shfl_xor(send, 32); }
                float cc[2];
#pragma unroll
                for (int k = 0; k < 2; ++k) { const float keep = b4 ? bb[2 * k + 1] : bb[2 * k], send = b4 ? bb[2 * k] : bb[2 * k + 1]; cc[k] = keep + __shfl_xor(send, 16); }
                float dd; { const float keep = b3 ? cc[1] : cc[0], send = b3 ? cc[0] : cc[1]; dd = keep + __shfl_xor(send, 8); }
                dd += __shfl_xor(dd, 4); dd += __shfl_xor(dd, 2); dd += __shfl_xor(dd, 1);
                dotreg = ((lane & 7) == gI) ? dd : dotreg;
            }
            const float dot = dotreg * SUi[eid];
            const float coef = gwt * 0.5f * dot * (1.f + erff(dot * 0.70710678118f)) * SVi[eid];
            COEF[(size_t)r * 128 + half * 64 + myslot] = coef;
        }
    }
}
template <bool USE_PEER>
__device__ __forceinline__ void peer_expert(const float* COEF, const int* EID, const unsigned char* V6,
                                            float* lat, float* ctx, const float* mod, const float* lnw, const float* lnb, int gw, int NGW, int lane, int dry, bool lat_only) {
    const int myslot = 8 * (lane & 7) + rev3(lane >> 3);
    const int nrows = lat_only ? NB * SEQ : TT;
    for (int ri = gw; ri < nrows; ri += NGW) {
        const int r = map_row(ri, lat_only);
        const int b = r / PB, p = r - b * PB; float* xr = srow(lat, ctx, r); const float* mr = mod + (size_t)(p < LC ? 8 : b) * 6144;
        float f[16];
#pragma unroll
        for (int i = 0; i < 16; ++i) f[i] = 0.f;
        if (USE_PEER) {
#pragma unroll 1
        for (int half = 0; half < 2; ++half) {
            const int eid = EID[(size_t)r * 128 + half * 64 + myslot];
            const float coef = COEF[(size_t)r * 128 + half * 64 + myslot];
            v3u ring[8];
#pragma unroll
            for (int k = 0; k < 8; ++k) { const int id = __builtin_amdgcn_readlane(eid, k); ring[k] = *(const v3u*)(V6 + (size_t)id * 768 + 12 * lane); }
#pragma unroll 1
            for (int e0 = 0; e0 < 64; e0 += 8) {
#pragma unroll
                for (int k = 0; k < 8; ++k) { const float c = __builtin_bit_cast(float, __builtin_amdgcn_readlane(__builtin_bit_cast(int, coef), e0 + k));
                    const v6u pk6 = (v6u){ring[k].x, ring[k].y, ring[k].z, 0u, 0u, 0u}; const v32f w = __builtin_amdgcn_cvt_scalef32_pk32_f32_fp6(pk6, 1.0f);
                    const int en = (e0 + 8 + k) < 64 ? (e0 + 8 + k) : 63; const int idn = __builtin_amdgcn_readlane(eid, en);
                    ring[k] = *(const v3u*)(V6 + (size_t)idn * 768 + 12 * lane);
#pragma unroll
                    for (int i = 0; i < 16; ++i) f[i] += c * w[i];
                    __builtin_amdgcn_sched_barrier(0); }
            }
        }
        }
        float v[16]; float s = 0.f;
#pragma unroll
        for (int q = 0; q < 4; ++q) { const int c = 16 * lane + 4 * q; const f32x4 x1 = *(const f32x4*)(xr + c), g2 = *(const f32x4*)(mr + 5120 + c);
#pragma unroll
            for (int i = 0; i < 4; ++i) { v[4 * q + i] = DN_ALPHA * x1[i] + g2[i] * f[4 * q + i]; s += v[4 * q + i]; } }
        const float mean = wave_sum(s) * (1.f / D); float s2 = 0.f;
#pragma unroll
        for (int i = 0; i < 16; ++i) { v[i] -= mean; s2 += v[i] * v[i]; }
        const float rstd = 1.f / sqrtf(wave_sum(s2) * (1.f / D) + LN_EPS);
#pragma unroll
        for (int q = 0; q < 4; ++q) { const int c = 16 * lane + 4 * q; const f32x4 w = *(const f32x4*)(lnw + c), bb2 = *(const f32x4*)(lnb + c); f32x4 o;
#pragma unroll
            for (int i = 0; i < 4; ++i) o[i] = v[4 * q + i] * rstd * w[i] + bb2[i];
            if (!dry) *(f32x4*)(xr + c) = o; }
    }
}

__device__ __forceinline__ bf16* od_row_base(unsigned char* ws, int dir, int b) {
    if (dir == 0) return (bf16*)(ws + WS_ST) + (size_t)b * SEQ * 1024;
    return b < 7 ? (bf16*)(ws + WS_ST + 64 * MiB) + (size_t)b * SEQ * 1024 : (bf16*)(ws + WS_XC);
}
__device__ __forceinline__ void gla_fused_scan(const bf16* P, const bf16* QKR, unsigned char* ws, LAS unsigned char* lds, int vcu, int G, int wave, int lane, int tid, int dry) {
    const float* ET = (const float*)(ws + WS_ET);
    LAS bf16* Qt = (LAS bf16*)lds;
    LAS bf16* Kt = (LAS bf16*)(lds + 34816);
    LAS bf16* Vt = (LAS bf16*)(lds + 69632);
    LAS bf16* SL = (LAS bf16*)(lds + 88064);
    LAS bf16* Pw = (LAS bf16*)(lds + 122880 + wave * 2304);
    const int g = lane >> 4, c16 = lane & 15, mt = wave & 3, cw = wave >> 2;
    for (int item = vcu; item < 256; item += G) {
        const int dir = item >> 7, b = (item >> 4) & 7, h = (item >> 2) & 3, eb = item & 3;
        const bf16* qsrc = dir == 0 ? P + h * 128 : QKR + h * 128; const int qld = dir == 0 ? N_C : 1024;
        const bf16* vsrc = P + 1024 + h * 256 + 64 * eb;
        const float* etp = ET + ((size_t)((dir * 8 + b) * 4 + h) * NCH) * 128 + 16 * wave + c16;
        bf16* odb = od_row_base(ws, dir, b) + h * 256 + 64 * eb;
        f32x4 acc[4];
#pragma unroll
        for (int et = 0; et < 4; ++et) acc[et] = (f32x4){0.f, 0.f, 0.f, 0.f};
        v4u qreg[2][2], kreg[2][2], vreg[2]; float etn[2];
#define GLA_JOF(sc_) (dir == 0 ? (sc_) : ((sc_) < 4 ? 3 - (sc_) : 71 - (sc_)))
#define GLA_PREFETCH(sc0_) do { _Pragma("unroll") for (int u = 0; u < 2; ++u) { const int jj = GLA_JOF((sc0_) + u); const int row0 = b * PB + jj * 64; \
            _Pragma("unroll") for (int i = 0; i < 2; ++i) { const int cidx = tid + 512 * i, rr = cidx >> 4, ch = cidx & 15; const bf16* sp = qsrc + (size_t)(row0 + rr) * qld + ch * 8; qreg[u][i] = *(const v4u*)sp; kreg[u][i] = *(const v4u*)(sp + 512); } \
            vreg[u] = *(const v4u*)(vsrc + (size_t)(row0 + (tid >> 3)) * N_C + (tid & 7) * 8); etn[u] = etp[(size_t)jj * 128]; } } while (0)
        GLA_PREFETCH(0);
        unsigned opk[8]; int ojc = -1;
#pragma unroll
        for (int i = 0; i < 8; ++i) opk[i] = 0u;
        for (int sc = 0; sc < NCH; sc += 2) {
            const int ja = GLA_JOF(sc), jb = GLA_JOF(sc + 1);
            __syncthreads();
            if (ojc >= 4 && !dry) {
#pragma unroll
                for (int nt = 0; nt < 4; ++nt) { bf16* orow = odb + (size_t)((ojc - 4) * 64 + 16 * mt + 4 * g) * 1024 + 16 * nt + c16;
#pragma unroll
                    for (int r = 0; r < 4; ++r) orow[(size_t)r * 1024] = (bf16)((opk[2 * nt + (r >> 1)] >> (16 * (r & 1))) & 0xffffu); } }
#pragma unroll
            for (int u = 0; u < 2; ++u) {
#pragma unroll
                for (int i = 0; i < 2; ++i) { const int cidx = tid + 512 * i, rr = cidx >> 4, ch = cidx & 15; *(LAS v4u*)(Qt + u * 8704 + rr * 136 + ch * 8) = qreg[u][i]; *(LAS v4u*)(Kt + u * 8704 + rr * 136 + ch * 8) = kreg[u][i]; }
                *(LAS v4u*)(Vt + u * 4608 + (tid >> 3) * 72 + (tid & 7) * 8) = vreg[u]; }
#pragma unroll
            for (int et = 0; et < 4; ++et)
#pragma unroll
                for (int r = 0; r < 4; ++r) SL[(16 * et + 4 * g + r) * 136 + 16 * wave + c16] = (bf16)f2bf(acc[et][r]);
            const float et_a = etn[0], et_b = etn[1];
            if (sc + 2 < NCH) GLA_PREFETCH(sc + 2);
            __syncthreads();
#pragma unroll
            for (int ks = 0; ks < 2; ++ks) { const bf16x8 kb = frag_tr(Kt, 136, 32 * ks, 16 * wave, lane);
#pragma unroll
                for (int et = 0; et < 4; ++et) acc[et] = mma(frag_tr(Vt, 72, 32 * ks, 16 * et, lane), kb, acc[et]); }
#pragma unroll
            for (int et = 0; et < 4; ++et) { acc[et] = acc[et] * et_a;
#pragma unroll
                for (int r = 0; r < 4; ++r) SL[8704 + (16 * et + 4 * g + r) * 136 + 16 * wave + c16] = (bf16)f2bf(acc[et][r]); }
            __syncthreads();
            const int jc = cw == 0 ? ja : jb;
            ojc = jc;
            if (jc >= 4) {
                const LAS bf16* Qc = Qt + cw * 8704; const LAS bf16* Kc = Kt + cw * 8704; const LAS bf16* Vc = Vt + cw * 4608; const LAS bf16* Sc = SL + cw * 8704;
                bf16x8 qf[4];
#pragma unroll
                for (int ks = 0; ks < 4; ++ks) qf[ks] = frag_row(Qc, 136, 16 * mt, 32 * ks, lane);
                bf16x8 pa[2];
                { f32x4 st[4];
#pragma unroll
                  for (int ns = 0; ns < 4; ++ns) { st[ns] = (f32x4){0.f, 0.f, 0.f, 0.f};
#pragma unroll
                      for (int ks = 0; ks < 4; ++ks) st[ns] = mma(frag_row(Kc, 136, 16 * ns, 32 * ks, lane), qf[ks], st[ns]);
#pragma unroll
                      for (int r = 0; r < 4; ++r) { const int sidx = 16 * ns + 4 * g + r, t = 16 * mt + c16; const bool ok = dir == 0 ? (sidx <= t) : (sidx >= t); st[ns][r] = ok ? st[ns][r] : 0.f; } }
#pragma unroll
                  for (int ks2 = 0; ks2 < 2; ++ks2) { const v4u wv = (v4u){pk2(st[2 * ks2][0], st[2 * ks2][1]), pk2(st[2 * ks2][2], st[2 * ks2][3]), pk2(st[2 * ks2 + 1][0], st[2 * ks2 + 1][1]), pk2(st[2 * ks2 + 1][2], st[2 * ks2 + 1][3])};
                      pa[ks2] = __builtin_bit_cast(bf16x8, wv); } }
#pragma unroll
                for (int nt = 0; nt < 4; ++nt) { f32x4 a = (f32x4){0.f, 0.f, 0.f, 0.f};
#pragma unroll
                    for (int ks = 0; ks < 4; ++ks) a = mma(qf[ks], frag_row(Sc, 136, 16 * nt, 32 * ks, lane), a);
                    a = mma(pa[0], frag_tr_perm(Vc, 72, 0, 16 * nt, lane), a); a = mma(pa[1], frag_tr_perm(Vc, 72, 32, 16 * nt, lane), a);
                    opk[2 * nt] = pk2(a[0], a[1]); opk[2 * nt + 1] = pk2(a[2], a[3]); }
                LDS_FENCE();
            }
#pragma unroll
            for (int ks = 0; ks < 2; ++ks) { const bf16x8 kb = frag_tr(Kt + 8704, 136, 32 * ks, 16 * wave, lane);
#pragma unroll
                for (int et = 0; et < 4; ++et) acc[et] = mma(frag_tr(Vt + 4608, 72, 32 * ks, 16 * et, lane), kb, acc[et]); }
#pragma unroll
            for (int et = 0; et < 4; ++et) acc[et] = acc[et] * et_b;
        }
        if (ojc >= 4 && !dry) {
#pragma unroll
            for (int nt = 0; nt < 4; ++nt) { bf16* orow = odb + (size_t)((ojc - 4) * 64 + 16 * mt + 4 * g) * 1024 + 16 * nt + c16;
#pragma unroll
                for (int r = 0; r < 4; ++r) orow[(size_t)r * 1024] = (bf16)((opk[2 * nt + (r >> 1)] >> (16 * (r & 1))) & 0xffffu); } }
#undef GLA_PREFETCH
#undef GLA_JOF
    }
}
__device__ __forceinline__ void gla_merge(bf16* P, const float* norm_w, unsigned char* ws, int gw, int NGW, int lane, int dry) {
    for (int i = gw; i < NB * SEQ; i += NGW) {
        const int b = i >> 12, lp = i & 4095; const size_t r = (size_t)b * PB + LC + lp;
        const bf16* of = od_row_base(ws, 0, b) + (size_t)lp * 1024 + 16 * lane; const bf16* orv = od_row_base(ws, 1, b) + (size_t)lp * 1024 + 16 * lane;
        bf16* grow = P + r * N_C + 2048 + 16 * lane;
        float x[16], y[16], gg[16];
        unpack8(*(const v4u*)of, x); unpack8(*(const v4u*)(of + 8), x + 8); unpack8(*(const v4u*)orv, y); unpack8(*(const v4u*)(orv + 8), y + 8);
        unpack8(*(const v4u*)grow, gg); unpack8(*(const v4u*)(grow + 8), gg + 8);
        float ss = 0.f;
#pragma unroll
        for (int k = 0; k < 16; ++k) { x[k] += y[k]; ss += x[k] * x[k]; }
        ss = gsum16(ss);
        const float rn = 1.f / sqrtf(ss * (1.f / 256.f) + LN_EPS);
        unsigned ow[8];
#pragma unroll
        for (int k = 0; k < 8; ++k) { const float4 dummy = make_float4(0.f, 0.f, 0.f, 0.f); (void)dummy;
            const float a = x[2 * k] * rn * norm_w[16 * lane + 2 * k] * siluf_(gg[2 * k]), c = x[2 * k + 1] * rn * norm_w[16 * lane + 2 * k + 1] * siluf_(gg[2 * k + 1]); ow[k] = pk2(a, c); }
        if (!dry) { v4u o0, o1; o0.x = ow[0]; o0.y = ow[1]; o0.z = ow[2]; o0.w = ow[3]; o1.x = ow[4]; o1.y = ow[5]; o1.z = ow[6]; o1.w = ow[7]; *(v4u*)grow = o0; *(v4u*)(grow + 8) = o1; }
    }
}

__device__ __forceinline__ void mlstm_fused_scan(const bf16* P, unsigned char* ws, LAS unsigned char* lds, int vcu, int G, int wave, int lane, int tid) {
    const float* BQ = (const float*)(ws + WS_BQ); const float* CQ = (const float*)(ws + WS_CQ); const float* EM = (const float*)(ws + WS_EM); const float* AI = (const float*)(ws + WS_AI);
    const float* AST = (const float*)(ws + WS_AST); const float* CL = (const float*)(ws + WS_CL);
    LAS bf16* Qt = (LAS bf16*)lds;
    LAS bf16* Kt = (LAS bf16*)(lds + 17408);
    LAS bf16* Vt = (LAS bf16*)(lds + 34816);
    LAS bf16* Vw = (LAS bf16*)(lds + 41984);
    LAS bf16* CT = (LAS bf16*)(lds + 49152);
    LAS bf16* Pw = (LAS bf16*)(lds + 62208 + wave * 2304);
    const int g = lane >> 4, c16 = lane & 15, mt = wave & 3, hf = wave >> 2;
    const int vrow = tid < 256 ? (tid >> 2) : ((tid - 256) & 63), vch = tid & 3;
    for (int item = vcu; item < 256; item += G) {
        const int dir = item >> 7, b = (item >> 4) & 7, h = (item >> 2) & 3, eb = item & 3;
        const int chain = dir * 32 + b * 4 + h;
        const bf16* qsrc = P + h * 128; const bf16* vsrc = P + 1024 + h * 128 + 32 * eb;
        bf16* odb = (bf16*)(ws + WS_ST) + (size_t)dir * TT * 512 + h * 128 + 32 * eb;
        f32x4 acc[3];
#pragma unroll
        for (int et = 0; et < 3; ++et) acc[et] = (f32x4){0.f, 0.f, 0.f, 0.f};
        v4u qreg[2], kreg[2], vreg; float bqr, cln, astn, cqn; f32x4 bqn[4], ain, emn;
        { const int j0 = dir == 0 ? 0 : 3; const int row0 = b * PB + j0 * 64; const size_t tb = (size_t)chain * PB + j0 * 64;
#pragma unroll
          for (int i = 0; i < 2; ++i) { const int cidx = tid + 512 * i, rr = cidx >> 4, ch = cidx & 15; const bf16* s = qsrc + (size_t)(row0 + rr) * N_AB + ch * 8; qreg[i] = *(const v4u*)s; kreg[i] = *(const v4u*)(s + 512); }
          vreg = *(const v4u*)(vsrc + (size_t)(row0 + vrow) * N_AB + vch * 8); bqr = BQ[tb + vrow]; cln = CL[chain * NCH + j0]; astn = AST[chain * NCH + j0];
#pragma unroll
          for (int k = 0; k < 4; ++k) bqn[k] = *(const f32x4*)(BQ + tb + 16 * k + 4 * g);
          cqn = CQ[tb + 16 * mt + c16]; ain = *(const f32x4*)(AI + tb + 16 * mt + 4 * g); emn = *(const f32x4*)(EM + tb + 16 * mt + 4 * g); }
        for (int sc = 0; sc < NCH; ++sc) {
            const int j = dir == 0 ? sc : (sc < 4 ? 3 - sc : 71 - sc);
            __syncthreads();
#pragma unroll
            for (int i = 0; i < 2; ++i) { const int cidx = tid + 512 * i, rr = cidx >> 4, ch = cidx & 15; *(LAS v4u*)(Qt + rr * 136 + ch * 8) = qreg[i]; *(LAS v4u*)(Kt + rr * 136 + ch * 8) = kreg[i]; }
            { const float wsv = __expf(bqr - cln);
              if (tid < 256) { const v4u raw = vreg; v4u o;
                  o.x = pk2(bflo(raw.x) * wsv, bfhi(raw.x) * wsv); o.y = pk2(bflo(raw.y) * wsv, bfhi(raw.y) * wsv); o.z = pk2(bflo(raw.z) * wsv, bfhi(raw.z) * wsv); o.w = pk2(bflo(raw.w) * wsv, bfhi(raw.w) * wsv);
                  *(LAS v4u*)(Vt + vrow * 56 + vch * 8) = raw; *(LAS v4u*)(Vw + vrow * 56 + vch * 8) = o;
              } else if (tid < 320) { v4u o; o.x = 0x3f80u; o.y = 0u; o.z = 0u; o.w = 0u; *(LAS v4u*)(Vt + vrow * 56 + 32) = o; o.x = f2bf(wsv); *(LAS v4u*)(Vw + vrow * 56 + 32) = o;
                  o.x = 0u; *(LAS v4u*)(Vt + vrow * 56 + 40) = o; *(LAS v4u*)(Vw + vrow * 56 + 40) = o; } }
#pragma unroll
            for (int et = 0; et < 3; ++et)
#pragma unroll
                for (int r = 0; r < 4; ++r) CT[(16 * et + 4 * g + r) * 136 + 16 * wave + c16] = (bf16)f2bf(acc[et][r]);
            const float ast = astn, cqt = cqn; f32x4 bq[4]; const f32x4 ai = ain, em = emn;
#pragma unroll
            for (int k = 0; k < 4; ++k) bq[k] = bqn[k];
            if (sc + 1 < NCH) { const int sn = sc + 1; const int jn = dir == 0 ? sn : (sn < 4 ? 3 - sn : 71 - sn); const int row0 = b * PB + jn * 64; const size_t tb = (size_t)chain * PB + jn * 64;
#pragma unroll
                for (int i = 0; i < 2; ++i) { const int cidx = tid + 512 * i, rr = cidx >> 4, ch = cidx & 15; const bf16* s = qsrc + (size_t)(row0 + rr) * N_AB + ch * 8; qreg[i] = *(const v4u*)s; kreg[i] = *(const v4u*)(s + 512); }
                vreg = *(const v4u*)(vsrc + (size_t)(row0 + vrow) * N_AB + vch * 8); bqr = BQ[tb + vrow]; cln = CL[chain * NCH + jn]; astn = AST[chain * NCH + jn];
#pragma unroll
                for (int k = 0; k < 4; ++k) bqn[k] = *(const f32x4*)(BQ + tb + 16 * k + 4 * g);
                cqn = CQ[tb + 16 * mt + c16]; ain = *(const f32x4*)(AI + tb + 16 * mt + 4 * g); emn = *(const f32x4*)(EM + tb + 16 * mt + 4 * g); }
            __syncthreads();
            bf16x8 qf[4];
#pragma unroll
            for (int ks = 0; ks < 4; ++ks) qf[ks] = frag_row(Qt, 136, 16 * mt, 32 * ks, lane);
            bf16x8 pa[2];
            { f32x4 st[4];
#pragma unroll
              for (int ns = 0; ns < 4; ++ns) { st[ns] = (f32x4){0.f, 0.f, 0.f, 0.f};
#pragma unroll
                  for (int ks = 0; ks < 4; ++ks) st[ns] = mma(frag_row(Kt, 136, 16 * ns, 32 * ks, lane), qf[ks], st[ns]);
#pragma unroll
                  for (int r = 0; r < 4; ++r) { const int sidx = 16 * ns + 4 * g + r, t = 16 * mt + c16; const bool ok = dir == 0 ? (sidx <= t) : (sidx >= t);
                      st[ns][r] = ok ? st[ns][r] * __expf(bq[ns][r] - cqt) : 0.f; } }
#pragma unroll
              for (int ks2 = 0; ks2 < 2; ++ks2) { const v4u wv = (v4u){pk2(st[2 * ks2][0], st[2 * ks2][1]), pk2(st[2 * ks2][2], st[2 * ks2][3]), pk2(st[2 * ks2 + 1][0], st[2 * ks2 + 1][1]), pk2(st[2 * ks2 + 1][2], st[2 * ks2 + 1][3])};
                  pa[ks2] = __builtin_bit_cast(bf16x8, wv); } }
            f32x4 av, ad;
            { f32x4 a = (f32x4){0.f, 0.f, 0.f, 0.f}, d = (f32x4){0.f, 0.f, 0.f, 0.f};
#pragma unroll
              for (int ks = 0; ks < 4; ++ks) { a = mma(qf[ks], frag_row(CT, 136, 16 * hf, 32 * ks, lane), a); d = mma(qf[ks], frag_row(CT, 136, 32, 32 * ks, lane), d); }
#pragma unroll
              for (int r = 0; r < 4; ++r) { a[r] *= ai[r]; d[r] *= ai[r]; }
#pragma unroll
              for (int ks = 0; ks < 2; ++ks) { a = mma(pa[ks], frag_tr_perm(Vt, 56, 32 * ks, 16 * hf, lane), a); d = mma(pa[ks], frag_tr_perm(Vt, 56, 32 * ks, 32, lane), d); }
              av = a; ad = d; }
            { bf16* orow = odb + (size_t)(b * PB + j * 64 + 16 * mt + 4 * g) * 512 + 16 * hf + c16;
#pragma unroll
              for (int r = 0; r < 4; ++r) { const float den = __shfl(ad[r], lane & 48); orow[(size_t)r * 512] = (bf16)f2bf(av[r] / fmaxf(fabsf(den), em[r])); } }
#pragma unroll
            for (int et = 0; et < 3; ++et) acc[et] = acc[et] * ast;
#pragma unroll
            for (int ks = 0; ks < 2; ++ks) { const bf16x8 kb = frag_tr(Kt, 136, 32 * ks, 16 * wave, lane);
#pragma unroll
                for (int et = 0; et < 3; ++et) acc[et] = mma(frag_tr(Vw, 56, 32 * ks, 16 * et, lane), kb, acc[et]); }
        }
    }
}
__device__ __forceinline__ void mlstm_merge(const bf16* P, bf16* CAT, const float* norm_w, unsigned char* ws, int gw, int NGW, int lane) {
    const bf16* OD = (const bf16*)(ws + WS_ST);
    for (int r = gw; r < TT; r += NGW) {
        float x[8], y[8], og[8];
        unpack8(*(const v4u*)(OD + (size_t)r * 512 + 8 * lane), x); unpack8(*(const v4u*)(OD + (size_t)TT * 512 + (size_t)r * 512 + 8 * lane), y);
        unpack8(*(const v4u*)(P + (size_t)r * N_AB + 1536 + 8 * lane), og);
        float ss = 0.f;
#pragma unroll
        for (int k = 0; k < 8; ++k) { x[k] += y[k]; ss += x[k] * x[k]; }
        ss = gsum16(ss);
        const float rn = 1.f / sqrtf(ss * (1.f / 128.f) + LN_EPS);
        unsigned ow[4];
#pragma unroll
        for (int k = 0; k < 4; ++k) ow[k] = pk2(x[2 * k] * rn * norm_w[8 * lane + 2 * k] * sigmoidf_(og[2 * k]), x[2 * k + 1] * rn * norm_w[8 * lane + 2 * k + 1] * sigmoidf_(og[2 * k + 1]));
        v4u o; o.x = ow[0]; o.y = ow[1]; o.z = ow[2]; o.w = ow[3]; *(v4u*)(CAT + (size_t)r * D + 8 * lane) = o;
    }
}

#ifndef PHMASK
#define PHMASK 0xffffffffu
#endif
#define PH(k) ((PHMASK >> (k)) & 1u)
#ifndef REPMASK
#define REPMASK 0u
#endif
#define REPS(k) (1 + (int)((REPMASK >> (k)) & 1u))
#if REPMASK
#define DRYV(k) ({ int d_ = (rep_ + 1 < REPS(k)) ? 1 : 0; asm volatile("" : "+s"(d_)); d_; })
#else
#define DRYV(k) 0
#endif
#ifndef DBG_LEVEL
#define DBG_LEVEL 3
#endif
typedef const __attribute__((address_space(4))) Args* KArgsP;
__device__ __forceinline__ KArgsP kargs() { KArgsP p = (KArgsP)__builtin_amdgcn_kernarg_segment_ptr(); asm volatile("" : "+s"(p)); return p; }
#define WSP(off) (ws + (off))
__global__ void __launch_bounds__(512, 2) fwd_megakernel(Args A_unused) {
    extern __shared__ __attribute__((aligned(16))) unsigned char lds_raw[];
    LAS unsigned char* lds = (LAS unsigned char*)lds_raw;
    const int tid0 = threadIdx.x;
    const int G = gridDim.x; const int bx = blockIdx.x; const int vcu = (G % 8 == 0) ? (bx % 8) * (G / 8) + bx / 8 : bx;
    const int NGW = G * 8;
    volatile LAS unsigned* MISC = (volatile LAS unsigned*)(lds + MISC_OFF);
    if (tid0 < 16) MISC[tid0] = 0u;
    __syncthreads();
    XcdBarrier bar;
    { KArgsP ap = kargs(); bar = xcd_barrier_post((unsigned*)(ap->ws + WS_CTL) + 1024, MISC + 8); }
#define GRID_BAR() xcd_barrier(bar)
#define PROLOG KArgsP ap = kargs(); unsigned char* ws = ap->ws; (void)ws; int tid = tid0; asm volatile("" : "+v"(tid)); const int lane = tid & 63, wave = __builtin_amdgcn_readfirstlane(tid >> 6), gw = vcu * 8 + wave; (void)lane; (void)wave; (void)gw;

    if (PH(0)) for (int rep_ = 0; rep_ < REPS(0); ++rep_) { int tid = tid0; asm volatile("" : "+v"(tid)); const int lane = tid & 63, wave = __builtin_amdgcn_readfirstlane(tid >> 6); Args A; { KArgsP ap = kargs();
#pragma unroll
        for (int i = 0; i < 22; ++i) A.in[i] = ap->in[i];
        A.out = ap->out; A.ws = ap->ws; }
        p0_prologue(A, lds, vcu, G, wave, lane, tid); }
    GRID_BAR();

    if (PH(1)) for (int rep_ = 0; rep_ < REPS(1); ++rep_) { PROLOG h_phase<16>(ap->in[I_X], ap->in[I_CTX], (const float*)WSP(WS_MOD), (bf16*)WSP(WS_HB), (const float*)WSP(WS_WG), (float*)WSP(WS_GL), lds, vcu, G, wave, lane, tid); }
    GRID_BAR();
    if (PH(2)) for (int rep_ = 0; rep_ < REPS(2); ++rep_) { PROLOG pg8::Gemm g{(const bf16*)WSP(WS_HB), (const bf16*)WSP(WS_WAB), TT, N_AB, 1024, 1024, 1024}; pg8::StaticOrder S; S.init(TT, N_AB, G, bx);
      pg8::EpiBf16 E{(bf16*)WSP(WS_P), N_AB}; pg8::gemm_phase<pg8::EpiBf16, pg8::StaticOrder>(lds, g, S, E, tid); }
    GRID_BAR();
#if DBG_LEVEL >= 2
    if (PH(3)) for (int rep_ = 0; rep_ < REPS(3); ++rep_) { PROLOG mlstm_gate_scan((const float*)WSP(WS_GL), ap->in[I_ABGB], ws, gw, NGW, lane); }
    if (PH(4)) for (int rep_ = 0; rep_ < REPS(4); ++rep_) { PROLOG attn_phase((const bf16*)WSP(WS_P), (bf16*)WSP(WS_HB), ap->in[I_ABSINK], (const float*)WSP(WS_ROPE), lds, (unsigned*)WSP(WS_CTL) + 6144 + 64 * rep_, vcu, G, wave, lane, tid); }
    GRID_BAR();
    if (PH(5)) for (int rep_ = 0; rep_ < REPS(5); ++rep_) { PROLOG mlstm_fused_scan((const bf16*)WSP(WS_P), ws, lds, vcu, G, wave, lane, tid); }
    GRID_BAR();
    if (PH(6)) for (int rep_ = 0; rep_ < REPS(6); ++rep_) { PROLOG mlstm_merge((const bf16*)WSP(WS_P), (bf16*)WSP(WS_HB), ap->in[I_ABNW], ws, gw, NGW, lane); }
    GRID_BAR();
#endif
    if (PH(7)) for (int rep_ = 0; rep_ < REPS(7); ++rep_) { PROLOG pg8::Gemm g{(const bf16*)WSP(WS_HB), (const bf16*)WSP(WS_WABO), TT, 1024, 1024, 1024, 1024}; pg8::StaticOrder S; S.init(TT, 1024, G, bx);
      pg8::EpiBf16 E{(bf16*)WSP(WS_P), 1024}; pg8::gemm_phase<pg8::EpiBf16, pg8::StaticOrder>(lds, g, S, E, tid); }
    GRID_BAR();
    if (PH(8)) for (int rep_ = 0; rep_ < REPS(8); ++rep_) { PROLOG ln_phase(ap->in[I_X], ap->in[I_CTX], ap->out, (float*)WSP(WS_XC), (const bf16*)WSP(WS_P), (const float*)WSP(WS_MOD), ap->in[I_LNW], ap->in[I_LNB], (bf16*)WSP(WS_HB), gw, NGW, lane, DRYV(8), false); }
    GRID_BAR();
#if DBG_LEVEL >= 3
    if (PH(9)) for (int rep_ = 0; rep_ < REPS(9); ++rep_) { PROLOG pg8::Gemm g{(const bf16*)WSP(WS_HB), (const bf16*)WSP(WS_WQ0), TT, 2048, 1024, 1024, 1024}; pg8::StaticOrder S; S.init(TT, 2048, G, bx);
      pg8::EpiBf16 E{(bf16*)WSP(WS_P), 2048}; pg8::gemm_phase<pg8::EpiBf16, pg8::StaticOrder>(lds, g, S, E, tid); }
    GRID_BAR();
    if (PH(10)) for (int rep_ = 0; rep_ < REPS(10); ++rep_) { PROLOG peer_route((const bf16*)WSP(WS_P), (const bf16*)WSP(WS_KEYS), (int*)WSP(WS_ST), (float*)WSP(WS_ST + 17 * MiB), gw, NGW, lane, false); }
    GRID_BAR();
#endif
    if (PH(11)) for (int rep_ = 0; rep_ < REPS(22); ++rep_) { PROLOG peer_pass1((const bf16*)WSP(WS_HB), (const int*)WSP(WS_ST), (const float*)WSP(WS_ST + 17 * MiB), WSP(WS_U), (const float*)WSP(WS_SCL), (const float*)WSP(WS_SCL) + 2 * NEXP, (float*)WSP(WS_ST + 34 * MiB), gw, NGW, lane, false); }
    if (PH(11)) for (int rep_ = 0; rep_ < REPS(11); ++rep_) { PROLOG peer_expert<(DBG_LEVEL >= 3)>((const float*)WSP(WS_ST + 34 * MiB), (const int*)WSP(WS_ST), WSP(WS_V),
        ap->out, (float*)WSP(WS_XC), (const float*)WSP(WS_MOD), ap->in[I_LNW] + 1024, ap->in[I_LNB] + 1024, gw, NGW, lane, DRYV(11), false); }
    GRID_BAR();

    if (PH(12)) for (int rep_ = 0; rep_ < REPS(12); ++rep_) { PROLOG h_phase<32>(ap->out, (const float*)WSP(WS_XC), (const float*)WSP(WS_MOD) + 9 * 6144, (bf16*)WSP(WS_HB), (const float*)WSP(WS_WLOW), (float*)WSP(WS_GL), lds, vcu, G, wave, lane, tid);
 }
    GRID_BAR();
    if (PH(13)) for (int rep_ = 0; rep_ < REPS(13); ++rep_) { PROLOG pg8::Gemm g{(const bf16*)WSP(WS_HB), (const bf16*)WSP(WS_WC), TT, N_C, 1024, 1024, 1024}; pg8::StaticOrder S; S.init(TT, N_C, G, bx);
      pg8::EpiBf16 E{(bf16*)WSP(WS_P), N_C}; pg8::gemm_phase<pg8::EpiBf16, pg8::StaticOrder>(lds, g, S, E, tid); }
    GRID_BAR();
#if DBG_LEVEL >= 2
    if (PH(14)) for (int rep_ = 0; rep_ < REPS(14); ++rep_) { PROLOG gla_prep((bf16*)WSP(WS_P), (bf16*)WSP(WS_HB), (const float*)WSP(WS_GL), ap->in[I_GGUP], ap->in[I_GGB], ws, lds, vcu, G, tid, DRYV(14)); }
    GRID_BAR();
    if (PH(15)) for (int rep_ = 0; rep_ < REPS(15); ++rep_) { PROLOG gla_fused_scan((const bf16*)WSP(WS_P), (const bf16*)WSP(WS_HB), ws, lds, vcu, G, wave, lane, tid, DRYV(15)); }
    GRID_BAR();
    if (PH(16)) for (int rep_ = 0; rep_ < REPS(16); ++rep_) { PROLOG gla_merge((bf16*)WSP(WS_P), ap->in[I_GNW], ws, gw, NGW, lane, DRYV(16)); }
    GRID_BAR();
#endif
    if (PH(17)) for (int rep_ = 0; rep_ < REPS(17); ++rep_) { PROLOG pg8::Gemm g{(const bf16*)WSP(WS_P) + 2048, (const bf16*)WSP(WS_WCO), TT, 1024, 1024, N_C, 1024}; pg8::LatOrder S; S.init(NB * SEQ, 1024, G, bx);
      pg8::EpiBf16 E{(bf16*)WSP(WS_HB), 1024}; pg8::gemm_phase<pg8::EpiBf16, pg8::LatOrder>(lds, g, S, E, tid); }
    GRID_BAR();
    if (PH(18)) for (int rep_ = 0; rep_ < REPS(18); ++rep_) { PROLOG ln_phase(ap->out, (const float*)WSP(WS_XC), ap->out, (float*)WSP(WS_XC), (const bf16*)WSP(WS_HB), (const float*)WSP(WS_MOD) + 9 * 6144, ap->in[I_LNW] + 2048, ap->in[I_LNB] + 2048, (bf16*)WSP(WS_HB), gw, NGW, lane, DRYV(18), true); }
    GRID_BAR();
#if DBG_LEVEL >= 3
    if (PH(19)) for (int rep_ = 0; rep_ < REPS(19); ++rep_) { PROLOG pg8::Gemm g{(const bf16*)WSP(WS_HB), (const bf16*)WSP(WS_WQ1), TT, 2048, 1024, 1024, 1024}; pg8::LatOrder S; S.init(NB * SEQ, 2048, G, bx);
      pg8::EpiBf16 E{(bf16*)WSP(WS_P), 2048}; pg8::gemm_phase<pg8::EpiBf16, pg8::LatOrder>(lds, g, S, E, tid); }
    GRID_BAR();
    if (PH(20)) for (int rep_ = 0; rep_ < REPS(20); ++rep_) { PROLOG peer_route((const bf16*)WSP(WS_P), (const bf16*)WSP(WS_KEYS) + (size_t)8 * 2 * 128 * 128, (int*)WSP(WS_ST), (float*)WSP(WS_ST + 17 * MiB), gw, NGW, lane, true); }
    GRID_BAR();
#endif
    if (PH(21)) for (int rep_ = 0; rep_ < REPS(22); ++rep_) { PROLOG peer_pass1((const bf16*)WSP(WS_HB), (const int*)WSP(WS_ST), (const float*)WSP(WS_ST + 17 * MiB), WSP(WS_U) + (size_t)NEXP * 768, (const float*)WSP(WS_SCL) + NEXP, (const float*)WSP(WS_SCL) + 3 * NEXP, (float*)WSP(WS_ST + 34 * MiB), gw, NGW, lane, true); }
    if (PH(21)) for (int rep_ = 0; rep_ < REPS(21); ++rep_) { PROLOG peer_expert<(DBG_LEVEL >= 3)>((const float*)WSP(WS_ST + 34 * MiB), (const int*)WSP(WS_ST), WSP(WS_V) + (size_t)NEXP * 768,
        ap->out, (float*)WSP(WS_XC), (const float*)WSP(WS_MOD) + 9 * 6144, ap->in[I_LNW] + 3072, ap->in[I_LNB] + 3072, gw, NGW, lane, DRYV(21), true); }
}

extern "C" void kernel_launch(void* const* d_in, const int* in_sizes, int n_in, void* d_out, int out_size, void* d_ws, size_t ws_size, hipStream_t stream) {
    static int grid = 0;
    if (grid == 0) {
        if (n_in != 22 || out_size != NB * SEQ * D || ws_size < 512 * MiB) { fprintf(stderr, "kernel_launch: unexpected shapes: n_in %d out %d ws %zu (need %zu)\n", n_in, out_size, ws_size, (size_t)WS_END); grid = -1; return; }
        int dev = 0, cus = 0, per_cu = 0;
        if (hipGetDevice(&dev) != hipSuccess || hipDeviceGetAttribute(&cus, hipDeviceAttributeMultiprocessorCount, dev) != hipSuccess) { grid = -1; return; }
        if (hipFuncSetAttribute((const void*)fwd_megakernel, hipFuncAttributeMaxDynamicSharedMemorySize, LDS_BYTES) != hipSuccess) { fprintf(stderr, "kernel_launch: hipFuncSetAttribute failed\n"); grid = -1; return; }
        if (hipOccupancyMaxActiveBlocksPerMultiprocessor(&per_cu, (const void*)fwd_megakernel, 512, LDS_BYTES) != hipSuccess || per_cu < 1) { fprintf(stderr, "kernel_launch: occupancy query says %d blocks per CU\n", per_cu); }
        (void)hipGetLastError();
        grid = cus;
        fprintf(stderr, "kernel_launch: grid %d, per_cu %d, ws %zu\n", grid, per_cu, ws_size);
    }
    if (grid < 0) return;
    if (hipMemsetAsync((char*)d_ws + WS_CTL, 0, CTL_ZERO_BYTES, stream) != hipSuccess) return;
    Args a{};
    for (int i = 0; i < 22; ++i) a.in[i] = (const float*)d_in[i];
    a.out = (float*)d_out; a.ws = (unsigned char*)d_ws;
    hipLaunchKernelGGL(fwd_megakernel, dim3(grid), dim3(512), LDS_BYTES, stream, a);
}
```

```cpp
#include <hip/hip_runtime.h>
#include <cstdio>
#include <cstdint>

#define GAS __attribute__((address_space(1)))
#define LAS __attribute__((address_space(3)))
typedef unsigned short bf16;
typedef unsigned v4u __attribute__((ext_vector_type(4)));
typedef unsigned v2u __attribute__((ext_vector_type(2)));
typedef float f32x4 __attribute__((ext_vector_type(4)));
typedef float f32x2 __attribute__((ext_vector_type(2)));
typedef short bf16x8 __attribute__((ext_vector_type(8)));
typedef short s16x4 __attribute__((ext_vector_type(4)));
typedef GAS unsigned gu32;
#define RLX_AGENT __ATOMIC_RELAXED, __HIP_MEMORY_SCOPE_AGENT

constexpr int NB = 8, SEQ = 4096, LC = 256, D = 1024;
constexpr int PB = LC + SEQ;
constexpr int TT = NB * PB;
constexpr int NCH = PB / 64;
constexpr int N_AB = 2816;
constexpr int N_C = 3072;
constexpr float LN_EPS = 1e-5f;
constexpr float DN_ALPHA = 1.41421356237f;
constexpr int NEXP = 16384;
__device__ __forceinline__ int map_row(int i, bool lat_only) { return lat_only ? (i >> 12) * 4352 + 256 + (i & 4095) : i; }

constexpr size_t MiB = 1u << 20;
constexpr size_t WS_CTL = 0, CTL_ZERO_BYTES = 64 * 1024;
constexpr size_t WS_MOD = 1 * MiB;
constexpr size_t WS_ROPE = 2 * MiB;
constexpr size_t WS_WG = 2 * MiB + 64 * 1024;
constexpr size_t WS_WLOW = 2 * MiB + 128 * 1024;
constexpr size_t WS_SCL = 3 * MiB;
constexpr size_t WS_BQ = 4 * MiB, WS_CQ = WS_BQ + 1200 * 1024, WS_EM = WS_CQ + 1200 * 1024, WS_AI = WS_EM + 1200 * 1024;
constexpr size_t WS_AST = WS_AI + 1200 * 1024, WS_CL = WS_AST + 32 * 1024;
constexpr size_t WS_ET = 10 * MiB;
constexpr size_t WS_GL = 13 * MiB;
constexpr size_t WS_WAB = 20 * MiB, WS_WABO = 26 * MiB, WS_WC = 28 * MiB, WS_WCO = 34 * MiB, WS_WQ0 = 36 * MiB, WS_WQ1 = 40 * MiB, WS_KEYS = 44 * MiB;
constexpr size_t WS_NST = 45 * MiB;
constexpr size_t WS_XC = 48 * MiB;
constexpr size_t WS_U = 56 * MiB, WS_V = 88 * MiB;
constexpr size_t WS_HB = 120 * MiB;
constexpr size_t WS_P = 188 * MiB;
constexpr size_t WS_ST = 392 * MiB;
constexpr size_t WS_END = 460 * MiB;

constexpr int LDS_BYTES = 163840;
constexpr int MISC_OFF = LDS_BYTES - 64;

__device__ __forceinline__ unsigned f2bf(float f) { unsigned u = __builtin_bit_cast(unsigned, f); return (u + 0x7fffu + ((u >> 16) & 1u)) >> 16; }
__device__ __forceinline__ unsigned pk2(float lo, float hi) { return f2bf(lo) | (f2bf(hi) << 16); }
__device__ __forceinline__ float bflo(unsigned w) { return __builtin_bit_cast(float, w << 16); }
__device__ __forceinline__ float bfhi(unsigned w) { return __builtin_bit_cast(float, w & 0xffff0000u); }
__device__ __forceinline__ float bf2f(bf16 b) { return __builtin_bit_cast(float, (unsigned)b << 16); }
template <int CTRL> __device__ __forceinline__ float dppmov_f(float x) { return __builtin_bit_cast(float, __builtin_amdgcn_mov_dpp(__builtin_bit_cast(int, x), CTRL, 0xf, 0xf, true)); }
__device__ __forceinline__ float wave_sum(float v) {
    v += dppmov_f<0xB1>(v); v += dppmov_f<0x4E>(v); v += dppmov_f<0x141>(v); v += dppmov_f<0x128>(v);
    v += __shfl_xor(v, 16); v += __shfl_xor(v, 32);
    return v;
}
__device__ __forceinline__ float sigmoidf_(float x) { return 1.f / (1.f + __expf(-x)); }
__device__ __forceinline__ float logsigmoidf_(float x) { return fminf(x, 0.f) - log1pf(__expf(-fabsf(x))); }
__device__ __forceinline__ float siluf_(float x) { return x / (1.f + __expf(-x)); }

namespace pg8 {
#define PG8_LAS __attribute__((address_space(3)))
typedef unsigned short bf16_t;
typedef short bf16x8 __attribute__((ext_vector_type(8)));
typedef float f32x4 __attribute__((ext_vector_type(4)));
typedef unsigned u32x4 __attribute__((ext_vector_type(4)));
constexpr int BM = 256, BK = 64, HALF = 128, HTB = HALF * BK * 2  , STAGE_BYTES = 8 * HTB, NXCD = 8, WGM = 8;

__host__ __device__ __forceinline__ int lds_byte(int r, int c) { const int st = (r >> 4) * 2 + (c >> 5), rr = r & 15, cc = c & 31, ob = rr * 64 + cc * 2; return st * 1024 + (ob ^ (((ob >> 9) & 1) << 5)); }
__host__ __device__ __forceinline__ void stage_rc(int b, int& R, int& C) { const int st = b / 1024, sb = b % 1024, swz = sb ^ (((sb >> 9) & 1) << 5); R = (st >> 1) * 16 + swz / 64; C = (st & 1) * 32 + (swz % 64) / 2; }
__host__ __device__ __forceinline__ int perm32(int rho) { const int n = rho >> 4, i = rho & 15; return 8 * (i >> 2) + 4 * n + (i & 3); }

struct Unit { int pm, pn; };
struct Gemm { const bf16_t* A; const bf16_t* Bt; int M, N, K, lda, ldb; };

struct StaticOrder {
    int nM, nN, nwg, G, c;
    __host__ __device__ void init(int M, int N, int G_, int c_) { nM = M / BM; nN = N / BM; nwg = nM * nN; G = G_; c = c_; }
    __host__ __device__ bool next(int i, Unit& u) const {
        const long L = (long)i * G + c; if (L >= nwg) return false;
        int wgid = (int)L; { const int q = nwg / NXCD, r = nwg % NXCD, xcd = wgid % NXCD, off = wgid / NXCD; wgid = (xcd < r ? xcd * (q + 1) : r * (q + 1) + (xcd - r) * q) + off; }
        const int nig = WGM * nN, gid = wgid / nig, fm = gid * WGM, gsz = (nM - fm) < WGM ? (nM - fm) : WGM;
        u.pm = fm + ((wgid % nig) % gsz); u.pn = (wgid % nig) / gsz; return true;
    }
    __device__ __forceinline__ void a_ready(const Unit&) const {}
    __device__ __forceinline__ void done(const Unit&) const {}
};

struct LatOrder : StaticOrder {
    __host__ __device__ bool next(int i, Unit& u) const { if (!StaticOrder::next(i, u)) return false; u.pm = (u.pm >> 4) * 17 + 1 + (u.pm & 15); return true; }
};
__device__ __forceinline__ unsigned cvt_pk_bf16(float lo, float hi) { unsigned r; asm volatile("v_cvt_pk_bf16_f32 %0, %1, %2" : "=v"(r) : "v"(lo), "v"(hi)); return r; }
struct EpiBf16 {
    static constexpr bool PERM = true, AFTER_DRAIN = false;
    bf16_t* O; int ldc;
    __device__ __forceinline__ void operator()(const f32x4 (&acc)[2][2][4][2], const Unit& u, int wr, int wc, int fr, int fq) const {
        const int row0 = u.pm * BM + wr * 64 + fr; const int col0 = u.pn * BM + wc * 32 + 8 * fq;
#pragma unroll
        for (int ai = 0; ai < 2; ++ai)
#pragma unroll
            for (int m = 0; m < 4; ++m) { bf16_t* rowp = O + (size_t)(row0 + ai * HALF + m * 16) * ldc + col0;
#pragma unroll
                for (int bj = 0; bj < 2; ++bj) { const f32x4 v0 = acc[ai][bj][m][0], v1 = acc[ai][bj][m][1];
                    u32x4 w; w.x = cvt_pk_bf16(v0[0], v0[1]); w.y = cvt_pk_bf16(v0[2], v0[3]); w.z = cvt_pk_bf16(v1[0], v1[1]); w.w = cvt_pk_bf16(v1[2], v1[3]);
                    *(u32x4*)(rowp + bj * HALF) = w; } }
    }
};
struct EpiResid {
    static constexpr bool PERM = false, AFTER_DRAIN = false;
    const float* src_lat; const float* src_ctx; float* dst_lat; float* dst_ctx; const float* gate; float gscale; int dry;
    __device__ __forceinline__ void operator()(const f32x4 (&acc)[2][2][4][2], const Unit& u, int wr, int wc, int fr, int fq) const {
        const int b = u.pm / 17, tb = u.pm - b * 17;
        const float* sbase; float* dbase; const float* gr;
        if (tb == 0) { sbase = src_ctx + (size_t)b * 256 * 1024; dbase = dst_ctx + (size_t)b * 256 * 1024; gr = gate + 8 * 6144; }
        else { sbase = src_lat + ((size_t)b * 4096 + (size_t)(tb - 1) * 256) * 1024; dbase = dst_lat + ((size_t)b * 4096 + (size_t)(tb - 1) * 256) * 1024; gr = gate + b * 6144; }
        const int row0 = wr * 64 + fr, col0 = u.pn * BM + wc * 32 + 4 * fq;
        f32x4 gv[2][2];
#pragma unroll
        for (int bj = 0; bj < 2; ++bj)
#pragma unroll
            for (int n = 0; n < 2; ++n) gv[bj][n] = *(const f32x4*)(gr + col0 + bj * HALF + n * 16) * gscale;
#pragma unroll
        for (int ai = 0; ai < 2; ++ai)
#pragma unroll
            for (int mp = 0; mp < 2; ++mp) {
                f32x4 sv[2][2][2];
#pragma unroll
                for (int mm = 0; mm < 2; ++mm) { const size_t off = (size_t)(row0 + ai * HALF + (2 * mp + mm) * 16) * 1024 + col0;
#pragma unroll
                    for (int bj = 0; bj < 2; ++bj)
#pragma unroll
                        for (int n = 0; n < 2; ++n) sv[mm][bj][n] = __builtin_nontemporal_load((const f32x4*)(sbase + off + bj * HALF + n * 16)); }
                asm volatile("" ::: "memory");
#pragma unroll
                for (int mm = 0; mm < 2; ++mm) { const int m = 2 * mp + mm; const size_t off = (size_t)(row0 + ai * HALF + m * 16) * 1024 + col0;
#pragma unroll
                    for (int bj = 0; bj < 2; ++bj)
#pragma unroll
                        for (int n = 0; n < 2; ++n) { const f32x4 ov = sv[mm][bj][n] * 1.41421356237f + gv[bj][n] * acc[ai][bj][m][n]; if (!dry) *(f32x4*)(dbase + off + bj * HALF + n * 16) = ov; } }
                asm volatile("" ::: "memory");
            }
    }
};

template <class Epi, class Sched>
__device__ __forceinline__ void gemm_phase(PG8_LAS unsigned char* lds, const Gemm g, const Sched& S, const Epi& E, const int tid_in) {
    const int tid = tid_in, wid = __builtin_amdgcn_readfirstlane(tid >> 6), lane = tid & 63, wr = wid >> 2, wc = wid & 3, fr = lane & 15, fq = lane >> 4;
    const int K = g.K, nt = K / BK;
    unsigned voffA[2], voffB[2];
#pragma unroll
    for (int i = 0; i < 2; ++i) { int R, C; stage_rc(tid * 16 + i * 8192, R, C); const int Rb = Epi::PERM ? ((R & ~31) + perm32(R & 31)) : R;
        voffA[i] = (unsigned)(R * g.lda + C) * 2u; voffB[i] = (unsigned)(Rb * g.ldb + C) * 2u; }
    const size_t kstep = (size_t)(BK * 2);
    const size_t hstepA = (size_t)HALF * g.lda * 2, hstepB = (size_t)HALF * g.ldb * 2;
    const size_t tstepA = 2 * hstepA, tstepB = 2 * hstepB;
    const unsigned ldsw = (unsigned)wid * 1024u;
    const int aoff = lds_byte(wr * 64 + fr, fq * 8), boff = lds_byte(wc * 32 + fr, fq * 8);
#define PG8_SA(b, h) (((b) * 2 + (h)) * HTB)
#define PG8_SB(b, h) ((4 + (b) * 2 + (h)) * HTB)
#define PG8_STAGE(bufoff, gbase, voff) do { _Pragma("unroll") for (int _i = 0; _i < 2; ++_i) \
        __builtin_amdgcn_global_load_lds((const unsigned*)((const char*)(gbase) + (voff)[_i]), (PG8_LAS unsigned*)(lds + (bufoff) + ldsw + _i * 8192), 16, 0, 0); } while (0)
#define PG8_LDA(dst, b, h) do { _Pragma("unroll") for (int m = 0; m < 4; ++m) _Pragma("unroll") for (int k = 0; k < 2; ++k) dst[m][k] = *(const PG8_LAS bf16x8*)(lds + PG8_SA(b, h) + aoff + m * 2048 + k * 1024); } while (0)
#define PG8_LDB(dst, b, h) do { _Pragma("unroll") for (int n = 0; n < 2; ++n) _Pragma("unroll") for (int k = 0; k < 2; ++k) dst[n][k] = *(const PG8_LAS bf16x8*)(lds + PG8_SB(b, h) + boff + n * 2048 + k * 1024); } while (0)
#define PG8_MMA(ai, bj, At, Bt) do { __builtin_amdgcn_s_setprio(1); _Pragma("unroll") for (int m = 0; m < 4; ++m) _Pragma("unroll") for (int n = 0; n < 2; ++n) _Pragma("unroll") for (int k = 0; k < 2; ++k) \
        acc[ai][bj][m][n] = __builtin_amdgcn_mfma_f32_16x16x32_bf16(Bt[n][k], At[m][k], acc[ai][bj][m][n], 0, 0, 0); __builtin_amdgcn_s_setprio(0); } while (0)
#define PG8_WAIT_V(n) asm volatile("s_waitcnt vmcnt(" #n ")" ::: "memory")
#define PG8_WAIT_L(n) asm volatile("s_waitcnt lgkmcnt(" #n ")" ::: "memory")
#define PG8_BAR __builtin_amdgcn_s_barrier()
#define PG8_SCHED __builtin_amdgcn_sched_barrier(0)
    Unit cur, nxt; int ui = 0;
    if (!S.next(0, cur)) return;
    f32x4 acc[2][2][4][2];
#pragma unroll
    for (int a = 0; a < 2; ++a)
#pragma unroll
        for (int b = 0; b < 2; ++b)
#pragma unroll
            for (int m = 0; m < 4; ++m)
#pragma unroll
                for (int n = 0; n < 2; ++n) acc[a][b][m][n] = (f32x4){0.f, 0.f, 0.f, 0.f};
    bf16x8 At[4][2], B0[2][2], B1[2][2];
    const char* cA = (const char*)g.A + (size_t)cur.pm * tstepA; const char* cB = (const char*)g.Bt + (size_t)cur.pn * tstepB;
    S.a_ready(cur);
    PG8_STAGE(PG8_SB(0, 0), cB, voffB); PG8_STAGE(PG8_SA(0, 0), cA, voffA); PG8_STAGE(PG8_SB(0, 1), cB + hstepB, voffB); PG8_STAGE(PG8_SA(0, 1), cA + hstepA, voffA);
    if (wr == 1) PG8_BAR;
    PG8_WAIT_V(4); PG8_BAR;
    PG8_STAGE(PG8_SB(1, 0), cB + kstep, voffB); PG8_STAGE(PG8_SA(1, 0), cA + kstep, voffA); PG8_STAGE(PG8_SB(1, 1), cB + hstepB + kstep, voffB);
    PG8_WAIT_V(6); PG8_BAR;
    for (;;) {
        const bool has_next = S.next(ui + 1, nxt);
        const char* nA = has_next ? (const char*)g.A + (size_t)nxt.pm * tstepA : cA; const char* nB = has_next ? (const char*)g.Bt + (size_t)nxt.pn * tstepB : cB;
        for (int t = 0; t < nt; t += 2) {
            const bool last = (t == nt - 2);
            const char* a1 = cA + (size_t)(t + 1) * kstep;
            const char* a2 = last ? nA : cA + (size_t)(t + 2) * kstep; const char* b2 = last ? nB : cB + (size_t)(t + 2) * kstep;
            const char* a3 = a2 + kstep; const char* b3 = b2 + kstep;
            if (last && has_next) S.a_ready(nxt);
            PG8_LDB(B0, 0, 0); PG8_SCHED; PG8_LDA(At, 0, 0); PG8_STAGE(PG8_SA(1, 1), a1 + hstepA, voffA);
            PG8_WAIT_L(8); PG8_BAR; PG8_WAIT_L(0); PG8_MMA(0, 0, At, B0); PG8_BAR; PG8_SCHED;
            PG8_LDB(B1, 0, 1); PG8_STAGE(PG8_SB(0, 0), b2, voffB);
            PG8_BAR; PG8_WAIT_L(0); PG8_MMA(0, 1, At, B1); PG8_BAR;
            PG8_LDA(At, 0, 1); PG8_STAGE(PG8_SA(0, 0), a2, voffA);
            PG8_BAR; PG8_WAIT_L(0); PG8_MMA(1, 0, At, B0); PG8_BAR; PG8_SCHED;
            PG8_STAGE(PG8_SB(0, 1), b2 + hstepB, voffB);
            PG8_WAIT_V(6); PG8_BAR; PG8_MMA(1, 1, At, B1); PG8_BAR;
            PG8_LDB(B0, 1, 0); PG8_SCHED; PG8_LDA(At, 1, 0); PG8_STAGE(PG8_SA(0, 1), a2 + hstepA, voffA);
            PG8_WAIT_L(8); PG8_BAR; PG8_WAIT_L(0); PG8_MMA(0, 0, At, B0); PG8_BAR; PG8_SCHED;
            PG8_LDB(B1, 1, 1); PG8_STAGE(PG8_SB(1, 0), b3, voffB);
            PG8_BAR; PG8_WAIT_L(0); PG8_MMA(0, 1, At, B1); PG8_BAR;
            PG8_LDA(At, 1, 1); PG8_STAGE(PG8_SA(1, 0), a3, voffA);
            PG8_BAR; PG8_WAIT_L(0); PG8_MMA(1, 0, At, B0); PG8_BAR; PG8_SCHED;
            PG8_STAGE(PG8_SB(1, 1), b3 + hstepB, voffB);
            PG8_WAIT_V(6); PG8_BAR; PG8_MMA(1, 1, At, B1); PG8_BAR;
        }
        if constexpr (!Epi::AFTER_DRAIN) { E(acc, cur, wr, wc, fr, fq); S.done(cur); }
        if (!has_next) break;
#pragma unroll
        for (int a = 0; a < 2; ++a)
#pragma unroll
            for (int b = 0; b < 2; ++b)
#pragma unroll
                for (int m = 0; m < 4; ++m)
#pragma unroll
                    for (int n = 0; n < 2; ++n) acc[a][b][m][n] = (f32x4){0.f, 0.f, 0.f, 0.f};
        cur = nxt; cA = nA; cB = nB; ++ui;
    }
    PG8_WAIT_V(0);
    if (wr == 0) PG8_BAR;
    PG8_BAR;
    if constexpr (Epi::AFTER_DRAIN) { E.fused(acc, cur, wr, wc, fr, fq, lds, wid, lane); S.done(cur); }
#undef PG8_SA
#undef PG8_SB
#undef PG8_STAGE
#undef PG8_LDA
#undef PG8_LDB
#undef PG8_MMA
#undef PG8_WAIT_V
#undef PG8_WAIT_L
#undef PG8_BAR
#undef PG8_SCHED
}
}

#define XB_TMO      128
#define XB_XCNT(j)  (256  + 64 * (j))
#define XB_XSUB(j)  (1280 + 64 * (j))
#define XB_XGEN(j)  (2304 + 64 * (j))
#define XB_TOP      3328
#define XB_TOPGEN   3392
#define XCD_BAR_WORDS 3456
#define XB_SPIN_CAP (1u << 18)

__device__ __forceinline__ unsigned xb_ld(unsigned* p)              { return __hip_atomic_load(p, __ATOMIC_RELAXED, __HIP_MEMORY_SCOPE_AGENT); }
__device__ __forceinline__ unsigned xb_add(unsigned* p, unsigned v) { return __hip_atomic_fetch_add(p, v, __ATOMIC_RELAXED, __HIP_MEMORY_SCOPE_AGENT); }
__device__ __forceinline__ unsigned xb_xcc_id() { return (unsigned)__builtin_amdgcn_s_getreg((3 << 11) | 20) & 0xFu; }
#define XB_SPIN(cond, bar) do { unsigned _sp = 0; while (cond) { __builtin_amdgcn_s_sleep(1); \
    if ((++_sp & 255u) == 0u) { if (xb_ld(&(bar)[XB_TMO])) break; if (_sp > XB_SPIN_CAP) { atomicAdd(&(bar)[XB_TMO], 1u); break; } } } } while (0)

struct XcdBarrier {
    unsigned* bar; unsigned x;
    volatile LAS unsigned* st;
};

__device__ __forceinline__ XcdBarrier xcd_barrier_post(unsigned* bar, volatile LAS unsigned* st) {
    XcdBarrier b; b.bar = bar; b.x = xb_xcc_id(); b.st = st;
    if (threadIdx.x == 0) (void)xb_add(&bar[XB_XCNT(b.x)], 1u);
    return b;
}
__device__ __forceinline__ void xcd_barrier_complete(unsigned* bar, unsigned x, unsigned& nloc, unsigned& nx) {
    const unsigned G = gridDim.x * gridDim.y * gridDim.z;
    unsigned sum, cnt, mine, sp = 0u;
    for (;;) {
        sum = 0u; cnt = 0u; mine = 0u;
#pragma unroll
        for (unsigned j = 0; j < 16; ++j) { const unsigned c = xb_ld(&bar[XB_XCNT(j)]); sum += c; cnt += (c > 0u) ? 1u : 0u; mine = (j == x) ? c : mine; }
        if (sum == G) break;
        __builtin_amdgcn_s_sleep(1);
        if ((++sp & 255u) == 0u) { if (xb_ld(&bar[XB_TMO])) break; if (sp > XB_SPIN_CAP) { atomicAdd(&bar[XB_TMO], 1u); break; } }
    }
    nloc = mine > 0u ? mine : 1u; nx = cnt > 0u ? cnt : 1u;
}

__device__ __forceinline__ void xcd_barrier(const XcdBarrier& b) {
    asm volatile("s_waitcnt vmcnt(0)" ::: "memory");
    __syncthreads();
    if (threadIdx.x == 0) {
        unsigned* bar = b.bar;
        __builtin_amdgcn_s_waitcnt(0);
        unsigned nloc = b.st[0], nx = b.st[1];
        if (nloc == 0u) { xcd_barrier_complete(bar, b.x, nloc, nx); b.st[0] = nloc; b.st[1] = nx; }
        const unsigned old = xb_add(&bar[XB_XSUB(b.x)], 1u);
        const unsigned gen = old / nloc;
        if (old + 1u == (gen + 1u) * nloc) {
            __builtin_amdgcn_fence(__ATOMIC_RELEASE, "agent");
            asm volatile("s_waitcnt vmcnt(0)" ::: "memory");
            const unsigned og = xb_add(&bar[XB_TOP], 1u);
            const unsigned tg = og / nx;
            if (og + 1u == (tg + 1u) * nx) xb_add(&bar[XB_TOPGEN], 1u);
            else XB_SPIN(xb_ld(&bar[XB_TOPGEN]) == tg, bar);
            __builtin_amdgcn_fence(__ATOMIC_ACQUIRE, "agent");
            xb_add(&bar[XB_XGEN(b.x)], 1u);
            asm volatile("s_waitcnt vmcnt(0)" ::: "memory");
        } else {
            XB_SPIN(xb_ld(&bar[XB_XGEN(b.x)]) == gen, bar);
            __builtin_amdgcn_fence(__ATOMIC_ACQUIRE, "agent");
            asm volatile("s_waitcnt vmcnt(0)" ::: "memory");
        }
    }
    __syncthreads();
}


__device__ __forceinline__ f32x4 mma(bf16x8 a, bf16x8 b, f32x4 c) { return __builtin_amdgcn_mfma_f32_16x16x32_bf16(a, b, c, 0, 0, 0); }
__device__ __forceinline__ bf16x8 frag_row(const LAS bf16* t, int ld, int r0, int c0, int lane) {
    return *(const LAS bf16x8*)(t + (r0 + (lane & 15)) * ld + c0 + 8 * (lane >> 4));
}
__device__ __forceinline__ bf16x8 frag_tr(const LAS bf16* t, int ld, int r0, int c0, int lane) {
    const int g = lane >> 4, q = (lane & 15) >> 2, p = lane & 3;
    const LAS bf16* a = t + (r0 + 8 * g + q) * ld + c0 + 4 * p;
    const s16x4 lo = __builtin_amdgcn_ds_read_tr16_b64_v4i16((LAS s16x4*)a);
    const s16x4 hi = __builtin_amdgcn_ds_read_tr16_b64_v4i16((LAS s16x4*)(a + 4 * ld));
    return (bf16x8){lo[0], lo[1], lo[2], lo[3], hi[0], hi[1], hi[2], hi[3]};
}
#define LDS_FENCE() do { asm volatile("s_waitcnt lgkmcnt(0)" ::: "memory"); __builtin_amdgcn_wave_barrier(); } while (0)

struct Args {
    const float* in[22]; float* out; unsigned char* ws;
};
enum { I_X = 0, I_C, I_CTX, I_CCTX, I_WMOD, I_BMOD, I_LNW, I_LNB, I_ABWIN, I_ABGB, I_ABNW, I_ABSINK, I_ABWOUT, I_GWIN, I_GGUP, I_GGB, I_GNW, I_GWOUT, I_PWQ, I_PKEYS, I_PU, I_PV };

__device__ __forceinline__ const float* srow_c(const float* lat, const float* ctx, int r) { const int b = r / PB, p = r - b * PB; return p < LC ? ctx + (size_t)(b * LC + p) * D : lat + (size_t)(b * SEQ + p - LC) * D; }
__device__ __forceinline__ float* srow(float* lat, float* ctx, int r) { const int b = r / PB, p = r - b * PB; return p < LC ? ctx + (size_t)(b * LC + p) * D : lat + (size_t)(b * SEQ + p - LC) * D; }

__device__ __forceinline__ void p0_transpose_item(const float* W, int K, int ldw, int c0, int ncols, bf16* WT, int row_off, LAS float* scr, int item, int lane,
                                                  int s0lo, int s0hi, float s0, int s1lo, int s1hi, float s1) {
    const int nblk = ncols / 32, kb = item / nblk, nb = item % nblk, k0 = 64 * kb, n0 = 32 * nb;
#pragma unroll 8
    for (int i = 0; i < 32; ++i) { const int kk = 2 * i + (lane >> 5); scr[kk * 33 + (lane & 31)] = W[(size_t)(k0 + kk) * ldw + c0 + n0 + (lane & 31)]; }
    asm volatile("s_waitcnt lgkmcnt(0)" ::: "memory");
    const int c = lane & 7;
#pragma unroll
    for (int j = 0; j < 4; ++j) { const int n = (lane >> 3) + 8 * j; const LAS float* s = scr + (8 * c) * 33 + n;
        const int dr = row_off + n0 + n; float sc = 1.f; if (dr >= s0lo && dr < s0hi) sc = s0; if (dr >= s1lo && dr < s1hi) sc = s1;
        v4u o; o.x = pk2(s[0 * 33] * sc, s[1 * 33] * sc); o.y = pk2(s[2 * 33] * sc, s[3 * 33] * sc); o.z = pk2(s[4 * 33] * sc, s[5 * 33] * sc); o.w = pk2(s[6 * 33] * sc, s[7 * 33] * sc);
        *(v4u*)(WT + (size_t)dr * K + k0 + 8 * c) = o; }
    asm volatile("s_waitcnt lgkmcnt(0)" ::: "memory");
}
__device__ __forceinline__ void cvt_f32_bf16(const float* src, bf16* dst, size_t n, int gtid, int gthreads) {
    const size_t nch = n / 8;
    for (size_t i = gtid; i < nch; i += gthreads) { const f32x4 a = *(const f32x4*)(src + i * 8), b = *(const f32x4*)(src + i * 8 + 4);
        v4u o; o.x = pk2(a[0], a[1]); o.y = pk2(a[2], a[3]); o.z = pk2(b[0], b[1]); o.w = pk2(b[2], b[3]); *(v4u*)(dst + i * 8) = o; }
}
typedef float v16f __attribute__((ext_vector_type(16)));
typedef float v32f __attribute__((ext_vector_type(32)));
typedef unsigned v6u __attribute__((ext_vector_type(6)));
typedef unsigned v3u __attribute__((ext_vector_type(3)));
__device__ __forceinline__ void cvt_rows_fp6(const float* src, unsigned char* dst, float* inv, int nrows, int gw, int NGW, int lane) {
    const int hl = lane & 31, hh = lane >> 5;
    for (int r2 = gw; r2 < nrows / 2; r2 += NGW) {
        const int r = 2 * r2 + hh; const float* sp = src + (size_t)r * 1024 + 32 * hl;
        f32x4 x[8]; float m = 0.f;
#pragma unroll
        for (int q = 0; q < 8; ++q) { x[q] = *(const f32x4*)(sp + 4 * q); m = fmaxf(m, fmaxf(fmaxf(fabsf(x[q][0]), fabsf(x[q][1])), fmaxf(fabsf(x[q][2]), fabsf(x[q][3])))); }
        m = fmaxf(m, dppmov_f<0xB1>(m)); m = fmaxf(m, dppmov_f<0x4E>(m)); m = fmaxf(m, dppmov_f<0x141>(m)); m = fmaxf(m, dppmov_f<0x128>(m)); m = fmaxf(m, __shfl_xor(m, 16));
        const float sc = m > 0.f ? 7.0f / m : 1.f;
        v16f a, b;
#pragma unroll
        for (int q = 0; q < 8; ++q) { a[2 * q] = x[q][0] * sc; b[2 * q] = x[q][1] * sc; a[2 * q + 1] = x[q][2] * sc; b[2 * q + 1] = x[q][3] * sc; }
        const v6u p = __builtin_amdgcn_cvt_scalef32_2xpk16_fp6_f32(a, b, 1.0f);
        unsigned char* dp = dst + (size_t)r * 768 + 24 * hl;
        *(v2u*)dp = (v2u){p[0], p[1]}; *(v2u*)(dp + 8) = (v2u){p[2], p[3]}; *(v2u*)(dp + 16) = (v2u){p[4], p[5]};
        if (hl == 0) inv[r] = m > 0.f ? m / 7.0f : 1.f;
    }
}
__device__ __forceinline__ void p0_prologue(const Args& A, LAS unsigned char* lds, int vcu, int G, int wave, int lane, int tid) {
    unsigned char* ws = A.ws;
    const int gw = vcu * 8 + wave, NGW = G * 8, gtid = vcu * 512 + tid, gthreads = G * 512;
    LAS float* sil = (LAS float*)lds;
    for (int i = tid; i < 9 * 1024; i += 512) { const float v = i < 8192 ? A.in[I_C][i] : A.in[I_CCTX][i - 8192]; sil[i] = siluf_(v); }
    __syncthreads();
    float* MOD = (float*)(ws + WS_MOD);
    LAS float* part = (LAS float*)(lds + 40960);
    for (int it = vcu; it < 2 * 96; it += G) {
        const int l = it / 96, n = (it % 96) * 64 + lane; const float* wm = A.in[I_WMOD] + (size_t)l * 1024 * 6144 + (size_t)(128 * wave) * 6144 + n;
        float acc[9];
#pragma unroll
        for (int r = 0; r < 9; ++r) acc[r] = 0.f;
#pragma unroll 8
        for (int k = 0; k < 128; ++k) { const float w = wm[(size_t)k * 6144];
#pragma unroll
            for (int r = 0; r < 9; ++r) acc[r] += sil[r * 1024 + 128 * wave + k] * w; }
        __syncthreads();
#pragma unroll
        for (int r = 0; r < 9; ++r) part[(wave * 9 + r) * 64 + lane] = acc[r];
        __syncthreads();
        for (int i = tid; i < 9 * 64; i += 512) { float sum = 0.f;
#pragma unroll
            for (int w8 = 0; w8 < 8; ++w8) sum += part[w8 * 576 + i];
            const int r = i >> 6, c = (it % 96) * 64 + (i & 63); MOD[(size_t)(l * 9 + r) * 6144 + c] = sum + A.in[I_BMOD][l * 6144 + c]; }
    }
    __syncthreads();
    LAS float* scr = (LAS float*)(lds + 40960 + wave * 8704);
    constexpr int I_AB1 = 16 * 64, I_AB2 = 16 * 24, I_ABO = 16 * 32, I_C1 = 16 * 96, I_CO = 16 * 32, I_Q = 16 * 64;
    constexpr int NITEMS = I_AB1 + I_AB2 + I_ABO + I_C1 + I_CO + 2 * I_Q;
    const float rs128 = 0.08838834764831845f;
    for (int it = gw; it < NITEMS; it += NGW) {
        int r = it;
        if (r < I_AB1) { p0_transpose_item(A.in[I_ABWIN], 1024, 2832, 0, 2048, (bf16*)(ws + WS_WAB), 0, scr, r, lane, 512, 1024, rs128, 0, 0, 1.f); continue; } r -= I_AB1;
        if (r < I_AB2) { p0_transpose_item(A.in[I_ABWIN], 1024, 2832, 2064, 768, (bf16*)(ws + WS_WAB), 2048, scr, r, lane, 2048, 2560, 0.125f, 0, 0, 1.f); continue; } r -= I_AB2;
        if (r < I_ABO) { p0_transpose_item(A.in[I_ABWOUT], 1024, 1024, 0, 1024, (bf16*)(ws + WS_WABO), 0, scr, r, lane, 0, 0, 1.f, 0, 0, 1.f); continue; } r -= I_ABO;
        if (r < I_C1) { p0_transpose_item(A.in[I_GWIN], 1024, 3104, 0, 3072, (bf16*)(ws + WS_WC), 0, scr, r, lane, 0, 512, rs128, 0, 0, 1.f); continue; } r -= I_C1;
        if (r < I_CO) { p0_transpose_item(A.in[I_GWOUT], 1024, 1024, 0, 1024, (bf16*)(ws + WS_WCO), 0, scr, r, lane, 0, 0, 1.f, 0, 0, 1.f); continue; } r -= I_CO;
        if (r < I_Q) { p0_transpose_item(A.in[I_PWQ], 1024, 2048, 0, 2048, (bf16*)(ws + WS_WQ0), 0, scr, r, lane, 0, 0, 1.f, 0, 0, 1.f); continue; } r -= I_Q;
        p0_transpose_item(A.in[I_PWQ] + (size_t)1024 * 2048, 1024, 2048, 0, 2048, (bf16*)(ws + WS_WQ1), 0, scr, r, lane, 0, 0, 1.f, 0, 0, 1.f);
    }
    for (int i = gtid; i < 16 * 1024; i += gthreads) { const int g = i >> 10, k = i & 1023; ((float*)(ws + WS_WG))[i] = A.in[I_ABWIN][(size_t)k * 2832 + 2048 + g]; }
    for (int i = gtid; i < 32 * 1024; i += gthreads) { const int g = i >> 10, k = i & 1023; ((float*)(ws + WS_WLOW))[i] = A.in[I_GWIN][(size_t)k * 3104 + 3072 + g]; }
    for (int i = gtid; i < 64 * 16; i += gthreads) { const int pos = i >> 4, f = i & 15; const float inv = powf(10000.f, -(float)f / 16.f); const float ang = (float)pos * inv;
        ((float*)(ws + WS_ROPE))[2 * i] = cosf(ang); ((float*)(ws + WS_ROPE))[2 * i + 1] = sinf(ang); }
    cvt_f32_bf16(A.in[I_PKEYS], (bf16*)(ws + WS_KEYS), (size_t)2 * 8 * 2 * 128 * 128, gtid, gthreads);
    cvt_rows_fp6(A.in[I_PU], ws + WS_U, (float*)(ws + WS_SCL), 2 * NEXP, gw, NGW, lane);
    cvt_rows_fp6(A.in[I_PV], ws + WS_V, (float*)(ws + WS_SCL) + 2 * NEXP, 2 * NEXP, gw, NGW, lane);
}

__device__ __forceinline__ void split8(const float* v, bf16x8& hi, bf16x8& lo) {
#pragma unroll
    for (int j = 0; j < 8; ++j) { const unsigned h = f2bf(v[j]); const float hf = __builtin_bit_cast(float, h << 16); hi[j] = (short)h; lo[j] = (short)f2bf(v[j] - hf); }
}
template <int NG>
__device__ __forceinline__ void h_phase(const float* lat, const float* ctx, const float* mod  , bf16* HB, const float* WGT, float* GL, LAS unsigned char* lds, int vcu, int G, int wave, int lane, int tid) {
    constexpr int NT = NG / 16;
    LAS float* part = (LAS float*)lds;
    const int g = lane >> 4, c16 = lane & 15;
    bf16x8 bhi[NT][4], blo[NT][4];
#pragma unroll
    for (int nt = 0; nt < NT; ++nt)
#pragma unroll
        for (int ks = 0; ks < 4; ++ks) { const float* wp = WGT + (size_t)(16 * nt + c16) * 1024 + 128 * wave + 32 * ks + 8 * g;
            const f32x4 w0 = *(const f32x4*)wp, w1 = *(const f32x4*)(wp + 4); const float wv[8] = {w0[0], w0[1], w0[2], w0[3], w1[0], w1[1], w1[2], w1[3]}; split8(wv, bhi[nt][ks], blo[nt][ks]); }
    for (int tile = vcu; tile < TT / 16; tile += G) {
        const int r0 = tile * 16, b = r0 / PB, p0 = r0 - b * PB; const float* mr = mod + (size_t)(p0 < LC ? 8 : b) * 6144 + 128 * wave + 8 * g;
        const int row = r0 + c16; const float* xr = srow_c(lat, ctx, row) + 128 * wave + 8 * g;
        f32x4 xa[4][2], sha[4][2], sca[4][2];
#pragma unroll
        for (int ks = 0; ks < 4; ++ks)
#pragma unroll
            for (int q = 0; q < 2; ++q) { xa[ks][q] = *(const f32x4*)(xr + 32 * ks + 4 * q); sha[ks][q] = *(const f32x4*)(mr + 32 * ks + 4 * q); sca[ks][q] = *(const f32x4*)(mr + 1024 + 32 * ks + 4 * q); }
        f32x4 acc[NT];
#pragma unroll
        for (int nt = 0; nt < NT; ++nt) acc[nt] = (f32x4){0.f, 0.f, 0.f, 0.f};
#pragma unroll
        for (int ks = 0; ks < 4; ++ks) {
            float hv[8];
#pragma unroll
            for (int q = 0; q < 2; ++q)
#pragma unroll
                for (int i = 0; i < 4; ++i) hv[4 * q + i] = xa[ks][q][i] * (sca[ks][q][i] + 1.0f) + sha[ks][q][i];
            bf16x8 ahi, alo; split8(hv, ahi, alo);
            *(bf16x8*)(HB + (size_t)row * D + 128 * wave + 32 * ks + 8 * g) = ahi;
#pragma unroll
            for (int nt = 0; nt < NT; ++nt) { acc[nt] = mma(ahi, bhi[nt][ks], acc[nt]); acc[nt] = mma(ahi, blo[nt][ks], acc[nt]); acc[nt] = mma(alo, bhi[nt][ks], acc[nt]); }
        }
        __syncthreads();
#pragma unroll
        for (int nt = 0; nt < NT; ++nt)
#pragma unroll
            for (int r = 0; r < 4; ++r) part[(wave * 16 + 4 * g + r) * NG + 16 * nt + c16] = acc[nt][r];
        __syncthreads();
        for (int i = tid; i < 16 * NG; i += 512) { float sum = 0.f;
#pragma unroll
            for (int w8 = 0; w8 < 8; ++w8) sum += part[w8 * 16 * NG + i];
            GL[(size_t)r0 * NG + i] = sum; }
    }
}

__device__ __forceinline__ void ln_row(const float* sr, float* xr, const bf16* yrow, const float* mr, const float* lnw, const float* lnb, bf16* hrow, int lane, int dry, bool active) {
    f32x4 v[4]; float s = 0.f;
#pragma unroll
    for (int j = 0; j < 4; ++j) { const int c = 4 * lane + 256 * j; const f32x4 x = *(const f32x4*)(sr + c), g1 = *(const f32x4*)(mr + 2048 + c); const v2u yw = *(const v2u*)(yrow + c);
        v[j][0] = DN_ALPHA * x[0] + g1[0] * bflo(yw.x); v[j][1] = DN_ALPHA * x[1] + g1[1] * bfhi(yw.x); v[j][2] = DN_ALPHA * x[2] + g1[2] * bflo(yw.y); v[j][3] = DN_ALPHA * x[3] + g1[3] * bfhi(yw.y);
        s += (v[j][0] + v[j][1]) + (v[j][2] + v[j][3]); }
    const float mean = wave_sum(s) * (1.f / D); float s2 = 0.f;
#pragma unroll
    for (int j = 0; j < 4; ++j) { v[j] = v[j] - mean; s2 += (v[j][0] * v[j][0] + v[j][1] * v[j][1]) + (v[j][2] * v[j][2] + v[j][3] * v[j][3]); }
    const float rstd = 1.f / sqrtf(wave_sum(s2) * (1.f / D) + LN_EPS);
    if (active) {
#pragma unroll
    for (int j = 0; j < 4; ++j) { const int c = 4 * lane + 256 * j; const f32x4 w = *(const f32x4*)(lnw + c), bb = *(const f32x4*)(lnb + c);
        const f32x4 x1 = v[j] * rstd * w + bb; if (!dry) *(f32x4*)(xr + c) = x1;
        const f32x4 sh = *(const f32x4*)(mr + 3072 + c), sc = *(const f32x4*)(mr + 4096 + c); const f32x4 hp = x1 * (sc + 1.0f) + sh;
        v2u o; o.x = pk2(hp[0], hp[1]); o.y = pk2(hp[2], hp[3]); if (!dry) *(v2u*)(hrow + c) = o; }
    }
}
__device__ __forceinline__ void ln_phase(const float* slat, const float* sctx, float* lat, float* ctx, const bf16* Y, const float* mod, const float* lnw, const float* lnb, bf16* HB, int gw, int NGW, int lane, int dry, bool lat_only) {
    const int nrows = lat_only ? NB * SEQ : TT;
    for (int i0 = gw; i0 < nrows; i0 += 2 * NGW) {
        const int i1 = i0 + NGW; const bool has1 = i1 < nrows; const int r0 = map_row(i0, lat_only), r1c = map_row(has1 ? i1 : i0, lat_only);
        const int b0 = r0 / PB, p0 = r0 - b0 * PB, b1 = r1c / PB, p1 = r1c - b1 * PB;
        ln_row(srow_c(slat, sctx, r0), srow(lat, ctx, r0), Y + (size_t)r0 * D, mod + (size_t)(p0 < LC ? 8 : b0) * 6144, lnw, lnb, HB + (size_t)r0 * D, lane, dry, true);
        ln_row(srow_c(slat, sctx, r1c), srow(lat, ctx, r1c), Y + (size_t)r1c * D, mod + (size_t)(p1 < LC ? 8 : b1) * 6144, lnw, lnb, HB + (size_t)r1c * D, lane, dry, has1);
    }
}

constexpr int AT_LD = 72;
__device__ __forceinline__ bf16x8 frag_tr_perm(const LAS bf16* t, int ld, int r0, int c0, int lane) {
    const int g = lane >> 4, q = (lane & 15) >> 2, p = lane & 3;
    const LAS bf16* a = t + (r0 + 4 * g + q) * ld + c0 + 4 * p;
    const s16x4 lo = __builtin_amdgcn_ds_read_tr16_b64_v4i16((LAS s16x4*)a);
    const s16x4 hi = __builtin_amdgcn_ds_read_tr16_b64_v4i16((LAS s16x4*)(a + 16 * ld));
    return (bf16x8){lo[0], lo[1], lo[2], lo[3], hi[0], hi[1], hi[2], hi[3]};
}
__device__ __forceinline__ void attn_phase(const bf16* P, bf16* CAT, const float* sink, const float* ropetab, LAS unsigned char* lds, unsigned* qctr, int vcu, int G, int wave, int lane, int tid) {
    LAS bf16* Kt = (LAS bf16*)lds;
    LAS bf16* Vt = (LAS bf16*)(lds + 9216);
    LAS bf16* Qw = (LAS bf16*)(lds + 18432 + wave * 4608);
    const int g = lane >> 4, c16 = lane & 15;
    volatile LAS int* qslot = (volatile LAS int*)(lds + MISC_OFF) + 12;
    for (;;) {
        if (tid == 0) *qslot = (int)__hip_atomic_fetch_add(qctr, 1u, __ATOMIC_RELAXED, __HIP_MEMORY_SCOPE_AGENT);
        __syncthreads();
        const int item = *qslot;
        if (item >= 1024 + 64) break;
        const bool is_ctx = item >= 1024;
        int b, hk, nb;
        if (!is_ctx) { b = item >> 7; hk = (item >> 6) & 1; nb = item & 63; } else { const int it = item - 1024; b = it >> 3; hk = (it >> 2) & 1; nb = it & 3; }
        const int head = hk * 4 + (wave >> 1);
        const int qrow0 = b * PB + (is_ctx ? 0 : LC) + nb * 64 + (wave & 1) * 32;
        const int qlat0 = nb * 64 + (wave & 1) * 32;
        __syncthreads();
#pragma unroll
        for (int i = 0; i < 4; ++i) { const int cidx = lane + 64 * i, rr = cidx >> 3, ch = cidx & 7;
            const v4u raw = *(const v4u*)(P + (size_t)(qrow0 + rr) * N_AB + 2048 + head * 64 + ch * 8); v4u o = raw;
            if (!is_ctx) { const int tl = qlat0 + rr; const int pos = (ch < 4) ? (tl >> 6) : (tl & 63); const float* tb = ropetab + (size_t)(pos * 16 + (ch & 3) * 4) * 2;
                const unsigned wv[4] = {raw.x, raw.y, raw.z, raw.w}; unsigned ov[4];
#pragma unroll
                for (int k = 0; k < 4; ++k) { const float x1 = bflo(wv[k]), x2 = bfhi(wv[k]), c = tb[2 * k], s = tb[2 * k + 1]; ov[k] = pk2(x1 * c - x2 * s, x1 * s + x2 * c); }
                o.x = ov[0]; o.y = ov[1]; o.z = ov[2]; o.w = ov[3]; }
            *(LAS v4u*)(Qw + rr * AT_LD + ch * 8) = o; }
        LDS_FENCE();
        bf16x8 qf[2][2];
#pragma unroll
        for (int mt = 0; mt < 2; ++mt)
#pragma unroll
            for (int ks = 0; ks < 2; ++ks) qf[mt][ks] = frag_row(Qw, AT_LD, 16 * mt, 32 * ks, lane);
        LDS_FENCE();
        f32x4 o[2][4]; float mrun[2], lrun[2];
        const float sk = sink[head];
#pragma unroll
        for (int qt = 0; qt < 2; ++qt) { mrun[qt] = sk; lrun[qt] = 1.f; }
#pragma unroll
        for (int qt = 0; qt < 2; ++qt)
#pragma unroll
            for (int nt = 0; nt < 4; ++nt) o[qt][nt] = (f32x4){0.f, 0.f, 0.f, 0.f};
        const int nkt = is_ctx ? 4 : 9;
        const int srr = tid >> 3, sch = tid & 7;
        int kt = 0; f32x2 trope[4];
#pragma unroll
        for (int i = 0; i < 4; ++i) trope[i] = (f32x2){1.f, 0.f};
        v4u kraw = *(const v4u*)(P + (size_t)(b * PB + srr) * N_AB + 2560 + hk * 64 + sch * 8), vraw = *(const v4u*)(P + (size_t)(b * PB + srr) * N_AB + 2688 + hk * 64 + sch * 8);
        while (kt < nkt) {
            const int kp0 = nb * 64 - 128 + 64 * (kt - 4);
            int kn = kt + 1;
            while (kn < nkt && kn >= 4 && ((nb * 64 - 128 + 64 * (kn - 4)) < 0 || (nb * 64 - 128 + 64 * (kn - 4)) >= SEQ)) ++kn;
            __syncthreads();
            { v4u o = kraw;
              if (kt >= 4) { const unsigned wv[4] = {kraw.x, kraw.y, kraw.z, kraw.w}; unsigned ov[4];
#pragma unroll
                  for (int i = 0; i < 4; ++i) { const float x1 = bflo(wv[i]), x2 = bfhi(wv[i]), c = trope[i][0], sn = trope[i][1]; ov[i] = pk2(x1 * c - x2 * sn, x1 * sn + x2 * c); }
                  o.x = ov[0]; o.y = ov[1]; o.z = ov[2]; o.w = ov[3]; }
              *(LAS v4u*)(Kt + srr * AT_LD + sch * 8) = o; *(LAS v4u*)(Vt + srr * AT_LD + sch * 8) = vraw; }
            if (kn < nkt) { const int kpn = nb * 64 - 128 + 64 * (kn - 4); const int krn = b * PB + (kn < 4 ? 64 * kn : LC + kpn);
                kraw = *(const v4u*)(P + (size_t)(krn + srr) * N_AB + 2560 + hk * 64 + sch * 8); vraw = *(const v4u*)(P + (size_t)(krn + srr) * N_AB + 2688 + hk * 64 + sch * 8);
                if (kn >= 4) { const int tl = kpn + srr; const int pos = (sch < 4) ? (tl >> 6) : (tl & 63); const f32x2* tb = (const f32x2*)(ropetab + (size_t)(pos * 16 + (sch & 3) * 4) * 2);
#pragma unroll
                    for (int i = 0; i < 4; ++i) trope[i] = tb[i]; } }
            __syncthreads();
            const bool need_mask = (kt == 4) || (kt == 8);
            bf16x8 kf[4][2];
#pragma unroll
            for (int km = 0; km < 4; ++km)
#pragma unroll
                for (int ks = 0; ks < 2; ++ks) kf[km][ks] = frag_row(Kt, AT_LD, 16 * km, 32 * ks, lane);
            bf16x8 pa[2][2];
#pragma unroll
            for (int qt = 0; qt < 2; ++qt) {
                f32x4 st[4];
#pragma unroll
                for (int km = 0; km < 4; ++km) { st[km] = (f32x4){0.f, 0.f, 0.f, 0.f};
#pragma unroll
                    for (int ks = 0; ks < 2; ++ks) st[km] = mma(kf[km][ks], qf[qt][ks], st[km]); }
                if (need_mask) {
#pragma unroll
                    for (int km = 0; km < 4; ++km)
#pragma unroll
                        for (int r = 0; r < 4; ++r) { const int dq = (kp0 + 16 * km + 4 * g + r) - (qlat0 + 16 * qt + c16); if (dq > 128 || dq < -128) st[km][r] = -3.0e38f; } }
                float mx = fmaxf(fmaxf(fmaxf(st[0][0], st[0][1]), fmaxf(st[0][2], st[0][3])), fmaxf(fmaxf(st[1][0], st[1][1]), fmaxf(st[1][2], st[1][3])));
                mx = fmaxf(mx, fmaxf(fmaxf(fmaxf(st[2][0], st[2][1]), fmaxf(st[2][2], st[2][3])), fmaxf(fmaxf(st[3][0], st[3][1]), fmaxf(st[3][2], st[3][3]))));
                mx = fmaxf(mx, __shfl_xor(mx, 16)); mx = fmaxf(mx, __shfl_xor(mx, 32));
                const float mnew = fmaxf(mrun[qt], mx), alpha = __expf(mrun[qt] - mnew);
                float ps = 0.f;
#pragma unroll
                for (int km = 0; km < 4; ++km)
#pragma unroll
                    for (int r = 0; r < 4; ++r) { const float pv = __expf(st[km][r] - mnew); st[km][r] = pv; ps += pv; }
                ps += __shfl_xor(ps, 16); ps += __shfl_xor(ps, 32);
                lrun[qt] = lrun[qt] * alpha + ps; mrun[qt] = mnew;
#pragma unroll
                for (int ks2 = 0; ks2 < 2; ++ks2) { const unsigned w0 = pk2(st[2 * ks2][0], st[2 * ks2][1]), w1 = pk2(st[2 * ks2][2], st[2 * ks2][3]), w2 = pk2(st[2 * ks2 + 1][0], st[2 * ks2 + 1][1]), w3 = pk2(st[2 * ks2 + 1][2], st[2 * ks2 + 1][3]);
                    const v4u wv = (v4u){w0, w1, w2, w3}; pa[qt][ks2] = __builtin_bit_cast(bf16x8, wv); }
#pragma unroll
                for (int r = 0; r < 4; ++r) { const float ar = __shfl(alpha, (lane & 48) + 4 * g + r);
#pragma unroll
                    for (int nt = 0; nt < 4; ++nt) o[qt][nt][r] *= ar; }
            }
#pragma unroll
            for (int ks2 = 0; ks2 < 2; ++ks2) {
                bf16x8 vf[4];
#pragma unroll
                for (int nt = 0; nt < 4; ++nt) vf[nt] = frag_tr_perm(Vt, AT_LD, 32 * ks2, 16 * nt, lane);
#pragma unroll
                for (int qt = 0; qt < 2; ++qt)
#pragma unroll
                    for (int nt = 0; nt < 4; ++nt) o[qt][nt] = mma(pa[qt][ks2], vf[nt], o[qt][nt]); }
            LDS_FENCE();
            kt = kn;
        }
#pragma unroll
        for (int qt = 0; qt < 2; ++qt)
#pragma unroll
            for (int r = 0; r < 4; ++r) { const float inv = 1.f / __shfl(lrun[qt], (lane & 48) + 4 * g + r); bf16* orow = CAT + (size_t)(qrow0 + 16 * qt + 4 * g + r) * D + 512 + head * 64;
#pragma unroll
                for (int nt = 0; nt < 4; ++nt) orow[16 * nt + c16] = (bf16)f2bf(o[qt][nt][r] * inv); }
    }
}

__device__ __forceinline__ float wave_prefix_sum(float v) {
    v += __builtin_bit_cast(float, __builtin_amdgcn_update_dpp(0, __builtin_bit_cast(int, v), 0x111, 0xf, 0xf, true)); v += __builtin_bit_cast(float, __builtin_amdgcn_update_dpp(0, __builtin_bit_cast(int, v), 0x112, 0xf, 0xf, true));
    v += __builtin_bit_cast(float, __builtin_amdgcn_update_dpp(0, __builtin_bit_cast(int, v), 0x114, 0xf, 0xf, true)); v += __builtin_bit_cast(float, __builtin_amdgcn_update_dpp(0, __builtin_bit_cast(int, v), 0x118, 0xf, 0xf, true));
    v += __builtin_bit_cast(float, __builtin_amdgcn_update_dpp(0, __builtin_bit_cast(int, v), 0x142, 0xa, 0xf, false)); v += __builtin_bit_cast(float, __builtin_amdgcn_update_dpp(0, __builtin_bit_cast(int, v), 0x143, 0xc, 0xf, false));
    return v;
}
__device__ __forceinline__ float wave_prefix_max(float v) {
    const int ninf = (int)0xff800000u;
    v = fmaxf(v, __builtin_bit_cast(float, __builtin_amdgcn_update_dpp(ninf, __builtin_bit_cast(int, v), 0x111, 0xf, 0xf, false))); v = fmaxf(v, __builtin_bit_cast(float, __builtin_amdgcn_update_dpp(ninf, __builtin_bit_cast(int, v), 0x112, 0xf, 0xf, false)));
    v = fmaxf(v, __builtin_bit_cast(float, __builtin_amdgcn_update_dpp(ninf, __builtin_bit_cast(int, v), 0x114, 0xf, 0xf, false))); v = fmaxf(v, __builtin_bit_cast(float, __builtin_amdgcn_update_dpp(ninf, __builtin_bit_cast(int, v), 0x118, 0xf, 0xf, false)));
    v = fmaxf(v, __builtin_bit_cast(float, __builtin_amdgcn_update_dpp(ninf, __builtin_bit_cast(int, v), 0x142, 0xa, 0xf, false))); v = fmaxf(v, __builtin_bit_cast(float, __builtin_amdgcn_update_dpp(ninf, __builtin_bit_cast(int, v), 0x143, 0xc, 0xf, false)));
    return v;
}
__device__ __forceinline__ void mlstm_gate_scan(const float* GL  , const float* gate_b  , unsigned char* ws, int gw, int NGW, int lane) {
    float* BQ = (float*)(ws + WS_BQ); float* CQ = (float*)(ws + WS_CQ); float* EM = (float*)(ws + WS_EM); float* AI = (float*)(ws + WS_AI);
    float* AST = (float*)(ws + WS_AST); float* CL = (float*)(ws + WS_CL);
    for (int chain = gw; chain < 64; chain += NGW) {
        const int dir = chain >> 5, b = (chain >> 2) & 7, h = chain & 3;
        const float bi = gate_b[dir * 8 + h], bfg = gate_b[dir * 8 + 4 + h];
        float m_st = 0.f;
        float gi_n, gf_n;
        { const int j0 = dir == 0 ? 0 : 3; const int p0 = j0 * 64 + (dir == 0 ? lane : 63 - lane); const float* gr = GL + (size_t)(b * PB + p0) * 16 + dir * 8; gi_n = gr[h]; gf_n = gr[4 + h]; }
        for (int sc = 0; sc < NCH; ++sc) {
            const int j = dir == 0 ? sc : (sc < 4 ? 3 - sc : 71 - sc);
            const int p = j * 64 + (dir == 0 ? lane : 63 - lane);
            const float li = gi_n + bi, lf = logsigmoidf_(gf_n + bfg);
            if (sc + 1 < NCH) { const int sn = sc + 1; const int jn = dir == 0 ? sn : (sn < 4 ? 3 - sn : 71 - sn); const int pn = jn * 64 + (dir == 0 ? lane : 63 - lane);
                const float* gr = GL + (size_t)(b * PB + pn) * 16 + dir * 8; gi_n = gr[h]; gf_n = gr[4 + h]; }
            const float cum = wave_prefix_sum(lf);
            const float bb = li - cum; const float pm = wave_prefix_max(bb);
            const float c = fmaxf(m_st, pm);
            const size_t ti = (size_t)chain * PB + p;
            BQ[ti] = bb; CQ[ti] = c; EM[ti] = __expf(-(cum + c)); AI[ti] = __expf(m_st - c);
            const float cl = __builtin_bit_cast(float, __builtin_amdgcn_readlane(__builtin_bit_cast(int, c), 63)), tot = __builtin_bit_cast(float, __builtin_amdgcn_readlane(__builtin_bit_cast(int, cum), 63));
            if (lane == 0) { CL[chain * NCH + j] = cl; AST[chain * NCH + j] = __expf(m_st - cl); }
            m_st = tot + cl;
        }
    }
}


__device__ __forceinline__ float logsig_fast(float x) { return fminf(x, 0.f) - __logf(1.f + __expf(-fabsf(x))); }
__device__ __forceinline__ void gla_prep(bf16* P, bf16* QKR, const float* LOW  , const float* gate_up  , const float* gate_b  , unsigned char* ws,
                                         LAS unsigned char* lds, int vcu, int G, int tid, int dry) {
    float* ET = (float*)(ws + WS_ET);
    LAS float* lowt = (LAS float*)lds;
    LAS bf16* qs = (LAS bf16*)(lds + 8192);
    LAS bf16* ks = (LAS bf16*)(lds + 24576);
    LAS float* LA = (LAS float*)(lds + 40960);
    LAS float* HT = (LAS float*)(lds + 106496);
    const int dc = tid & 255, dir = dc >> 7, ch = dc & 127, half = tid >> 8;
    for (int item = vcu; item < NB * NCH * 4; item += G) {
        const int b = item / (NCH * 4), j = (item >> 2) % NCH, h = item & 3;
        const int row0 = b * PB + j * 64, c = h * 128 + ch;
        __syncthreads();
        for (int i = tid; i < 64 * 32; i += 512) lowt[i] = LOW[(size_t)row0 * 32 + i];
#pragma unroll
        for (int i = 0; i < 2; ++i) { const int cidx = tid + 512 * i, rr = cidx >> 4, c8 = cidx & 15; const bf16* src = P + (size_t)(row0 + rr) * N_C + h * 128 + c8 * 8;
            *(LAS v4u*)(qs + rr * 128 + c8 * 8) = *(const v4u*)src; *(LAS v4u*)(ks + rr * 128 + c8 * 8) = *(const v4u*)(src + 512); }
        float gu[16];
#pragma unroll
        for (int k = 0; k < 16; ++k) gu[k] = gate_up[(size_t)(dir * 16 + k) * 512 + c];
        const float gb = gate_b[dir * 512 + c];
        __syncthreads();
        float hsum = 0.f;
#pragma unroll 4
        for (int i = 0; i < 32; ++i) { const int t = half * 32 + i; float x = gb;
#pragma unroll
            for (int k = 0; k < 16; ++k) x += lowt[t * 32 + dir * 16 + k] * gu[k];
            const float la = logsig_fast(x) * (1.f / 16.f); LA[t * 256 + dc] = la; hsum += la; }
        HT[half * 256 + dc] = hsum;
        __syncthreads();
        float cum = (dir == 0) ? (half == 1 ? HT[dc] : 0.f) : (half == 0 ? HT[256 + dc] : 0.f);
#pragma unroll 4
        for (int i = 0; i < 32; ++i) { const int t = half * 32 + (dir == 0 ? i : 31 - i);
            cum += LA[t * 256 + dc];
            const float e = __expf(cum), ei = __expf(-cum);
            const size_t ro = (size_t)(row0 + t) * N_C;
            const float qv = bf2f(qs[t * 128 + ch]), kv = bf2f(ks[t * 128 + ch]);
            if (dir == 0) { if (!dry) { P[ro + c] = (bf16)f2bf(qv * e); P[ro + 512 + c] = (bf16)f2bf(kv * ei); } }
            else { QKR[(size_t)(row0 + t) * 1024 + c] = (bf16)f2bf(qv * e); QKR[(size_t)(row0 + t) * 1024 + 512 + c] = (bf16)f2bf(kv * ei); } }
        if (half == 0) ET[((size_t)((dir * 8 + b) * 4 + h) * NCH + j) * 128 + ch] = __expf(HT[dc] + HT[256 + dc]);
    }
}


__device__ __forceinline__ unsigned f2sort(float f) { const unsigned u = __builtin_bit_cast(unsigned, f); return (u & 0x80000000u) ? ~u : (u | 0x80000000u); }
__device__ __forceinline__ float sort2f(unsigned s) { const unsigned u = (s & 0x80000000u) ? (s & 0x7fffffffu) : ~s; return __builtin_bit_cast(float, u); }
template <int CTRL> __device__ __forceinline__ unsigned dppmov_u(unsigned x) { return (unsigned)__builtin_amdgcn_mov_dpp((int)x, CTRL, 0xf, 0xf, true); }
__device__ __forceinline__ unsigned gmax16(unsigned x) { unsigned y;
    y = dppmov_u<0xB1>(x); x = x > y ? x : y; y = dppmov_u<0x4E>(x); x = x > y ? x : y; y = dppmov_u<0x141>(x); x = x > y ? x : y; y = dppmov_u<0x128>(x); x = x > y ? x : y; return x; }
__device__ __forceinline__ float gsum16(float x) {
    x += __builtin_bit_cast(float, dppmov_u<0xB1>(__builtin_bit_cast(unsigned, x))); x += __builtin_bit_cast(float, dppmov_u<0x4E>(__builtin_bit_cast(unsigned, x)));
    x += __builtin_bit_cast(float, dppmov_u<0x141>(__builtin_bit_cast(unsigned, x))); x += __builtin_bit_cast(float, dppmov_u<0x128>(__builtin_bit_cast(unsigned, x))); return x; }
#define CSWAP(a, b) do { const unsigned hi_ = (a) > (b) ? (a) : (b), lo_ = (a) > (b) ? (b) : (a); (a) = hi_; (b) = lo_; } while (0)
__device__ __forceinline__ void peer_route(const bf16* Q, const bf16* KEYS, int* EID, float* GWT, int gw, int NGW, int lane, bool lat_only) {
    const int g = lane >> 4, c16 = lane & 15, gbase = lane & 48;
    const int nwi = (lat_only ? NB * SEQ / 16 : TT / 16) * 8;
    for (int wi = gw; wi < nwi; wi += NGW) {
        const int t0 = map_row((wi >> 3) * 16, lat_only), head = wi & 7;
        unsigned tops[2][4];
#pragma unroll
        for (int p = 0; p < 2; ++p) {
            const bf16* qrow = Q + (size_t)(t0 + c16) * 2048 + head * 256 + p * 128 + 8 * g;
            bf16x8 qf[4];
#pragma unroll
            for (int ks = 0; ks < 4; ++ks) qf[ks] = *(const bf16x8*)(qrow + 32 * ks);
            const bf16* kb = KEYS + (size_t)(head * 2 + p) * 128 * 128 + (size_t)c16 * 128 + 8 * g;
            unsigned key[8][4];
#pragma unroll
            for (int nt = 0; nt < 8; ++nt) { f32x4 s = (f32x4){0.f, 0.f, 0.f, 0.f};
#pragma unroll
                for (int ks = 0; ks < 4; ++ks) s = mma(qf[ks], *(const bf16x8*)(kb + (size_t)nt * 16 * 128 + 32 * ks), s);
#pragma unroll
                for (int r = 0; r < 4; ++r) key[nt][r] = (f2sort(s[r]) & ~127u) | (unsigned)(127 - (16 * nt + c16)); }
            unsigned kk[4][8];
#pragma unroll
            for (int r = 0; r < 4; ++r) {
#pragma unroll
                for (int nt = 0; nt < 8; ++nt) kk[r][nt] = key[nt][r];
                CSWAP(kk[r][0], kk[r][1]); CSWAP(kk[r][2], kk[r][3]); CSWAP(kk[r][4], kk[r][5]); CSWAP(kk[r][6], kk[r][7]); CSWAP(kk[r][0], kk[r][2]); CSWAP(kk[r][1], kk[r][3]); CSWAP(kk[r][4], kk[r][6]); CSWAP(kk[r][5], kk[r][7]);
                CSWAP(kk[r][1], kk[r][2]); CSWAP(kk[r][5], kk[r][6]); CSWAP(kk[r][0], kk[r][4]); CSWAP(kk[r][1], kk[r][5]); CSWAP(kk[r][2], kk[r][6]); CSWAP(kk[r][3], kk[r][7]); CSWAP(kk[r][2], kk[r][4]); CSWAP(kk[r][3], kk[r][5]);
                CSWAP(kk[r][1], kk[r][2]); CSWAP(kk[r][3], kk[r][4]); CSWAP(kk[r][5], kk[r][6]); }
            unsigned tt[4] = {0u, 0u, 0u, 0u};
#pragma unroll 2
            for (int rd = 0; rd < 16; ++rd) {
#pragma unroll
                for (int r = 0; r < 4; ++r) { const unsigned m = gmax16(kk[r][0]); const bool w = (kk[r][0] == m);
#pragma unroll
                    for (int q = 0; q < 7; ++q) kk[r][q] = w ? kk[r][q + 1] : kk[r][q];
                    kk[r][7] = w ? 0u : kk[r][7];
                    tt[r] = (c16 == rd) ? m : tt[r]; } }
#pragma unroll
            for (int r = 0; r < 4; ++r) tops[p][r] = tt[r];
        }
        float v0[4], s1v[4]; int ptr[4]; unsigned res[4];
#pragma unroll
        for (int r = 0; r < 4; ++r) { v0[r] = sort2f(tops[0][r] & ~127u); s1v[r] = sort2f((unsigned)__shfl((int)tops[1][r], gbase) & ~127u); ptr[r] = 0; res[r] = 0u; }
#pragma unroll 2
        for (int rd = 0; rd < 16; ++rd) {
#pragma unroll
            for (int r = 0; r < 4; ++r) {
                const unsigned ck = ptr[r] < 16 ? ((f2sort(v0[r] + s1v[r]) & ~255u) | (unsigned)((15 - c16) << 4) | (unsigned)(15 - ptr[r])) : 0u;
                const unsigned m = gmax16(ck);
                res[r] = (c16 == rd) ? m : res[r];
                if (ck == m) ++ptr[r];
                s1v[r] = sort2f((unsigned)__shfl((int)tops[1][r], gbase + (ptr[r] < 15 ? ptr[r] : 15)) & ~127u); } }
#pragma unroll
        for (int r = 0; r < 4; ++r) {
            const float val = sort2f(res[r] & ~255u); const int ii = 15 - (int)((res[r] >> 4) & 15u), jj = 15 - (int)(res[r] & 15u);
            const float mx = __shfl(val, gbase);
            const float ex = __expf(val - mx), sum = gsum16(ex);
            const unsigned i0 = 127u - ((unsigned)__shfl((int)tops[0][r], gbase + ii) & 127u), i1 = 127u - ((unsigned)__shfl((int)tops[1][r], gbase + jj) & 127u);
            const size_t o = (size_t)(t0 + 4 * g + r) * 128 + head * 16 + c16;
            EID[o] = (int)(i0 * 128u + i1); GWT[o] = ex / sum;
        }
    }
}

__device__ __forceinline__ void unpack8(const v4u w, float* o) { o[0] = bflo(w.x); o[1] = bfhi(w.x); o[2] = bflo(w.y); o[3] = bfhi(w.y); o[4] = bflo(w.z); o[5] = bfhi(w.z); o[6] = bflo(w.w); o[7] = bfhi(w.w); }
__device__ __forceinline__ int rev3(int x) { return ((x & 1) << 2) | (x & 2) | ((x >> 2) & 1); }
__device__ __forceinline__ void peer_pass1(const bf16* HB, const int* EID, const float* GWT, const unsigned char* U6, const float* SUi, const float* SVi, float* COEF, int gw, int NGW, int lane, bool lat_only) {
    const int myslot = 8 * (lane & 7) + rev3(lane >> 3);
    const bool b5 = (lane & 32) != 0, b4 = (lane & 16) != 0, b3 = (lane & 8) != 0;
    const int nrows = lat_only ? NB * SEQ : TT;
    for (int ri = gw; ri < nrows; ri += NGW) {
        const int r = map_row(ri, lat_only);
        float h[16];
        { const v4u a = *(const v4u*)(HB + (size_t)r * D + 16 * lane), bq = *(const v4u*)(HB + (size_t)r * D + 16 * lane + 8); unpack8(a, h); unpack8(bq, h + 8); }
#pragma unroll 1
        for (int half = 0; half < 2; ++half) {
            const int eid = EID[(size_t)r * 128 + half * 64 + myslot]; const float gwt = GWT[(size_t)r * 128 + half * 64 + myslot];
            float dotreg = 0.f;
            v3u raw[8];
#pragma unroll
            for (int vi = 0; vi < 8; ++vi) { const int id = __builtin_amdgcn_readlane(eid, 8 * rev3(vi)); raw[vi] = *(const v3u*)(U6 + (size_t)id * 768 + 12 * lane); }
#pragma unroll 1
            for (int gI = 0; gI < 8; ++gI) {
                const int gn = gI < 7 ? gI + 1 : 7;
                float a[8];
#pragma unroll
                for (int vi = 0; vi < 8; ++vi) { const v6u pk6 = (v6u){raw[vi].x, raw[vi].y, raw[vi].z, 0u, 0u, 0u}; const v32f w = __builtin_amdgcn_cvt_scalef32_pk32_f32_fp6(pk6, 1.0f);
                    const int idn = __builtin_amdgcn_readlane(eid, gn + 8 * rev3(vi)); raw[vi] = *(const v3u*)(U6 + (size_t)idn * 768 + 12 * lane);
                    float sacc = 0.f;
#pragma unroll
                    for (int i = 0; i < 16; ++i) sacc += h[i] * w[i];
                    a[vi] = sacc;
                    __builtin_amdgcn_sched_barrier(0); }
                float bb[4];
#pragma unroll
                for (int k = 0; k < 4; ++k) { const float keep = b5 ? a[2 * k + 1] : a[2 * k], send = b5 ? a[2 * k] : a[2 * k + 1]; bb[k] = keep + __shfl_xor(send, 32); }
                float cc[2];
#pragma unroll
                for (int k = 0; k < 2; ++k) { const float keep = b4 ? bb[2 * k + 1] : bb[2 * k], send = b4 ? bb[2 * k] : bb[2 * k + 1]; cc[k] = keep + __shfl_xor(send, 16); }
                float dd; { const float keep = b3 ? cc[1] : cc[0], send = b3 ? cc[0] : cc[1]; dd = keep + __shfl_xor(send, 8); }
                dd += __shfl_xor(dd, 4); dd += __shfl_xor(dd, 2); dd += __shfl_xor(dd, 1);
                dotreg = ((lane & 7) == gI) ? dd : dotreg;
            }
            const float dot = dotreg * SUi[eid];
            const float coef = gwt * 0.5f * dot * (1.f + erff(dot * 0.70710678118f)) * SVi[eid];
            COEF[(size_t)r * 128 + half * 64 + myslot] = coef;
        }
    }
}
template <bool USE_PEER>
__device__ __forceinline__ void peer_expert(const float* COEF, const int* EID, const unsigned char* V6,
                                            float* lat, float* ctx, const float* mod, const float* lnw, const float* lnb, int gw, int NGW, int lane, int dry, bool lat_only) {
    const int myslot = 8 * (lane & 7) + rev3(lane >> 3);
    const int nrows = lat_only ? NB * SEQ : TT;
    for (int ri = gw; ri < nrows; ri += NGW) {
        const int r = map_row(ri, lat_only);
        const int b = r / PB, p = r - b * PB; float* xr = srow(lat, ctx, r); const float* mr = mod + (size_t)(p < LC ? 8 : b) * 6144;
        float f[16];
#pragma unroll
        for (int i = 0; i < 16; ++i) f[i] = 0.f;
        if (USE_PEER) {
#pragma unroll 1
        for (int half = 0; half < 2; ++half) {
            const int eid = EID[(size_t)r * 128 + half * 64 + myslot];
            const float coef = COEF[(size_t)r * 128 + half * 64 + myslot];
            v3u ring[8];
#pragma unroll
            for (int k = 0; k < 8; ++k) { const int id = __builtin_amdgcn_readlane(eid, k); ring[k] = *(const v3u*)(V6 + (size_t)id * 768 + 12 * lane); }
#pragma unroll 1
            for (int e0 = 0; e0 < 64; e0 += 8) {
#pragma unroll
                for (int k = 0; k < 8; ++k) { const float c = __builtin_bit_cast(float, __builtin_amdgcn_readlane(__builtin_bit_cast(int, coef), e0 + k));
                    const v6u pk6 = (v6u){ring[k].x, ring[k].y, ring[k].z, 0u, 0u, 0u}; const v32f w = __builtin_amdgcn_cvt_scalef32_pk32_f32_fp6(pk6, 1.0f);
                    const int en = (e0 + 8 + k) < 64 ? (e0 + 8 + k) : 63; const int idn = __builtin_amdgcn_readlane(eid, en);
                    ring[k] = *(const v3u*)(V6 + (size_t)idn * 768 + 12 * lane);
#pragma unroll
                    for (int i = 0; i < 16; ++i) f[i] += c * w[i];
                    __builtin_amdgcn_sched_barrier(0); }
            }
        }
        }
        float v[16]; float s = 0.f;
#pragma unroll
        for (int q = 0; q < 4; ++q) { const int c = 16 * lane + 4 * q; const f32x4 x1 = *(const f32x4*)(xr + c), g2 = *(const f32x4*)(mr + 5120 + c);
#pragma unroll
            for (int i = 0; i < 4; ++i) { v[4 * q + i] = DN_ALPHA * x1[i] + g2[i] * f[4 * q + i]; s += v[4 * q + i]; } }
        const float mean = wave_sum(s) * (1.f / D); float s2 = 0.f;
#pragma unroll
        for (int i = 0; i < 16; ++i) { v[i] -= mean; s2 += v[i] * v[i]; }
        const float rstd = 1.f / sqrtf(wave_sum(s2) * (1.f / D) + LN_EPS);
#pragma unroll
        for (int q = 0; q < 4; ++q) { const int c = 16 * lane + 4 * q; const f32x4 w = *(const f32x4*)(lnw + c), bb2 = *(const f32x4*)(lnb + c); f32x4 o;
#pragma unroll
            for (int i = 0; i < 4; ++i) o[i] = v[4 * q + i] * rstd * w[i] + bb2[i];
            if (!dry) *(f32x4*)(xr + c) = o; }
    }
}

__device__ __forceinline__ bf16* od_row_base(unsigned char* ws, int dir, int b) {
    if (dir == 0) return (bf16*)(ws + WS_ST) + (size_t)b * SEQ * 1024;
    return b < 7 ? (bf16*)(ws + WS_ST + 64 * MiB) + (size_t)b * SEQ * 1024 : (bf16*)(ws + WS_XC);
}
__device__ __forceinline__ void gla_fused_scan(const bf16* P, const bf16* QKR, unsigned char* ws, LAS unsigned char* lds, int vcu, int G, int wave, int lane, int tid, int dry) {
    const float* ET = (const float*)(ws + WS_ET);
    LAS bf16* Qt = (LAS bf16*)lds;
    LAS bf16* Kt = (LAS bf16*)(lds + 34816);
    LAS bf16* Vt = (LAS bf16*)(lds + 69632);
    LAS bf16* SL = (LAS bf16*)(lds + 88064);
    LAS bf16* Pw = (LAS bf16*)(lds + 122880 + wave * 2304);
    const int g = lane >> 4, c16 = lane & 15, mt = wave & 3, cw = wave >> 2;
    for (int item = vcu; item < 256; item += G) {
        const int dir = item >> 7, b = (item >> 4) & 7, h = (item >> 2) & 3, eb = item & 3;
        const bf16* qsrc = dir == 0 ? P + h * 128 : QKR + h * 128; const int qld = dir == 0 ? N_C : 1024;
        const bf16* vsrc = P + 1024 + h * 256 + 64 * eb;
        const float* etp = ET + ((size_t)((dir * 8 + b) * 4 + h) * NCH) * 128 + 16 * wave + c16;
        bf16* odb = od_row_base(ws, dir, b) + h * 256 + 64 * eb;
        f32x4 acc[4];
#pragma unroll
        for (int et = 0; et < 4; ++et) acc[et] = (f32x4){0.f, 0.f, 0.f, 0.f};
        v4u qreg[2][2], kreg[2][2], vreg[2]; float etn[2];
#define GLA_JOF(sc_) (dir == 0 ? (sc_) : ((sc_) < 4 ? 3 - (sc_) : 71 - (sc_)))
#define GLA_PREFETCH(sc0_) do { _Pragma("unroll") for (int u = 0; u < 2; ++u) { const int jj = GLA_JOF((sc0_) + u); const int row0 = b * PB + jj * 64; \
            _Pragma("unroll") for (int i = 0; i < 2; ++i) { const int cidx = tid + 512 * i, rr = cidx >> 4, ch = cidx & 15; const bf16* sp = qsrc + (size_t)(row0 + rr) * qld + ch * 8; qreg[u][i] = *(const v4u*)sp; kreg[u][i] = *(const v4u*)(sp + 512); } \
            vreg[u] = *(const v4u*)(vsrc + (size_t)(row0 + (tid >> 3)) * N_C + (tid & 7) * 8); etn[u] = etp[(size_t)jj * 128]; } } while (0)
        GLA_PREFETCH(0);
        unsigned opk[8]; int ojc = -1;
#pragma unroll
        for (int i = 0; i < 8; ++i) opk[i] = 0u;
        for (int sc = 0; sc < NCH; sc += 2) {
            const int ja = GLA_JOF(sc), jb = GLA_JOF(sc + 1);
            __syncthreads();
            if (ojc >= 4 && !dry) {
#pragma unroll
                for (int nt = 0; nt < 4; ++nt) { bf16* orow = odb + (size_t)((ojc - 4) * 64 + 16 * mt + 4 * g) * 1024 + 16 * nt + c16;
#pragma unroll
                    for (int r = 0; r < 4; ++r) orow[(size_t)r * 1024] = (bf16)((opk[2 * nt + (r >> 1)] >> (16 * (r & 1))) & 0xffffu); } }
#pragma unroll
            for (int u = 0; u < 2; ++u) {
#pragma unroll
                for (int i = 0; i < 2; ++i) { const int cidx = tid + 512 * i, rr = cidx >> 4, ch = cidx & 15; *(LAS v4u*)(Qt + u * 8704 + rr * 136 + ch * 8) = qreg[u][i]; *(LAS v4u*)(Kt + u * 8704 + rr * 136 + ch * 8) = kreg[u][i]; }
                *(LAS v4u*)(Vt + u * 4608 + (tid >> 3) * 72 + (tid & 7) * 8) = vreg[u]; }
#pragma unroll
            for (int et = 0; et < 4; ++et)
#pragma unroll
                for (int r = 0; r < 4; ++r) SL[(16 * et + 4 * g + r) * 136 + 16 * wave + c16] = (bf16)f2bf(acc[et][r]);
            const float et_a = etn[0], et_b = etn[1];
            if (sc + 2 < NCH) GLA_PREFETCH(sc + 2);
            __syncthreads();
#pragma unroll
            for (int ks = 0; ks < 2; ++ks) { const bf16x8 kb = frag_tr(Kt, 136, 32 * ks, 16 * wave, lane);
#pragma unroll
                for (int et = 0; et < 4; ++et) acc[et] = mma(frag_tr(Vt, 72, 32 * ks, 16 * et, lane), kb, acc[et]); }
#pragma unroll
            for (int et = 0; et < 4; ++et) { acc[et] = acc[et] * et_a;
#pragma unroll
                for (int r = 0; r < 4; ++r) SL[8704 + (16 * et + 4 * g + r) * 136 + 16 * wave + c16] = (bf16)f2bf(acc[et][r]); }
            __syncthreads();
            const int jc = cw == 0 ? ja : jb;
            ojc = jc;
            if (jc >= 4) {
                const LAS bf16* Qc = Qt + cw * 8704; const LAS bf16* Kc = Kt + cw * 8704; const LAS bf16* Vc = Vt + cw * 4608; const LAS bf16* Sc = SL + cw * 8704;
                bf16x8 qf[4];
#pragma unroll
                for (int ks = 0; ks < 4; ++ks) qf[ks] = frag_row(Qc, 136, 16 * mt, 32 * ks, lane);
                bf16x8 pa[2];
                { f32x4 st[4];
#pragma unroll
                  for (int ns = 0; ns < 4; ++ns) { st[ns] = (f32x4){0.f, 0.f, 0.f, 0.f};
#pragma unroll
                      for (int ks = 0; ks < 4; ++ks) st[ns] = mma(frag_row(Kc, 136, 16 * ns, 32 * ks, lane), qf[ks], st[ns]);
#pragma unroll
                      for (int r = 0; r < 4; ++r) { const int sidx = 16 * ns + 4 * g + r, t = 16 * mt + c16; const bool ok = dir == 0 ? (sidx <= t) : (sidx >= t); st[ns][r] = ok ? st[ns][r] : 0.f; } }
#pragma unroll
                  for (int ks2 = 0; ks2 < 2; ++ks2) { const v4u wv = (v4u){pk2(st[2 * ks2][0], st[2 * ks2][1]), pk2(st[2 * ks2][2], st[2 * ks2][3]), pk2(st[2 * ks2 + 1][0], st[2 * ks2 + 1][1]), pk2(st[2 * ks2 + 1][2], st[2 * ks2 + 1][3])};
                      pa[ks2] = __builtin_bit_cast(bf16x8, wv); } }
#pragma unroll
                for (int nt = 0; nt < 4; ++nt) { f32x4 a = (f32x4){0.f, 0.f, 0.f, 0.f};
#pragma unroll
                    for (int ks = 0; ks < 4; ++ks) a = mma(qf[ks], frag_row(Sc, 136, 16 * nt, 32 * ks, lane), a);
                    a = mma(pa[0], frag_tr_perm(Vc, 72, 0, 16 * nt, lane), a); a = mma(pa[1], frag_tr_perm(Vc, 72, 32, 16 * nt, lane), a);
                    opk[2 * nt] = pk2(a[0], a[1]); opk[2 * nt + 1] = pk2(a[2], a[3]); }
                LDS_FENCE();
            }
#pragma unroll
            for (int ks = 0; ks < 2; ++ks) { const bf16x8 kb = frag_tr(Kt + 8704, 136, 32 * ks, 16 * wave, lane);
#pragma unroll
                for (int et = 0; et < 4; ++et) acc[et] = mma(frag_tr(Vt + 4608, 72, 32 * ks, 16 * et, lane), kb, acc[et]); }
#pragma unroll
            for (int et = 0; et < 4; ++et) acc[et] = acc[et] * et_b;
        }
        if (ojc >= 4 && !dry) {
#pragma unroll
            for (int nt = 0; nt < 4; ++nt) { bf16* orow = odb + (size_t)((ojc - 4) * 64 + 16 * mt + 4 * g) * 1024 + 16 * nt + c16;
#pragma unroll
                for (int r = 0; r < 4; ++r) orow[(size_t)r * 1024] = (bf16)((opk[2 * nt + (r >> 1)] >> (16 * (r & 1))) & 0xffffu); } }
#undef GLA_PREFETCH
#undef GLA_JOF
    }
}
__device__ __forceinline__ void gla_merge(bf16* P, const float* norm_w, unsigned char* ws, int gw, int NGW, int lane, int dry) {
    for (int i = gw; i < NB * SEQ; i += NGW) {
        const int b = i >> 12, lp = i & 4095; const size_t r = (size_t)b * PB + LC + lp;
        const bf16* of = od_row_base(ws, 0, b) + (size_t)lp * 1024 + 16 * lane; const bf16* orv = od_row_base(ws, 1, b) + (size_t)lp * 1024 + 16 * lane;
        bf16* grow = P + r * N_C + 2048 + 16 * lane;
        float x[16], y[16], gg[16];
        unpack8(*(const v4u*)of, x); unpack8(*(const v4u*)(of + 8), x + 8); unpack8(*(const v4u*)orv, y); unpack8(*(const v4u*)(orv + 8), y + 8);
        unpack8(*(const v4u*)grow, gg); unpack8(*(const v4u*)(grow + 8), gg + 8);
        float ss = 0.f;
#pragma unroll
        for (int k = 0; k < 16; ++k) { x[k] += y[k]; ss += x[k] * x[k]; }
        ss = gsum16(ss);
        const float rn = 1.f / sqrtf(ss * (1.f / 256.f) + LN_EPS);
        unsigned ow[8];
#pragma unroll
        for (int k = 0; k < 8; ++k) { const float4 dummy = make_float4(0.f, 0.f, 0.f, 0.f); (void)dummy;
            const float a = x[2 * k] * rn * norm_w[16 * lane + 2 * k] * siluf_(gg[2 * k]), c = x[2 * k + 1] * rn * norm_w[16 * lane + 2 * k + 1] * siluf_(gg[2 * k + 1]); ow[k] = pk2(a, c); }
        if (!dry) { v4u o0, o1; o0.x = ow[0]; o0.y = ow[1]; o0.z = ow[2]; o0.w = ow[3]; o1.x = ow[4]; o1.y = ow[5]; o1.z = ow[6]; o1.w = ow[7]; *(v4u*)grow = o0; *(v4u*)(grow + 8) = o1; }
    }
}

__device__ __forceinline__ void mlstm_fused_scan(const bf16* P, unsigned char* ws, LAS unsigned char* lds, int vcu, int G, int wave, int lane, int tid) {
    const float* BQ = (const float*)(ws + WS_BQ); const float* CQ = (const float*)(ws + WS_CQ); const float* EM = (const float*)(ws + WS_EM); const float* AI = (const float*)(ws + WS_AI);
    const float* AST = (const float*)(ws + WS_AST); const float* CL = (const float*)(ws + WS_CL);
    LAS bf16* Qt = (LAS bf16*)lds;
    LAS bf16* Kt = (LAS bf16*)(lds + 17408);
    LAS bf16* Vt = (LAS bf16*)(lds + 34816);
    LAS bf16* Vw = (LAS bf16*)(lds + 41984);
    LAS bf16* CT = (LAS bf16*)(lds + 49152);
    LAS bf16* Pw = (LAS bf16*)(lds + 62208 + wave * 2304);
    const int g = lane >> 4, c16 = lane & 15, mt = wave & 3, hf = wave >> 2;
    const int vrow = tid < 256 ? (tid >> 2) : ((tid - 256) & 63), vch = tid & 3;
    for (int item = vcu; item < 256; item += G) {
        const int dir = item >> 7, b = (item >> 4) & 7, h = (item >> 2) & 3, eb = item & 3;
        const int chain = dir * 32 + b * 4 + h;
        const bf16* qsrc = P + h * 128; const bf16* vsrc = P + 1024 + h * 128 + 32 * eb;
        bf16* odb = (bf16*)(ws + WS_ST) + (size_t)dir * TT * 512 + h * 128 + 32 * eb;
        f32x4 acc[3];
#pragma unroll
        for (int et = 0; et < 3; ++et) acc[et] = (f32x4){0.f, 0.f, 0.f, 0.f};
        v4u qreg[2], kreg[2], vreg; float bqr, cln, astn, cqn; f32x4 bqn[4], ain, emn;
        { const int j0 = dir == 0 ? 0 : 3; const int row0 = b * PB + j0 * 64; const size_t tb = (size_t)chain * PB + j0 * 64;
#pragma unroll
          for (int i = 0; i < 2; ++i) { const int cidx = tid + 512 * i, rr = cidx >> 4, ch = cidx & 15; const bf16* s = qsrc + (size_t)(row0 + rr) * N_AB + ch * 8; qreg[i] = *(const v4u*)s; kreg[i] = *(const v4u*)(s + 512); }
          vreg = *(const v4u*)(vsrc + (size_t)(row0 + vrow) * N_AB + vch * 8); bqr = BQ[tb + vrow]; cln = CL[chain * NCH + j0]; astn = AST[chain * NCH + j0];
#pragma unroll
          for (int k = 0; k < 4; ++k) bqn[k] = *(const f32x4*)(BQ + tb + 16 * k + 4 * g);
          cqn = CQ[tb + 16 * mt + c16]; ain = *(const f32x4*)(AI + tb + 16 * mt + 4 * g); emn = *(const f32x4*)(EM + tb + 16 * mt + 4 * g); }
        for (int sc = 0; sc < NCH; ++sc) {
            const int j = dir == 0 ? sc : (sc < 4 ? 3 - sc : 71 - sc);
            __syncthreads();
#pragma unroll
            for (int i = 0; i < 2; ++i) { const int cidx = tid + 512 * i, rr = cidx >> 4, ch = cidx & 15; *(LAS v4u*)(Qt + rr * 136 + ch * 8) = qreg[i]; *(LAS v4u*)(Kt + rr * 136 + ch * 8) = kreg[i]; }
            { const float wsv = __expf(bqr - cln);
              if (tid < 256) { const v4u raw = vreg; v4u o;
                  o.x = pk2(bflo(raw.x) * wsv, bfhi(raw.x) * wsv); o.y = pk2(bflo(raw.y) * wsv, bfhi(raw.y) * wsv); o.z = pk2(bflo(raw.z) * wsv, bfhi(raw.z) * wsv); o.w = pk2(bflo(raw.w) * wsv, bfhi(raw.w) * wsv);
                  *(LAS v4u*)(Vt + vrow * 56 + vch * 8) = raw; *(LAS v4u*)(Vw + vrow * 56 + vch * 8) = o;
              } else if (tid < 320) { v4u o; o.x = 0x3f80u; o.y = 0u; o.z = 0u; o.w = 0u; *(LAS v4u*)(Vt + vrow * 56 + 32) = o; o.x = f2bf(wsv); *(LAS v4u*)(Vw + vrow * 56 + 32) = o;
                  o.x = 0u; *(LAS v4u*)(Vt + vrow * 56 + 40) = o; *(LAS v4u*)(Vw + vrow * 56 + 40) = o; } }
#pragma unroll
            for (int et = 0; et < 3; ++et)
#pragma unroll
                for (int r = 0; r < 4; ++r) CT[(16 * et + 4 * g + r) * 136 + 16 * wave + c16] = (bf16)f2bf(acc[et][r]);
            const float ast = astn, cqt = cqn; f32x4 bq[4]; const f32x4 ai = ain, em = emn;
#pragma unroll
            for (int k = 0; k < 4; ++k) bq[k] = bqn[k];
            if (sc + 1 < NCH) { const int sn = sc + 1; const int jn = dir == 0 ? sn : (sn < 4 ? 3 - sn : 71 - sn); const int row0 = b * PB + jn * 64; const size_t tb = (size_t)chain * PB + jn * 64;
#pragma unroll
                for (int i = 0; i < 2; ++i) { const int cidx = tid + 512 * i, rr = cidx >> 4, ch = cidx & 15; const bf16* s = qsrc + (size_t)(row0 + rr) * N_AB + ch * 8; qreg[i] = *(const v4u*)s; kreg[i] = *(const v4u*)(s + 512); }
                vreg = *(const v4u*)(vsrc + (size_t)(row0 + vrow) * N_AB + vch * 8); bqr = BQ[tb + vrow]; cln = CL[chain * NCH + jn]; astn = AST[chain * NCH + jn];
#pragma unroll
                for (int k = 0; k < 4; ++k) bqn[k] = *(const f32x4*)(BQ + tb + 16 * k + 4 * g);
                cqn = CQ[tb + 16 * mt + c16]; ain = *(const f32x4*)(AI + tb + 16 * mt + 4 * g); emn = *(const f32x4*)(EM + tb + 16 * mt + 4 * g); }
            __syncthreads();
            bf16x8 qf[4];
#pragma unroll
            for (int ks = 0; ks < 4; ++ks) qf[ks] = frag_row(Qt, 136, 16 * mt, 32 * ks, lane);
            bf16x8 pa[2];
            { f32x4 st[4];
#pragma unroll
              for (int ns = 0; ns < 4; ++ns) { st[ns] = (f32x4){0.f, 0.f, 0.f, 0.f};
#pragma unroll
                  for (int ks = 0; ks < 4; ++ks) st[ns] = mma(frag_row(Kt, 136, 16 * ns, 32 * ks, lane), qf[ks], st[ns]);
#pragma unroll
                  for (int r = 0; r < 4; ++r) { const int sidx = 16 * ns + 4 * g + r, t = 16 * mt + c16; const bool ok = dir == 0 ? (sidx <= t) : (sidx >= t);
                      st[ns][r] = ok ? st[ns][r] * __expf(bq[ns][r] - cqt) : 0.f; } }
#pragma unroll
              for (int ks2 = 0; ks2 < 2; ++ks2) { const v4u wv = (v4u){pk2(st[2 * ks2][0], st[2 * ks2][1]), pk2(st[2 * ks2][2], st[2 * ks2][3]), pk2(st[2 * ks2 + 1][0], st[2 * ks2 + 1][1]), pk2(st[2 * ks2 + 1][2], st[2 * ks2 + 1][3])};
                  pa[ks2] = __builtin_bit_cast(bf16x8, wv); } }
            f32x4 av, ad;
            { f32x4 a = (f32x4){0.f, 0.f, 0.f, 0.f}, d = (f32x4){0.f, 0.f, 0.f, 0.f};
#pragma unroll
              for (int ks = 0; ks < 4; ++ks) { a = mma(qf[ks], frag_row(CT, 136, 16 * hf, 32 * ks, lane), a); d = mma(qf[ks], frag_row(CT, 136, 32, 32 * ks, lane), d); }
#pragma unroll
              for (int r = 0; r < 4; ++r) { a[r] *= ai[r]; d[r] *= ai[r]; }
#pragma unroll
              for (int ks = 0; ks < 2; ++ks) { a = mma(pa[ks], frag_tr_perm(Vt, 56, 32 * ks, 16 * hf, lane), a); d = mma(pa[ks], frag_tr_perm(Vt, 56, 32 * ks, 32, lane), d); }
              av = a; ad = d; }
            { bf16* orow = odb + (size_t)(b * PB + j * 64 + 16 * mt + 4 * g) * 512 + 16 * hf + c16;
#pragma unroll
              for (int r = 0; r < 4; ++r) { const float den = __shfl(ad[r], lane & 48); orow[(size_t)r * 512] = (bf16)f2bf(av[r] / fmaxf(fabsf(den), em[r])); } }
#pragma unroll
            for (int et = 0; et < 3; ++et) acc[et] = acc[et] * ast;
#pragma unroll
            for (int ks = 0; ks < 2; ++ks) { const bf16x8 kb = frag_tr(Kt, 136, 32 * ks, 16 * wave, lane);
#pragma unroll
                for (int et = 0; et < 3; ++et) acc[et] = mma(frag_tr(Vw, 56, 32 * ks, 16 * et, lane), kb, acc[et]); }
        }
    }
}
__device__ __forceinline__ void mlstm_merge(const bf16* P, bf16* CAT, const float* norm_w, unsigned char* ws, int gw, int NGW, int lane) {
    const bf16* OD = (const bf16*)(ws + WS_ST);
    for (int r = gw; r < TT; r += NGW) {
        float x[8], y[8], og[8];
        unpack8(*(const v4u*)(OD + (size_t)r * 512 + 8 * lane), x); unpack8(*(const v4u*)(OD + (size_t)TT * 512 + (size_t)r * 512 + 8 * lane), y);
        unpack8(*(const v4u*)(P + (size_t)r * N_AB + 1536 + 8 * lane), og);
        float ss = 0.f;
#pragma unroll
        for (int k = 0; k < 8; ++k) { x[k] += y[k]; ss += x[k] * x[k]; }
        ss = gsum16(ss);
        const float rn = 1.f / sqrtf(ss * (1.f / 128.f) + LN_EPS);
        unsigned ow[4];
#pragma unroll
        for (int k = 0; k < 4; ++k) ow[k] = pk2(x[2 * k] * rn * norm_w[8 * lane + 2 * k] * sigmoidf_(og[2 * k]), x[2 * k + 1] * rn * norm_w[8 * lane + 2 * k + 1] * sigmoidf_(og[2 * k + 1]));
        v4u o; o.x = ow[0]; o.y = ow[1]; o.z = ow[2]; o.w = ow[3]; *(v4u*)(CAT + (size_t)r * D + 8 * lane) = o;
    }
}

#ifndef PHMASK
#define PHMASK 0xffffffffu
#endif
#define PH(k) ((PHMASK >> (k)) & 1u)
#ifndef REPMASK
#define REPMASK 0u
#endif
#define REPS(k) (1 + (int)((REPMASK >> (k)) & 1u))
#if REPMASK
#define DRYV(k) ({ int d_ = (rep_ + 1 < REPS(k)) ? 1 : 0; asm volatile("" : "+s"(d_)); d_; })
#else
#define DRYV(k) 0
#endif
#ifndef DBG_LEVEL
#define DBG_LEVEL 3
#endif
typedef const __attribute__((address_space(4))) Args* KArgsP;
__device__ __forceinline__ KArgsP kargs() { KArgsP p = (KArgsP)__builtin_amdgcn_kernarg_segment_ptr(); asm volatile("" : "+s"(p)); return p; }
#define WSP(off) (ws + (off))
__global__ void __launch_bounds__(512, 2) fwd_megakernel(Args A_unused) {
    extern __shared__ __attribute__((aligned(16))) unsigned char lds_raw[];
    LAS unsigned char* lds = (LAS unsigned char*)lds_raw;
    const int tid0 = threadIdx.x;
    const int G = gridDim.x; const int bx = blockIdx.x; const int vcu = (G % 8 == 0) ? (bx % 8) * (G / 8) + bx / 8 : bx;
    const int NGW = G * 8;
    volatile LAS unsigned* MISC = (volatile LAS unsigned*)(lds + MISC_OFF);
    if (tid0 < 16) MISC[tid0] = 0u;
    __syncthreads();
    XcdBarrier bar;
    { KArgsP ap = kargs(); bar = xcd_barrier_post((unsigned*)(ap->ws + WS_CTL) + 1024, MISC + 8); }
#define GRID_BAR() xcd_barrier(bar)
#define PROLOG KArgsP ap = kargs(); unsigned char* ws = ap->ws; (void)ws; int tid = tid0; asm volatile("" : "+v"(tid)); const int lane = tid & 63, wave = __builtin_amdgcn_readfirstlane(tid >> 6), gw = vcu * 8 + wave; (void)lane; (void)wave; (void)gw;

    if (PH(0)) for (int rep_ = 0; rep_ < REPS(0); ++rep_) { int tid = tid0; asm volatile("" : "+v"(tid)); const int lane = tid & 63, wave = __builtin_amdgcn_readfirstlane(tid >> 6); Args A; { KArgsP ap = kargs();
#pragma unroll
        for (int i = 0; i < 22; ++i) A.in[i] = ap->in[i];
        A.out = ap->out; A.ws = ap->ws; }
        p0_prologue(A, lds, vcu, G, wave, lane, tid); }
    GRID_BAR();

    if (PH(1)) for (int rep_ = 0; rep_ < REPS(1); ++rep_) { PROLOG h_phase<16>(ap->in[I_X], ap->in[I_CTX], (const float*)WSP(WS_MOD), (bf16*)WSP(WS_HB), (const float*)WSP(WS_WG), (float*)WSP(WS_GL), lds, vcu, G, wave, lane, tid); }
    GRID_BAR();
    if (PH(2)) for (int rep_ = 0; rep_ < REPS(2); ++rep_) { PROLOG pg8::Gemm g{(const bf16*)WSP(WS_HB), (const bf16*)WSP(WS_WAB), TT, N_AB, 1024, 1024, 1024}; pg8::StaticOrder S; S.init(TT, N_AB, G, bx);
      pg8::EpiBf16 E{(bf16*)WSP(WS_P), N_AB}; pg8::gemm_phase<pg8::EpiBf16, pg8::StaticOrder>(lds, g, S, E, tid); }
    GRID_BAR();
#if DBG_LEVEL >= 2
    if (PH(3)) for (int rep_ = 0; rep_ < REPS(3); ++rep_) { PROLOG mlstm_gate_scan((const float*)WSP(WS_GL), ap->in[I_ABGB], ws, gw, NGW, lane); }
    if (PH(4)) for (int rep_ = 0; rep_ < REPS(4); ++rep_) { PROLOG attn_phase((const bf16*)WSP(WS_P), (bf16*)WSP(WS_HB), ap->in[I_ABSINK], (const float*)WSP(WS_ROPE), lds, (unsigned*)WSP(WS_CTL) + 6144 + 64 * rep_, vcu, G, wave, lane, tid); }
    GRID_BAR();
    if (PH(5)) for (int rep_ = 0; rep_ < REPS(5); ++rep_) { PROLOG mlstm_fused_scan((const bf16*)WSP(WS_P), ws, lds, vcu, G, wave, lane, tid); }
    GRID_BAR();
    if (PH(6)) for (int rep_ = 0; rep_ < REPS(6); ++rep_) { PROLOG mlstm_merge((const bf16*)WSP(WS_P), (bf16*)WSP(WS_HB), ap->in[I_ABNW], ws, gw, NGW, lane); }
    GRID_BAR();
#endif
    if (PH(7)) for (int rep_ = 0; rep_ < REPS(7); ++rep_) { PROLOG pg8::Gemm g{(const bf16*)WSP(WS_HB), (const bf16*)WSP(WS_WABO), TT, 1024, 1024, 1024, 1024}; pg8::StaticOrder S; S.init(TT, 1024, G, bx);
      pg8::EpiBf16 E{(bf16*)WSP(WS_P), 1024}; pg8::gemm_phase<pg8::EpiBf16, pg8::StaticOrder>(lds, g, S, E, tid); }
    GRID_BAR();
    if (PH(8)) for (int rep_ = 0; rep_ < REPS(8); ++rep_) { PROLOG ln_phase(ap->in[I_X], ap->in[I_CTX], ap->out, (float*)WSP(WS_XC), (const bf16*)WSP(WS_P), (const float*)WSP(WS_MOD), ap->in[I_LNW], ap->in[I_LNB], (bf16*)WSP(WS_HB), gw, NGW, lane, DRYV(8), false); }
    GRID_BAR();
#if DBG_LEVEL >= 3
    if (PH(9)) for (int rep_ = 0; rep_ < REPS(9); ++rep_) { PROLOG pg8::Gemm g{(const bf16*)WSP(WS_HB), (const bf16*)WSP(WS_WQ0), TT, 2048, 1024, 1024, 1024}; pg8::StaticOrder S; S.init(TT, 2048, G, bx);
      pg8::EpiBf16 E{(bf16*)WSP(WS_P), 2048}; pg8::gemm_phase<pg8::EpiBf16, pg8::StaticOrder>(lds, g, S, E, tid); }
    GRID_BAR();
    if (PH(10)) for (int rep_ = 0; rep_ < REPS(10); ++rep_) { PROLOG peer_route((const bf16*)WSP(WS_P), (const bf16*)WSP(WS_KEYS), (int*)WSP(WS_ST), (float*)WSP(WS_ST + 17 * MiB), gw, NGW, lane, false); }
    GRID_BAR();
#endif
    if (PH(11)) for (int rep_ = 0; rep_ < REPS(22); ++rep_) { PROLOG peer_pass1((const bf16*)WSP(WS_HB), (const int*)WSP(WS_ST), (const float*)WSP(WS_ST + 17 * MiB), WSP(WS_U), (const float*)WSP(WS_SCL), (const float*)WSP(WS_SCL) + 2 * NEXP, (float*)WSP(WS_ST + 34 * MiB), gw, NGW, lane, false); }
    if (PH(11)) for (int rep_ = 0; rep_ < REPS(11); ++rep_) { PROLOG peer_expert<(DBG_LEVEL >= 3)>((const float*)WSP(WS_ST + 34 * MiB), (const int*)WSP(WS_ST), WSP(WS_V),
        ap->out, (float*)WSP(WS_XC), (const float*)WSP(WS_MOD), ap->in[I_LNW] + 1024, ap->in[I_LNB] + 1024, gw, NGW, lane, DRYV(11), false); }
    GRID_BAR();

    if (PH(12)) for (int rep_ = 0; rep_ < REPS(12); ++rep_) { PROLOG h_phase<32>(ap->out, (const float*)WSP(WS_XC), (const float*)WSP(WS_MOD) + 9 * 6144, (bf16*)WSP(WS_HB), (const float*)WSP(WS_WLOW), (float*)WSP(WS_GL), lds, vcu, G, wave, lane, tid);
 }
    GRID_BAR();
    if (PH(13)) for (int rep_ = 0; rep_ < REPS(13); ++rep_) { PROLOG pg8::Gemm g{(const bf16*)WSP(WS_HB), (const bf16*)WSP(WS_WC), TT, N_C, 1024, 1024, 1024}; pg8::StaticOrder S; S.init(TT, N_C, G, bx);
      pg8::EpiBf16 E{(bf16*)WSP(WS_P), N_C}; pg8::gemm_phase<pg8::EpiBf16, pg8::StaticOrder>(lds, g, S, E, tid); }
    GRID_BAR();
#if DBG_LEVEL >= 2
    if (PH(14)) for (int rep_ = 0; rep_ < REPS(14); ++rep_) { PROLOG gla_prep((bf16*)WSP(WS_P), (bf16*)WSP(WS_HB), (const float*)WSP(WS_GL), ap->in[I_GGUP], ap->in[I_GGB], ws, lds, vcu, G, tid, DRYV(14)); }
    GRID_BAR();
    if (PH(15)) for (int rep_ = 0; rep_ < REPS(15); ++rep_) { PROLOG gla_fused_scan((const bf16*)WSP(WS_P), (const bf16*)WSP(WS_HB), ws, lds, vcu, G, wave, lane, tid, DRYV(15)); }
    GRID_BAR();
    if (PH(16)) for (int rep_ = 0; rep_ < REPS(16); ++rep_) { PROLOG gla_merge((bf16*)WSP(WS_P), ap->in[I_GNW], ws, gw, NGW, lane, DRYV(16)); }
    GRID_BAR();
#endif
    if (PH(17)) for (int rep_ = 0; rep_ < REPS(17); ++rep_) { PROLOG pg8::Gemm g{(const bf16*)WSP(WS_P) + 2048, (const bf16*)WSP(WS_WCO), TT, 1024, 1024, N_C, 1024}; pg8::LatOrder S; S.init(NB * SEQ, 1024, G, bx);
      pg8::EpiBf16 E{(bf16*)WSP(WS_HB), 1024}; pg8::gemm_phase<pg8::EpiBf16, pg8::LatOrder>(lds, g, S, E, tid); }
    GRID_BAR();
    if (PH(18)) for (int rep_ = 0; rep_ < REPS(18); ++rep_) { PROLOG ln_phase(ap->out, (const float*)WSP(WS_XC), ap->out, (float*)WSP(WS_XC), (const bf16*)WSP(WS_HB), (const float*)WSP(WS_MOD) + 9 * 6144, ap->in[I_LNW] + 2048, ap->in[I_LNB] + 2048, (bf16*)WSP(WS_HB), gw, NGW, lane, DRYV(18), true); }
    GRID_BAR();
#if DBG_LEVEL >= 3
    if (PH(19)) for (int rep_ = 0; rep_ < REPS(19); ++rep_) { PROLOG pg8::Gemm g{(const bf16*)WSP(WS_HB), (const bf16*)WSP(WS_WQ1), TT, 2048, 1024, 1024, 1024}; pg8::LatOrder S; S.init(NB * SEQ, 2048, G, bx);
      pg8::EpiBf16 E{(bf16*)WSP(WS_P), 2048}; pg8::gemm_phase<pg8::EpiBf16, pg8::LatOrder>(lds, g, S, E, tid); }
    GRID_BAR();
    if (PH(20)) for (int rep_ = 0; rep_ < REPS(20); ++rep_) { PROLOG peer_route((const bf16*)WSP(WS_P), (const bf16*)WSP(WS_KEYS) + (size_t)8 * 2 * 128 * 128, (int*)WSP(WS_ST), (float*)WSP(WS_ST + 17 * MiB), gw, NGW, lane, true); }
    GRID_BAR();
#endif
    if (PH(21)) for (int rep_ = 0; rep_ < REPS(22); ++rep_) { PROLOG peer_pass1((const bf16*)WSP(WS_HB), (const int*)WSP(WS_ST), (const float*)WSP(WS_ST + 17 * MiB), WSP(WS_U) + (size_t)NEXP * 768, (const float*)WSP(WS_SCL) + NEXP, (const float*)WSP(WS_SCL) + 3 * NEXP, (float*)WSP(WS_ST + 34 * MiB), gw, NGW, lane, true); }
    if (PH(21)) for (int rep_ = 0; rep_ < REPS(21); ++rep_) { PROLOG peer_expert<(DBG_LEVEL >= 3)>((const float*)WSP(WS_ST + 34 * MiB), (const int*)WSP(WS_ST), WSP(WS_V) + (size_t)NEXP * 768,
        ap->out, (float*)WSP(WS_XC), (const float*)WSP(WS_MOD) + 9 * 6144, ap->in[I_LNW] + 3072, ap->in[I_LNB] + 3072, gw, NGW, lane, DRYV(21), true); }
}

extern "C" void kernel_launch(void* const* d_in, const int* in_sizes, int n_in, void* d_out, int out_size, void* d_ws, size_t ws_size, hipStream_t stream) {
    static int grid = 0;
    if (grid == 0) {
        if (n_in != 22 || out_size != NB * SEQ * D || ws_size < 512 * MiB) { fprintf(stderr, "kernel_launch: unexpected shapes: n_in %d out %d ws %zu (need %zu)\n", n_in, out_size, ws_size, (size_t)WS_END); grid = -1; return; }
        int dev = 0, cus = 0, per_cu = 0;
        if (hipGetDevice(&dev) != hipSuccess || hipDeviceGetAttribute(&cus, hipDeviceAttributeMultiprocessorCount, dev) != hipSuccess) { grid = -1; return; }
        if (hipFuncSetAttribute((const void*)fwd_megakernel, hipFuncAttributeMaxDynamicSharedMemorySize, LDS_BYTES) != hipSuccess) { fprintf(stderr, "kernel_launch: hipFuncSetAttribute failed\n"); grid = -1; return; }
        if (hipOccupancyMaxActiveBlocksPerMultiprocessor(&per_cu, (const void*)fwd_megakernel, 512, LDS_BYTES) != hipSuccess || per_cu < 1) { fprintf(stderr, "kernel_launch: occupancy query says %d blocks per CU\n", per_cu); }
        (void)hipGetLastError();
        grid = cus;
        fprintf(stderr, "kernel_launch: grid %d, per_cu %d, ws %zu\n", grid, per_cu, ws_size);
    }
    if (grid < 0) return;
    if (hipMemsetAsync((char*)d_ws + WS_CTL, 0, CTL_ZERO_BYTES, stream) != hipSuccess) return;
    Args a{};
    for (int i = 0; i < 22; ++i) a.in[i] = (const float*)d_in[i];
    a.out = (float*)d_out; a.ws = (unsigned char*)d_ws;
    hipLaunchKernelGGL(fwd_megakernel, dim3(grid), dim3(512), LDS_BYTES, stream, a);
}
```

```cpp
#include <hip/hip_runtime.h>
#include <cstdio>
#include <cstdint>

#define GAS __attribute__((address_space(1)))
#define LAS __attribute__((address_space(3)))
typedef unsigned short bf16;
typedef unsigned v4u __attribute__((ext_vector_type(4)));
typedef unsigned v2u __attribute__((ext_vector_type(2)));
typedef float f32x4 __attribute__((ext_vector_type(4)));
typedef float f32x2 __attribute__((ext_vector_type(2)));
typedef short bf16x8 __attribute__((ext_vector_type(8)));
typedef short s16x4 __attribute__((ext_vector_type(4)));
typedef GAS unsigned gu32;
#define RLX_AGENT __ATOMIC_RELAXED, __HIP_MEMORY_SCOPE_AGENT

constexpr int NB = 8, SEQ = 4096, LC = 256, D = 1024;
constexpr int PB = LC + SEQ;
constexpr int TT = NB * PB;
constexpr int NCH = PB / 64;
constexpr int N_AB = 2816;
constexpr int N_C = 3072;
constexpr float LN_EPS = 1e-5f;
constexpr float DN_ALPHA = 1.41421356237f;
constexpr int NEXP = 16384;
__device__ __forceinline__ int map_row(int i, bool lat_only) { return lat_only ? (i >> 12) * 4352 + 256 + (i & 4095) : i; }

constexpr size_t MiB = 1u << 20;
constexpr size_t WS_CTL = 0, CTL_ZERO_BYTES = 64 * 1024;
constexpr size_t WS_MOD = 1 * MiB;
constexpr size_t WS_ROPE = 2 * MiB;
constexpr size_t WS_WG = 2 * MiB + 64 * 1024;
constexpr size_t WS_WLOW = 2 * MiB + 128 * 1024;
constexpr size_t WS_SCL = 3 * MiB;
constexpr size_t WS_BQ = 4 * MiB, WS_CQ = WS_BQ + 1200 * 1024, WS_EM = WS_CQ + 1200 * 1024, WS_AI = WS_EM + 1200 * 1024;
constexpr size_t WS_AST = WS_AI + 1200 * 1024, WS_CL = WS_AST + 32 * 1024;
constexpr size_t WS_ET = 10 * MiB;
constexpr size_t WS_GL = 13 * MiB;
constexpr size_t WS_WAB = 20 * MiB, WS_WABO = 26 * MiB, WS_WC = 28 * MiB, WS_WCO = 34 * MiB, WS_WQ0 = 36 * MiB, WS_WQ1 = 40 * MiB, WS_KEYS = 44 * MiB;
constexpr size_t WS_NST = 45 * MiB;
constexpr size_t WS_XC = 48 * MiB;
constexpr size_t WS_U = 56 * MiB, WS_V = 88 * MiB;
constexpr size_t WS_HB = 120 * MiB;
constexpr size_t WS_P = 188 * MiB;
constexpr size_t WS_ST = 392 * MiB;
constexpr size_t WS_END = 460 * MiB;

constexpr int LDS_BYTES = 163840;
constexpr int MISC_OFF = LDS_BYTES - 64;

__device__ __forceinline__ unsigned f2bf(float f) { unsigned u = __builtin_bit_cast(unsigned, f); return (u + 0x7fffu + ((u >> 16) & 1u)) >> 16; }
__device__ __forceinline__ unsigned pk2(float lo, float hi) { return f2bf(lo) | (f2bf(hi) << 16); }
__device__ __forceinline__ float bflo(unsigned w) { return __builtin_bit_cast(float, w << 16); }
__device__ __forceinline__ float bfhi(unsigned w) { return __builtin_bit_cast(float, w & 0xffff0000u); }
__device__ __forceinline__ float bf2f(bf16 b) { return __builtin_bit_cast(float, (unsigned)b << 16); }
template <int CTRL> __device__ __forceinline__ float dppmov_f(float x) { return __builtin_bit_cast(float, __builtin_amdgcn_mov_dpp(__builtin_bit_cast(int, x), CTRL, 0xf, 0xf, true)); }
__device__ __forceinline__ float wave_sum(float v) {
    v += dppmov_f<0xB1>(v); v += dppmov_f<0x4E>(v); v += dppmov_f<0x141>(v); v += dppmov_f<0x128>(v);
    v += __shfl_xor(v, 16); v += __shfl_xor(v, 32);
    return v;
}
__device__ __forceinline__ float sigmoidf_(float x) { return 1.f / (1.f + __expf(-x)); }
__device__ __forceinline__ float logsigmoidf_(float x) { return fminf(x, 0.f) - log1pf(__expf(-fabsf(x))); }
__device__ __forceinline__ float siluf_(float x) { return x / (1.f + __expf(-x)); }

namespace pg8 {
#define PG8_LAS __attribute__((address_space(3)))
typedef unsigned short bf16_t;
typedef short bf16x8 __attribute__((ext_vector_type(8)));
typedef float f32x4 __attribute__((ext_vector_type(4)));
typedef unsigned u32x4 __attribute__((ext_vector_type(4)));
constexpr int BM = 256, BK = 64, HALF = 128, HTB = HALF * BK * 2  , STAGE_BYTES = 8 * HTB, NXCD = 8, WGM = 8;

__host__ __device__ __forceinline__ int lds_byte(int r, int c) { const int st = (r >> 4) * 2 + (c >> 5), rr = r & 15, cc = c & 31, ob = rr * 64 + cc * 2; return st * 1024 + (ob ^ (((ob >> 9) & 1) << 5)); }
__host__ __device__ __forceinline__ void stage_rc(int b, int& R, int& C) { const int st = b / 1024, sb = b % 1024, swz = sb ^ (((sb >> 9) & 1) << 5); R = (st >> 1) * 16 + swz / 64; C = (st & 1) * 32 + (swz % 64) / 2; }
__host__ __device__ __forceinline__ int perm32(int rho) { const int n = rho >> 4, i = rho & 15; return 8 * (i >> 2) + 4 * n + (i & 3); }

struct Unit { int pm, pn; };
struct Gemm { const bf16_t* A; const bf16_t* Bt; int M, N, K, lda, ldb; };

struct StaticOrder {
    int nM, nN, nwg, G, c;
    __host__ __device__ void init(int M, int N, int G_, int c_) { nM = M / BM; nN = N / BM; nwg = nM * nN; G = G_; c = c_; }
    __host__ __device__ bool next(int i, Unit& u) const {
        const long L = (long)i * G + c; if (L >= nwg) return false;
        int wgid = (int)L; { const int q = nwg / NXCD, r = nwg % NXCD, xcd = wgid % NXCD, off = wgid / NXCD; wgid = (xcd < r ? xcd * (q + 1) : r * (q + 1) + (xcd - r) * q) + off; }
        const int nig = WGM * nN, gid = wgid / nig, fm = gid * WGM, gsz = (nM - fm) < WGM ? (nM - fm) : WGM;
        u.pm = fm + ((wgid % nig) % gsz); u.pn = (wgid % nig) / gsz; return true;
    }
    __device__ __forceinline__ void a_ready(const Unit&) const {}
    __device__ __forceinline__ void done(const Unit&) const {}
};

struct LatOrder : StaticOrder {
    __host__ __device__ bool next(int i, Unit& u) const { if (!StaticOrder::next(i, u)) return false; u.pm = (u.pm >> 4) * 17 + 1 + (u.pm & 15); return true; }
};
__device__ __forceinline__ unsigned cvt_pk_bf16(float lo, float hi) { unsigned r; asm volatile("v_cvt_pk_bf16_f32 %0, %1, %2" : "=v"(r) : "v"(lo), "v"(hi)); return r; }
struct EpiBf16 {
    static constexpr bool PERM = true, AFTER_DRAIN = false;
    bf16_t* O; int ldc;
    __device__ __forceinline__ void operator()(const f32x4 (&acc)[2][2][4][2], const Unit& u, int wr, int wc, int fr, int fq) const {
        const int row0 = u.pm * BM + wr * 64 + fr; const int col0 = u.pn * BM + wc * 32 + 8 * fq;
#pragma unroll
        for (int ai = 0; ai < 2; ++ai)
#pragma unroll
            for (int m = 0; m < 4; ++m) { bf16_t* rowp = O + (size_t)(row0 + ai * HALF + m * 16) * ldc + col0;
#pragma unroll
                for (int bj = 0; bj < 2; ++bj) { const f32x4 v0 = acc[ai][bj][m][0], v1 = acc[ai][bj][m][1];
                    u32x4 w; w.x = cvt_pk_bf16(v0[0], v0[1]); w.y = cvt_pk_bf16(v0[2], v0[3]); w.z = cvt_pk_bf16(v1[0], v1[1]); w.w = cvt_pk_bf16(v1[2], v1[3]);
                    *(u32x4*)(rowp + bj * HALF) = w; } }
    }
};
struct EpiResid {
    static constexpr bool PERM = false, AFTER_DRAIN = false;
    const float* src_lat; const float* src_ctx; float* dst_lat; float* dst_ctx; const float* gate; float gscale; int dry;
    __device__ __forceinline__ void operator()(const f32x4 (&acc)[2][2][4][2], const Unit& u, int wr, int wc, int fr, int fq) const {
        const int b = u.pm / 17, tb = u.pm - b * 17;
        const float* sbase; float* dbase; const float* gr;
        if (tb == 0) { sbase = src_ctx + (size_t)b * 256 * 1024; dbase = dst_ctx + (size_t)b * 256 * 1024; gr = gate + 8 * 6144; }
        else { sbase = src_lat + ((size_t)b * 4096 + (size_t)(tb - 1) * 256) * 1024; dbase = dst_lat + ((size_t)b * 4096 + (size_t)(tb - 1) * 256) * 1024; gr = gate + b * 6144; }
        const int row0 = wr * 64 + fr, col0 = u.pn * BM + wc * 32 + 4 * fq;
        f32x4 gv[2][2];
#pragma unroll
        for (int bj = 0; bj < 2; ++bj)
#pragma unroll
            for (int n = 0; n < 2; ++n) gv[bj][n] = *(const f32x4*)(gr + col0 + bj * HALF + n * 16) * gscale;
#pragma unroll
        for (int ai = 0; ai < 2; ++ai)
#pragma unroll
            for (int mp = 0; mp < 2; ++mp) {
                f32x4 sv[2][2][2];
#pragma unroll
                for (int mm = 0; mm < 2; ++mm) { const size_t off = (size_t)(row0 + ai * HALF + (2 * mp + mm) * 16) * 1024 + col0;
#pragma unroll
                    for (int bj = 0; bj < 2; ++bj)
#pragma unroll
                        for (int n = 0; n < 2; ++n) sv[mm][bj][n] = __builtin_nontemporal_load((const f32x4*)(sbase + off + bj * HALF + n * 16)); }
                asm volatile("" ::: "memory");
#pragma unroll
                for (int mm = 0; mm < 2; ++mm) { const int m = 2 * mp + mm; const size_t off = (size_t)(row0 + ai * HALF + m * 16) * 1024 + col0;
#pragma unroll
                    for (int bj = 0; bj < 2; ++bj)
#pragma unroll
                        for (int n = 0; n < 2; ++n) { const f32x4 ov = sv[mm][bj][n] * 1.41421356237f + gv[bj][n] * acc[ai][bj][m][n]; if (!dry) *(f32x4*)(dbase + off + bj * HALF + n * 16) = ov; } }
                asm volatile("" ::: "memory");
            }
    }
};

template <class Epi, class Sched>
__device__ __forceinline__ void gemm_phase(PG8_LAS unsigned char* lds, const Gemm g, const Sched& S, const Epi& E, const int tid_in) {
    const int tid = tid_in, wid = __builtin_amdgcn_readfirstlane(tid >> 6), lane = tid & 63, wr = wid >> 2, wc = wid & 3, fr = lane & 15, fq = lane >> 4;
    const int K = g.K, nt = K / BK;
    unsigned voffA[2], voffB[2];
#pragma unroll
    for (int i = 0; i < 2; ++i) { int R, C; stage_rc(tid * 16 + i * 8192, R, C); const int Rb = Epi::PERM ? ((R & ~31) + perm32(R & 31)) : R;
        voffA[i] = (unsigned)(R * g.lda + C) * 2u; voffB[i] = (unsigned)(Rb * g.ldb + C) * 2u; }
    const size_t kstep = (size_t)(BK * 2);
    const size_t hstepA = (size_t)HALF * g.lda * 2, hstepB = (size_t)HALF * g.ldb * 2;
    const size_t tstepA = 2 * hstepA, tstepB = 2 * hstepB;
    const unsigned ldsw = (unsigned)wid * 1024u;
    const int aoff = lds_byte(wr * 64 + fr, fq * 8), boff = lds_byte(wc * 32 + fr, fq * 8);
#define PG8_SA(b, h) (((b) * 2 + (h)) * HTB)
#define PG8_SB(b, h) ((4 + (b) * 2 + (h)) * HTB)
#define PG8_STAGE(bufoff, gbase, voff) do { _Pragma("unroll") for (int _i = 0; _i < 2; ++_i) \
        __builtin_amdgcn_global_load_lds((const unsigned*)((const char*)(gbase) + (voff)[_i]), (PG8_LAS unsigned*)(lds + (bufoff) + ldsw + _i * 8192), 16, 0, 0); } while (0)
#define PG8_LDA(dst, b, h) do { _Pragma("unroll") for (int m = 0; m < 4; ++m) _Pragma("unroll") for (int k = 0; k < 2; ++k) dst[m][k] = *(const PG8_LAS bf16x8*)(lds + PG8_SA(b, h) + aoff + m * 2048 + k * 1024); } while (0)
#define PG8_LDB(dst, b, h) do { _Pragma("unroll") for (int n = 0; n < 2; ++n) _Pragma("unroll") for (int k = 0; k < 2; ++k) dst[n][k] = *(const PG8_LAS bf16x8*)(lds + PG8_SB(b, h) + boff + n * 2048 + k * 1024); } while (0)
#define PG8_MMA(ai, bj, At, Bt) do { __builtin_amdgcn_s_setprio(1); _Pragma("unroll") for (int m = 0; m < 4; ++m) _Pragma("unroll") for (int n = 0; n < 2; ++n) _Pragma("unroll") for (int k = 0; k < 2; ++k) \
        acc[ai][bj][m][n] = __builtin_amdgcn_mfma_f32_16x16x32_bf16(Bt[n][k], At[m][k], acc[ai][bj][m][n], 0, 0, 0); __builtin_amdgcn_s_setprio(0); } while (0)
#define PG8_WAIT_V(n) asm volatile("s_waitcnt vmcnt(" #n ")" ::: "memory")
#define PG8_WAIT_L(n) asm volatile("s_waitcnt lgkmcnt(" #n ")" ::: "memory")
#define PG8_BAR __builtin_amdgcn_s_barrier()
#define PG8_SCHED __builtin_amdgcn_sched_barrier(0)
    Unit cur, nxt; int ui = 0;
    if (!S.next(0, cur)) return;
    f32x4 acc[2][2][4][2];
#pragma unroll
    for (int a = 0; a < 2; ++a)
#pragma unroll
        for (int b = 0; b < 2; ++b)
#pragma unroll
            for (int m = 0; m < 4; ++m)
#pragma unroll
                for (int n = 0; n < 2; ++n) acc[a][b][m][n] = (f32x4){0.f, 0.f, 0.f, 0.f};
    bf16x8 At[4][2], B0[2][2], B1[2][2];
    const char* cA = (const char*)g.A + (size_t)cur.pm * tstepA; const char* cB = (const char*)g.Bt + (size_t)cur.pn * tstepB;
    S.a_ready(cur);
    PG8_STAGE(PG8_SB(0, 0), cB, voffB); PG8_STAGE(PG8_SA(0, 0), cA, voffA); PG8_STAGE(PG8_SB(0, 1), cB + hstepB, voffB); PG8_STAGE(PG8_SA(0, 1), cA + hstepA, voffA);
    if (wr == 1) PG8_BAR;
    PG8_WAIT_V(4); PG8_BAR;
    PG8_STAGE(PG8_SB(1, 0), cB + kstep, voffB); PG8_STAGE(PG8_SA(1, 0), cA + kstep, voffA); PG8_STAGE(PG8_SB(1, 1), cB + hstepB + kstep, voffB);
    PG8_WAIT_V(6); PG8_BAR;
    for (;;) {
        const bool has_next = S.next(ui + 1, nxt);
        const char* nA = has_next ? (const char*)g.A + (size_t)nxt.pm * tstepA : cA; const char* nB = has_next ? (const char*)g.Bt + (size_t)nxt.pn * tstepB : cB;
        for (int t = 0; t < nt; t += 2) {
            const bool last = (t == nt - 2);
            const char* a1 = cA + (size_t)(t + 1) * kstep;
            const char* a2 = last ? nA : cA + (size_t)(t + 2) * kstep; const char* b2 = last ? nB : cB + (size_t)(t + 2) * kstep;
            const char* a3 = a2 + kstep; const char* b3 = b2 + kstep;
            if (last && has_next) S.a_ready(nxt);
            PG8_LDB(B0, 0, 0); PG8_SCHED; PG8_LDA(At, 0, 0); PG8_STAGE(PG8_SA(1, 1), a1 + hstepA, voffA);
            PG8_WAIT_L(8); PG8_BAR; PG8_WAIT_L(0); PG8_MMA(0, 0, At, B0); PG8_BAR; PG8_SCHED;
            PG8_LDB(B1, 0, 1); PG8_STAGE(PG8_SB(0, 0), b2, voffB);
            PG8_BAR; PG8_WAIT_L(0); PG8_MMA(0, 1, At, B1); PG8_BAR;
            PG8_LDA(At, 0, 1); PG8_STAGE(PG8_SA(0, 0), a2, voffA);
            PG8_BAR; PG8_WAIT_L(0); PG8_MMA(1, 0, At, B0); PG8_BAR; PG8_SCHED;
            PG8_STAGE(PG8_SB(0, 1), b2 + hstepB, voffB);
            PG8_WAIT_V(6); PG8_BAR; PG8_MMA(1, 1, At, B1); PG8_BAR;
            PG8_LDB(B0, 1, 0); PG8_SCHED; PG8_LDA(At, 1, 0); PG8_STAGE(PG8_SA(0, 1), a2 + hstepA, voffA);
            PG8_WAIT_L(8); PG8_BAR; PG8_WAIT_L(0); PG8_MMA(0, 0, At, B0); PG8_BAR; PG8_SCHED;
            PG8_LDB(B1, 1, 1); PG8_STAGE(PG8_SB(1, 0), b3, voffB);
            PG8_BAR; PG8_WAIT_L(0); PG8_MMA(0, 1, At, B1); PG8_BAR;
            PG8_LDA(At, 1, 1); PG8_STAGE(PG8_SA(1, 0), a3, voffA);
            PG8_BAR; PG8_WAIT_L(0); PG8_MMA(1, 0, At, B0); PG8_BAR; PG8_SCHED;
            PG8_STAGE(PG8_SB(1, 1), b3 + hstepB, voffB);
            PG8_WAIT_V(6); PG8_BAR; PG8_MMA(1, 1, At, B1); PG8_BAR;
        }
        if constexpr (!Epi::AFTER_DRAIN) { E(acc, cur, wr, wc, fr, fq); S.done(cur); }
        if (!has_next) break;
#pragma unroll
        for (int a = 0; a < 2; ++a)
#pragma unroll
            for (int b = 0; b < 2; ++b)
#pragma unroll
                for (int m = 0; m < 4; ++m)
#pragma unroll
                    for (int n = 0; n < 2; ++n) acc[a][b][m][n] = (f32x4){0.f, 0.f, 0.f, 0.f};
        cur = nxt; cA = nA; cB = nB; ++ui;
    }
    PG8_WAIT_V(0);
    if (wr == 0) PG8_BAR;
    PG8_BAR;
    if constexpr (Epi::AFTER_DRAIN) { E.fused(acc, cur, wr, wc, fr, fq, lds, wid, lane); S.done(cur); }
#undef PG8_SA
#undef PG8_SB
#undef PG8_STAGE
#undef PG8_LDA
#undef PG8_LDB
#undef PG8_MMA
#undef PG8_WAIT_V
#undef PG8_WAIT_L
#undef PG8_BAR
#undef PG8_SCHED
}
}

#define XB_TMO      128
#define XB_XCNT(j)  (256  + 64 * (j))
#define XB_XSUB(j)  (1280 + 64 * (j))
#define XB_XGEN(j)  (2304 + 64 * (j))
#define XB_TOP      3328
#define XB_TOPGEN   3392
#define XCD_BAR_WORDS 3456
#define XB_SPIN_CAP (1u << 18)

__device__ __forceinline__ unsigned xb_ld(unsigned* p)              { return __hip_atomic_load(p, __ATOMIC_RELAXED, __HIP_MEMORY_SCOPE_AGENT); }
__device__ __forceinline__ unsigned xb_add(unsigned* p, unsigned v) { return __hip_atomic_fetch_add(p, v, __ATOMIC_RELAXED, __HIP_MEMORY_SCOPE_AGENT); }
__device__ __forceinline__ unsigned xb_xcc_id() { return (unsigned)__builtin_amdgcn_s_getreg((3 << 11) | 20) & 0xFu; }
#define XB_SPIN(cond, bar) do { unsigned _sp = 0; while (cond) { __builtin_amdgcn_s_sleep(1); \
    if ((++_sp & 255u) == 0u) { if (xb_ld(&(bar)[XB_TMO])) break; if (_sp > XB_SPIN_CAP) { atomicAdd(&(bar)[XB_TMO], 1u); break; } } } } while (0)

struct XcdBarrier {
    unsigned* bar; unsigned x;
    volatile LAS unsigned* st;
};

__device__ __forceinline__ XcdBarrier xcd_barrier_post(unsigned* bar, volatile LAS unsigned* st) {
    XcdBarrier b; b.bar = bar; b.x = xb_xcc_id(); b.st = st;
    if (threadIdx.x == 0) (void)xb_add(&bar[XB_XCNT(b.x)], 1u);
    return b;
}
__device__ __forceinline__ void xcd_barrier_complete(unsigned* bar, unsigned x, unsigned& nloc, unsigned& nx) {
    const unsigned G = gridDim.x * gridDim.y * gridDim.z;
    unsigned sum, cnt, mine, sp = 0u;
    for (;;) {
        sum = 0u; cnt = 0u; mine = 0u;
#pragma unroll
        for (unsigned j = 0; j < 16; ++j) { const unsigned c = xb_ld(&bar[XB_XCNT(j)]); sum += c; cnt += (c > 0u) ? 1u : 0u; mine = (j == x) ? c : mine; }
        if (sum == G) break;
        __builtin_amdgcn_s_sleep(1);
        if ((++sp & 255u) == 0u) { if (xb_ld(&bar[XB_TMO])) break; if (sp > XB_SPIN_CAP) { atomicAdd(&bar[XB_TMO], 1u); break; } }
    }
    nloc = mine > 0u ? mine : 1u; nx = cnt > 0u ? cnt : 1u;
}

__device__ __forceinline__ void xcd_barrier(const XcdBarrier& b) {
    asm volatile("s_waitcnt vmcnt(0)" ::: "memory");
    __syncthreads();
    if (threadIdx.x == 0) {
        unsigned* bar = b.bar;
        __builtin_amdgcn_s_waitcnt(0);
        unsigned nloc = b.st[0], nx = b.st[1];
        if (nloc == 0u) { xcd_barrier_complete(bar, b.x, nloc, nx); b.st[0] = nloc; b.st[1] = nx; }
        const unsigned old = xb_add(&bar[XB_XSUB(b.x)], 1u);
        const unsigned gen = old / nloc;
        if (old + 1u == (gen + 1u) * nloc) {
            __builtin_amdgcn_fence(__ATOMIC_RELEASE, "agent");
            asm volatile("s_waitcnt vmcnt(0)" ::: "memory");
            const unsigned og = xb_add(&bar[XB_TOP], 1u);
            const unsigned tg = og / nx;
            if (og + 1u == (tg + 1u) * nx) xb_add(&bar[XB_TOPGEN], 1u);
            else XB_SPIN(xb_ld(&bar[XB_TOPGEN]) == tg, bar);
            __builtin_amdgcn_fence(__ATOMIC_ACQUIRE, "agent");
            xb_add(&bar[XB_XGEN(b.x)], 1u);
            asm volatile("s_waitcnt vmcnt(0)" ::: "memory");
        } else {
            XB_SPIN(xb_ld(&bar[XB_XGEN(b.x)]) == gen, bar);
            __builtin_amdgcn_fence(__ATOMIC_ACQUIRE, "agent");
            asm volatile("s_waitcnt vmcnt(0)" ::: "memory");
        }
    }
    __syncthreads();
}


__device__ __forceinline__ f32x4 mma(bf16x8 a, bf16x8 b, f32x4 c) { return __builtin_amdgcn_mfma_f32_16x16x32_bf16(a, b, c, 0, 0, 0); }
__device__ __forceinline__ bf16x8 frag_row(const LAS bf16* t, int ld, int r0, int c0, int lane) {
    return *(const LAS bf16x8*)(t + (r0 + (lane & 15)) * ld + c0 + 8 * (lane >> 4));
}
__device__ __forceinline__ bf16x8 frag_tr(const LAS bf16* t, int ld, int r0, int c0, int lane) {
    const int g = lane >> 4, q = (lane & 15) >> 2, p = lane & 3;
    const LAS bf16* a = t + (r0 + 8 * g + q) * ld + c0 + 4 * p;
    const s16x4 lo = __builtin_amdgcn_ds_read_tr16_b64_v4i16((LAS s16x4*)a);
    const s16x4 hi = __builtin_amdgcn_ds_read_tr16_b64_v4i16((LAS s16x4*)(a + 4 * ld));
    return (bf16x8){lo[0], lo[1], lo[2], lo[3], hi[0], hi[1], hi[2], hi[3]};
}
#define LDS_FENCE() do { asm volatile("s_waitcnt lgkmcnt(0)" ::: "memory"); __builtin_amdgcn_wave_barrier(); } while (0)

struct Args {
    const float* in[22]; float* out; unsigned char* ws;
};
enum { I_X = 0, I_C, I_CTX, I_CCTX, I_WMOD, I_BMOD, I_LNW, I_LNB, I_ABWIN, I_ABGB, I_ABNW, I_ABSINK, I_ABWOUT, I_GWIN, I_GGUP, I_GGB, I_GNW, I_GWOUT, I_PWQ, I_PKEYS, I_PU, I_PV };

__device__ __forceinline__ const float* srow_c(const float* lat, const float* ctx, int r) { const int b = r / PB, p = r - b * PB; return p < LC ? ctx + (size_t)(b * LC + p) * D : lat + (size_t)(b * SEQ + p - LC) * D; }
__device__ __forceinline__ float* srow(float* lat, float* ctx, int r) { const int b = r / PB, p = r - b * PB; return p < LC ? ctx + (size_t)(b * LC + p) * D : lat + (size_t)(b * SEQ + p - LC) * D; }

__device__ __forceinline__ void p0_transpose_item(const float* W, int K, int ldw, int c0, int ncols, bf16* WT, int row_off, LAS float* scr, int item, int lane,
                                                  int s0lo, int s0hi, float s0, int s1lo, int s1hi, float s1) {
    const int nblk = ncols / 32, kb = item / nblk, nb = item % nblk, k0 = 64 * kb, n0 = 32 * nb;
#pragma unroll 8
    for (int i = 0; i < 32; ++i) { const int kk = 2 * i + (lane >> 5); scr[kk * 33 + (lane & 31)] = W[(size_t)(k0 + kk) * ldw + c0 + n0 + (lane & 31)]; }
    asm volatile("s_waitcnt lgkmcnt(0)" ::: "memory");
    const int c = lane & 7;
#pragma unroll
    for (int j = 0; j < 4; ++j) { const int n = (lane >> 3) + 8 * j; const LAS float* s = scr + (8 * c) * 33 + n;
        const int dr = row_off + n0 + n; float sc = 1.f; if (dr >= s0lo && dr < s0hi) sc = s0; if (dr >= s1lo && dr < s1hi) sc = s1;
        v4u o; o.x = pk2(s[0 * 33] * sc, s[1 * 33] * sc); o.y = pk2(s[2 * 33] * sc, s[3 * 33] * sc); o.z = pk2(s[4 * 33] * sc, s[5 * 33] * sc); o.w = pk2(s[6 * 33] * sc, s[7 * 33] * sc);
        *(v4u*)(WT + (size_t)dr * K + k0 + 8 * c) = o; }
    asm volatile("s_waitcnt lgkmcnt(0)" ::: "memory");
}
__device__ __forceinline__ void cvt_f32_bf16(const float* src, bf16* dst, size_t n, int gtid, int gthreads) {
    const size_t nch = n / 8;
    for (size_t i = gtid; i < nch; i += gthreads) { const f32x4 a = *(const f32x4*)(src + i * 8), b = *(const f32x4*)(src + i * 8 + 4);
        v4u o; o.x = pk2(a[0], a[1]); o.y = pk2(a[2], a[3]); o.z = pk2(b[0], b[1]); o.w = pk2(b[2], b[3]); *(v4u*)(dst + i * 8) = o; }
}
typedef float v16f __attribute__((ext_vector_type(16)));
typedef float v32f __attribute__((ext_vector_type(32)));
typedef unsigned v6u __attribute__((ext_vector_type(6)));
typedef unsigned v3u __attribute__((ext_vector_type(3)));
__device__ __forceinline__ void cvt_rows_fp6(const float* src, unsigned char* dst, float* inv, int nrows, int gw, int NGW, int lane) {
    const int hl = lane & 31, hh = lane >> 5;
    for (int r2 = gw; r2 < nrows / 2; r2 += NGW) {
        const int r = 2 * r2 + hh; const float* sp = src + (size_t)r * 1024 + 32 * hl;
        f32x4 x[8]; float m = 0.f;
#pragma unroll
        for (int q = 0; q < 8; ++q) { x[q] = *(const f32x4*)(sp + 4 * q); m = fmaxf(m, fmaxf(fmaxf(fabsf(x[q][0]), fabsf(x[q][1])), fmaxf(fabsf(x[q][2]), fabsf(x[q][3])))); }
        m = fmaxf(m, dppmov_f<0xB1>(m)); m = fmaxf(m, dppmov_f<0x4E>(m)); m = fmaxf(m, dppmov_f<0x141>(m)); m = fmaxf(m, dppmov_f<0x128>(m)); m = fmaxf(m, __shfl_xor(m, 16));
        const float sc = m > 0.f ? 7.0f / m : 1.f;
        v16f a, b;
#pragma unroll
        for (int q = 0; q < 8; ++q) { a[2 * q] = x[q][0] * sc; b[2 * q] = x[q][1] * sc; a[2 * q + 1] = x[q][2] * sc; b[2 * q + 1] = x[q][3] * sc; }
        const v6u p = __builtin_amdgcn_cvt_scalef32_2xpk16_fp6_f32(a, b, 1.0f);
        unsigned char* dp = dst + (size_t)r * 768 + 24 * hl;
        *(v2u*)dp = (v2u){p[0], p[1]}; *(v2u*)(dp + 8) = (v2u){p[2], p[3]}; *(v2u*)(dp + 16) = (v2u){p[4], p[5]};
        if (hl == 0) inv[r] = m > 0.f ? m / 7.0f : 1.f;
    }
}
__device__ __forceinline__ void p0_prologue(const Args& A, LAS unsigned char* lds, int vcu, int G, int wave, int lane, int tid) {
    unsigned char* ws = A.ws;
    const int gw = vcu * 8 + wave, NGW = G * 8, gtid = vcu * 512 + tid, gthreads = G * 512;
    LAS float* sil = (LAS float*)lds;
    for (int i = tid; i < 9 * 1024; i += 512) { const float v = i < 8192 ? A.in[I_C][i] : A.in[I_CCTX][i - 8192]; sil[i] = siluf_(v); }
    __syncthreads();
    float* MOD = (float*)(ws + WS_MOD);
    LAS float* part = (LAS float*)(lds + 40960);
    for (int it = vcu; it < 2 * 96; it += G) {
        const int l = it / 96, n = (it % 96) * 64 + lane; const float* wm = A.in[I_WMOD] + (size_t)l * 1024 * 6144 + (size_t)(128 * wave) * 6144 + n;
        float acc[9];
#pragma unroll
        for (int r = 0; r < 9; ++r) acc[r] = 0.f;
#pragma unroll 8
        for (int k = 0; k < 128; ++k) { const float w = wm[(size_t)k * 6144];
#pragma unroll
            for (int r = 0; r < 9; ++r) acc[r] += sil[r * 1024 + 128 * wave + k] * w; }
        __syncthreads();
#pragma unroll
        for (int r = 0; r < 9; ++r) part[(wave * 9 + r) * 64 + lane] = acc[r];
        __syncthreads();
        for (int i = tid; i < 9 * 64; i += 512) { float sum = 0.f;
#pragma unroll
            for (int w8 = 0; w8 < 8; ++w8) sum += part[w8 * 576 + i];
            const int r = i >> 6, c = (it % 96) * 64 + (i & 63); MOD[(size_t)(l * 9 + r) * 6144 + c] = sum + A.in[I_BMOD][l * 6144 + c]; }
    }
    __syncthreads();
    LAS float* scr = (LAS float*)(lds + 40960 + wave * 8704);
    constexpr int I_AB1 = 16 * 64, I_AB2 = 16 * 24, I_ABO = 16 * 32, I_C1 = 16 * 96, I_CO = 16 * 32, I_Q = 16 * 64;
    constexpr int NITEMS = I_AB1 + I_AB2 + I_ABO + I_C1 + I_CO + 2 * I_Q;
    const float rs128 = 0.08838834764831845f;
    for (int it = gw; it < NITEMS; it += NGW) {
        int r = it;
        if (r < I_AB1) { p0_transpose_item(A.in[I_ABWIN], 1024, 2832, 0, 2048, (bf16*)(ws + WS_WAB), 0, scr, r, lane, 512, 1024, rs128, 0, 0, 1.f); continue; } r -= I_AB1;
        if (r < I_AB2) { p0_transpose_item(A.in[I_ABWIN], 1024, 2832, 2064, 768, (bf16*)(ws + WS_WAB), 2048, scr, r, lane, 2048, 2560, 0.125f, 0, 0, 1.f); continue; } r -= I_AB2;
        if (r < I_ABO) { p0_transpose_item(A.in[I_ABWOUT], 1024, 1024, 0, 1024, (bf16*)(ws + WS_WABO), 0, scr, r, lane, 0, 0, 1.f, 0, 0, 1.f); continue; } r -= I_ABO;
        if (r < I_C1) { p0_transpose_item(A.in[I_GWIN], 1024, 3104, 0, 3072, (bf16*)(ws + WS_WC), 0, scr, r, lane, 0, 512, rs128, 0, 0, 1.f); continue; } r -= I_C1;
        if (r < I_CO) { p0_transpose_item(A.in[I_GWOUT], 1024, 1024, 0, 1024, (bf16*)(ws + WS_WCO), 0, scr, r, lane, 0, 0, 1.f, 0, 0, 1.f); continue; } r -= I_CO;
        if (r < I_Q) { p0_transpose_item(A.in[I_PWQ], 1024, 2048, 0, 2048, (bf16*)(ws + WS_WQ0), 0, scr, r, lane, 0, 0, 1.f, 0, 0, 1.f); continue; } r -= I_Q;
        p0_transpose_item(A.in[I_PWQ] + (size_t)1024 * 2048, 1024, 2048, 0, 2048, (bf16*)(ws + WS_WQ1), 0, scr, r, lane, 0, 0, 1.f, 0, 0, 1.f);
    }
    for (int i = gtid; i < 16 * 1024; i += gthreads) { const int g = i >> 10, k = i & 1023; ((float*)(ws + WS_WG))[i] = A.in[I_ABWIN][(size_t)k * 2832 + 2048 + g]; }
    for (int i = gtid; i < 32 * 1024; i += gthreads) { const int g = i >> 10, k = i & 1023; ((float*)(ws + WS_WLOW))[i] = A.in[I_GWIN][(size_t)k * 3104 + 3072 + g]; }
    for (int i = gtid; i < 64 * 16; i += gthreads) { const int pos = i >> 4, f = i & 15; const float inv = powf(10000.f, -(float)f / 16.f); const float ang = (float)pos * inv;
        ((float*)(ws + WS_ROPE))[2 * i] = cosf(ang); ((float*)(ws + WS_ROPE))[2 * i + 1] = sinf(ang); }
    cvt_f32_bf16(A.in[I_PKEYS], (bf16*)(ws + WS_KEYS), (size_t)2 * 8 * 2 * 128 * 128, gtid, gthreads);
    cvt_rows_fp6(A.in[I_PU], ws + WS_U, (float*)(ws + WS_SCL), 2 * NEXP, gw, NGW, lane);
    cvt_rows_fp6(A.in[I_PV], ws + WS_V, (float*)(ws + WS_SCL) + 2 * NEXP, 2 * NEXP, gw, NGW, lane);
}

__device__ __forceinline__ void split8(const float* v, bf16x8& hi, bf16x8& lo) {
#pragma unroll
    for (int j = 0; j < 8; ++j) { const unsigned h = f2bf(v[j]); const float hf = __builtin_bit_cast(float, h << 16); hi[j] = (short)h; lo[j] = (short)f2bf(v[j] - hf); }
}
template <int NG>
__device__ __forceinline__ void h_phase(const float* lat, const float* ctx, const float* mod  , bf16* HB, const float* WGT, float* GL, LAS unsigned char* lds, int vcu, int G, int wave, int lane, int tid) {
    constexpr int NT = NG / 16;
    LAS float* part = (LAS float*)lds;
    const int g = lane >> 4, c16 = lane & 15;
    bf16x8 bhi[NT][4], blo[NT][4];
#pragma unroll
    for (int nt = 0; nt < NT; ++nt)
#pragma unroll
        for (int ks = 0; ks < 4; ++ks) { const float* wp = WGT + (size_t)(16 * nt + c16) * 1024 + 128 * wave + 32 * ks + 8 * g;
            const f32x4 w0 = *(const f32x4*)wp, w1 = *(const f32x4*)(wp + 4); const float wv[8] = {w0[0], w0[1], w0[2], w0[3], w1[0], w1[1], w1[2], w1[3]}; split8(wv, bhi[nt][ks], blo[nt][ks]); }
    for (int tile = vcu; tile < TT / 16; tile += G) {
        const int r0 = tile * 16, b = r0 / PB, p0 = r0 - b * PB; const float* mr = mod + (size_t)(p0 < LC ? 8 : b) * 6144 + 128 * wave + 8 * g;
        const int row = r0 + c16; const float* xr = srow_c(lat, ctx, row) + 128 * wave + 8 * g;
        f32x4 xa[4][2], sha[4][2], sca[4][2];
#pragma unroll
        for (int ks = 0; ks < 4; ++ks)
#pragma unroll
            for (int q = 0; q < 2; ++q) { xa[ks][q] = *(const f32x4*)(xr + 32 * ks + 4 * q); sha[ks][q] = *(const f32x4*)(mr + 32 * ks + 4 * q); sca[ks][q] = *(const f32x4*)(mr + 1024 + 32 * ks + 4 * q); }
        f32x4 acc[NT];
#pragma unroll
        for (int nt = 0; nt < NT; ++nt) acc[nt] = (f32x4){0.f, 0.f, 0.f, 0.f};
#pragma unroll
        for (int ks = 0; ks < 4; ++ks) {
            float hv[8];
#pragma unroll
            for (int q = 0; q < 2; ++q)
#pragma unroll
                for (int i = 0; i < 4; ++i) hv[4 * q + i] = xa[ks][q][i] * (sca[ks][q][i] + 1.0f) + sha[ks][q][i];
            bf16x8 ahi, alo; split8(hv, ahi, alo);
            *(bf16x8*)(HB + (size_t)row * D + 128 * wave + 32 * ks + 8 * g) = ahi;
#pragma unroll
            for (int nt = 0; nt < NT; ++nt) { acc[nt] = mma(ahi, bhi[nt][ks], acc[nt]); acc[nt] = mma(ahi, blo[nt][ks], acc[nt]); acc[nt] = mma(alo, bhi[nt][ks], acc[nt]); }
        }
        __syncthreads();
#pragma unroll
        for (int nt = 0; nt < NT; ++nt)
#pragma unroll
            for (int r = 0; r < 4; ++r) part[(wave * 16 + 4 * g + r) * NG + 16 * nt + c16] = acc[nt][r];
        __syncthreads();
        for (int i = tid; i < 16 * NG; i += 512) { float sum = 0.f;
#pragma unroll
            for (int w8 = 0; w8 < 8; ++w8) sum += part[w8 * 16 * NG + i];
            GL[(size_t)r0 * NG + i] = sum; }
    }
}

__device__ __forceinline__ void ln_row(const float* sr, float* xr, const bf16* yrow, const float* mr, const float* lnw, const float* lnb, bf16* hrow, int lane, int dry, bool active) {
    f32x4 v[4]; float s = 0.f;
#pragma unroll
    for (int j = 0; j < 4; ++j) { const int c = 4 * lane + 256 * j; const f32x4 x = *(const f32x4*)(sr + c), g1 = *(const f32x4*)(mr + 2048 + c); const v2u yw = *(const v2u*)(yrow + c);
        v[j][0] = DN_ALPHA * x[0] + g1[0] * bflo(yw.x); v[j][1] = DN_ALPHA * x[1] + g1[1] * bfhi(yw.x); v[j][2] = DN_ALPHA * x[2] + g1[2] * bflo(yw.y); v[j][3] = DN_ALPHA * x[3] + g1[3] * bfhi(yw.y);
        s += (v[j][0] + v[j][1]) + (v[j][2] + v[j][3]); }
    const float mean = wave_sum(s) * (1.f / D); float s2 = 0.f;
#pragma unroll
    for (int j = 0; j < 4; ++j) { v[j] = v[j] - mean; s2 += (v[j][0] * v[j][0] + v[j][1] * v[j][1]) + (v[j][2] * v[j][2] + v[j][3] * v[j][3]); }
    const float rstd = 1.f / sqrtf(wave_sum(s2) * (1.f / D) + LN_EPS);
    if (active) {
#pragma unroll
    for (int j = 0; j < 4; ++j) { const int c = 4 * lane + 256 * j; const f32x4 w = *(const f32x4*)(lnw + c), bb = *(const f32x4*)(lnb + c);
        const f32x4 x1 = v[j] * rstd * w + bb; if (!dry) *(f32x4*)(xr + c) = x1;
        const f32x4 sh = *(const f32x4*)(mr + 3072 + c), sc = *(const f32x4*)(mr + 4096 + c); const f32x4 hp = x1 * (sc + 1.0f) + sh;
        v2u o; o.x = pk2(hp[0], hp[1]); o.y = pk2(hp[2], hp[3]); if (!dry) *(v2u*)(hrow + c) = o; }
    }
}
__device__ __forceinline__ void ln_phase(const float* slat, const float* sctx, float* lat, float* ctx, const bf16* Y, const float* mod, const float* lnw, const float* lnb, bf16* HB, int gw, int NGW, int lane, int dry, bool lat_only) {
    const int nrows = lat_only ? NB * SEQ : TT;
    for (int i0 = gw; i0 < nrows; i0 += 2 * NGW) {
        const int i1 = i0 + NGW; const bool has1 = i1 < nrows; const int r0 = map_row(i0, lat_only), r1c = map_row(has1 ? i1 : i0, lat_only);
        const int b0 = r0 / PB, p0 = r0 - b0 * PB, b1 = r1c / PB, p1 = r1c - b1 * PB;
        ln_row(srow_c(slat, sctx, r0), srow(lat, ctx, r0), Y + (size_t)r0 * D, mod + (size_t)(p0 < LC ? 8 : b0) * 6144, lnw, lnb, HB + (size_t)r0 * D, lane, dry, true);
        ln_row(srow_c(slat, sctx, r1c), srow(lat, ctx, r1c), Y + (size_t)r1c * D, mod + (size_t)(p1 < LC ? 8 : b1) * 6144, lnw, lnb, HB + (size_t)r1c * D, lane, dry, has1);
    }
}

constexpr int AT_LD = 72;
__device__ __forceinline__ bf16x8 frag_tr_perm(const LAS bf16* t, int ld, int r0, int c0, int lane) {
    const int g = lane >> 4, q = (lane & 15) >> 2, p = lane & 3;
    const LAS bf16* a = t + (r0 + 4 * g + q) * ld + c0 + 4 * p;
    const s16x4 lo = __builtin_amdgcn_ds_read_tr16_b64_v4i16((LAS s16x4*)a);
    const s16x4 hi = __builtin_amdgcn_ds_read_tr16_b64_v4i16((LAS s16x4*)(a + 16 * ld));
    return (bf16x8){lo[0], lo[1], lo[2], lo[3], hi[0], hi[1], hi[2], hi[3]};
}
__device__ __forceinline__ void attn_phase(const bf16* P, bf16* CAT, const float* sink, const float* ropetab, LAS unsigned char* lds, unsigned* qctr, int vcu, int G, int wave, int lane, int tid) {
    LAS bf16* Kt = (LAS bf16*)lds;
    LAS bf16* Vt = (LAS bf16*)(lds + 9216);
    LAS bf16* Qw = (LAS bf16*)(lds + 18432 + wave * 4608);
    const int g = lane >> 4, c16 = lane & 15;
    volatile LAS int* qslot = (volatile LAS int*)(lds + MISC_OFF) + 12;
    for (;;) {
        if (tid == 0) *qslot = (int)__hip_atomic_fetch_add(qctr, 1u, __ATOMIC_RELAXED, __HIP_MEMORY_SCOPE_AGENT);
        __syncthreads();
        const int item = *qslot;
        if (item >= 1024 + 64) break;
        const bool is_ctx = item >= 1024;
        int b, hk, nb;
        if (!is_ctx) { b = item >> 7; hk = (item >> 6) & 1; nb = item & 63; } else { const int it = item - 1024; b = it >> 3; hk = (it >> 2) & 1; nb = it & 3; }
        const int head = hk * 4 + (wave >> 1);
        const int qrow0 = b * PB + (is_ctx ? 0 : LC) + nb * 64 + (wave & 1) * 32;
        const int qlat0 = nb * 64 + (wave & 1) * 32;
        __syncthreads();
#pragma unroll
        for (int i = 0; i < 4; ++i) { const int cidx = lane + 64 * i, rr = cidx >> 3, ch = cidx & 7;
            const v4u raw = *(const v4u*)(P + (size_t)(qrow0 + rr) * N_AB + 2048 + head * 64 + ch * 8); v4u o = raw;
            if (!is_ctx) { const int tl = qlat0 + rr; const int pos = (ch < 4) ? (tl >> 6) : (tl & 63); const float* tb = ropetab + (size_t)(pos * 16 + (ch & 3) * 4) * 2;
                const unsigned wv[4] = {raw.x, raw.y, raw.z, raw.w}; unsigned ov[4];
#pragma unroll
                for (int k = 0; k < 4; ++k) { const float x1 = bflo(wv[k]), x2 = bfhi(wv[k]), c = tb[2 * k], s = tb[2 * k + 1]; ov[k] = pk2(x1 * c - x2 * s, x1 * s + x2 * c); }
                o.x = ov[0]; o.y = ov[1]; o.z = ov[2]; o.w = ov[3]; }
            *(LAS v4u*)(Qw + rr * AT_LD + ch * 8) = o; }
        LDS_FENCE();
        bf16x8 qf[2][2];
#pragma unroll
        for (int mt = 0; mt < 2; ++mt)
#pragma unroll
            for (int ks = 0; ks < 2; ++ks) qf[mt][ks] = frag_row(Qw, AT_LD, 16 * mt, 32 * ks, lane);
        LDS_FENCE();
        f32x4 o[2][4]; float mrun[2], lrun[2];
        const float sk = sink[head];
#pragma unroll
        for (int qt = 0; qt < 2; ++qt) { mrun[qt] = sk; lrun[qt] = 1.f; }
#pragma unroll
        for (int qt = 0; qt < 2; ++qt)
#pragma unroll
            for (int nt = 0; nt < 4; ++nt) o[qt][nt] = (f32x4){0.f, 0.f, 0.f, 0.f};
        const int nkt = is_ctx ? 4 : 9;
        const int srr = tid >> 3, sch = tid & 7;
        int kt = 0; f32x2 trope[4];
#pragma unroll
        for (int i = 0; i < 4; ++i) trope[i] = (f32x2){1.f, 0.f};
        v4u kraw = *(const v4u*)(P + (size_t)(b * PB + srr) * N_AB + 2560 + hk * 64 + sch * 8), vraw = *(const v4u*)(P + (size_t)(b * PB + srr) * N_AB + 2688 + hk * 64 + sch * 8);
        while (kt < nkt) {
            const int kp0 = nb * 64 - 128 + 64 * (kt - 4);
            int kn = kt + 1;
            while (kn < nkt && kn >= 4 && ((nb * 64 - 128 + 64 * (kn - 4)) < 0 || (nb * 64 - 128 + 64 * (kn - 4)) >= SEQ)) ++kn;
            __syncthreads();
            { v4u o = kraw;
              if (kt >= 4) { const unsigned wv[4] = {kraw.x, kraw.y, kraw.z, kraw.w}; unsigned ov[4];
#pragma unroll
                  for (int i = 0; i < 4; ++i) { const float x1 = bflo(wv[i]), x2 = bfhi(wv[i]), c = trope[i][0], sn = trope[i][1]; ov[i] = pk2(x1 * c - x2 * sn, x1 * sn + x2 * c); }
                  o.x = ov[0]; o.y = ov[1]; o.z = ov[2]; o.w = ov[3]; }
              *(LAS v4u*)(Kt + srr * AT_LD + sch * 8) = o; *(LAS v4u*)(Vt + srr * AT_LD + sch * 8) = vraw; }
            if (kn < nkt) { const int kpn = nb * 64 - 128 + 64 * (kn - 4); const int krn = b * PB + (kn < 4 ? 64 * kn : LC + kpn);
                kraw = *(const v4u*)(P + (size_t)(krn + srr) * N_AB + 2560 + hk * 64 + sch * 8); vraw = *(const v4u*)(P + (size_t)(krn + srr) * N_AB + 2688 + hk * 64 + sch * 8);
                if (kn >= 4) { const int tl = kpn + srr; const int pos = (sch < 4) ? (tl >> 6) : (tl & 63); const f32x2* tb = (const f32x2*)(ropetab + (size_t)(pos * 16 + (sch & 3) * 4) * 2);
#pragma unroll
                    for (int i = 0; i < 4; ++i) trope[i] = tb[i]; } }
            __syncthreads();
            const bool need_mask = (kt == 4) || (kt == 8);
            bf16x8 kf[4][2];
#pragma unroll
            for (int km = 0; km < 4; ++km)
#pragma unroll
                for (int ks = 0; ks < 2; ++ks) kf[km][ks] = frag_row(Kt, AT_LD, 16 * km, 32 * ks, lane);
            bf16x8 pa[2][2];
#pragma unroll
            for (int qt = 0; qt < 2; ++qt) {
                f32x4 st[4];
#pragma unroll
                for (int km = 0; km < 4; ++km) { st[km] = (f32x4){0.f, 0.f, 0.f, 0.f};
#pragma unroll
                    for (int ks = 0; ks < 2; ++ks) st[km] = mma(kf[km][ks], qf[qt][ks], st[km]); }
                if (need_mask) {
#pragma unroll
                    for (int km = 0; km < 4; ++km)
#pragma unroll
                        for (int r = 0; r < 4; ++r) { const int dq = (kp0 + 16 * km + 4 * g + r) - (qlat0 + 16 * qt + c16); if (dq > 128 || dq < -128) st[km][r] = -3.0e38f; } }
                float mx = fmaxf(fmaxf(fmaxf(st[0][0], st[0][1]), fmaxf(st[0][2], st[0][3])), fmaxf(fmaxf(st[1][0], st[1][1]), fmaxf(st[1][2], st[1][3])));
                mx = fmaxf(mx, fmaxf(fmaxf(fmaxf(st[2][0], st[2][1]), fmaxf(st[2][2], st[2][3])), fmaxf(fmaxf(st[3][0], st[3][1]), fmaxf(st[3][2], st[3][3]))));
                mx = fmaxf(mx, __shfl_xor(mx, 16)); mx = fmaxf(mx, __shfl_xor(mx, 32));
                const float mnew = fmaxf(mrun[qt], mx), alpha = __expf(mrun[qt] - mnew);
                float ps = 0.f;
#pragma unroll
                for (int km = 0; km < 4; ++km)
#pragma unroll
                    for (int r = 0; r < 4; ++r) { const float pv = __expf(st[km][r] - mnew); st[km][r] = pv; ps += pv; }
                ps += __shfl_xor(ps, 16); ps += __shfl_xor(ps, 32);
                lrun[qt] = lrun[qt] * alpha + ps; mrun[qt] = mnew;
#pragma unroll
                for (int ks2 = 0; ks2 < 2; ++ks2) { const unsigned w0 = pk2(st[2 * ks2][0], st[2 * ks2][1]), w1 = pk2(st[2 * ks2][2], st[2 * ks2][3]), w2 = pk2(st[2 * ks2 + 1][0], st[2 * ks2 + 1][1]), w3 = pk2(st[2 * ks2 + 1][2], st[2 * ks2 + 1][3]);
                    const v4u wv = (v4u){w0, w1, w2, w3}; pa[qt][ks2] = __builtin_bit_cast(bf16x8, wv); }
#pragma unroll
                for (int r = 0; r < 4; ++r) { const float ar = __shfl(alpha, (lane & 48) + 4 * g + r);
#pragma unroll
                    for (int nt = 0; nt < 4; ++nt) o[qt][nt][r] *= ar; }
            }
#pragma unroll
            for (int ks2 = 0; ks2 < 2; ++ks2) {
                bf16x8 vf[4];
#pragma unroll
                for (int nt = 0; nt < 4; ++nt) vf[nt] = frag_tr_perm(Vt, AT_LD, 32 * ks2, 16 * nt, lane);
#pragma unroll
                for (int qt = 0; qt < 2; ++qt)
#pragma unroll
                    for (int nt = 0; nt < 4; ++nt) o[qt][nt] = mma(pa[qt][ks2], vf[nt], o[qt][nt]); }
            LDS_FENCE();
            kt = kn;
        }
#pragma unroll
        for (int qt = 0; qt < 2; ++qt)
#pragma unroll
            for (int r = 0; r < 4; ++r) { const float inv = 1.f / __shfl(lrun[qt], (lane & 48) + 4 * g + r); bf16* orow = CAT + (size_t)(qrow0 + 16 * qt + 4 * g + r) * D + 512 + head * 64;
#pragma unroll
                for (int nt = 0; nt < 4; ++nt) orow[16 * nt + c16] = (bf16)f2bf(o[qt][nt][r] * inv); }
    }
}

__device__ __forceinline__ float wave_prefix_sum(float v) {
    v += __builtin_bit_cast(float, __builtin_amdgcn_update_dpp(0, __builtin_bit_cast(int, v), 0x111, 0xf, 0xf, true)); v += __builtin_bit_cast(float, __builtin_amdgcn_update_dpp(0, __builtin_bit_cast(int, v), 0x112, 0xf, 0xf, true));
    v += __builtin_bit_cast(float, __builtin_amdgcn_update_dpp(0, __builtin_bit_cast(int, v), 0x114, 0xf, 0xf, true)); v += __builtin_bit_cast(float, __builtin_amdgcn_update_dpp(0, __builtin_bit_cast(int, v), 0x118, 0xf, 0xf, true));
    v += __builtin_bit_cast(float, __builtin_amdgcn_update_dpp(0, __builtin_bit_cast(int, v), 0x142, 0xa, 0xf, false)); v += __builtin_bit_cast(float, __builtin_amdgcn_update_dpp(0, __builtin_bit_cast(int, v), 0x143, 0xc, 0xf, false));
    return v;
}
__device__ __forceinline__ float wave_prefix_max(float v) {
    const int ninf = (int)0xff800000u;
    v = fmaxf(v, __builtin_bit_cast(float, __builtin_amdgcn_update_dpp(ninf, __builtin_bit_cast(int, v), 0x111, 0xf, 0xf, false))); v = fmaxf(v, __builtin_bit_cast(float, __builtin_amdgcn_update_dpp(ninf, __builtin_bit_cast(int, v), 0x112, 0xf, 0xf, false)));
    v = fmaxf(v, __builtin_bit_cast(float, __builtin_amdgcn_update_dpp(ninf, __builtin_bit_cast(int, v), 0x114, 0xf, 0xf, false))); v = fmaxf(v, __builtin_bit_cast(float, __builtin_amdgcn_update_dpp(ninf, __builtin_bit_cast(int, v), 0x118, 0xf, 0xf, false)));
    v = fmaxf(v, __builtin_bit_cast(float, __builtin_amdgcn_update_dpp(ninf, __builtin_bit_cast(int, v), 0x142, 0xa, 0xf, false))); v = fmaxf(v, __builtin_bit_cast(float, __builtin_amdgcn_update_dpp(ninf, __builtin_bit_cast(int, v), 0x143, 0xc, 0xf, false)));
    return v;
}
__device__ __forceinline__ void mlstm_gate_scan(const float* GL  , const float* gate_b  , unsigned char* ws, int gw, int NGW, int lane) {
    float* BQ = (float*)(ws + WS_BQ); float* CQ = (float*)(ws + WS_CQ); float* EM = (float*)(ws + WS_EM); float* AI = (float*)(ws + WS_AI);
    float* AST = (float*)(ws + WS_AST); float* CL = (float*)(ws + WS_CL);
    for (int chain = gw; chain < 64; chain += NGW) {
        const int dir = chain >> 5, b = (chain >> 2) & 7, h = chain & 3;
        const float bi = gate_b[dir * 8 + h], bfg = gate_b[dir * 8 + 4 + h];
        float m_st = 0.f;
        float gi_n, gf_n;
        { const int j0 = dir == 0 ? 0 : 3; const int p0 = j0 * 64 + (dir == 0 ? lane : 63 - lane); const float* gr = GL + (size_t)(b * PB + p0) * 16 + dir * 8; gi_n = gr[h]; gf_n = gr[4 + h]; }
        for (int sc = 0; sc < NCH; ++sc) {
            const int j = dir == 0 ? sc : (sc < 4 ? 3 - sc : 71 - sc);
            const int p = j * 64 + (dir == 0 ? lane : 63 - lane);
            const float li = gi_n + bi, lf = logsigmoidf_(gf_n + bfg);
            if (sc + 1 < NCH) { const int sn = sc + 1; const int jn = dir == 0 ? sn : (sn < 4 ? 3 - sn : 71 - sn); const int pn = jn * 64 + (dir == 0 ? lane : 63 - lane);
                const float* gr = GL + (size_t)(b * PB + pn) * 16 + dir * 8; gi_n = gr[h]; gf_n = gr[4 + h]; }
            const float cum = wave_prefix_sum(lf);
            const float bb = li - cum; const float pm = wave_prefix_max(bb);
            const float c = fmaxf(m_st, pm);
            const size_t ti = (size_t)chain * PB + p;
            BQ[ti] = bb; CQ[ti] = c; EM[ti] = __expf(-(cum + c)); AI[ti] = __expf(m_st - c);
            const float cl = __builtin_bit_cast(float, __builtin_amdgcn_readlane(__builtin_bit_cast(int, c), 63)), tot = __builtin_bit_cast(float, __builtin_amdgcn_readlane(__builtin_bit_cast(int, cum), 63));
            if (lane == 0) { CL[chain * NCH + j] = cl; AST[chain * NCH + j] = __expf(m_st - cl); }
            m_st = tot + cl;
        }
    }
}


__device__ __forceinline__ float logsig_fast(float x) { return fminf(x, 0.f) - __logf(1.f + __expf(-fabsf(x))); }
__device__ __forceinline__ void gla_prep(bf16* P, bf16* QKR, const float* LOW  , const float* gate_up  , const float* gate_b  , unsigned char* ws,
                                         LAS unsigned char* lds, int vcu, int G, int tid, int dry) {
    float* ET = (float*)(ws + WS_ET);
    LAS float* lowt = (LAS float*)lds;
    LAS bf16* qs = (LAS bf16*)(lds + 8192);
    LAS bf16* ks = (LAS bf16*)(lds + 24576);
    LAS float* LA = (LAS float*)(lds + 40960);
    LAS float* HT = (LAS float*)(lds + 106496);
    const int dc = tid & 255, dir = dc >> 7, ch = dc & 127, half = tid >> 8;
    for (int item = vcu; item < NB * NCH * 4; item += G) {
        const int b = item / (NCH * 4), j = (item >> 2) % NCH, h = item & 3;
        const int row0 = b * PB + j * 64, c = h * 128 + ch;
        __syncthreads();
        for (int i = tid; i < 64 * 32; i += 512) lowt[i] = LOW[(size_t)row0 * 32 + i];
#pragma unroll
        for (int i = 0; i < 2; ++i) { const int cidx = tid + 512 * i, rr = cidx >> 4, c8 = cidx & 15; const bf16* src = P + (size_t)(row0 + rr) * N_C + h * 128 + c8 * 8;
            *(LAS v4u*)(qs + rr * 128 + c8 * 8) = *(const v4u*)src; *(LAS v4u*)(ks + rr * 128 + c8 * 8) = *(const v4u*)(src + 512); }
        float gu[16];
#pragma unroll
        for (int k = 0; k < 16; ++k) gu[k] = gate_up[(size_t)(dir * 16 + k) * 512 + c];
        const float gb = gate_b[dir * 512 + c];
        __syncthreads();
        float hsum = 0.f;
#pragma unroll 4
        for (int i = 0; i < 32; ++i) { const int t = half * 32 + i; float x = gb;
#pragma unroll
            for (int k = 0; k < 16; ++k) x += lowt[t * 32 + dir * 16 + k] * gu[k];
            const float la = logsig_fast(x) * (1.f / 16.f); LA[t * 256 + dc] = la; hsum += la; }
        HT[half * 256 + dc] = hsum;
        __syncthreads();
        float cum = (dir == 0) ? (half == 1 ? HT[dc] : 0.f) : (half == 0 ? HT[256 + dc] : 0.f);
#pragma unroll 4
        for (int i = 0; i < 32; ++i) { const int t = half * 32 + (dir == 0 ? i : 31 - i);
            cum += LA[t * 256 + dc];
            const float e = __expf(cum), ei = __expf(-cum);
            const size_t ro = (size_t)(row0 + t) * N_C;
            const float qv = bf2f(qs[t * 128 + ch]), kv = bf2f(ks[t * 128 + ch]);
            if (dir == 0) { if (!dry) { P[ro + c] = (bf16)f2bf(qv * e); P[ro + 512 + c] = (bf16)f2bf(kv * ei); } }
            else { QKR[(size_t)(row0 + t) * 1024 + c] = (bf16)f2bf(qv * e); QKR[(size_t)(row0 + t) * 1024 + 512 + c] = (bf16)f2bf(kv * ei); } }
        if (half == 0) ET[((size_t)((dir * 8 + b) * 4 + h) * NCH + j) * 128 + ch] = __expf(HT[dc] + HT[256 + dc]);
    }
}


__device__ __forceinline__ unsigned f2sort(float f) { const unsigned u = __builtin_bit_cast(unsigned, f); return (u & 0x80000000u) ? ~u : (u | 0x80000000u); }
__device__ __forceinline__ float sort2f(unsigned s) { const unsigned u = (s & 0x80000000u) ? (s & 0x7fffffffu) : ~s; return __builtin_bit_cast(float, u); }
template <int CTRL> __device__ __forceinline__ unsigned dppmov_u(unsigned x) { return (unsigned)__builtin_amdgcn_mov_dpp((int)x, CTRL, 0xf, 0xf, true); }
__device__ __forceinline__ unsigned gmax16(unsigned x) { unsigned y;
    y = dppmov_u<0xB1>(x); x = x > y ? x : y; y = dppmov_u<0x4E>(x); x = x > y ? x : y; y = dppmov_u<0x141>(x); x = x > y ? x : y; y = dppmov_u<0x128>(x); x = x > y ? x : y; return x; }
__device__ __forceinline__ float gsum16(float x) {
    x += __builtin_bit_cast(float, dppmov_u<0xB1>(__builtin_bit_cast(unsigned, x))); x += __builtin_bit_cast(float, dppmov_u<0x4E>(__builtin_bit_cast(unsigned, x)));
    x += __builtin_bit_cast(float, dppmov_u<0x141>(__builtin_bit_cast(unsigned, x))); x += __builtin_bit_cast(float, dppmov_u<0x128>(__builtin_bit_cast(unsigned, x))); return x; }
#define CSWAP(a, b) do { const unsigned hi_ = (a) > (b) ? (a) : (b), lo_ = (a) > (b) ? (b) : (a); (a) = hi_; (b) = lo_; } while (0)
__device__ __forceinline__ void peer_route(const bf16* Q, const bf16* KEYS, int* EID, float* GWT, int gw, int NGW, int lane, bool lat_only) {
    const int g = lane >> 4, c16 = lane & 15, gbase = lane & 48;
    const int nwi = (lat_only ? NB * SEQ / 16 : TT / 16) * 8;
    for (int wi = gw; wi < nwi; wi += NGW) {
        const int t0 = map_row((wi >> 3) * 16, lat_only), head = wi & 7;
        unsigned tops[2][4];
#pragma unroll
        for (int p = 0; p < 2; ++p) {
            const bf16* qrow = Q + (size_t)(t0 + c16) * 2048 + head * 256 + p * 128 + 8 * g;
            bf16x8 qf[4];
#pragma unroll
            for (int ks = 0; ks < 4; ++ks) qf[ks] = *(const bf16x8*)(qrow + 32 * ks);
            const bf16* kb = KEYS + (size_t)(head * 2 + p) * 128 * 128 + (size_t)c16 * 128 + 8 * g;
            unsigned key[8][4];
#pragma unroll
            for (int nt = 0; nt < 8; ++nt) { f32x4 s = (f32x4){0.f, 0.f, 0.f, 0.f};
#pragma unroll
                for (int ks = 0; ks < 4; ++ks) s = mma(qf[ks], *(const bf16x8*)(kb + (size_t)nt * 16 * 128 + 32 * ks), s);
#pragma unroll
                for (int r = 0; r < 4; ++r) key[nt][r] = (f2sort(s[r]) & ~127u) | (unsigned)(127 - (16 * nt + c16)); }
            unsigned kk[4][8];
#pragma unroll
            for (int r = 0; r < 4; ++r) {
#pragma unroll
                for (int nt = 0; nt < 8; ++nt) kk[r][nt] = key[nt][r];
                CSWAP(kk[r][0], kk[r][1]); CSWAP(kk[r][2], kk[r][3]); CSWAP(kk[r][4], kk[r][5]); CSWAP(kk[r][6], kk[r][7]); CSWAP(kk[r][0], kk[r][2]); CSWAP(kk[r][1], kk[r][3]); CSWAP(kk[r][4], kk[r][6]); CSWAP(kk[r][5], kk[r][7]);
                CSWAP(kk[r][1], kk[r][2]); CSWAP(kk[r][5], kk[r][6]); CSWAP(kk[r][0], kk[r][4]); CSWAP(kk[r][1], kk[r][5]); CSWAP(kk[r][2], kk[r][6]); CSWAP(kk[r][3], kk[r][7]); CSWAP(kk[r][2], kk[r][4]); CSWAP(kk[r][3], kk[r][5]);
                CSWAP(kk[r][1], kk[r][2]); CSWAP(kk[r][3], kk[r][4]); CSWAP(kk[r][5], kk[r][6]); }
            unsigned tt[4] = {0u, 0u, 0u, 0u};
#pragma unroll 2
            for (int rd = 0; rd < 16; ++rd) {
#pragma unroll
                for (int r = 0; r < 4; ++r) { const unsigned m = gmax16(kk[r][0]); const bool w = (kk[r][0] == m);
#pragma unroll
                    for (int q = 0; q < 7; ++q) kk[r][q] = w ? kk[r][q + 1] : kk[r][q];
                    kk[r][7] = w ? 0u : kk[r][7];
                    tt[r] = (c16 == rd) ? m : tt[r]; } }
#pragma unroll
            for (int r = 0; r < 4; ++r) tops[p][r] = tt[r];
        }
        float v0[4], s1v[4]; int ptr[4]; unsigned res[4];
#pragma unroll
        for (int r = 0; r < 4; ++r) { v0[r] = sort2f(tops[0][r] & ~127u); s1v[r] = sort2f((unsigned)__shfl((int)tops[1][r], gbase) & ~127u); ptr[r] = 0; res[r] = 0u; }
#pragma unroll 2
        for (int rd = 0; rd < 16; ++rd) {
#pragma unroll
            for (int r = 0; r < 4; ++r) {
                const unsigned ck = ptr[r] < 16 ? ((f2sort(v0[r] + s1v[r]) & ~255u) | (unsigned)((15 - c16) << 4) | (unsigned)(15 - ptr[r])) : 0u;
                const unsigned m = gmax16(ck);
                res[r] = (c16 == rd) ? m : res[r];
                if (ck == m) ++ptr[r];
                s1v[r] = sort2f((unsigned)__shfl((int)tops[1][r], gbase + (ptr[r] < 15 ? ptr[r] : 15)) & ~127u); } }
#pragma unroll
        for (int r = 0; r < 4; ++r) {
            const float val = sort2f(res[r] & ~255u); const int ii = 15 - (int)((res[r] >> 4) & 15u), jj = 15 - (int)(res[r] & 15u);
            const float mx = __shfl(val, gbase);
            const float ex = __expf(val - mx), sum = gsum16(ex);
            const unsigned i0 = 127u - ((unsigned)__shfl((int)tops[0][r], gbase + ii) & 127u), i1 = 127u - ((unsigned)__shfl((int)tops[1][r], gbase + jj) & 127u);
            const size_t o = (size_t)(t0 + 4 * g + r) * 128 + head * 16 + c16;
            EID[o] = (int)(i0 * 128u + i1); GWT[o] = ex / sum;
        }
    }
}

__device__ __forceinline__ void unpack8(const v4u w, float* o) { o[0] = bflo(w.x); o[1] = bfhi(w.x); o[2] = bflo(w.y); o[3] = bfhi(w.y); o[4] = bflo(w.z); o[5] = bfhi(w.z); o[6] = bflo(w.w); o[7] = bfhi(w.w); }
__device__ __forceinline__ int rev3(int x) { return ((x & 1) << 2) | (x & 2) | ((x >> 2) & 1); }
__device__ __forceinline__ void peer_pass1(const bf16* HB, const int* EID, const float* GWT, const unsigned char* U6, const float* SUi, const float* SVi, float* COEF, int gw, int NGW, int lane, bool lat_only) {
    const int myslot = 8 * (lane & 7) + rev3(lane >> 3);
    const bool b5 = (lane & 32) != 0, b4 = (lane & 16) != 0, b3 = (lane & 8) != 0;
    const int nrows = lat_only ? NB * SEQ : TT;
    for (int ri = gw; ri < nrows; ri += NGW) {
        const int r = map_row(ri, lat_only);
        float h[16];
        { const v4u a = *(const v4u*)(HB + (size_t)r * D + 16 * lane), bq = *(const v4u*)(HB + (size_t)r * D + 16 * lane + 8); unpack8(a, h); unpack8(bq, h + 8); }
#pragma unroll 1
        for (int half = 0; half < 2; ++half) {
            const int eid = EID[(size_t)r * 128 + half * 64 + myslot]; const float gwt = GWT[(size_t)r * 128 + half * 64 + myslot];
            float dotreg = 0.f;
            v3u raw[8];
#pragma unroll
            for (int vi = 0; vi < 8; ++vi) { const int id = __builtin_amdgcn_readlane(eid, 8 * rev3(vi)); raw[vi] = *(const v3u*)(U6 + (size_t)id * 768 + 12 * lane); }
#pragma unroll 1
            for (int gI = 0; gI < 8; ++gI) {
                const int gn = gI < 7 ? gI + 1 : 7;
                float a[8];
#pragma unroll
                for (int vi = 0; vi < 8; ++vi) { const v6u pk6 = (v6u){raw[vi].x, raw[vi].y, raw[vi].z, 0u, 0u, 0u}; const v32f w = __builtin_amdgcn_cvt_scalef32_pk32_f32_fp6(pk6, 1.0f);
                    const int idn = __builtin_amdgcn_readlane(eid, gn + 8 * rev3(vi)); raw[vi] = *(const v3u*)(U6 + (size_t)idn * 768 + 12 * lane);
                    float sacc = 0.f;
#pragma unroll
                    for (int i = 0; i < 16; ++i) sacc += h[i] * w[i];
                    a[vi] = sacc;
                    __builtin_amdgcn_sched_barrier(0); }
                float bb[4];
#pragma unroll
                for (int k = 0; k < 4; ++k) { const float keep = b5 ? a[2 * k + 1] : a[2 * k], send = b5 ? a[2 * k] : a[2 * k + 1]; bb[k] = keep + __shfl_xor(send, 32); }
                float cc[2];
#pragma unroll
                for (int k = 0; k < 2; ++k) { const float keep = b4 ? bb[2 * k + 1] : bb[2 * k], send = b4 ? bb[2 * k] : bb[2 * k + 1]; cc[k] = keep + __shfl_xor(send, 16); }
                float dd; { const float keep = b3 ? cc[1] : cc[0], send = b3 ? cc[0] : cc[1]; dd = keep + __shfl_xor(send, 8); }
                dd += __shfl_xor(dd, 4); dd += __shfl_xor(dd, 2); dd += __shfl_xor(dd, 1);
                dotreg = ((lane & 7) == gI) ? dd : dotreg;
            }
            const float dot = dotreg * SUi[eid];
            const float coef = gwt * 0.5f * dot * (1.f + erff(dot * 0.70710678118f)) * SVi[eid];
            COEF[(size_t)r * 128 + half * 64 + myslot] = coef;
        }
    }
}
template <bool USE_PEER>
__device__ __forceinline__ void peer_expert(const float* COEF, const int* EID, const unsigned char* V6,
                                            float* lat, float* ctx, const float* mod, const float* lnw, const float* lnb, int gw, int NGW, int lane, int dry, bool lat_only) {
    const int myslot = 8 * (lane & 7) + rev3(lane >> 3);
    const int nrows = lat_only ? NB * SEQ : TT;
    for (int ri = gw; ri < nrows; ri += NGW) {
        const int r = map_row(ri, lat_only);
        const int b = r / PB, p = r - b * PB; float* xr = srow(lat, ctx, r); const float* mr = mod + (size_t)(p < LC ? 8 : b) * 6144;
        float f[16];
#pragma unroll
        for (int i = 0; i < 16; ++i) f[i] = 0.f;
        if (USE_PEER) {
#pragma unroll 1
        for (int half = 0; half < 2; ++half) {
            const int eid = EID[(size_t)r * 128 + half * 64 + myslot];
            const float coef = COEF[(size_t)r * 128 + half * 64 + myslot];
            v3u ring[8];
#pragma unroll
            for (int k = 0; k < 8; ++k) { const int id = __builtin_amdgcn_readlane(eid, k); ring[k] = *(const v3u*)(V6 + (size_t)id * 768 + 12 * lane); }
#pragma unroll 1
            for (int e0 = 0; e0 < 64; e0 += 8) {
#pragma unroll
                for (int k = 0; k < 8; k += 2) {
                    const float c0 = __builtin_bit_cast(float, __builtin_amdgcn_readlane(__builtin_bit_cast(int, coef), e0 + k)), c1 = __builtin_bit_cast(float, __builtin_amdgcn_readlane(__builtin_bit_cast(int, coef), e0 + k + 1));
                    const v6u pk6 = (v6u){ring[k].x, ring[k].y, ring[k].z, ring[k + 1].x, ring[k + 1].y, ring[k + 1].z}; const v32f w = __builtin_amdgcn_cvt_scalef32_pk32_f32_fp6(pk6, 1.0f);
                    const int en0 = (e0 + 8 + k) < 64 ? (e0 + 8 + k) : 63, en1 = (e0 + 9 + k) < 64 ? (e0 + 9 + k) : 63;
                    const int idn0 = __builtin_amdgcn_readlane(eid, en0), idn1 = __builtin_amdgcn_readlane(eid, en1);
                    ring[k] = *(const v3u*)(V6 + (size_t)idn0 * 768 + 12 * lane); ring[k + 1] = *(const v3u*)(V6 + (size_t)idn1 * 768 + 12 * lane);
#pragma unroll
                    for (int i = 0; i < 16; ++i) f[i] += c0 * w[i];
#pragma unroll
                    for (int i = 0; i < 16; ++i) f[i] += c1 * w[16 + i];
                    __builtin_amdgcn_sched_barrier(0); }
            }
        }
        }
        float v[16]; float s = 0.f;
#pragma unroll
        for (int q = 0; q < 4; ++q) { const int c = 16 * lane + 4 * q; const f32x4 x1 = *(const f32x4*)(xr + c), g2 = *(const f32x4*)(mr + 5120 + c);
#pragma unroll
            for (int i = 0; i < 4; ++i) { v[4 * q + i] = DN_ALPHA * x1[i] + g2[i] * f[4 * q + i]; s += v[4 * q + i]; } }
        const float mean = wave_sum(s) * (1.f / D); float s2 = 0.f;
#pragma unroll
        for (int i = 0; i < 16; ++i) { v[i] -= mean; s2 += v[i] * v[i]; }
        const float rstd = 1.f / sqrtf(wave_sum(s2) * (1.f / D) + LN_EPS);
#pragma unroll
        for (int q = 0; q < 4; ++q) { const int c = 16 * lane + 4 * q; const f32x4 w = *(const f32x4*)(lnw + c), bb2 = *(const f32x4*)(lnb + c); f32x4 o;
#pragma unroll
            for (int i = 0; i < 4; ++i) o[i] = v[4 * q + i] * rstd * w[i] + bb2[i];
            if (!dry) *(f32x4*)(xr + c) = o; }
    }
}

__device__ __forceinline__ bf16* od_row_base(unsigned char* ws, int dir, int b) {
    if (dir == 0) return (bf16*)(ws + WS_ST) + (size_t)b * SEQ * 1024;
    return b < 7 ? (bf16*)(ws + WS_ST + 64 * MiB) + (size_t)b * SEQ * 1024 : (bf16*)(ws + WS_XC);
}
__device__ __forceinline__ void gla_fused_scan(const bf16* P, const bf16* QKR, unsigned char* ws, LAS unsigned char* lds, int vcu, int G, int wave, int lane, int tid, int dry) {
    const float* ET = (const float*)(ws + WS_ET);
    LAS bf16* Qt = (LAS bf16*)lds;
    LAS bf16* Kt = (LAS bf16*)(lds + 34816);
    LAS bf16* Vt = (LAS bf16*)(lds + 69632);
    LAS bf16* SL = (LAS bf16*)(lds + 88064);
    LAS bf16* Pw = (LAS bf16*)(lds + 122880 + wave * 2304);
    const int g = lane >> 4, c16 = lane & 15, mt = wave & 3, cw = wave >> 2;
    for (int item = vcu; item < 256; item += G) {
        const int dir = item >> 7, b = (item >> 4) & 7, h = (item >> 2) & 3, eb = item & 3;
        const bf16* qsrc = dir == 0 ? P + h * 128 : QKR + h * 128; const int qld = dir == 0 ? N_C : 1024;
        const bf16* vsrc = P + 1024 + h * 256 + 64 * eb;
        const float* etp = ET + ((size_t)((dir * 8 + b) * 4 + h) * NCH) * 128 + 16 * wave + c16;
        bf16* odb = od_row_base(ws, dir, b) + h * 256 + 64 * eb;
        f32x4 acc[4];
#pragma unroll
        for (int et = 0; et < 4; ++et) acc[et] = (f32x4){0.f, 0.f, 0.f, 0.f};
        v4u qreg[2][2], kreg[2][2], vreg[2]; float etn[2];
#define GLA_JOF(sc_) (dir == 0 ? (sc_) : ((sc_) < 4 ? 3 - (sc_) : 71 - (sc_)))
#define GLA_PREFETCH(sc0_) do { _Pragma("unroll") for (int u = 0; u < 2; ++u) { const int jj = GLA_JOF((sc0_) + u); const int row0 = b * PB + jj * 64; \
            _Pragma("unroll") for (int i = 0; i < 2; ++i) { const int cidx = tid + 512 * i, rr = cidx >> 4, ch = cidx & 15; const bf16* sp = qsrc + (size_t)(row0 + rr) * qld + ch * 8; qreg[u][i] = *(const v4u*)sp; kreg[u][i] = *(const v4u*)(sp + 512); } \
            vreg[u] = *(const v4u*)(vsrc + (size_t)(row0 + (tid >> 3)) * N_C + (tid & 7) * 8); etn[u] = etp[(size_t)jj * 128]; } } while (0)
        GLA_PREFETCH(0);
        unsigned opk[8]; int ojc = -1;
#pragma unroll
        for (int i = 0; i < 8; ++i) opk[i] = 0u;
        for (int sc = 0; sc < NCH; sc += 2) {
            const int ja = GLA_JOF(sc), jb = GLA_JOF(sc + 1);
            __syncthreads();
            if (ojc >= 4 && !dry) {
#pragma unroll
                for (int nt = 0; nt < 4; ++nt) { bf16* orow = odb + (size_t)((ojc - 4) * 64 + 16 * mt + 4 * g) * 1024 + 16 * nt + c16;
#pragma unroll
                    for (int r = 0; r < 4; ++r) orow[(size_t)r * 1024] = (bf16)((opk[2 * nt + (r >> 1)] >> (16 * (r & 1))) & 0xffffu); } }
#pragma unroll
            for (int u = 0; u < 2; ++u) {
#pragma unroll
                for (int i = 0; i < 2; ++i) { const int cidx = tid + 512 * i, rr = cidx >> 4, ch = cidx & 15; *(LAS v4u*)(Qt + u * 8704 + rr * 136 + ch * 8) = qreg[u][i]; *(LAS v4u*)(Kt + u * 8704 + rr * 136 + ch * 8) = kreg[u][i]; }
                *(LAS v4u*)(Vt + u * 4608 + (tid >> 3) * 72 + (tid & 7) * 8) = vreg[u]; }
#pragma unroll
            for (int et = 0; et < 4; ++et)
#pragma unroll
                for (int r = 0; r < 4; ++r) SL[(16 * et + 4 * g + r) * 136 + 16 * wave + c16] = (bf16)f2bf(acc[et][r]);
            const float et_a = etn[0], et_b = etn[1];
            if (sc + 2 < NCH) GLA_PREFETCH(sc + 2);
            __syncthreads();
#pragma unroll
            for (int ks = 0; ks < 2; ++ks) { const bf16x8 kb = frag_tr(Kt, 136, 32 * ks, 16 * wave, lane);
#pragma unroll
                for (int et = 0; et < 4; ++et) acc[et] = mma(frag_tr(Vt, 72, 32 * ks, 16 * et, lane), kb, acc[et]); }
#pragma unroll
            for (int et = 0; et < 4; ++et) { acc[et] = acc[et] * et_a;
#pragma unroll
                for (int r = 0; r < 4; ++r) SL[8704 + (16 * et + 4 * g + r) * 136 + 16 * wave + c16] = (bf16)f2bf(acc[et][r]); }
            __syncthreads();
            const int jc = cw == 0 ? ja : jb;
            ojc = jc;
            if (jc >= 4) {
                const LAS bf16* Qc = Qt + cw * 8704; const LAS bf16* Kc = Kt + cw * 8704; const LAS bf16* Vc = Vt + cw * 4608; const LAS bf16* Sc = SL + cw * 8704;
                bf16x8 qf[4];
#pragma unroll
                for (int ks = 0; ks < 4; ++ks) qf[ks] = frag_row(Qc, 136, 16 * mt, 32 * ks, lane);
                bf16x8 pa[2];
                { f32x4 st[4];
#pragma unroll
                  for (int ns = 0; ns < 4; ++ns) { st[ns] = (f32x4){0.f, 0.f, 0.f, 0.f};
#pragma unroll
                      for (int ks = 0; ks < 4; ++ks) st[ns] = mma(frag_row(Kc, 136, 16 * ns, 32 * ks, lane), qf[ks], st[ns]);
#pragma unroll
                      for (int r = 0; r < 4; ++r) { const int sidx = 16 * ns + 4 * g + r, t = 16 * mt + c16; const bool ok = dir == 0 ? (sidx <= t) : (sidx >= t); st[ns][r] = ok ? st[ns][r] : 0.f; } }
#pragma unroll
                  for (int ks2 = 0; ks2 < 2; ++ks2) { const v4u wv = (v4u){pk2(st[2 * ks2][0], st[2 * ks2][1]), pk2(st[2 * ks2][2], st[2 * ks2][3]), pk2(st[2 * ks2 + 1][0], st[2 * ks2 + 1][1]), pk2(st[2 * ks2 + 1][2], st[2 * ks2 + 1][3])};
                      pa[ks2] = __builtin_bit_cast(bf16x8, wv); } }
#pragma unroll
                for (int nt = 0; nt < 4; ++nt) { f32x4 a = (f32x4){0.f, 0.f, 0.f, 0.f};
#pragma unroll
                    for (int ks = 0; ks < 4; ++ks) a = mma(qf[ks], frag_row(Sc, 136, 16 * nt, 32 * ks, lane), a);
                    a = mma(pa[0], frag_tr_perm(Vc, 72, 0, 16 * nt, lane), a); a = mma(pa[1], frag_tr_perm(Vc, 72, 32, 16 * nt, lane), a);
                    opk[2 * nt] = pk2(a[0], a[1]); opk[2 * nt + 1] = pk2(a[2], a[3]); }
                LDS_FENCE();
            }
#pragma unroll
            for (int ks = 0; ks < 2; ++ks) { const bf16x8 kb = frag_tr(Kt + 8704, 136, 32 * ks, 16 * wave, lane);
#pragma unroll
                for (int et = 0; et < 4; ++et) acc[et] = mma(frag_tr(Vt + 4608, 72, 32 * ks, 16 * et, lane), kb, acc[et]); }
#pragma unroll
            for (int et = 0; et < 4; ++et) acc[et] = acc[et] * et_b;
        }
        if (ojc >= 4 && !dry) {
#pragma unroll
            for (int nt = 0; nt < 4; ++nt) { bf16* orow = odb + (size_t)((ojc - 4) * 64 + 16 * mt + 4 * g) * 1024 + 16 * nt + c16;
#pragma unroll
                for (int r = 0; r < 4; ++r) orow[(size_t)r * 1024] = (bf16)((opk[2 * nt + (r >> 1)] >> (16 * (r & 1))) & 0xffffu); } }
#undef GLA_PREFETCH
#undef GLA_JOF
    }
}
__device__ __forceinline__ void gla_merge(bf16* P, const float* norm_w, unsigned char* ws, int gw, int NGW, int lane, int dry) {
    for (int i = gw; i < NB * SEQ; i += NGW) {
        const int b = i >> 12, lp = i & 4095; const size_t r = (size_t)b * PB + LC + lp;
        const bf16* of = od_row_base(ws, 0, b) + (size_t)lp * 1024 + 16 * lane; const bf16* orv = od_row_base(ws, 1, b) + (size_t)lp * 1024 + 16 * lane;
        bf16* grow = P + r * N_C + 2048 + 16 * lane;
        float x[16], y[16], gg[16];
        unpack8(*(const v4u*)of, x); unpack8(*(const v4u*)(of + 8), x + 8); unpack8(*(const v4u*)orv, y); unpack8(*(const v4u*)(orv + 8), y + 8);
        unpack8(*(const v4u*)grow, gg); unpack8(*(const v4u*)(grow + 8), gg + 8);
        float ss = 0.f;
#pragma unroll
        for (int k = 0; k < 16; ++k) { x[k] += y[k]; ss += x[k] * x[k]; }
        ss = gsum16(ss);
        const float rn = 1.f / sqrtf(ss * (1.f / 256.f) + LN_EPS);
        unsigned ow[8];
#pragma unroll
        for (int k = 0; k < 8; ++k) { const float4 dummy = make_float4(0.f, 0.f, 0.f, 0.f); (void)dummy;
            const float a = x[2 * k] * rn * norm_w[16 * lane + 2 * k] * siluf_(gg[2 * k]), c = x[2 * k + 1] * rn * norm_w[16 * lane + 2 * k + 1] * siluf_(gg[2 * k + 1]); ow[k] = pk2(a, c); }
        if (!dry) { v4u o0, o1; o0.x = ow[0]; o0.y = ow[1]; o0.z = ow[2]; o0.w = ow[3]; o1.x = ow[4]; o1.y = ow[5]; o1.z = ow[6]; o1.w = ow[7]; *(v4u*)grow = o0; *(v4u*)(grow + 8) = o1; }
    }
}

__device__ __forceinline__ void mlstm_fused_scan(const bf16* P, unsigned char* ws, LAS unsigned char* lds, int vcu, int G, int wave, int lane, int tid) {
    const float* BQ = (const float*)(ws + WS_BQ); const float* CQ = (const float*)(ws + WS_CQ); const float* EM = (const float*)(ws + WS_EM); const float* AI = (const float*)(ws + WS_AI);
    const float* AST = (const float*)(ws + WS_AST); const float* CL = (const float*)(ws + WS_CL);
    LAS bf16* Qt = (LAS bf16*)lds;
    LAS bf16* Kt = (LAS bf16*)(lds + 17408);
    LAS bf16* Vt = (LAS bf16*)(lds + 34816);
    LAS bf16* Vw = (LAS bf16*)(lds + 41984);
    LAS bf16* CT = (LAS bf16*)(lds + 49152);
    LAS bf16* Pw = (LAS bf16*)(lds + 62208 + wave * 2304);
    const int g = lane >> 4, c16 = lane & 15, mt = wave & 3, hf = wave >> 2;
    const int vrow = tid < 256 ? (tid >> 2) : ((tid - 256) & 63), vch = tid & 3;
    for (int item = vcu; item < 256; item += G) {
        const int dir = item >> 7, b = (item >> 4) & 7, h = (item >> 2) & 3, eb = item & 3;
        const int chain = dir * 32 + b * 4 + h;
        const bf16* qsrc = P + h * 128; const bf16* vsrc = P + 1024 + h * 128 + 32 * eb;
        bf16* odb = (bf16*)(ws + WS_ST) + (size_t)dir * TT * 512 + h * 128 + 32 * eb;
        f32x4 acc[3];
#pragma unroll
        for (int et = 0; et < 3; ++et) acc[et] = (f32x4){0.f, 0.f, 0.f, 0.f};
        v4u qreg[2], kreg[2], vreg; float bqr, cln, astn, cqn; f32x4 bqn[4], ain, emn;
        { const int j0 = dir == 0 ? 0 : 3; const int row0 = b * PB + j0 * 64; const size_t tb = (size_t)chain * PB + j0 * 64;
#pragma unroll
          for (int i = 0; i < 2; ++i) { const int cidx = tid + 512 * i, rr = cidx >> 4, ch = cidx & 15; const bf16* s = qsrc + (size_t)(row0 + rr) * N_AB + ch * 8; qreg[i] = *(const v4u*)s; kreg[i] = *(const v4u*)(s + 512); }
          vreg = *(const v4u*)(vsrc + (size_t)(row0 + vrow) * N_AB + vch * 8); bqr = BQ[tb + vrow]; cln = CL[chain * NCH + j0]; astn = AST[chain * NCH + j0];
#pragma unroll
          for (int k = 0; k < 4; ++k) bqn[k] = *(const f32x4*)(BQ + tb + 16 * k + 4 * g);
          cqn = CQ[tb + 16 * mt + c16]; ain = *(const f32x4*)(AI + tb + 16 * mt + 4 * g); emn = *(const f32x4*)(EM + tb + 16 * mt + 4 * g); }
        for (int sc = 0; sc < NCH; ++sc) {
            const int j = dir == 0 ? sc : (sc < 4 ? 3 - sc : 71 - sc);
            __syncthreads();
#pragma unroll
            for (int i = 0; i < 2; ++i) { const int cidx = tid + 512 * i, rr = cidx >> 4, ch = cidx & 15; *(LAS v4u*)(Qt + rr * 136 + ch * 8) = qreg[i]; *(LAS v4u*)(Kt + rr * 136 + ch * 8) = kreg[i]; }
            { const float wsv = __expf(bqr - cln);
              if (tid < 256) { const v4u raw = vreg; v4u o;
                  o.x = pk2(bflo(raw.x) * wsv, bfhi(raw.x) * wsv); o.y = pk2(bflo(raw.y) * wsv, bfhi(raw.y) * wsv); o.z = pk2(bflo(raw.z) * wsv, bfhi(raw.z) * wsv); o.w = pk2(bflo(raw.w) * wsv, bfhi(raw.w) * wsv);
                  *(LAS v4u*)(Vt + vrow * 56 + vch * 8) = raw; *(LAS v4u*)(Vw + vrow * 56 + vch * 8) = o;
              } else if (tid < 320) { v4u o; o.x = 0x3f80u; o.y = 0u; o.z = 0u; o.w = 0u; *(LAS v4u*)(Vt + vrow * 56 + 32) = o; o.x = f2bf(wsv); *(LAS v4u*)(Vw + vrow * 56 + 32) = o;
                  o.x = 0u; *(LAS v4u*)(Vt + vrow * 56 + 40) = o; *(LAS v4u*)(Vw + vrow * 56 + 40) = o; } }
#pragma unroll
            for (int et = 0; et < 3; ++et)
#pragma unroll
                for (int r = 0; r < 4; ++r) CT[(16 * et + 4 * g + r) * 136 + 16 * wave + c16] = (bf16)f2bf(acc[et][r]);
            const float ast = astn, cqt = cqn; f32x4 bq[4]; const f32x4 ai = ain, em = emn;
#pragma unroll
            for (int k = 0; k < 4; ++k) bq[k] = bqn[k];
            if (sc + 1 < NCH) { const int sn = sc + 1; const int jn = dir == 0 ? sn : (sn < 4 ? 3 - sn : 71 - sn); const int row0 = b * PB + jn * 64; const size_t tb = (size_t)chain * PB + jn * 64;
#pragma unroll
                for (int i = 0; i < 2; ++i) { const int cidx = tid + 512 * i, rr = cidx >> 4, ch = cidx & 15; const bf16* s = qsrc + (size_t)(row0 + rr) * N_AB + ch * 8; qreg[i] = *(const v4u*)s; kreg[i] = *(const v4u*)(s + 512); }
                vreg = *(const v4u*)(vsrc + (size_t)(row0 + vrow) * N_AB + vch * 8); bqr = BQ[tb + vrow]; cln = CL[chain * NCH + jn]; astn = AST[chain * NCH + jn];
#pragma unroll
                for (int k = 0; k < 4; ++k) bqn[k] = *(const f32x4*)(BQ + tb + 16 * k + 4 * g);
                cqn = CQ[tb + 16 * mt + c16]; ain = *(const f32x4*)(AI + tb + 16 * mt + 4 * g); emn = *(const f32x4*)(EM + tb + 16 * mt + 4 * g); }
            __syncthreads();
            bf16x8 qf[4];
#pragma unroll
            for (int ks = 0; ks < 4; ++ks) qf[ks] = frag_row(Qt, 136, 16 * mt, 32 * ks, lane);
            bf16x8 pa[2];
            { f32x4 st[4];
#pragma unroll
              for (int ns = 0; ns < 4; ++ns) { st[ns] = (f32x4){0.f, 0.f, 0.f, 0.f};
#pragma unroll
                  for (int ks = 0; ks < 4; ++ks) st[ns] = mma(frag_row(Kt, 136, 16 * ns, 32 * ks, lane), qf[ks], st[ns]);
#pragma unroll
                  for (int r = 0; r < 4; ++r) { const int sidx = 16 * ns + 4 * g + r, t = 16 * mt + c16; const bool ok = dir == 0 ? (sidx <= t) : (sidx >= t);
                      st[ns][r] = ok ? st[ns][r] * __expf(bq[ns][r] - cqt) : 0.f; } }
#pragma unroll
              for (int ks2 = 0; ks2 < 2; ++ks2) { const v4u wv = (v4u){pk2(st[2 * ks2][0], st[2 * ks2][1]), pk2(st[2 * ks2][2], st[2 * ks2][3]), pk2(st[2 * ks2 + 1][0], st[2 * ks2 + 1][1]), pk2(st[2 * ks2 + 1][2], st[2 * ks2 + 1][3])};
                  pa[ks2] = __builtin_bit_cast(bf16x8, wv); } }
            f32x4 av, ad;
            { f32x4 a = (f32x4){0.f, 0.f, 0.f, 0.f}, d = (f32x4){0.f, 0.f, 0.f, 0.f};
#pragma unroll
              for (int ks = 0; ks < 4; ++ks) { a = mma(qf[ks], frag_row(CT, 136, 16 * hf, 32 * ks, lane), a); d = mma(qf[ks], frag_row(CT, 136, 32, 32 * ks, lane), d); }
#pragma unroll
              for (int r = 0; r < 4; ++r) { a[r] *= ai[r]; d[r] *= ai[r]; }
#pragma unroll
              for (int ks = 0; ks < 2; ++ks) { a = mma(pa[ks], frag_tr_perm(Vt, 56, 32 * ks, 16 * hf, lane), a); d = mma(pa[ks], frag_tr_perm(Vt, 56, 32 * ks, 32, lane), d); }
              av = a; ad = d; }
            { bf16* orow = odb + (size_t)(b * PB + j * 64 + 16 * mt + 4 * g) * 512 + 16 * hf + c16;
#pragma unroll
              for (int r = 0; r < 4; ++r) { const float den = __shfl(ad[r], lane & 48); orow[(size_t)r * 512] = (bf16)f2bf(av[r] / fmaxf(fabsf(den), em[r])); } }
#pragma unroll
            for (int et = 0; et < 3; ++et) acc[et] = acc[et] * ast;
#pragma unroll
            for (int ks = 0; ks < 2; ++ks) { const bf16x8 kb = frag_tr(Kt, 136, 32 * ks, 16 * wave, lane);
#pragma unroll
                for (int et = 0; et < 3; ++et) acc[et] = mma(frag_tr(Vw, 56, 32 * ks, 16 * et, lane), kb, acc[et]); }
        }
    }
}
__device__ __forceinline__ void mlstm_merge(const bf16* P, bf16* CAT, const float* norm_w, unsigned char* ws, int gw, int NGW, int lane) {
    const bf16* OD = (const bf16*)(ws + WS_ST);
    for (int r = gw; r < TT; r += NGW) {
        float x[8], y[8], og[8];
        unpack8(*(const v4u*)(OD + (size_t)r * 512 + 8 * lane), x); unpack8(*(const v4u*)(OD + (size_t)TT * 512 + (size_t)r * 512 + 8 * lane), y);
        unpack8(*(const v4u*)(P + (size_t)r * N_AB + 1536 + 8 * lane), og);
        float ss = 0.f;
#pragma unroll
        for (int k = 0; k < 8; ++k) { x[k] += y[k]; ss += x[k] * x[k]; }
        ss = gsum16(ss);
        const float rn = 1.f / sqrtf(ss * (1.f / 128.f) + LN_EPS);
        unsigned ow[4];
#pragma unroll
        for (int k = 0; k < 4; ++k) ow[k] = pk2(x[2 * k] * rn * norm_w[8 * lane + 2 * k] * sigmoidf_(og[2 * k]), x[2 * k + 1] * rn * norm_w[8 * lane + 2 * k + 1] * sigmoidf_(og[2 * k + 1]));
        v4u o; o.x = ow[0]; o.y = ow[1]; o.z = ow[2]; o.w = ow[3]; *(v4u*)(CAT + (size_t)r * D + 8 * lane) = o;
    }
}

#ifndef PHMASK
#define PHMASK 0xffffffffu
#endif
#define PH(k) ((PHMASK >> (k)) & 1u)
#ifndef REPMASK
#define REPMASK 0u
#endif
#define REPS(k) (1 + (int)((REPMASK >> (k)) & 1u))
#if REPMASK
#define DRYV(k) ({ int d_ = (rep_ + 1 < REPS(k)) ? 1 : 0; asm volatile("" : "+s"(d_)); d_; })
#else
#define DRYV(k) 0
#endif
#ifndef DBG_LEVEL
#define DBG_LEVEL 3
#endif
typedef const __attribute__((address_space(4))) Args* KArgsP;
__device__ __forceinline__ KArgsP kargs() { KArgsP p = (KArgsP)__builtin_amdgcn_kernarg_segment_ptr(); asm volatile("" : "+s"(p)); return p; }
#define WSP(off) (ws + (off))
__global__ void __launch_bounds__(512, 2) fwd_megakernel(Args A_unused) {
    extern __shared__ __attribute__((aligned(16))) unsigned char lds_raw[];
    LAS unsigned char* lds = (LAS unsigned char*)lds_raw;
    const int tid0 = threadIdx.x;
    const int G = gridDim.x; const int bx = blockIdx.x; const int vcu = (G % 8 == 0) ? (bx % 8) * (G / 8) + bx / 8 : bx;
    const int NGW = G * 8;
    volatile LAS unsigned* MISC = (volatile LAS unsigned*)(lds + MISC_OFF);
    if (tid0 < 16) MISC[tid0] = 0u;
    __syncthreads();
    XcdBarrier bar;
    { KArgsP ap = kargs(); bar = xcd_barrier_post((unsigned*)(ap->ws + WS_CTL) + 1024, MISC + 8); }
#define GRID_BAR() xcd_barrier(bar)
#define PROLOG KArgsP ap = kargs(); unsigned char* ws = ap->ws; (void)ws; int tid = tid0; asm volatile("" : "+v"(tid)); const int lane = tid & 63, wave = __builtin_amdgcn_readfirstlane(tid >> 6), gw = vcu * 8 + wave; (void)lane; (void)wave; (void)gw;

    if (PH(0)) for (int rep_ = 0; rep_ < REPS(0); ++rep_) { int tid = tid0; asm volatile("" : "+v"(tid)); const int lane = tid & 63, wave = __builtin_amdgcn_readfirstlane(tid >> 6); Args A; { KArgsP ap = kargs();
#pragma unroll
        for (int i = 0; i < 22; ++i) A.in[i] = ap->in[i];
        A.out = ap->out; A.ws = ap->ws; }
        p0_prologue(A, lds, vcu, G, wave, lane, tid); }
    GRID_BAR();

    if (PH(1)) for (int rep_ = 0; rep_ < REPS(1); ++rep_) { PROLOG h_phase<16>(ap->in[I_X], ap->in[I_CTX], (const float*)WSP(WS_MOD), (bf16*)WSP(WS_HB), (const float*)WSP(WS_WG), (float*)WSP(WS_GL), lds, vcu, G, wave, lane, tid); }
    GRID_BAR();
    if (PH(2)) for (int rep_ = 0; rep_ < REPS(2); ++rep_) { PROLOG pg8::Gemm g{(const bf16*)WSP(WS_HB), (const bf16*)WSP(WS_WAB), TT, N_AB, 1024, 1024, 1024}; pg8::StaticOrder S; S.init(TT, N_AB, G, bx);
      pg8::EpiBf16 E{(bf16*)WSP(WS_P), N_AB}; pg8::gemm_phase<pg8::EpiBf16, pg8::StaticOrder>(lds, g, S, E, tid); }
    GRID_BAR();
#if DBG_LEVEL >= 2
    if (PH(3)) for (int rep_ = 0; rep_ < REPS(3); ++rep_) { PROLOG mlstm_gate_scan((const float*)WSP(WS_GL), ap->in[I_ABGB], ws, gw, NGW, lane); }
    if (PH(4)) for (int rep_ = 0; rep_ < REPS(4); ++rep_) { PROLOG attn_phase((const bf16*)WSP(WS_P), (bf16*)WSP(WS_HB), ap->in[I_ABSINK], (const float*)WSP(WS_ROPE), lds, (unsigned*)WSP(WS_CTL) + 6144 + 64 * rep_, vcu, G, wave, lane, tid); }
    GRID_BAR();
    if (PH(5)) for (int rep_ = 0; rep_ < REPS(5); ++rep_) { PROLOG mlstm_fused_scan((const bf16*)WSP(WS_P), ws, lds, vcu, G, wave, lane, tid); }
    GRID_BAR();
    if (PH(6)) for (int rep_ = 0; rep_ < REPS(6); ++rep_) { PROLOG mlstm_merge((const bf16*)WSP(WS_P), (bf16*)WSP(WS_HB), ap->in[I_ABNW], ws, gw, NGW, lane); }
    GRID_BAR();
#endif
    if (PH(7)) for (int rep_ = 0; rep_ < REPS(7); ++rep_) { PROLOG pg8::Gemm g{(const bf16*)WSP(WS_HB), (const bf16*)WSP(WS_WABO), TT, 1024, 1024, 1024, 1024}; pg8::StaticOrder S; S.init(TT, 1024, G, bx);
      pg8::EpiBf16 E{(bf16*)WSP(WS_P), 1024}; pg8::gemm_phase<pg8::EpiBf16, pg8::StaticOrder>(lds, g, S, E, tid); }
    GRID_BAR();
    if (PH(8)) for (int rep_ = 0; rep_ < REPS(8); ++rep_) { PROLOG ln_phase(ap->in[I_X], ap->in[I_CTX], ap->out, (float*)WSP(WS_XC), (const bf16*)WSP(WS_P), (const float*)WSP(WS_MOD), ap->in[I_LNW], ap->in[I_LNB], (bf16*)WSP(WS_HB), gw, NGW, lane, DRYV(8), false); }
    GRID_BAR();
#if DBG_LEVEL >= 3
    if (PH(9)) for (int rep_ = 0; rep_ < REPS(9); ++rep_) { PROLOG pg8::Gemm g{(const bf16*)WSP(WS_HB), (const bf16*)WSP(WS_WQ0), TT, 2048, 1024, 1024, 1024}; pg8::StaticOrder S; S.init(TT, 2048, G, bx);
      pg8::EpiBf16 E{(bf16*)WSP(WS_P), 2048}; pg8::gemm_phase<pg8::EpiBf16, pg8::StaticOrder>(lds, g, S, E, tid); }
    GRID_BAR();
    if (PH(10)) for (int rep_ = 0; rep_ < REPS(10); ++rep_) { PROLOG peer_route((const bf16*)WSP(WS_P), (const bf16*)WSP(WS_KEYS), (int*)WSP(WS_ST), (float*)WSP(WS_ST + 17 * MiB), gw, NGW, lane, false); }
    GRID_BAR();
#endif
    if (PH(11)) for (int rep_ = 0; rep_ < REPS(22); ++rep_) { PROLOG peer_pass1((const bf16*)WSP(WS_HB), (const int*)WSP(WS_ST), (const float*)WSP(WS_ST + 17 * MiB), WSP(WS_U), (const float*)WSP(WS_SCL), (const float*)WSP(WS_SCL) + 2 * NEXP, (float*)WSP(WS_ST + 34 * MiB), gw, NGW, lane, false); }
    if (PH(11)) for (int rep_ = 0; rep_ < REPS(11); ++rep_) { PROLOG peer_expert<(DBG_LEVEL >= 3)>((const float*)WSP(WS_ST + 34 * MiB), (const int*)WSP(WS_ST), WSP(WS_V),
        ap->out, (float*)WSP(WS_XC), (const float*)WSP(WS_MOD), ap->in[I_LNW] + 1024, ap->in[I_LNB] + 1024, gw, NGW, lane, DRYV(11), false); }
    GRID_BAR();

    if (PH(12)) for (int rep_ = 0; rep_ < REPS(12); ++rep_) { PROLOG h_phase<32>(ap->out, (const float*)WSP(WS_XC), (const float*)WSP(WS_MOD) + 9 * 6144, (bf16*)WSP(WS_HB), (const float*)WSP(WS_WLOW), (float*)WSP(WS_GL), lds, vcu, G, wave, lane, tid);
 }
    GRID_BAR();
    if (PH(13)) for (int rep_ = 0; rep_ < REPS(13); ++rep_) { PROLOG pg8::Gemm g{(const bf16*)WSP(WS_HB), (const bf16*)WSP(WS_WC), TT, N_C, 1024, 1024, 1024}; pg8::StaticOrder S; S.init(TT, N_C, G, bx);
      pg8::EpiBf16 E{(bf16*)WSP(WS_P), N_C}; pg8::gemm_phase<pg8::EpiBf16, pg8::StaticOrder>(lds, g, S, E, tid); }
    GRID_BAR();
#if DBG_LEVEL >= 2
    if (PH(14)) for (int rep_ = 0; rep_ < REPS(14); ++rep_) { PROLOG gla_prep((bf16*)WSP(WS_P), (bf16*)WSP(WS_HB), (const float*)WSP(WS_GL), ap->in[I_GGUP], ap->in[I_GGB], ws, lds, vcu, G, tid, DRYV(14)); }
    GRID_BAR();
    if (PH(15)) for (int rep_ = 0; rep_ < REPS(15); ++rep_) { PROLOG gla_fused_scan((const bf16*)WSP(WS_P), (const bf16*)WSP(WS_HB), ws, lds, vcu, G, wave, lane, tid, DRYV(15)); }
    GRID_BAR();
    if (PH(16)) for (int rep_ = 0; rep_ < REPS(16); ++rep_) { PROLOG gla_merge((bf16*)WSP(WS_P), ap->in[I_GNW], ws, gw, NGW, lane, DRYV(16)); }
    GRID_BAR();
#endif
    if (PH(17)) for (int rep_ = 0; rep_ < REPS(17); ++rep_) { PROLOG pg8::Gemm g{(const bf16*)WSP(WS_P) + 2048, (const bf16*)WSP(WS_WCO), TT, 1024, 1024, N_C, 1024}; pg8::LatOrder S; S.init(NB * SEQ, 1024, G, bx);
      pg8::EpiBf16 E{(bf16*)WSP(WS_HB), 1024}; pg8::gemm_phase<pg8::EpiBf16, pg8::LatOrder>(lds, g, S, E, tid); }
    GRID_BAR();
    if (PH(18)) for (int rep_ = 0; rep_ < REPS(18); ++rep_) { PROLOG ln_phase(ap->out, (const float*)WSP(WS_XC), ap->out, (float*)WSP(WS_XC), (const bf16*)WSP(WS_HB), (const float*)WSP(WS_MOD) + 9 * 6144, ap->in[I_LNW] + 2048, ap->in[I_LNB] + 2048, (bf16*)WSP(WS_HB), gw, NGW, lane, DRYV(18), true); }
    GRID_BAR();
#if DBG_LEVEL >= 3
    if (PH(19)) for (int rep_ = 0; rep_ < REPS(19); ++rep_) { PROLOG pg8::Gemm g{(const bf16*)WSP(WS_HB), (const bf16*)WSP(WS_WQ1), TT, 2048, 1024, 1024, 1024}; pg8::LatOrder S; S.init(NB * SEQ, 2048, G, bx);
      pg8::EpiBf16 E{(bf16*)WSP(WS_P), 2048}; pg8::gemm_phase<pg8::EpiBf16, pg8::LatOrder>(lds, g, S, E, tid); }
    GRID_BAR();
    if (PH(20)) for (int rep_ = 0; rep_ < REPS(20); ++rep_) { PROLOG peer_route((const bf16*)WSP(WS_P), (const bf16*)WSP(WS_KEYS) + (size_t)8 * 2 * 128 * 128, (int*)WSP(WS_ST), (float*)WSP(WS_ST + 17 * MiB), gw, NGW, lane, true); }
    GRID_BAR();
#endif
    if (PH(21)) for (int rep_ = 0; rep_ < REPS(22); ++rep_) { PROLOG peer_pass1((const bf16*)WSP(WS_HB), (const int*)WSP(WS_ST), (const float*)WSP(WS_ST + 17 * MiB), WSP(WS_U) + (size_t)NEXP * 768, (const float*)WSP(WS_SCL) + NEXP, (const float*)WSP(WS_SCL) + 3 * NEXP, (float*)WSP(WS_ST + 34 * MiB), gw, NGW, lane, true); }
    if (PH(21)) for (int rep_ = 0; rep_ < REPS(21); ++rep_) { PROLOG peer_expert<(DBG_LEVEL >= 3)>((const float*)WSP(WS_ST + 34 * MiB), (const int*)WSP(WS_ST), WSP(WS_V) + (size_t)NEXP * 768,
        ap->out, (float*)WSP(WS_XC), (const float*)WSP(WS_MOD) + 9 * 6144, ap->in[I_LNW] + 3072, ap->in[I_LNB] + 3072, gw, NGW, lane, DRYV(21), true); }
}

extern "C" void kernel_launch(void* const* d_in, const int* in_sizes, int n_in, void* d_out, int out_size, void* d_ws, size_t ws_size, hipStream_t stream) {
    static int grid = 0;
    if (grid == 0) {
        if (n_in != 22 || out_size != NB * SEQ * D || ws_size < 512 * MiB) { fprintf(stderr, "kernel_launch: unexpected shapes: n_in %d out %d ws %zu (need %zu)\n", n_in, out_size, ws_size, (size_t)WS_END); grid = -1; return; }
        int dev = 0, cus = 0, per_cu = 0;
        if (hipGetDevice(&dev) != hipSuccess || hipDeviceGetAttribute(&cus, hipDeviceAttributeMultiprocessorCount, dev) != hipSuccess) { grid = -1; return; }
        if (hipFuncSetAttribute((const void*)fwd_megakernel, hipFuncAttributeMaxDynamicSharedMemorySize, LDS_BYTES) != hipSuccess) { fprintf(stderr, "kernel_launch: hipFuncSetAttribute failed\n"); grid = -1; return; }
        if (hipOccupancyMaxActiveBlocksPerMultiprocessor(&per_cu, (const void*)fwd_megakernel, 512, LDS_BYTES) != hipSuccess || per_cu < 1) { fprintf(stderr, "kernel_launch: occupancy query says %d blocks per CU\n", per_cu); }
        (void)hipGetLastError();
        grid = cus;
        fprintf(stderr, "kernel_launch: grid %d, per_cu %d, ws %zu\n", grid, per_cu, ws_size);
    }
    if (grid < 0) return;
    if (hipMemsetAsync((char*)d_ws + WS_CTL, 0, CTL_ZERO_BYTES, stream) != hipSuccess) return;
    Args a{};
    for (int i = 0; i < 22; ++i) a.in[i] = (const float*)d_in[i];
    a.out = (float*)d_out; a.ws = (unsigned char*)d_ws;
    hipLaunchKernelGGL(fwd_megakernel, dim3(grid), dim3(512), LDS_BYTES, stream, a);
}
```

```cpp
#include <hip/hip_runtime.h>
#include <cstdio>
#include <cstdint>

#define GAS __attribute__((address_space(1)))
#define LAS __attribute__((address_space(3)))
typedef unsigned short bf16;
typedef unsigned v4u __attribute__((ext_vector_type(4)));
typedef unsigned v2u __attribute__((ext_vector_type(2)));
typedef float f32x4 __attribute__((ext_vector_type(4)));
typedef float f32x2 __attribute__((ext_vector_type(2)));
typedef short bf16x8 __attribute__((ext_vector_type(8)));
typedef short s16x4 __attribute__((ext_vector_type(4)));
typedef GAS unsigned gu32;
#define RLX_AGENT __ATOMIC_RELAXED, __HIP_MEMORY_SCOPE_AGENT

constexpr int NB = 8, SEQ = 4096, LC = 256, D = 1024;
constexpr int PB = LC + SEQ;
constexpr int TT = NB * PB;
constexpr int NCH = PB / 64;
constexpr int N_AB = 2816;
constexpr int N_C = 3072;
constexpr float LN_EPS = 1e-5f;
constexpr float DN_ALPHA = 1.41421356237f;
constexpr int NEXP = 16384;
__device__ __forceinline__ int map_row(int i, bool lat_only) { return lat_only ? (i >> 12) * 4352 + 256 + (i & 4095) : i; }

constexpr size_t MiB = 1u << 20;
constexpr size_t WS_CTL = 0, CTL_ZERO_BYTES = 64 * 1024;
constexpr size_t WS_MOD = 1 * MiB;
constexpr size_t WS_ROPE = 2 * MiB;
constexpr size_t WS_WG = 2 * MiB + 64 * 1024;
constexpr size_t WS_WLOW = 2 * MiB + 128 * 1024;
constexpr size_t WS_SCL = 3 * MiB;
constexpr size_t WS_BQ = 4 * MiB, WS_CQ = WS_BQ + 1200 * 1024, WS_EM = WS_CQ + 1200 * 1024, WS_AI = WS_EM + 1200 * 1024;
constexpr size_t WS_AST = WS_AI + 1200 * 1024, WS_CL = WS_AST + 32 * 1024;
constexpr size_t WS_ET = 10 * MiB;
constexpr size_t WS_GL = 13 * MiB;
constexpr size_t WS_WAB = 20 * MiB, WS_WABO = 26 * MiB, WS_WC = 28 * MiB, WS_WCO = 34 * MiB, WS_WQ0 = 36 * MiB, WS_WQ1 = 40 * MiB, WS_KEYS = 44 * MiB;
constexpr size_t WS_NST = 45 * MiB;
constexpr size_t WS_XC = 48 * MiB;
constexpr size_t WS_U = 56 * MiB, WS_V = 88 * MiB;
constexpr size_t WS_HB = 120 * MiB;
constexpr size_t WS_P = 188 * MiB;
constexpr size_t WS_ST = 392 * MiB;
constexpr size_t WS_END = 460 * MiB;

constexpr int LDS_BYTES = 163840;
constexpr int MISC_OFF = LDS_BYTES - 64;

__device__ __forceinline__ unsigned f2bf(float f) { unsigned u = __builtin_bit_cast(unsigned, f); return (u + 0x7fffu + ((u >> 16) & 1u)) >> 16; }
__device__ __forceinline__ unsigned pk2(float lo, float hi) { return f2bf(lo) | (f2bf(hi) << 16); }
__device__ __forceinline__ float bflo(unsigned w) { return __builtin_bit_cast(float, w << 16); }
__device__ __forceinline__ float bfhi(unsigned w) { return __builtin_bit_cast(float, w & 0xffff0000u); }
__device__ __forceinline__ float bf2f(bf16 b) { return __builtin_bit_cast(float, (unsigned)b << 16); }
template <int CTRL> __device__ __forceinline__ float dppmov_f(float x) { return __builtin_bit_cast(float, __builtin_amdgcn_mov_dpp(__builtin_bit_cast(int, x), CTRL, 0xf, 0xf, true)); }
__device__ __forceinline__ float wave_sum(float v) {
    v += dppmov_f<0xB1>(v); v += dppmov_f<0x4E>(v); v += dppmov_f<0x141>(v); v += dppmov_f<0x128>(v);
    v += __shfl_xor(v, 16); v += __shfl_xor(v, 32);
    return v;
}
__device__ __forceinline__ float sigmoidf_(float x) { return 1.f / (1.f + __expf(-x)); }
__device__ __forceinline__ float logsigmoidf_(float x) { return fminf(x, 0.f) - log1pf(__expf(-fabsf(x))); }
__device__ __forceinline__ float siluf_(float x) { return x / (1.f + __expf(-x)); }

namespace pg8 {
#define PG8_LAS __attribute__((address_space(3)))
typedef unsigned short bf16_t;
typedef short bf16x8 __attribute__((ext_vector_type(8)));
typedef float f32x4 __attribute__((ext_vector_type(4)));
typedef unsigned u32x4 __attribute__((ext_vector_type(4)));
constexpr int BM = 256, BK = 64, HALF = 128, HTB = HALF * BK * 2  , STAGE_BYTES = 8 * HTB, NXCD = 8, WGM = 8;

__host__ __device__ __forceinline__ int lds_byte(int r, int c) { const int st = (r >> 4) * 2 + (c >> 5), rr = r & 15, cc = c & 31, ob = rr * 64 + cc * 2; return st * 1024 + (ob ^ (((ob >> 9) & 1) << 5)); }
__host__ __device__ __forceinline__ void stage_rc(int b, int& R, int& C) { const int st = b / 1024, sb = b % 1024, swz = sb ^ (((sb >> 9) & 1) << 5); R = (st >> 1) * 16 + swz / 64; C = (st & 1) * 32 + (swz % 64) / 2; }
__host__ __device__ __forceinline__ int perm32(int rho) { const int n = rho >> 4, i = rho & 15; return 8 * (i >> 2) + 4 * n + (i & 3); }

struct Unit { int pm, pn; };
struct Gemm { const bf16_t* A; const bf16_t* Bt; int M, N, K, lda, ldb; };

struct StaticOrder {
    int nM, nN, nwg, G, c;
    __host__ __device__ void init(int M, int N, int G_, int c_) { nM = M / BM; nN = N / BM; nwg = nM * nN; G = G_; c = c_; }
    __host__ __device__ bool next(int i, Unit& u) const {
        const long L = (long)i * G + c; if (L >= nwg) return false;
        int wgid = (int)L; { const int q = nwg / NXCD, r = nwg % NXCD, xcd = wgid % NXCD, off = wgid / NXCD; wgid = (xcd < r ? xcd * (q + 1) : r * (q + 1) + (xcd - r) * q) + off; }
        const int nig = WGM * nN, gid = wgid / nig, fm = gid * WGM, gsz = (nM - fm) < WGM ? (nM - fm) : WGM;
        u.pm = fm + ((wgid % nig) % gsz); u.pn = (wgid % nig) / gsz; return true;
    }
    __device__ __forceinline__ void a_ready(const Unit&) const {}
    __device__ __forceinline__ void done(const Unit&) const {}
};

struct LatOrder : StaticOrder {
    __host__ __device__ bool next(int i, Unit& u) const { if (!StaticOrder::next(i, u)) return false; u.pm = (u.pm >> 4) * 17 + 1 + (u.pm & 15); return true; }
};
__device__ __forceinline__ unsigned cvt_pk_bf16(float lo, float hi) { unsigned r; asm volatile("v_cvt_pk_bf16_f32 %0, %1, %2" : "=v"(r) : "v"(lo), "v"(hi)); return r; }
struct EpiBf16 {
    static constexpr bool PERM = true, AFTER_DRAIN = false;
    bf16_t* O; int ldc;
    __device__ __forceinline__ void operator()(const f32x4 (&acc)[2][2][4][2], const Unit& u, int wr, int wc, int fr, int fq) const {
        const int row0 = u.pm * BM + wr * 64 + fr; const int col0 = u.pn * BM + wc * 32 + 8 * fq;
#pragma unroll
        for (int ai = 0; ai < 2; ++ai)
#pragma unroll
            for (int m = 0; m < 4; ++m) { bf16_t* rowp = O + (size_t)(row0 + ai * HALF + m * 16) * ldc + col0;
#pragma unroll
                for (int bj = 0; bj < 2; ++bj) { const f32x4 v0 = acc[ai][bj][m][0], v1 = acc[ai][bj][m][1];
                    u32x4 w; w.x = cvt_pk_bf16(v0[0], v0[1]); w.y = cvt_pk_bf16(v0[2], v0[3]); w.z = cvt_pk_bf16(v1[0], v1[1]); w.w = cvt_pk_bf16(v1[2], v1[3]);
                    *(u32x4*)(rowp + bj * HALF) = w; } }
    }
};
struct EpiResid {
    static constexpr bool PERM = false, AFTER_DRAIN = false;
    const float* src_lat; const float* src_ctx; float* dst_lat; float* dst_ctx; const float* gate; float gscale; int dry;
    __device__ __forceinline__ void operator()(const f32x4 (&acc)[2][2][4][2], const Unit& u, int wr, int wc, int fr, int fq) const {
        const int b = u.pm / 17, tb = u.pm - b * 17;
        const float* sbase; float* dbase; const float* gr;
        if (tb == 0) { sbase = src_ctx + (size_t)b * 256 * 1024; dbase = dst_ctx + (size_t)b * 256 * 1024; gr = gate + 8 * 6144; }
        else { sbase = src_lat + ((size_t)b * 4096 + (size_t)(tb - 1) * 256) * 1024; dbase = dst_lat + ((size_t)b * 4096 + (size_t)(tb - 1) * 256) * 1024; gr = gate + b * 6144; }
        const int row0 = wr * 64 + fr, col0 = u.pn * BM + wc * 32 + 4 * fq;
        f32x4 gv[2][2];
#pragma unroll
        for (int bj = 0; bj < 2; ++bj)
#pragma unroll
            for (int n = 0; n < 2; ++n) gv[bj][n] = *(const f32x4*)(gr + col0 + bj * HALF + n * 16) * gscale;
#pragma unroll
        for (int ai = 0; ai < 2; ++ai)
#pragma unroll
            for (int mp = 0; mp < 2; ++mp) {
                f32x4 sv[2][2][2];
#pragma unroll
                for (int mm = 0; mm < 2; ++mm) { const size_t off = (size_t)(row0 + ai * HALF + (2 * mp + mm) * 16) * 1024 + col0;
#pragma unroll
                    for (int bj = 0; bj < 2; ++bj)
#pragma unroll
                        for (int n = 0; n < 2; ++n) sv[mm][bj][n] = __builtin_nontemporal_load((const f32x4*)(sbase + off + bj * HALF + n * 16)); }
                asm volatile("" ::: "memory");
#pragma unroll
                for (int mm = 0; mm < 2; ++mm) { const int m = 2 * mp + mm; const size_t off = (size_t)(row0 + ai * HALF + m * 16) * 1024 + col0;
#pragma unroll
                    for (int bj = 0; bj < 2; ++bj)
#pragma unroll
                        for (int n = 0; n < 2; ++n) { const f32x4 ov = sv[mm][bj][n] * 1.41421356237f + gv[bj][n] * acc[ai][bj][m][n]; if (!dry) *(f32x4*)(dbase + off + bj * HALF + n * 16) = ov; } }
                asm volatile("" ::: "memory");
            }
    }
};

template <class Epi, class Sched>
__device__ __forceinline__ void gemm_phase(PG8_LAS unsigned char* lds, const Gemm g, const Sched& S, const Epi& E, const int tid_in) {
    const int tid = tid_in, wid = __builtin_amdgcn_readfirstlane(tid >> 6), lane = tid & 63, wr = wid >> 2, wc = wid & 3, fr = lane & 15, fq = lane >> 4;
    const int K = g.K, nt = K / BK;
    unsigned voffA[2], voffB[2];
#pragma unroll
    for (int i = 0; i < 2; ++i) { int R, C; stage_rc(tid * 16 + i * 8192, R, C); const int Rb = Epi::PERM ? ((R & ~31) + perm32(R & 31)) : R;
        voffA[i] = (unsigned)(R * g.lda + C) * 2u; voffB[i] = (unsigned)(Rb * g.ldb + C) * 2u; }
    const size_t kstep = (size_t)(BK * 2);
    const size_t hstepA = (size_t)HALF * g.lda * 2, hstepB = (size_t)HALF * g.ldb * 2;
    const size_t tstepA = 2 * hstepA, tstepB = 2 * hstepB;
    const unsigned ldsw = (unsigned)wid * 1024u;
    const int aoff = lds_byte(wr * 64 + fr, fq * 8), boff = lds_byte(wc * 32 + fr, fq * 8);
#define PG8_SA(b, h) (((b) * 2 + (h)) * HTB)
#define PG8_SB(b, h) ((4 + (b) * 2 + (h)) * HTB)
#define PG8_STAGE(bufoff, gbase, voff) do { _Pragma("unroll") for (int _i = 0; _i < 2; ++_i) \
        __builtin_amdgcn_global_load_lds((const unsigned*)((const char*)(gbase) + (voff)[_i]), (PG8_LAS unsigned*)(lds + (bufoff) + ldsw + _i * 8192), 16, 0, 0); } while (0)
#define PG8_LDA(dst, b, h) do { _Pragma("unroll") for (int m = 0; m < 4; ++m) _Pragma("unroll") for (int k = 0; k < 2; ++k) dst[m][k] = *(const PG8_LAS bf16x8*)(lds + PG8_SA(b, h) + aoff + m * 2048 + k * 1024); } while (0)
#define PG8_LDB(dst, b, h) do { _Pragma("unroll") for (int n = 0; n < 2; ++n) _Pragma("unroll") for (int k = 0; k < 2; ++k) dst[n][k] = *(const PG8_LAS bf16x8*)(lds + PG8_SB(b, h) + boff + n * 2048 + k * 1024); } while (0)
#define PG8_MMA(ai, bj, At, Bt) do { __builtin_amdgcn_s_setprio(1); _Pragma("unroll") for (int m = 0; m < 4; ++m) _Pragma("unroll") for (int n = 0; n < 2; ++n) _Pragma("unroll") for (int k = 0; k < 2; ++k) \
        acc[ai][bj][m][n] = __builtin_amdgcn_mfma_f32_16x16x32_bf16(Bt[n][k], At[m][k], acc[ai][bj][m][n], 0, 0, 0); __builtin_amdgcn_s_setprio(0); } while (0)
#define PG8_WAIT_V(n) asm volatile("s_waitcnt vmcnt(" #n ")" ::: "memory")
#define PG8_WAIT_L(n) asm volatile("s_waitcnt lgkmcnt(" #n ")" ::: "memory")
#define PG8_BAR __builtin_amdgcn_s_barrier()
#define PG8_SCHED __builtin_amdgcn_sched_barrier(0)
    Unit cur, nxt; int ui = 0;
    if (!S.next(0, cur)) return;
    f32x4 acc[2][2][4][2];
#pragma unroll
    for (int a = 0; a < 2; ++a)
#pragma unroll
        for (int b = 0; b < 2; ++b)
#pragma unroll
            for (int m = 0; m < 4; ++m)
#pragma unroll
                for (int n = 0; n < 2; ++n) acc[a][b][m][n] = (f32x4){0.f, 0.f, 0.f, 0.f};
    bf16x8 At[4][2], B0[2][2], B1[2][2];
    const char* cA = (const char*)g.A + (size_t)cur.pm * tstepA; const char* cB = (const char*)g.Bt + (size_t)cur.pn * tstepB;
    S.a_ready(cur);
    PG8_STAGE(PG8_SB(0, 0), cB, voffB); PG8_STAGE(PG8_SA(0, 0), cA, voffA); PG8_STAGE(PG8_SB(0, 1), cB + hstepB, voffB); PG8_STAGE(PG8_SA(0, 1), cA + hstepA, voffA);
    if (wr == 1) PG8_BAR;
    PG8_WAIT_V(4); PG8_BAR;
    PG8_STAGE(PG8_SB(1, 0), cB + kstep, voffB); PG8_STAGE(PG8_SA(1, 0), cA + kstep, voffA); PG8_STAGE(PG8_SB(1, 1), cB + hstepB + kstep, voffB);
    PG8_WAIT_V(6); PG8_BAR;
    for (;;) {
        const bool has_next = S.next(ui + 1, nxt);
        const char* nA = has_next ? (const char*)g.A + (size_t)nxt.pm * tstepA : cA; const char* nB = has_next ? (const char*)g.Bt + (size_t)nxt.pn * tstepB : cB;
        for (int t = 0; t < nt; t += 2) {
            const bool last = (t == nt - 2);
            const char* a1 = cA + (size_t)(t + 1) * kstep;
            const char* a2 = last ? nA : cA + (size_t)(t + 2) * kstep; const char* b2 = last ? nB : cB + (size_t)(t + 2) * kstep;
            const char* a3 = a2 + kstep; const char* b3 = b2 + kstep;
            if (last && has_next) S.a_ready(nxt);
            PG8_LDB(B0, 0, 0); PG8_SCHED; PG8_LDA(At, 0, 0); PG8_STAGE(PG8_SA(1, 1), a1 + hstepA, voffA);
            PG8_WAIT_L(8); PG8_BAR; PG8_WAIT_L(0); PG8_MMA(0, 0, At, B0); PG8_BAR; PG8_SCHED;
            PG8_LDB(B1, 0, 1); PG8_STAGE(PG8_SB(0, 0), b2, voffB);
            PG8_BAR; PG8_WAIT_L(0); PG8_MMA(0, 1, At, B1); PG8_BAR;
            PG8_LDA(At, 0, 1); PG8_STAGE(PG8_SA(0, 0), a2, voffA);
            PG8_BAR; PG8_WAIT_L(0); PG8_MMA(1, 0, At, B0); PG8_BAR; PG8_SCHED;
            PG8_STAGE(PG8_SB(0, 1), b2 + hstepB, voffB);
            PG8_WAIT_V(6); PG8_BAR; PG8_MMA(1, 1, At, B1); PG8_BAR;
            PG8_LDB(B0, 1, 0); PG8_SCHED; PG8_LDA(At, 1, 0); PG8_STAGE(PG8_SA(0, 1), a2 + hstepA, voffA);
            PG8_WAIT_L(8); PG8_BAR; PG8_WAIT_L(0); PG8_MMA(0, 0, At, B0); PG8_BAR; PG8_SCHED;
            PG8_LDB(B1, 1, 1); PG8_STAGE(PG8_SB(1, 0), b3, voffB);
            PG8_BAR; PG8_WAIT_L(0); PG8_MMA(0, 1, At, B1); PG8_BAR;
            PG8_LDA(At, 1, 1); PG8_STAGE(PG8_SA(1, 0), a3, voffA);
            PG8_BAR; PG8_WAIT_L(0); PG8_MMA(1, 0, At, B0); PG8_BAR; PG8_SCHED;
            PG8_STAGE(PG8_SB(1, 1), b3 + hstepB, voffB);
            PG8_WAIT_V(6); PG8_BAR; PG8_MMA(1, 1, At, B1); PG8_BAR;
        }
        if constexpr (!Epi::AFTER_DRAIN) { E(acc, cur, wr, wc, fr, fq); S.done(cur); }
        if (!has_next) break;
#pragma unroll
        for (int a = 0; a < 2; ++a)
#pragma unroll
            for (int b = 0; b < 2; ++b)
#pragma unroll
                for (int m = 0; m < 4; ++m)
#pragma unroll
                    for (int n = 0; n < 2; ++n) acc[a][b][m][n] = (f32x4){0.f, 0.f, 0.f, 0.f};
        cur = nxt; cA = nA; cB = nB; ++ui;
    }
    PG8_WAIT_V(0);
    if (wr == 0) PG8_BAR;
    PG8_BAR;
    if constexpr (Epi::AFTER_DRAIN) { E.fused(acc, cur, wr, wc, fr, fq, lds, wid, lane); S.done(cur); }
#undef PG8_SA
#undef PG8_SB
#undef PG8_STAGE
#undef PG8_LDA
#undef PG8_LDB
#undef PG8_MMA
#undef PG8_WAIT_V
#undef PG8_WAIT_L
#undef PG8_BAR
#undef PG8_SCHED
}
}

#define XB_TMO      128
#define XB_XCNT(j)  (256  + 64 * (j))
#define XB_XSUB(j)  (1280 + 64 * (j))
#define XB_XGEN(j)  (2304 + 64 * (j))
#define XB_TOP      3328
#define XB_TOPGEN   3392
#define XCD_BAR_WORDS 3456
#define XB_SPIN_CAP (1u << 18)

__device__ __forceinline__ unsigned xb_ld(unsigned* p)              { return __hip_atomic_load(p, __ATOMIC_RELAXED, __HIP_MEMORY_SCOPE_AGENT); }
__device__ __forceinline__ unsigned xb_add(unsigned* p, unsigned v) { return __hip_atomic_fetch_add(p, v, __ATOMIC_RELAXED, __HIP_MEMORY_SCOPE_AGENT); }
__device__ __forceinline__ unsigned xb_xcc_id() { return (unsigned)__builtin_amdgcn_s_getreg((3 << 11) | 20) & 0xFu; }
#define XB_SPIN(cond, bar) do { unsigned _sp = 0; while (cond) { __builtin_amdgcn_s_sleep(1); \
    if ((++_sp & 255u) == 0u) { if (xb_ld(&(bar)[XB_TMO])) break; if (_sp > XB_SPIN_CAP) { atomicAdd(&(bar)[XB_TMO], 1u); break; } } } } while (0)

struct XcdBarrier {
    unsigned* bar; unsigned x;
    volatile LAS unsigned* st;
};

__device__ __forceinline__ XcdBarrier xcd_barrier_post(unsigned* bar, volatile LAS unsigned* st) {
    XcdBarrier b; b.bar = bar; b.x = xb_xcc_id(); b.st = st;
    if (threadIdx.x == 0) (void)xb_add(&bar[XB_XCNT(b.x)], 1u);
    return b;
}
__device__ __forceinline__ void xcd_barrier_complete(unsigned* bar, unsigned x, unsigned& nloc, unsigned& nx) {
    const unsigned G = gridDim.x * gridDim.y * gridDim.z;
    unsigned sum, cnt, mine, sp = 0u;
    for (;;) {
        sum = 0u; cnt = 0u; mine = 0u;
#pragma unroll
        for (unsigned j = 0; j < 16; ++j) { const unsigned c = xb_ld(&bar[XB_XCNT(j)]); sum += c; cnt += (c > 0u) ? 1u : 0u; mine = (j == x) ? c : mine; }
        if (sum == G) break;
        __builtin_amdgcn_s_sleep(1);
        if ((++sp & 255u) == 0u) { if (xb_ld(&bar[XB_TMO])) break; if (sp > XB_SPIN_CAP) { atomicAdd(&bar[XB_TMO], 1u); break; } }
    }
    nloc = mine > 0u ? mine : 1u; nx = cnt > 0u ? cnt : 1u;
}

__device__ __forceinline__ void xcd_barrier(const XcdBarrier& b) {
    asm volatile("s_waitcnt vmcnt(0)" ::: "memory");
    __syncthreads();
    if (threadIdx.x == 0) {
        unsigned* bar = b.bar;
        __builtin_amdgcn_s_waitcnt(0);
        unsigned nloc = b.st[0], nx = b.st[1];
        if (nloc == 0u) { xcd_barrier_complete(bar, b.x, nloc, nx); b.st[0] = nloc; b.st[1] = nx; }
        const unsigned old = xb_add(&bar[XB_XSUB(b.x)], 1u);
        const unsigned gen = old / nloc;
        if (old + 1u == (gen + 1u) * nloc) {
            __builtin_amdgcn_fence(__ATOMIC_RELEASE, "agent");
            asm volatile("s_waitcnt vmcnt(0)" ::: "memory");
            const unsigned og = xb_add(&bar[XB_TOP], 1u);
            const unsigned tg = og / nx;
            if (og + 1u == (tg + 1u) * nx) xb_add(&bar[XB_TOPGEN], 1u);
            else XB_SPIN(xb_ld(&bar[XB_TOPGEN]) == tg, bar);
            __builtin_amdgcn_fence(__ATOMIC_ACQUIRE, "agent");
            xb_add(&bar[XB_XGEN(b.x)], 1u);
            asm volatile("s_waitcnt vmcnt(0)" ::: "memory");
        } else {
            XB_SPIN(xb_ld(&bar[XB_XGEN(b.x)]) == gen, bar);
            __builtin_amdgcn_fence(__ATOMIC_ACQUIRE, "agent");
            asm volatile("s_waitcnt vmcnt(0)" ::: "memory");
        }
    }
    __syncthreads();
}


__device__ __forceinline__ f32x4 mma(bf16x8 a, bf16x8 b, f32x4 c) { return __builtin_amdgcn_mfma_f32_16x16x32_bf16(a, b, c, 0, 0, 0); }
__device__ __forceinline__ bf16x8 frag_row(const LAS bf16* t, int ld, int r0, int c0, int lane) {
    return *(const LAS bf16x8*)(t + (r0 + (lane & 15)) * ld + c0 + 8 * (lane >> 4));
}
__device__ __forceinline__ bf16x8 frag_tr(const LAS bf16* t, int ld, int r0, int c0, int lane) {
    const int g = lane >> 4, q = (lane & 15) >> 2, p = lane & 3;
    const LAS bf16* a = t + (r0 + 8 * g + q) * ld + c0 + 4 * p;
    const s16x4 lo = __builtin_amdgcn_ds_read_tr16_b64_v4i16((LAS s16x4*)a);
    const s16x4 hi = __builtin_amdgcn_ds_read_tr16_b64_v4i16((LAS s16x4*)(a + 4 * ld));
    return (bf16x8){lo[0], lo[1], lo[2], lo[3], hi[0], hi[1], hi[2], hi[3]};
}
#define LDS_FENCE() do { asm volatile("s_waitcnt lgkmcnt(0)" ::: "memory"); __builtin_amdgcn_wave_barrier(); } while (0)

struct Args {
    const float* in[22]; float* out; unsigned char* ws;
};
enum { I_X = 0, I_C, I_CTX, I_CCTX, I_WMOD, I_BMOD, I_LNW, I_LNB, I_ABWIN, I_ABGB, I_ABNW, I_ABSINK, I_ABWOUT, I_GWIN, I_GGUP, I_GGB, I_GNW, I_GWOUT, I_PWQ, I_PKEYS, I_PU, I_PV };

__device__ __forceinline__ const float* srow_c(const float* lat, const float* ctx, int r) { const int b = r / PB, p = r - b * PB; return p < LC ? ctx + (size_t)(b * LC + p) * D : lat + (size_t)(b * SEQ + p - LC) * D; }
__device__ __forceinline__ float* srow(float* lat, float* ctx, int r) { const int b = r / PB, p = r - b * PB; return p < LC ? ctx + (size_t)(b * LC + p) * D : lat + (size_t)(b * SEQ + p - LC) * D; }

__device__ __forceinline__ void p0_transpose_item(const float* W, int K, int ldw, int c0, int ncols, bf16* WT, int row_off, LAS float* scr, int item, int lane,
                                                  int s0lo, int s0hi, float s0, int s1lo, int s1hi, float s1) {
    const int nblk = ncols / 32, kb = item / nblk, nb = item % nblk, k0 = 64 * kb, n0 = 32 * nb;
#pragma unroll 8
    for (int i = 0; i < 32; ++i) { const int kk = 2 * i + (lane >> 5); scr[kk * 33 + (lane & 31)] = W[(size_t)(k0 + kk) * ldw + c0 + n0 + (lane & 31)]; }
    asm volatile("s_waitcnt lgkmcnt(0)" ::: "memory");
    const int c = lane & 7;
#pragma unroll
    for (int j = 0; j < 4; ++j) { const int n = (lane >> 3) + 8 * j; const LAS float* s = scr + (8 * c) * 33 + n;
        const int dr = row_off + n0 + n; float sc = 1.f; if (dr >= s0lo && dr < s0hi) sc = s0; if (dr >= s1lo && dr < s1hi) sc = s1;
        v4u o; o.x = pk2(s[0 * 33] * sc, s[1 * 33] * sc); o.y = pk2(s[2 * 33] * sc, s[3 * 33] * sc); o.z = pk2(s[4 * 33] * sc, s[5 * 33] * sc); o.w = pk2(s[6 * 33] * sc, s[7 * 33] * sc);
        *(v4u*)(WT + (size_t)dr * K + k0 + 8 * c) = o; }
    asm volatile("s_waitcnt lgkmcnt(0)" ::: "memory");
}
__device__ __forceinline__ void cvt_f32_bf16(const float* src, bf16* dst, size_t n, int gtid, int gthreads) {
    const size_t nch = n / 8;
    for (size_t i = gtid; i < nch; i += gthreads) { const f32x4 a = *(const f32x4*)(src + i * 8), b = *(const f32x4*)(src + i * 8 + 4);
        v4u o; o.x = pk2(a[0], a[1]); o.y = pk2(a[2], a[3]); o.z = pk2(b[0], b[1]); o.w = pk2(b[2], b[3]); *(v4u*)(dst + i * 8) = o; }
}
typedef float v16f __attribute__((ext_vector_type(16)));
typedef float v32f __attribute__((ext_vector_type(32)));
typedef unsigned v6u __attribute__((ext_vector_type(6)));
typedef unsigned v3u __attribute__((ext_vector_type(3)));
__device__ __forceinline__ void cvt_rows_fp6(const float* src, unsigned char* dst, float* inv, int nrows, int gw, int NGW, int lane) {
    const int hl = lane & 31, hh = lane >> 5;
    for (int r2 = gw; r2 < nrows / 2; r2 += NGW) {
        const int r = 2 * r2 + hh; const float* sp = src + (size_t)r * 1024 + 32 * hl;
        f32x4 x[8]; float m = 0.f;
#pragma unroll
        for (int q = 0; q < 8; ++q) { x[q] = *(const f32x4*)(sp + 4 * q); m = fmaxf(m, fmaxf(fmaxf(fabsf(x[q][0]), fabsf(x[q][1])), fmaxf(fabsf(x[q][2]), fabsf(x[q][3])))); }
        m = fmaxf(m, dppmov_f<0xB1>(m)); m = fmaxf(m, dppmov_f<0x4E>(m)); m = fmaxf(m, dppmov_f<0x141>(m)); m = fmaxf(m, dppmov_f<0x128>(m)); m = fmaxf(m, __shfl_xor(m, 16));
        const float sc = m > 0.f ? 7.0f / m : 1.f;
        v16f a, b;
#pragma unroll
        for (int q = 0; q < 8; ++q) { a[2 * q] = x[q][0] * sc; b[2 * q] = x[q][1] * sc; a[2 * q + 1] = x[q][2] * sc; b[2 * q + 1] = x[q][3] * sc; }
        const v6u p = __builtin_amdgcn_cvt_scalef32_2xpk16_fp6_f32(a, b, 1.0f);
        unsigned char* dp = dst + (size_t)r * 768 + 24 * hl;
        *(v2u*)dp = (v2u){p[0], p[1]}; *(v2u*)(dp + 8) = (v2u){p[2], p[3]}; *(v2u*)(dp + 16) = (v2u){p[4], p[5]};
        if (hl == 0) inv[r] = m > 0.f ? m / 7.0f : 1.f;
    }
}
__device__ __forceinline__ void p0_prologue(const Args& A, LAS unsigned char* lds, int vcu, int G, int wave, int lane, int tid) {
    unsigned char* ws = A.ws;
    const int gw = vcu * 8 + wave, NGW = G * 8, gtid = vcu * 512 + tid, gthreads = G * 512;
    LAS float* sil = (LAS float*)lds;
    for (int i = tid; i < 9 * 1024; i += 512) { const float v = i < 8192 ? A.in[I_C][i] : A.in[I_CCTX][i - 8192]; sil[i] = siluf_(v); }
    __syncthreads();
    float* MOD = (float*)(ws + WS_MOD);
    LAS float* part = (LAS float*)(lds + 40960);
    for (int it = vcu; it < 2 * 96; it += G) {
        const int l = it / 96, n = (it % 96) * 64 + lane; const float* wm = A.in[I_WMOD] + (size_t)l * 1024 * 6144 + (size_t)(128 * wave) * 6144 + n;
        float acc[9];
#pragma unroll
        for (int r = 0; r < 9; ++r) acc[r] = 0.f;
#pragma unroll 8
        for (int k = 0; k < 128; ++k) { const float w = wm[(size_t)k * 6144];
#pragma unroll
            for (int r = 0; r < 9; ++r) acc[r] += sil[r * 1024 + 128 * wave + k] * w; }
        __syncthreads();
#pragma unroll
        for (int r = 0; r < 9; ++r) part[(wave * 9 + r) * 64 + lane] = acc[r];
        __syncthreads();
        for (int i = tid; i < 9 * 64; i += 512) { float sum = 0.f;
#pragma unroll
            for (int w8 = 0; w8 < 8; ++w8) sum += part[w8 * 576 + i];
            const int r = i >> 6, c = (it % 96) * 64 + (i & 63); MOD[(size_t)(l * 9 + r) * 6144 + c] = sum + A.in[I_BMOD][l * 6144 + c]; }
    }
    __syncthreads();
    LAS float* scr = (LAS float*)(lds + 40960 + wave * 8704);
    constexpr int I_AB1 = 16 * 64, I_AB2 = 16 * 24, I_ABO = 16 * 32, I_C1 = 16 * 96, I_CO = 16 * 32, I_Q = 16 * 64;
    constexpr int NITEMS = I_AB1 + I_AB2 + I_ABO + I_C1 + I_CO + 2 * I_Q;
    const float rs128 = 0.08838834764831845f;
    for (int it = gw; it < NITEMS; it += NGW) {
        int r = it;
        if (r < I_AB1) { p0_transpose_item(A.in[I_ABWIN], 1024, 2832, 0, 2048, (bf16*)(ws + WS_WAB), 0, scr, r, lane, 512, 1024, rs128, 0, 0, 1.f); continue; } r -= I_AB1;
        if (r < I_AB2) { p0_transpose_item(A.in[I_ABWIN], 1024, 2832, 2064, 768, (bf16*)(ws + WS_WAB), 2048, scr, r, lane, 2048, 2560, 0.125f, 0, 0, 1.f); continue; } r -= I_AB2;
        if (r < I_ABO) { p0_transpose_item(A.in[I_ABWOUT], 1024, 1024, 0, 1024, (bf16*)(ws + WS_WABO), 0, scr, r, lane, 0, 0, 1.f, 0, 0, 1.f); continue; } r -= I_ABO;
        if (r < I_C1) { p0_transpose_item(A.in[I_GWIN], 1024, 3104, 0, 3072, (bf16*)(ws + WS_WC), 0, scr, r, lane, 0, 512, rs128, 0, 0, 1.f); continue; } r -= I_C1;
        if (r < I_CO) { p0_transpose_item(A.in[I_GWOUT], 1024, 1024, 0, 1024, (bf16*)(ws + WS_WCO), 0, scr, r, lane, 0, 0, 1.f, 0, 0, 1.f); continue; } r -= I_CO;
        if (r < I_Q) { p0_transpose_item(A.in[I_PWQ], 1024, 2048, 0, 2048, (bf16*)(ws + WS_WQ0), 0, scr, r, lane, 0, 0, 1.f, 0, 0, 1.f); continue; } r -= I_Q;
        p0_transpose_item(A.in[I_PWQ] + (size_t)1024 * 2048, 1024, 2048, 0, 2048, (bf16*)(ws + WS_WQ1), 0, scr, r, lane, 0, 0, 1.f, 0, 0, 1.f);
    }
    for (int i = gtid; i < 16 * 1024; i += gthreads) { const int g = i >> 10, k = i & 1023; ((float*)(ws + WS_WG))[i] = A.in[I_ABWIN][(size_t)k * 2832 + 2048 + g]; }
    for (int i = gtid; i < 32 * 1024; i += gthreads) { const int g = i >> 10, k = i & 1023; ((float*)(ws + WS_WLOW))[i] = A.in[I_GWIN][(size_t)k * 3104 + 3072 + g]; }
    for (int i = gtid; i < 64 * 16; i += gthreads) { const int pos = i >> 4, f = i & 15; const float inv = powf(10000.f, -(float)f / 16.f); const float ang = (float)pos * inv;
        ((float*)(ws + WS_ROPE))[2 * i] = cosf(ang); ((float*)(ws + WS_ROPE))[2 * i + 1] = sinf(ang); }
    cvt_f32_bf16(A.in[I_PKEYS], (bf16*)(ws + WS_KEYS), (size_t)2 * 8 * 2 * 128 * 128, gtid, gthreads);
    cvt_rows_fp6(A.in[I_PU], ws + WS_U, (float*)(ws + WS_SCL), 2 * NEXP, gw, NGW, lane);
    cvt_rows_fp6(A.in[I_PV], ws + WS_V, (float*)(ws + WS_SCL) + 2 * NEXP, 2 * NEXP, gw, NGW, lane);
}

__device__ __forceinline__ void split8(const float* v, bf16x8& hi, bf16x8& lo) {
#pragma unroll
    for (int j = 0; j < 8; ++j) { const unsigned h = f2bf(v[j]); const float hf = __builtin_bit_cast(float, h << 16); hi[j] = (short)h; lo[j] = (short)f2bf(v[j] - hf); }
}
template <int NG>
__device__ __forceinline__ void h_phase(const float* lat, const float* ctx, const float* mod  , bf16* HB, const float* WGT, float* GL, LAS unsigned char* lds, int vcu, int G, int wave, int lane, int tid) {
    constexpr int NT = NG / 16;
    LAS float* part = (LAS float*)lds;
    const int g = lane >> 4, c16 = lane & 15;
    bf16x8 bhi[NT][4], blo[NT][4];
#pragma unroll
    for (int nt = 0; nt < NT; ++nt)
#pragma unroll
        for (int ks = 0; ks < 4; ++ks) { const float* wp = WGT + (size_t)(16 * nt + c16) * 1024 + 128 * wave + 32 * ks + 8 * g;
            const f32x4 w0 = *(const f32x4*)wp, w1 = *(const f32x4*)(wp + 4); const float wv[8] = {w0[0], w0[1], w0[2], w0[3], w1[0], w1[1], w1[2], w1[3]}; split8(wv, bhi[nt][ks], blo[nt][ks]); }
    for (int tile = vcu; tile < TT / 16; tile += G) {
        const int r0 = tile * 16, b = r0 / PB, p0 = r0 - b * PB; const float* mr = mod + (size_t)(p0 < LC ? 8 : b) * 6144 + 128 * wave + 8 * g;
        const int row = r0 + c16; const float* xr = srow_c(lat, ctx, row) + 128 * wave + 8 * g;
        f32x4 xa[4][2], sha[4][2], sca[4][2];
#pragma unroll
        for (int ks = 0; ks < 4; ++ks)
#pragma unroll
            for (int q = 0; q < 2; ++q) { xa[ks][q] = *(const f32x4*)(xr + 32 * ks + 4 * q); sha[ks][q] = *(const f32x4*)(mr + 32 * ks + 4 * q); sca[ks][q] = *(const f32x4*)(mr + 1024 + 32 * ks + 4 * q); }
        f32x4 acc[NT];
#pragma unroll
        for (int nt = 0; nt < NT; ++nt) acc[nt] = (f32x4){0.f, 0.f, 0.f, 0.f};
#pragma unroll
        for (int ks = 0; ks < 4; ++ks) {
            float hv[8];
#pragma unroll
            for (int q = 0; q < 2; ++q)
#pragma unroll
                for (int i = 0; i < 4; ++i) hv[4 * q + i] = xa[ks][q][i] * (sca[ks][q][i] + 1.0f) + sha[ks][q][i];
            bf16x8 ahi, alo; split8(hv, ahi, alo);
            *(bf16x8*)(HB + (size_t)row * D + 128 * wave + 32 * ks + 8 * g) = ahi;
#pragma unroll
            for (int nt = 0; nt < NT; ++nt) { acc[nt] = mma(ahi, bhi[nt][ks], acc[nt]); acc[nt] = mma(ahi, blo[nt][ks], acc[nt]); acc[nt] = mma(alo, bhi[nt][ks], acc[nt]); }
        }
        __syncthreads();
#pragma unroll
        for (int nt = 0; nt < NT; ++nt)
#pragma unroll
            for (int r = 0; r < 4; ++r) part[(wave * 16 + 4 * g + r) * NG + 16 * nt + c16] = acc[nt][r];
        __syncthreads();
        for (int i = tid; i < 16 * NG; i += 512) { float sum = 0.f;
#pragma unroll
            for (int w8 = 0; w8 < 8; ++w8) sum += part[w8 * 16 * NG + i];
            GL[(size_t)r0 * NG + i] = sum; }
    }
}

__device__ __forceinline__ void ln_row(const float* sr, float* xr, const bf16* yrow, const float* mr, const float* lnw, const float* lnb, bf16* hrow, int lane, int dry, bool active) {
    f32x4 v[4]; float s = 0.f;
#pragma unroll
    for (int j = 0; j < 4; ++j) { const int c = 4 * lane + 256 * j; const f32x4 x = *(const f32x4*)(sr + c), g1 = *(const f32x4*)(mr + 2048 + c); const v2u yw = *(const v2u*)(yrow + c);
        v[j][0] = DN_ALPHA * x[0] + g1[0] * bflo(yw.x); v[j][1] = DN_ALPHA * x[1] + g1[1] * bfhi(yw.x); v[j][2] = DN_ALPHA * x[2] + g1[2] * bflo(yw.y); v[j][3] = DN_ALPHA * x[3] + g1[3] * bfhi(yw.y);
        s += (v[j][0] + v[j][1]) + (v[j][2] + v[j][3]); }
    const float mean = wave_sum(s) * (1.f / D); float s2 = 0.f;
#pragma unroll
    for (int j = 0; j < 4; ++j) { v[j] = v[j] - mean; s2 += (v[j][0] * v[j][0] + v[j][1] * v[j][1]) + (v[j][2] * v[j][2] + v[j][3] * v[j][3]); }
    const float rstd = 1.f / sqrtf(wave_sum(s2) * (1.f / D) + LN_EPS);
    if (active) {
#pragma unroll
    for (int j = 0; j < 4; ++j) { const int c = 4 * lane + 256 * j; const f32x4 w = *(const f32x4*)(lnw + c), bb = *(const f32x4*)(lnb + c);
        const f32x4 x1 = v[j] * rstd * w + bb; if (!dry) *(f32x4*)(xr + c) = x1;
        const f32x4 sh = *(const f32x4*)(mr + 3072 + c), sc = *(const f32x4*)(mr + 4096 + c); const f32x4 hp = x1 * (sc + 1.0f) + sh;
        v2u o; o.x = pk2(hp[0], hp[1]); o.y = pk2(hp[2], hp[3]); if (!dry) *(v2u*)(hrow + c) = o; }
    }
}
__device__ __forceinline__ void ln_phase(const float* slat, const float* sctx, float* lat, float* ctx, const bf16* Y, const float* mod, const float* lnw, const float* lnb, bf16* HB, int gw, int NGW, int lane, int dry, bool lat_only) {
    const int nrows = lat_only ? NB * SEQ : TT;
    for (int i0 = gw; i0 < nrows; i0 += 2 * NGW) {
        const int i1 = i0 + NGW; const bool has1 = i1 < nrows; const int r0 = map_row(i0, lat_only), r1c = map_row(has1 ? i1 : i0, lat_only);
        const int b0 = r0 / PB, p0 = r0 - b0 * PB, b1 = r1c / PB, p1 = r1c - b1 * PB;
        ln_row(srow_c(slat, sctx, r0), srow(lat, ctx, r0), Y + (size_t)r0 * D, mod + (size_t)(p0 < LC ? 8 : b0) * 6144, lnw, lnb, HB + (size_t)r0 * D, lane, dry, true);
        ln_row(srow_c(slat, sctx, r1c), srow(lat, ctx, r1c), Y + (size_t)r1c * D, mod + (size_t)(p1 < LC ? 8 : b1) * 6144, lnw, lnb, HB + (size_t)r1c * D, lane, dry, has1);
    }
}

constexpr int AT_LD = 72;
__device__ __forceinline__ bf16x8 frag_tr_perm(const LAS bf16* t, int ld, int r0, int c0, int lane) {
    const int g = lane >> 4, q = (lane & 15) >> 2, p = lane & 3;
    const LAS bf16* a = t + (r0 + 4 * g + q) * ld + c0 + 4 * p;
    const s16x4 lo = __builtin_amdgcn_ds_read_tr16_b64_v4i16((LAS s16x4*)a);
    const s16x4 hi = __builtin_amdgcn_ds_read_tr16_b64_v4i16((LAS s16x4*)(a + 16 * ld));
    return (bf16x8){lo[0], lo[1], lo[2], lo[3], hi[0], hi[1], hi[2], hi[3]};
}
__device__ __forceinline__ void attn_phase(const bf16* P, bf16* CAT, const float* sink, const float* ropetab, LAS unsigned char* lds, unsigned* qctr, int vcu, int G, int wave, int lane, int tid) {
    LAS bf16* Kt = (LAS bf16*)lds;
    LAS bf16* Vt = (LAS bf16*)(lds + 9216);
    LAS bf16* Qw = (LAS bf16*)(lds + 18432 + wave * 4608);
    const int g = lane >> 4, c16 = lane & 15;
    volatile LAS int* qslot = (volatile LAS int*)(lds + MISC_OFF) + 12;
    for (;;) {
        if (tid == 0) *qslot = (int)__hip_atomic_fetch_add(qctr, 1u, __ATOMIC_RELAXED, __HIP_MEMORY_SCOPE_AGENT);
        __syncthreads();
        const int item = *qslot;
        if (item >= 1024 + 64) break;
        const bool is_ctx = item >= 1024;
        int b, hk, nb;
        if (!is_ctx) { b = item >> 7; hk = (item >> 6) & 1; nb = item & 63; } else { const int it = item - 1024; b = it >> 3; hk = (it >> 2) & 1; nb = it & 3; }
        const int head = hk * 4 + (wave >> 1);
        const int qrow0 = b * PB + (is_ctx ? 0 : LC) + nb * 64 + (wave & 1) * 32;
        const int qlat0 = nb * 64 + (wave & 1) * 32;
        __syncthreads();
#pragma unroll
        for (int i = 0; i < 4; ++i) { const int cidx = lane + 64 * i, rr = cidx >> 3, ch = cidx & 7;
            const v4u raw = *(const v4u*)(P + (size_t)(qrow0 + rr) * N_AB + 2048 + head * 64 + ch * 8); v4u o = raw;
            if (!is_ctx) { const int tl = qlat0 + rr; const int pos = (ch < 4) ? (tl >> 6) : (tl & 63); const float* tb = ropetab + (size_t)(pos * 16 + (ch & 3) * 4) * 2;
                const unsigned wv[4] = {raw.x, raw.y, raw.z, raw.w}; unsigned ov[4];
#pragma unroll
                for (int k = 0; k < 4; ++k) { const float x1 = bflo(wv[k]), x2 = bfhi(wv[k]), c = tb[2 * k], s = tb[2 * k + 1]; ov[k] = pk2(x1 * c - x2 * s, x1 * s + x2 * c); }
                o.x = ov[0]; o.y = ov[1]; o.z = ov[2]; o.w = ov[3]; }
            *(LAS v4u*)(Qw + rr * AT_LD + ch * 8) = o; }
        LDS_FENCE();
        bf16x8 qf[2][2];
#pragma unroll
        for (int mt = 0; mt < 2; ++mt)
#pragma unroll
            for (int ks = 0; ks < 2; ++ks) qf[mt][ks] = frag_row(Qw, AT_LD, 16 * mt, 32 * ks, lane);
        LDS_FENCE();
        f32x4 o[2][4]; float mrun[2], lrun[2];
        const float sk = sink[head];
#pragma unroll
        for (int qt = 0; qt < 2; ++qt) { mrun[qt] = sk; lrun[qt] = 1.f; }
#pragma unroll
        for (int qt = 0; qt < 2; ++qt)
#pragma unroll
            for (int nt = 0; nt < 4; ++nt) o[qt][nt] = (f32x4){0.f, 0.f, 0.f, 0.f};
        const int nkt = is_ctx ? 4 : 9;
        const int srr = tid >> 3, sch = tid & 7;
        int kt = 0; f32x2 trope[4];
#pragma unroll
        for (int i = 0; i < 4; ++i) trope[i] = (f32x2){1.f, 0.f};
        v4u kraw = *(const v4u*)(P + (size_t)(b * PB + srr) * N_AB + 2560 + hk * 64 + sch * 8), vraw = *(const v4u*)(P + (size_t)(b * PB + srr) * N_AB + 2688 + hk * 64 + sch * 8);
        while (kt < nkt) {
            const int kp0 = nb * 64 - 128 + 64 * (kt - 4);
            int kn = kt + 1;
            while (kn < nkt && kn >= 4 && ((nb * 64 - 128 + 64 * (kn - 4)) < 0 || (nb * 64 - 128 + 64 * (kn - 4)) >= SEQ)) ++kn;
            __syncthreads();
            { v4u o = kraw;
              if (kt >= 4) { const unsigned wv[4] = {kraw.x, kraw.y, kraw.z, kraw.w}; unsigned ov[4];
#pragma unroll
                  for (int i = 0; i < 4; ++i) { const float x1 = bflo(wv[i]), x2 = bfhi(wv[i]), c = trope[i][0], sn = trope[i][1]; ov[i] = pk2(x1 * c - x2 * sn, x1 * sn + x2 * c); }
                  o.x = ov[0]; o.y = ov[1]; o.z = ov[2]; o.w = ov[3]; }
              *(LAS v4u*)(Kt + srr * AT_LD + sch * 8) = o; *(LAS v4u*)(Vt + srr * AT_LD + sch * 8) = vraw; }
            if (kn < nkt) { const int kpn = nb * 64 - 128 + 64 * (kn - 4); const int krn = b * PB + (kn < 4 ? 64 * kn : LC + kpn);
                kraw = *(const v4u*)(P + (size_t)(krn + srr) * N_AB + 2560 + hk * 64 + sch * 8); vraw = *(const v4u*)(P + (size_t)(krn + srr) * N_AB + 2688 + hk * 64 + sch * 8);
                if (kn >= 4) { const int tl = kpn + srr; const int pos = (sch < 4) ? (tl >> 6) : (tl & 63); const f32x2* tb = (const f32x2*)(ropetab + (size_t)(pos * 16 + (sch & 3) * 4) * 2);
#pragma unroll
                    for (int i = 0; i < 4; ++i) trope[i] = tb[i]; } }
            __syncthreads();
            const bool need_mask = (kt == 4) || (kt == 8);
            bf16x8 kf[4][2];
#pragma unroll
            for (int km = 0; km < 4; ++km)
#pragma unroll
                for (int ks = 0; ks < 2; ++ks) kf[km][ks] = frag_row(Kt, AT_LD, 16 * km, 32 * ks, lane);
            bf16x8 pa[2][2];
#pragma unroll
            for (int qt = 0; qt < 2; ++qt) {
                f32x4 st[4];
#pragma unroll
                for (int km = 0; km < 4; ++km) { st[km] = (f32x4){0.f, 0.f, 0.f, 0.f};
#pragma unroll
                    for (int ks = 0; ks < 2; ++ks) st[km] = mma(kf[km][ks], qf[qt][ks], st[km]); }
                if (need_mask) {
#pragma unroll
                    for (int km = 0; km < 4; ++km)
#pragma unroll
                        for (int r = 0; r < 4; ++r) { const int dq = (kp0 + 16 * km + 4 * g + r) - (qlat0 + 16 * qt + c16); if (dq > 128 || dq < -128) st[km][r] = -3.0e38f; } }
                float mx = fmaxf(fmaxf(fmaxf(st[0][0], st[0][1]), fmaxf(st[0][2], st[0][3])), fmaxf(fmaxf(st[1][0], st[1][1]), fmaxf(st[1][2], st[1][3])));
                mx = fmaxf(mx, fmaxf(fmaxf(fmaxf(st[2][0], st[2][1]), fmaxf(st[2][2], st[2][3])), fmaxf(fmaxf(st[3][0], st[3][1]), fmaxf(st[3][2], st[3][3]))));
                mx = fmaxf(mx, __shfl_xor(mx, 16)); mx = fmaxf(mx, __shfl_xor(mx, 32));
                const float mnew = fmaxf(mrun[qt], mx), alpha = __expf(mrun[qt] - mnew);
                float ps = 0.f;
#pragma unroll
                for (int km = 0; km < 4; ++km)
#pragma unroll
                    for (int r = 0; r < 4; ++r) { const float pv = __expf(st[km][r] - mnew); st[km][r] = pv; ps += pv; }
                ps += __shfl_xor(ps, 16); ps += __shfl_xor(ps, 32);
                lrun[qt] = lrun[qt] * alpha + ps; mrun[qt] = mnew;
#pragma unroll
                for (int ks2 = 0; ks2 < 2; ++ks2) { const unsigned w0 = pk2(st[2 * ks2][0], st[2 * ks2][1]), w1 = pk2(st[2 * ks2][2], st[2 * ks2][3]), w2 = pk2(st[2 * ks2 + 1][0], st[2 * ks2 + 1][1]), w3 = pk2(st[2 * ks2 + 1][2], st[2 * ks2 + 1][3]);
                    const v4u wv = (v4u){w0, w1, w2, w3}; pa[qt][ks2] = __builtin_bit_cast(bf16x8, wv); }
#pragma unroll
                for (int r = 0; r < 4; ++r) { const float ar = __shfl(alpha, (lane & 48) + 4 * g + r);
#pragma unroll
                    for (int nt = 0; nt < 4; ++nt) o[qt][nt][r] *= ar; }
            }
#pragma unroll
            for (int ks2 = 0; ks2 < 2; ++ks2) {
                bf16x8 vf[4];
#pragma unroll
                for (int nt = 0; nt < 4; ++nt) vf[nt] = frag_tr_perm(Vt, AT_LD, 32 * ks2, 16 * nt, lane);
#pragma unroll
                for (int qt = 0; qt < 2; ++qt)
#pragma unroll
                    for (int nt = 0; nt < 4; ++nt) o[qt][nt] = mma(pa[qt][ks2], vf[nt], o[qt][nt]); }
            LDS_FENCE();
            kt = kn;
        }
#pragma unroll
        for (int qt = 0; qt < 2; ++qt)
#pragma unroll
            for (int r = 0; r < 4; ++r) { const float inv = 1.f / __shfl(lrun[qt], (lane & 48) + 4 * g + r); bf16* orow = CAT + (size_t)(qrow0 + 16 * qt + 4 * g + r) * D + 512 + head * 64;
#pragma unroll
                for (int nt = 0; nt < 4; ++nt) orow[16 * nt + c16] = (bf16)f2bf(o[qt][nt][r] * inv); }
    }
}

__device__ __forceinline__ float wave_prefix_sum(float v) {
    v += __builtin_bit_cast(float, __builtin_amdgcn_update_dpp(0, __builtin_bit_cast(int, v), 0x111, 0xf, 0xf, true)); v += __builtin_bit_cast(float, __builtin_amdgcn_update_dpp(0, __builtin_bit_cast(int, v), 0x112, 0xf, 0xf, true));
    v += __builtin_bit_cast(float, __builtin_amdgcn_update_dpp(0, __builtin_bit_cast(int, v), 0x114, 0xf, 0xf, true)); v += __builtin_bit_cast(float, __builtin_amdgcn_update_dpp(0, __builtin_bit_cast(int, v), 0x118, 0xf, 0xf, true));
    v += __builtin_bit_cast(float, __builtin_amdgcn_update_dpp(0, __builtin_bit_cast(int, v), 0x142, 0xa, 0xf, false)); v += __builtin_bit_cast(float, __builtin_amdgcn_update_dpp(0, __builtin_bit_cast(int, v), 0x143, 0xc, 0xf, false));
    return v;
}
__device__ __forceinline__ float wave_prefix_max(float v) {
    const int ninf = (int)0xff800000u;
    v = fmaxf(v, __builtin_bit_cast(float, __builtin_amdgcn_update_dpp(ninf, __builtin_bit_cast(int, v), 0x111, 0xf, 0xf, false))); v = fmaxf(v, __builtin_bit_cast(float, __builtin_amdgcn_update_dpp(ninf, __builtin_bit_cast(int, v), 0x112, 0xf, 0xf, false)));
    v = fmaxf(v, __builtin_bit_cast(float, __builtin_amdgcn_update_dpp(ninf, __builtin_bit_cast(int, v), 0x114, 0xf, 0xf, false))); v = fmaxf(v, __builtin_bit_cast(float, __builtin_amdgcn_update_dpp(ninf, __builtin_bit_cast(int, v), 0x118, 0xf, 0xf, false)));
    v = fmaxf(v, __builtin_bit_cast(float, __builtin_amdgcn_update_dpp(ninf, __builtin_bit_cast(int, v), 0x142, 0xa, 0xf, false))); v = fmaxf(v, __builtin_bit_cast(float, __builtin_amdgcn_update_dpp(ninf, __builtin_bit_cast(int, v), 0x143, 0xc, 0xf, false)));
    return v;
}
__device__ __forceinline__ void mlstm_gate_scan(const float* GL  , const float* gate_b  , unsigned char* ws, int gw, int NGW, int lane) {
    float* BQ = (float*)(ws + WS_BQ); float* CQ = (float*)(ws + WS_CQ); float* EM = (float*)(ws + WS_EM); float* AI = (float*)(ws + WS_AI);
    float* AST = (float*)(ws + WS_AST); float* CL = (float*)(ws + WS_CL);
    for (int chain = gw; chain < 64; chain += NGW) {
        const int dir = chain >> 5, b = (chain >> 2) & 7, h = chain & 3;
        const float bi = gate_b[dir * 8 + h], bfg = gate_b[dir * 8 + 4 + h];
        float m_st = 0.f;
        float gi_n, gf_n;
        { const int j0 = dir == 0 ? 0 : 3; const int p0 = j0 * 64 + (dir == 0 ? lane : 63 - lane); const float* gr = GL + (size_t)(b * PB + p0) * 16 + dir * 8; gi_n = gr[h]; gf_n = gr[4 + h]; }
        for (int sc = 0; sc < NCH; ++sc) {
            const int j = dir == 0 ? sc : (sc < 4 ? 3 - sc : 71 - sc);
            const int p = j * 64 + (dir == 0 ? lane : 63 - lane);
            const float li = gi_n + bi, lf = logsigmoidf_(gf_n + bfg);
            if (sc + 1 < NCH) { const int sn = sc + 1; const int jn = dir == 0 ? sn : (sn < 4 ? 3 - sn : 71 - sn); const int pn = jn * 64 + (dir == 0 ? lane : 63 - lane);
                const float* gr = GL + (size_t)(b * PB + pn) * 16 + dir * 8; gi_n = gr[h]; gf_n = gr[4 + h]; }
            const float cum = wave_prefix_sum(lf);
            const float bb = li - cum; const float pm = wave_prefix_max(bb);
            const float c = fmaxf(m_st, pm);
            const size_t ti = (size_t)chain * PB + p;
            BQ[ti] = bb; CQ[ti] = c; EM[ti] = __expf(-(cum + c)); AI[ti] = __expf(m_st - c);
            const float cl = __builtin_bit_cast(float, __builtin_amdgcn_readlane(__builtin_bit_cast(int, c), 63)), tot = __builtin_bit_cast(float, __builtin_amdgcn_readlane(__builtin_bit_cast(int, cum), 63));
            if (lane == 0) { CL[chain * NCH + j] = cl; AST[chain * NCH + j] = __expf(m_st - cl); }
            m_st = tot + cl;
        }
    }
}


__device__ __forceinline__ float logsig_fast(float x) { return fminf(x, 0.f) - __logf(1.f + __expf(-fabsf(x))); }
__device__ __forceinline__ void gla_prep(bf16* P, bf16* QKR, const float* LOW  , const float* gate_up  , const float* gate_b  , unsigned char* ws,
                                         LAS unsigned char* lds, int vcu, int G, int tid, int dry) {
    float* ET = (float*)(ws + WS_ET);
    LAS float* lowt = (LAS float*)lds;
    LAS bf16* qs = (LAS bf16*)(lds + 8192);
    LAS bf16* ks = (LAS bf16*)(lds + 24576);
    LAS float* LA = (LAS float*)(lds + 40960);
    LAS float* HT = (LAS float*)(lds + 106496);
    const int dc = tid & 255, dir = dc >> 7, ch = dc & 127, half = tid >> 8;
    for (int item = vcu; item < NB * NCH * 4; item += G) {
        const int b = item / (NCH * 4), j = (item >> 2) % NCH, h = item & 3;
        const int row0 = b * PB + j * 64, c = h * 128 + ch;
        __syncthreads();
        for (int i = tid; i < 64 * 32; i += 512) lowt[i] = LOW[(size_t)row0 * 32 + i];
#pragma unroll
        for (int i = 0; i < 2; ++i) { const int cidx = tid + 512 * i, rr = cidx >> 4, c8 = cidx & 15; const bf16* src = P + (size_t)(row0 + rr) * N_C + h * 128 + c8 * 8;
            *(LAS v4u*)(qs + rr * 128 + c8 * 8) = *(const v4u*)src; *(LAS v4u*)(ks + rr * 128 + c8 * 8) = *(const v4u*)(src + 512); }
        float gu[16];
#pragma unroll
        for (int k = 0; k < 16; ++k) gu[k] = gate_up[(size_t)(dir * 16 + k) * 512 + c];
        const float gb = gate_b[dir * 512 + c];
        __syncthreads();
        float hsum = 0.f;
#pragma unroll 4
        for (int i = 0; i < 32; ++i) { const int t = half * 32 + i; float x = gb;
#pragma unroll
            for (int k = 0; k < 16; ++k) x += lowt[t * 32 + dir * 16 + k] * gu[k];
            const float la = logsig_fast(x) * (1.f / 16.f); LA[t * 256 + dc] = la; hsum += la; }
        HT[half * 256 + dc] = hsum;
        __syncthreads();
        float cum = (dir == 0) ? (half == 1 ? HT[dc] : 0.f) : (half == 0 ? HT[256 + dc] : 0.f);
#pragma unroll 4
        for (int i = 0; i < 32; ++i) { const int t = half * 32 + (dir == 0 ? i : 31 - i);
            cum += LA[t * 256 + dc];
            const float e = __expf(cum), ei = __expf(-cum);
            const size_t ro = (size_t)(row0 + t) * N_C;
            const float qv = bf2f(qs[t * 128 + ch]), kv = bf2f(ks[t * 128 + ch]);
            if (dir == 0) { if (!dry) { P[ro + c] = (bf16)f2bf(qv * e); P[ro + 512 + c] = (bf16)f2bf(kv * ei); } }
            else { QKR[(size_t)(row0 + t) * 1024 + c] = (bf16)f2bf(qv * e); QKR[(size_t)(row0 + t) * 1024 + 512 + c] = (bf16)f2bf(kv * ei); } }
        if (half == 0) ET[((size_t)((dir * 8 + b) * 4 + h) * NCH + j) * 128 + ch] = __expf(HT[dc] + HT[256 + dc]);
    }
}


__device__ __forceinline__ unsigned f2sort(float f) { const unsigned u = __builtin_bit_cast(unsigned, f); return (u & 0x80000000u) ? ~u : (u | 0x80000000u); }
__device__ __forceinline__ float sort2f(unsigned s) { const unsigned u = (s & 0x80000000u) ? (s & 0x7fffffffu) : ~s; return __builtin_bit_cast(float, u); }
template <int CTRL> __device__ __forceinline__ unsigned dppmov_u(unsigned x) { return (unsigned)__builtin_amdgcn_mov_dpp((int)x, CTRL, 0xf, 0xf, true); }
__device__ __forceinline__ unsigned gmax16(unsigned x) { unsigned y;
    y = dppmov_u<0xB1>(x); x = x > y ? x : y; y = dppmov_u<0x4E>(x); x = x > y ? x : y; y = dppmov_u<0x141>(x); x = x > y ? x : y; y = dppmov_u<0x128>(x); x = x > y ? x : y; return x; }
__device__ __forceinline__ float gsum16(float x) {
    x += __builtin_bit_cast(float, dppmov_u<0xB1>(__builtin_bit_cast(unsigned, x))); x += __builtin_bit_cast(float, dppmov_u<0x4E>(__builtin_bit_cast(unsigned, x)));
    x += __builtin_bit_cast(float, dppmov_u<0x141>(__builtin_bit_cast(unsigned, x))); x += __builtin_bit_cast(float, dppmov_u<0x128>(__builtin_bit_cast(unsigned, x))); return x; }
#define CSWAP(a, b) do { const unsigned hi_ = (a) > (b) ? (a) : (b), lo_ = (a) > (b) ? (b) : (a); (a) = hi_; (b) = lo_; } while (0)
__device__ __forceinline__ void peer_route(const bf16* Q, const bf16* KEYS, int* EID, float* GWT, int gw, int NGW, int lane, bool lat_only) {
    const int g = lane >> 4, c16 = lane & 15, gbase = lane & 48;
    const int nwi = (lat_only ? NB * SEQ / 16 : TT / 16) * 8;
    for (int wi = gw; wi < nwi; wi += NGW) {
        const int t0 = map_row((wi >> 3) * 16, lat_only), head = wi & 7;
        unsigned tops[2][4];
#pragma unroll
        for (int p = 0; p < 2; ++p) {
            const bf16* qrow = Q + (size_t)(t0 + c16) * 2048 + head * 256 + p * 128 + 8 * g;
            bf16x8 qf[4];
#pragma unroll
            for (int ks = 0; ks < 4; ++ks) qf[ks] = *(const bf16x8*)(qrow + 32 * ks);
            const bf16* kb = KEYS + (size_t)(head * 2 + p) * 128 * 128 + (size_t)c16 * 128 + 8 * g;
            unsigned key[8][4];
#pragma unroll
            for (int nt = 0; nt < 8; ++nt) { f32x4 s = (f32x4){0.f, 0.f, 0.f, 0.f};
#pragma unroll
                for (int ks = 0; ks < 4; ++ks) s = mma(qf[ks], *(const bf16x8*)(kb + (size_t)nt * 16 * 128 + 32 * ks), s);
#pragma unroll
                for (int r = 0; r < 4; ++r) key[nt][r] = (f2sort(s[r]) & ~127u) | (unsigned)(127 - (16 * nt + c16)); }
            unsigned kk[4][8];
#pragma unroll
            for (int r = 0; r < 4; ++r) {
#pragma unroll
                for (int nt = 0; nt < 8; ++nt) kk[r][nt] = key[nt][r];
                CSWAP(kk[r][0], kk[r][1]); CSWAP(kk[r][2], kk[r][3]); CSWAP(kk[r][4], kk[r][5]); CSWAP(kk[r][6], kk[r][7]); CSWAP(kk[r][0], kk[r][2]); CSWAP(kk[r][1], kk[r][3]); CSWAP(kk[r][4], kk[r][6]); CSWAP(kk[r][5], kk[r][7]);
                CSWAP(kk[r][1], kk[r][2]); CSWAP(kk[r][5], kk[r][6]); CSWAP(kk[r][0], kk[r][4]); CSWAP(kk[r][1], kk[r][5]); CSWAP(kk[r][2], kk[r][6]); CSWAP(kk[r][3], kk[r][7]); CSWAP(kk[r][2], kk[r][4]); CSWAP(kk[r][3], kk[r][5]);
                CSWAP(kk[r][1], kk[r][2]); CSWAP(kk[r][3], kk[r][4]); CSWAP(kk[r][5], kk[r][6]); }
            unsigned tt[4] = {0u, 0u, 0u, 0u};
#pragma unroll 2
            for (int rd = 0; rd < 16; ++rd) {
#pragma unroll
                for (int r = 0; r < 4; ++r) { const unsigned m = gmax16(kk[r][0]); const bool w = (kk[r][0] == m);
#pragma unroll
                    for (int q = 0; q < 7; ++q) kk[r][q] = w ? kk[r][q + 1] : kk[r][q];
                    kk[r][7] = w ? 0u : kk[r][7];
                    tt[r] = (c16 == rd) ? m : tt[r]; } }
#pragma unroll
            for (int r = 0; r < 4; ++r) tops[p][r] = tt[r];
        }
        float v0[4], s1v[4]; int ptr[4]; unsigned res[4];
#pragma unroll
        for (int r = 0; r < 4; ++r) { v0[r] = sort2f(tops[0][r] & ~127u); s1v[r] = sort2f((unsigned)__shfl((int)tops[1][r], gbase) & ~127u); ptr[r] = 0; res[r] = 0u; }
#pragma unroll 2
        for (int rd = 0; rd < 16; ++rd) {
#pragma unroll
            for (int r = 0; r < 4; ++r) {
                const unsigned ck = ptr[r] < 16 ? ((f2sort(v0[r] + s1v[r]) & ~255u) | (unsigned)((15 - c16) << 4) | (unsigned)(15 - ptr[r])) : 0u;
                const unsigned m = gmax16(ck);
                res[r] = (c16 == rd) ? m : res[r];
                if (ck == m) ++ptr[r];
                s1v[r] = sort2f((unsigned)__shfl((int)tops[1][r], gbase + (ptr[r] < 15 ? ptr[r] : 15)) & ~127u); } }
#pragma unroll
        for (int r = 0; r < 4; ++r) {
            const float val = sort2f(res[r] & ~255u); const int ii = 15 - (int)((res[r] >> 4) & 15u), jj = 15 - (int)(res[r] & 15u);
            const float mx = __shfl(val, gbase);
            const float ex = __expf(val - mx), sum = gsum16(ex);
            const unsigned i0 = 127u - ((unsigned)__shfl((int)tops[0][r], gbase + ii) & 127u), i1 = 127u - ((unsigned)__shfl((int)tops[1][r], gbase + jj) & 127u);
            const size_t o = (size_t)(t0 + 4 * g + r) * 128 + head * 16 + c16;
            EID[o] = (int)(i0 * 128u + i1); GWT[o] = ex / sum;
        }
    }
}

__device__ __forceinline__ void unpack8(const v4u w, float* o) { o[0] = bflo(w.x); o[1] = bfhi(w.x); o[2] = bflo(w.y); o[3] = bfhi(w.y); o[4] = bflo(w.z); o[5] = bfhi(w.z); o[6] = bflo(w.w); o[7] = bfhi(w.w); }
__device__ __forceinline__ int rev3(int x) { return ((x & 1) << 2) | (x & 2) | ((x >> 2) & 1); }
typedef int v8i __attribute__((ext_vector_type(8)));
constexpr int P1_SLOT = 784, P1_WAVE_LDS = 15360, P1_HQ = 16 * P1_SLOT, P1_DOTS = P1_HQ + 2304;
__device__ __forceinline__ int p1_sigma(int j) { return (j >= 4 && j < 12) ? 2 * (j - 4) : (j < 4 ? 2 * j + 1 : 2 * (j - 12) + 9); }
__device__ __forceinline__ void peer_pass1(const bf16* HB, const int* EID, const float* GWT, const unsigned char* U6, const float* SUi, const float* SVi, float* COEF,
                                           LAS unsigned char* lds, int wave, int gw, int NGW, int lane, bool lat_only) {
    LAS unsigned char* wl = lds + wave * P1_WAVE_LDS;
    LAS float* dots = (LAS float*)(wl + P1_DOTS);
    const int n = lane & 15, g = lane >> 4;
    const int nrows = lat_only ? NB * SEQ : TT;
    const unsigned aoff = (unsigned)(p1_sigma(n) * P1_SLOT + 96 * g);
    const unsigned boff = (unsigned)(P1_HQ + (n == 1 ? 768 : (n == 2 ? 1536 : 0)) + 96 * g);
    int ri = gw;
    if (ri >= nrows) return;
    int r = map_row(ri, lat_only);
    v4u hn0 = *(const v4u*)(HB + (size_t)r * D + 16 * lane), hn1 = *(const v4u*)(HB + (size_t)r * D + 16 * lane + 8);
    int eidAn = EID[(size_t)r * 128 + lane], eidBn = EID[(size_t)r * 128 + 64 + lane];
#define P1_DMA(src_e, base_) do { int ids_[16]; _Pragma("unroll") for (int j_ = 0; j_ < 16; ++j_) ids_[j_] = __builtin_amdgcn_readlane((src_e), (base_) + j_); \
        if (lane < 48) { _Pragma("unroll") for (int j_ = 0; j_ < 16; ++j_) \
        __builtin_amdgcn_global_load_lds((const unsigned*)(U6 + (size_t)ids_[j_] * 768 + 16 * lane), (LAS unsigned*)(wl + p1_sigma(j_) * P1_SLOT), 16, 0, 0); } } while (0)
    P1_DMA(eidAn, 0);
    for (; ri < nrows; ri += NGW) {
        r = map_row(ri, lat_only);
        const int eidA = eidAn, eidB = eidBn;
        { float h[16]; unpack8(hn0, h); unpack8(hn1, h + 8);
#pragma unroll
          for (int part = 0; part < 3; ++part) {
              v16f a, b;
#pragma unroll
              for (int k = 0; k < 8; ++k) { a[k] = h[2 * k]; b[k] = h[2 * k + 1]; a[8 + k] = 0.f; b[8 + k] = 0.f; }
              const v6u p = __builtin_amdgcn_cvt_scalef32_2xpk16_fp6_f32(a, b, 1.0f);
              *(LAS v3u*)(wl + P1_HQ + 768 * part + 12 * lane) = (v3u){p[0], p[1], p[2]};
              if (part < 2) { const v32f w = __builtin_amdgcn_cvt_scalef32_pk32_f32_fp6((v6u){p[0], p[1], p[2], 0u, 0u, 0u}, 1.0f);
#pragma unroll
                  for (int k = 0; k < 16; ++k) h[k] = (h[k] - w[k]) * 8.f; } } }
        const float gwtA = GWT[(size_t)r * 128 + lane], gwtB = GWT[(size_t)r * 128 + 64 + lane];
        const int rin = ri + NGW; const bool more = rin < nrows; const int rn = map_row(more ? rin : ri, lat_only);
        hn0 = *(const v4u*)(HB + (size_t)rn * D + 16 * lane); hn1 = *(const v4u*)(HB + (size_t)rn * D + 16 * lane + 8);
        eidAn = EID[(size_t)rn * 128 + lane]; eidBn = EID[(size_t)rn * 128 + 64 + lane];
        LDS_FENCE();
        v4u bw[2][6];
#pragma unroll
        for (int q = 0; q < 2; ++q)
#pragma unroll
            for (int u = 0; u < 6; ++u) bw[q][u] = *(LAS const v4u*)(wl + boff + 384 * q + 16 * u);
#pragma unroll 1
        for (int G = 0; G < 8; ++G) {
            asm volatile("s_waitcnt vmcnt(0)" ::: "memory");
            v4u aw[2][6];
#pragma unroll
            for (int q = 0; q < 2; ++q)
#pragma unroll
                for (int u = 0; u < 6; ++u) aw[q][u] = *(LAS const v4u*)(wl + aoff + 384 * q + 16 * u);
            asm volatile("s_waitcnt lgkmcnt(0)" ::: "memory");
            { const int srcsel = G < 3 ? eidA : (G < 7 ? eidB : eidAn); const int base = 16 * ((G + 1) & 3);
              if (G < 7 || more) P1_DMA(srcsel, base); }
            f32x4 acc = (f32x4){0.f, 0.f, 0.f, 0.f};
#pragma unroll
            for (int q = 0; q < 2; ++q)
#pragma unroll
                for (int t = 0; t < 4; ++t) {
                    unsigned e[6];
#pragma unroll
                    for (int d = 0; d < 6; ++d) { const int w = 6 * t + d; e[d] = aw[q][w >> 2][w & 3]; }
                    const v8i A = (v8i){(int)e[0], (int)e[1], (int)e[2], (int)e[3], (int)e[4], (int)e[5], 0, 0};
                    unsigned eb[6];
#pragma unroll
                    for (int d = 0; d < 6; ++d) { const int w = 6 * t + d; eb[d] = bw[q][w >> 2][w & 3]; }
                    const v8i Bv = (v8i){(int)eb[0], (int)eb[1], (int)eb[2], (int)eb[3], (int)eb[4], (int)eb[5], 0, 0};
                    acc = __builtin_amdgcn_mfma_scale_f32_16x16x128_f8f6f4(A, Bv, acc, 2, 2, 0, 0, 0, 0); }
            f32x4 dv;
#pragma unroll
            for (int k = 0; k < 4; ++k) dv[k] = acc[k] + 0.125f * dppmov_f<0xB1>(acc[k]) + 0.015625f * dppmov_f<0x4E>(acc[k]);
            if (n == 0) *(LAS f32x4*)(dots + 16 * G + 4 * g) = dv;
        }
        LDS_FENCE();
        { const float dot = dots[lane] * SUi[eidA]; COEF[(size_t)r * 128 + lane] = gwtA * 0.5f * dot * (1.f + erff(dot * 0.70710678118f)) * SVi[eidA]; }
        { const float dot = dots[64 + lane] * SUi[eidB]; COEF[(size_t)r * 128 + 64 + lane] = gwtB * 0.5f * dot * (1.f + erff(dot * 0.70710678118f)) * SVi[eidB]; }
    }
#undef P1_DMA
}
template <bool USE_PEER>
__device__ __forceinline__ void peer_expert(const float* COEF, const int* EID, const unsigned char* V6,
                                            float* lat, float* ctx, const float* mod, const float* lnw, const float* lnb, int gw, int NGW, int lane, int dry, bool lat_only) {
    const int myslot = 8 * (lane & 7) + rev3(lane >> 3);
    const int nrows = lat_only ? NB * SEQ : TT;
    for (int ri = gw; ri < nrows; ri += NGW) {
        const int r = map_row(ri, lat_only);
        const int b = r / PB, p = r - b * PB; float* xr = srow(lat, ctx, r); const float* mr = mod + (size_t)(p < LC ? 8 : b) * 6144;
        float f[16];
#pragma unroll
        for (int i = 0; i < 16; ++i) f[i] = 0.f;
        if (USE_PEER) {
#pragma unroll 1
        for (int half = 0; half < 2; ++half) {
            const int eid = EID[(size_t)r * 128 + half * 64 + myslot];
            const float coef = COEF[(size_t)r * 128 + half * 64 + myslot];
            v3u ring[8];
#pragma unroll
            for (int k = 0; k < 8; ++k) { const int id = __builtin_amdgcn_readlane(eid, k); ring[k] = *(const v3u*)(V6 + (size_t)id * 768 + 12 * lane); }
#pragma unroll 1
            for (int e0 = 0; e0 < 64; e0 += 8) {
#pragma unroll
                for (int k = 0; k < 8; k += 2) {
                    const float c0 = __builtin_bit_cast(float, __builtin_amdgcn_readlane(__builtin_bit_cast(int, coef), e0 + k)), c1 = __builtin_bit_cast(float, __builtin_amdgcn_readlane(__builtin_bit_cast(int, coef), e0 + k + 1));
                    const v6u pk6 = (v6u){ring[k].x, ring[k].y, ring[k].z, ring[k + 1].x, ring[k + 1].y, ring[k + 1].z}; const v32f w = __builtin_amdgcn_cvt_scalef32_pk32_f32_fp6(pk6, 1.0f);
                    const int en0 = (e0 + 8 + k) < 64 ? (e0 + 8 + k) : 63, en1 = (e0 + 9 + k) < 64 ? (e0 + 9 + k) : 63;
                    const int idn0 = __builtin_amdgcn_readlane(eid, en0), idn1 = __builtin_amdgcn_readlane(eid, en1);
                    ring[k] = *(const v3u*)(V6 + (size_t)idn0 * 768 + 12 * lane); ring[k + 1] = *(const v3u*)(V6 + (size_t)idn1 * 768 + 12 * lane);
#pragma unroll
                    for (int i = 0; i < 16; ++i) f[i] += c0 * w[i];
#pragma unroll
                    for (int i = 0; i < 16; ++i) f[i] += c1 * w[16 + i];
                    __builtin_amdgcn_sched_barrier(0); }
            }
        }
        }
        float v[16]; float s = 0.f;
#pragma unroll
        for (int q = 0; q < 4; ++q) { const int c = 16 * lane + 4 * q; const f32x4 x1 = *(const f32x4*)(xr + c), g2 = *(const f32x4*)(mr + 5120 + c);
#pragma unroll
            for (int i = 0; i < 4; ++i) { v[4 * q + i] = DN_ALPHA * x1[i] + g2[i] * f[4 * q + i]; s += v[4 * q + i]; } }
        const float mean = wave_sum(s) * (1.f / D); float s2 = 0.f;
#pragma unroll
        for (int i = 0; i < 16; ++i) { v[i] -= mean; s2 += v[i] * v[i]; }
        const float rstd = 1.f / sqrtf(wave_sum(s2) * (1.f / D) + LN_EPS);
#pragma unroll
        for (int q = 0; q < 4; ++q) { const int c = 16 * lane + 4 * q; const f32x4 w = *(const f32x4*)(lnw + c), bb2 = *(const f32x4*)(lnb + c); f32x4 o;
#pragma unroll
            for (int i = 0; i < 4; ++i) o[i] = v[4 * q + i] * rstd * w[i] + bb2[i];
            if (!dry) *(f32x4*)(xr + c) = o; }
    }
}

__device__ __forceinline__ bf16* od_row_base(unsigned char* ws, int dir, int b) {
    if (dir == 0) return (bf16*)(ws + WS_ST) + (size_t)b * SEQ * 1024;
    return b < 7 ? (bf16*)(ws + WS_ST + 64 * MiB) + (size_t)b * SEQ * 1024 : (bf16*)(ws + WS_XC);
}
__device__ __forceinline__ void gla_fused_scan(const bf16* P, const bf16* QKR, unsigned char* ws, LAS unsigned char* lds, int vcu, int G, int wave, int lane, int tid, int dry) {
    const float* ET = (const float*)(ws + WS_ET);
    LAS bf16* Qt = (LAS bf16*)lds;
    LAS bf16* Kt = (LAS bf16*)(lds + 34816);
    LAS bf16* Vt = (LAS bf16*)(lds + 69632);
    LAS bf16* SL = (LAS bf16*)(lds + 88064);
    LAS bf16* Pw = (LAS bf16*)(lds + 122880 + wave * 2304);
    const int g = lane >> 4, c16 = lane & 15, mt = wave & 3, cw = wave >> 2;
    for (int item = vcu; item < 256; item += G) {
        const int dir = item >> 7, b = (item >> 4) & 7, h = (item >> 2) & 3, eb = item & 3;
        const bf16* qsrc = dir == 0 ? P + h * 128 : QKR + h * 128; const int qld = dir == 0 ? N_C : 1024;
        const bf16* vsrc = P + 1024 + h * 256 + 64 * eb;
        const float* etp = ET + ((size_t)((dir * 8 + b) * 4 + h) * NCH) * 128 + 16 * wave + c16;
        bf16* odb = od_row_base(ws, dir, b) + h * 256 + 64 * eb;
        f32x4 acc[4];
#pragma unroll
        for (int et = 0; et < 4; ++et) acc[et] = (f32x4){0.f, 0.f, 0.f, 0.f};
        v4u qreg[2][2], kreg[2][2], vreg[2]; float etn[2];
#define GLA_JOF(sc_) (dir == 0 ? (sc_) : ((sc_) < 4 ? 3 - (sc_) : 71 - (sc_)))
#define GLA_PREFETCH(sc0_) do { _Pragma("unroll") for (int u = 0; u < 2; ++u) { const int jj = GLA_JOF((sc0_) + u); const int row0 = b * PB + jj * 64; \
            _Pragma("unroll") for (int i = 0; i < 2; ++i) { const int cidx = tid + 512 * i, rr = cidx >> 4, ch = cidx & 15; const bf16* sp = qsrc + (size_t)(row0 + rr) * qld + ch * 8; qreg[u][i] = *(const v4u*)sp; kreg[u][i] = *(const v4u*)(sp + 512); } \
            vreg[u] = *(const v4u*)(vsrc + (size_t)(row0 + (tid >> 3)) * N_C + (tid & 7) * 8); etn[u] = etp[(size_t)jj * 128]; } } while (0)
        GLA_PREFETCH(0);
        unsigned opk[8]; int ojc = -1;
#pragma unroll
        for (int i = 0; i < 8; ++i) opk[i] = 0u;
        for (int sc = 0; sc < NCH; sc += 2) {
            const int ja = GLA_JOF(sc), jb = GLA_JOF(sc + 1);
            __syncthreads();
            if (ojc >= 4 && !dry) {
#pragma unroll
                for (int nt = 0; nt < 4; ++nt) { bf16* orow = odb + (size_t)((ojc - 4) * 64 + 16 * mt + 4 * g) * 1024 + 16 * nt + c16;
#pragma unroll
                    for (int r = 0; r < 4; ++r) orow[(size_t)r * 1024] = (bf16)((opk[2 * nt + (r >> 1)] >> (16 * (r & 1))) & 0xffffu); } }
#pragma unroll
            for (int u = 0; u < 2; ++u) {
#pragma unroll
                for (int i = 0; i < 2; ++i) { const int cidx = tid + 512 * i, rr = cidx >> 4, ch = cidx & 15; *(LAS v4u*)(Qt + u * 8704 + rr * 136 + ch * 8) = qreg[u][i]; *(LAS v4u*)(Kt + u * 8704 + rr * 136 + ch * 8) = kreg[u][i]; }
                *(LAS v4u*)(Vt + u * 4608 + (tid >> 3) * 72 + (tid & 7) * 8) = vreg[u]; }
#pragma unroll
            for (int et = 0; et < 4; ++et)
#pragma unroll
                for (int r = 0; r < 4; ++r) SL[(16 * et + 4 * g + r) * 136 + 16 * wave + c16] = (bf16)f2bf(acc[et][r]);
            const float et_a = etn[0], et_b = etn[1];
            if (sc + 2 < NCH) GLA_PREFETCH(sc + 2);
            __syncthreads();
#pragma unroll
            for (int ks = 0; ks < 2; ++ks) { const bf16x8 kb = frag_tr(Kt, 136, 32 * ks, 16 * wave, lane);
#pragma unroll
                for (int et = 0; et < 4; ++et) acc[et] = mma(frag_tr(Vt, 72, 32 * ks, 16 * et, lane), kb, acc[et]); }
#pragma unroll
            for (int et = 0; et < 4; ++et) { acc[et] = acc[et] * et_a;
#pragma unroll
                for (int r = 0; r < 4; ++r) SL[8704 + (16 * et + 4 * g + r) * 136 + 16 * wave + c16] = (bf16)f2bf(acc[et][r]); }
            __syncthreads();
            const int jc = cw == 0 ? ja : jb;
            ojc = jc;
            if (jc >= 4) {
                const LAS bf16* Qc = Qt + cw * 8704; const LAS bf16* Kc = Kt + cw * 8704; const LAS bf16* Vc = Vt + cw * 4608; const LAS bf16* Sc = SL + cw * 8704;
                bf16x8 qf[4];
#pragma unroll
                for (int ks = 0; ks < 4; ++ks) qf[ks] = frag_row(Qc, 136, 16 * mt, 32 * ks, lane);
                bf16x8 pa[2];
                { f32x4 st[4];
#pragma unroll
                  for (int ns = 0; ns < 4; ++ns) { st[ns] = (f32x4){0.f, 0.f, 0.f, 0.f};
#pragma unroll
                      for (int ks = 0; ks < 4; ++ks) st[ns] = mma(frag_row(Kc, 136, 16 * ns, 32 * ks, lane), qf[ks], st[ns]);
#pragma unroll
                      for (int r = 0; r < 4; ++r) { const int sidx = 16 * ns + 4 * g + r, t = 16 * mt + c16; const bool ok = dir == 0 ? (sidx <= t) : (sidx >= t); st[ns][r] = ok ? st[ns][r] : 0.f; } }
#pragma unroll
                  for (int ks2 = 0; ks2 < 2; ++ks2) { const v4u wv = (v4u){pk2(st[2 * ks2][0], st[2 * ks2][1]), pk2(st[2 * ks2][2], st[2 * ks2][3]), pk2(st[2 * ks2 + 1][0], st[2 * ks2 + 1][1]), pk2(st[2 * ks2 + 1][2], st[2 * ks2 + 1][3])};
                      pa[ks2] = __builtin_bit_cast(bf16x8, wv); } }
#pragma unroll
                for (int nt = 0; nt < 4; ++nt) { f32x4 a = (f32x4){0.f, 0.f, 0.f, 0.f};
#pragma unroll
                    for (int ks = 0; ks < 4; ++ks) a = mma(qf[ks], frag_row(Sc, 136, 16 * nt, 32 * ks, lane), a);
                    a = mma(pa[0], frag_tr_perm(Vc, 72, 0, 16 * nt, lane), a); a = mma(pa[1], frag_tr_perm(Vc, 72, 32, 16 * nt, lane), a);
                    opk[2 * nt] = pk2(a[0], a[1]); opk[2 * nt + 1] = pk2(a[2], a[3]); }
                LDS_FENCE();
            }
#pragma unroll
            for (int ks = 0; ks < 2; ++ks) { const bf16x8 kb = frag_tr(Kt + 8704, 136, 32 * ks, 16 * wave, lane);
#pragma unroll
                for (int et = 0; et < 4; ++et) acc[et] = mma(frag_tr(Vt + 4608, 72, 32 * ks, 16 * et, lane), kb, acc[et]); }
#pragma unroll
            for (int et = 0; et < 4; ++et) acc[et] = acc[et] * et_b;
        }
        if (ojc >= 4 && !dry) {
#pragma unroll
            for (int nt = 0; nt < 4; ++nt) { bf16* orow = odb + (size_t)((ojc - 4) * 64 + 16 * mt + 4 * g) * 1024 + 16 * nt + c16;
#pragma unroll
                for (int r = 0; r < 4; ++r) orow[(size_t)r * 1024] = (bf16)((opk[2 * nt + (r >> 1)] >> (16 * (r & 1))) & 0xffffu); } }
#undef GLA_PREFETCH
#undef GLA_JOF
    }
}
__device__ __forceinline__ void gla_merge(bf16* P, const float* norm_w, unsigned char* ws, int gw, int NGW, int lane, int dry) {
    for (int i = gw; i < NB * SEQ; i += NGW) {
        const int b = i >> 12, lp = i & 4095; const size_t r = (size_t)b * PB + LC + lp;
        const bf16* of = od_row_base(ws, 0, b) + (size_t)lp * 1024 + 16 * lane; const bf16* orv = od_row_base(ws, 1, b) + (size_t)lp * 1024 + 16 * lane;
        bf16* grow = P + r * N_C + 2048 + 16 * lane;
        float x[16], y[16], gg[16];
        unpack8(*(const v4u*)of, x); unpack8(*(const v4u*)(of + 8), x + 8); unpack8(*(const v4u*)orv, y); unpack8(*(const v4u*)(orv + 8), y + 8);
        unpack8(*(const v4u*)grow, gg); unpack8(*(const v4u*)(grow + 8), gg + 8);
        float ss = 0.f;
#pragma unroll
        for (int k = 0; k < 16; ++k) { x[k] += y[k]; ss += x[k] * x[k]; }
        ss = gsum16(ss);
        const float rn = 1.f / sqrtf(ss * (1.f / 256.f) + LN_EPS);
        unsigned ow[8];
#pragma unroll
        for (int k = 0; k < 8; ++k) { const float4 dummy = make_float4(0.f, 0.f, 0.f, 0.f); (void)dummy;
            const float a = x[2 * k] * rn * norm_w[16 * lane + 2 * k] * siluf_(gg[2 * k]), c = x[2 * k + 1] * rn * norm_w[16 * lane + 2 * k + 1] * siluf_(gg[2 * k + 1]); ow[k] = pk2(a, c); }
        if (!dry) { v4u o0, o1; o0.x = ow[0]; o0.y = ow[1]; o0.z = ow[2]; o0.w = ow[3]; o1.x = ow[4]; o1.y = ow[5]; o1.z = ow[6]; o1.w = ow[7]; *(v4u*)grow = o0; *(v4u*)(grow + 8) = o1; }
    }
}

__device__ __forceinline__ void mlstm_fused_scan(const bf16* P, unsigned char* ws, LAS unsigned char* lds, int vcu, int G, int wave, int lane, int tid) {
    const float* BQ = (const float*)(ws + WS_BQ); const float* CQ = (const float*)(ws + WS_CQ); const float* EM = (const float*)(ws + WS_EM); const float* AI = (const float*)(ws + WS_AI);
    const float* AST = (const float*)(ws + WS_AST); const float* CL = (const float*)(ws + WS_CL);
    LAS bf16* Qt = (LAS bf16*)lds;
    LAS bf16* Kt = (LAS bf16*)(lds + 17408);
    LAS bf16* Vt = (LAS bf16*)(lds + 34816);
    LAS bf16* Vw = (LAS bf16*)(lds + 41984);
    LAS bf16* CT = (LAS bf16*)(lds + 49152);
    LAS bf16* Pw = (LAS bf16*)(lds + 62208 + wave * 2304);
    const int g = lane >> 4, c16 = lane & 15, mt = wave & 3, hf = wave >> 2;
    const int vrow = tid < 256 ? (tid >> 2) : ((tid - 256) & 63), vch = tid & 3;
    for (int item = vcu; item < 256; item += G) {
        const int dir = item >> 7, b = (item >> 4) & 7, h = (item >> 2) & 3, eb = item & 3;
        const int chain = dir * 32 + b * 4 + h;
        const bf16* qsrc = P + h * 128; const bf16* vsrc = P + 1024 + h * 128 + 32 * eb;
        bf16* odb = (bf16*)(ws + WS_ST) + (size_t)dir * TT * 512 + h * 128 + 32 * eb;
        f32x4 acc[3];
#pragma unroll
        for (int et = 0; et < 3; ++et) acc[et] = (f32x4){0.f, 0.f, 0.f, 0.f};
        v4u qreg[2], kreg[2], vreg; float bqr, cln, astn, cqn; f32x4 bqn[4], ain, emn;
        { const int j0 = dir == 0 ? 0 : 3; const int row0 = b * PB + j0 * 64; const size_t tb = (size_t)chain * PB + j0 * 64;
#pragma unroll
          for (int i = 0; i < 2; ++i) { const int cidx = tid + 512 * i, rr = cidx >> 4, ch = cidx & 15; const bf16* s = qsrc + (size_t)(row0 + rr) * N_AB + ch * 8; qreg[i] = *(const v4u*)s; kreg[i] = *(const v4u*)(s + 512); }
          vreg = *(const v4u*)(vsrc + (size_t)(row0 + vrow) * N_AB + vch * 8); bqr = BQ[tb + vrow]; cln = CL[chain * NCH + j0]; astn = AST[chain * NCH + j0];
#pragma unroll
          for (int k = 0; k < 4; ++k) bqn[k] = *(const f32x4*)(BQ + tb + 16 * k + 4 * g);
          cqn = CQ[tb + 16 * mt + c16]; ain = *(const f32x4*)(AI + tb + 16 * mt + 4 * g); emn = *(const f32x4*)(EM + tb + 16 * mt + 4 * g); }
        for (int sc = 0; sc < NCH; ++sc) {
            const int j = dir == 0 ? sc : (sc < 4 ? 3 - sc : 71 - sc);
            __syncthreads();
#pragma unroll
            for (int i = 0; i < 2; ++i) { const int cidx = tid + 512 * i, rr = cidx >> 4, ch = cidx & 15; *(LAS v4u*)(Qt + rr * 136 + ch * 8) = qreg[i]; *(LAS v4u*)(Kt + rr * 136 + ch * 8) = kreg[i]; }
            { const float wsv = __expf(bqr - cln);
              if (tid < 256) { const v4u raw = vreg; v4u o;
                  o.x = pk2(bflo(raw.x) * wsv, bfhi(raw.x) * wsv); o.y = pk2(bflo(raw.y) * wsv, bfhi(raw.y) * wsv); o.z = pk2(bflo(raw.z) * wsv, bfhi(raw.z) * wsv); o.w = pk2(bflo(raw.w) * wsv, bfhi(raw.w) * wsv);
                  *(LAS v4u*)(Vt + vrow * 56 + vch * 8) = raw; *(LAS v4u*)(Vw + vrow * 56 + vch * 8) = o;
              } else if (tid < 320) { v4u o; o.x = 0x3f80u; o.y = 0u; o.z = 0u; o.w = 0u; *(LAS v4u*)(Vt + vrow * 56 + 32) = o; o.x = f2bf(wsv); *(LAS v4u*)(Vw + vrow * 56 + 32) = o;
                  o.x = 0u; *(LAS v4u*)(Vt + vrow * 56 + 40) = o; *(LAS v4u*)(Vw + vrow * 56 + 40) = o; } }
#pragma unroll
            for (int et = 0; et < 3; ++et)
#pragma unroll
                for (int r = 0; r < 4; ++r) CT[(16 * et + 4 * g + r) * 136 + 16 * wave + c16] = (bf16)f2bf(acc[et][r]);
            const float ast = astn, cqt = cqn; f32x4 bq[4]; const f32x4 ai = ain, em = emn;
#pragma unroll
            for (int k = 0; k < 4; ++k) bq[k] = bqn[k];
            if (sc + 1 < NCH) { const int sn = sc + 1; const int jn = dir == 0 ? sn : (sn < 4 ? 3 - sn : 71 - sn); const int row0 = b * PB + jn * 64; const size_t tb = (size_t)chain * PB + jn * 64;
#pragma unroll
                for (int i = 0; i < 2; ++i) { const int cidx = tid + 512 * i, rr = cidx >> 4, ch = cidx & 15; const bf16* s = qsrc + (size_t)(row0 + rr) * N_AB + ch * 8; qreg[i] = *(const v4u*)s; kreg[i] = *(const v4u*)(s + 512); }
                vreg = *(const v4u*)(vsrc + (size_t)(row0 + vrow) * N_AB + vch * 8); bqr = BQ[tb + vrow]; cln = CL[chain * NCH + jn]; astn = AST[chain * NCH + jn];
#pragma unroll
                for (int k = 0; k < 4; ++k) bqn[k] = *(const f32x4*)(BQ + tb + 16 * k + 4 * g);
                cqn = CQ[tb + 16 * mt + c16]; ain = *(const f32x4*)(AI + tb + 16 * mt + 4 * g); emn = *(const f32x4*)(EM + tb + 16 * mt + 4 * g); }
            __syncthreads();
            bf16x8 qf[4];
#pragma unroll
            for (int ks = 0; ks < 4; ++ks) qf[ks] = frag_row(Qt, 136, 16 * mt, 32 * ks, lane);
            bf16x8 pa[2];
            { f32x4 st[4];
#pragma unroll
              for (int ns = 0; ns < 4; ++ns) { st[ns] = (f32x4){0.f, 0.f, 0.f, 0.f};
#pragma unroll
                  for (int ks = 0; ks < 4; ++ks) st[ns] = mma(frag_row(Kt, 136, 16 * ns, 32 * ks, lane), qf[ks], st[ns]);
#pragma unroll
                  for (int r = 0; r < 4; ++r) { const int sidx = 16 * ns + 4 * g + r, t = 16 * mt + c16; const bool ok = dir == 0 ? (sidx <= t) : (sidx >= t);
                      st[ns][r] = ok ? st[ns][r] * __expf(bq[ns][r] - cqt) : 0.f; } }
#pragma unroll
              for (int ks2 = 0; ks2 < 2; ++ks2) { const v4u wv = (v4u){pk2(st[2 * ks2][0], st[2 * ks2][1]), pk2(st[2 * ks2][2], st[2 * ks2][3]), pk2(st[2 * ks2 + 1][0], st[2 * ks2 + 1][1]), pk2(st[2 * ks2 + 1][2], st[2 * ks2 + 1][3])};
                  pa[ks2] = __builtin_bit_cast(bf16x8, wv); } }
            f32x4 av, ad;
            { f32x4 a = (f32x4){0.f, 0.f, 0.f, 0.f}, d = (f32x4){0.f, 0.f, 0.f, 0.f};
#pragma unroll
              for (int ks = 0; ks < 4; ++ks) { a = mma(qf[ks], frag_row(CT, 136, 16 * hf, 32 * ks, lane), a); d = mma(qf[ks], frag_row(CT, 136, 32, 32 * ks, lane), d); }
#pragma unroll
              for (int r = 0; r < 4; ++r) { a[r] *= ai[r]; d[r] *= ai[r]; }
#pragma unroll
              for (int ks = 0; ks < 2; ++ks) { a = mma(pa[ks], frag_tr_perm(Vt, 56, 32 * ks, 16 * hf, lane), a); d = mma(pa[ks], frag_tr_perm(Vt, 56, 32 * ks, 32, lane), d); }
              av = a; ad = d; }
            { bf16* orow = odb + (size_t)(b * PB + j * 64 + 16 * mt + 4 * g) * 512 + 16 * hf + c16;
#pragma unroll
              for (int r = 0; r < 4; ++r) { const float den = __shfl(ad[r], lane & 48); orow[(size_t)r * 512] = (bf16)f2bf(av[r] / fmaxf(fabsf(den), em[r])); } }
#pragma unroll
            for (int et = 0; et < 3; ++et) acc[et] = acc[et] * ast;
#pragma unroll
            for (int ks = 0; ks < 2; ++ks) { const bf16x8 kb = frag_tr(Kt, 136, 32 * ks, 16 * wave, lane);
#pragma unroll
                for (int et = 0; et < 3; ++et) acc[et] = mma(frag_tr(Vw, 56, 32 * ks, 16 * et, lane), kb, acc[et]); }
        }
    }
}
__device__ __forceinline__ void mlstm_merge(const bf16* P, bf16* CAT, const float* norm_w, unsigned char* ws, int gw, int NGW, int lane) {
    const bf16* OD = (const bf16*)(ws + WS_ST);
    for (int r = gw; r < TT; r += NGW) {
        float x[8], y[8], og[8];
        unpack8(*(const v4u*)(OD + (size_t)r * 512 + 8 * lane), x); unpack8(*(const v4u*)(OD + (size_t)TT * 512 + (size_t)r * 512 + 8 * lane), y);
        unpack8(*(const v4u*)(P + (size_t)r * N_AB + 1536 + 8 * lane), og);
        float ss = 0.f;
#pragma unroll
        for (int k = 0; k < 8; ++k) { x[k] += y[k]; ss += x[k] * x[k]; }
        ss = gsum16(ss);
        const float rn = 1.f / sqrtf(ss * (1.f / 128.f) + LN_EPS);
        unsigned ow[4];
#pragma unroll
        for (int k = 0; k < 4; ++k) ow[k] = pk2(x[2 * k] * rn * norm_w[8 * lane + 2 * k] * sigmoidf_(og[2 * k]), x[2 * k + 1] * rn * norm_w[8 * lane + 2 * k + 1] * sigmoidf_(og[2 * k + 1]));
        v4u o; o.x = ow[0]; o.y = ow[1]; o.z = ow[2]; o.w = ow[3]; *(v4u*)(CAT + (size_t)r * D + 8 * lane) = o;
    }
}

#ifndef PHMASK
#define PHMASK 0xffffffffu
#endif
#define PH(k) ((PHMASK >> (k)) & 1u)
#ifndef REPMASK
#define REPMASK 0u
#endif
#define REPS(k) (1 + (int)((REPMASK >> (k)) & 1u))
#if REPMASK
#define DRYV(k) ({ int d_ = (rep_ + 1 < REPS(k)) ? 1 : 0; asm volatile("" : "+s"(d_)); d_; })
#else
#define DRYV(k) 0
#endif
#ifndef DBG_LEVEL
#define DBG_LEVEL 3
#endif
typedef const __attribute__((address_space(4))) Args* KArgsP;
__device__ __forceinline__ KArgsP kargs() { KArgsP p = (KArgsP)__builtin_amdgcn_kernarg_segment_ptr(); asm volatile("" : "+s"(p)); return p; }
#define WSP(off) (ws + (off))
__global__ void __launch_bounds__(512, 2) fwd_megakernel(Args A_unused) {
    extern __shared__ __attribute__((aligned(16))) unsigned char lds_raw[];
    LAS unsigned char* lds = (LAS unsigned char*)lds_raw;
    const int tid0 = threadIdx.x;
    const int G = gridDim.x; const int bx = blockIdx.x; const int vcu = (G % 8 == 0) ? (bx % 8) * (G / 8) + bx / 8 : bx;
    const int NGW = G * 8;
    volatile LAS unsigned* MISC = (volatile LAS unsigned*)(lds + MISC_OFF);
    if (tid0 < 16) MISC[tid0] = 0u;
    __syncthreads();
    XcdBarrier bar;
    { KArgsP ap = kargs(); bar = xcd_barrier_post((unsigned*)(ap->ws + WS_CTL) + 1024, MISC + 8); }
#define GRID_BAR() xcd_barrier(bar)
#define PROLOG KArgsP ap = kargs(); unsigned char* ws = ap->ws; (void)ws; int tid = tid0; asm volatile("" : "+v"(tid)); const int lane = tid & 63, wave = __builtin_amdgcn_readfirstlane(tid >> 6), gw = vcu * 8 + wave; (void)lane; (void)wave; (void)gw;

    if (PH(0)) for (int rep_ = 0; rep_ < REPS(0); ++rep_) { int tid = tid0; asm volatile("" : "+v"(tid)); const int lane = tid & 63, wave = __builtin_amdgcn_readfirstlane(tid >> 6); Args A; { KArgsP ap = kargs();
#pragma unroll
        for (int i = 0; i < 22; ++i) A.in[i] = ap->in[i];
        A.out = ap->out; A.ws = ap->ws; }
        p0_prologue(A, lds, vcu, G, wave, lane, tid); }
    GRID_BAR();

    if (PH(1)) for (int rep_ = 0; rep_ < REPS(1); ++rep_) { PROLOG h_phase<16>(ap->in[I_X], ap->in[I_CTX], (const float*)WSP(WS_MOD), (bf16*)WSP(WS_HB), (const float*)WSP(WS_WG), (float*)WSP(WS_GL), lds, vcu, G, wave, lane, tid); }
    GRID_BAR();
    if (PH(2)) for (int rep_ = 0; rep_ < REPS(2); ++rep_) { PROLOG pg8::Gemm g{(const bf16*)WSP(WS_HB), (const bf16*)WSP(WS_WAB), TT, N_AB, 1024, 1024, 1024}; pg8::StaticOrder S; S.init(TT, N_AB, G, bx);
      pg8::EpiBf16 E{(bf16*)WSP(WS_P), N_AB}; pg8::gemm_phase<pg8::EpiBf16, pg8::StaticOrder>(lds, g, S, E, tid); }
    GRID_BAR();
#if DBG_LEVEL >= 2
    if (PH(3)) for (int rep_ = 0; rep_ < REPS(3); ++rep_) { PROLOG mlstm_gate_scan((const float*)WSP(WS_GL), ap->in[I_ABGB], ws, gw, NGW, lane); }
    if (PH(4)) for (int rep_ = 0; rep_ < REPS(4); ++rep_) { PROLOG attn_phase((const bf16*)WSP(WS_P), (bf16*)WSP(WS_HB), ap->in[I_ABSINK], (const float*)WSP(WS_ROPE), lds, (unsigned*)WSP(WS_CTL) + 6144 + 64 * rep_, vcu, G, wave, lane, tid); }
    GRID_BAR();
    if (PH(5)) for (int rep_ = 0; rep_ < REPS(5); ++rep_) { PROLOG mlstm_fused_scan((const bf16*)WSP(WS_P), ws, lds, vcu, G, wave, lane, tid); }
    GRID_BAR();
    if (PH(6)) for (int rep_ = 0; rep_ < REPS(6); ++rep_) { PROLOG mlstm_merge((const bf16*)WSP(WS_P), (bf16*)WSP(WS_HB), ap->in[I_ABNW], ws, gw, NGW, lane); }
    GRID_BAR();
#endif
    if (PH(7)) for (int rep_ = 0; rep_ < REPS(7); ++rep_) { PROLOG pg8::Gemm g{(const bf16*)WSP(WS_HB), (const bf16*)WSP(WS_WABO), TT, 1024, 1024, 1024, 1024}; pg8::StaticOrder S; S.init(TT, 1024, G, bx);
      pg8::EpiBf16 E{(bf16*)WSP(WS_P), 1024}; pg8::gemm_phase<pg8::EpiBf16, pg8::StaticOrder>(lds, g, S, E, tid); }
    GRID_BAR();
    if (PH(8)) for (int rep_ = 0; rep_ < REPS(8); ++rep_) { PROLOG ln_phase(ap->in[I_X], ap->in[I_CTX], ap->out, (float*)WSP(WS_XC), (const bf16*)WSP(WS_P), (const float*)WSP(WS_MOD), ap->in[I_LNW], ap->in[I_LNB], (bf16*)WSP(WS_HB), gw, NGW, lane, DRYV(8), false); }
    GRID_BAR();
#if DBG_LEVEL >= 3
    if (PH(9)) for (int rep_ = 0; rep_ < REPS(9); ++rep_) { PROLOG pg8::Gemm g{(const bf16*)WSP(WS_HB), (const bf16*)WSP(WS_WQ0), TT, 2048, 1024, 1024, 1024}; pg8::StaticOrder S; S.init(TT, 2048, G, bx);
      pg8::EpiBf16 E{(bf16*)WSP(WS_P), 2048}; pg8::gemm_phase<pg8::EpiBf16, pg8::StaticOrder>(lds, g, S, E, tid); }
    GRID_BAR();
    if (PH(10)) for (int rep_ = 0; rep_ < REPS(10); ++rep_) { PROLOG peer_route((const bf16*)WSP(WS_P), (const bf16*)WSP(WS_KEYS), (int*)WSP(WS_ST), (float*)WSP(WS_ST + 17 * MiB), gw, NGW, lane, false); }
    GRID_BAR();
#endif
    if (PH(11)) for (int rep_ = 0; rep_ < REPS(22); ++rep_) { PROLOG peer_pass1((const bf16*)WSP(WS_HB), (const int*)WSP(WS_ST), (const float*)WSP(WS_ST + 17 * MiB), WSP(WS_U), (const float*)WSP(WS_SCL), (const float*)WSP(WS_SCL) + 2 * NEXP, (float*)WSP(WS_ST + 34 * MiB), lds, wave, gw, NGW, lane, false); }
    if (PH(11)) for (int rep_ = 0; rep_ < REPS(11); ++rep_) { PROLOG peer_expert<(DBG_LEVEL >= 3)>((const float*)WSP(WS_ST + 34 * MiB), (const int*)WSP(WS_ST), WSP(WS_V),
        ap->out, (float*)WSP(WS_XC), (const float*)WSP(WS_MOD), ap->in[I_LNW] + 1024, ap->in[I_LNB] + 1024, gw, NGW, lane, DRYV(11), false); }
    GRID_BAR();

    if (PH(12)) for (int rep_ = 0; rep_ < REPS(12); ++rep_) { PROLOG h_phase<32>(ap->out, (const float*)WSP(WS_XC), (const float*)WSP(WS_MOD) + 9 * 6144, (bf16*)WSP(WS_HB), (const float*)WSP(WS_WLOW), (float*)WSP(WS_GL), lds, vcu, G, wave, lane, tid);
 }
    GRID_BAR();
    if (PH(13)) for (int rep_ = 0; rep_ < REPS(13); ++rep_) { PROLOG pg8::Gemm g{(const bf16*)WSP(WS_HB), (const bf16*)WSP(WS_WC), TT, N_C, 1024, 1024, 1024}; pg8::StaticOrder S; S.init(TT, N_C, G, bx);
      pg8::EpiBf16 E{(bf16*)WSP(WS_P), N_C}; pg8::gemm_phase<pg8::EpiBf16, pg8::StaticOrder>(lds, g, S, E, tid); }
    GRID_BAR();
#if DBG_LEVEL >= 2
    if (PH(14)) for (int rep_ = 0; rep_ < REPS(14); ++rep_) { PROLOG gla_prep((bf16*)WSP(WS_P), (bf16*)WSP(WS_HB), (const float*)WSP(WS_GL), ap->in[I_GGUP], ap->in[I_GGB], ws, lds, vcu, G, tid, DRYV(14)); }
    GRID_BAR();
    if (PH(15)) for (int rep_ = 0; rep_ < REPS(15); ++rep_) { PROLOG gla_fused_scan((const bf16*)WSP(WS_P), (const bf16*)WSP(WS_HB), ws, lds, vcu, G, wave, lane, tid, DRYV(15)); }
    GRID_BAR();
    if (PH(16)) for (int rep_ = 0; rep_ < REPS(16); ++rep_) { PROLOG gla_merge((bf16*)WSP(WS_P), ap->in[I_GNW], ws, gw, NGW, lane, DRYV(16)); }
    GRID_BAR();
#endif
    if (PH(17)) for (int rep_ = 0; rep_ < REPS(17); ++rep_) { PROLOG pg8::Gemm g{(const bf16*)WSP(WS_P) + 2048, (const bf16*)WSP(WS_WCO), TT, 1024, 1024, N_C, 1024}; pg8::LatOrder S; S.init(NB * SEQ, 1024, G, bx);
      pg8::EpiBf16 E{(bf16*)WSP(WS_HB), 1024}; pg8::gemm_phase<pg8::EpiBf16, pg8::LatOrder>(lds, g, S, E, tid); }
    GRID_BAR();
    if (PH(18)) for (int rep_ = 0; rep_ < REPS(18); ++rep_) { PROLOG ln_phase(ap->out, (const float*)WSP(WS_XC), ap->out, (float*)WSP(WS_XC), (const bf16*)WSP(WS_HB), (const float*)WSP(WS_MOD) + 9 * 6144, ap->in[I_LNW] + 2048, ap->in[I_LNB] + 2048, (bf16*)WSP(WS_HB), gw, NGW, lane, DRYV(18), true); }
    GRID_BAR();
#if DBG_LEVEL >= 3
    if (PH(19)) for (int rep_ = 0; rep_ < REPS(19); ++rep_) { PROLOG pg8::Gemm g{(const bf16*)WSP(WS_HB), (const bf16*)WSP(WS_WQ1), TT, 2048, 1024, 1024, 1024}; pg8::LatOrder S; S.init(NB * SEQ, 2048, G, bx);
      pg8::EpiBf16 E{(bf16*)WSP(WS_P), 2048}; pg8::gemm_phase<pg8::EpiBf16, pg8::LatOrder>(lds, g, S, E, tid); }
    GRID_BAR();
    if (PH(20)) for (int rep_ = 0; rep_ < REPS(20); ++rep_) { PROLOG peer_route((const bf16*)WSP(WS_P), (const bf16*)WSP(WS_KEYS) + (size_t)8 * 2 * 128 * 128, (int*)WSP(WS_ST), (float*)WSP(WS_ST + 17 * MiB), gw, NGW, lane, true); }
    GRID_BAR();
#endif
    if (PH(21)) for (int rep_ = 0; rep_ < REPS(22); ++rep_) { PROLOG peer_pass1((const bf16*)WSP(WS_HB), (const int*)WSP(WS_ST), (const float*)WSP(WS_ST + 17 * MiB), WSP(WS_U) + (size_t)NEXP * 768, (const float*)WSP(WS_SCL) + NEXP, (const float*)WSP(WS_SCL) + 3 * NEXP, (float*)WSP(WS_ST + 34 * MiB), lds, wave, gw, NGW, lane, true); }
    if (PH(21)) for (int rep_ = 0; rep_ < REPS(21); ++rep_) { PROLOG peer_expert<(DBG_LEVEL >= 3)>((const float*)WSP(WS_ST + 34 * MiB), (const int*)WSP(WS_ST), WSP(WS_V) + (size_t)NEXP * 768,
        ap->out, (float*)WSP(WS_XC), (const float*)WSP(WS_MOD) + 9 * 6144, ap->in[I_LNW] + 3072, ap->in[I_LNB] + 3072, gw, NGW, lane, DRYV(21), true); }
}

extern "C" void kernel_launch(void* const* d_in, const int* in_sizes, int n_in, void* d_out, int out_size, void* d_ws, size_t ws_size, hipStream_t stream) {
    static int grid = 0;
    if (grid == 0) {
        if (n_in != 22 || out_size != NB * SEQ * D || ws_size < 512 * MiB) { fprintf(stderr, "kernel_launch: unexpected shapes: n_in %d out %d ws %zu (need %zu)\n", n_in, out_size, ws_size, (size_t)WS_END); grid = -1; return; }
        int dev = 0, cus = 0, per_cu = 0;
        if (hipGetDevice(&dev) != hipSuccess || hipDeviceGetAttribute(&cus, hipDeviceAttributeMultiprocessorCount, dev) != hipSuccess) { grid = -1; return; }
        if (hipFuncSetAttribute((const void*)fwd_megakernel, hipFuncAttributeMaxDynamicSharedMemorySize, LDS_BYTES) != hipSuccess) { fprintf(stderr, "kernel_launch: hipFuncSetAttribute failed\n"); grid = -1; return; }
        if (hipOccupancyMaxActiveBlocksPerMultiprocessor(&per_cu, (const void*)fwd_megakernel, 512, LDS_BYTES) != hipSuccess || per_cu < 1) { fprintf(stderr, "kernel_launch: occupancy query says %d blocks per CU\n", per_cu); }
        (void)hipGetLastError();
        grid = cus;
        fprintf(stderr, "kernel_launch: grid %d, per_cu %d, ws %zu\n", grid, per_cu, ws_size);
    }
    if (grid < 0) return;
    if (hipMemsetAsync((char*)d_ws + WS_CTL, 0, CTL_ZERO_BYTES, stream) != hipSuccess) return;
    Args a{};
    for (int i = 0; i < 22; ++i) a.in[i] = (const float*)d_in[i];
    a.out = (float*)d_out; a.ws = (unsigned char*)d_ws;
    hipLaunchKernelGGL(fwd_megakernel, dim3(grid), dim3(512), LDS_BYTES, stream, a);
}
```

```cpp
#include <hip/hip_runtime.h>
#include <cstdio>
#include <cstdint>

#define GAS __attribute__((address_space(1)))
#define LAS __attribute__((address_space(3)))
typedef unsigned short bf16;
typedef unsigned v4u __attribute__((ext_vector_type(4)));
typedef unsigned v2u __attribute__((ext_vector_type(2)));
typedef float f32x4 __attribute__((ext_vector_type(4)));
typedef float f32x2 __attribute__((ext_vector_type(2)));
typedef short bf16x8 __attribute__((ext_vector_type(8)));
typedef short s16x4 __attribute__((ext_vector_type(4)));
typedef GAS unsigned gu32;
#define RLX_AGENT __ATOMIC_RELAXED, __HIP_MEMORY_SCOPE_AGENT

constexpr int NB = 8, SEQ = 4096, LC = 256, D = 1024;
constexpr int PB = LC + SEQ;
constexpr int TT = NB * PB;
constexpr int NCH = PB / 64;
constexpr int N_AB = 2816;
constexpr int N_C = 3072;
constexpr float LN_EPS = 1e-5f;
constexpr float DN_ALPHA = 1.41421356237f;
constexpr int NEXP = 16384;
__device__ __forceinline__ int map_row(int i, bool lat_only) { return lat_only ? (i >> 12) * 4352 + 256 + (i & 4095) : i; }

constexpr size_t MiB = 1u << 20;
constexpr size_t WS_CTL = 0, CTL_ZERO_BYTES = 64 * 1024;
constexpr size_t WS_MOD = 1 * MiB;
constexpr size_t WS_ROPE = 2 * MiB;
constexpr size_t WS_WG = 2 * MiB + 64 * 1024;
constexpr size_t WS_WLOW = 2 * MiB + 128 * 1024;
constexpr size_t WS_SCL = 3 * MiB;
constexpr size_t WS_BQ = 4 * MiB, WS_CQ = WS_BQ + 1200 * 1024, WS_EM = WS_CQ + 1200 * 1024, WS_AI = WS_EM + 1200 * 1024;
constexpr size_t WS_AST = WS_AI + 1200 * 1024, WS_CL = WS_AST + 32 * 1024;
constexpr size_t WS_ET = 10 * MiB;
constexpr size_t WS_GL = 13 * MiB;
constexpr size_t WS_WAB = 20 * MiB, WS_WABO = 26 * MiB, WS_WC = 28 * MiB, WS_WCO = 34 * MiB, WS_WQ0 = 36 * MiB, WS_WQ1 = 40 * MiB, WS_KEYS = 44 * MiB;
constexpr size_t WS_NST = 45 * MiB;
constexpr size_t WS_XC = 48 * MiB;
constexpr size_t WS_U = 56 * MiB, WS_V = 88 * MiB;
constexpr size_t WS_HB = 120 * MiB;
constexpr size_t WS_P = 188 * MiB;
constexpr size_t WS_ST = 392 * MiB;
constexpr size_t WS_END = 460 * MiB;

constexpr int LDS_BYTES = 163840;
constexpr int MISC_OFF = LDS_BYTES - 64;

__device__ __forceinline__ unsigned f2bf(float f) { unsigned u = __builtin_bit_cast(unsigned, f); return (u + 0x7fffu + ((u >> 16) & 1u)) >> 16; }
__device__ __forceinline__ unsigned pk2(float lo, float hi) { return f2bf(lo) | (f2bf(hi) << 16); }
__device__ __forceinline__ float bflo(unsigned w) { return __builtin_bit_cast(float, w << 16); }
__device__ __forceinline__ float bfhi(unsigned w) { return __builtin_bit_cast(float, w & 0xffff0000u); }
__device__ __forceinline__ float bf2f(bf16 b) { return __builtin_bit_cast(float, (unsigned)b << 16); }
template <int CTRL> __device__ __forceinline__ float dppmov_f(float x) { return __builtin_bit_cast(float, __builtin_amdgcn_mov_dpp(__builtin_bit_cast(int, x), CTRL, 0xf, 0xf, true)); }
__device__ __forceinline__ float wave_sum(float v) {
    v += dppmov_f<0xB1>(v); v += dppmov_f<0x4E>(v); v += dppmov_f<0x141>(v); v += dppmov_f<0x128>(v);
    v += __shfl_xor(v, 16); v += __shfl_xor(v, 32);
    return v;
}
__device__ __forceinline__ float sigmoidf_(float x) { return 1.f / (1.f + __expf(-x)); }
__device__ __forceinline__ float logsigmoidf_(float x) { return fminf(x, 0.f) - log1pf(__expf(-fabsf(x))); }
__device__ __forceinline__ float siluf_(float x) { return x / (1.f + __expf(-x)); }

namespace pg8 {
#define PG8_LAS __attribute__((address_space(3)))
typedef unsigned short bf16_t;
typedef short bf16x8 __attribute__((ext_vector_type(8)));
typedef float f32x4 __attribute__((ext_vector_type(4)));
typedef unsigned u32x4 __attribute__((ext_vector_type(4)));
constexpr int BM = 256, BK = 64, HALF = 128, HTB = HALF * BK * 2  , STAGE_BYTES = 8 * HTB, NXCD = 8, WGM = 8;

__host__ __device__ __forceinline__ int lds_byte(int r, int c) { const int st = (r >> 4) * 2 + (c >> 5), rr = r & 15, cc = c & 31, ob = rr * 64 + cc * 2; return st * 1024 + (ob ^ (((ob >> 9) & 1) << 5)); }
__host__ __device__ __forceinline__ void stage_rc(int b, int& R, int& C) { const int st = b / 1024, sb = b % 1024, swz = sb ^ (((sb >> 9) & 1) << 5); R = (st >> 1) * 16 + swz / 64; C = (st & 1) * 32 + (swz % 64) / 2; }
__host__ __device__ __forceinline__ int perm32(int rho) { const int n = rho >> 4, i = rho & 15; return 8 * (i >> 2) + 4 * n + (i & 3); }

struct Unit { int pm, pn; };
struct Gemm { const bf16_t* A; const bf16_t* Bt; int M, N, K, lda, ldb; };

struct StaticOrder {
    int nM, nN, nwg, G, c;
    __host__ __device__ void init(int M, int N, int G_, int c_) { nM = M / BM; nN = N / BM; nwg = nM * nN; G = G_; c = c_; }
    __host__ __device__ bool next(int i, Unit& u) const {
        const long L = (long)i * G + c; if (L >= nwg) return false;
        int wgid = (int)L; { const int q = nwg / NXCD, r = nwg % NXCD, xcd = wgid % NXCD, off = wgid / NXCD; wgid = (xcd < r ? xcd * (q + 1) : r * (q + 1) + (xcd - r) * q) + off; }
        const int nig = WGM * nN, gid = wgid / nig, fm = gid * WGM, gsz = (nM - fm) < WGM ? (nM - fm) : WGM;
        u.pm = fm + ((wgid % nig) % gsz); u.pn = (wgid % nig) / gsz; return true;
    }
    __device__ __forceinline__ void a_ready(const Unit&) const {}
    __device__ __forceinline__ void done(const Unit&) const {}
};

struct LatOrder : StaticOrder {
    __host__ __device__ bool next(int i, Unit& u) const { if (!StaticOrder::next(i, u)) return false; u.pm = (u.pm >> 4) * 17 + 1 + (u.pm & 15); return true; }
};
__device__ __forceinline__ unsigned cvt_pk_bf16(float lo, float hi) { unsigned r; asm volatile("v_cvt_pk_bf16_f32 %0, %1, %2" : "=v"(r) : "v"(lo), "v"(hi)); return r; }
struct EpiBf16 {
    static constexpr bool PERM = true, AFTER_DRAIN = false;
    bf16_t* O; int ldc;
    __device__ __forceinline__ void operator()(const f32x4 (&acc)[2][2][4][2], const Unit& u, int wr, int wc, int fr, int fq) const {
        const int row0 = u.pm * BM + wr * 64 + fr; const int col0 = u.pn * BM + wc * 32 + 8 * fq;
#pragma unroll
        for (int ai = 0; ai < 2; ++ai)
#pragma unroll
            for (int m = 0; m < 4; ++m) { bf16_t* rowp = O + (size_t)(row0 + ai * HALF + m * 16) * ldc + col0;
#pragma unroll
                for (int bj = 0; bj < 2; ++bj) { const f32x4 v0 = acc[ai][bj][m][0], v1 = acc[ai][bj][m][1];
                    u32x4 w; w.x = cvt_pk_bf16(v0[0], v0[1]); w.y = cvt_pk_bf16(v0[2], v0[3]); w.z = cvt_pk_bf16(v1[0], v1[1]); w.w = cvt_pk_bf16(v1[2], v1[3]);
                    *(u32x4*)(rowp + bj * HALF) = w; } }
    }
};
struct EpiResid {
    static constexpr bool PERM = false, AFTER_DRAIN = false;
    const float* src_lat; const float* src_ctx; float* dst_lat; float* dst_ctx; const float* gate; float gscale; int dry;
    __device__ __forceinline__ void operator()(const f32x4 (&acc)[2][2][4][2], const Unit& u, int wr, int wc, int fr, int fq) const {
        const int b = u.pm / 17, tb = u.pm - b * 17;
        const float* sbase; float* dbase; const float* gr;
        if (tb == 0) { sbase = src_ctx + (size_t)b * 256 * 1024; dbase = dst_ctx + (size_t)b * 256 * 1024; gr = gate + 8 * 6144; }
        else { sbase = src_lat + ((size_t)b * 4096 + (size_t)(tb - 1) * 256) * 1024; dbase = dst_lat + ((size_t)b * 4096 + (size_t)(tb - 1) * 256) * 1024; gr = gate + b * 6144; }
        const int row0 = wr * 64 + fr, col0 = u.pn * BM + wc * 32 + 4 * fq;
        f32x4 gv[2][2];
#pragma unroll
        for (int bj = 0; bj < 2; ++bj)
#pragma unroll
            for (int n = 0; n < 2; ++n) gv[bj][n] = *(const f32x4*)(gr + col0 + bj * HALF + n * 16) * gscale;
#pragma unroll
        for (int ai = 0; ai < 2; ++ai)
#pragma unroll
            for (int mp = 0; mp < 2; ++mp) {
                f32x4 sv[2][2][2];
#pragma unroll
                for (int mm = 0; mm < 2; ++mm) { const size_t off = (size_t)(row0 + ai * HALF + (2 * mp + mm) * 16) * 1024 + col0;
#pragma unroll
                    for (int bj = 0; bj < 2; ++bj)
#pragma unroll
                        for (int n = 0; n < 2; ++n) sv[mm][bj][n] = __builtin_nontemporal_load((const f32x4*)(sbase + off + bj * HALF + n * 16)); }
                asm volatile("" ::: "memory");
#pragma unroll
                for (int mm = 0; mm < 2; ++mm) { const int m = 2 * mp + mm; const size_t off = (size_t)(row0 + ai * HALF + m * 16) * 1024 + col0;
#pragma unroll
                    for (int bj = 0; bj < 2; ++bj)
#pragma unroll
                        for (int n = 0; n < 2; ++n) { const f32x4 ov = sv[mm][bj][n] * 1.41421356237f + gv[bj][n] * acc[ai][bj][m][n]; if (!dry) *(f32x4*)(dbase + off + bj * HALF + n * 16) = ov; } }
                asm volatile("" ::: "memory");
            }
    }
};

template <class Epi, class Sched>
__device__ __forceinline__ void gemm_phase(PG8_LAS unsigned char* lds, const Gemm g, const Sched& S, const Epi& E, const int tid_in) {
    const int tid = tid_in, wid = __builtin_amdgcn_readfirstlane(tid >> 6), lane = tid & 63, wr = wid >> 2, wc = wid & 3, fr = lane & 15, fq = lane >> 4;
    const int K = g.K, nt = K / BK;
    unsigned voffA[2], voffB[2];
#pragma unroll
    for (int i = 0; i < 2; ++i) { int R, C; stage_rc(tid * 16 + i * 8192, R, C); const int Rb = Epi::PERM ? ((R & ~31) + perm32(R & 31)) : R;
        voffA[i] = (unsigned)(R * g.lda + C) * 2u; voffB[i] = (unsigned)(Rb * g.ldb + C) * 2u; }
    const size_t kstep = (size_t)(BK * 2);
    const size_t hstepA = (size_t)HALF * g.lda * 2, hstepB = (size_t)HALF * g.ldb * 2;
    const size_t tstepA = 2 * hstepA, tstepB = 2 * hstepB;
    const unsigned ldsw = (unsigned)wid * 1024u;
    const int aoff = lds_byte(wr * 64 + fr, fq * 8), boff = lds_byte(wc * 32 + fr, fq * 8);
#define PG8_SA(b, h) (((b) * 2 + (h)) * HTB)
#define PG8_SB(b, h) ((4 + (b) * 2 + (h)) * HTB)
#define PG8_STAGE(bufoff, gbase, voff) do { _Pragma("unroll") for (int _i = 0; _i < 2; ++_i) \
        __builtin_amdgcn_global_load_lds((const unsigned*)((const char*)(gbase) + (voff)[_i]), (PG8_LAS unsigned*)(lds + (bufoff) + ldsw + _i * 8192), 16, 0, 0); } while (0)
#define PG8_LDA(dst, b, h) do { _Pragma("unroll") for (int m = 0; m < 4; ++m) _Pragma("unroll") for (int k = 0; k < 2; ++k) dst[m][k] = *(const PG8_LAS bf16x8*)(lds + PG8_SA(b, h) + aoff + m * 2048 + k * 1024); } while (0)
#define PG8_LDB(dst, b, h) do { _Pragma("unroll") for (int n = 0; n < 2; ++n) _Pragma("unroll") for (int k = 0; k < 2; ++k) dst[n][k] = *(const PG8_LAS bf16x8*)(lds + PG8_SB(b, h) + boff + n * 2048 + k * 1024); } while (0)
#define PG8_MMA(ai, bj, At, Bt) do { __builtin_amdgcn_s_setprio(1); _Pragma("unroll") for (int m = 0; m < 4; ++m) _Pragma("unroll") for (int n = 0; n < 2; ++n) _Pragma("unroll") for (int k = 0; k < 2; ++k) \
        acc[ai][bj][m][n] = __builtin_amdgcn_mfma_f32_16x16x32_bf16(Bt[n][k], At[m][k], acc[ai][bj][m][n], 0, 0, 0); __builtin_amdgcn_s_setprio(0); } while (0)
#define PG8_WAIT_V(n) asm volatile("s_waitcnt vmcnt(" #n ")" ::: "memory")
#define PG8_WAIT_L(n) asm volatile("s_waitcnt lgkmcnt(" #n ")" ::: "memory")
#define PG8_BAR __builtin_amdgcn_s_barrier()
#define PG8_SCHED __builtin_amdgcn_sched_barrier(0)
    Unit cur, nxt; int ui = 0;
    if (!S.next(0, cur)) return;
    f32x4 acc[2][2][4][2];
#pragma unroll
    for (int a = 0; a < 2; ++a)
#pragma unroll
        for (int b = 0; b < 2; ++b)
#pragma unroll
            for (int m = 0; m < 4; ++m)
#pragma unroll
                for (int n = 0; n < 2; ++n) acc[a][b][m][n] = (f32x4){0.f, 0.f, 0.f, 0.f};
    bf16x8 At[4][2], B0[2][2], B1[2][2];
    const char* cA = (const char*)g.A + (size_t)cur.pm * tstepA; const char* cB = (const char*)g.Bt + (size_t)cur.pn * tstepB;
    S.a_ready(cur);
    PG8_STAGE(PG8_SB(0, 0), cB, voffB); PG8_STAGE(PG8_SA(0, 0), cA, voffA); PG8_STAGE(PG8_SB(0, 1), cB + hstepB, voffB); PG8_STAGE(PG8_SA(0, 1), cA + hstepA, voffA);
    if (wr == 1) PG8_BAR;
    PG8_WAIT_V(4); PG8_BAR;
    PG8_STAGE(PG8_SB(1, 0), cB + kstep, voffB); PG8_STAGE(PG8_SA(1, 0), cA + kstep, voffA); PG8_STAGE(PG8_SB(1, 1), cB + hstepB + kstep, voffB);
    PG8_WAIT_V(6); PG8_BAR;
    for (;;) {
        const bool has_next = S.next(ui + 1, nxt);
        const char* nA = has_next ? (const char*)g.A + (size_t)nxt.pm * tstepA : cA; const char* nB = has_next ? (const char*)g.Bt + (size_t)nxt.pn * tstepB : cB;
        for (int t = 0; t < nt; t += 2) {
            const bool last = (t == nt - 2);
            const char* a1 = cA + (size_t)(t + 1) * kstep;
            const char* a2 = last ? nA : cA + (size_t)(t + 2) * kstep; const char* b2 = last ? nB : cB + (size_t)(t + 2) * kstep;
            const char* a3 = a2 + kstep; const char* b3 = b2 + kstep;
            if (last && has_next) S.a_ready(nxt);
            PG8_LDB(B0, 0, 0); PG8_SCHED; PG8_LDA(At, 0, 0); PG8_STAGE(PG8_SA(1, 1), a1 + hstepA, voffA);
            PG8_WAIT_L(8); PG8_BAR; PG8_WAIT_L(0); PG8_MMA(0, 0, At, B0); PG8_BAR; PG8_SCHED;
            PG8_LDB(B1, 0, 1); PG8_STAGE(PG8_SB(0, 0), b2, voffB);
            PG8_BAR; PG8_WAIT_L(0); PG8_MMA(0, 1, At, B1); PG8_BAR;
            PG8_LDA(At, 0, 1); PG8_STAGE(PG8_SA(0, 0), a2, voffA);
            PG8_BAR; PG8_WAIT_L(0); PG8_MMA(1, 0, At, B0); PG8_BAR; PG8_SCHED;
            PG8_STAGE(PG8_SB(0, 1), b2 + hstepB, voffB);
            PG8_WAIT_V(6); PG8_BAR; PG8_MMA(1, 1, At, B1); PG8_BAR;
            PG8_LDB(B0, 1, 0); PG8_SCHED; PG8_LDA(At, 1, 0); PG8_STAGE(PG8_SA(0, 1), a2 + hstepA, voffA);
            PG8_WAIT_L(8); PG8_BAR; PG8_WAIT_L(0); PG8_MMA(0, 0, At, B0); PG8_BAR; PG8_SCHED;
            PG8_LDB(B1, 1, 1); PG8_STAGE(PG8_SB(1, 0), b3, voffB);
            PG8_BAR; PG8_WAIT_L(0); PG8_MMA(0, 1, At, B1); PG8_BAR;
            PG8_LDA(At, 1, 1); PG8_STAGE(PG8_SA(1, 0), a3, voffA);
            PG8_BAR; PG8_WAIT_L(0); PG8_MMA(1, 0, At, B0); PG8_BAR; PG8_SCHED;
            PG8_STAGE(PG8_SB(1, 1), b3 + hstepB, voffB);
            PG8_WAIT_V(6); PG8_BAR; PG8_MMA(1, 1, At, B1); PG8_BAR;
        }
        if constexpr (!Epi::AFTER_DRAIN) { E(acc, cur, wr, wc, fr, fq); S.done(cur); }
        if (!has_next) break;
#pragma unroll
        for (int a = 0; a < 2; ++a)
#pragma unroll
            for (int b = 0; b < 2; ++b)
#pragma unroll
                for (int m = 0; m < 4; ++m)
#pragma unroll
                    for (int n = 0; n < 2; ++n) acc[a][b][m][n] = (f32x4){0.f, 0.f, 0.f, 0.f};
        cur = nxt; cA = nA; cB = nB; ++ui;
    }
    PG8_WAIT_V(0);
    if (wr == 0) PG8_BAR;
    PG8_BAR;
    if constexpr (Epi::AFTER_DRAIN) { E.fused(acc, cur, wr, wc, fr, fq, lds, wid, lane); S.done(cur); }
#undef PG8_SA
#undef PG8_SB
#undef PG8_STAGE
#undef PG8_LDA
#undef PG8_LDB
#undef PG8_MMA
#undef PG8_WAIT_V
#undef PG8_WAIT_L
#undef PG8_BAR
#undef PG8_SCHED
}
}

#define XB_TMO      128
#define XB_XCNT(j)  (256  + 64 * (j))
#define XB_XSUB(j)  (1280 + 64 * (j))
#define XB_XGEN(j)  (2304 + 64 * (j))
#define XB_TOP      3328
#define XB_TOPGEN   3392
#define XCD_BAR_WORDS 3456
#define XB_SPIN_CAP (1u << 18)

__device__ __forceinline__ unsigned xb_ld(unsigned* p)              { return __hip_atomic_load(p, __ATOMIC_RELAXED, __HIP_MEMORY_SCOPE_AGENT); }
__device__ __forceinline__ unsigned xb_add(unsigned* p, unsigned v) { return __hip_atomic_fetch_add(p, v, __ATOMIC_RELAXED, __HIP_MEMORY_SCOPE_AGENT); }
__device__ __forceinline__ unsigned xb_xcc_id() { return (unsigned)__builtin_amdgcn_s_getreg((3 << 11) | 20) & 0xFu; }
#define XB_SPIN(cond, bar) do { unsigned _sp = 0; while (cond) { __builtin_amdgcn_s_sleep(1); \
    if ((++_sp & 255u) == 0u) { if (xb_ld(&(bar)[XB_TMO])) break; if (_sp > XB_SPIN_CAP) { atomicAdd(&(bar)[XB_TMO], 1u); break; } } } } while (0)

struct XcdBarrier {
    unsigned* bar; unsigned x;
    volatile LAS unsigned* st;
};

__device__ __forceinline__ XcdBarrier xcd_barrier_post(unsigned* bar, volatile LAS unsigned* st) {
    XcdBarrier b; b.bar = bar; b.x = xb_xcc_id(); b.st = st;
    if (threadIdx.x == 0) (void)xb_add(&bar[XB_XCNT(b.x)], 1u);
    return b;
}
__device__ __forceinline__ void xcd_barrier_complete(unsigned* bar, unsigned x, unsigned& nloc, unsigned& nx) {
    const unsigned G = gridDim.x * gridDim.y * gridDim.z;
    unsigned sum, cnt, mine, sp = 0u;
    for (;;) {
        sum = 0u; cnt = 0u; mine = 0u;
#pragma unroll
        for (unsigned j = 0; j < 16; ++j) { const unsigned c = xb_ld(&bar[XB_XCNT(j)]); sum += c; cnt += (c > 0u) ? 1u : 0u; mine = (j == x) ? c : mine; }
        if (sum == G) break;
        __builtin_amdgcn_s_sleep(1);
        if ((++sp & 255u) == 0u) { if (xb_ld(&bar[XB_TMO])) break; if (sp > XB_SPIN_CAP) { atomicAdd(&bar[XB_TMO], 1u); break; } }
    }
    nloc = mine > 0u ? mine : 1u; nx = cnt > 0u ? cnt : 1u;
}

__device__ __forceinline__ void xcd_barrier(const XcdBarrier& b) {
    asm volatile("s_waitcnt vmcnt(0)" ::: "memory");
    __syncthreads();
    if (threadIdx.x == 0) {
        unsigned* bar = b.bar;
        __builtin_amdgcn_s_waitcnt(0);
        unsigned nloc = b.st[0], nx = b.st[1];
        if (nloc == 0u) { xcd_barrier_complete(bar, b.x, nloc, nx); b.st[0] = nloc; b.st[1] = nx; }
        const unsigned old = xb_add(&bar[XB_XSUB(b.x)], 1u);
        const unsigned gen = old / nloc;
        if (old + 1u == (gen + 1u) * nloc) {
            __builtin_amdgcn_fence(__ATOMIC_RELEASE, "agent");
            asm volatile("s_waitcnt vmcnt(0)" ::: "memory");
            const unsigned og = xb_add(&bar[XB_TOP], 1u);
            const unsigned tg = og / nx;
            if (og + 1u == (tg + 1u) * nx) xb_add(&bar[XB_TOPGEN], 1u);
            else XB_SPIN(xb_ld(&bar[XB_TOPGEN]) == tg, bar);
            __builtin_amdgcn_fence(__ATOMIC_ACQUIRE, "agent");
            xb_add(&bar[XB_XGEN(b.x)], 1u);
            asm volatile("s_waitcnt vmcnt(0)" ::: "memory");
        } else {
            XB_SPIN(xb_ld(&bar[XB_XGEN(b.x)]) == gen, bar);
            __builtin_amdgcn_fence(__ATOMIC_ACQUIRE, "agent");
            asm volatile("s_waitcnt vmcnt(0)" ::: "memory");
        }
    }
    __syncthreads();
}


__device__ __forceinline__ f32x4 mma(bf16x8 a, bf16x8 b, f32x4 c) { return __builtin_amdgcn_mfma_f32_16x16x32_bf16(a, b, c, 0, 0, 0); }
__device__ __forceinline__ bf16x8 frag_row(const LAS bf16* t, int ld, int r0, int c0, int lane) {
    return *(const LAS bf16x8*)(t + (r0 + (lane & 15)) * ld + c0 + 8 * (lane >> 4));
}
__device__ __forceinline__ bf16x8 frag_tr(const LAS bf16* t, int ld, int r0, int c0, int lane) {
    const int g = lane >> 4, q = (lane & 15) >> 2, p = lane & 3;
    const LAS bf16* a = t + (r0 + 8 * g + q) * ld + c0 + 4 * p;
    const s16x4 lo = __builtin_amdgcn_ds_read_tr16_b64_v4i16((LAS s16x4*)a);
    const s16x4 hi = __builtin_amdgcn_ds_read_tr16_b64_v4i16((LAS s16x4*)(a + 4 * ld));
    return (bf16x8){lo[0], lo[1], lo[2], lo[3], hi[0], hi[1], hi[2], hi[3]};
}
#define LDS_FENCE() do { asm volatile("s_waitcnt lgkmcnt(0)" ::: "memory"); __builtin_amdgcn_wave_barrier(); } while (0)

struct Args {
    const float* in[22]; float* out; unsigned char* ws;
};
enum { I_X = 0, I_C, I_CTX, I_CCTX, I_WMOD, I_BMOD, I_LNW, I_LNB, I_ABWIN, I_ABGB, I_ABNW, I_ABSINK, I_ABWOUT, I_GWIN, I_GGUP, I_GGB, I_GNW, I_GWOUT, I_PWQ, I_PKEYS, I_PU, I_PV };

__device__ __forceinline__ const float* srow_c(const float* lat, const float* ctx, int r) { const int b = r / PB, p = r - b * PB; return p < LC ? ctx + (size_t)(b * LC + p) * D : lat + (size_t)(b * SEQ + p - LC) * D; }
__device__ __forceinline__ float* srow(float* lat, float* ctx, int r) { const int b = r / PB, p = r - b * PB; return p < LC ? ctx + (size_t)(b * LC + p) * D : lat + (size_t)(b * SEQ + p - LC) * D; }

__device__ __forceinline__ void p0_transpose_item(const float* W, int K, int ldw, int c0, int ncols, bf16* WT, int row_off, LAS float* scr, int item, int lane,
                                                  int s0lo, int s0hi, float s0, int s1lo, int s1hi, float s1) {
    const int nblk = ncols / 32, kb = item / nblk, nb = item % nblk, k0 = 64 * kb, n0 = 32 * nb;
#pragma unroll 8
    for (int i = 0; i < 32; ++i) { const int kk = 2 * i + (lane >> 5); scr[kk * 33 + (lane & 31)] = W[(size_t)(k0 + kk) * ldw + c0 + n0 + (lane & 31)]; }
    asm volatile("s_waitcnt lgkmcnt(0)" ::: "memory");
    const int c = lane & 7;
#pragma unroll
    for (int j = 0; j < 4; ++j) { const int n = (lane >> 3) + 8 * j; const LAS float* s = scr + (8 * c) * 33 + n;
        const int dr = row_off + n0 + n; float sc = 1.f; if (dr >= s0lo && dr < s0hi) sc = s0; if (dr >= s1lo && dr < s1hi) sc = s1;
        v4u o; o.x = pk2(s[0 * 33] * sc, s[1 * 33] * sc); o.y = pk2(s[2 * 33] * sc, s[3 * 33] * sc); o.z = pk2(s[4 * 33] * sc, s[5 * 33] * sc); o.w = pk2(s[6 * 33] * sc, s[7 * 33] * sc);
        *(v4u*)(WT + (size_t)dr * K + k0 + 8 * c) = o; }
    asm volatile("s_waitcnt lgkmcnt(0)" ::: "memory");
}
__device__ __forceinline__ void cvt_f32_bf16(const float* src, bf16* dst, size_t n, int gtid, int gthreads) {
    const size_t nch = n / 8;
    for (size_t i = gtid; i < nch; i += gthreads) { const f32x4 a = *(const f32x4*)(src + i * 8), b = *(const f32x4*)(src + i * 8 + 4);
        v4u o; o.x = pk2(a[0], a[1]); o.y = pk2(a[2], a[3]); o.z = pk2(b[0], b[1]); o.w = pk2(b[2], b[3]); *(v4u*)(dst + i * 8) = o; }
}
typedef float v16f __attribute__((ext_vector_type(16)));
typedef float v32f __attribute__((ext_vector_type(32)));
typedef unsigned v6u __attribute__((ext_vector_type(6)));
typedef unsigned v3u __attribute__((ext_vector_type(3)));
__device__ __forceinline__ void cvt_rows_fp6(const float* src, unsigned char* dst, float* inv, int nrows, int gw, int NGW, int lane) {
    const int hl = lane & 31, hh = lane >> 5;
    for (int r2 = gw; r2 < nrows / 2; r2 += NGW) {
        const int r = 2 * r2 + hh; const float* sp = src + (size_t)r * 1024 + 32 * hl;
        f32x4 x[8]; float m = 0.f;
#pragma unroll
        for (int q = 0; q < 8; ++q) { x[q] = *(const f32x4*)(sp + 4 * q); m = fmaxf(m, fmaxf(fmaxf(fabsf(x[q][0]), fabsf(x[q][1])), fmaxf(fabsf(x[q][2]), fabsf(x[q][3])))); }
        m = fmaxf(m, dppmov_f<0xB1>(m)); m = fmaxf(m, dppmov_f<0x4E>(m)); m = fmaxf(m, dppmov_f<0x141>(m)); m = fmaxf(m, dppmov_f<0x128>(m)); m = fmaxf(m, __shfl_xor(m, 16));
        const float sc = m > 0.f ? 7.0f / m : 1.f;
        v16f a, b;
#pragma unroll
        for (int q = 0; q < 8; ++q) { a[2 * q] = x[q][0] * sc; b[2 * q] = x[q][1] * sc; a[2 * q + 1] = x[q][2] * sc; b[2 * q + 1] = x[q][3] * sc; }
        const v6u p = __builtin_amdgcn_cvt_scalef32_2xpk16_fp6_f32(a, b, 1.0f);
        unsigned char* dp = dst + (size_t)r * 768 + 24 * hl;
        *(v2u*)dp = (v2u){p[0], p[1]}; *(v2u*)(dp + 8) = (v2u){p[2], p[3]}; *(v2u*)(dp + 16) = (v2u){p[4], p[5]};
        if (hl == 0) inv[r] = m > 0.f ? m / 7.0f : 1.f;
    }
}
__device__ __forceinline__ void cvt_rows_fp4(const float* src, unsigned char* dst, float* inv, int nrows, int gw, int NGW, int lane) {
    const int hl = lane & 31, hh = lane >> 5;
    for (int r2 = gw; r2 < nrows / 2; r2 += NGW) {
        const int r = 2 * r2 + hh; const float* sp = src + (size_t)r * 1024 + 32 * hl;
        f32x4 x[8]; float m = 0.f;
#pragma unroll
        for (int q = 0; q < 8; ++q) { x[q] = *(const f32x4*)(sp + 4 * q); m = fmaxf(m, fmaxf(fmaxf(fabsf(x[q][0]), fabsf(x[q][1])), fmaxf(fabsf(x[q][2]), fabsf(x[q][3])))); }
        m = fmaxf(m, dppmov_f<0xB1>(m)); m = fmaxf(m, dppmov_f<0x4E>(m)); m = fmaxf(m, dppmov_f<0x141>(m)); m = fmaxf(m, dppmov_f<0x128>(m)); m = fmaxf(m, __shfl_xor(m, 16));
        const float sc = m > 0.f ? 6.0f / m : 1.f;
        unsigned w[4];
#pragma unroll
        for (int d = 0; d < 4; ++d) { unsigned t = 0u;
            t = __builtin_amdgcn_cvt_scalef32_pk_fp4_f32(t, x[2 * d][0] * sc, x[2 * d][1] * sc, 1.0f, 0); t = __builtin_amdgcn_cvt_scalef32_pk_fp4_f32(t, x[2 * d][2] * sc, x[2 * d][3] * sc, 1.0f, 1);
            t = __builtin_amdgcn_cvt_scalef32_pk_fp4_f32(t, x[2 * d + 1][0] * sc, x[2 * d + 1][1] * sc, 1.0f, 2); t = __builtin_amdgcn_cvt_scalef32_pk_fp4_f32(t, x[2 * d + 1][2] * sc, x[2 * d + 1][3] * sc, 1.0f, 3);
            w[d] = t; }
        *(v4u*)(dst + (size_t)r * 512 + 16 * hl) = (v4u){w[0], w[1], w[2], w[3]};
        if (hl == 0) inv[r] = m > 0.f ? m / 6.0f : 1.f;
    }
}
__device__ __forceinline__ void p0_prologue(const Args& A, LAS unsigned char* lds, int vcu, int G, int wave, int lane, int tid) {
    unsigned char* ws = A.ws;
    const int gw = vcu * 8 + wave, NGW = G * 8, gtid = vcu * 512 + tid, gthreads = G * 512;
    LAS float* sil = (LAS float*)lds;
    for (int i = tid; i < 9 * 1024; i += 512) { const float v = i < 8192 ? A.in[I_C][i] : A.in[I_CCTX][i - 8192]; sil[i] = siluf_(v); }
    __syncthreads();
    float* MOD = (float*)(ws + WS_MOD);
    LAS float* part = (LAS float*)(lds + 40960);
    for (int it = vcu; it < 2 * 96; it += G) {
        const int l = it / 96, n = (it % 96) * 64 + lane; const float* wm = A.in[I_WMOD] + (size_t)l * 1024 * 6144 + (size_t)(128 * wave) * 6144 + n;
        float acc[9];
#pragma unroll
        for (int r = 0; r < 9; ++r) acc[r] = 0.f;
#pragma unroll 8
        for (int k = 0; k < 128; ++k) { const float w = wm[(size_t)k * 6144];
#pragma unroll
            for (int r = 0; r < 9; ++r) acc[r] += sil[r * 1024 + 128 * wave + k] * w; }
        __syncthreads();
#pragma unroll
        for (int r = 0; r < 9; ++r) part[(wave * 9 + r) * 64 + lane] = acc[r];
        __syncthreads();
        for (int i = tid; i < 9 * 64; i += 512) { float sum = 0.f;
#pragma unroll
            for (int w8 = 0; w8 < 8; ++w8) sum += part[w8 * 576 + i];
            const int r = i >> 6, c = (it % 96) * 64 + (i & 63); MOD[(size_t)(l * 9 + r) * 6144 + c] = sum + A.in[I_BMOD][l * 6144 + c]; }
    }
    __syncthreads();
    LAS float* scr = (LAS float*)(lds + 40960 + wave * 8704);
    constexpr int I_AB1 = 16 * 64, I_AB2 = 16 * 24, I_ABO = 16 * 32, I_C1 = 16 * 96, I_CO = 16 * 32, I_Q = 16 * 64;
    constexpr int NITEMS = I_AB1 + I_AB2 + I_ABO + I_C1 + I_CO + 2 * I_Q;
    const float rs128 = 0.08838834764831845f;
    for (int it = gw; it < NITEMS; it += NGW) {
        int r = it;
        if (r < I_AB1) { p0_transpose_item(A.in[I_ABWIN], 1024, 2832, 0, 2048, (bf16*)(ws + WS_WAB), 0, scr, r, lane, 512, 1024, rs128, 0, 0, 1.f); continue; } r -= I_AB1;
        if (r < I_AB2) { p0_transpose_item(A.in[I_ABWIN], 1024, 2832, 2064, 768, (bf16*)(ws + WS_WAB), 2048, scr, r, lane, 2048, 2560, 0.125f, 0, 0, 1.f); continue; } r -= I_AB2;
        if (r < I_ABO) { p0_transpose_item(A.in[I_ABWOUT], 1024, 1024, 0, 1024, (bf16*)(ws + WS_WABO), 0, scr, r, lane, 0, 0, 1.f, 0, 0, 1.f); continue; } r -= I_ABO;
        if (r < I_C1) { p0_transpose_item(A.in[I_GWIN], 1024, 3104, 0, 3072, (bf16*)(ws + WS_WC), 0, scr, r, lane, 0, 512, rs128, 0, 0, 1.f); continue; } r -= I_C1;
        if (r < I_CO) { p0_transpose_item(A.in[I_GWOUT], 1024, 1024, 0, 1024, (bf16*)(ws + WS_WCO), 0, scr, r, lane, 0, 0, 1.f, 0, 0, 1.f); continue; } r -= I_CO;
        if (r < I_Q) { p0_transpose_item(A.in[I_PWQ], 1024, 2048, 0, 2048, (bf16*)(ws + WS_WQ0), 0, scr, r, lane, 0, 0, 1.f, 0, 0, 1.f); continue; } r -= I_Q;
        p0_transpose_item(A.in[I_PWQ] + (size_t)1024 * 2048, 1024, 2048, 0, 2048, (bf16*)(ws + WS_WQ1), 0, scr, r, lane, 0, 0, 1.f, 0, 0, 1.f);
    }
    for (int i = gtid; i < 16 * 1024; i += gthreads) { const int g = i >> 10, k = i & 1023; ((float*)(ws + WS_WG))[i] = A.in[I_ABWIN][(size_t)k * 2832 + 2048 + g]; }
    for (int i = gtid; i < 32 * 1024; i += gthreads) { const int g = i >> 10, k = i & 1023; ((float*)(ws + WS_WLOW))[i] = A.in[I_GWIN][(size_t)k * 3104 + 3072 + g]; }
    for (int i = gtid; i < 64 * 16; i += gthreads) { const int pos = i >> 4, f = i & 15; const float inv = powf(10000.f, -(float)f / 16.f); const float ang = (float)pos * inv;
        ((float*)(ws + WS_ROPE))[2 * i] = cosf(ang); ((float*)(ws + WS_ROPE))[2 * i + 1] = sinf(ang); }
    cvt_f32_bf16(A.in[I_PKEYS], (bf16*)(ws + WS_KEYS), (size_t)2 * 8 * 2 * 128 * 128, gtid, gthreads);
    cvt_rows_fp4(A.in[I_PU], ws + WS_U, (float*)(ws + WS_SCL), 2 * NEXP, gw, NGW, lane);
    cvt_rows_fp6(A.in[I_PV], ws + WS_V, (float*)(ws + WS_SCL) + 2 * NEXP, 2 * NEXP, gw, NGW, lane);
}

__device__ __forceinline__ void split8(const float* v, bf16x8& hi, bf16x8& lo) {
#pragma unroll
    for (int j = 0; j < 8; ++j) { const unsigned h = f2bf(v[j]); const float hf = __builtin_bit_cast(float, h << 16); hi[j] = (short)h; lo[j] = (short)f2bf(v[j] - hf); }
}
template <int NG>
__device__ __forceinline__ void h_phase(const float* lat, const float* ctx, const float* mod  , bf16* HB, const float* WGT, float* GL, LAS unsigned char* lds, int vcu, int G, int wave, int lane, int tid) {
    constexpr int NT = NG / 16;
    LAS float* part = (LAS float*)lds;
    const int g = lane >> 4, c16 = lane & 15;
    bf16x8 bhi[NT][4], blo[NT][4];
#pragma unroll
    for (int nt = 0; nt < NT; ++nt)
#pragma unroll
        for (int ks = 0; ks < 4; ++ks) { const float* wp = WGT + (size_t)(16 * nt + c16) * 1024 + 128 * wave + 32 * ks + 8 * g;
            const f32x4 w0 = *(const f32x4*)wp, w1 = *(const f32x4*)(wp + 4); const float wv[8] = {w0[0], w0[1], w0[2], w0[3], w1[0], w1[1], w1[2], w1[3]}; split8(wv, bhi[nt][ks], blo[nt][ks]); }
    for (int tile = vcu; tile < TT / 16; tile += G) {
        const int r0 = tile * 16, b = r0 / PB, p0 = r0 - b * PB; const float* mr = mod + (size_t)(p0 < LC ? 8 : b) * 6144 + 128 * wave + 8 * g;
        const int row = r0 + c16; const float* xr = srow_c(lat, ctx, row) + 128 * wave + 8 * g;
        f32x4 xa[4][2], sha[4][2], sca[4][2];
#pragma unroll
        for (int ks = 0; ks < 4; ++ks)
#pragma unroll
            for (int q = 0; q < 2; ++q) { xa[ks][q] = *(const f32x4*)(xr + 32 * ks + 4 * q); sha[ks][q] = *(const f32x4*)(mr + 32 * ks + 4 * q); sca[ks][q] = *(const f32x4*)(mr + 1024 + 32 * ks + 4 * q); }
        f32x4 acc[NT];
#pragma unroll
        for (int nt = 0; nt < NT; ++nt) acc[nt] = (f32x4){0.f, 0.f, 0.f, 0.f};
#pragma unroll
        for (int ks = 0; ks < 4; ++ks) {
            float hv[8];
#pragma unroll
            for (int q = 0; q < 2; ++q)
#pragma unroll
                for (int i = 0; i < 4; ++i) hv[4 * q + i] = xa[ks][q][i] * (sca[ks][q][i] + 1.0f) + sha[ks][q][i];
            bf16x8 ahi, alo; split8(hv, ahi, alo);
            *(bf16x8*)(HB + (size_t)row * D + 128 * wave + 32 * ks + 8 * g) = ahi;
#pragma unroll
            for (int nt = 0; nt < NT; ++nt) { acc[nt] = mma(ahi, bhi[nt][ks], acc[nt]); acc[nt] = mma(ahi, blo[nt][ks], acc[nt]); acc[nt] = mma(alo, bhi[nt][ks], acc[nt]); }
        }
        __syncthreads();
#pragma unroll
        for (int nt = 0; nt < NT; ++nt)
#pragma unroll
            for (int r = 0; r < 4; ++r) part[(wave * 16 + 4 * g + r) * NG + 16 * nt + c16] = acc[nt][r];
        __syncthreads();
        for (int i = tid; i < 16 * NG; i += 512) { float sum = 0.f;
#pragma unroll
            for (int w8 = 0; w8 < 8; ++w8) sum += part[w8 * 16 * NG + i];
            GL[(size_t)r0 * NG + i] = sum; }
    }
}

__device__ __forceinline__ void ln_row(const float* sr, float* xr, const bf16* yrow, const float* mr, const float* lnw, const float* lnb, bf16* hrow, int lane, int dry, bool active) {
    f32x4 v[4]; float s = 0.f;
#pragma unroll
    for (int j = 0; j < 4; ++j) { const int c = 4 * lane + 256 * j; const f32x4 x = *(const f32x4*)(sr + c), g1 = *(const f32x4*)(mr + 2048 + c); const v2u yw = *(const v2u*)(yrow + c);
        v[j][0] = DN_ALPHA * x[0] + g1[0] * bflo(yw.x); v[j][1] = DN_ALPHA * x[1] + g1[1] * bfhi(yw.x); v[j][2] = DN_ALPHA * x[2] + g1[2] * bflo(yw.y); v[j][3] = DN_ALPHA * x[3] + g1[3] * bfhi(yw.y);
        s += (v[j][0] + v[j][1]) + (v[j][2] + v[j][3]); }
    const float mean = wave_sum(s) * (1.f / D); float s2 = 0.f;
#pragma unroll
    for (int j = 0; j < 4; ++j) { v[j] = v[j] - mean; s2 += (v[j][0] * v[j][0] + v[j][1] * v[j][1]) + (v[j][2] * v[j][2] + v[j][3] * v[j][3]); }
    const float rstd = 1.f / sqrtf(wave_sum(s2) * (1.f / D) + LN_EPS);
    if (active) {
#pragma unroll
    for (int j = 0; j < 4; ++j) { const int c = 4 * lane + 256 * j; const f32x4 w = *(const f32x4*)(lnw + c), bb = *(const f32x4*)(lnb + c);
        const f32x4 x1 = v[j] * rstd * w + bb; if (!dry) *(f32x4*)(xr + c) = x1;
        const f32x4 sh = *(const f32x4*)(mr + 3072 + c), sc = *(const f32x4*)(mr + 4096 + c); const f32x4 hp = x1 * (sc + 1.0f) + sh;
        v2u o; o.x = pk2(hp[0], hp[1]); o.y = pk2(hp[2], hp[3]); if (!dry) *(v2u*)(hrow + c) = o; }
    }
}
__device__ __forceinline__ void ln_phase(const float* slat, const float* sctx, float* lat, float* ctx, const bf16* Y, const float* mod, const float* lnw, const float* lnb, bf16* HB, int gw, int NGW, int lane, int dry, bool lat_only) {
    const int nrows = lat_only ? NB * SEQ : TT;
    for (int i0 = gw; i0 < nrows; i0 += 2 * NGW) {
        const int i1 = i0 + NGW; const bool has1 = i1 < nrows; const int r0 = map_row(i0, lat_only), r1c = map_row(has1 ? i1 : i0, lat_only);
        const int b0 = r0 / PB, p0 = r0 - b0 * PB, b1 = r1c / PB, p1 = r1c - b1 * PB;
        ln_row(srow_c(slat, sctx, r0), srow(lat, ctx, r0), Y + (size_t)r0 * D, mod + (size_t)(p0 < LC ? 8 : b0) * 6144, lnw, lnb, HB + (size_t)r0 * D, lane, dry, true);
        ln_row(srow_c(slat, sctx, r1c), srow(lat, ctx, r1c), Y + (size_t)r1c * D, mod + (size_t)(p1 < LC ? 8 : b1) * 6144, lnw, lnb, HB + (size_t)r1c * D, lane, dry, has1);
    }
}

constexpr int AT_LD = 72;
__device__ __forceinline__ bf16x8 frag_tr_perm(const LAS bf16* t, int ld, int r0, int c0, int lane) {
    const int g = lane >> 4, q = (lane & 15) >> 2, p = lane & 3;
    const LAS bf16* a = t + (r0 + 4 * g + q) * ld + c0 + 4 * p;
    const s16x4 lo = __builtin_amdgcn_ds_read_tr16_b64_v4i16((LAS s16x4*)a);
    const s16x4 hi = __builtin_amdgcn_ds_read_tr16_b64_v4i16((LAS s16x4*)(a + 16 * ld));
    return (bf16x8){lo[0], lo[1], lo[2], lo[3], hi[0], hi[1], hi[2], hi[3]};
}
__device__ __forceinline__ void attn_phase(const bf16* P, bf16* CAT, const float* sink, const float* ropetab, LAS unsigned char* lds, unsigned* qctr, int vcu, int G, int wave, int lane, int tid) {
    LAS bf16* Kt = (LAS bf16*)lds;
    LAS bf16* Vt = (LAS bf16*)(lds + 9216);
    LAS bf16* Qw = (LAS bf16*)(lds + 18432 + wave * 4608);
    const int g = lane >> 4, c16 = lane & 15;
    volatile LAS int* qslot = (volatile LAS int*)(lds + MISC_OFF) + 12;
    for (;;) {
        if (tid == 0) *qslot = (int)__hip_atomic_fetch_add(qctr, 1u, __ATOMIC_RELAXED, __HIP_MEMORY_SCOPE_AGENT);
        __syncthreads();
        const int item = *qslot;
        if (item >= 1024 + 64) break;
        const bool is_ctx = item >= 1024;
        int b, hk, nb;
        if (!is_ctx) { b = item >> 7; hk = (item >> 6) & 1; nb = item & 63; } else { const int it = item - 1024; b = it >> 3; hk = (it >> 2) & 1; nb = it & 3; }
        const int head = hk * 4 + (wave >> 1);
        const int qrow0 = b * PB + (is_ctx ? 0 : LC) + nb * 64 + (wave & 1) * 32;
        const int qlat0 = nb * 64 + (wave & 1) * 32;
        __syncthreads();
#pragma unroll
        for (int i = 0; i < 4; ++i) { const int cidx = lane + 64 * i, rr = cidx >> 3, ch = cidx & 7;
            const v4u raw = *(const v4u*)(P + (size_t)(qrow0 + rr) * N_AB + 2048 + head * 64 + ch * 8); v4u o = raw;
            if (!is_ctx) { const int tl = qlat0 + rr; const int pos = (ch < 4) ? (tl >> 6) : (tl & 63); const float* tb = ropetab + (size_t)(pos * 16 + (ch & 3) * 4) * 2;
                const unsigned wv[4] = {raw.x, raw.y, raw.z, raw.w}; unsigned ov[4];
#pragma unroll
                for (int k = 0; k < 4; ++k) { const float x1 = bflo(wv[k]), x2 = bfhi(wv[k]), c = tb[2 * k], s = tb[2 * k + 1]; ov[k] = pk2(x1 * c - x2 * s, x1 * s + x2 * c); }
                o.x = ov[0]; o.y = ov[1]; o.z = ov[2]; o.w = ov[3]; }
            *(LAS v4u*)(Qw + rr * AT_LD + ch * 8) = o; }
        LDS_FENCE();
        bf16x8 qf[2][2];
#pragma unroll
        for (int mt = 0; mt < 2; ++mt)
#pragma unroll
            for (int ks = 0; ks < 2; ++ks) qf[mt][ks] = frag_row(Qw, AT_LD, 16 * mt, 32 * ks, lane);
        LDS_FENCE();
        f32x4 o[2][4]; float mrun[2], lrun[2];
        const float sk = sink[head];
#pragma unroll
        for (int qt = 0; qt < 2; ++qt) { mrun[qt] = sk; lrun[qt] = 1.f; }
#pragma unroll
        for (int qt = 0; qt < 2; ++qt)
#pragma unroll
            for (int nt = 0; nt < 4; ++nt) o[qt][nt] = (f32x4){0.f, 0.f, 0.f, 0.f};
        const int nkt = is_ctx ? 4 : 9;
        const int srr = tid >> 3, sch = tid & 7;
        int kt = 0; f32x2 trope[4];
#pragma unroll
        for (int i = 0; i < 4; ++i) trope[i] = (f32x2){1.f, 0.f};
        v4u kraw = *(const v4u*)(P + (size_t)(b * PB + srr) * N_AB + 2560 + hk * 64 + sch * 8), vraw = *(const v4u*)(P + (size_t)(b * PB + srr) * N_AB + 2688 + hk * 64 + sch * 8);
        while (kt < nkt) {
            const int kp0 = nb * 64 - 128 + 64 * (kt - 4);
            int kn = kt + 1;
            while (kn < nkt && kn >= 4 && ((nb * 64 - 128 + 64 * (kn - 4)) < 0 || (nb * 64 - 128 + 64 * (kn - 4)) >= SEQ)) ++kn;
            __syncthreads();
            { v4u o = kraw;
              if (kt >= 4) { const unsigned wv[4] = {kraw.x, kraw.y, kraw.z, kraw.w}; unsigned ov[4];
#pragma unroll
                  for (int i = 0; i < 4; ++i) { const float x1 = bflo(wv[i]), x2 = bfhi(wv[i]), c = trope[i][0], sn = trope[i][1]; ov[i] = pk2(x1 * c - x2 * sn, x1 * sn + x2 * c); }
                  o.x = ov[0]; o.y = ov[1]; o.z = ov[2]; o.w = ov[3]; }
              *(LAS v4u*)(Kt + srr * AT_LD + sch * 8) = o; *(LAS v4u*)(Vt + srr * AT_LD + sch * 8) = vraw; }
            if (kn < nkt) { const int kpn = nb * 64 - 128 + 64 * (kn - 4); const int krn = b * PB + (kn < 4 ? 64 * kn : LC + kpn);
                kraw = *(const v4u*)(P + (size_t)(krn + srr) * N_AB + 2560 + hk * 64 + sch * 8); vraw = *(const v4u*)(P + (size_t)(krn + srr) * N_AB + 2688 + hk * 64 + sch * 8);
                if (kn >= 4) { const int tl = kpn + srr; const int pos = (sch < 4) ? (tl >> 6) : (tl & 63); const f32x2* tb = (const f32x2*)(ropetab + (size_t)(pos * 16 + (sch & 3) * 4) * 2);
#pragma unroll
                    for (int i = 0; i < 4; ++i) trope[i] = tb[i]; } }
            __syncthreads();
            const bool need_mask = (kt == 4) || (kt == 8);
            bf16x8 kf[4][2];
#pragma unroll
            for (int km = 0; km < 4; ++km)
#pragma unroll
                for (int ks = 0; ks < 2; ++ks) kf[km][ks] = frag_row(Kt, AT_LD, 16 * km, 32 * ks, lane);
            bf16x8 pa[2][2];
#pragma unroll
            for (int qt = 0; qt < 2; ++qt) {
                f32x4 st[4];
#pragma unroll
                for (int km = 0; km < 4; ++km) { st[km] = (f32x4){0.f, 0.f, 0.f, 0.f};
#pragma unroll
                    for (int ks = 0; ks < 2; ++ks) st[km] = mma(kf[km][ks], qf[qt][ks], st[km]); }
                if (need_mask) {
#pragma unroll
                    for (int km = 0; km < 4; ++km)
#pragma unroll
                        for (int r = 0; r < 4; ++r) { const int dq = (kp0 + 16 * km + 4 * g + r) - (qlat0 + 16 * qt + c16); if (dq > 128 || dq < -128) st[km][r] = -3.0e38f; } }
                float mx = fmaxf(fmaxf(fmaxf(st[0][0], st[0][1]), fmaxf(st[0][2], st[0][3])), fmaxf(fmaxf(st[1][0], st[1][1]), fmaxf(st[1][2], st[1][3])));
                mx = fmaxf(mx, fmaxf(fmaxf(fmaxf(st[2][0], st[2][1]), fmaxf(st[2][2], st[2][3])), fmaxf(fmaxf(st[3][0], st[3][1]), fmaxf(st[3][2], st[3][3]))));
                mx = fmaxf(mx, __shfl_xor(mx, 16)); mx = fmaxf(mx, __shfl_xor(mx, 32));
                const float mnew = fmaxf(mrun[qt], mx), alpha = __expf(mrun[qt] - mnew);
                float ps = 0.f;
#pragma unroll
                for (int km = 0; km < 4; ++km)
#pragma unroll
                    for (int r = 0; r < 4; ++r) { const float pv = __expf(st[km][r] - mnew); st[km][r] = pv; ps += pv; }
                ps += __shfl_xor(ps, 16); ps += __shfl_xor(ps, 32);
                lrun[qt] = lrun[qt] * alpha + ps; mrun[qt] = mnew;
#pragma unroll
                for (int ks2 = 0; ks2 < 2; ++ks2) { const unsigned w0 = pk2(st[2 * ks2][0], st[2 * ks2][1]), w1 = pk2(st[2 * ks2][2], st[2 * ks2][3]), w2 = pk2(st[2 * ks2 + 1][0], st[2 * ks2 + 1][1]), w3 = pk2(st[2 * ks2 + 1][2], st[2 * ks2 + 1][3]);
                    const v4u wv = (v4u){w0, w1, w2, w3}; pa[qt][ks2] = __builtin_bit_cast(bf16x8, wv); }
#pragma unroll
                for (int r = 0; r < 4; ++r) { const float ar = __shfl(alpha, (lane & 48) + 4 * g + r);
#pragma unroll
                    for (int nt = 0; nt < 4; ++nt) o[qt][nt][r] *= ar; }
            }
#pragma unroll
            for (int ks2 = 0; ks2 < 2; ++ks2) {
                bf16x8 vf[4];
#pragma unroll
                for (int nt = 0; nt < 4; ++nt) vf[nt] = frag_tr_perm(Vt, AT_LD, 32 * ks2, 16 * nt, lane);
#pragma unroll
                for (int qt = 0; qt < 2; ++qt)
#pragma unroll
                    for (int nt = 0; nt < 4; ++nt) o[qt][nt] = mma(pa[qt][ks2], vf[nt], o[qt][nt]); }
            LDS_FENCE();
            kt = kn;
        }
#pragma unroll
        for (int qt = 0; qt < 2; ++qt)
#pragma unroll
            for (int r = 0; r < 4; ++r) { const float inv = 1.f / __shfl(lrun[qt], (lane & 48) + 4 * g + r); bf16* orow = CAT + (size_t)(qrow0 + 16 * qt + 4 * g + r) * D + 512 + head * 64;
#pragma unroll
                for (int nt = 0; nt < 4; ++nt) orow[16 * nt + c16] = (bf16)f2bf(o[qt][nt][r] * inv); }
    }
}

__device__ __forceinline__ float wave_prefix_sum(float v) {
    v += __builtin_bit_cast(float, __builtin_amdgcn_update_dpp(0, __builtin_bit_cast(int, v), 0x111, 0xf, 0xf, true)); v += __builtin_bit_cast(float, __builtin_amdgcn_update_dpp(0, __builtin_bit_cast(int, v), 0x112, 0xf, 0xf, true));
    v += __builtin_bit_cast(float, __builtin_amdgcn_update_dpp(0, __builtin_bit_cast(int, v), 0x114, 0xf, 0xf, true)); v += __builtin_bit_cast(float, __builtin_amdgcn_update_dpp(0, __builtin_bit_cast(int, v), 0x118, 0xf, 0xf, true));
    v += __builtin_bit_cast(float, __builtin_amdgcn_update_dpp(0, __builtin_bit_cast(int, v), 0x142, 0xa, 0xf, false)); v += __builtin_bit_cast(float, __builtin_amdgcn_update_dpp(0, __builtin_bit_cast(int, v), 0x143, 0xc, 0xf, false));
    return v;
}
__device__ __forceinline__ float wave_prefix_max(float v) {
    const int ninf = (int)0xff800000u;
    v = fmaxf(v, __builtin_bit_cast(float, __builtin_amdgcn_update_dpp(ninf, __builtin_bit_cast(int, v), 0x111, 0xf, 0xf, false))); v = fmaxf(v, __builtin_bit_cast(float, __builtin_amdgcn_update_dpp(ninf, __builtin_bit_cast(int, v), 0x112, 0xf, 0xf, false)));
    v = fmaxf(v, __builtin_bit_cast(float, __builtin_amdgcn_update_dpp(ninf, __builtin_bit_cast(int, v), 0x114, 0xf, 0xf, false))); v = fmaxf(v, __builtin_bit_cast(float, __builtin_amdgcn_update_dpp(ninf, __builtin_bit_cast(int, v), 0x118, 0xf, 0xf, false)));
    v = fmaxf(v, __builtin_bit_cast(float, __builtin_amdgcn_update_dpp(ninf, __builtin_bit_cast(int, v), 0x142, 0xa, 0xf, false))); v = fmaxf(v, __builtin_bit_cast(float, __builtin_amdgcn_update_dpp(ninf, __builtin_bit_cast(int, v), 0x143, 0xc, 0xf, false)));
    return v;
}
__device__ __forceinline__ void mlstm_gate_scan(const float* GL  , const float* gate_b  , unsigned char* ws, int gw, int NGW, int lane) {
    float* BQ = (float*)(ws + WS_BQ); float* CQ = (float*)(ws + WS_CQ); float* EM = (float*)(ws + WS_EM); float* AI = (float*)(ws + WS_AI);
    float* AST = (float*)(ws + WS_AST); float* CL = (float*)(ws + WS_CL);
    for (int chain = gw; chain < 64; chain += NGW) {
        const int dir = chain >> 5, b = (chain >> 2) & 7, h = chain & 3;
        const float bi = gate_b[dir * 8 + h], bfg = gate_b[dir * 8 + 4 + h];
        float m_st = 0.f;
        float gi_n, gf_n;
        { const int j0 = dir == 0 ? 0 : 3; const int p0 = j0 * 64 + (dir == 0 ? lane : 63 - lane); const float* gr = GL + (size_t)(b * PB + p0) * 16 + dir * 8; gi_n = gr[h]; gf_n = gr[4 + h]; }
        for (int sc = 0; sc < NCH; ++sc) {
            const int j = dir == 0 ? sc : (sc < 4 ? 3 - sc : 71 - sc);
            const int p = j * 64 + (dir == 0 ? lane : 63 - lane);
            const float li = gi_n + bi, lf = logsigmoidf_(gf_n + bfg);
            if (sc + 1 < NCH) { const int sn = sc + 1; const int jn = dir == 0 ? sn : (sn < 4 ? 3 - sn : 71 - sn); const int pn = jn * 64 + (dir == 0 ? lane : 63 - lane);
                const float* gr = GL + (size_t)(b * PB + pn) * 16 + dir * 8; gi_n = gr[h]; gf_n = gr[4 + h]; }
            const float cum = wave_prefix_sum(lf);
            const float bb = li - cum; const float pm = wave_prefix_max(bb);
            const float c = fmaxf(m_st, pm);
            const size_t ti = (size_t)chain * PB + p;
            BQ[ti] = bb; CQ[ti] = c; EM[ti] = __expf(-(cum + c)); AI[ti] = __expf(m_st - c);
            const float cl = __builtin_bit_cast(float, __builtin_amdgcn_readlane(__builtin_bit_cast(int, c), 63)), tot = __builtin_bit_cast(float, __builtin_amdgcn_readlane(__builtin_bit_cast(int, cum), 63));
            if (lane == 0) { CL[chain * NCH + j] = cl; AST[chain * NCH + j] = __expf(m_st - cl); }
            m_st = tot + cl;
        }
    }
}


__device__ __forceinline__ float logsig_fast(float x) { return fminf(x, 0.f) - __logf(1.f + __expf(-fabsf(x))); }
__device__ __forceinline__ void gla_prep(bf16* P, bf16* QKR, const float* LOW  , const float* gate_up  , const float* gate_b  , unsigned char* ws,
                                         LAS unsigned char* lds, int vcu, int G, int tid, int dry) {
    float* ET = (float*)(ws + WS_ET);
    LAS float* lowt = (LAS float*)lds;
    LAS bf16* qs = (LAS bf16*)(lds + 8192);
    LAS bf16* ks = (LAS bf16*)(lds + 24576);
    LAS float* LA = (LAS float*)(lds + 40960);
    LAS float* HT = (LAS float*)(lds + 106496);
    const int dc = tid & 255, dir = dc >> 7, ch = dc & 127, half = tid >> 8;
    for (int item = vcu; item < NB * NCH * 4; item += G) {
        const int b = item / (NCH * 4), j = (item >> 2) % NCH, h = item & 3;
        const int row0 = b * PB + j * 64, c = h * 128 + ch;
        __syncthreads();
        for (int i = tid; i < 64 * 32; i += 512) lowt[i] = LOW[(size_t)row0 * 32 + i];
#pragma unroll
        for (int i = 0; i < 2; ++i) { const int cidx = tid + 512 * i, rr = cidx >> 4, c8 = cidx & 15; const bf16* src = P + (size_t)(row0 + rr) * N_C + h * 128 + c8 * 8;
            *(LAS v4u*)(qs + rr * 128 + c8 * 8) = *(const v4u*)src; *(LAS v4u*)(ks + rr * 128 + c8 * 8) = *(const v4u*)(src + 512); }
        float gu[16];
#pragma unroll
        for (int k = 0; k < 16; ++k) gu[k] = gate_up[(size_t)(dir * 16 + k) * 512 + c];
        const float gb = gate_b[dir * 512 + c];
        __syncthreads();
        float hsum = 0.f;
#pragma unroll 4
        for (int i = 0; i < 32; ++i) { const int t = half * 32 + i; float x = gb;
#pragma unroll
            for (int k = 0; k < 16; ++k) x += lowt[t * 32 + dir * 16 + k] * gu[k];
            const float la = logsig_fast(x) * (1.f / 16.f); LA[t * 256 + dc] = la; hsum += la; }
        HT[half * 256 + dc] = hsum;
        __syncthreads();
        float cum = (dir == 0) ? (half == 1 ? HT[dc] : 0.f) : (half == 0 ? HT[256 + dc] : 0.f);
#pragma unroll 4
        for (int i = 0; i < 32; ++i) { const int t = half * 32 + (dir == 0 ? i : 31 - i);
            cum += LA[t * 256 + dc];
            const float e = __expf(cum), ei = __expf(-cum);
            const size_t ro = (size_t)(row0 + t) * N_C;
            const float qv = bf2f(qs[t * 128 + ch]), kv = bf2f(ks[t * 128 + ch]);
            if (dir == 0) { if (!dry) { P[ro + c] = (bf16)f2bf(qv * e); P[ro + 512 + c] = (bf16)f2bf(kv * ei); } }
            else { QKR[(size_t)(row0 + t) * 1024 + c] = (bf16)f2bf(qv * e); QKR[(size_t)(row0 + t) * 1024 + 512 + c] = (bf16)f2bf(kv * ei); } }
        if (half == 0) ET[((size_t)((dir * 8 + b) * 4 + h) * NCH + j) * 128 + ch] = __expf(HT[dc] + HT[256 + dc]);
    }
}


__device__ __forceinline__ unsigned f2sort(float f) { const unsigned u = __builtin_bit_cast(unsigned, f); return (u & 0x80000000u) ? ~u : (u | 0x80000000u); }
__device__ __forceinline__ float sort2f(unsigned s) { const unsigned u = (s & 0x80000000u) ? (s & 0x7fffffffu) : ~s; return __builtin_bit_cast(float, u); }
template <int CTRL> __device__ __forceinline__ unsigned dppmov_u(unsigned x) { return (unsigned)__builtin_amdgcn_mov_dpp((int)x, CTRL, 0xf, 0xf, true); }
__device__ __forceinline__ unsigned gmax16(unsigned x) { unsigned y;
    y = dppmov_u<0xB1>(x); x = x > y ? x : y; y = dppmov_u<0x4E>(x); x = x > y ? x : y; y = dppmov_u<0x141>(x); x = x > y ? x : y; y = dppmov_u<0x128>(x); x = x > y ? x : y; return x; }
__device__ __forceinline__ float gsum16(float x) {
    x += __builtin_bit_cast(float, dppmov_u<0xB1>(__builtin_bit_cast(unsigned, x))); x += __builtin_bit_cast(float, dppmov_u<0x4E>(__builtin_bit_cast(unsigned, x)));
    x += __builtin_bit_cast(float, dppmov_u<0x141>(__builtin_bit_cast(unsigned, x))); x += __builtin_bit_cast(float, dppmov_u<0x128>(__builtin_bit_cast(unsigned, x))); return x; }
#define CSWAP(a, b) do { const unsigned hi_ = (a) > (b) ? (a) : (b), lo_ = (a) > (b) ? (b) : (a); (a) = hi_; (b) = lo_; } while (0)
__device__ __forceinline__ void peer_route(const bf16* Q, const bf16* KEYS, int* EID, float* GWT, int gw, int NGW, int lane, bool lat_only) {
    const int g = lane >> 4, c16 = lane & 15, gbase = lane & 48;
    const int nwi = (lat_only ? NB * SEQ / 16 : TT / 16) * 8;
    for (int wi = gw; wi < nwi; wi += NGW) {
        const int t0 = map_row((wi >> 3) * 16, lat_only), head = wi & 7;
        unsigned tops[2][4];
#pragma unroll
        for (int p = 0; p < 2; ++p) {
            const bf16* qrow = Q + (size_t)(t0 + c16) * 2048 + head * 256 + p * 128 + 8 * g;
            bf16x8 qf[4];
#pragma unroll
            for (int ks = 0; ks < 4; ++ks) qf[ks] = *(const bf16x8*)(qrow + 32 * ks);
            const bf16* kb = KEYS + (size_t)(head * 2 + p) * 128 * 128 + (size_t)c16 * 128 + 8 * g;
            unsigned key[8][4];
#pragma unroll
            for (int nt = 0; nt < 8; ++nt) { f32x4 s = (f32x4){0.f, 0.f, 0.f, 0.f};
#pragma unroll
                for (int ks = 0; ks < 4; ++ks) s = mma(qf[ks], *(const bf16x8*)(kb + (size_t)nt * 16 * 128 + 32 * ks), s);
#pragma unroll
                for (int r = 0; r < 4; ++r) key[nt][r] = (f2sort(s[r]) & ~127u) | (unsigned)(127 - (16 * nt + c16)); }
            unsigned kk[4][8];
#pragma unroll
            for (int r = 0; r < 4; ++r) {
#pragma unroll
                for (int nt = 0; nt < 8; ++nt) kk[r][nt] = key[nt][r];
                CSWAP(kk[r][0], kk[r][1]); CSWAP(kk[r][2], kk[r][3]); CSWAP(kk[r][4], kk[r][5]); CSWAP(kk[r][6], kk[r][7]); CSWAP(kk[r][0], kk[r][2]); CSWAP(kk[r][1], kk[r][3]); CSWAP(kk[r][4], kk[r][6]); CSWAP(kk[r][5], kk[r][7]);
                CSWAP(kk[r][1], kk[r][2]); CSWAP(kk[r][5], kk[r][6]); CSWAP(kk[r][0], kk[r][4]); CSWAP(kk[r][1], kk[r][5]); CSWAP(kk[r][2], kk[r][6]); CSWAP(kk[r][3], kk[r][7]); CSWAP(kk[r][2], kk[r][4]); CSWAP(kk[r][3], kk[r][5]);
                CSWAP(kk[r][1], kk[r][2]); CSWAP(kk[r][3], kk[r][4]); CSWAP(kk[r][5], kk[r][6]); }
            unsigned tt[4] = {0u, 0u, 0u, 0u};
#pragma unroll 2
            for (int rd = 0; rd < 16; ++rd) {
#pragma unroll
                for (int r = 0; r < 4; ++r) { const unsigned m = gmax16(kk[r][0]); const bool w = (kk[r][0] == m);
#pragma unroll
                    for (int q = 0; q < 7; ++q) kk[r][q] = w ? kk[r][q + 1] : kk[r][q];
                    kk[r][7] = w ? 0u : kk[r][7];
                    tt[r] = (c16 == rd) ? m : tt[r]; } }
#pragma unroll
            for (int r = 0; r < 4; ++r) tops[p][r] = tt[r];
        }
        float v0[4], s1v[4]; int ptr[4]; unsigned res[4];
#pragma unroll
        for (int r = 0; r < 4; ++r) { v0[r] = sort2f(tops[0][r] & ~127u); s1v[r] = sort2f((unsigned)__shfl((int)tops[1][r], gbase) & ~127u); ptr[r] = 0; res[r] = 0u; }
#pragma unroll 2
        for (int rd = 0; rd < 16; ++rd) {
#pragma unroll
            for (int r = 0; r < 4; ++r) {
                const unsigned ck = ptr[r] < 16 ? ((f2sort(v0[r] + s1v[r]) & ~255u) | (unsigned)((15 - c16) << 4) | (unsigned)(15 - ptr[r])) : 0u;
                const unsigned m = gmax16(ck);
                res[r] = (c16 == rd) ? m : res[r];
                if (ck == m) ++ptr[r];
                s1v[r] = sort2f((unsigned)__shfl((int)tops[1][r], gbase + (ptr[r] < 15 ? ptr[r] : 15)) & ~127u); } }
#pragma unroll
        for (int r = 0; r < 4; ++r) {
            const float val = sort2f(res[r] & ~255u); const int ii = 15 - (int)((res[r] >> 4) & 15u), jj = 15 - (int)(res[r] & 15u);
            const float mx = __shfl(val, gbase);
            const float ex = __expf(val - mx), sum = gsum16(ex);
            const unsigned i0 = 127u - ((unsigned)__shfl((int)tops[0][r], gbase + ii) & 127u), i1 = 127u - ((unsigned)__shfl((int)tops[1][r], gbase + jj) & 127u);
            const size_t o = (size_t)(t0 + 4 * g + r) * 128 + head * 16 + c16;
            EID[o] = (int)(i0 * 128u + i1); GWT[o] = ex / sum;
        }
    }
}

__device__ __forceinline__ void unpack8(const v4u w, float* o) { o[0] = bflo(w.x); o[1] = bfhi(w.x); o[2] = bflo(w.y); o[3] = bfhi(w.y); o[4] = bflo(w.z); o[5] = bfhi(w.z); o[6] = bflo(w.w); o[7] = bfhi(w.w); }
__device__ __forceinline__ int rev3(int x) { return ((x & 1) << 2) | (x & 2) | ((x >> 2) & 1); }
typedef int v8i __attribute__((ext_vector_type(8)));
constexpr int P1_SLOT = 528, P1_WAVE_LDS = 12288, P1_HQ = 16 * P1_SLOT, P1_DOTS = P1_HQ + 3072;
__device__ __forceinline__ int p1_sigma(int j) { return j < 8 ? (j ^ 4) : j; }
__device__ __forceinline__ void peer_pass1(const bf16* HB, const int* EID, const float* GWT, const unsigned char* U4, const float* SUi, const float* SVi, float* COEF,
                                           LAS unsigned char* lds, int wave, int gw, int NGW, int lane, bool lat_only) {
    LAS unsigned char* wl = lds + wave * P1_WAVE_LDS;
    LAS float* dots = (LAS float*)(wl + P1_DOTS);
    const int n = lane & 15, g = lane >> 4;
    const int nrows = lat_only ? NB * SEQ : TT;
    const unsigned aoff = (unsigned)(p1_sigma(n) * P1_SLOT + 128 * g);
    const unsigned boff = (unsigned)(P1_HQ + (n < 6 ? 512 * n : 0) + 128 * g);
    const float wn = n == 0 ? 1.f : (n == 1 ? 0.25f : (n == 2 ? 0.0625f : (n == 3 ? 0.015625f : (n == 4 ? 0.00390625f : (n == 5 ? 0.0009765625f : 0.f)))));
    int ri = gw;
    if (ri >= nrows) return;
    int r = map_row(ri, lat_only);
    v4u hn0 = *(const v4u*)(HB + (size_t)r * D + 16 * lane), hn1 = *(const v4u*)(HB + (size_t)r * D + 16 * lane + 8);
    int eidAn = EID[(size_t)r * 128 + lane], eidBn = EID[(size_t)r * 128 + 64 + lane];
#define P1_DMA(src_e, base_) do { int ids_[16]; _Pragma("unroll") for (int j_ = 0; j_ < 16; ++j_) ids_[j_] = __builtin_amdgcn_readlane((src_e), (base_) + j_); \
        if (lane < 32) { _Pragma("unroll") for (int j_ = 0; j_ < 16; ++j_) \
        __builtin_amdgcn_global_load_lds((const unsigned*)(U4 + (size_t)ids_[j_] * 512 + 16 * lane), (LAS unsigned*)(wl + p1_sigma(j_) * P1_SLOT), 16, 0, 0); } } while (0)
    P1_DMA(eidAn, 0);
    for (; ri < nrows; ri += NGW) {
        r = map_row(ri, lat_only);
        const int eidA = eidAn, eidB = eidBn;
        { float h[16]; unpack8(hn0, h); unpack8(hn1, h + 8);
#pragma unroll
          for (int part = 0; part < 6; ++part) {
              unsigned w[2];
#pragma unroll
              for (int d = 0; d < 2; ++d) { unsigned t = 0u;
                  t = __builtin_amdgcn_cvt_scalef32_pk_fp4_f32(t, h[8 * d], h[8 * d + 1], 1.0f, 0); t = __builtin_amdgcn_cvt_scalef32_pk_fp4_f32(t, h[8 * d + 2], h[8 * d + 3], 1.0f, 1);
                  t = __builtin_amdgcn_cvt_scalef32_pk_fp4_f32(t, h[8 * d + 4], h[8 * d + 5], 1.0f, 2); t = __builtin_amdgcn_cvt_scalef32_pk_fp4_f32(t, h[8 * d + 6], h[8 * d + 7], 1.0f, 3);
                  w[d] = t; }
              *(LAS v2u*)(wl + P1_HQ + 512 * part + 8 * lane) = (v2u){w[0], w[1]};
              if (part < 5) {
#pragma unroll
                  for (int d = 0; d < 2; ++d) {
                      const f32x2 q0 = __builtin_amdgcn_cvt_scalef32_pk_f32_fp4(w[d], 1.0f, 0), q1 = __builtin_amdgcn_cvt_scalef32_pk_f32_fp4(w[d], 1.0f, 1);
                      const f32x2 q2 = __builtin_amdgcn_cvt_scalef32_pk_f32_fp4(w[d], 1.0f, 2), q3 = __builtin_amdgcn_cvt_scalef32_pk_f32_fp4(w[d], 1.0f, 3);
                      h[8 * d] = (h[8 * d] - q0[0]) * 4.f; h[8 * d + 1] = (h[8 * d + 1] - q0[1]) * 4.f; h[8 * d + 2] = (h[8 * d + 2] - q1[0]) * 4.f; h[8 * d + 3] = (h[8 * d + 3] - q1[1]) * 4.f;
                      h[8 * d + 4] = (h[8 * d + 4] - q2[0]) * 4.f; h[8 * d + 5] = (h[8 * d + 5] - q2[1]) * 4.f; h[8 * d + 6] = (h[8 * d + 6] - q3[0]) * 4.f; h[8 * d + 7] = (h[8 * d + 7] - q3[1]) * 4.f; } } } }
        const float gwtA = GWT[(size_t)r * 128 + lane], gwtB = GWT[(size_t)r * 128 + 64 + lane];
        const int rin = ri + NGW; const bool more = rin < nrows; const int rn = map_row(more ? rin : ri, lat_only);
        hn0 = *(const v4u*)(HB + (size_t)rn * D + 16 * lane); hn1 = *(const v4u*)(HB + (size_t)rn * D + 16 * lane + 8);
        eidAn = EID[(size_t)rn * 128 + lane]; eidBn = EID[(size_t)rn * 128 + 64 + lane];
        LDS_FENCE();
        v4u bw[8];
#pragma unroll
        for (int c = 0; c < 8; ++c) bw[c] = *(LAS const v4u*)(wl + boff + 16 * c);
#pragma unroll 1
        for (int G = 0; G < 8; ++G) {
            asm volatile("s_waitcnt vmcnt(0)" ::: "memory");
            v4u aw[8];
#pragma unroll
            for (int c = 0; c < 8; ++c) aw[c] = *(LAS const v4u*)(wl + aoff + 16 * c);
            asm volatile("s_waitcnt lgkmcnt(0)" ::: "memory");
            { const int srcsel = G < 3 ? eidA : (G < 7 ? eidB : eidAn); const int base = 16 * ((G + 1) & 3);
              if (G < 7 || more) P1_DMA(srcsel, base); }
            f32x4 acc = (f32x4){0.f, 0.f, 0.f, 0.f};
#pragma unroll
            for (int c = 0; c < 8; ++c) {
                const v8i A = (v8i){(int)aw[c].x, (int)aw[c].y, (int)aw[c].z, (int)aw[c].w, 0, 0, 0, 0};
                const v8i Bv = (v8i){(int)bw[c].x, (int)bw[c].y, (int)bw[c].z, (int)bw[c].w, 0, 0, 0, 0};
                acc = __builtin_amdgcn_mfma_scale_f32_16x16x128_f8f6f4(A, Bv, acc, 4, 4, 0, 0, 0, 0); }
            f32x4 dv;
#pragma unroll
            for (int k = 0; k < 4; ++k) dv[k] = gsum16(acc[k] * wn);
            if (n == 0) *(LAS f32x4*)(dots + 16 * G + 4 * g) = dv;
        }
        LDS_FENCE();
        { const float dot = dots[lane] * SUi[eidA]; COEF[(size_t)r * 128 + lane] = gwtA * 0.5f * dot * (1.f + erff(dot * 0.70710678118f)) * SVi[eidA]; }
        { const float dot = dots[64 + lane] * SUi[eidB]; COEF[(size_t)r * 128 + 64 + lane] = gwtB * 0.5f * dot * (1.f + erff(dot * 0.70710678118f)) * SVi[eidB]; }
    }
#undef P1_DMA
}
template <bool USE_PEER>
__device__ __forceinline__ void peer_expert(const float* COEF, const int* EID, const unsigned char* V6,
                                            float* lat, float* ctx, const float* mod, const float* lnw, const float* lnb, int gw, int NGW, int lane, int dry, bool lat_only) {
    const int myslot = 8 * (lane & 7) + rev3(lane >> 3);
    const int nrows = lat_only ? NB * SEQ : TT;
    for (int ri = gw; ri < nrows; ri += NGW) {
        const int r = map_row(ri, lat_only);
        const int b = r / PB, p = r - b * PB; float* xr = srow(lat, ctx, r); const float* mr = mod + (size_t)(p < LC ? 8 : b) * 6144;
        float f[16];
#pragma unroll
        for (int i = 0; i < 16; ++i) f[i] = 0.f;
        if (USE_PEER) {
#pragma unroll 1
        for (int half = 0; half < 2; ++half) {
            const int eid = EID[(size_t)r * 128 + half * 64 + myslot];
            const float coef = COEF[(size_t)r * 128 + half * 64 + myslot];
            v3u ring[8];
#pragma unroll
            for (int k = 0; k < 8; ++k) { const int id = __builtin_amdgcn_readlane(eid, k); ring[k] = *(const v3u*)(V6 + (size_t)id * 768 + 12 * lane); }
#pragma unroll 1
            for (int e0 = 0; e0 < 64; e0 += 8) {
#pragma unroll
                for (int k = 0; k < 8; k += 2) {
                    const float c0 = __builtin_bit_cast(float, __builtin_amdgcn_readlane(__builtin_bit_cast(int, coef), e0 + k)), c1 = __builtin_bit_cast(float, __builtin_amdgcn_readlane(__builtin_bit_cast(int, coef), e0 + k + 1));
                    const v6u pk6 = (v6u){ring[k].x, ring[k].y, ring[k].z, ring[k + 1].x, ring[k + 1].y, ring[k + 1].z}; const v32f w = __builtin_amdgcn_cvt_scalef32_pk32_f32_fp6(pk6, 1.0f);
                    const int en0 = (e0 + 8 + k) < 64 ? (e0 + 8 + k) : 63, en1 = (e0 + 9 + k) < 64 ? (e0 + 9 + k) : 63;
                    const int idn0 = __builtin_amdgcn_readlane(eid, en0), idn1 = __builtin_amdgcn_readlane(eid, en1);
                    ring[k] = *(const v3u*)(V6 + (size_t)idn0 * 768 + 12 * lane); ring[k + 1] = *(const v3u*)(V6 + (size_t)idn1 * 768 + 12 * lane);
#pragma unroll
                    for (int i = 0; i < 16; ++i) f[i] += c0 * w[i];
#pragma unroll
                    for (int i = 0; i < 16; ++i) f[i] += c1 * w[16 + i];
                    __builtin_amdgcn_sched_barrier(0); }
            }
        }
        }
        float v[16]; float s = 0.f;
#pragma unroll
        for (int q = 0; q < 4; ++q) { const int c = 16 * lane + 4 * q; const f32x4 x1 = *(const f32x4*)(xr + c), g2 = *(const f32x4*)(mr + 5120 + c);
#pragma unroll
            for (int i = 0; i < 4; ++i) { v[4 * q + i] = DN_ALPHA * x1[i] + g2[i] * f[4 * q + i]; s += v[4 * q + i]; } }
        const float mean = wave_sum(s) * (1.f / D); float s2 = 0.f;
#pragma unroll
        for (int i = 0; i < 16; ++i) { v[i] -= mean; s2 += v[i] * v[i]; }
        const float rstd = 1.f / sqrtf(wave_sum(s2) * (1.f / D) + LN_EPS);
#pragma unroll
        for (int q = 0; q < 4; ++q) { const int c = 16 * lane + 4 * q; const f32x4 w = *(const f32x4*)(lnw + c), bb2 = *(const f32x4*)(lnb + c); f32x4 o;
#pragma unroll
            for (int i = 0; i < 4; ++i) o[i] = v[4 * q + i] * rstd * w[i] + bb2[i];
            if (!dry) *(f32x4*)(xr + c) = o; }
    }
}

__device__ __forceinline__ bf16* od_row_base(unsigned char* ws, int dir, int b) {
    if (dir == 0) return (bf16*)(ws + WS_ST) + (size_t)b * SEQ * 1024;
    return b < 7 ? (bf16*)(ws + WS_ST + 64 * MiB) + (size_t)b * SEQ * 1024 : (bf16*)(ws + WS_XC);
}
__device__ __forceinline__ void gla_fused_scan(const bf16* P, const bf16* QKR, unsigned char* ws, LAS unsigned char* lds, int vcu, int G, int wave, int lane, int tid, int dry) {
    const float* ET = (const float*)(ws + WS_ET);
    LAS bf16* Qt = (LAS bf16*)lds;
    LAS bf16* Kt = (LAS bf16*)(lds + 34816);
    LAS bf16* Vt = (LAS bf16*)(lds + 69632);
    LAS bf16* SL = (LAS bf16*)(lds + 88064);
    LAS bf16* Pw = (LAS bf16*)(lds + 122880 + wave * 2304);
    const int g = lane >> 4, c16 = lane & 15, mt = wave & 3, cw = wave >> 2;
    for (int item = vcu; item < 256; item += G) {
        const int dir = item >> 7, b = (item >> 4) & 7, h = (item >> 2) & 3, eb = item & 3;
        const bf16* qsrc = dir == 0 ? P + h * 128 : QKR + h * 128; const int qld = dir == 0 ? N_C : 1024;
        const bf16* vsrc = P + 1024 + h * 256 + 64 * eb;
        const float* etp = ET + ((size_t)((dir * 8 + b) * 4 + h) * NCH) * 128 + 16 * wave + c16;
        bf16* odb = od_row_base(ws, dir, b) + h * 256 + 64 * eb;
        f32x4 acc[4];
#pragma unroll
        for (int et = 0; et < 4; ++et) acc[et] = (f32x4){0.f, 0.f, 0.f, 0.f};
        v4u qreg[2][2], kreg[2][2], vreg[2]; float etn[2];
#define GLA_JOF(sc_) (dir == 0 ? (sc_) : ((sc_) < 4 ? 3 - (sc_) : 71 - (sc_)))
#define GLA_PREFETCH(sc0_) do { _Pragma("unroll") for (int u = 0; u < 2; ++u) { const int jj = GLA_JOF((sc0_) + u); const int row0 = b * PB + jj * 64; \
            _Pragma("unroll") for (int i = 0; i < 2; ++i) { const int cidx = tid + 512 * i, rr = cidx >> 4, ch = cidx & 15; const bf16* sp = qsrc + (size_t)(row0 + rr) * qld + ch * 8; qreg[u][i] = *(const v4u*)sp; kreg[u][i] = *(const v4u*)(sp + 512); } \
            vreg[u] = *(const v4u*)(vsrc + (size_t)(row0 + (tid >> 3)) * N_C + (tid & 7) * 8); etn[u] = etp[(size_t)jj * 128]; } } while (0)
        GLA_PREFETCH(0);
        unsigned opk[8]; int ojc = -1;
#pragma unroll
        for (int i = 0; i < 8; ++i) opk[i] = 0u;
        for (int sc = 0; sc < NCH; sc += 2) {
            const int ja = GLA_JOF(sc), jb = GLA_JOF(sc + 1);
            __syncthreads();
            if (ojc >= 4 && !dry) {
#pragma unroll
                for (int nt = 0; nt < 4; ++nt) { bf16* orow = odb + (size_t)((ojc - 4) * 64 + 16 * mt + 4 * g) * 1024 + 16 * nt + c16;
#pragma unroll
                    for (int r = 0; r < 4; ++r) orow[(size_t)r * 1024] = (bf16)((opk[2 * nt + (r >> 1)] >> (16 * (r & 1))) & 0xffffu); } }
#pragma unroll
            for (int u = 0; u < 2; ++u) {
#pragma unroll
                for (int i = 0; i < 2; ++i) { const int cidx = tid + 512 * i, rr = cidx >> 4, ch = cidx & 15; *(LAS v4u*)(Qt + u * 8704 + rr * 136 + ch * 8) = qreg[u][i]; *(LAS v4u*)(Kt + u * 8704 + rr * 136 + ch * 8) = kreg[u][i]; }
                *(LAS v4u*)(Vt + u * 4608 + (tid >> 3) * 72 + (tid & 7) * 8) = vreg[u]; }
#pragma unroll
            for (int et = 0; et < 4; ++et)
#pragma unroll
                for (int r = 0; r < 4; ++r) SL[(16 * et + 4 * g + r) * 136 + 16 * wave + c16] = (bf16)f2bf(acc[et][r]);
            const float et_a = etn[0], et_b = etn[1];
            if (sc + 2 < NCH) GLA_PREFETCH(sc + 2);
            __syncthreads();
#pragma unroll
            for (int ks = 0; ks < 2; ++ks) { const bf16x8 kb = frag_tr(Kt, 136, 32 * ks, 16 * wave, lane);
#pragma unroll
                for (int et = 0; et < 4; ++et) acc[et] = mma(frag_tr(Vt, 72, 32 * ks, 16 * et, lane), kb, acc[et]); }
#pragma unroll
            for (int et = 0; et < 4; ++et) { acc[et] = acc[et] * et_a;
#pragma unroll
                for (int r = 0; r < 4; ++r) SL[8704 + (16 * et + 4 * g + r) * 136 + 16 * wave + c16] = (bf16)f2bf(acc[et][r]); }
            __syncthreads();
            const int jc = cw == 0 ? ja : jb;
            ojc = jc;
            if (jc >= 4) {
                const LAS bf16* Qc = Qt + cw * 8704; const LAS bf16* Kc = Kt + cw * 8704; const LAS bf16* Vc = Vt + cw * 4608; const LAS bf16* Sc = SL + cw * 8704;
                bf16x8 qf[4];
#pragma unroll
                for (int ks = 0; ks < 4; ++ks) qf[ks] = frag_row(Qc, 136, 16 * mt, 32 * ks, lane);
                bf16x8 pa[2];
                { f32x4 st[4];
#pragma unroll
                  for (int ns = 0; ns < 4; ++ns) { st[ns] = (f32x4){0.f, 0.f, 0.f, 0.f};
#pragma unroll
                      for (int ks = 0; ks < 4; ++ks) st[ns] = mma(frag_row(Kc, 136, 16 * ns, 32 * ks, lane), qf[ks], st[ns]);
#pragma unroll
                      for (int r = 0; r < 4; ++r) { const int sidx = 16 * ns + 4 * g + r, t = 16 * mt + c16; const bool ok = dir == 0 ? (sidx <= t) : (sidx >= t); st[ns][r] = ok ? st[ns][r] : 0.f; } }
#pragma unroll
                  for (int ks2 = 0; ks2 < 2; ++ks2) { const v4u wv = (v4u){pk2(st[2 * ks2][0], st[2 * ks2][1]), pk2(st[2 * ks2][2], st[2 * ks2][3]), pk2(st[2 * ks2 + 1][0], st[2 * ks2 + 1][1]), pk2(st[2 * ks2 + 1][2], st[2 * ks2 + 1][3])};
                      pa[ks2] = __builtin_bit_cast(bf16x8, wv); } }
#pragma unroll
                for (int nt = 0; nt < 4; ++nt) { f32x4 a = (f32x4){0.f, 0.f, 0.f, 0.f};
#pragma unroll
                    for (int ks = 0; ks < 4; ++ks) a = mma(qf[ks], frag_row(Sc, 136, 16 * nt, 32 * ks, lane), a);
                    a = mma(pa[0], frag_tr_perm(Vc, 72, 0, 16 * nt, lane), a); a = mma(pa[1], frag_tr_perm(Vc, 72, 32, 16 * nt, lane), a);
                    opk[2 * nt] = pk2(a[0], a[1]); opk[2 * nt + 1] = pk2(a[2], a[3]); }
                LDS_FENCE();
            }
#pragma unroll
            for (int ks = 0; ks < 2; ++ks) { const bf16x8 kb = frag_tr(Kt + 8704, 136, 32 * ks, 16 * wave, lane);
#pragma unroll
                for (int et = 0; et < 4; ++et) acc[et] = mma(frag_tr(Vt + 4608, 72, 32 * ks, 16 * et, lane), kb, acc[et]); }
#pragma unroll
            for (int et = 0; et < 4; ++et) acc[et] = acc[et] * et_b;
        }
        if (ojc >= 4 && !dry) {
#pragma unroll
            for (int nt = 0; nt < 4; ++nt) { bf16* orow = odb + (size_t)((ojc - 4) * 64 + 16 * mt + 4 * g) * 1024 + 16 * nt + c16;
#pragma unroll
                for (int r = 0; r < 4; ++r) orow[(size_t)r * 1024] = (bf16)((opk[2 * nt + (r >> 1)] >> (16 * (r & 1))) & 0xffffu); } }
#undef GLA_PREFETCH
#undef GLA_JOF
    }
}
__device__ __forceinline__ void gla_merge(bf16* P, const float* norm_w, unsigned char* ws, int gw, int NGW, int lane, int dry) {
    for (int i = gw; i < NB * SEQ; i += NGW) {
        const int b = i >> 12, lp = i & 4095; const size_t r = (size_t)b * PB + LC + lp;
        const bf16* of = od_row_base(ws, 0, b) + (size_t)lp * 1024 + 16 * lane; const bf16* orv = od_row_base(ws, 1, b) + (size_t)lp * 1024 + 16 * lane;
        bf16* grow = P + r * N_C + 2048 + 16 * lane;
        float x[16], y[16], gg[16];
        unpack8(*(const v4u*)of, x); unpack8(*(const v4u*)(of + 8), x + 8); unpack8(*(const v4u*)orv, y); unpack8(*(const v4u*)(orv + 8), y + 8);
        unpack8(*(const v4u*)grow, gg); unpack8(*(const v4u*)(grow + 8), gg + 8);
        float ss = 0.f;
#pragma unroll
        for (int k = 0; k < 16; ++k) { x[k] += y[k]; ss += x[k] * x[k]; }
        ss = gsum16(ss);
        const float rn = 1.f / sqrtf(ss * (1.f / 256.f) + LN_EPS);
        unsigned ow[8];
#pragma unroll
        for (int k = 0; k < 8; ++k) { const float4 dummy = make_float4(0.f, 0.f, 0.f, 0.f); (void)dummy;
            const float a = x[2 * k] * rn * norm_w[16 * lane + 2 * k] * siluf_(gg[2 * k]), c = x[2 * k + 1] * rn * norm_w[16 * lane + 2 * k + 1] * siluf_(gg[2 * k + 1]); ow[k] = pk2(a, c); }
        if (!dry) { v4u o0, o1; o0.x = ow[0]; o0.y = ow[1]; o0.z = ow[2]; o0.w = ow[3]; o1.x = ow[4]; o1.y = ow[5]; o1.z = ow[6]; o1.w = ow[7]; *(v4u*)grow = o0; *(v4u*)(grow + 8) = o1; }
    }
}

__device__ __forceinline__ void mlstm_fused_scan(const bf16* P, unsigned char* ws, LAS unsigned char* lds, int vcu, int G, int wave, int lane, int tid) {
    const float* BQ = (const float*)(ws + WS_BQ); const float* CQ = (const float*)(ws + WS_CQ); const float* EM = (const float*)(ws + WS_EM); const float* AI = (const float*)(ws + WS_AI);
    const float* AST = (const float*)(ws + WS_AST); const float* CL = (const float*)(ws + WS_CL);
    LAS bf16* Qt = (LAS bf16*)lds;
    LAS bf16* Kt = (LAS bf16*)(lds + 17408);
    LAS bf16* Vt = (LAS bf16*)(lds + 34816);
    LAS bf16* Vw = (LAS bf16*)(lds + 41984);
    LAS bf16* CT = (LAS bf16*)(lds + 49152);
    LAS bf16* Pw = (LAS bf16*)(lds + 62208 + wave * 2304);
    const int g = lane >> 4, c16 = lane & 15, mt = wave & 3, hf = wave >> 2;
    const int vrow = tid < 256 ? (tid >> 2) : ((tid - 256) & 63), vch = tid & 3;
    for (int item = vcu; item < 256; item += G) {
        const int dir = item >> 7, b = (item >> 4) & 7, h = (item >> 2) & 3, eb = item & 3;
        const int chain = dir * 32 + b * 4 + h;
        const bf16* qsrc = P + h * 128; const bf16* vsrc = P + 1024 + h * 128 + 32 * eb;
        bf16* odb = (bf16*)(ws + WS_ST) + (size_t)dir * TT * 512 + h * 128 + 32 * eb;
        f32x4 acc[3];
#pragma unroll
        for (int et = 0; et < 3; ++et) acc[et] = (f32x4){0.f, 0.f, 0.f, 0.f};
        v4u qreg[2], kreg[2], vreg; float bqr, cln, astn, cqn; f32x4 bqn[4], ain, emn;
        { const int j0 = dir == 0 ? 0 : 3; const int row0 = b * PB + j0 * 64; const size_t tb = (size_t)chain * PB + j0 * 64;
#pragma unroll
          for (int i = 0; i < 2; ++i) { const int cidx = tid + 512 * i, rr = cidx >> 4, ch = cidx & 15; const bf16* s = qsrc + (size_t)(row0 + rr) * N_AB + ch * 8; qreg[i] = *(const v4u*)s; kreg[i] = *(const v4u*)(s + 512); }
          vreg = *(const v4u*)(vsrc + (size_t)(row0 + vrow) * N_AB + vch * 8); bqr = BQ[tb + vrow]; cln = CL[chain * NCH + j0]; astn = AST[chain * NCH + j0];
#pragma unroll
          for (int k = 0; k < 4; ++k) bqn[k] = *(const f32x4*)(BQ + tb + 16 * k + 4 * g);
          cqn = CQ[tb + 16 * mt + c16]; ain = *(const f32x4*)(AI + tb + 16 * mt + 4 * g); emn = *(const f32x4*)(EM + tb + 16 * mt + 4 * g); }
        for (int sc = 0; sc < NCH; ++sc) {
            const int j = dir == 0 ? sc : (sc < 4 ? 3 - sc : 71 - sc);
            __syncthreads();
#pragma unroll
            for (int i = 0; i < 2; ++i) { const int cidx = tid + 512 * i, rr = cidx >> 4, ch = cidx & 15; *(LAS v4u*)(Qt + rr * 136 + ch * 8) = qreg[i]; *(LAS v4u*)(Kt + rr * 136 + ch * 8) = kreg[i]; }
            { const float wsv = __expf(bqr - cln);
              if (tid < 256) { const v4u raw = vreg; v4u o;
                  o.x = pk2(bflo(raw.x) * wsv, bfhi(raw.x) * wsv); o.y = pk2(bflo(raw.y) * wsv, bfhi(raw.y) * wsv); o.z = pk2(bflo(raw.z) * wsv, bfhi(raw.z) * wsv); o.w = pk2(bflo(raw.w) * wsv, bfhi(raw.w) * wsv);
                  *(LAS v4u*)(Vt + vrow * 56 + vch * 8) = raw; *(LAS v4u*)(Vw + vrow * 56 + vch * 8) = o;
              } else if (tid < 320) { v4u o; o.x = 0x3f80u; o.y = 0u; o.z = 0u; o.w = 0u; *(LAS v4u*)(Vt + vrow * 56 + 32) = o; o.x = f2bf(wsv); *(LAS v4u*)(Vw + vrow * 56 + 32) = o;
                  o.x = 0u; *(LAS v4u*)(Vt + vrow * 56 + 40) = o; *(LAS v4u*)(Vw + vrow * 56 + 40) = o; } }
#pragma unroll
            for (int et = 0; et < 3; ++et)
#pragma unroll
                for (int r = 0; r < 4; ++r) CT[(16 * et + 4 * g + r) * 136 + 16 * wave + c16] = (bf16)f2bf(acc[et][r]);
            const float ast = astn, cqt = cqn; f32x4 bq[4]; const f32x4 ai = ain, em = emn;
#pragma unroll
            for (int k = 0; k < 4; ++k) bq[k] = bqn[k];
            if (sc + 1 < NCH) { const int sn = sc + 1; const int jn = dir == 0 ? sn : (sn < 4 ? 3 - sn : 71 - sn); const int row0 = b * PB + jn * 64; const size_t tb = (size_t)chain * PB + jn * 64;
#pragma unroll
                for (int i = 0; i < 2; ++i) { const int cidx = tid + 512 * i, rr = cidx >> 4, ch = cidx & 15; const bf16* s = qsrc + (size_t)(row0 + rr) * N_AB + ch * 8; qreg[i] = *(const v4u*)s; kreg[i] = *(const v4u*)(s + 512); }
                vreg = *(const v4u*)(vsrc + (size_t)(row0 + vrow) * N_AB + vch * 8); bqr = BQ[tb + vrow]; cln = CL[chain * NCH + jn]; astn = AST[chain * NCH + jn];
#pragma unroll
                for (int k = 0; k < 4; ++k) bqn[k] = *(const f32x4*)(BQ + tb + 16 * k + 4 * g);
                cqn = CQ[tb + 16 * mt + c16]; ain = *(const f32x4*)(AI + tb + 16 * mt + 4 * g); emn = *(const f32x4*)(EM + tb + 16 * mt + 4 * g); }
            __syncthreads();
            bf16x8 qf[4];
#pragma unroll
            for (int ks = 0; ks < 4; ++ks) qf[ks] = frag_row(Qt, 136, 16 * mt, 32 * ks, lane);
            bf16x8 pa[2];
            { f32x4 st[4];
#pragma unroll
              for (int ns = 0; ns < 4; ++ns) { st[ns] = (f32x4){0.f, 0.f, 0.f, 0.f};
#pragma unroll
                  for (int ks = 0; ks < 4; ++ks) st[ns] = mma(frag_row(Kt, 136, 16 * ns, 32 * ks, lane), qf[ks], st[ns]);
#pragma unroll
                  for (int r = 0; r < 4; ++r) { const int sidx = 16 * ns + 4 * g + r, t = 16 * mt + c16; const bool ok = dir == 0 ? (sidx <= t) : (sidx >= t);
                      st[ns][r] = ok ? st[ns][r] * __expf(bq[ns][r] - cqt) : 0.f; } }
#pragma unroll
              for (int ks2 = 0; ks2 < 2; ++ks2) { const v4u wv = (v4u){pk2(st[2 * ks2][0], st[2 * ks2][1]), pk2(st[2 * ks2][2], st[2 * ks2][3]), pk2(st[2 * ks2 + 1][0], st[2 * ks2 + 1][1]), pk2(st[2 * ks2 + 1][2], st[2 * ks2 + 1][3])};
                  pa[ks2] = __builtin_bit_cast(bf16x8, wv); } }
            f32x4 av, ad;
            { f32x4 a = (f32x4){0.f, 0.f, 0.f, 0.f}, d = (f32x4){0.f, 0.f, 0.f, 0.f};
#pragma unroll
              for (int ks = 0; ks < 4; ++ks) { a = mma(qf[ks], frag_row(CT, 136, 16 * hf, 32 * ks, lane), a); d = mma(qf[ks], frag_row(CT, 136, 32, 32 * ks, lane), d); }
#pragma unroll
              for (int r = 0; r < 4; ++r) { a[r] *= ai[r]; d[r] *= ai[r]; }
#pragma unroll
              for (int ks = 0; ks < 2; ++ks) { a = mma(pa[ks], frag_tr_perm(Vt, 56, 32 * ks, 16 * hf, lane), a); d = mma(pa[ks], frag_tr_perm(Vt, 56, 32 * ks, 32, lane), d); }
              av = a; ad = d; }
            { bf16* orow = odb + (size_t)(b * PB + j * 64 + 16 * mt + 4 * g) * 512 + 16 * hf + c16;
#pragma unroll
              for (int r = 0; r < 4; ++r) { const float den = __shfl(ad[r], lane & 48); orow[(size_t)r * 512] = (bf16)f2bf(av[r] / fmaxf(fabsf(den), em[r])); } }
#pragma unroll
            for (int et = 0; et < 3; ++et) acc[et] = acc[et] * ast;
#pragma unroll
            for (int ks = 0; ks < 2; ++ks) { const bf16x8 kb = frag_tr(Kt, 136, 32 * ks, 16 * wave, lane);
#pragma unroll
                for (int et = 0; et < 3; ++et) acc[et] = mma(frag_tr(Vw, 56, 32 * ks, 16 * et, lane), kb, acc[et]); }
        }
    }
}
__device__ __forceinline__ void mlstm_merge(const bf16* P, bf16* CAT, const float* norm_w, unsigned char* ws, int gw, int NGW, int lane) {
    const bf16* OD = (const bf16*)(ws + WS_ST);
    for (int r = gw; r < TT; r += NGW) {
        float x[8], y[8], og[8];
        unpack8(*(const v4u*)(OD + (size_t)r * 512 + 8 * lane), x); unpack8(*(const v4u*)(OD + (size_t)TT * 512 + (size_t)r * 512 + 8 * lane), y);
        unpack8(*(const v4u*)(P + (size_t)r * N_AB + 1536 + 8 * lane), og);
        float ss = 0.f;
#pragma unroll
        for (int k = 0; k < 8; ++k) { x[k] += y[k]; ss += x[k] * x[k]; }
        ss = gsum16(ss);
        const float rn = 1.f / sqrtf(ss * (1.f / 128.f) + LN_EPS);
        unsigned ow[4];
#pragma unroll
        for (int k = 0; k < 4; ++k) ow[k] = pk2(x[2 * k] * rn * norm_w[8 * lane + 2 * k] * sigmoidf_(og[2 * k]), x[2 * k + 1] * rn * norm_w[8 * lane + 2 * k + 1] * sigmoidf_(og[2 * k + 1]));
        v4u o; o.x = ow[0]; o.y = ow[1]; o.z = ow[2]; o.w = ow[3]; *(v4u*)(CAT + (size_t)r * D + 8 * lane) = o;
    }
}

#ifndef PHMASK
#define PHMASK 0xffffffffu
#endif
#define PH(k) ((PHMASK >> (k)) & 1u)
#ifndef REPMASK
#define REPMASK 0u
#endif
#define REPS(k) (1 + (int)((REPMASK >> (k)) & 1u))
#if REPMASK
#define DRYV(k) ({ int d_ = (rep_ + 1 < REPS(k)) ? 1 : 0; asm volatile("" : "+s"(d_)); d_; })
#else
#define DRYV(k) 0
#endif
#ifndef DBG_LEVEL
#define DBG_LEVEL 3
#endif
typedef const __attribute__((address_space(4))) Args* KArgsP;
__device__ __forceinline__ KArgsP kargs() { KArgsP p = (KArgsP)__builtin_amdgcn_kernarg_segment_ptr(); asm volatile("" : "+s"(p)); return p; }
#define WSP(off) (ws + (off))
__global__ void __launch_bounds__(512, 2) fwd_megakernel(Args A_unused) {
    extern __shared__ __attribute__((aligned(16))) unsigned char lds_raw[];
    LAS unsigned char* lds = (LAS unsigned char*)lds_raw;
    const int tid0 = threadIdx.x;
    const int G = gridDim.x; const int bx = blockIdx.x; const int vcu = (G % 8 == 0) ? (bx % 8) * (G / 8) + bx / 8 : bx;
    const int NGW = G * 8;
    volatile LAS unsigned* MISC = (volatile LAS unsigned*)(lds + MISC_OFF);
    if (tid0 < 16) MISC[tid0] = 0u;
    __syncthreads();
    XcdBarrier bar;
    { KArgsP ap = kargs(); bar = xcd_barrier_post((unsigned*)(ap->ws + WS_CTL) + 1024, MISC + 8); }
#define GRID_BAR() xcd_barrier(bar)
#define PROLOG KArgsP ap = kargs(); unsigned char* ws = ap->ws; (void)ws; int tid = tid0; asm volatile("" : "+v"(tid)); const int lane = tid & 63, wave = __builtin_amdgcn_readfirstlane(tid >> 6), gw = vcu * 8 + wave; (void)lane; (void)wave; (void)gw;

    if (PH(0)) for (int rep_ = 0; rep_ < REPS(0); ++rep_) { int tid = tid0; asm volatile("" : "+v"(tid)); const int lane = tid & 63, wave = __builtin_amdgcn_readfirstlane(tid >> 6); Args A; { KArgsP ap = kargs();
#pragma unroll
        for (int i = 0; i < 22; ++i) A.in[i] = ap->in[i];
        A.out = ap->out; A.ws = ap->ws; }
        p0_prologue(A, lds, vcu, G, wave, lane, tid); }
    GRID_BAR();

    if (PH(1)) for (int rep_ = 0; rep_ < REPS(1); ++rep_) { PROLOG h_phase<16>(ap->in[I_X], ap->in[I_CTX], (const float*)WSP(WS_MOD), (bf16*)WSP(WS_HB), (const float*)WSP(WS_WG), (float*)WSP(WS_GL), lds, vcu, G, wave, lane, tid); }
    GRID_BAR();
    if (PH(2)) for (int rep_ = 0; rep_ < REPS(2); ++rep_) { PROLOG pg8::Gemm g{(const bf16*)WSP(WS_HB), (const bf16*)WSP(WS_WAB), TT, N_AB, 1024, 1024, 1024}; pg8::StaticOrder S; S.init(TT, N_AB, G, bx);
      pg8::EpiBf16 E{(bf16*)WSP(WS_P), N_AB}; pg8::gemm_phase<pg8::EpiBf16, pg8::StaticOrder>(lds, g, S, E, tid); }
    GRID_BAR();
#if DBG_LEVEL >= 2
    if (PH(3)) for (int rep_ = 0; rep_ < REPS(3); ++rep_) { PROLOG mlstm_gate_scan((const float*)WSP(WS_GL), ap->in[I_ABGB], ws, gw, NGW, lane); }
    if (PH(4)) for (int rep_ = 0; rep_ < REPS(4); ++rep_) { PROLOG attn_phase((const bf16*)WSP(WS_P), (bf16*)WSP(WS_HB), ap->in[I_ABSINK], (const float*)WSP(WS_ROPE), lds, (unsigned*)WSP(WS_CTL) + 6144 + 64 * rep_, vcu, G, wave, lane, tid); }
    GRID_BAR();
    if (PH(5)) for (int rep_ = 0; rep_ < REPS(5); ++rep_) { PROLOG mlstm_fused_scan((const bf16*)WSP(WS_P), ws, lds, vcu, G, wave, lane, tid); }
    GRID_BAR();
    if (PH(6)) for (int rep_ = 0; rep_ < REPS(6); ++rep_) { PROLOG mlstm_merge((const bf16*)WSP(WS_P), (bf16*)WSP(WS_HB), ap->in[I_ABNW], ws, gw, NGW, lane); }
    GRID_BAR();
#endif
    if (PH(7)) for (int rep_ = 0; rep_ < REPS(7); ++rep_) { PROLOG pg8::Gemm g{(const bf16*)WSP(WS_HB), (const bf16*)WSP(WS_WABO), TT, 1024, 1024, 1024, 1024}; pg8::StaticOrder S; S.init(TT, 1024, G, bx);
      pg8::EpiBf16 E{(bf16*)WSP(WS_P), 1024}; pg8::gemm_phase<pg8::EpiBf16, pg8::StaticOrder>(lds, g, S, E, tid); }
    GRID_BAR();
    if (PH(8)) for (int rep_ = 0; rep_ < REPS(8); ++rep_) { PROLOG ln_phase(ap->in[I_X], ap->in[I_CTX], ap->out, (float*)WSP(WS_XC), (const bf16*)WSP(WS_P), (const float*)WSP(WS_MOD), ap->in[I_LNW], ap->in[I_LNB], (bf16*)WSP(WS_HB), gw, NGW, lane, DRYV(8), false); }
    GRID_BAR();
#if DBG_LEVEL >= 3
    if (PH(9)) for (int rep_ = 0; rep_ < REPS(9); ++rep_) { PROLOG pg8::Gemm g{(const bf16*)WSP(WS_HB), (const bf16*)WSP(WS_WQ0), TT, 2048, 1024, 1024, 1024}; pg8::StaticOrder S; S.init(TT, 2048, G, bx);
      pg8::EpiBf16 E{(bf16*)WSP(WS_P), 2048}; pg8::gemm_phase<pg8::EpiBf16, pg8::StaticOrder>(lds, g, S, E, tid); }
    GRID_BAR();
    if (PH(10)) for (int rep_ = 0; rep_ < REPS(10); ++rep_) { PROLOG peer_route((const bf16*)WSP(WS_P), (const bf16*)WSP(WS_KEYS), (int*)WSP(WS_ST), (float*)WSP(WS_ST + 17 * MiB), gw, NGW, lane, false); }
    GRID_BAR();
#endif
    if (PH(11)) for (int rep_ = 0; rep_ < REPS(22); ++rep_) { PROLOG peer_pass1((const bf16*)WSP(WS_HB), (const int*)WSP(WS_ST), (const float*)WSP(WS_ST + 17 * MiB), WSP(WS_U), (const float*)WSP(WS_SCL), (const float*)WSP(WS_SCL) + 2 * NEXP, (float*)WSP(WS_ST + 34 * MiB), lds, wave, gw, NGW, lane, false); }
    if (PH(11)) for (int rep_ = 0; rep_ < REPS(11); ++rep_) { PROLOG peer_expert<(DBG_LEVEL >= 3)>((const float*)WSP(WS_ST + 34 * MiB), (const int*)WSP(WS_ST), WSP(WS_V),
        ap->out, (float*)WSP(WS_XC), (const float*)WSP(WS_MOD), ap->in[I_LNW] + 1024, ap->in[I_LNB] + 1024, gw, NGW, lane, DRYV(11), false); }
    GRID_BAR();

    if (PH(12)) for (int rep_ = 0; rep_ < REPS(12); ++rep_) { PROLOG h_phase<32>(ap->out, (const float*)WSP(WS_XC), (const float*)WSP(WS_MOD) + 9 * 6144, (bf16*)WSP(WS_HB), (const float*)WSP(WS_WLOW), (float*)WSP(WS_GL), lds, vcu, G, wave, lane, tid);
 }
    GRID_BAR();
    if (PH(13)) for (int rep_ = 0; rep_ < REPS(13); ++rep_) { PROLOG pg8::Gemm g{(const bf16*)WSP(WS_HB), (const bf16*)WSP(WS_WC), TT, N_C, 1024, 1024, 1024}; pg8::StaticOrder S; S.init(TT, N_C, G, bx);
      pg8::EpiBf16 E{(bf16*)WSP(WS_P), N_C}; pg8::gemm_phase<pg8::EpiBf16, pg8::StaticOrder>(lds, g, S, E, tid); }
    GRID_BAR();
#if DBG_LEVEL >= 2
    if (PH(14)) for (int rep_ = 0; rep_ < REPS(14); ++rep_) { PROLOG gla_prep((bf16*)WSP(WS_P), (bf16*)WSP(WS_HB), (const float*)WSP(WS_GL), ap->in[I_GGUP], ap->in[I_GGB], ws, lds, vcu, G, tid, DRYV(14)); }
    GRID_BAR();
    if (PH(15)) for (int rep_ = 0; rep_ < REPS(15); ++rep_) { PROLOG gla_fused_scan((const bf16*)WSP(WS_P), (const bf16*)WSP(WS_HB), ws, lds, vcu, G, wave, lane, tid, DRYV(15)); }
    GRID_BAR();
    if (PH(16)) for (int rep_ = 0; rep_ < REPS(16); ++rep_) { PROLOG gla_merge((bf16*)WSP(WS_P), ap->in[I_GNW], ws, gw, NGW, lane, DRYV(16)); }
    GRID_BAR();
#endif
    if (PH(17)) for (int rep_ = 0; rep_ < REPS(17); ++rep_) { PROLOG pg8::Gemm g{(const bf16*)WSP(WS_P) + 2048, (const bf16*)WSP(WS_WCO), TT, 1024, 1024, N_C, 1024}; pg8::LatOrder S; S.init(NB * SEQ, 1024, G, bx);
      pg8::EpiBf16 E{(bf16*)WSP(WS_HB), 1024}; pg8::gemm_phase<pg8::EpiBf16, pg8::LatOrder>(lds, g, S, E, tid); }
    GRID_BAR();
    if (PH(18)) for (int rep_ = 0; rep_ < REPS(18); ++rep_) { PROLOG ln_phase(ap->out, (const float*)WSP(WS_XC), ap->out, (float*)WSP(WS_XC), (const bf16*)WSP(WS_HB), (const float*)WSP(WS_MOD) + 9 * 6144, ap->in[I_LNW] + 2048, ap->in[I_LNB] + 2048, (bf16*)WSP(WS_HB), gw, NGW, lane, DRYV(18), true); }
    GRID_BAR();
#if DBG_LEVEL >= 3
    if (PH(19)) for (int rep_ = 0; rep_ < REPS(19); ++rep_) { PROLOG pg8::Gemm g{(const bf16*)WSP(WS_HB), (const bf16*)WSP(WS_WQ1), TT, 2048, 1024, 1024, 1024}; pg8::LatOrder S; S.init(NB * SEQ, 2048, G, bx);
      pg8::EpiBf16 E{(bf16*)WSP(WS_P), 2048}; pg8::gemm_phase<pg8::EpiBf16, pg8::LatOrder>(lds, g, S, E, tid); }
    GRID_BAR();
    if (PH(20)) for (int rep_ = 0; rep_ < REPS(20); ++rep_) { PROLOG peer_route((const bf16*)WSP(WS_P), (const bf16*)WSP(WS_KEYS) + (size_t)8 * 2 * 128 * 128, (int*)WSP(WS_ST), (float*)WSP(WS_ST + 17 * MiB), gw, NGW, lane, true); }
    GRID_BAR();
#endif
    if (PH(21)) for (int rep_ = 0; rep_ < REPS(22); ++rep_) { PROLOG peer_pass1((const bf16*)WSP(WS_HB), (const int*)WSP(WS_ST), (const float*)WSP(WS_ST + 17 * MiB), WSP(WS_U) + (size_t)NEXP * 512, (const float*)WSP(WS_SCL) + NEXP, (const float*)WSP(WS_SCL) + 3 * NEXP, (float*)WSP(WS_ST + 34 * MiB), lds, wave, gw, NGW, lane, true); }
    if (PH(21)) for (int rep_ = 0; rep_ < REPS(21); ++rep_) { PROLOG peer_expert<(DBG_LEVEL >= 3)>((const float*)WSP(WS_ST + 34 * MiB), (const int*)WSP(WS_ST), WSP(WS_V) + (size_t)NEXP * 768,
        ap->out, (float*)WSP(WS_XC), (const float*)WSP(WS_MOD) + 9 * 6144, ap->in[I_LNW] + 3072, ap->in[I_LNB] + 3072, gw, NGW, lane, DRYV(21), true); }
}

extern "C" void kernel_launch(void* const* d_in, const int* in_sizes, int n_in, void* d_out, int out_size, void* d_ws, size_t ws_size, hipStream_t stream) {
    static int grid = 0;
    if (grid == 0) {
        if (n_in != 22 || out_size != NB * SEQ * D || ws_size < 512 * MiB) { fprintf(stderr, "kernel_launch: unexpected shapes: n_in %d out %d ws %zu (need %zu)\n", n_in, out_size, ws_size, (size_t)WS_END); grid = -1; return; }
        int dev = 0, cus = 0, per_cu = 0;
        if (hipGetDevice(&dev) != hipSuccess || hipDeviceGetAttribute(&cus, hipDeviceAttributeMultiprocessorCount, dev) != hipSuccess) { grid = -1; return; }
        if (hipFuncSetAttribute((const void*)fwd_megakernel, hipFuncAttributeMaxDynamicSharedMemorySize, LDS_BYTES) != hipSuccess) { fprintf(stderr, "kernel_launch: hipFuncSetAttribute failed\n"); grid = -1; return; }
        if (hipOccupancyMaxActiveBlocksPerMultiprocessor(&per_cu, (const void*)fwd_megakernel, 512, LDS_BYTES) != hipSuccess || per_cu < 1) { fprintf(stderr, "kernel_launch: occupancy query says %d blocks per CU\n", per_cu); }
        (void)hipGetLastError();
        grid = cus;
        fprintf(stderr, "kernel_launch: grid %d, per_cu %d, ws %zu\n", grid, per_cu, ws_size);
    }
    if (grid < 0) return;
    if (hipMemsetAsync((char*)d_ws + WS_CTL, 0, CTL_ZERO_BYTES, stream) != hipSuccess) return;
    Args a{};
    for (int i = 0; i < 22; ++i) a.in[i] = (const float*)d_in[i];
    a.out = (float*)d_out; a.ws = (unsigned char*)d_ws;
    hipLaunchKernelGGL(fwd_megakernel, dim3(grid), dim3(512), LDS_BYTES, stream, a);
}
```

```cpp
#include <hip/hip_runtime.h>
#include <cstdio>
#include <cstdint>

#define GAS __attribute__((address_space(1)))
#define LAS __attribute__((address_space(3)))
typedef unsigned short bf16;
typedef unsigned v4u __attribute__((ext_vector_type(4)));
typedef unsigned v2u __attribute__((ext_vector_type(2)));
typedef float f32x4 __attribute__((ext_vector_type(4)));
typedef float f32x2 __attribute__((ext_vector_type(2)));
typedef short bf16x8 __attribute__((ext_vector_type(8)));
typedef short s16x4 __attribute__((ext_vector_type(4)));
typedef GAS unsigned gu32;
#define RLX_AGENT __ATOMIC_RELAXED, __HIP_MEMORY_SCOPE_AGENT

constexpr int NB = 8, SEQ = 4096, LC = 256, D = 1024;
constexpr int PB = LC + SEQ;
constexpr int TT = NB * PB;
constexpr int NCH = PB / 64;
constexpr int N_AB = 2816;
constexpr int N_C = 3072;
constexpr float LN_EPS = 1e-5f;
constexpr float DN_ALPHA = 1.41421356237f;
constexpr int NEXP = 16384;
__device__ __forceinline__ int map_row(int i, bool lat_only) { return lat_only ? (i >> 12) * 4352 + 256 + (i & 4095) : i; }

constexpr size_t MiB = 1u << 20;
constexpr size_t WS_CTL = 0, CTL_ZERO_BYTES = 64 * 1024;
constexpr size_t WS_MOD = 1 * MiB;
constexpr size_t WS_ROPE = 2 * MiB;
constexpr size_t WS_WG = 2 * MiB + 64 * 1024;
constexpr size_t WS_WLOW = 2 * MiB + 128 * 1024;
constexpr size_t WS_SCL = 3 * MiB;
constexpr size_t WS_BQ = 4 * MiB, WS_CQ = WS_BQ + 1200 * 1024, WS_EM = WS_CQ + 1200 * 1024, WS_AI = WS_EM + 1200 * 1024;
constexpr size_t WS_AST = WS_AI + 1200 * 1024, WS_CL = WS_AST + 32 * 1024;
constexpr size_t WS_ET = 10 * MiB;
constexpr size_t WS_GL = 13 * MiB;
constexpr size_t WS_WAB = 20 * MiB, WS_WABO = 26 * MiB, WS_WC = 28 * MiB, WS_WCO = 34 * MiB, WS_WQ0 = 36 * MiB, WS_WQ1 = 40 * MiB, WS_KEYS = 44 * MiB;
constexpr size_t WS_NST = 45 * MiB;
constexpr size_t WS_XC = 48 * MiB;
constexpr size_t WS_U = 56 * MiB, WS_V = 88 * MiB;
constexpr size_t WS_HB = 120 * MiB;
constexpr size_t WS_P = 188 * MiB;
constexpr size_t WS_ST = 392 * MiB;
constexpr size_t WS_END = 460 * MiB;

constexpr int LDS_BYTES = 163840;
constexpr int MISC_OFF = LDS_BYTES - 64;

__device__ __forceinline__ unsigned f2bf(float f) { unsigned u = __builtin_bit_cast(unsigned, f); return (u + 0x7fffu + ((u >> 16) & 1u)) >> 16; }
__device__ __forceinline__ unsigned pk2(float lo, float hi) { return f2bf(lo) | (f2bf(hi) << 16); }
__device__ __forceinline__ float bflo(unsigned w) { return __builtin_bit_cast(float, w << 16); }
__device__ __forceinline__ float bfhi(unsigned w) { return __builtin_bit_cast(float, w & 0xffff0000u); }
__device__ __forceinline__ float bf2f(bf16 b) { return __builtin_bit_cast(float, (unsigned)b << 16); }
template <int CTRL> __device__ __forceinline__ float dppmov_f(float x) { return __builtin_bit_cast(float, __builtin_amdgcn_mov_dpp(__builtin_bit_cast(int, x), CTRL, 0xf, 0xf, true)); }
__device__ __forceinline__ float wave_sum(float v) {
    v += dppmov_f<0xB1>(v); v += dppmov_f<0x4E>(v); v += dppmov_f<0x141>(v); v += dppmov_f<0x128>(v);
    v += __shfl_xor(v, 16); v += __shfl_xor(v, 32);
    return v;
}
__device__ __forceinline__ float sigmoidf_(float x) { return 1.f / (1.f + __expf(-x)); }
__device__ __forceinline__ float logsigmoidf_(float x) { return fminf(x, 0.f) - log1pf(__expf(-fabsf(x))); }
__device__ __forceinline__ float siluf_(float x) { return x / (1.f + __expf(-x)); }

namespace pg8 {
#define PG8_LAS __attribute__((address_space(3)))
typedef unsigned short bf16_t;
typedef short bf16x8 __attribute__((ext_vector_type(8)));
typedef float f32x4 __attribute__((ext_vector_type(4)));
typedef unsigned u32x4 __attribute__((ext_vector_type(4)));
constexpr int BM = 256, BK = 64, HALF = 128, HTB = HALF * BK * 2  , STAGE_BYTES = 8 * HTB, NXCD = 8, WGM = 8;

__host__ __device__ __forceinline__ int lds_byte(int r, int c) { const int st = (r >> 4) * 2 + (c >> 5), rr = r & 15, cc = c & 31, ob = rr * 64 + cc * 2; return st * 1024 + (ob ^ (((ob >> 9) & 1) << 5)); }
__host__ __device__ __forceinline__ void stage_rc(int b, int& R, int& C) { const int st = b / 1024, sb = b % 1024, swz = sb ^ (((sb >> 9) & 1) << 5); R = (st >> 1) * 16 + swz / 64; C = (st & 1) * 32 + (swz % 64) / 2; }
__host__ __device__ __forceinline__ int perm32(int rho) { const int n = rho >> 4, i = rho & 15; return 8 * (i >> 2) + 4 * n + (i & 3); }

struct Unit { int pm, pn; };
struct Gemm { const bf16_t* A; const bf16_t* Bt; int M, N, K, lda, ldb; };

struct StaticOrder {
    int nM, nN, nwg, G, c;
    __host__ __device__ void init(int M, int N, int G_, int c_) { nM = M / BM; nN = N / BM; nwg = nM * nN; G = G_; c = c_; }
    __host__ __device__ bool next(int i, Unit& u) const {
        const long L = (long)i * G + c; if (L >= nwg) return false;
        int wgid = (int)L; { const int q = nwg / NXCD, r = nwg % NXCD, xcd = wgid % NXCD, off = wgid / NXCD; wgid = (xcd < r ? xcd * (q + 1) : r * (q + 1) + (xcd - r) * q) + off; }
        const int nig = WGM * nN, gid = wgid / nig, fm = gid * WGM, gsz = (nM - fm) < WGM ? (nM - fm) : WGM;
        u.pm = fm + ((wgid % nig) % gsz); u.pn = (wgid % nig) / gsz; return true;
    }
    __device__ __forceinline__ void a_ready(const Unit&) const {}
    __device__ __forceinline__ void done(const Unit&) const {}
};

struct LatOrder : StaticOrder {
    __host__ __device__ bool next(int i, Unit& u) const { if (!StaticOrder::next(i, u)) return false; u.pm = (u.pm >> 4) * 17 + 1 + (u.pm & 15); return true; }
};
__device__ __forceinline__ unsigned cvt_pk_bf16(float lo, float hi) { unsigned r; asm volatile("v_cvt_pk_bf16_f32 %0, %1, %2" : "=v"(r) : "v"(lo), "v"(hi)); return r; }
struct EpiBf16 {
    static constexpr bool PERM = true, AFTER_DRAIN = false;
    bf16_t* O; int ldc;
    __device__ __forceinline__ void operator()(const f32x4 (&acc)[2][2][4][2], const Unit& u, int wr, int wc, int fr, int fq) const {
        const int row0 = u.pm * BM + wr * 64 + fr; const int col0 = u.pn * BM + wc * 32 + 8 * fq;
#pragma unroll
        for (int ai = 0; ai < 2; ++ai)
#pragma unroll
            for (int m = 0; m < 4; ++m) { bf16_t* rowp = O + (size_t)(row0 + ai * HALF + m * 16) * ldc + col0;
#pragma unroll
                for (int bj = 0; bj < 2; ++bj) { const f32x4 v0 = acc[ai][bj][m][0], v1 = acc[ai][bj][m][1];
                    u32x4 w; w.x = cvt_pk_bf16(v0[0], v0[1]); w.y = cvt_pk_bf16(v0[2], v0[3]); w.z = cvt_pk_bf16(v1[0], v1[1]); w.w = cvt_pk_bf16(v1[2], v1[3]);
                    *(u32x4*)(rowp + bj * HALF) = w; } }
    }
};
struct EpiResid {
    static constexpr bool PERM = false, AFTER_DRAIN = false;
    const float* src_lat; const float* src_ctx; float* dst_lat; float* dst_ctx; const float* gate; float gscale; int dry;
    __device__ __forceinline__ void operator()(const f32x4 (&acc)[2][2][4][2], const Unit& u, int wr, int wc, int fr, int fq) const {
        const int b = u.pm / 17, tb = u.pm - b * 17;
        const float* sbase; float* dbase; const float* gr;
        if (tb == 0) { sbase = src_ctx + (size_t)b * 256 * 1024; dbase = dst_ctx + (size_t)b * 256 * 1024; gr = gate + 8 * 6144; }
        else { sbase = src_lat + ((size_t)b * 4096 + (size_t)(tb - 1) * 256) * 1024; dbase = dst_lat + ((size_t)b * 4096 + (size_t)(tb - 1) * 256) * 1024; gr = gate + b * 6144; }
        const int row0 = wr * 64 + fr, col0 = u.pn * BM + wc * 32 + 4 * fq;
        f32x4 gv[2][2];
#pragma unroll
        for (int bj = 0; bj < 2; ++bj)
#pragma unroll
            for (int n = 0; n < 2; ++n) gv[bj][n] = *(const f32x4*)(gr + col0 + bj * HALF + n * 16) * gscale;
#pragma unroll
        for (int ai = 0; ai < 2; ++ai)
#pragma unroll
            for (int mp = 0; mp < 2; ++mp) {
                f32x4 sv[2][2][2];
#pragma unroll
                for (int mm = 0; mm < 2; ++mm) { const size_t off = (size_t)(row0 + ai * HALF + (2 * mp + mm) * 16) * 1024 + col0;
#pragma unroll
                    for (int bj = 0; bj < 2; ++bj)
#pragma unroll
                        for (int n = 0; n < 2; ++n) sv[mm][bj][n] = __builtin_nontemporal_load((const f32x4*)(sbase + off + bj * HALF + n * 16)); }
                asm volatile("" ::: "memory");
#pragma unroll
                for (int mm = 0; mm < 2; ++mm) { const int m = 2 * mp + mm; const size_t off = (size_t)(row0 + ai * HALF + m * 16) * 1024 + col0;
#pragma unroll
                    for (int bj = 0; bj < 2; ++bj)
#pragma unroll
                        for (int n = 0; n < 2; ++n) { const f32x4 ov = sv[mm][bj][n] * 1.41421356237f + gv[bj][n] * acc[ai][bj][m][n]; if (!dry) *(f32x4*)(dbase + off + bj * HALF + n * 16) = ov; } }
                asm volatile("" ::: "memory");
            }
    }
};

template <class Epi, class Sched>
__device__ __forceinline__ void gemm_phase(PG8_LAS unsigned char* lds, const Gemm g, const Sched& S, const Epi& E, const int tid_in) {
    const int tid = tid_in, wid = __builtin_amdgcn_readfirstlane(tid >> 6), lane = tid & 63, wr = wid >> 2, wc = wid & 3, fr = lane & 15, fq = lane >> 4;
    const int K = g.K, nt = K / BK;
    unsigned voffA[2], voffB[2];
#pragma unroll
    for (int i = 0; i < 2; ++i) { int R, C; stage_rc(tid * 16 + i * 8192, R, C); const int Rb = Epi::PERM ? ((R & ~31) + perm32(R & 31)) : R;
        voffA[i] = (unsigned)(R * g.lda + C) * 2u; voffB[i] = (unsigned)(Rb * g.ldb + C) * 2u; }
    const size_t kstep = (size_t)(BK * 2);
    const size_t hstepA = (size_t)HALF * g.lda * 2, hstepB = (size_t)HALF * g.ldb * 2;
    const size_t tstepA = 2 * hstepA, tstepB = 2 * hstepB;
    const unsigned ldsw = (unsigned)wid * 1024u;
    const int aoff = lds_byte(wr * 64 + fr, fq * 8), boff = lds_byte(wc * 32 + fr, fq * 8);
#define PG8_SA(b, h) (((b) * 2 + (h)) * HTB)
#define PG8_SB(b, h) ((4 + (b) * 2 + (h)) * HTB)
#define PG8_STAGE(bufoff, gbase, voff) do { _Pragma("unroll") for (int _i = 0; _i < 2; ++_i) \
        __builtin_amdgcn_global_load_lds((const unsigned*)((const char*)(gbase) + (voff)[_i]), (PG8_LAS unsigned*)(lds + (bufoff) + ldsw + _i * 8192), 16, 0, 0); } while (0)
#define PG8_LDA(dst, b, h) do { _Pragma("unroll") for (int m = 0; m < 4; ++m) _Pragma("unroll") for (int k = 0; k < 2; ++k) dst[m][k] = *(const PG8_LAS bf16x8*)(lds + PG8_SA(b, h) + aoff + m * 2048 + k * 1024); } while (0)
#define PG8_LDB(dst, b, h) do { _Pragma("unroll") for (int n = 0; n < 2; ++n) _Pragma("unroll") for (int k = 0; k < 2; ++k) dst[n][k] = *(const PG8_LAS bf16x8*)(lds + PG8_SB(b, h) + boff + n * 2048 + k * 1024); } while (0)
#define PG8_MMA(ai, bj, At, Bt) do { __builtin_amdgcn_s_setprio(1); _Pragma("unroll") for (int m = 0; m < 4; ++m) _Pragma("unroll") for (int n = 0; n < 2; ++n) _Pragma("unroll") for (int k = 0; k < 2; ++k) \
        acc[ai][bj][m][n] = __builtin_amdgcn_mfma_f32_16x16x32_bf16(Bt[n][k], At[m][k], acc[ai][bj][m][n], 0, 0, 0); __builtin_amdgcn_s_setprio(0); } while (0)
#define PG8_WAIT_V(n) asm volatile("s_waitcnt vmcnt(" #n ")" ::: "memory")
#define PG8_WAIT_L(n) asm volatile("s_waitcnt lgkmcnt(" #n ")" ::: "memory")
#define PG8_BAR __builtin_amdgcn_s_barrier()
#define PG8_SCHED __builtin_amdgcn_sched_barrier(0)
    Unit cur, nxt; int ui = 0;
    if (!S.next(0, cur)) return;
    f32x4 acc[2][2][4][2];
#pragma unroll
    for (int a = 0; a < 2; ++a)
#pragma unroll
        for (int b = 0; b < 2; ++b)
#pragma unroll
            for (int m = 0; m < 4; ++m)
#pragma unroll
                for (int n = 0; n < 2; ++n) acc[a][b][m][n] = (f32x4){0.f, 0.f, 0.f, 0.f};
    bf16x8 At[4][2], B0[2][2], B1[2][2];
    const char* cA = (const char*)g.A + (size_t)cur.pm * tstepA; const char* cB = (const char*)g.Bt + (size_t)cur.pn * tstepB;
    S.a_ready(cur);
    PG8_STAGE(PG8_SB(0, 0), cB, voffB); PG8_STAGE(PG8_SA(0, 0), cA, voffA); PG8_STAGE(PG8_SB(0, 1), cB + hstepB, voffB); PG8_STAGE(PG8_SA(0, 1), cA + hstepA, voffA);
    if (wr == 1) PG8_BAR;
    PG8_WAIT_V(4); PG8_BAR;
    PG8_STAGE(PG8_SB(1, 0), cB + kstep, voffB); PG8_STAGE(PG8_SA(1, 0), cA + kstep, voffA); PG8_STAGE(PG8_SB(1, 1), cB + hstepB + kstep, voffB);
    PG8_WAIT_V(6); PG8_BAR;
    for (;;) {
        const bool has_next = S.next(ui + 1, nxt);
        const char* nA = has_next ? (const char*)g.A + (size_t)nxt.pm * tstepA : cA; const char* nB = has_next ? (const char*)g.Bt + (size_t)nxt.pn * tstepB : cB;
        for (int t = 0; t < nt; t += 2) {
            const bool last = (t == nt - 2);
            const char* a1 = cA + (size_t)(t + 1) * kstep;
            const char* a2 = last ? nA : cA + (size_t)(t + 2) * kstep; const char* b2 = last ? nB : cB + (size_t)(t + 2) * kstep;
            const char* a3 = a2 + kstep; const char* b3 = b2 + kstep;
            if (last && has_next) S.a_ready(nxt);
            PG8_LDB(B0, 0, 0); PG8_SCHED; PG8_LDA(At, 0, 0); PG8_STAGE(PG8_SA(1, 1), a1 + hstepA, voffA);
            PG8_WAIT_L(8); PG8_BAR; PG8_WAIT_L(0); PG8_MMA(0, 0, At, B0); PG8_BAR; PG8_SCHED;
            PG8_LDB(B1, 0, 1); PG8_STAGE(PG8_SB(0, 0), b2, voffB);
            PG8_BAR; PG8_WAIT_L(0); PG8_MMA(0, 1, At, B1); PG8_BAR;
            PG8_LDA(At, 0, 1); PG8_STAGE(PG8_SA(0, 0), a2, voffA);
            PG8_BAR; PG8_WAIT_L(0); PG8_MMA(1, 0, At, B0); PG8_BAR; PG8_SCHED;
            PG8_STAGE(PG8_SB(0, 1), b2 + hstepB, voffB);
            PG8_WAIT_V(6); PG8_BAR; PG8_MMA(1, 1, At, B1); PG8_BAR;
            PG8_LDB(B0, 1, 0); PG8_SCHED; PG8_LDA(At, 1, 0); PG8_STAGE(PG8_SA(0, 1), a2 + hstepA, voffA);
            PG8_WAIT_L(8); PG8_BAR; PG8_WAIT_L(0); PG8_MMA(0, 0, At, B0); PG8_BAR; PG8_SCHED;
            PG8_LDB(B1, 1, 1); PG8_STAGE(PG8_SB(1, 0), b3, voffB);
            PG8_BAR; PG8_WAIT_L(0); PG8_MMA(0, 1, At, B1); PG8_BAR;
            PG8_LDA(At, 1, 1); PG8_STAGE(PG8_SA(1, 0), a3, voffA);
            PG8_BAR; PG8_WAIT_L(0); PG8_MMA(1, 0, At, B0); PG8_BAR; PG8_SCHED;
            PG8_STAGE(PG8_SB(1, 1), b3 + hstepB, voffB);
            PG8_WAIT_V(6); PG8_BAR; PG8_MMA(1, 1, At, B1); PG8_BAR;
        }
        if constexpr (!Epi::AFTER_DRAIN) { E(acc, cur, wr, wc, fr, fq); S.done(cur); }
        if (!has_next) break;
#pragma unroll
        for (int a = 0; a < 2; ++a)
#pragma unroll
            for (int b = 0; b < 2; ++b)
#pragma unroll
                for (int m = 0; m < 4; ++m)
#pragma unroll
                    for (int n = 0; n < 2; ++n) acc[a][b][m][n] = (f32x4){0.f, 0.f, 0.f, 0.f};
        cur = nxt; cA = nA; cB = nB; ++ui;
    }
    PG8_WAIT_V(0);
    if (wr == 0) PG8_BAR;
    PG8_BAR;
    if constexpr (Epi::AFTER_DRAIN) { E.fused(acc, cur, wr, wc, fr, fq, lds, wid, lane); S.done(cur); }
#undef PG8_SA
#undef PG8_SB
#undef PG8_STAGE
#undef PG8_LDA
#undef PG8_LDB
#undef PG8_MMA
#undef PG8_WAIT_V
#undef PG8_WAIT_L
#undef PG8_BAR
#undef PG8_SCHED
}
}

#define XB_TMO      128
#define XB_XCNT(j)  (256  + 64 * (j))
#define XB_XSUB(j)  (1280 + 64 * (j))
#define XB_XGEN(j)  (2304 + 64 * (j))
#define XB_TOP      3328
#define XB_TOPGEN   3392
#define XCD_BAR_WORDS 3456
#define XB_SPIN_CAP (1u << 18)

__device__ __forceinline__ unsigned xb_ld(unsigned* p)              { return __hip_atomic_load(p, __ATOMIC_RELAXED, __HIP_MEMORY_SCOPE_AGENT); }
__device__ __forceinline__ unsigned xb_add(unsigned* p, unsigned v) { return __hip_atomic_fetch_add(p, v, __ATOMIC_RELAXED, __HIP_MEMORY_SCOPE_AGENT); }
__device__ __forceinline__ unsigned xb_xcc_id() { return (unsigned)__builtin_amdgcn_s_getreg((3 << 11) | 20) & 0xFu; }
#define XB_SPIN(cond, bar) do { unsigned _sp = 0; while (cond) { __builtin_amdgcn_s_sleep(1); \
    if ((++_sp & 255u) == 0u) { if (xb_ld(&(bar)[XB_TMO])) break; if (_sp > XB_SPIN_CAP) { atomicAdd(&(bar)[XB_TMO], 1u); break; } } } } while (0)

struct XcdBarrier {
    unsigned* bar; unsigned x;
    volatile LAS unsigned* st;
};

__device__ __forceinline__ XcdBarrier xcd_barrier_post(unsigned* bar, volatile LAS unsigned* st) {
    XcdBarrier b; b.bar = bar; b.x = xb_xcc_id(); b.st = st;
    if (threadIdx.x == 0) (void)xb_add(&bar[XB_XCNT(b.x)], 1u);
    return b;
}
__device__ __forceinline__ void xcd_barrier_complete(unsigned* bar, unsigned x, unsigned& nloc, unsigned& nx) {
    const unsigned G = gridDim.x * gridDim.y * gridDim.z;
    unsigned sum, cnt, mine, sp = 0u;
    for (;;) {
        sum = 0u; cnt = 0u; mine = 0u;
#pragma unroll
        for (unsigned j = 0; j < 16; ++j) { const unsigned c = xb_ld(&bar[XB_XCNT(j)]); sum += c; cnt += (c > 0u) ? 1u : 0u; mine = (j == x) ? c : mine; }
        if (sum == G) break;
        __builtin_amdgcn_s_sleep(1);
        if ((++sp & 255u) == 0u) { if (xb_ld(&bar[XB_TMO])) break; if (sp > XB_SPIN_CAP) { atomicAdd(&bar[XB_TMO], 1u); break; } }
    }
    nloc = mine > 0u ? mine : 1u; nx = cnt > 0u ? cnt : 1u;
}

__device__ __forceinline__ void xcd_barrier(const XcdBarrier& b) {
    asm volatile("s_waitcnt vmcnt(0)" ::: "memory");
    __syncthreads();
    if (threadIdx.x == 0) {
        unsigned* bar = b.bar;
        __builtin_amdgcn_s_waitcnt(0);
        unsigned nloc = b.st[0], nx = b.st[1];
        if (nloc == 0u) { xcd_barrier_complete(bar, b.x, nloc, nx); b.st[0] = nloc; b.st[1] = nx; }
        const unsigned old = xb_add(&bar[XB_XSUB(b.x)], 1u);
        const unsigned gen = old / nloc;
        if (old + 1u == (gen + 1u) * nloc) {
            __builtin_amdgcn_fence(__ATOMIC_RELEASE, "agent");
            asm volatile("s_waitcnt vmcnt(0)" ::: "memory");
            const unsigned og = xb_add(&bar[XB_TOP], 1u);
            const unsigned tg = og / nx;
            if (og + 1u == (tg + 1u) * nx) xb_add(&bar[XB_TOPGEN], 1u);
            else XB_SPIN(xb_ld(&bar[XB_TOPGEN]) == tg, bar);
            __builtin_amdgcn_fence(__ATOMIC_ACQUIRE, "agent");
            xb_add(&bar[XB_XGEN(b.x)], 1u);
            asm volatile("s_waitcnt vmcnt(0)" ::: "memory");
        } else {
            XB_SPIN(xb_ld(&bar[XB_XGEN(b.x)]) == gen, bar);
            __builtin_amdgcn_fence(__ATOMIC_ACQUIRE, "agent");
            asm volatile("s_waitcnt vmcnt(0)" ::: "memory");
        }
    }
    __syncthreads();
}


__device__ __forceinline__ f32x4 mma(bf16x8 a, bf16x8 b, f32x4 c) { return __builtin_amdgcn_mfma_f32_16x16x32_bf16(a, b, c, 0, 0, 0); }
__device__ __forceinline__ bf16x8 frag_row(const LAS bf16* t, int ld, int r0, int c0, int lane) {
    return *(const LAS bf16x8*)(t + (r0 + (lane & 15)) * ld + c0 + 8 * (lane >> 4));
}
__device__ __forceinline__ bf16x8 frag_tr(const LAS bf16* t, int ld, int r0, int c0, int lane) {
    const int g = lane >> 4, q = (lane & 15) >> 2, p = lane & 3;
    const LAS bf16* a = t + (r0 + 8 * g + q) * ld + c0 + 4 * p;
    const s16x4 lo = __builtin_amdgcn_ds_read_tr16_b64_v4i16((LAS s16x4*)a);
    const s16x4 hi = __builtin_amdgcn_ds_read_tr16_b64_v4i16((LAS s16x4*)(a + 4 * ld));
    return (bf16x8){lo[0], lo[1], lo[2], lo[3], hi[0], hi[1], hi[2], hi[3]};
}
#define LDS_FENCE() do { asm volatile("s_waitcnt lgkmcnt(0)" ::: "memory"); __builtin_amdgcn_wave_barrier(); } while (0)

struct Args {
    const float* in[22]; float* out; unsigned char* ws;
};
enum { I_X = 0, I_C, I_CTX, I_CCTX, I_WMOD, I_BMOD, I_LNW, I_LNB, I_ABWIN, I_ABGB, I_ABNW, I_ABSINK, I_ABWOUT, I_GWIN, I_GGUP, I_GGB, I_GNW, I_GWOUT, I_PWQ, I_PKEYS, I_PU, I_PV };

__device__ __forceinline__ const float* srow_c(const float* lat, const float* ctx, int r) { const int b = r / PB, p = r - b * PB; return p < LC ? ctx + (size_t)(b * LC + p) * D : lat + (size_t)(b * SEQ + p - LC) * D; }
__device__ __forceinline__ float* srow(float* lat, float* ctx, int r) { const int b = r / PB, p = r - b * PB; return p < LC ? ctx + (size_t)(b * LC + p) * D : lat + (size_t)(b * SEQ + p - LC) * D; }

__device__ __forceinline__ void p0_transpose_item(const float* W, int K, int ldw, int c0, int ncols, bf16* WT, int row_off, LAS float* scr, int item, int lane,
                                                  int s0lo, int s0hi, float s0, int s1lo, int s1hi, float s1) {
    const int nblk = ncols / 32, kb = item / nblk, nb = item % nblk, k0 = 64 * kb, n0 = 32 * nb;
#pragma unroll 8
    for (int i = 0; i < 32; ++i) { const int kk = 2 * i + (lane >> 5); scr[kk * 33 + (lane & 31)] = W[(size_t)(k0 + kk) * ldw + c0 + n0 + (lane & 31)]; }
    asm volatile("s_waitcnt lgkmcnt(0)" ::: "memory");
    const int c = lane & 7;
#pragma unroll
    for (int j = 0; j < 4; ++j) { const int n = (lane >> 3) + 8 * j; const LAS float* s = scr + (8 * c) * 33 + n;
        const int dr = row_off + n0 + n; float sc = 1.f; if (dr >= s0lo && dr < s0hi) sc = s0; if (dr >= s1lo && dr < s1hi) sc = s1;
        v4u o; o.x = pk2(s[0 * 33] * sc, s[1 * 33] * sc); o.y = pk2(s[2 * 33] * sc, s[3 * 33] * sc); o.z = pk2(s[4 * 33] * sc, s[5 * 33] * sc); o.w = pk2(s[6 * 33] * sc, s[7 * 33] * sc);
        *(v4u*)(WT + (size_t)dr * K + k0 + 8 * c) = o; }
    asm volatile("s_waitcnt lgkmcnt(0)" ::: "memory");
}
__device__ __forceinline__ void cvt_f32_bf16(const float* src, bf16* dst, size_t n, int gtid, int gthreads) {
    const size_t nch = n / 8;
    for (size_t i = gtid; i < nch; i += gthreads) { const f32x4 a = *(const f32x4*)(src + i * 8), b = *(const f32x4*)(src + i * 8 + 4);
        v4u o; o.x = pk2(a[0], a[1]); o.y = pk2(a[2], a[3]); o.z = pk2(b[0], b[1]); o.w = pk2(b[2], b[3]); *(v4u*)(dst + i * 8) = o; }
}
typedef float v16f __attribute__((ext_vector_type(16)));
typedef float v32f __attribute__((ext_vector_type(32)));
typedef unsigned v6u __attribute__((ext_vector_type(6)));
typedef unsigned v3u __attribute__((ext_vector_type(3)));
__device__ __forceinline__ void cvt_rows_fp6(const float* src, unsigned char* dst, float* inv, int nrows, int gw, int NGW, int lane) {
    const int hl = lane & 31, hh = lane >> 5;
    for (int r2 = gw; r2 < nrows / 2; r2 += NGW) {
        const int r = 2 * r2 + hh; const float* sp = src + (size_t)r * 1024 + 32 * hl;
        f32x4 x[8]; float m = 0.f;
#pragma unroll
        for (int q = 0; q < 8; ++q) { x[q] = *(const f32x4*)(sp + 4 * q); m = fmaxf(m, fmaxf(fmaxf(fabsf(x[q][0]), fabsf(x[q][1])), fmaxf(fabsf(x[q][2]), fabsf(x[q][3])))); }
        m = fmaxf(m, dppmov_f<0xB1>(m)); m = fmaxf(m, dppmov_f<0x4E>(m)); m = fmaxf(m, dppmov_f<0x141>(m)); m = fmaxf(m, dppmov_f<0x128>(m)); m = fmaxf(m, __shfl_xor(m, 16));
        const float sc = m > 0.f ? 7.0f / m : 1.f;
        v16f a, b;
#pragma unroll
        for (int q = 0; q < 8; ++q) { a[2 * q] = x[q][0] * sc; b[2 * q] = x[q][1] * sc; a[2 * q + 1] = x[q][2] * sc; b[2 * q + 1] = x[q][3] * sc; }
        const v6u p = __builtin_amdgcn_cvt_scalef32_2xpk16_fp6_f32(a, b, 1.0f);
        unsigned char* dp = dst + (size_t)r * 768 + 24 * hl;
        *(v2u*)dp = (v2u){p[0], p[1]}; *(v2u*)(dp + 8) = (v2u){p[2], p[3]}; *(v2u*)(dp + 16) = (v2u){p[4], p[5]};
        if (hl == 0) inv[r] = m > 0.f ? m / 7.0f : 1.f;
    }
}
__device__ __forceinline__ void cvt_rows_fp4(const float* src, unsigned char* dst, float* inv, int nrows, int gw, int NGW, int lane) {
    const int hl = lane & 31, hh = lane >> 5;
    for (int r2 = gw; r2 < nrows / 2; r2 += NGW) {
        const int r = 2 * r2 + hh; const float* sp = src + (size_t)r * 1024 + 32 * hl;
        f32x4 x[8]; float m = 0.f;
#pragma unroll
        for (int q = 0; q < 8; ++q) { x[q] = *(const f32x4*)(sp + 4 * q); m = fmaxf(m, fmaxf(fmaxf(fabsf(x[q][0]), fabsf(x[q][1])), fmaxf(fabsf(x[q][2]), fabsf(x[q][3])))); }
        m = fmaxf(m, dppmov_f<0xB1>(m)); m = fmaxf(m, dppmov_f<0x4E>(m)); m = fmaxf(m, dppmov_f<0x141>(m)); m = fmaxf(m, dppmov_f<0x128>(m)); m = fmaxf(m, __shfl_xor(m, 16));
        const float sc = m > 0.f ? 6.0f / m : 1.f;
        unsigned w[4];
#pragma unroll
        for (int d = 0; d < 4; ++d) { unsigned t = 0u;
            t = __builtin_amdgcn_cvt_scalef32_pk_fp4_f32(t, x[2 * d][0] * sc, x[2 * d][1] * sc, 1.0f, 0); t = __builtin_amdgcn_cvt_scalef32_pk_fp4_f32(t, x[2 * d][2] * sc, x[2 * d][3] * sc, 1.0f, 1);
            t = __builtin_amdgcn_cvt_scalef32_pk_fp4_f32(t, x[2 * d + 1][0] * sc, x[2 * d + 1][1] * sc, 1.0f, 2); t = __builtin_amdgcn_cvt_scalef32_pk_fp4_f32(t, x[2 * d + 1][2] * sc, x[2 * d + 1][3] * sc, 1.0f, 3);
            w[d] = t; }
        *(v4u*)(dst + (size_t)r * 512 + 16 * hl) = (v4u){w[0], w[1], w[2], w[3]};
        if (hl == 0) inv[r] = m > 0.f ? m / 6.0f : 1.f;
    }
}
__device__ __forceinline__ void p0_prologue(const Args& A, LAS unsigned char* lds, int vcu, int G, int wave, int lane, int tid) {
    unsigned char* ws = A.ws;
    const int gw = vcu * 8 + wave, NGW = G * 8, gtid = vcu * 512 + tid, gthreads = G * 512;
    LAS float* sil = (LAS float*)lds;
    for (int i = tid; i < 9 * 1024; i += 512) { const float v = i < 8192 ? A.in[I_C][i] : A.in[I_CCTX][i - 8192]; sil[i] = siluf_(v); }
    __syncthreads();
    float* MOD = (float*)(ws + WS_MOD);
    LAS float* part = (LAS float*)(lds + 40960);
    for (int it = vcu; it < 2 * 96; it += G) {
        const int l = it / 96, n = (it % 96) * 64 + lane; const float* wm = A.in[I_WMOD] + (size_t)l * 1024 * 6144 + (size_t)(128 * wave) * 6144 + n;
        float acc[9];
#pragma unroll
        for (int r = 0; r < 9; ++r) acc[r] = 0.f;
#pragma unroll 8
        for (int k = 0; k < 128; ++k) { const float w = wm[(size_t)k * 6144];
#pragma unroll
            for (int r = 0; r < 9; ++r) acc[r] += sil[r * 1024 + 128 * wave + k] * w; }
        __syncthreads();
#pragma unroll
        for (int r = 0; r < 9; ++r) part[(wave * 9 + r) * 64 + lane] = acc[r];
        __syncthreads();
        for (int i = tid; i < 9 * 64; i += 512) { float sum = 0.f;
#pragma unroll
            for (int w8 = 0; w8 < 8; ++w8) sum += part[w8 * 576 + i];
            const int r = i >> 6, c = (it % 96) * 64 + (i & 63); MOD[(size_t)(l * 9 + r) * 6144 + c] = sum + A.in[I_BMOD][l * 6144 + c]; }
    }
    __syncthreads();
    LAS float* scr = (LAS float*)(lds + 40960 + wave * 8704);
    constexpr int I_AB1 = 16 * 64, I_AB2 = 16 * 24, I_ABO = 16 * 32, I_C1 = 16 * 96, I_CO = 16 * 32, I_Q = 16 * 64;
    constexpr int NITEMS = I_AB1 + I_AB2 + I_ABO + I_C1 + I_CO + 2 * I_Q;
    const float rs128 = 0.08838834764831845f;
    for (int it = gw; it < NITEMS; it += NGW) {
        int r = it;
        if (r < I_AB1) { p0_transpose_item(A.in[I_ABWIN], 1024, 2832, 0, 2048, (bf16*)(ws + WS_WAB), 0, scr, r, lane, 512, 1024, rs128, 0, 0, 1.f); continue; } r -= I_AB1;
        if (r < I_AB2) { p0_transpose_item(A.in[I_ABWIN], 1024, 2832, 2064, 768, (bf16*)(ws + WS_WAB), 2048, scr, r, lane, 2048, 2560, 0.125f, 0, 0, 1.f); continue; } r -= I_AB2;
        if (r < I_ABO) { p0_transpose_item(A.in[I_ABWOUT], 1024, 1024, 0, 1024, (bf16*)(ws + WS_WABO), 0, scr, r, lane, 0, 0, 1.f, 0, 0, 1.f); continue; } r -= I_ABO;
        if (r < I_C1) { p0_transpose_item(A.in[I_GWIN], 1024, 3104, 0, 3072, (bf16*)(ws + WS_WC), 0, scr, r, lane, 0, 512, rs128, 0, 0, 1.f); continue; } r -= I_C1;
        if (r < I_CO) { p0_transpose_item(A.in[I_GWOUT], 1024, 1024, 0, 1024, (bf16*)(ws + WS_WCO), 0, scr, r, lane, 0, 0, 1.f, 0, 0, 1.f); continue; } r -= I_CO;
        if (r < I_Q) { p0_transpose_item(A.in[I_PWQ], 1024, 2048, 0, 2048, (bf16*)(ws + WS_WQ0), 0, scr, r, lane, 0, 0, 1.f, 0, 0, 1.f); continue; } r -= I_Q;
        p0_transpose_item(A.in[I_PWQ] + (size_t)1024 * 2048, 1024, 2048, 0, 2048, (bf16*)(ws + WS_WQ1), 0, scr, r, lane, 0, 0, 1.f, 0, 0, 1.f);
    }
    for (int i = gtid; i < 16 * 1024; i += gthreads) { const int g = i >> 10, k = i & 1023; ((float*)(ws + WS_WG))[i] = A.in[I_ABWIN][(size_t)k * 2832 + 2048 + g]; }
    for (int i = gtid; i < 32 * 1024; i += gthreads) { const int g = i >> 10, k = i & 1023; ((float*)(ws + WS_WLOW))[i] = A.in[I_GWIN][(size_t)k * 3104 + 3072 + g]; }
    for (int i = gtid; i < 64 * 16; i += gthreads) { const int pos = i >> 4, f = i & 15; const float inv = powf(10000.f, -(float)f / 16.f); const float ang = (float)pos * inv;
        ((float*)(ws + WS_ROPE))[2 * i] = cosf(ang); ((float*)(ws + WS_ROPE))[2 * i + 1] = sinf(ang); }
    cvt_f32_bf16(A.in[I_PKEYS], (bf16*)(ws + WS_KEYS), (size_t)2 * 8 * 2 * 128 * 128, gtid, gthreads);
    cvt_rows_fp4(A.in[I_PU], ws + WS_U, (float*)(ws + WS_SCL), 2 * NEXP, gw, NGW, lane);
    cvt_rows_fp4(A.in[I_PV], ws + WS_V, (float*)(ws + WS_SCL) + 2 * NEXP, 2 * NEXP, gw, NGW, lane);
}

__device__ __forceinline__ void split8(const float* v, bf16x8& hi, bf16x8& lo) {
#pragma unroll
    for (int j = 0; j < 8; ++j) { const unsigned h = f2bf(v[j]); const float hf = __builtin_bit_cast(float, h << 16); hi[j] = (short)h; lo[j] = (short)f2bf(v[j] - hf); }
}
template <int NG>
__device__ __forceinline__ void h_phase(const float* lat, const float* ctx, const float* mod  , bf16* HB, const float* WGT, float* GL, LAS unsigned char* lds, int vcu, int G, int wave, int lane, int tid) {
    constexpr int NT = NG / 16;
    LAS float* part = (LAS float*)lds;
    const int g = lane >> 4, c16 = lane & 15;
    bf16x8 bhi[NT][4], blo[NT][4];
#pragma unroll
    for (int nt = 0; nt < NT; ++nt)
#pragma unroll
        for (int ks = 0; ks < 4; ++ks) { const float* wp = WGT + (size_t)(16 * nt + c16) * 1024 + 128 * wave + 32 * ks + 8 * g;
            const f32x4 w0 = *(const f32x4*)wp, w1 = *(const f32x4*)(wp + 4); const float wv[8] = {w0[0], w0[1], w0[2], w0[3], w1[0], w1[1], w1[2], w1[3]}; split8(wv, bhi[nt][ks], blo[nt][ks]); }
    for (int tile = vcu; tile < TT / 16; tile += G) {
        const int r0 = tile * 16, b = r0 / PB, p0 = r0 - b * PB; const float* mr = mod + (size_t)(p0 < LC ? 8 : b) * 6144 + 128 * wave + 8 * g;
        const int row = r0 + c16; const float* xr = srow_c(lat, ctx, row) + 128 * wave + 8 * g;
        f32x4 xa[4][2], sha[4][2], sca[4][2];
#pragma unroll
        for (int ks = 0; ks < 4; ++ks)
#pragma unroll
            for (int q = 0; q < 2; ++q) { xa[ks][q] = *(const f32x4*)(xr + 32 * ks + 4 * q); sha[ks][q] = *(const f32x4*)(mr + 32 * ks + 4 * q); sca[ks][q] = *(const f32x4*)(mr + 1024 + 32 * ks + 4 * q); }
        f32x4 acc[NT];
#pragma unroll
        for (int nt = 0; nt < NT; ++nt) acc[nt] = (f32x4){0.f, 0.f, 0.f, 0.f};
#pragma unroll
        for (int ks = 0; ks < 4; ++ks) {
            float hv[8];
#pragma unroll
            for (int q = 0; q < 2; ++q)
#pragma unroll
                for (int i = 0; i < 4; ++i) hv[4 * q + i] = xa[ks][q][i] * (sca[ks][q][i] + 1.0f) + sha[ks][q][i];
            bf16x8 ahi, alo; split8(hv, ahi, alo);
            *(bf16x8*)(HB + (size_t)row * D + 128 * wave + 32 * ks + 8 * g) = ahi;
#pragma unroll
            for (int nt = 0; nt < NT; ++nt) { acc[nt] = mma(ahi, bhi[nt][ks], acc[nt]); acc[nt] = mma(ahi, blo[nt][ks], acc[nt]); acc[nt] = mma(alo, bhi[nt][ks], acc[nt]); }
        }
        __syncthreads();
#pragma unroll
        for (int nt = 0; nt < NT; ++nt)
#pragma unroll
            for (int r = 0; r < 4; ++r) part[(wave * 16 + 4 * g + r) * NG + 16 * nt + c16] = acc[nt][r];
        __syncthreads();
        for (int i = tid; i < 16 * NG; i += 512) { float sum = 0.f;
#pragma unroll
            for (int w8 = 0; w8 < 8; ++w8) sum += part[w8 * 16 * NG + i];
            GL[(size_t)r0 * NG + i] = sum; }
    }
}

__device__ __forceinline__ void ln_row(const float* sr, float* xr, const bf16* yrow, const float* mr, const float* lnw, const float* lnb, bf16* hrow, int lane, int dry, bool active) {
    f32x4 v[4]; float s = 0.f;
#pragma unroll
    for (int j = 0; j < 4; ++j) { const int c = 4 * lane + 256 * j; const f32x4 x = *(const f32x4*)(sr + c), g1 = *(const f32x4*)(mr + 2048 + c); const v2u yw = *(const v2u*)(yrow + c);
        v[j][0] = DN_ALPHA * x[0] + g1[0] * bflo(yw.x); v[j][1] = DN_ALPHA * x[1] + g1[1] * bfhi(yw.x); v[j][2] = DN_ALPHA * x[2] + g1[2] * bflo(yw.y); v[j][3] = DN_ALPHA * x[3] + g1[3] * bfhi(yw.y);
        s += (v[j][0] + v[j][1]) + (v[j][2] + v[j][3]); }
    const float mean = wave_sum(s) * (1.f / D); float s2 = 0.f;
#pragma unroll
    for (int j = 0; j < 4; ++j) { v[j] = v[j] - mean; s2 += (v[j][0] * v[j][0] + v[j][1] * v[j][1]) + (v[j][2] * v[j][2] + v[j][3] * v[j][3]); }
    const float rstd = 1.f / sqrtf(wave_sum(s2) * (1.f / D) + LN_EPS);
    if (active) {
#pragma unroll
    for (int j = 0; j < 4; ++j) { const int c = 4 * lane + 256 * j; const f32x4 w = *(const f32x4*)(lnw + c), bb = *(const f32x4*)(lnb + c);
        const f32x4 x1 = v[j] * rstd * w + bb; if (!dry) *(f32x4*)(xr + c) = x1;
        const f32x4 sh = *(const f32x4*)(mr + 3072 + c), sc = *(const f32x4*)(mr + 4096 + c); const f32x4 hp = x1 * (sc + 1.0f) + sh;
        v2u o; o.x = pk2(hp[0], hp[1]); o.y = pk2(hp[2], hp[3]); if (!dry) *(v2u*)(hrow + c) = o; }
    }
}
__device__ __forceinline__ void ln_phase(const float* slat, const float* sctx, float* lat, float* ctx, const bf16* Y, const float* mod, const float* lnw, const float* lnb, bf16* HB, int gw, int NGW, int lane, int dry, bool lat_only) {
    const int nrows = lat_only ? NB * SEQ : TT;
    for (int i0 = gw; i0 < nrows; i0 += 2 * NGW) {
        const int i1 = i0 + NGW; const bool has1 = i1 < nrows; const int r0 = map_row(i0, lat_only), r1c = map_row(has1 ? i1 : i0, lat_only);
        const int b0 = r0 / PB, p0 = r0 - b0 * PB, b1 = r1c / PB, p1 = r1c - b1 * PB;
        ln_row(srow_c(slat, sctx, r0), srow(lat, ctx, r0), Y + (size_t)r0 * D, mod + (size_t)(p0 < LC ? 8 : b0) * 6144, lnw, lnb, HB + (size_t)r0 * D, lane, dry, true);
        ln_row(srow_c(slat, sctx, r1c), srow(lat, ctx, r1c), Y + (size_t)r1c * D, mod + (size_t)(p1 < LC ? 8 : b1) * 6144, lnw, lnb, HB + (size_t)r1c * D, lane, dry, has1);
    }
}

constexpr int AT_LD = 72;
__device__ __forceinline__ bf16x8 frag_tr_perm(const LAS bf16* t, int ld, int r0, int c0, int lane) {
    const int g = lane >> 4, q = (lane & 15) >> 2, p = lane & 3;
    const LAS bf16* a = t + (r0 + 4 * g + q) * ld + c0 + 4 * p;
    const s16x4 lo = __builtin_amdgcn_ds_read_tr16_b64_v4i16((LAS s16x4*)a);
    const s16x4 hi = __builtin_amdgcn_ds_read_tr16_b64_v4i16((LAS s16x4*)(a + 16 * ld));
    return (bf16x8){lo[0], lo[1], lo[2], lo[3], hi[0], hi[1], hi[2], hi[3]};
}
__device__ __forceinline__ void attn_phase(const bf16* P, bf16* CAT, const float* sink, const float* ropetab, LAS unsigned char* lds, unsigned* qctr, int vcu, int G, int wave, int lane, int tid) {
    LAS bf16* Kt = (LAS bf16*)lds;
    LAS bf16* Vt = (LAS bf16*)(lds + 9216);
    LAS bf16* Qw = (LAS bf16*)(lds + 18432 + wave * 4608);
    const int g = lane >> 4, c16 = lane & 15;
    volatile LAS int* qslot = (volatile LAS int*)(lds + MISC_OFF) + 12;
    for (;;) {
        if (tid == 0) *qslot = (int)__hip_atomic_fetch_add(qctr, 1u, __ATOMIC_RELAXED, __HIP_MEMORY_SCOPE_AGENT);
        __syncthreads();
        const int item = *qslot;
        if (item >= 1024 + 64) break;
        const bool is_ctx = item >= 1024;
        int b, hk, nb;
        if (!is_ctx) { b = item >> 7; hk = (item >> 6) & 1; nb = item & 63; } else { const int it = item - 1024; b = it >> 3; hk = (it >> 2) & 1; nb = it & 3; }
        const int head = hk * 4 + (wave >> 1);
        const int qrow0 = b * PB + (is_ctx ? 0 : LC) + nb * 64 + (wave & 1) * 32;
        const int qlat0 = nb * 64 + (wave & 1) * 32;
        __syncthreads();
#pragma unroll
        for (int i = 0; i < 4; ++i) { const int cidx = lane + 64 * i, rr = cidx >> 3, ch = cidx & 7;
            const v4u raw = *(const v4u*)(P + (size_t)(qrow0 + rr) * N_AB + 2048 + head * 64 + ch * 8); v4u o = raw;
            if (!is_ctx) { const int tl = qlat0 + rr; const int pos = (ch < 4) ? (tl >> 6) : (tl & 63); const float* tb = ropetab + (size_t)(pos * 16 + (ch & 3) * 4) * 2;
                const unsigned wv[4] = {raw.x, raw.y, raw.z, raw.w}; unsigned ov[4];
#pragma unroll
                for (int k = 0; k < 4; ++k) { const float x1 = bflo(wv[k]), x2 = bfhi(wv[k]), c = tb[2 * k], s = tb[2 * k + 1]; ov[k] = pk2(x1 * c - x2 * s, x1 * s + x2 * c); }
                o.x = ov[0]; o.y = ov[1]; o.z = ov[2]; o.w = ov[3]; }
            *(LAS v4u*)(Qw + rr * AT_LD + ch * 8) = o; }
        LDS_FENCE();
        bf16x8 qf[2][2];
#pragma unroll
        for (int mt = 0; mt < 2; ++mt)
#pragma unroll
            for (int ks = 0; ks < 2; ++ks) qf[mt][ks] = frag_row(Qw, AT_LD, 16 * mt, 32 * ks, lane);
        LDS_FENCE();
        f32x4 o[2][4]; float mrun[2], lrun[2];
        const float sk = sink[head];
#pragma unroll
        for (int qt = 0; qt < 2; ++qt) { mrun[qt] = sk; lrun[qt] = 1.f; }
#pragma unroll
        for (int qt = 0; qt < 2; ++qt)
#pragma unroll
            for (int nt = 0; nt < 4; ++nt) o[qt][nt] = (f32x4){0.f, 0.f, 0.f, 0.f};
        const int nkt = is_ctx ? 4 : 9;
        const int srr = tid >> 3, sch = tid & 7;
        int kt = 0; f32x2 trope[4];
#pragma unroll
        for (int i = 0; i < 4; ++i) trope[i] = (f32x2){1.f, 0.f};
        v4u kraw = *(const v4u*)(P + (size_t)(b * PB + srr) * N_AB + 2560 + hk * 64 + sch * 8), vraw = *(const v4u*)(P + (size_t)(b * PB + srr) * N_AB + 2688 + hk * 64 + sch * 8);
        while (kt < nkt) {
            const int kp0 = nb * 64 - 128 + 64 * (kt - 4);
            int kn = kt + 1;
            while (kn < nkt && kn >= 4 && ((nb * 64 - 128 + 64 * (kn - 4)) < 0 || (nb * 64 - 128 + 64 * (kn - 4)) >= SEQ)) ++kn;
            __syncthreads();
            { v4u o = kraw;
              if (kt >= 4) { const unsigned wv[4] = {kraw.x, kraw.y, kraw.z, kraw.w}; unsigned ov[4];
#pragma unroll
                  for (int i = 0; i < 4; ++i) { const float x1 = bflo(wv[i]), x2 = bfhi(wv[i]), c = trope[i][0], sn = trope[i][1]; ov[i] = pk2(x1 * c - x2 * sn, x1 * sn + x2 * c); }
                  o.x = ov[0]; o.y = ov[1]; o.z = ov[2]; o.w = ov[3]; }
              *(LAS v4u*)(Kt + srr * AT_LD + sch * 8) = o; *(LAS v4u*)(Vt + srr * AT_LD + sch * 8) = vraw; }
            if (kn < nkt) { const int kpn = nb * 64 - 128 + 64 * (kn - 4); const int krn = b * PB + (kn < 4 ? 64 * kn : LC + kpn);
                kraw = *(const v4u*)(P + (size_t)(krn + srr) * N_AB + 2560 + hk * 64 + sch * 8); vraw = *(const v4u*)(P + (size_t)(krn + srr) * N_AB + 2688 + hk * 64 + sch * 8);
                if (kn >= 4) { const int tl = kpn + srr; const int pos = (sch < 4) ? (tl >> 6) : (tl & 63); const f32x2* tb = (const f32x2*)(ropetab + (size_t)(pos * 16 + (sch & 3) * 4) * 2);
#pragma unroll
                    for (int i = 0; i < 4; ++i) trope[i] = tb[i]; } }
            __syncthreads();
            const bool need_mask = (kt == 4) || (kt == 8);
            bf16x8 kf[4][2];
#pragma unroll
            for (int km = 0; km < 4; ++km)
#pragma unroll
                for (int ks = 0; ks < 2; ++ks) kf[km][ks] = frag_row(Kt, AT_LD, 16 * km, 32 * ks, lane);
            bf16x8 pa[2][2];
#pragma unroll
            for (int qt = 0; qt < 2; ++qt) {
                f32x4 st[4];
#pragma unroll
                for (int km = 0; km < 4; ++km) { st[km] = (f32x4){0.f, 0.f, 0.f, 0.f};
#pragma unroll
                    for (int ks = 0; ks < 2; ++ks) st[km] = mma(kf[km][ks], qf[qt][ks], st[km]); }
                if (need_mask) {
#pragma unroll
                    for (int km = 0; km < 4; ++km)
#pragma unroll
                        for (int r = 0; r < 4; ++r) { const int dq = (kp0 + 16 * km + 4 * g + r) - (qlat0 + 16 * qt + c16); if (dq > 128 || dq < -128) st[km][r] = -3.0e38f; } }
                float mx = fmaxf(fmaxf(fmaxf(st[0][0], st[0][1]), fmaxf(st[0][2], st[0][3])), fmaxf(fmaxf(st[1][0], st[1][1]), fmaxf(st[1][2], st[1][3])));
                mx = fmaxf(mx, fmaxf(fmaxf(fmaxf(st[2][0], st[2][1]), fmaxf(st[2][2], st[2][3])), fmaxf(fmaxf(st[3][0], st[3][1]), fmaxf(st[3][2], st[3][3]))));
                mx = fmaxf(mx, __shfl_xor(mx, 16)); mx = fmaxf(mx, __shfl_xor(mx, 32));
                const float mnew = fmaxf(mrun[qt], mx), alpha = __expf(mrun[qt] - mnew);
                float ps = 0.f;
#pragma unroll
                for (int km = 0; km < 4; ++km)
#pragma unroll
                    for (int r = 0; r < 4; ++r) { const float pv = __expf(st[km][r] - mnew); st[km][r] = pv; ps += pv; }
                ps += __shfl_xor(ps, 16); ps += __shfl_xor(ps, 32);
                lrun[qt] = lrun[qt] * alpha + ps; mrun[qt] = mnew;
#pragma unroll
                for (int ks2 = 0; ks2 < 2; ++ks2) { const unsigned w0 = pk2(st[2 * ks2][0], st[2 * ks2][1]), w1 = pk2(st[2 * ks2][2], st[2 * ks2][3]), w2 = pk2(st[2 * ks2 + 1][0], st[2 * ks2 + 1][1]), w3 = pk2(st[2 * ks2 + 1][2], st[2 * ks2 + 1][3]);
                    const v4u wv = (v4u){w0, w1, w2, w3}; pa[qt][ks2] = __builtin_bit_cast(bf16x8, wv); }
#pragma unroll
                for (int r = 0; r < 4; ++r) { const float ar = __shfl(alpha, (lane & 48) + 4 * g + r);
#pragma unroll
                    for (int nt = 0; nt < 4; ++nt) o[qt][nt][r] *= ar; }
            }
#pragma unroll
            for (int ks2 = 0; ks2 < 2; ++ks2) {
                bf16x8 vf[4];
#pragma unroll
                for (int nt = 0; nt < 4; ++nt) vf[nt] = frag_tr_perm(Vt, AT_LD, 32 * ks2, 16 * nt, lane);
#pragma unroll
                for (int qt = 0; qt < 2; ++qt)
#pragma unroll
                    for (int nt = 0; nt < 4; ++nt) o[qt][nt] = mma(pa[qt][ks2], vf[nt], o[qt][nt]); }
            LDS_FENCE();
            kt = kn;
        }
#pragma unroll
        for (int qt = 0; qt < 2; ++qt)
#pragma unroll
            for (int r = 0; r < 4; ++r) { const float inv = 1.f / __shfl(lrun[qt], (lane & 48) + 4 * g + r); bf16* orow = CAT + (size_t)(qrow0 + 16 * qt + 4 * g + r) * D + 512 + head * 64;
#pragma unroll
                for (int nt = 0; nt < 4; ++nt) orow[16 * nt + c16] = (bf16)f2bf(o[qt][nt][r] * inv); }
    }
}

__device__ __forceinline__ float wave_prefix_sum(float v) {
    v += __builtin_bit_cast(float, __builtin_amdgcn_update_dpp(0, __builtin_bit_cast(int, v), 0x111, 0xf, 0xf, true)); v += __builtin_bit_cast(float, __builtin_amdgcn_update_dpp(0, __builtin_bit_cast(int, v), 0x112, 0xf, 0xf, true));
    v += __builtin_bit_cast(float, __builtin_amdgcn_update_dpp(0, __builtin_bit_cast(int, v), 0x114, 0xf, 0xf, true)); v += __builtin_bit_cast(float, __builtin_amdgcn_update_dpp(0, __builtin_bit_cast(int, v), 0x118, 0xf, 0xf, true));
    v += __builtin_bit_cast(float, __builtin_amdgcn_update_dpp(0, __builtin_bit_cast(int, v), 0x142, 0xa, 0xf, false)); v += __builtin_bit_cast(float, __builtin_amdgcn_update_dpp(0, __builtin_bit_cast(int, v), 0x143, 0xc, 0xf, false));
    return v;
}
__device__ __forceinline__ float wave_prefix_max(float v) {
    const int ninf = (int)0xff800000u;
    v = fmaxf(v, __builtin_bit_cast(float, __builtin_amdgcn_update_dpp(ninf, __builtin_bit_cast(int, v), 0x111, 0xf, 0xf, false))); v = fmaxf(v, __builtin_bit_cast(float, __builtin_amdgcn_update_dpp(ninf, __builtin_bit_cast(int, v), 0x112, 0xf, 0xf, false)));
    v = fmaxf(v, __builtin_bit_cast(float, __builtin_amdgcn_update_dpp(ninf, __builtin_bit_cast(int, v), 0x114, 0xf, 0xf, false))); v = fmaxf(v, __builtin_bit_cast(float, __builtin_amdgcn_update_dpp(ninf, __builtin_bit_cast(int, v), 0x118, 0xf, 0xf, false)));
    v = fmaxf(v, __builtin_bit_cast(float, __builtin_amdgcn_update_dpp(ninf, __builtin_bit_cast(int, v), 0x142, 0xa, 0xf, false))); v = fmaxf(v, __builtin_bit_cast(float, __builtin_amdgcn_update_dpp(ninf, __builtin_bit_cast(int, v), 0x143, 0xc, 0xf, false)));
    return v;
}
__device__ __forceinline__ void mlstm_gate_scan(const float* GL  , const float* gate_b  , unsigned char* ws, int gw, int NGW, int lane) {
    float* BQ = (float*)(ws + WS_BQ); float* CQ = (float*)(ws + WS_CQ); float* EM = (float*)(ws + WS_EM); float* AI = (float*)(ws + WS_AI);
    float* AST = (float*)(ws + WS_AST); float* CL = (float*)(ws + WS_CL);
    for (int chain = gw; chain < 64; chain += NGW) {
        const int dir = chain >> 5, b = (chain >> 2) & 7, h = chain & 3;
        const float bi = gate_b[dir * 8 + h], bfg = gate_b[dir * 8 + 4 + h];
        float m_st = 0.f;
        float gi_n, gf_n;
        { const int j0 = dir == 0 ? 0 : 3; const int p0 = j0 * 64 + (dir == 0 ? lane : 63 - lane); const float* gr = GL + (size_t)(b * PB + p0) * 16 + dir * 8; gi_n = gr[h]; gf_n = gr[4 + h]; }
        for (int sc = 0; sc < NCH; ++sc) {
            const int j = dir == 0 ? sc : (sc < 4 ? 3 - sc : 71 - sc);
            const int p = j * 64 + (dir == 0 ? lane : 63 - lane);
            const float li = gi_n + bi, lf = logsigmoidf_(gf_n + bfg);
            if (sc + 1 < NCH) { const int sn = sc + 1; const int jn = dir == 0 ? sn : (sn < 4 ? 3 - sn : 71 - sn); const int pn = jn * 64 + (dir == 0 ? lane : 63 - lane);
                const float* gr = GL + (size_t)(b * PB + pn) * 16 + dir * 8; gi_n = gr[h]; gf_n = gr[4 + h]; }
            const float cum = wave_prefix_sum(lf);
            const float bb = li - cum; const float pm = wave_prefix_max(bb);
            const float c = fmaxf(m_st, pm);
            const size_t ti = (size_t)chain * PB + p;
            BQ[ti] = bb; CQ[ti] = c; EM[ti] = __expf(-(cum + c)); AI[ti] = __expf(m_st - c);
            const float cl = __builtin_bit_cast(float, __builtin_amdgcn_readlane(__builtin_bit_cast(int, c), 63)), tot = __builtin_bit_cast(float, __builtin_amdgcn_readlane(__builtin_bit_cast(int, cum), 63));
            if (lane == 0) { CL[chain * NCH + j] = cl; AST[chain * NCH + j] = __expf(m_st - cl); }
            m_st = tot + cl;
        }
    }
}


__device__ __forceinline__ float logsig_fast(float x) { return fminf(x, 0.f) - __logf(1.f + __expf(-fabsf(x))); }
__device__ __forceinline__ void gla_prep(bf16* P, bf16* QKR, const float* LOW  , const float* gate_up  , const float* gate_b  , unsigned char* ws,
                                         LAS unsigned char* lds, int vcu, int G, int tid, int dry) {
    float* ET = (float*)(ws + WS_ET);
    LAS float* lowt = (LAS float*)lds;
    LAS bf16* qs = (LAS bf16*)(lds + 8192);
    LAS bf16* ks = (LAS bf16*)(lds + 24576);
    LAS float* LA = (LAS float*)(lds + 40960);
    LAS float* HT = (LAS float*)(lds + 106496);
    const int dc = tid & 255, dir = dc >> 7, ch = dc & 127, half = tid >> 8;
    for (int item = vcu; item < NB * NCH * 4; item += G) {
        const int b = item / (NCH * 4), j = (item >> 2) % NCH, h = item & 3;
        const int row0 = b * PB + j * 64, c = h * 128 + ch;
        __syncthreads();
        for (int i = tid; i < 64 * 32; i += 512) lowt[i] = LOW[(size_t)row0 * 32 + i];
#pragma unroll
        for (int i = 0; i < 2; ++i) { const int cidx = tid + 512 * i, rr = cidx >> 4, c8 = cidx & 15; const bf16* src = P + (size_t)(row0 + rr) * N_C + h * 128 + c8 * 8;
            *(LAS v4u*)(qs + rr * 128 + c8 * 8) = *(const v4u*)src; *(LAS v4u*)(ks + rr * 128 + c8 * 8) = *(const v4u*)(src + 512); }
        float gu[16];
#pragma unroll
        for (int k = 0; k < 16; ++k) gu[k] = gate_up[(size_t)(dir * 16 + k) * 512 + c];
        const float gb = gate_b[dir * 512 + c];
        __syncthreads();
        float hsum = 0.f;
#pragma unroll 4
        for (int i = 0; i < 32; ++i) { const int t = half * 32 + i; float x = gb;
#pragma unroll
            for (int k = 0; k < 16; ++k) x += lowt[t * 32 + dir * 16 + k] * gu[k];
            const float la = logsig_fast(x) * (1.f / 16.f); LA[t * 256 + dc] = la; hsum += la; }
        HT[half * 256 + dc] = hsum;
        __syncthreads();
        float cum = (dir == 0) ? (half == 1 ? HT[dc] : 0.f) : (half == 0 ? HT[256 + dc] : 0.f);
#pragma unroll 4
        for (int i = 0; i < 32; ++i) { const int t = half * 32 + (dir == 0 ? i : 31 - i);
            cum += LA[t * 256 + dc];
            const float e = __expf(cum), ei = __expf(-cum);
            const size_t ro = (size_t)(row0 + t) * N_C;
            const float qv = bf2f(qs[t * 128 + ch]), kv = bf2f(ks[t * 128 + ch]);
            if (dir == 0) { if (!dry) { P[ro + c] = (bf16)f2bf(qv * e); P[ro + 512 + c] = (bf16)f2bf(kv * ei); } }
            else { QKR[(size_t)(row0 + t) * 1024 + c] = (bf16)f2bf(qv * e); QKR[(size_t)(row0 + t) * 1024 + 512 + c] = (bf16)f2bf(kv * ei); } }
        if (half == 0) ET[((size_t)((dir * 8 + b) * 4 + h) * NCH + j) * 128 + ch] = __expf(HT[dc] + HT[256 + dc]);
    }
}


__device__ __forceinline__ unsigned f2sort(float f) { const unsigned u = __builtin_bit_cast(unsigned, f); return (u & 0x80000000u) ? ~u : (u | 0x80000000u); }
__device__ __forceinline__ float sort2f(unsigned s) { const unsigned u = (s & 0x80000000u) ? (s & 0x7fffffffu) : ~s; return __builtin_bit_cast(float, u); }
template <int CTRL> __device__ __forceinline__ unsigned dppmov_u(unsigned x) { return (unsigned)__builtin_amdgcn_mov_dpp((int)x, CTRL, 0xf, 0xf, true); }
__device__ __forceinline__ unsigned gmax16(unsigned x) { unsigned y;
    y = dppmov_u<0xB1>(x); x = x > y ? x : y; y = dppmov_u<0x4E>(x); x = x > y ? x : y; y = dppmov_u<0x141>(x); x = x > y ? x : y; y = dppmov_u<0x128>(x); x = x > y ? x : y; return x; }
__device__ __forceinline__ float gsum16(float x) {
    x += __builtin_bit_cast(float, dppmov_u<0xB1>(__builtin_bit_cast(unsigned, x))); x += __builtin_bit_cast(float, dppmov_u<0x4E>(__builtin_bit_cast(unsigned, x)));
    x += __builtin_bit_cast(float, dppmov_u<0x141>(__builtin_bit_cast(unsigned, x))); x += __builtin_bit_cast(float, dppmov_u<0x128>(__builtin_bit_cast(unsigned, x))); return x; }
#define CSWAP(a, b) do { const unsigned hi_ = (a) > (b) ? (a) : (b), lo_ = (a) > (b) ? (b) : (a); (a) = hi_; (b) = lo_; } while (0)
__device__ __forceinline__ void peer_route(const bf16* Q, const bf16* KEYS, int* EID, float* GWT, int gw, int NGW, int lane, bool lat_only) {
    const int g = lane >> 4, c16 = lane & 15, gbase = lane & 48;
    const int nwi = (lat_only ? NB * SEQ / 16 : TT / 16) * 8;
    for (int wi = gw; wi < nwi; wi += NGW) {
        const int t0 = map_row((wi >> 3) * 16, lat_only), head = wi & 7;
        unsigned tops[2][4];
#pragma unroll
        for (int p = 0; p < 2; ++p) {
            const bf16* qrow = Q + (size_t)(t0 + c16) * 2048 + head * 256 + p * 128 + 8 * g;
            bf16x8 qf[4];
#pragma unroll
            for (int ks = 0; ks < 4; ++ks) qf[ks] = *(const bf16x8*)(qrow + 32 * ks);
            const bf16* kb = KEYS + (size_t)(head * 2 + p) * 128 * 128 + (size_t)c16 * 128 + 8 * g;
            unsigned key[8][4];
#pragma unroll
            for (int nt = 0; nt < 8; ++nt) { f32x4 s = (f32x4){0.f, 0.f, 0.f, 0.f};
#pragma unroll
                for (int ks = 0; ks < 4; ++ks) s = mma(qf[ks], *(const bf16x8*)(kb + (size_t)nt * 16 * 128 + 32 * ks), s);
#pragma unroll
                for (int r = 0; r < 4; ++r) key[nt][r] = (f2sort(s[r]) & ~127u) | (unsigned)(127 - (16 * nt + c16)); }
            unsigned kk[4][8];
#pragma unroll
            for (int r = 0; r < 4; ++r) {
#pragma unroll
                for (int nt = 0; nt < 8; ++nt) kk[r][nt] = key[nt][r];
                CSWAP(kk[r][0], kk[r][1]); CSWAP(kk[r][2], kk[r][3]); CSWAP(kk[r][4], kk[r][5]); CSWAP(kk[r][6], kk[r][7]); CSWAP(kk[r][0], kk[r][2]); CSWAP(kk[r][1], kk[r][3]); CSWAP(kk[r][4], kk[r][6]); CSWAP(kk[r][5], kk[r][7]);
                CSWAP(kk[r][1], kk[r][2]); CSWAP(kk[r][5], kk[r][6]); CSWAP(kk[r][0], kk[r][4]); CSWAP(kk[r][1], kk[r][5]); CSWAP(kk[r][2], kk[r][6]); CSWAP(kk[r][3], kk[r][7]); CSWAP(kk[r][2], kk[r][4]); CSWAP(kk[r][3], kk[r][5]);
                CSWAP(kk[r][1], kk[r][2]); CSWAP(kk[r][3], kk[r][4]); CSWAP(kk[r][5], kk[r][6]); }
            unsigned tt[4] = {0u, 0u, 0u, 0u};
#pragma unroll 2
            for (int rd = 0; rd < 16; ++rd) {
#pragma unroll
                for (int r = 0; r < 4; ++r) { const unsigned m = gmax16(kk[r][0]); const bool w = (kk[r][0] == m);
#pragma unroll
                    for (int q = 0; q < 7; ++q) kk[r][q] = w ? kk[r][q + 1] : kk[r][q];
                    kk[r][7] = w ? 0u : kk[r][7];
                    tt[r] = (c16 == rd) ? m : tt[r]; } }
#pragma unroll
            for (int r = 0; r < 4; ++r) tops[p][r] = tt[r];
        }
        float v0[4], s1v[4]; int ptr[4]; unsigned res[4];
#pragma unroll
        for (int r = 0; r < 4; ++r) { v0[r] = sort2f(tops[0][r] & ~127u); s1v[r] = sort2f((unsigned)__shfl((int)tops[1][r], gbase) & ~127u); ptr[r] = 0; res[r] = 0u; }
#pragma unroll 2
        for (int rd = 0; rd < 16; ++rd) {
#pragma unroll
            for (int r = 0; r < 4; ++r) {
                const unsigned ck = ptr[r] < 16 ? ((f2sort(v0[r] + s1v[r]) & ~255u) | (unsigned)((15 - c16) << 4) | (unsigned)(15 - ptr[r])) : 0u;
                const unsigned m = gmax16(ck);
                res[r] = (c16 == rd) ? m : res[r];
                if (ck == m) ++ptr[r];
                s1v[r] = sort2f((unsigned)__shfl((int)tops[1][r], gbase + (ptr[r] < 15 ? ptr[r] : 15)) & ~127u); } }
#pragma unroll
        for (int r = 0; r < 4; ++r) {
            const float val = sort2f(res[r] & ~255u); const int ii = 15 - (int)((res[r] >> 4) & 15u), jj = 15 - (int)(res[r] & 15u);
            const float mx = __shfl(val, gbase);
            const float ex = __expf(val - mx), sum = gsum16(ex);
            const unsigned i0 = 127u - ((unsigned)__shfl((int)tops[0][r], gbase + ii) & 127u), i1 = 127u - ((unsigned)__shfl((int)tops[1][r], gbase + jj) & 127u);
            const size_t o = (size_t)(t0 + 4 * g + r) * 128 + head * 16 + c16;
            EID[o] = (int)(i0 * 128u + i1); GWT[o] = ex / sum;
        }
    }
}

__device__ __forceinline__ void unpack8(const v4u w, float* o) { o[0] = bflo(w.x); o[1] = bfhi(w.x); o[2] = bflo(w.y); o[3] = bfhi(w.y); o[4] = bflo(w.z); o[5] = bfhi(w.z); o[6] = bflo(w.w); o[7] = bfhi(w.w); }
__device__ __forceinline__ int rev3(int x) { return ((x & 1) << 2) | (x & 2) | ((x >> 2) & 1); }
typedef int v8i __attribute__((ext_vector_type(8)));
constexpr int P1_SLOT = 528, P1_BUF = 16 * P1_SLOT, P1_HQ = 2 * P1_BUF, P1_DOTS = P1_HQ, P1_WAVE_LDS = P1_HQ + 3072;
__device__ __forceinline__ int p1_sigma(int j) { return j < 8 ? (j ^ 4) : j; }
__device__ __forceinline__ void peer_pass1(const bf16* HB, const int* EID, const float* GWT, const unsigned char* U4, const float* SUi, const float* SVi, float* COEF,
                                           LAS unsigned char* lds, int wave, int gw, int NGW, int lane, bool lat_only) {
    LAS unsigned char* wl = lds + wave * P1_WAVE_LDS;
    LAS float* dots = (LAS float*)(wl + P1_DOTS);
    const int n = lane & 15, g = lane >> 4;
    const int nrows = lat_only ? NB * SEQ : TT;
    const unsigned aoff = (unsigned)(p1_sigma(n) * P1_SLOT + 128 * g);
    const unsigned boff = (unsigned)(P1_HQ + (n < 6 ? 512 * n : 0) + 128 * g);
    const float wn = n == 0 ? 1.f : (n == 1 ? 0.25f : (n == 2 ? 0.0625f : (n == 3 ? 0.015625f : (n == 4 ? 0.00390625f : (n == 5 ? 0.0009765625f : 0.f)))));
    int ri = gw;
    if (ri >= nrows) return;
    int r = map_row(ri, lat_only);
    v4u hn0 = *(const v4u*)(HB + (size_t)r * D + 16 * lane), hn1 = *(const v4u*)(HB + (size_t)r * D + 16 * lane + 8);
    int eidAn = EID[(size_t)r * 128 + lane], eidBn = EID[(size_t)r * 128 + 64 + lane];
#define P1_DMA(src_e, base_, bufo_) do { int ids_[16]; _Pragma("unroll") for (int j_ = 0; j_ < 16; ++j_) ids_[j_] = __builtin_amdgcn_readlane((src_e), (base_) + j_); \
        if (lane < 32) { _Pragma("unroll") for (int j_ = 0; j_ < 16; ++j_) \
        __builtin_amdgcn_global_load_lds((const unsigned*)(U4 + (size_t)ids_[j_] * 512 + 16 * lane), (LAS unsigned*)(wl + (bufo_) + p1_sigma(j_) * P1_SLOT), 16, 0, 0); } } while (0)
    P1_DMA(eidAn, 0, 0); P1_DMA(eidAn, 16, P1_BUF);
    for (; ri < nrows; ri += NGW) {
        r = map_row(ri, lat_only);
        const int eidA = eidAn, eidB = eidBn;
        { float h[16]; unpack8(hn0, h); unpack8(hn1, h + 8);
#pragma unroll
          for (int part = 0; part < 6; ++part) {
              unsigned w[2];
#pragma unroll
              for (int d = 0; d < 2; ++d) { unsigned t = 0u;
                  t = __builtin_amdgcn_cvt_scalef32_pk_fp4_f32(t, h[8 * d], h[8 * d + 1], 1.0f, 0); t = __builtin_amdgcn_cvt_scalef32_pk_fp4_f32(t, h[8 * d + 2], h[8 * d + 3], 1.0f, 1);
                  t = __builtin_amdgcn_cvt_scalef32_pk_fp4_f32(t, h[8 * d + 4], h[8 * d + 5], 1.0f, 2); t = __builtin_amdgcn_cvt_scalef32_pk_fp4_f32(t, h[8 * d + 6], h[8 * d + 7], 1.0f, 3);
                  w[d] = t; }
              *(LAS v2u*)(wl + P1_HQ + 512 * part + 8 * lane) = (v2u){w[0], w[1]};
              if (part < 5) {
#pragma unroll
                  for (int d = 0; d < 2; ++d) {
                      const f32x2 q0 = __builtin_amdgcn_cvt_scalef32_pk_f32_fp4(w[d], 1.0f, 0), q1 = __builtin_amdgcn_cvt_scalef32_pk_f32_fp4(w[d], 1.0f, 1);
                      const f32x2 q2 = __builtin_amdgcn_cvt_scalef32_pk_f32_fp4(w[d], 1.0f, 2), q3 = __builtin_amdgcn_cvt_scalef32_pk_f32_fp4(w[d], 1.0f, 3);
                      h[8 * d] = (h[8 * d] - q0[0]) * 4.f; h[8 * d + 1] = (h[8 * d + 1] - q0[1]) * 4.f; h[8 * d + 2] = (h[8 * d + 2] - q1[0]) * 4.f; h[8 * d + 3] = (h[8 * d + 3] - q1[1]) * 4.f;
                      h[8 * d + 4] = (h[8 * d + 4] - q2[0]) * 4.f; h[8 * d + 5] = (h[8 * d + 5] - q2[1]) * 4.f; h[8 * d + 6] = (h[8 * d + 6] - q3[0]) * 4.f; h[8 * d + 7] = (h[8 * d + 7] - q3[1]) * 4.f; } } } }
        const float gwtA = GWT[(size_t)r * 128 + lane], gwtB = GWT[(size_t)r * 128 + 64 + lane];
        const float suA = SUi[eidA], suB = SUi[eidB], svA = SVi[eidA], svB = SVi[eidB];
        const int rin = ri + NGW; const bool more = rin < nrows; const int rn = map_row(more ? rin : ri, lat_only);
        hn0 = *(const v4u*)(HB + (size_t)rn * D + 16 * lane); hn1 = *(const v4u*)(HB + (size_t)rn * D + 16 * lane + 8);
        eidAn = EID[(size_t)rn * 128 + lane]; eidBn = EID[(size_t)rn * 128 + 64 + lane];
        LDS_FENCE();
        v4u bw[8];
#pragma unroll
        for (int c = 0; c < 8; ++c) bw[c] = *(LAS const v4u*)(wl + boff + 16 * c);
#pragma unroll 1
        for (int G = 0; G < 8; ++G) {
            if (G < 7 || more) asm volatile("s_waitcnt vmcnt(16)" ::: "memory"); else asm volatile("s_waitcnt vmcnt(0)" ::: "memory");
            const unsigned bufo = (G & 1) ? (unsigned)P1_BUF : 0u;
            v4u aw[8];
#pragma unroll
            for (int c = 0; c < 8; ++c) aw[c] = *(LAS const v4u*)(wl + bufo + aoff + 16 * c);
            asm volatile("s_waitcnt lgkmcnt(0)" ::: "memory");
            { const int srcsel = G < 2 ? eidA : (G < 6 ? eidB : eidAn); const int base = 16 * ((G + 2) & 3);
              if (G < 6 || more) { if (G & 1) P1_DMA(srcsel, base, P1_BUF); else P1_DMA(srcsel, base, 0); } }
            f32x4 acc = (f32x4){0.f, 0.f, 0.f, 0.f};
#pragma unroll
            for (int c = 0; c < 8; ++c) {
                const v8i A = (v8i){(int)aw[c].x, (int)aw[c].y, (int)aw[c].z, (int)aw[c].w, 0, 0, 0, 0};
                const v8i Bv = (v8i){(int)bw[c].x, (int)bw[c].y, (int)bw[c].z, (int)bw[c].w, 0, 0, 0, 0};
                acc = __builtin_amdgcn_mfma_scale_f32_16x16x128_f8f6f4(A, Bv, acc, 4, 4, 0, 0, 0, 0); }
            f32x4 dv;
#pragma unroll
            for (int k = 0; k < 4; ++k) dv[k] = gsum16(acc[k] * wn);
            if (n == 0) *(LAS f32x4*)(dots + 16 * G + 4 * g) = dv;
        }
        LDS_FENCE();
        { const float dot = dots[lane] * suA; COEF[(size_t)r * 128 + lane] = gwtA * 0.5f * dot * (1.f + erff(dot * 0.70710678118f)) * svA; }
        { const float dot = dots[64 + lane] * suB; COEF[(size_t)r * 128 + 64 + lane] = gwtB * 0.5f * dot * (1.f + erff(dot * 0.70710678118f)) * svB; }
    }
#undef P1_DMA
}
template <bool USE_PEER>
__device__ __forceinline__ void peer_expert(const float* COEF, const int* EID, const unsigned char* V6,
                                            float* lat, float* ctx, const float* mod, const float* lnw, const float* lnb, int gw, int NGW, int lane, int dry, bool lat_only) {
    const int myslot = 8 * (lane & 7) + rev3(lane >> 3);
    const int nrows = lat_only ? NB * SEQ : TT;
    for (int ri = gw; ri < nrows; ri += NGW) {
        const int r = map_row(ri, lat_only);
        const int b = r / PB, p = r - b * PB; float* xr = srow(lat, ctx, r); const float* mr = mod + (size_t)(p < LC ? 8 : b) * 6144;
        float f[16];
#pragma unroll
        for (int i = 0; i < 16; ++i) f[i] = 0.f;
        if (USE_PEER) {
#pragma unroll 1
        for (int half = 0; half < 2; ++half) {
            const int eid = EID[(size_t)r * 128 + half * 64 + myslot];
            const float coef = COEF[(size_t)r * 128 + half * 64 + myslot];
            v2u ring[8];
#pragma unroll
            for (int k = 0; k < 8; ++k) { const int id = __builtin_amdgcn_readlane(eid, k); ring[k] = *(const v2u*)(V6 + (size_t)id * 512 + 8 * lane); }
#pragma unroll 1
            for (int e0 = 0; e0 < 64; e0 += 8) {
#pragma unroll
                for (int k = 0; k < 8; ++k) {
                    const float c0 = __builtin_bit_cast(float, __builtin_amdgcn_readlane(__builtin_bit_cast(int, coef), e0 + k));
                    const unsigned w0 = ring[k].x, w1 = ring[k].y;
                    const f32x2 q0 = __builtin_amdgcn_cvt_scalef32_pk_f32_fp4(w0, 1.0f, 0), q1 = __builtin_amdgcn_cvt_scalef32_pk_f32_fp4(w0, 1.0f, 1), q2 = __builtin_amdgcn_cvt_scalef32_pk_f32_fp4(w0, 1.0f, 2), q3 = __builtin_amdgcn_cvt_scalef32_pk_f32_fp4(w0, 1.0f, 3);
                    const f32x2 q4 = __builtin_amdgcn_cvt_scalef32_pk_f32_fp4(w1, 1.0f, 0), q5 = __builtin_amdgcn_cvt_scalef32_pk_f32_fp4(w1, 1.0f, 1), q6 = __builtin_amdgcn_cvt_scalef32_pk_f32_fp4(w1, 1.0f, 2), q7 = __builtin_amdgcn_cvt_scalef32_pk_f32_fp4(w1, 1.0f, 3);
                    const int en0 = (e0 + 8 + k) < 64 ? (e0 + 8 + k) : 63; const int idn0 = __builtin_amdgcn_readlane(eid, en0);
                    ring[k] = *(const v2u*)(V6 + (size_t)idn0 * 512 + 8 * lane);
                    f[0] += c0 * q0[0]; f[1] += c0 * q0[1]; f[2] += c0 * q1[0]; f[3] += c0 * q1[1]; f[4] += c0 * q2[0]; f[5] += c0 * q2[1]; f[6] += c0 * q3[0]; f[7] += c0 * q3[1];
                    f[8] += c0 * q4[0]; f[9] += c0 * q4[1]; f[10] += c0 * q5[0]; f[11] += c0 * q5[1]; f[12] += c0 * q6[0]; f[13] += c0 * q6[1]; f[14] += c0 * q7[0]; f[15] += c0 * q7[1];
                    __builtin_amdgcn_sched_barrier(0); }
            }
        }
        }
        float v[16]; float s = 0.f;
#pragma unroll
        for (int q = 0; q < 4; ++q) { const int c = 16 * lane + 4 * q; const f32x4 x1 = *(const f32x4*)(xr + c), g2 = *(const f32x4*)(mr + 5120 + c);
#pragma unroll
            for (int i = 0; i < 4; ++i) { v[4 * q + i] = DN_ALPHA * x1[i] + g2[i] * f[4 * q + i]; s += v[4 * q + i]; } }
        const float mean = wave_sum(s) * (1.f / D); float s2 = 0.f;
#pragma unroll
        for (int i = 0; i < 16; ++i) { v[i] -= mean; s2 += v[i] * v[i]; }
        const float rstd = 1.f / sqrtf(wave_sum(s2) * (1.f / D) + LN_EPS);
#pragma unroll
        for (int q = 0; q < 4; ++q) { const int c = 16 * lane + 4 * q; const f32x4 w = *(const f32x4*)(lnw + c), bb2 = *(const f32x4*)(lnb + c); f32x4 o;
#pragma unroll
            for (int i = 0; i < 4; ++i) o[i] = v[4 * q + i] * rstd * w[i] + bb2[i];
            if (!dry) *(f32x4*)(xr + c) = o; }
    }
}

__device__ __forceinline__ bf16* od_row_base(unsigned char* ws, int dir, int b) {
    if (dir == 0) return (bf16*)(ws + WS_ST) + (size_t)b * SEQ * 1024;
    return b < 7 ? (bf16*)(ws + WS_ST + 64 * MiB) + (size_t)b * SEQ * 1024 : (bf16*)(ws + WS_XC);
}
__device__ __forceinline__ void gla_fused_scan(const bf16* P, const bf16* QKR, unsigned char* ws, LAS unsigned char* lds, int vcu, int G, int wave, int lane, int tid, int dry) {
    const float* ET = (const float*)(ws + WS_ET);
    LAS bf16* Qt = (LAS bf16*)lds;
    LAS bf16* Kt = (LAS bf16*)(lds + 34816);
    LAS bf16* Vt = (LAS bf16*)(lds + 69632);
    LAS bf16* SL = (LAS bf16*)(lds + 88064);
    LAS bf16* Pw = (LAS bf16*)(lds + 122880 + wave * 2304);
    const int g = lane >> 4, c16 = lane & 15, mt = wave & 3, cw = wave >> 2;
    for (int item = vcu; item < 256; item += G) {
        const int dir = item >> 7, b = (item >> 4) & 7, h = (item >> 2) & 3, eb = item & 3;
        const bf16* qsrc = dir == 0 ? P + h * 128 : QKR + h * 128; const int qld = dir == 0 ? N_C : 1024;
        const bf16* vsrc = P + 1024 + h * 256 + 64 * eb;
        const float* etp = ET + ((size_t)((dir * 8 + b) * 4 + h) * NCH) * 128 + 16 * wave + c16;
        bf16* odb = od_row_base(ws, dir, b) + h * 256 + 64 * eb;
        f32x4 acc[4];
#pragma unroll
        for (int et = 0; et < 4; ++et) acc[et] = (f32x4){0.f, 0.f, 0.f, 0.f};
        v4u qreg[2][2], kreg[2][2], vreg[2]; float etn[2];
#define GLA_JOF(sc_) (dir == 0 ? (sc_) : ((sc_) < 4 ? 3 - (sc_) : 71 - (sc_)))
#define GLA_PREFETCH(sc0_) do { _Pragma("unroll") for (int u = 0; u < 2; ++u) { const int jj = GLA_JOF((sc0_) + u); const int row0 = b * PB + jj * 64; \
            _Pragma("unroll") for (int i = 0; i < 2; ++i) { const int cidx = tid + 512 * i, rr = cidx >> 4, ch = cidx & 15; const bf16* sp = qsrc + (size_t)(row0 + rr) * qld + ch * 8; qreg[u][i] = *(const v4u*)sp; kreg[u][i] = *(const v4u*)(sp + 512); } \
            vreg[u] = *(const v4u*)(vsrc + (size_t)(row0 + (tid >> 3)) * N_C + (tid & 7) * 8); etn[u] = etp[(size_t)jj * 128]; } } while (0)
        GLA_PREFETCH(0);
        unsigned opk[8]; int ojc = -1;
#pragma unroll
        for (int i = 0; i < 8; ++i) opk[i] = 0u;
        for (int sc = 0; sc < NCH; sc += 2) {
            const int ja = GLA_JOF(sc), jb = GLA_JOF(sc + 1);
            __syncthreads();
            if (ojc >= 4 && !dry) {
#pragma unroll
                for (int nt = 0; nt < 4; ++nt) { bf16* orow = odb + (size_t)((ojc - 4) * 64 + 16 * mt + 4 * g) * 1024 + 16 * nt + c16;
#pragma unroll
                    for (int r = 0; r < 4; ++r) orow[(size_t)r * 1024] = (bf16)((opk[2 * nt + (r >> 1)] >> (16 * (r & 1))) & 0xffffu); } }
#pragma unroll
            for (int u = 0; u < 2; ++u) {
#pragma unroll
                for (int i = 0; i < 2; ++i) { const int cidx = tid + 512 * i, rr = cidx >> 4, ch = cidx & 15; *(LAS v4u*)(Qt + u * 8704 + rr * 136 + ch * 8) = qreg[u][i]; *(LAS v4u*)(Kt + u * 8704 + rr * 136 + ch * 8) = kreg[u][i]; }
                *(LAS v4u*)(Vt + u * 4608 + (tid >> 3) * 72 + (tid & 7) * 8) = vreg[u]; }
#pragma unroll
            for (int et = 0; et < 4; ++et)
#pragma unroll
                for (int r = 0; r < 4; ++r) SL[(16 * et + 4 * g + r) * 136 + 16 * wave + c16] = (bf16)f2bf(acc[et][r]);
            const float et_a = etn[0], et_b = etn[1];
            if (sc + 2 < NCH) GLA_PREFETCH(sc + 2);
            __syncthreads();
#pragma unroll
            for (int ks = 0; ks < 2; ++ks) { const bf16x8 kb = frag_tr(Kt, 136, 32 * ks, 16 * wave, lane);
#pragma unroll
                for (int et = 0; et < 4; ++et) acc[et] = mma(frag_tr(Vt, 72, 32 * ks, 16 * et, lane), kb, acc[et]); }
#pragma unroll
            for (int et = 0; et < 4; ++et) { acc[et] = acc[et] * et_a;
#pragma unroll
                for (int r = 0; r < 4; ++r) SL[8704 + (16 * et + 4 * g + r) * 136 + 16 * wave + c16] = (bf16)f2bf(acc[et][r]); }
            __syncthreads();
            const int jc = cw == 0 ? ja : jb;
            ojc = jc;
            if (jc >= 4) {
                const LAS bf16* Qc = Qt + cw * 8704; const LAS bf16* Kc = Kt + cw * 8704; const LAS bf16* Vc = Vt + cw * 4608; const LAS bf16* Sc = SL + cw * 8704;
                bf16x8 qf[4];
#pragma unroll
                for (int ks = 0; ks < 4; ++ks) qf[ks] = frag_row(Qc, 136, 16 * mt, 32 * ks, lane);
                bf16x8 pa[2];
                { f32x4 st[4];
#pragma unroll
                  for (int ns = 0; ns < 4; ++ns) { st[ns] = (f32x4){0.f, 0.f, 0.f, 0.f};
#pragma unroll
                      for (int ks = 0; ks < 4; ++ks) st[ns] = mma(frag_row(Kc, 136, 16 * ns, 32 * ks, lane), qf[ks], st[ns]);
#pragma unroll
                      for (int r = 0; r < 4; ++r) { const int sidx = 16 * ns + 4 * g + r, t = 16 * mt + c16; const bool ok = dir == 0 ? (sidx <= t) : (sidx >= t); st[ns][r] = ok ? st[ns][r] : 0.f; } }
#pragma unroll
                  for (int ks2 = 0; ks2 < 2; ++ks2) { const v4u wv = (v4u){pk2(st[2 * ks2][0], st[2 * ks2][1]), pk2(st[2 * ks2][2], st[2 * ks2][3]), pk2(st[2 * ks2 + 1][0], st[2 * ks2 + 1][1]), pk2(st[2 * ks2 + 1][2], st[2 * ks2 + 1][3])};
                      pa[ks2] = __builtin_bit_cast(bf16x8, wv); } }
#pragma unroll
                for (int nt = 0; nt < 4; ++nt) { f32x4 a = (f32x4){0.f, 0.f, 0.f, 0.f};
#pragma unroll
                    for (int ks = 0; ks < 4; ++ks) a = mma(qf[ks], frag_row(Sc, 136, 16 * nt, 32 * ks, lane), a);
                    a = mma(pa[0], frag_tr_perm(Vc, 72, 0, 16 * nt, lane), a); a = mma(pa[1], frag_tr_perm(Vc, 72, 32, 16 * nt, lane), a);
                    opk[2 * nt] = pk2(a[0], a[1]); opk[2 * nt + 1] = pk2(a[2], a[3]); }
                LDS_FENCE();
            }
#pragma unroll
            for (int ks = 0; ks < 2; ++ks) { const bf16x8 kb = frag_tr(Kt + 8704, 136, 32 * ks, 16 * wave, lane);
#pragma unroll
                for (int et = 0; et < 4; ++et) acc[et] = mma(frag_tr(Vt + 4608, 72, 32 * ks, 16 * et, lane), kb, acc[et]); }
#pragma unroll
            for (int et = 0; et < 4; ++et) acc[et] = acc[et] * et_b;
        }
        if (ojc >= 4 && !dry) {
#pragma unroll
            for (int nt = 0; nt < 4; ++nt) { bf16* orow = odb + (size_t)((ojc - 4) * 64 + 16 * mt + 4 * g) * 1024 + 16 * nt + c16;
#pragma unroll
                for (int r = 0; r < 4; ++r) orow[(size_t)r * 1024] = (bf16)((opk[2 * nt + (r >> 1)] >> (16 * (r & 1))) & 0xffffu); } }
#undef GLA_PREFETCH
#undef GLA_JOF
    }
}
__device__ __forceinline__ void gla_merge(bf16* P, const float* norm_w, unsigned char* ws, int gw, int NGW, int lane, int dry) {
    for (int i = gw; i < NB * SEQ; i += NGW) {
        const int b = i >> 12, lp = i & 4095; const size_t r = (size_t)b * PB + LC + lp;
        const bf16* of = od_row_base(ws, 0, b) + (size_t)lp * 1024 + 16 * lane; const bf16* orv = od_row_base(ws, 1, b) + (size_t)lp * 1024 + 16 * lane;
        bf16* grow = P + r * N_C + 2048 + 16 * lane;
        float x[16], y[16], gg[16];
        unpack8(*(const v4u*)of, x); unpack8(*(const v4u*)(of + 8), x + 8); unpack8(*(const v4u*)orv, y); unpack8(*(const v4u*)(orv + 8), y + 8);
        unpack8(*(const v4u*)grow, gg); unpack8(*(const v4u*)(grow + 8), gg + 8);
        float ss = 0.f;
#pragma unroll
        for (int k = 0; k < 16; ++k) { x[k] += y[k]; ss += x[k] * x[k]; }
        ss = gsum16(ss);
        const float rn = 1.f / sqrtf(ss * (1.f / 256.f) + LN_EPS);
        unsigned ow[8];
#pragma unroll
        for (int k = 0; k < 8; ++k) { const float4 dummy = make_float4(0.f, 0.f, 0.f, 0.f); (void)dummy;
            const float a = x[2 * k] * rn * norm_w[16 * lane + 2 * k] * siluf_(gg[2 * k]), c = x[2 * k + 1] * rn * norm_w[16 * lane + 2 * k + 1] * siluf_(gg[2 * k + 1]); ow[k] = pk2(a, c); }
        if (!dry) { v4u o0, o1; o0.x = ow[0]; o0.y = ow[1]; o0.z = ow[2]; o0.w = ow[3]; o1.x = ow[4]; o1.y = ow[5]; o1.z = ow[6]; o1.w = ow[7]; *(v4u*)grow = o0; *(v4u*)(grow + 8) = o1; }
    }
}

__device__ __forceinline__ void mlstm_fused_scan(const bf16* P, unsigned char* ws, LAS unsigned char* lds, int vcu, int G, int wave, int lane, int tid) {
    const float* BQ = (const float*)(ws + WS_BQ); const float* CQ = (const float*)(ws + WS_CQ); const float* EM = (const float*)(ws + WS_EM); const float* AI = (const float*)(ws + WS_AI);
    const float* AST = (const float*)(ws + WS_AST); const float* CL = (const float*)(ws + WS_CL);
    LAS bf16* Qt = (LAS bf16*)lds;
    LAS bf16* Kt = (LAS bf16*)(lds + 17408);
    LAS bf16* Vt = (LAS bf16*)(lds + 34816);
    LAS bf16* Vw = (LAS bf16*)(lds + 41984);
    LAS bf16* CT = (LAS bf16*)(lds + 49152);
    LAS bf16* Pw = (LAS bf16*)(lds + 62208 + wave * 2304);
    const int g = lane >> 4, c16 = lane & 15, mt = wave & 3, hf = wave >> 2;
    const int vrow = tid < 256 ? (tid >> 2) : ((tid - 256) & 63), vch = tid & 3;
    for (int item = vcu; item < 256; item += G) {
        const int dir = item >> 7, b = (item >> 4) & 7, h = (item >> 2) & 3, eb = item & 3;
        const int chain = dir * 32 + b * 4 + h;
        const bf16* qsrc = P + h * 128; const bf16* vsrc = P + 1024 + h * 128 + 32 * eb;
        bf16* odb = (bf16*)(ws + WS_ST) + (size_t)dir * TT * 512 + h * 128 + 32 * eb;
        f32x4 acc[3];
#pragma unroll
        for (int et = 0; et < 3; ++et) acc[et] = (f32x4){0.f, 0.f, 0.f, 0.f};
        v4u qreg[2], kreg[2], vreg; float bqr, cln, astn, cqn; f32x4 bqn[4], ain, emn;
        { const int j0 = dir == 0 ? 0 : 3; const int row0 = b * PB + j0 * 64; const size_t tb = (size_t)chain * PB + j0 * 64;
#pragma unroll
          for (int i = 0; i < 2; ++i) { const int cidx = tid + 512 * i, rr = cidx >> 4, ch = cidx & 15; const bf16* s = qsrc + (size_t)(row0 + rr) * N_AB + ch * 8; qreg[i] = *(const v4u*)s; kreg[i] = *(const v4u*)(s + 512); }
          vreg = *(const v4u*)(vsrc + (size_t)(row0 + vrow) * N_AB + vch * 8); bqr = BQ[tb + vrow]; cln = CL[chain * NCH + j0]; astn = AST[chain * NCH + j0];
#pragma unroll
          for (int k = 0; k < 4; ++k) bqn[k] = *(const f32x4*)(BQ + tb + 16 * k + 4 * g);
          cqn = CQ[tb + 16 * mt + c16]; ain = *(const f32x4*)(AI + tb + 16 * mt + 4 * g); emn = *(const f32x4*)(EM + tb + 16 * mt + 4 * g); }
        for (int sc = 0; sc < NCH; ++sc) {
            const int j = dir == 0 ? sc : (sc < 4 ? 3 - sc : 71 - sc);
            __syncthreads();
#pragma unroll
            for (int i = 0; i < 2; ++i) { const int cidx = tid + 512 * i, rr = cidx >> 4, ch = cidx & 15; *(LAS v4u*)(Qt + rr * 136 + ch * 8) = qreg[i]; *(LAS v4u*)(Kt + rr * 136 + ch * 8) = kreg[i]; }
            { const float wsv = __expf(bqr - cln);
              if (tid < 256) { const v4u raw = vreg; v4u o;
                  o.x = pk2(bflo(raw.x) * wsv, bfhi(raw.x) * wsv); o.y = pk2(bflo(raw.y) * wsv, bfhi(raw.y) * wsv); o.z = pk2(bflo(raw.z) * wsv, bfhi(raw.z) * wsv); o.w = pk2(bflo(raw.w) * wsv, bfhi(raw.w) * wsv);
                  *(LAS v4u*)(Vt + vrow * 56 + vch * 8) = raw; *(LAS v4u*)(Vw + vrow * 56 + vch * 8) = o;
              } else if (tid < 320) { v4u o; o.x = 0x3f80u; o.y = 0u; o.z = 0u; o.w = 0u; *(LAS v4u*)(Vt + vrow * 56 + 32) = o; o.x = f2bf(wsv); *(LAS v4u*)(Vw + vrow * 56 + 32) = o;
                  o.x = 0u; *(LAS v4u*)(Vt + vrow * 56 + 40) = o; *(LAS v4u*)(Vw + vrow * 56 + 40) = o; } }
#pragma unroll
            for (int et = 0; et < 3; ++et)
#pragma unroll
                for (int r = 0; r < 4; ++r) CT[(16 * et + 4 * g + r) * 136 + 16 * wave + c16] = (bf16)f2bf(acc[et][r]);
            const float ast = astn, cqt = cqn; f32x4 bq[4]; const f32x4 ai = ain, em = emn;
#pragma unroll
            for (int k = 0; k < 4; ++k) bq[k] = bqn[k];
            if (sc + 1 < NCH) { const int sn = sc + 1; const int jn = dir == 0 ? sn : (sn < 4 ? 3 - sn : 71 - sn); const int row0 = b * PB + jn * 64; const size_t tb = (size_t)chain * PB + jn * 64;
#pragma unroll
                for (int i = 0; i < 2; ++i) { const int cidx = tid + 512 * i, rr = cidx >> 4, ch = cidx & 15; const bf16* s = qsrc + (size_t)(row0 + rr) * N_AB + ch * 8; qreg[i] = *(const v4u*)s; kreg[i] = *(const v4u*)(s + 512); }
                vreg = *(const v4u*)(vsrc + (size_t)(row0 + vrow) * N_AB + vch * 8); bqr = BQ[tb + vrow]; cln = CL[chain * NCH + jn]; astn = AST[chain * NCH + jn];
#pragma unroll
                for (int k = 0; k < 4; ++k) bqn[k] = *(const f32x4*)(BQ + tb + 16 * k + 4 * g);
                cqn = CQ[tb + 16 * mt + c16]; ain = *(const f32x4*)(AI + tb + 16 * mt + 4 * g); emn = *(const f32x4*)(EM + tb + 16 * mt + 4 * g); }
            __syncthreads();
            bf16x8 qf[4];
#pragma unroll
            for (int ks = 0; ks < 4; ++ks) qf[ks] = frag_row(Qt, 136, 16 * mt, 32 * ks, lane);
            bf16x8 pa[2];
            { f32x4 st[4];
#pragma unroll
              for (int ns = 0; ns < 4; ++ns) { st[ns] = (f32x4){0.f, 0.f, 0.f, 0.f};
#pragma unroll
                  for (int ks = 0; ks < 4; ++ks) st[ns] = mma(frag_row(Kt, 136, 16 * ns, 32 * ks, lane), qf[ks], st[ns]);
#pragma unroll
                  for (int r = 0; r < 4; ++r) { const int sidx = 16 * ns + 4 * g + r, t = 16 * mt + c16; const bool ok = dir == 0 ? (sidx <= t) : (sidx >= t);
                      st[ns][r] = ok ? st[ns][r] * __expf(bq[ns][r] - cqt) : 0.f; } }
#pragma unroll
              for (int ks2 = 0; ks2 < 2; ++ks2) { const v4u wv = (v4u){pk2(st[2 * ks2][0], st[2 * ks2][1]), pk2(st[2 * ks2][2], st[2 * ks2][3]), pk2(st[2 * ks2 + 1][0], st[2 * ks2 + 1][1]), pk2(st[2 * ks2 + 1][2], st[2 * ks2 + 1][3])};
                  pa[ks2] = __builtin_bit_cast(bf16x8, wv); } }
            f32x4 av, ad;
            { f32x4 a = (f32x4){0.f, 0.f, 0.f, 0.f}, d = (f32x4){0.f, 0.f, 0.f, 0.f};
#pragma unroll
              for (int ks = 0; ks < 4; ++ks) { a = mma(qf[ks], frag_row(CT, 136, 16 * hf, 32 * ks, lane), a); d = mma(qf[ks], frag_row(CT, 136, 32, 32 * ks, lane), d); }
#pragma unroll
              for (int r = 0; r < 4; ++r) { a[r] *= ai[r]; d[r] *= ai[r]; }
#pragma unroll
              for (int ks = 0; ks < 2; ++ks) { a = mma(pa[ks], frag_tr_perm(Vt, 56, 32 * ks, 16 * hf, lane), a); d = mma(pa[ks], frag_tr_perm(Vt, 56, 32 * ks, 32, lane), d); }
              av = a; ad = d; }
            { bf16* orow = odb + (size_t)(b * PB + j * 64 + 16 * mt + 4 * g) * 512 + 16 * hf + c16;
#pragma unroll
              for (int r = 0; r < 4; ++r) { const float den = __shfl(ad[r], lane & 48); orow[(size_t)r * 512] = (bf16)f2bf(av[r] / fmaxf(fabsf(den), em[r])); } }
#pragma unroll
            for (int et = 0; et < 3; ++et) acc[et] = acc[et] * ast;
#pragma unroll
            for (int ks = 0; ks < 2; ++ks) { const bf16x8 kb = frag_tr(Kt, 136, 32 * ks, 16 * wave, lane);
#pragma unroll
                for (int et = 0; et < 3; ++et) acc[et] = mma(frag_tr(Vw, 56, 32 * ks, 16 * et, lane), kb, acc[et]); }
        }
    }
}
__device__ __forceinline__ void mlstm_merge(const bf16* P, bf16* CAT, const float* norm_w, unsigned char* ws, int gw, int NGW, int lane) {
    const bf16* OD = (const bf16*)(ws + WS_ST);
    for (int r = gw; r < TT; r += NGW) {
        float x[8], y[8], og[8];
        unpack8(*(const v4u*)(OD + (size_t)r * 512 + 8 * lane), x); unpack8(*(const v4u*)(OD + (size_t)TT * 512 + (size_t)r * 512 + 8 * lane), y);
        unpack8(*(const v4u*)(P + (size_t)r * N_AB + 1536 + 8 * lane), og);
        float ss = 0.f;
#pragma unroll
        for (int k = 0; k < 8; ++k) { x[k] += y[k]; ss += x[k] * x[k]; }
        ss = gsum16(ss);
        const float rn = 1.f / sqrtf(ss * (1.f / 128.f) + LN_EPS);
        unsigned ow[4];
#pragma unroll
        for (int k = 0; k < 4; ++k) ow[k] = pk2(x[2 * k] * rn * norm_w[8 * lane + 2 * k] * sigmoidf_(og[2 * k]), x[2 * k + 1] * rn * norm_w[8 * lane + 2 * k + 1] * sigmoidf_(og[2 * k + 1]));
        v4u o; o.x = ow[0]; o.y = ow[1]; o.z = ow[2]; o.w = ow[3]; *(v4u*)(CAT + (size_t)r * D + 8 * lane) = o;
    }
}

#ifndef PHMASK
#define PHMASK 0xffffffffu
#endif
#define PH(k) ((PHMASK >> (k)) & 1u)
#ifndef REPMASK
#define REPMASK 0u
#endif
#define REPS(k) (1 + (int)((REPMASK >> (k)) & 1u))
#if REPMASK
#define DRYV(k) ({ int d_ = (rep_ + 1 < REPS(k)) ? 1 : 0; asm volatile("" : "+s"(d_)); d_; })
#else
#define DRYV(k) 0
#endif
#ifndef DBG_LEVEL
#define DBG_LEVEL 3
#endif
typedef const __attribute__((address_space(4))) Args* KArgsP;
__device__ __forceinline__ KArgsP kargs() { KArgsP p = (KArgsP)__builtin_amdgcn_kernarg_segment_ptr(); asm volatile("" : "+s"(p)); return p; }
#define WSP(off) (ws + (off))
__global__ void __launch_bounds__(512, 2) fwd_megakernel(Args A_unused) {
    extern __shared__ __attribute__((aligned(16))) unsigned char lds_raw[];
    LAS unsigned char* lds = (LAS unsigned char*)lds_raw;
    const int tid0 = threadIdx.x;
    const int G = gridDim.x; const int bx = blockIdx.x; const int vcu = (G % 8 == 0) ? (bx % 8) * (G / 8) + bx / 8 : bx;
    const int NGW = G * 8;
    volatile LAS unsigned* MISC = (volatile LAS unsigned*)(lds + MISC_OFF);
    if (tid0 < 16) MISC[tid0] = 0u;
    __syncthreads();
    XcdBarrier bar;
    { KArgsP ap = kargs(); bar = xcd_barrier_post((unsigned*)(ap->ws + WS_CTL) + 1024, MISC + 8); }
#define GRID_BAR() xcd_barrier(bar)
#define PROLOG KArgsP ap = kargs(); unsigned char* ws = ap->ws; (void)ws; int tid = tid0; asm volatile("" : "+v"(tid)); const int lane = tid & 63, wave = __builtin_amdgcn_readfirstlane(tid >> 6), gw = vcu * 8 + wave; (void)lane; (void)wave; (void)gw;

    if (PH(0)) for (int rep_ = 0; rep_ < REPS(0); ++rep_) { int tid = tid0; asm volatile("" : "+v"(tid)); const int lane = tid & 63, wave = __builtin_amdgcn_readfirstlane(tid >> 6); Args A; { KArgsP ap = kargs();
#pragma unroll
        for (int i = 0; i < 22; ++i) A.in[i] = ap->in[i];
        A.out = ap->out; A.ws = ap->ws; }
        p0_prologue(A, lds, vcu, G, wave, lane, tid); }
    GRID_BAR();

    if (PH(1)) for (int rep_ = 0; rep_ < REPS(1); ++rep_) { PROLOG h_phase<16>(ap->in[I_X], ap->in[I_CTX], (const float*)WSP(WS_MOD), (bf16*)WSP(WS_HB), (const float*)WSP(WS_WG), (float*)WSP(WS_GL), lds, vcu, G, wave, lane, tid); }
    GRID_BAR();
    if (PH(2)) for (int rep_ = 0; rep_ < REPS(2); ++rep_) { PROLOG pg8::Gemm g{(const bf16*)WSP(WS_HB), (const bf16*)WSP(WS_WAB), TT, N_AB, 1024, 1024, 1024}; pg8::StaticOrder S; S.init(TT, N_AB, G, bx);
      pg8::EpiBf16 E{(bf16*)WSP(WS_P), N_AB}; pg8::gemm_phase<pg8::EpiBf16, pg8::StaticOrder>(lds, g, S, E, tid); }
    GRID_BAR();
#if DBG_LEVEL >= 2
    if (PH(3)) for (int rep_ = 0; rep_ < REPS(3); ++rep_) { PROLOG mlstm_gate_scan((const float*)WSP(WS_GL), ap->in[I_ABGB], ws, gw, NGW, lane); }
    if (PH(4)) for (int rep_ = 0; rep_ < REPS(4); ++rep_) { PROLOG attn_phase((const bf16*)WSP(WS_P), (bf16*)WSP(WS_HB), ap->in[I_ABSINK], (const float*)WSP(WS_ROPE), lds, (unsigned*)WSP(WS_CTL) + 6144 + 64 * rep_, vcu, G, wave, lane, tid); }
    GRID_BAR();
    if (PH(5)) for (int rep_ = 0; rep_ < REPS(5); ++rep_) { PROLOG mlstm_fused_scan((const bf16*)WSP(WS_P), ws, lds, vcu, G, wave, lane, tid); }
    GRID_BAR();
    if (PH(6)) for (int rep_ = 0; rep_ < REPS(6); ++rep_) { PROLOG mlstm_merge((const bf16*)WSP(WS_P), (bf16*)WSP(WS_HB), ap->in[I_ABNW], ws, gw, NGW, lane); }
    GRID_BAR();
#endif
    if (PH(7)) for (int rep_ = 0; rep_ < REPS(7); ++rep_) { PROLOG pg8::Gemm g{(const bf16*)WSP(WS_HB), (const bf16*)WSP(WS_WABO), TT, 1024, 1024, 1024, 1024}; pg8::StaticOrder S; S.init(TT, 1024, G, bx);
      pg8::EpiBf16 E{(bf16*)WSP(WS_P), 1024}; pg8::gemm_phase<pg8::EpiBf16, pg8::StaticOrder>(lds, g, S, E, tid); }
    GRID_BAR();
    if (PH(8)) for (int rep_ = 0; rep_ < REPS(8); ++rep_) { PROLOG ln_phase(ap->in[I_X], ap->in[I_CTX], ap->out, (float*)WSP(WS_XC), (const bf16*)WSP(WS_P), (const float*)WSP(WS_MOD), ap->in[I_LNW], ap->in[I_LNB], (bf16*)WSP(WS_HB), gw, NGW, lane, DRYV(8), false); }
    GRID_BAR();
#if DBG_LEVEL >= 3
    if (PH(9)) for (int rep_ = 0; rep_ < REPS(9); ++rep_) { PROLOG pg8::Gemm g{(const bf16*)WSP(WS_HB), (const bf16*)WSP(WS_WQ0), TT, 2048, 1024, 1024, 1024}; pg8::StaticOrder S; S.init(TT, 2048, G, bx);
      pg8::EpiBf16 E{(bf16*)WSP(WS_P), 2048}; pg8::gemm_phase<pg8::EpiBf16, pg8::StaticOrder>(lds, g, S, E, tid); }
    GRID_BAR();
    if (PH(10)) for (int rep_ = 0; rep_ < REPS(10); ++rep_) { PROLOG peer_route((const bf16*)WSP(WS_P), (const bf16*)WSP(WS_KEYS), (int*)WSP(WS_ST), (float*)WSP(WS_ST + 17 * MiB), gw, NGW, lane, false); }
    GRID_BAR();
#endif
    if (PH(11)) for (int rep_ = 0; rep_ < REPS(22); ++rep_) { PROLOG peer_pass1((const bf16*)WSP(WS_HB), (const int*)WSP(WS_ST), (const float*)WSP(WS_ST + 17 * MiB), WSP(WS_U), (const float*)WSP(WS_SCL), (const float*)WSP(WS_SCL) + 2 * NEXP, (float*)WSP(WS_ST + 34 * MiB), lds, wave, gw, NGW, lane, false); }
    if (PH(11)) for (int rep_ = 0; rep_ < REPS(11); ++rep_) { PROLOG peer_expert<(DBG_LEVEL >= 3)>((const float*)WSP(WS_ST + 34 * MiB), (const int*)WSP(WS_ST), WSP(WS_V),
        ap->out, (float*)WSP(WS_XC), (const float*)WSP(WS_MOD), ap->in[I_LNW] + 1024, ap->in[I_LNB] + 1024, gw, NGW, lane, DRYV(11), false); }
    GRID_BAR();

    if (PH(12)) for (int rep_ = 0; rep_ < REPS(12); ++rep_) { PROLOG h_phase<32>(ap->out, (const float*)WSP(WS_XC), (const float*)WSP(WS_MOD) + 9 * 6144, (bf16*)WSP(WS_HB), (const float*)WSP(WS_WLOW), (float*)WSP(WS_GL), lds, vcu, G, wave, lane, tid);
 }
    GRID_BAR();
    if (PH(13)) for (int rep_ = 0; rep_ < REPS(13); ++rep_) { PROLOG pg8::Gemm g{(const bf16*)WSP(WS_HB), (const bf16*)WSP(WS_WC), TT, N_C, 1024, 1024, 1024}; pg8::StaticOrder S; S.init(TT, N_C, G, bx);
      pg8::EpiBf16 E{(bf16*)WSP(WS_P), N_C}; pg8::gemm_phase<pg8::EpiBf16, pg8::StaticOrder>(lds, g, S, E, tid); }
    GRID_BAR();
#if DBG_LEVEL >= 2
    if (PH(14)) for (int rep_ = 0; rep_ < REPS(14); ++rep_) { PROLOG gla_prep((bf16*)WSP(WS_P), (bf16*)WSP(WS_HB), (const float*)WSP(WS_GL), ap->in[I_GGUP], ap->in[I_GGB], ws, lds, vcu, G, tid, DRYV(14)); }
    GRID_BAR();
    if (PH(15)) for (int rep_ = 0; rep_ < REPS(15); ++rep_) { PROLOG gla_fused_scan((const bf16*)WSP(WS_P), (const bf16*)WSP(WS_HB), ws, lds, vcu, G, wave, lane, tid, DRYV(15)); }
    GRID_BAR();
    if (PH(16)) for (int rep_ = 0; rep_ < REPS(16); ++rep_) { PROLOG gla_merge((bf16*)WSP(WS_P), ap->in[I_GNW], ws, gw, NGW, lane, DRYV(16)); }
    GRID_BAR();
#endif
    if (PH(17)) for (int rep_ = 0; rep_ < REPS(17); ++rep_) { PROLOG pg8::Gemm g{(const bf16*)WSP(WS_P) + 2048, (const bf16*)WSP(WS_WCO), TT, 1024, 1024, N_C, 1024}; pg8::LatOrder S; S.init(NB * SEQ, 1024, G, bx);
      pg8::EpiBf16 E{(bf16*)WSP(WS_HB), 1024}; pg8::gemm_phase<pg8::EpiBf16, pg8::LatOrder>(lds, g, S, E, tid); }
    GRID_BAR();
    if (PH(18)) for (int rep_ = 0; rep_ < REPS(18); ++rep_) { PROLOG ln_phase(ap->out, (const float*)WSP(WS_XC), ap->out, (float*)WSP(WS_XC), (const bf16*)WSP(WS_HB), (const float*)WSP(WS_MOD) + 9 * 6144, ap->in[I_LNW] + 2048, ap->in[I_LNB] + 2048, (bf16*)WSP(WS_HB), gw, NGW, lane, DRYV(18), true); }
    GRID_BAR();
#if DBG_LEVEL >= 3
    if (PH(19)) for (int rep_ = 0; rep_ < REPS(19); ++rep_) { PROLOG pg8::Gemm g{(const bf16*)WSP(WS_HB), (const bf16*)WSP(WS_WQ1), TT, 2048, 1024, 1024, 1024}; pg8::LatOrder S; S.init(NB * SEQ, 2048, G, bx);
      pg8::EpiBf16 E{(bf16*)WSP(WS_P), 2048}; pg8::gemm_phase<pg8::EpiBf16, pg8::LatOrder>(lds, g, S, E, tid); }
    GRID_BAR();
    if (PH(20)) for (int rep_ = 0; rep_ < REPS(20); ++rep_) { PROLOG peer_route((const bf16*)WSP(WS_P), (const bf16*)WSP(WS_KEYS) + (size_t)8 * 2 * 128 * 128, (int*)WSP(WS_ST), (float*)WSP(WS_ST + 17 * MiB), gw, NGW, lane, true); }
    GRID_BAR();
#endif
    if (PH(21)) for (int rep_ = 0; rep_ < REPS(22); ++rep_) { PROLOG peer_pass1((const bf16*)WSP(WS_HB), (const int*)WSP(WS_ST), (const float*)WSP(WS_ST + 17 * MiB), WSP(WS_U) + (size_t)NEXP * 512, (const float*)WSP(WS_SCL) + NEXP, (const float*)WSP(WS_SCL) + 3 * NEXP, (float*)WSP(WS_ST + 34 * MiB), lds, wave, gw, NGW, lane, true); }
    if (PH(21)) for (int rep_ = 0; rep_ < REPS(21); ++rep_) { PROLOG peer_expert<(DBG_LEVEL >= 3)>((const float*)WSP(WS_ST + 34 * MiB), (const int*)WSP(WS_ST), WSP(WS_V) + (size_t)NEXP * 512,
        ap->out, (float*)WSP(WS_XC), (const float*)WSP(WS_MOD) + 9 * 6144, ap->in[I_LNW] + 3072, ap->in[I_LNB] + 3072, gw, NGW, lane, DRYV(21), true); }
}

extern "C" void kernel_launch(void* const* d_in, const int* in_sizes, int n_in, void* d_out, int out_size, void* d_ws, size_t ws_size, hipStream_t stream) {
    static int grid = 0;
    if (grid == 0) {
        if (n_in != 22 || out_size != NB * SEQ * D || ws_size < 512 * MiB) { fprintf(stderr, "kernel_launch: unexpected shapes: n_in %d out %d ws %zu (need %zu)\n", n_in, out_size, ws_size, (size_t)WS_END); grid = -1; return; }
        int dev = 0, cus = 0, per_cu = 0;
        if (hipGetDevice(&dev) != hipSuccess || hipDeviceGetAttribute(&cus, hipDeviceAttributeMultiprocessorCount, dev) != hipSuccess) { grid = -1; return; }
        if (hipFuncSetAttribute((const void*)fwd_megakernel, hipFuncAttributeMaxDynamicSharedMemorySize, LDS_BYTES) != hipSuccess) { fprintf(stderr, "kernel_launch: hipFuncSetAttribute failed\n"); grid = -1; return; }
        if (hipOccupancyMaxActiveBlocksPerMultiprocessor(&per_cu, (const void*)fwd_megakernel, 512, LDS_BYTES) != hipSuccess || per_cu < 1) { fprintf(stderr, "kernel_launch: occupancy query says %d blocks per CU\n", per_cu); }
        (void)hipGetLastError();
        grid = cus;
        fprintf(stderr, "kernel_launch: grid %d, per_cu %d, ws %zu\n", grid, per_cu, ws_size);
    }
    if (grid < 0) return;
    if (hipMemsetAsync((char*)d_ws + WS_CTL, 0, CTL_ZERO_BYTES, stream) != hipSuccess) return;
    Args a{};
    for (int i = 0; i < 22; ++i) a.in[i] = (const float*)d_in[i];
    a.out = (float*)d_out; a.ws = (unsigned char*)d_ws;
    hipLaunchKernelGGL(fwd_megakernel, dim3(grid), dim3(512), LDS_BYTES, stream, a);
}
```

```cpp
#include <hip/hip_runtime.h>
#include <cstdio>
#include <cstdint>

#define GAS __attribute__((address_space(1)))
#define LAS __attribute__((address_space(3)))
typedef unsigned short bf16;
typedef unsigned v4u __attribute__((ext_vector_type(4)));
typedef unsigned v2u __attribute__((ext_vector_type(2)));
typedef float f32x4 __attribute__((ext_vector_type(4)));
typedef float f32x2 __attribute__((ext_vector_type(2)));
typedef short bf16x8 __attribute__((ext_vector_type(8)));
typedef short s16x4 __attribute__((ext_vector_type(4)));
typedef GAS unsigned gu32;
#define RLX_AGENT __ATOMIC_RELAXED, __HIP_MEMORY_SCOPE_AGENT

constexpr int NB = 8, SEQ = 4096, LC = 256, D = 1024;
constexpr int PB = LC + SEQ;
constexpr int TT = NB * PB;
constexpr int NCH = PB / 64;
constexpr int N_AB = 2816;
constexpr int N_C = 3072;
constexpr float LN_EPS = 1e-5f;
constexpr float DN_ALPHA = 1.41421356237f;
constexpr int NEXP = 16384;
__device__ __forceinline__ int map_row(int i, bool lat_only) { return lat_only ? (i >> 12) * 4352 + 256 + (i & 4095) : i; }

constexpr size_t MiB = 1u << 20;
constexpr size_t WS_CTL = 0, CTL_ZERO_BYTES = 64 * 1024;
constexpr size_t WS_MOD = 1 * MiB;
constexpr size_t WS_ROPE = 2 * MiB;
constexpr size_t WS_WG = 2 * MiB + 64 * 1024;
constexpr size_t WS_WLOW = 2 * MiB + 128 * 1024;
constexpr size_t WS_SCL = 3 * MiB;
constexpr size_t WS_BQ = 4 * MiB, WS_CQ = WS_BQ + 1200 * 1024, WS_EM = WS_CQ + 1200 * 1024, WS_AI = WS_EM + 1200 * 1024;
constexpr size_t WS_AST = WS_AI + 1200 * 1024, WS_CL = WS_AST + 32 * 1024;
constexpr size_t WS_ET = 10 * MiB;
constexpr size_t WS_GL = 13 * MiB;
constexpr size_t WS_WAB = 20 * MiB, WS_WABO = 26 * MiB, WS_WC = 28 * MiB, WS_WCO = 34 * MiB, WS_WQ0 = 36 * MiB, WS_WQ1 = 40 * MiB, WS_KEYS = 44 * MiB;
constexpr size_t WS_NST = 45 * MiB;
constexpr size_t WS_XC = 48 * MiB;
constexpr size_t WS_U = 56 * MiB, WS_V = 88 * MiB;
constexpr size_t WS_HB = 120 * MiB;
constexpr size_t WS_P = 188 * MiB;
constexpr size_t WS_ST = 392 * MiB;
constexpr size_t WS_END = 460 * MiB;

constexpr int LDS_BYTES = 163840;
constexpr int MISC_OFF = LDS_BYTES - 64;

__device__ __forceinline__ unsigned f2bf(float f) { unsigned u = __builtin_bit_cast(unsigned, f); return (u + 0x7fffu + ((u >> 16) & 1u)) >> 16; }
__device__ __forceinline__ unsigned pk2(float lo, float hi) { return f2bf(lo) | (f2bf(hi) << 16); }
__device__ __forceinline__ float bflo(unsigned w) { return __builtin_bit_cast(float, w << 16); }
__device__ __forceinline__ float bfhi(unsigned w) { return __builtin_bit_cast(float, w & 0xffff0000u); }
__device__ __forceinline__ float bf2f(bf16 b) { return __builtin_bit_cast(float, (unsigned)b << 16); }
template <int CTRL> __device__ __forceinline__ float dppmov_f(float x) { return __builtin_bit_cast(float, __builtin_amdgcn_mov_dpp(__builtin_bit_cast(int, x), CTRL, 0xf, 0xf, true)); }
__device__ __forceinline__ float wave_sum(float v) {
    v += dppmov_f<0xB1>(v); v += dppmov_f<0x4E>(v); v += dppmov_f<0x141>(v); v += dppmov_f<0x128>(v);
    v += __shfl_xor(v, 16); v += __shfl_xor(v, 32);
    return v;
}
__device__ __forceinline__ float sigmoidf_(float x) { return 1.f / (1.f + __expf(-x)); }
__device__ __forceinline__ float logsigmoidf_(float x) { return fminf(x, 0.f) - log1pf(__expf(-fabsf(x))); }
__device__ __forceinline__ float siluf_(float x) { return x / (1.f + __expf(-x)); }

namespace pg8 {
#define PG8_LAS __attribute__((address_space(3)))
typedef unsigned short bf16_t;
typedef short bf16x8 __attribute__((ext_vector_type(8)));
typedef float f32x4 __attribute__((ext_vector_type(4)));
typedef unsigned u32x4 __attribute__((ext_vector_type(4)));
constexpr int BM = 256, BK = 64, HALF = 128, HTB = HALF * BK * 2  , STAGE_BYTES = 8 * HTB, NXCD = 8, WGM = 8;

__host__ __device__ __forceinline__ int lds_byte(int r, int c) { const int st = (r >> 4) * 2 + (c >> 5), rr = r & 15, cc = c & 31, ob = rr * 64 + cc * 2; return st * 1024 + (ob ^ (((ob >> 9) & 1) << 5)); }
__host__ __device__ __forceinline__ void stage_rc(int b, int& R, int& C) { const int st = b / 1024, sb = b % 1024, swz = sb ^ (((sb >> 9) & 1) << 5); R = (st >> 1) * 16 + swz / 64; C = (st & 1) * 32 + (swz % 64) / 2; }
__host__ __device__ __forceinline__ int perm32(int rho) { const int n = rho >> 4, i = rho & 15; return 8 * (i >> 2) + 4 * n + (i & 3); }

struct Unit { int pm, pn; };
struct Gemm { const bf16_t* A; const bf16_t* Bt; int M, N, K, lda, ldb; };

struct StaticOrder {
    int nM, nN, nwg, G, c;
    __host__ __device__ void init(int M, int N, int G_, int c_) { nM = M / BM; nN = N / BM; nwg = nM * nN; G = G_; c = c_; }
    __host__ __device__ bool next(int i, Unit& u) const {
        const long L = (long)i * G + c; if (L >= nwg) return false;
        int wgid = (int)L; { const int q = nwg / NXCD, r = nwg % NXCD, xcd = wgid % NXCD, off = wgid / NXCD; wgid = (xcd < r ? xcd * (q + 1) : r * (q + 1) + (xcd - r) * q) + off; }
        const int nig = WGM * nN, gid = wgid / nig, fm = gid * WGM, gsz = (nM - fm) < WGM ? (nM - fm) : WGM;
        u.pm = fm + ((wgid % nig) % gsz); u.pn = (wgid % nig) / gsz; return true;
    }
    __device__ __forceinline__ void a_ready(const Unit&) const {}
    __device__ __forceinline__ void done(const Unit&) const {}
};

struct LatOrder : StaticOrder {
    __host__ __device__ bool next(int i, Unit& u) const { if (!StaticOrder::next(i, u)) return false; u.pm = (u.pm >> 4) * 17 + 1 + (u.pm & 15); return true; }
};
__device__ __forceinline__ unsigned cvt_pk_bf16(float lo, float hi) { unsigned r; asm volatile("v_cvt_pk_bf16_f32 %0, %1, %2" : "=v"(r) : "v"(lo), "v"(hi)); return r; }
struct EpiBf16 {
    static constexpr bool PERM = true, AFTER_DRAIN = false;
    bf16_t* O; int ldc;
    __device__ __forceinline__ void operator()(const f32x4 (&acc)[2][2][4][2], const Unit& u, int wr, int wc, int fr, int fq) const {
        const int row0 = u.pm * BM + wr * 64 + fr; const int col0 = u.pn * BM + wc * 32 + 8 * fq;
#pragma unroll
        for (int ai = 0; ai < 2; ++ai)
#pragma unroll
            for (int m = 0; m < 4; ++m) { bf16_t* rowp = O + (size_t)(row0 + ai * HALF + m * 16) * ldc + col0;
#pragma unroll
                for (int bj = 0; bj < 2; ++bj) { const f32x4 v0 = acc[ai][bj][m][0], v1 = acc[ai][bj][m][1];
                    u32x4 w; w.x = cvt_pk_bf16(v0[0], v0[1]); w.y = cvt_pk_bf16(v0[2], v0[3]); w.z = cvt_pk_bf16(v1[0], v1[1]); w.w = cvt_pk_bf16(v1[2], v1[3]);
                    *(u32x4*)(rowp + bj * HALF) = w; } }
    }
};
struct EpiResid {
    static constexpr bool PERM = false, AFTER_DRAIN = false;
    const float* src_lat; const float* src_ctx; float* dst_lat; float* dst_ctx; const float* gate; float gscale; int dry;
    __device__ __forceinline__ void operator()(const f32x4 (&acc)[2][2][4][2], const Unit& u, int wr, int wc, int fr, int fq) const {
        const int b = u.pm / 17, tb = u.pm - b * 17;
        const float* sbase; float* dbase; const float* gr;
        if (tb == 0) { sbase = src_ctx + (size_t)b * 256 * 1024; dbase = dst_ctx + (size_t)b * 256 * 1024; gr = gate + 8 * 6144; }
        else { sbase = src_lat + ((size_t)b * 4096 + (size_t)(tb - 1) * 256) * 1024; dbase = dst_lat + ((size_t)b * 4096 + (size_t)(tb - 1) * 256) * 1024; gr = gate + b * 6144; }
        const int row0 = wr * 64 + fr, col0 = u.pn * BM + wc * 32 + 4 * fq;
        f32x4 gv[2][2];
#pragma unroll
        for (int bj = 0; bj < 2; ++bj)
#pragma unroll
            for (int n = 0; n < 2; ++n) gv[bj][n] = *(const f32x4*)(gr + col0 + bj * HALF + n * 16) * gscale;
#pragma unroll
        for (int ai = 0; ai < 2; ++ai)
#pragma unroll
            for (int mp = 0; mp < 2; ++mp) {
                f32x4 sv[2][2][2];
#pragma unroll
                for (int mm = 0; mm < 2; ++mm) { const size_t off = (size_t)(row0 + ai * HALF + (2 * mp + mm) * 16) * 1024 + col0;
#pragma unroll
                    for (int bj = 0; bj < 2; ++bj)
#pragma unroll
                        for (int n = 0; n < 2; ++n) sv[mm][bj][n] = __builtin_nontemporal_load((const f32x4*)(sbase + off + bj * HALF + n * 16)); }
                asm volatile("" ::: "memory");
#pragma unroll
                for (int mm = 0; mm < 2; ++mm) { const int m = 2 * mp + mm; const size_t off = (size_t)(row0 + ai * HALF + m * 16) * 1024 + col0;
#pragma unroll
                    for (int bj = 0; bj < 2; ++bj)
#pragma unroll
                        for (int n = 0; n < 2; ++n) { const f32x4 ov = sv[mm][bj][n] * 1.41421356237f + gv[bj][n] * acc[ai][bj][m][n]; if (!dry) *(f32x4*)(dbase + off + bj * HALF + n * 16) = ov; } }
                asm volatile("" ::: "memory");
            }
    }
};

template <class Epi, class Sched>
__device__ __forceinline__ void gemm_phase(PG8_LAS unsigned char* lds, const Gemm g, const Sched& S, const Epi& E, const int tid_in) {
    const int tid = tid_in, wid = __builtin_amdgcn_readfirstlane(tid >> 6), lane = tid & 63, wr = wid >> 2, wc = wid & 3, fr = lane & 15, fq = lane >> 4;
    const int K = g.K, nt = K / BK;
    unsigned voffA[2], voffB[2];
#pragma unroll
    for (int i = 0; i < 2; ++i) { int R, C; stage_rc(tid * 16 + i * 8192, R, C); const int Rb = Epi::PERM ? ((R & ~31) + perm32(R & 31)) : R;
        voffA[i] = (unsigned)(R * g.lda + C) * 2u; voffB[i] = (unsigned)(Rb * g.ldb + C) * 2u; }
    const size_t kstep = (size_t)(BK * 2);
    const size_t hstepA = (size_t)HALF * g.lda * 2, hstepB = (size_t)HALF * g.ldb * 2;
    const size_t tstepA = 2 * hstepA, tstepB = 2 * hstepB;
    const unsigned ldsw = (unsigned)wid * 1024u;
    const int aoff = lds_byte(wr * 64 + fr, fq * 8), boff = lds_byte(wc * 32 + fr, fq * 8);
#define PG8_SA(b, h) (((b) * 2 + (h)) * HTB)
#define PG8_SB(b, h) ((4 + (b) * 2 + (h)) * HTB)
#define PG8_STAGE(bufoff, gbase, voff) do { _Pragma("unroll") for (int _i = 0; _i < 2; ++_i) \
        __builtin_amdgcn_global_load_lds((const unsigned*)((const char*)(gbase) + (voff)[_i]), (PG8_LAS unsigned*)(lds + (bufoff) + ldsw + _i * 8192), 16, 0, 0); } while (0)
#define PG8_LDA(dst, b, h) do { _Pragma("unroll") for (int m = 0; m < 4; ++m) _Pragma("unroll") for (int k = 0; k < 2; ++k) dst[m][k] = *(const PG8_LAS bf16x8*)(lds + PG8_SA(b, h) + aoff + m * 2048 + k * 1024); } while (0)
#define PG8_LDB(dst, b, h) do { _Pragma("unroll") for (int n = 0; n < 2; ++n) _Pragma("unroll") for (int k = 0; k < 2; ++k) dst[n][k] = *(const PG8_LAS bf16x8*)(lds + PG8_SB(b, h) + boff + n * 2048 + k * 1024); } while (0)
#define PG8_MMA(ai, bj, At, Bt) do { __builtin_amdgcn_s_setprio(1); _Pragma("unroll") for (int m = 0; m < 4; ++m) _Pragma("unroll") for (int n = 0; n < 2; ++n) _Pragma("unroll") for (int k = 0; k < 2; ++k) \
        acc[ai][bj][m][n] = __builtin_amdgcn_mfma_f32_16x16x32_bf16(Bt[n][k], At[m][k], acc[ai][bj][m][n], 0, 0, 0); __builtin_amdgcn_s_setprio(0); } while (0)
#define PG8_WAIT_V(n) asm volatile("s_waitcnt vmcnt(" #n ")" ::: "memory")
#define PG8_WAIT_L(n) asm volatile("s_waitcnt lgkmcnt(" #n ")" ::: "memory")
#define PG8_BAR __builtin_amdgcn_s_barrier()
#define PG8_SCHED __builtin_amdgcn_sched_barrier(0)
    Unit cur, nxt; int ui = 0;
    if (!S.next(0, cur)) return;
    f32x4 acc[2][2][4][2];
#pragma unroll
    for (int a = 0; a < 2; ++a)
#pragma unroll
        for (int b = 0; b < 2; ++b)
#pragma unroll
            for (int m = 0; m < 4; ++m)
#pragma unroll
                for (int n = 0; n < 2; ++n) acc[a][b][m][n] = (f32x4){0.f, 0.f, 0.f, 0.f};
    bf16x8 At[4][2], B0[2][2], B1[2][2];
    const char* cA = (const char*)g.A + (size_t)cur.pm * tstepA; const char* cB = (const char*)g.Bt + (size_t)cur.pn * tstepB;
    S.a_ready(cur);
    PG8_STAGE(PG8_SB(0, 0), cB, voffB); PG8_STAGE(PG8_SA(0, 0), cA, voffA); PG8_STAGE(PG8_SB(0, 1), cB + hstepB, voffB); PG8_STAGE(PG8_SA(0, 1), cA + hstepA, voffA);
    if (wr == 1) PG8_BAR;
    PG8_WAIT_V(4); PG8_BAR;
    PG8_STAGE(PG8_SB(1, 0), cB + kstep, voffB); PG8_STAGE(PG8_SA(1, 0), cA + kstep, voffA); PG8_STAGE(PG8_SB(1, 1), cB + hstepB + kstep, voffB);
    PG8_WAIT_V(6); PG8_BAR;
    for (;;) {
        const bool has_next = S.next(ui + 1, nxt);
        const char* nA = has_next ? (const char*)g.A + (size_t)nxt.pm * tstepA : cA; const char* nB = has_next ? (const char*)g.Bt + (size_t)nxt.pn * tstepB : cB;
        for (int t = 0; t < nt; t += 2) {
            const bool last = (t == nt - 2);
            const char* a1 = cA + (size_t)(t + 1) * kstep;
            const char* a2 = last ? nA : cA + (size_t)(t + 2) * kstep; const char* b2 = last ? nB : cB + (size_t)(t + 2) * kstep;
            const char* a3 = a2 + kstep; const char* b3 = b2 + kstep;
            if (last && has_next) S.a_ready(nxt);
            PG8_LDB(B0, 0, 0); PG8_SCHED; PG8_LDA(At, 0, 0); PG8_STAGE(PG8_SA(1, 1), a1 + hstepA, voffA);
            PG8_WAIT_L(8); PG8_BAR; PG8_WAIT_L(0); PG8_MMA(0, 0, At, B0); PG8_BAR; PG8_SCHED;
            PG8_LDB(B1, 0, 1); PG8_STAGE(PG8_SB(0, 0), b2, voffB);
            PG8_BAR; PG8_WAIT_L(0); PG8_MMA(0, 1, At, B1); PG8_BAR;
            PG8_LDA(At, 0, 1); PG8_STAGE(PG8_SA(0, 0), a2, voffA);
            PG8_BAR; PG8_WAIT_L(0); PG8_MMA(1, 0, At, B0); PG8_BAR; PG8_SCHED;
            PG8_STAGE(PG8_SB(0, 1), b2 + hstepB, voffB);
            PG8_WAIT_V(6); PG8_BAR; PG8_MMA(1, 1, At, B1); PG8_BAR;
            PG8_LDB(B0, 1, 0); PG8_SCHED; PG8_LDA(At, 1, 0); PG8_STAGE(PG8_SA(0, 1), a2 + hstepA, voffA);
            PG8_WAIT_L(8); PG8_BAR; PG8_WAIT_L(0); PG8_MMA(0, 0, At, B0); PG8_BAR; PG8_SCHED;
            PG8_LDB(B1, 1, 1); PG8_STAGE(PG8_SB(1, 0), b3, voffB);
            PG8_BAR; PG8_WAIT_L(0); PG8_MMA(0, 1, At, B1); PG8_BAR;
            PG8_LDA(At, 1, 1); PG8_STAGE(PG8_SA(1, 0), a3, voffA);
            PG8_BAR; PG8_WAIT_L(0); PG8_MMA(1, 0, At, B0); PG8_BAR; PG8_SCHED;
            PG8_STAGE(PG8_SB(1, 1), b3 + hstepB, voffB);
            PG8_WAIT_V(6); PG8_BAR; PG8_MMA(1, 1, At, B1); PG8_BAR;
        }
        if constexpr (!Epi::AFTER_DRAIN) { E(acc, cur, wr, wc, fr, fq); S.done(cur); }
        if (!has_next) break;
#pragma unroll
        for (int a = 0; a < 2; ++a)
#pragma unroll
            for (int b = 0; b < 2; ++b)
#pragma unroll
                for (int m = 0; m < 4; ++m)
#pragma unroll
                    for (int n = 0; n < 2; ++n) acc[a][b][m][n] = (f32x4){0.f, 0.f, 0.f, 0.f};
        cur = nxt; cA = nA; cB = nB; ++ui;
    }
    PG8_WAIT_V(0);
    if (wr == 0) PG8_BAR;
    PG8_BAR;
    if constexpr (Epi::AFTER_DRAIN) { E.fused(acc, cur, wr, wc, fr, fq, lds, wid, lane); S.done(cur); }
#undef PG8_SA
#undef PG8_SB
#undef PG8_STAGE
#undef PG8_LDA
#undef PG8_LDB
#undef PG8_MMA
#undef PG8_WAIT_V
#undef PG8_WAIT_L
#undef PG8_BAR
#undef PG8_SCHED
}
}

#define XB_TMO      128
#define XB_XCNT(j)  (256  + 64 * (j))
#define XB_XSUB(j)  (1280 + 64 * (j))
#define XB_XGEN(j)  (2304 + 64 * (j))
#define XB_TOP      3328
#define XB_TOPGEN   3392
#define XCD_BAR_WORDS 3456
#define XB_SPIN_CAP (1u << 18)

__device__ __forceinline__ unsigned xb_ld(unsigned* p)              { return __hip_atomic_load(p, __ATOMIC_RELAXED, __HIP_MEMORY_SCOPE_AGENT); }
__device__ __forceinline__ unsigned xb_add(unsigned* p, unsigned v) { return __hip_atomic_fetch_add(p, v, __ATOMIC_RELAXED, __HIP_MEMORY_SCOPE_AGENT); }
__device__ __forceinline__ unsigned xb_xcc_id() { return (unsigned)__builtin_amdgcn_s_getreg((3 << 11) | 20) & 0xFu; }
#define XB_SPIN(cond, bar) do { unsigned _sp = 0; while (cond) { __builtin_amdgcn_s_sleep(1); \
    if ((++_sp & 255u) == 0u) { if (xb_ld(&(bar)[XB_TMO])) break; if (_sp > XB_SPIN_CAP) { atomicAdd(&(bar)[XB_TMO], 1u); break; } } } } while (0)

struct XcdBarrier {
    unsigned* bar; unsigned x;
    volatile LAS unsigned* st;
};

__device__ __forceinline__ XcdBarrier xcd_barrier_post(unsigned* bar, volatile LAS unsigned* st) {
    XcdBarrier b; b.bar = bar; b.x = xb_xcc_id(); b.st = st;
    if (threadIdx.x == 0) (void)xb_add(&bar[XB_XCNT(b.x)], 1u);
    return b;
}
__device__ __forceinline__ void xcd_barrier_complete(unsigned* bar, unsigned x, unsigned& nloc, unsigned& nx) {
    const unsigned G = gridDim.x * gridDim.y * gridDim.z;
    unsigned sum, cnt, mine, sp = 0u;
    for (;;) {
        sum = 0u; cnt = 0u; mine = 0u;
#pragma unroll
        for (unsigned j = 0; j < 16; ++j) { const unsigned c = xb_ld(&bar[XB_XCNT(j)]); sum += c; cnt += (c > 0u) ? 1u : 0u; mine = (j == x) ? c : mine; }
        if (sum == G) break;
        __builtin_amdgcn_s_sleep(1);
        if ((++sp & 255u) == 0u) { if (xb_ld(&bar[XB_TMO])) break; if (sp > XB_SPIN_CAP) { atomicAdd(&bar[XB_TMO], 1u); break; } }
    }
    nloc = mine > 0u ? mine : 1u; nx = cnt > 0u ? cnt : 1u;
}

__device__ __forceinline__ void xcd_barrier(const XcdBarrier& b) {
    asm volatile("s_waitcnt vmcnt(0)" ::: "memory");
    __syncthreads();
    if (threadIdx.x == 0) {
        unsigned* bar = b.bar;
        __builtin_amdgcn_s_waitcnt(0);
        unsigned nloc = b.st[0], nx = b.st[1];
        if (nloc == 0u) { xcd_barrier_complete(bar, b.x, nloc, nx); b.st[0] = nloc; b.st[1] = nx; }
        const unsigned old = xb_add(&bar[XB_XSUB(b.x)], 1u);
        const unsigned gen = old / nloc;
        if (old + 1u == (gen + 1u) * nloc) {
            __builtin_amdgcn_fence(__ATOMIC_RELEASE, "agent");
            asm volatile("s_waitcnt vmcnt(0)" ::: "memory");
            const unsigned og = xb_add(&bar[XB_TOP], 1u);
            const unsigned tg = og / nx;
            if (og + 1u == (tg + 1u) * nx) xb_add(&bar[XB_TOPGEN], 1u);
            else XB_SPIN(xb_ld(&bar[XB_TOPGEN]) == tg, bar);
            __builtin_amdgcn_fence(__ATOMIC_ACQUIRE, "agent");
            xb_add(&bar[XB_XGEN(b.x)], 1u);
            asm volatile("s_waitcnt vmcnt(0)" ::: "memory");
        } else {
            XB_SPIN(xb_ld(&bar[XB_XGEN(b.x)]) == gen, bar);
            __builtin_amdgcn_fence(__ATOMIC_ACQUIRE, "agent");
            asm volatile("s_waitcnt vmcnt(0)" ::: "memory");
        }
    }
    __syncthreads();
}


__device__ __forceinline__ f32x4 mma(bf16x8 a, bf16x8 b, f32x4 c) { return __builtin_amdgcn_mfma_f32_16x16x32_bf16(a, b, c, 0, 0, 0); }
__device__ __forceinline__ bf16x8 frag_row(const LAS bf16* t, int ld, int r0, int c0, int lane) {
    return *(const LAS bf16x8*)(t + (r0 + (lane & 15)) * ld + c0 + 8 * (lane >> 4));
}
__device__ __forceinline__ bf16x8 frag_tr(const LAS bf16* t, int ld, int r0, int c0, int lane) {
    const int g = lane >> 4, q = (lane & 15) >> 2, p = lane & 3;
    const LAS bf16* a = t + (r0 + 8 * g + q) * ld + c0 + 4 * p;
    const s16x4 lo = __builtin_amdgcn_ds_read_tr16_b64_v4i16((LAS s16x4*)a);
    const s16x4 hi = __builtin_amdgcn_ds_read_tr16_b64_v4i16((LAS s16x4*)(a + 4 * ld));
    return (bf16x8){lo[0], lo[1], lo[2], lo[3], hi[0], hi[1], hi[2], hi[3]};
}
#define LDS_FENCE() do { asm volatile("s_waitcnt lgkmcnt(0)" ::: "memory"); __builtin_amdgcn_wave_barrier(); } while (0)

struct Args {
    const float* in[22]; float* out; unsigned char* ws;
};
enum { I_X = 0, I_C, I_CTX, I_CCTX, I_WMOD, I_BMOD, I_LNW, I_LNB, I_ABWIN, I_ABGB, I_ABNW, I_ABSINK, I_ABWOUT, I_GWIN, I_GGUP, I_GGB, I_GNW, I_GWOUT, I_PWQ, I_PKEYS, I_PU, I_PV };

__device__ __forceinline__ const float* srow_c(const float* lat, const float* ctx, int r) { const int b = r / PB, p = r - b * PB; return p < LC ? ctx + (size_t)(b * LC + p) * D : lat + (size_t)(b * SEQ + p - LC) * D; }
__device__ __forceinline__ float* srow(float* lat, float* ctx, int r) { const int b = r / PB, p = r - b * PB; return p < LC ? ctx + (size_t)(b * LC + p) * D : lat + (size_t)(b * SEQ + p - LC) * D; }

__device__ __forceinline__ void p0_transpose_item(const float* W, int K, int ldw, int c0, int ncols, bf16* WT, int row_off, LAS float* scr, int item, int lane,
                                                  int s0lo, int s0hi, float s0, int s1lo, int s1hi, float s1) {
    const int nblk = ncols / 32, kb = item / nblk, nb = item % nblk, k0 = 64 * kb, n0 = 32 * nb;
#pragma unroll 8
    for (int i = 0; i < 32; ++i) { const int kk = 2 * i + (lane >> 5); scr[kk * 33 + (lane & 31)] = W[(size_t)(k0 + kk) * ldw + c0 + n0 + (lane & 31)]; }
    asm volatile("s_waitcnt lgkmcnt(0)" ::: "memory");
    const int c = lane & 7;
#pragma unroll
    for (int j = 0; j < 4; ++j) { const int n = (lane >> 3) + 8 * j; const LAS float* s = scr + (8 * c) * 33 + n;
        const int dr = row_off + n0 + n; float sc = 1.f; if (dr >= s0lo && dr < s0hi) sc = s0; if (dr >= s1lo && dr < s1hi) sc = s1;
        v4u o; o.x = pk2(s[0 * 33] * sc, s[1 * 33] * sc); o.y = pk2(s[2 * 33] * sc, s[3 * 33] * sc); o.z = pk2(s[4 * 33] * sc, s[5 * 33] * sc); o.w = pk2(s[6 * 33] * sc, s[7 * 33] * sc);
        *(v4u*)(WT + (size_t)dr * K + k0 + 8 * c) = o; }
    asm volatile("s_waitcnt lgkmcnt(0)" ::: "memory");
}
__device__ __forceinline__ void cvt_f32_bf16(const float* src, bf16* dst, size_t n, int gtid, int gthreads) {
    const size_t nch = n / 8;
    for (size_t i = gtid; i < nch; i += gthreads) { const f32x4 a = *(const f32x4*)(src + i * 8), b = *(const f32x4*)(src + i * 8 + 4);
        v4u o; o.x = pk2(a[0], a[1]); o.y = pk2(a[2], a[3]); o.z = pk2(b[0], b[1]); o.w = pk2(b[2], b[3]); *(v4u*)(dst + i * 8) = o; }
}
typedef float v16f __attribute__((ext_vector_type(16)));
typedef float v32f __attribute__((ext_vector_type(32)));
typedef unsigned v6u __attribute__((ext_vector_type(6)));
typedef unsigned v3u __attribute__((ext_vector_type(3)));
__device__ __forceinline__ void cvt_rows_fp6(const float* src, unsigned char* dst, float* inv, int nrows, int gw, int NGW, int lane) {
    const int hl = lane & 31, hh = lane >> 5;
    for (int r2 = gw; r2 < nrows / 2; r2 += NGW) {
        const int r = 2 * r2 + hh; const float* sp = src + (size_t)r * 1024 + 32 * hl;
        f32x4 x[8]; float m = 0.f;
#pragma unroll
        for (int q = 0; q < 8; ++q) { x[q] = *(const f32x4*)(sp + 4 * q); m = fmaxf(m, fmaxf(fmaxf(fabsf(x[q][0]), fabsf(x[q][1])), fmaxf(fabsf(x[q][2]), fabsf(x[q][3])))); }
        m = fmaxf(m, dppmov_f<0xB1>(m)); m = fmaxf(m, dppmov_f<0x4E>(m)); m = fmaxf(m, dppmov_f<0x141>(m)); m = fmaxf(m, dppmov_f<0x128>(m)); m = fmaxf(m, __shfl_xor(m, 16));
        const float sc = m > 0.f ? 7.0f / m : 1.f;
        v16f a, b;
#pragma unroll
        for (int q = 0; q < 8; ++q) { a[2 * q] = x[q][0] * sc; b[2 * q] = x[q][1] * sc; a[2 * q + 1] = x[q][2] * sc; b[2 * q + 1] = x[q][3] * sc; }
        const v6u p = __builtin_amdgcn_cvt_scalef32_2xpk16_fp6_f32(a, b, 1.0f);
        unsigned char* dp = dst + (size_t)r * 768 + 24 * hl;
        *(v2u*)dp = (v2u){p[0], p[1]}; *(v2u*)(dp + 8) = (v2u){p[2], p[3]}; *(v2u*)(dp + 16) = (v2u){p[4], p[5]};
        if (hl == 0) inv[r] = m > 0.f ? m / 7.0f : 1.f;
    }
}
__device__ __forceinline__ void cvt_rows_fp4(const float* src, unsigned char* dst, float* inv, int nrows, int gw, int NGW, int lane) {
    const int hl = lane & 31, hh = lane >> 5;
    for (int r2 = gw; r2 < nrows / 2; r2 += NGW) {
        const int r = 2 * r2 + hh; const float* sp = src + (size_t)r * 1024 + 32 * hl;
        f32x4 x[8]; float m = 0.f;
#pragma unroll
        for (int q = 0; q < 8; ++q) { x[q] = *(const f32x4*)(sp + 4 * q); m = fmaxf(m, fmaxf(fmaxf(fabsf(x[q][0]), fabsf(x[q][1])), fmaxf(fabsf(x[q][2]), fabsf(x[q][3])))); }
        m = fmaxf(m, dppmov_f<0xB1>(m)); m = fmaxf(m, dppmov_f<0x4E>(m)); m = fmaxf(m, dppmov_f<0x141>(m)); m = fmaxf(m, dppmov_f<0x128>(m)); m = fmaxf(m, __shfl_xor(m, 16));
        const float sc = m > 0.f ? 6.0f / m : 1.f;
        unsigned w[4];
#pragma unroll
        for (int d = 0; d < 4; ++d) { unsigned t = 0u;
            t = __builtin_amdgcn_cvt_scalef32_pk_fp4_f32(t, x[2 * d][0] * sc, x[2 * d][1] * sc, 1.0f, 0); t = __builtin_amdgcn_cvt_scalef32_pk_fp4_f32(t, x[2 * d][2] * sc, x[2 * d][3] * sc, 1.0f, 1);
            t = __builtin_amdgcn_cvt_scalef32_pk_fp4_f32(t, x[2 * d + 1][0] * sc, x[2 * d + 1][1] * sc, 1.0f, 2); t = __builtin_amdgcn_cvt_scalef32_pk_fp4_f32(t, x[2 * d + 1][2] * sc, x[2 * d + 1][3] * sc, 1.0f, 3);
            w[d] = t; }
        *(v4u*)(dst + (size_t)r * 512 + 16 * hl) = (v4u){w[0], w[1], w[2], w[3]};
        if (hl == 0) inv[r] = m > 0.f ? m / 6.0f : 1.f;
    }
}
__device__ __forceinline__ void p0_prologue(const Args& A, LAS unsigned char* lds, int vcu, int G, int wave, int lane, int tid) {
    unsigned char* ws = A.ws;
    const int gw = vcu * 8 + wave, NGW = G * 8, gtid = vcu * 512 + tid, gthreads = G * 512;
    LAS float* sil = (LAS float*)lds;
    for (int i = tid; i < 9 * 1024; i += 512) { const float v = i < 8192 ? A.in[I_C][i] : A.in[I_CCTX][i - 8192]; sil[i] = siluf_(v); }
    __syncthreads();
    float* MOD = (float*)(ws + WS_MOD);
    LAS float* part = (LAS float*)(lds + 40960);
    for (int it = vcu; it < 2 * 96; it += G) {
        const int l = it / 96, n = (it % 96) * 64 + lane; const float* wm = A.in[I_WMOD] + (size_t)l * 1024 * 6144 + (size_t)(128 * wave) * 6144 + n;
        float acc[9];
#pragma unroll
        for (int r = 0; r < 9; ++r) acc[r] = 0.f;
#pragma unroll 8
        for (int k = 0; k < 128; ++k) { const float w = wm[(size_t)k * 6144];
#pragma unroll
            for (int r = 0; r < 9; ++r) acc[r] += sil[r * 1024 + 128 * wave + k] * w; }
        __syncthreads();
#pragma unroll
        for (int r = 0; r < 9; ++r) part[(wave * 9 + r) * 64 + lane] = acc[r];
        __syncthreads();
        for (int i = tid; i < 9 * 64; i += 512) { float sum = 0.f;
#pragma unroll
            for (int w8 = 0; w8 < 8; ++w8) sum += part[w8 * 576 + i];
            const int r = i >> 6, c = (it % 96) * 64 + (i & 63); MOD[(size_t)(l * 9 + r) * 6144 + c] = sum + A.in[I_BMOD][l * 6144 + c]; }
    }
    __syncthreads();
    LAS float* scr = (LAS float*)(lds + 40960 + wave * 8704);
    constexpr int I_AB1 = 16 * 64, I_AB2 = 16 * 24, I_ABO = 16 * 32, I_C1 = 16 * 96, I_CO = 16 * 32, I_Q = 16 * 64;
    constexpr int NITEMS = I_AB1 + I_AB2 + I_ABO + I_C1 + I_CO + 2 * I_Q;
    const float rs128 = 0.08838834764831845f;
    for (int it = gw; it < NITEMS; it += NGW) {
        int r = it;
        if (r < I_AB1) { p0_transpose_item(A.in[I_ABWIN], 1024, 2832, 0, 2048, (bf16*)(ws + WS_WAB), 0, scr, r, lane, 512, 1024, rs128, 0, 0, 1.f); continue; } r -= I_AB1;
        if (r < I_AB2) { p0_transpose_item(A.in[I_ABWIN], 1024, 2832, 2064, 768, (bf16*)(ws + WS_WAB), 2048, scr, r, lane, 2048, 2560, 0.125f, 0, 0, 1.f); continue; } r -= I_AB2;
        if (r < I_ABO) { p0_transpose_item(A.in[I_ABWOUT], 1024, 1024, 0, 1024, (bf16*)(ws + WS_WABO), 0, scr, r, lane, 0, 0, 1.f, 0, 0, 1.f); continue; } r -= I_ABO;
        if (r < I_C1) { p0_transpose_item(A.in[I_GWIN], 1024, 3104, 0, 3072, (bf16*)(ws + WS_WC), 0, scr, r, lane, 0, 512, rs128, 0, 0, 1.f); continue; } r -= I_C1;
        if (r < I_CO) { p0_transpose_item(A.in[I_GWOUT], 1024, 1024, 0, 1024, (bf16*)(ws + WS_WCO), 0, scr, r, lane, 0, 0, 1.f, 0, 0, 1.f); continue; } r -= I_CO;
        if (r < I_Q) { p0_transpose_item(A.in[I_PWQ], 1024, 2048, 0, 2048, (bf16*)(ws + WS_WQ0), 0, scr, r, lane, 0, 0, 1.f, 0, 0, 1.f); continue; } r -= I_Q;
        p0_transpose_item(A.in[I_PWQ] + (size_t)1024 * 2048, 1024, 2048, 0, 2048, (bf16*)(ws + WS_WQ1), 0, scr, r, lane, 0, 0, 1.f, 0, 0, 1.f);
    }
    for (int i = gtid; i < 16 * 1024; i += gthreads) { const int g = i >> 10, k = i & 1023; ((float*)(ws + WS_WG))[i] = A.in[I_ABWIN][(size_t)k * 2832 + 2048 + g]; }
    for (int i = gtid; i < 32 * 1024; i += gthreads) { const int g = i >> 10, k = i & 1023; ((float*)(ws + WS_WLOW))[i] = A.in[I_GWIN][(size_t)k * 3104 + 3072 + g]; }
    for (int i = gtid; i < 64 * 16; i += gthreads) { const int pos = i >> 4, f = i & 15; const float inv = powf(10000.f, -(float)f / 16.f); const float ang = (float)pos * inv;
        ((float*)(ws + WS_ROPE))[2 * i] = cosf(ang); ((float*)(ws + WS_ROPE))[2 * i + 1] = sinf(ang); }
    cvt_f32_bf16(A.in[I_PKEYS], (bf16*)(ws + WS_KEYS), (size_t)2 * 8 * 2 * 128 * 128, gtid, gthreads);
    cvt_rows_fp4(A.in[I_PU], ws + WS_U, (float*)(ws + WS_SCL), 2 * NEXP, gw, NGW, lane);
    cvt_rows_fp4(A.in[I_PV], ws + WS_V, (float*)(ws + WS_SCL) + 2 * NEXP, 2 * NEXP, gw, NGW, lane);
}

__device__ __forceinline__ void split8(const float* v, bf16x8& hi, bf16x8& lo) {
#pragma unroll
    for (int j = 0; j < 8; ++j) { const unsigned h = f2bf(v[j]); const float hf = __builtin_bit_cast(float, h << 16); hi[j] = (short)h; lo[j] = (short)f2bf(v[j] - hf); }
}
template <int NG>
__device__ __forceinline__ void h_phase(const float* lat, const float* ctx, const float* mod  , bf16* HB, const float* WGT, float* GL, LAS unsigned char* lds, int vcu, int G, int wave, int lane, int tid) {
    constexpr int NT = NG / 16;
    LAS float* part = (LAS float*)lds;
    const int g = lane >> 4, c16 = lane & 15;
    bf16x8 bhi[NT][4], blo[NT][4];
#pragma unroll
    for (int nt = 0; nt < NT; ++nt)
#pragma unroll
        for (int ks = 0; ks < 4; ++ks) { const float* wp = WGT + (size_t)(16 * nt + c16) * 1024 + 128 * wave + 32 * ks + 8 * g;
            const f32x4 w0 = *(const f32x4*)wp, w1 = *(const f32x4*)(wp + 4); const float wv[8] = {w0[0], w0[1], w0[2], w0[3], w1[0], w1[1], w1[2], w1[3]}; split8(wv, bhi[nt][ks], blo[nt][ks]); }
    for (int tile = vcu; tile < TT / 16; tile += G) {
        const int r0 = tile * 16, b = r0 / PB, p0 = r0 - b * PB; const float* mr = mod + (size_t)(p0 < LC ? 8 : b) * 6144 + 128 * wave + 8 * g;
        const int row = r0 + c16; const float* xr = srow_c(lat, ctx, row) + 128 * wave + 8 * g;
        f32x4 xa[4][2], sha[4][2], sca[4][2];
#pragma unroll
        for (int ks = 0; ks < 4; ++ks)
#pragma unroll
            for (int q = 0; q < 2; ++q) { xa[ks][q] = *(const f32x4*)(xr + 32 * ks + 4 * q); sha[ks][q] = *(const f32x4*)(mr + 32 * ks + 4 * q); sca[ks][q] = *(const f32x4*)(mr + 1024 + 32 * ks + 4 * q); }
        f32x4 acc[NT];
#pragma unroll
        for (int nt = 0; nt < NT; ++nt) acc[nt] = (f32x4){0.f, 0.f, 0.f, 0.f};
#pragma unroll
        for (int ks = 0; ks < 4; ++ks) {
            float hv[8];
#pragma unroll
            for (int q = 0; q < 2; ++q)
#pragma unroll
                for (int i = 0; i < 4; ++i) hv[4 * q + i] = xa[ks][q][i] * (sca[ks][q][i] + 1.0f) + sha[ks][q][i];
            bf16x8 ahi, alo; split8(hv, ahi, alo);
            *(bf16x8*)(HB + (size_t)row * D + 128 * wave + 32 * ks + 8 * g) = ahi;
#pragma unroll
            for (int nt = 0; nt < NT; ++nt) { acc[nt] = mma(ahi, bhi[nt][ks], acc[nt]); acc[nt] = mma(ahi, blo[nt][ks], acc[nt]); acc[nt] = mma(alo, bhi[nt][ks], acc[nt]); }
        }
        __syncthreads();
#pragma unroll
        for (int nt = 0; nt < NT; ++nt)
#pragma unroll
            for (int r = 0; r < 4; ++r) part[(wave * 16 + 4 * g + r) * NG + 16 * nt + c16] = acc[nt][r];
        __syncthreads();
        for (int i = tid; i < 16 * NG; i += 512) { float sum = 0.f;
#pragma unroll
            for (int w8 = 0; w8 < 8; ++w8) sum += part[w8 * 16 * NG + i];
            GL[(size_t)r0 * NG + i] = sum; }
    }
}

__device__ __forceinline__ void ln_row(const float* sr, float* xr, const bf16* yrow, const float* mr, const float* lnw, const float* lnb, bf16* hrow, int lane, int dry, bool active) {
    f32x4 v[4]; float s = 0.f;
#pragma unroll
    for (int j = 0; j < 4; ++j) { const int c = 4 * lane + 256 * j; const f32x4 x = *(const f32x4*)(sr + c), g1 = *(const f32x4*)(mr + 2048 + c); const v2u yw = *(const v2u*)(yrow + c);
        v[j][0] = DN_ALPHA * x[0] + g1[0] * bflo(yw.x); v[j][1] = DN_ALPHA * x[1] + g1[1] * bfhi(yw.x); v[j][2] = DN_ALPHA * x[2] + g1[2] * bflo(yw.y); v[j][3] = DN_ALPHA * x[3] + g1[3] * bfhi(yw.y);
        s += (v[j][0] + v[j][1]) + (v[j][2] + v[j][3]); }
    const float mean = wave_sum(s) * (1.f / D); float s2 = 0.f;
#pragma unroll
    for (int j = 0; j < 4; ++j) { v[j] = v[j] - mean; s2 += (v[j][0] * v[j][0] + v[j][1] * v[j][1]) + (v[j][2] * v[j][2] + v[j][3] * v[j][3]); }
    const float rstd = 1.f / sqrtf(wave_sum(s2) * (1.f / D) + LN_EPS);
    if (active) {
#pragma unroll
    for (int j = 0; j < 4; ++j) { const int c = 4 * lane + 256 * j; const f32x4 w = *(const f32x4*)(lnw + c), bb = *(const f32x4*)(lnb + c);
        const f32x4 x1 = v[j] * rstd * w + bb; if (!dry) *(f32x4*)(xr + c) = x1;
        const f32x4 sh = *(const f32x4*)(mr + 3072 + c), sc = *(const f32x4*)(mr + 4096 + c); const f32x4 hp = x1 * (sc + 1.0f) + sh;
        v2u o; o.x = pk2(hp[0], hp[1]); o.y = pk2(hp[2], hp[3]); if (!dry) *(v2u*)(hrow + c) = o; }
    }
}
__device__ __forceinline__ void ln_phase(const float* slat, const float* sctx, float* lat, float* ctx, const bf16* Y, const float* mod, const float* lnw, const float* lnb, bf16* HB, int gw, int NGW, int lane, int dry, bool lat_only) {
    const int nrows = lat_only ? NB * SEQ : TT;
    for (int i0 = gw; i0 < nrows; i0 += 2 * NGW) {
        const int i1 = i0 + NGW; const bool has1 = i1 < nrows; const int r0 = map_row(i0, lat_only), r1c = map_row(has1 ? i1 : i0, lat_only);
        const int b0 = r0 / PB, p0 = r0 - b0 * PB, b1 = r1c / PB, p1 = r1c - b1 * PB;
        ln_row(srow_c(slat, sctx, r0), srow(lat, ctx, r0), Y + (size_t)r0 * D, mod + (size_t)(p0 < LC ? 8 : b0) * 6144, lnw, lnb, HB + (size_t)r0 * D, lane, dry, true);
        ln_row(srow_c(slat, sctx, r1c), srow(lat, ctx, r1c), Y + (size_t)r1c * D, mod + (size_t)(p1 < LC ? 8 : b1) * 6144, lnw, lnb, HB + (size_t)r1c * D, lane, dry, has1);
    }
}

constexpr int AT_LD = 72;
__device__ __forceinline__ bf16x8 frag_tr_perm(const LAS bf16* t, int ld, int r0, int c0, int lane) {
    const int g = lane >> 4, q = (lane & 15) >> 2, p = lane & 3;
    const LAS bf16* a = t + (r0 + 4 * g + q) * ld + c0 + 4 * p;
    const s16x4 lo = __builtin_amdgcn_ds_read_tr16_b64_v4i16((LAS s16x4*)a);
    const s16x4 hi = __builtin_amdgcn_ds_read_tr16_b64_v4i16((LAS s16x4*)(a + 16 * ld));
    return (bf16x8){lo[0], lo[1], lo[2], lo[3], hi[0], hi[1], hi[2], hi[3]};
}
__device__ __forceinline__ void attn_phase(const bf16* P, bf16* CAT, const float* sink, const float* ropetab, LAS unsigned char* lds, unsigned* qctr, int vcu, int G, int wave, int lane, int tid) {
    LAS bf16* Kt = (LAS bf16*)lds;
    LAS bf16* Vt = (LAS bf16*)(lds + 9216);
    LAS bf16* Qw = (LAS bf16*)(lds + 18432 + wave * 4608);
    const int g = lane >> 4, c16 = lane & 15;
    volatile LAS int* qslot = (volatile LAS int*)(lds + MISC_OFF) + 12;
    for (;;) {
        if (tid == 0) *qslot = (int)__hip_atomic_fetch_add(qctr, 1u, __ATOMIC_RELAXED, __HIP_MEMORY_SCOPE_AGENT);
        __syncthreads();
        const int item = *qslot;
        if (item >= 1024 + 64) break;
        const bool is_ctx = item >= 1024;
        int b, hk, nb;
        if (!is_ctx) { b = item >> 7; hk = (item >> 6) & 1; nb = item & 63; } else { const int it = item - 1024; b = it >> 3; hk = (it >> 2) & 1; nb = it & 3; }
        const int head = hk * 4 + (wave >> 1);
        const int qrow0 = b * PB + (is_ctx ? 0 : LC) + nb * 64 + (wave & 1) * 32;
        const int qlat0 = nb * 64 + (wave & 1) * 32;
        __syncthreads();
#pragma unroll
        for (int i = 0; i < 4; ++i) { const int cidx = lane + 64 * i, rr = cidx >> 3, ch = cidx & 7;
            const v4u raw = *(const v4u*)(P + (size_t)(qrow0 + rr) * N_AB + 2048 + head * 64 + ch * 8); v4u o = raw;
            if (!is_ctx) { const int tl = qlat0 + rr; const int pos = (ch < 4) ? (tl >> 6) : (tl & 63); const float* tb = ropetab + (size_t)(pos * 16 + (ch & 3) * 4) * 2;
                const unsigned wv[4] = {raw.x, raw.y, raw.z, raw.w}; unsigned ov[4];
#pragma unroll
                for (int k = 0; k < 4; ++k) { const float x1 = bflo(wv[k]), x2 = bfhi(wv[k]), c = tb[2 * k], s = tb[2 * k + 1]; ov[k] = pk2(x1 * c - x2 * s, x1 * s + x2 * c); }
                o.x = ov[0]; o.y = ov[1]; o.z = ov[2]; o.w = ov[3]; }
            *(LAS v4u*)(Qw + rr * AT_LD + ch * 8) = o; }
        LDS_FENCE();
        bf16x8 qf[2][2];
#pragma unroll
        for (int mt = 0; mt < 2; ++mt)
#pragma unroll
            for (int ks = 0; ks < 2; ++ks) qf[mt][ks] = frag_row(Qw, AT_LD, 16 * mt, 32 * ks, lane);
        LDS_FENCE();
        f32x4 o[2][4]; float mrun[2], lrun[2];
        const float sk = sink[head];
#pragma unroll
        for (int qt = 0; qt < 2; ++qt) { mrun[qt] = sk; lrun[qt] = 1.f; }
#pragma unroll
        for (int qt = 0; qt < 2; ++qt)
#pragma unroll
            for (int nt = 0; nt < 4; ++nt) o[qt][nt] = (f32x4){0.f, 0.f, 0.f, 0.f};
        const int nkt = is_ctx ? 4 : 9;
        const int srr = tid >> 3, sch = tid & 7;
        int kt = 0; f32x2 trope[4];
#pragma unroll
        for (int i = 0; i < 4; ++i) trope[i] = (f32x2){1.f, 0.f};
        v4u kraw = *(const v4u*)(P + (size_t)(b * PB + srr) * N_AB + 2560 + hk * 64 + sch * 8), vraw = *(const v4u*)(P + (size_t)(b * PB + srr) * N_AB + 2688 + hk * 64 + sch * 8);
        while (kt < nkt) {
            const int kp0 = nb * 64 - 128 + 64 * (kt - 4);
            int kn = kt + 1;
            while (kn < nkt && kn >= 4 && ((nb * 64 - 128 + 64 * (kn - 4)) < 0 || (nb * 64 - 128 + 64 * (kn - 4)) >= SEQ)) ++kn;
            __syncthreads();
            { v4u o = kraw;
              if (kt >= 4) { const unsigned wv[4] = {kraw.x, kraw.y, kraw.z, kraw.w}; unsigned ov[4];
#pragma unroll
                  for (int i = 0; i < 4; ++i) { const float x1 = bflo(wv[i]), x2 = bfhi(wv[i]), c = trope[i][0], sn = trope[i][1]; ov[i] = pk2(x1 * c - x2 * sn, x1 * sn + x2 * c); }
                  o.x = ov[0]; o.y = ov[1]; o.z = ov[2]; o.w = ov[3]; }
              *(LAS v4u*)(Kt + srr * AT_LD + sch * 8) = o; *(LAS v4u*)(Vt + srr * AT_LD + sch * 8) = vraw; }
            if (kn < nkt) { const int kpn = nb * 64 - 128 + 64 * (kn - 4); const int krn = b * PB + (kn < 4 ? 64 * kn : LC + kpn);
                kraw = *(const v4u*)(P + (size_t)(krn + srr) * N_AB + 2560 + hk * 64 + sch * 8); vraw = *(const v4u*)(P + (size_t)(krn + srr) * N_AB + 2688 + hk * 64 + sch * 8);
                if (kn >= 4) { const int tl = kpn + srr; const int pos = (sch < 4) ? (tl >> 6) : (tl & 63); const f32x2* tb = (const f32x2*)(ropetab + (size_t)(pos * 16 + (sch & 3) * 4) * 2);
#pragma unroll
                    for (int i = 0; i < 4; ++i) trope[i] = tb[i]; } }
            __syncthreads();
            const bool need_mask = (kt == 4) || (kt == 8);
            bf16x8 kf[4][2];
#pragma unroll
            for (int km = 0; km < 4; ++km)
#pragma unroll
                for (int ks = 0; ks < 2; ++ks) kf[km][ks] = frag_row(Kt, AT_LD, 16 * km, 32 * ks, lane);
            bf16x8 pa[2][2];
#pragma unroll
            for (int qt = 0; qt < 2; ++qt) {
                f32x4 st[4];
#pragma unroll
                for (int km = 0; km < 4; ++km) { st[km] = (f32x4){0.f, 0.f, 0.f, 0.f};
#pragma unroll
                    for (int ks = 0; ks < 2; ++ks) st[km] = mma(kf[km][ks], qf[qt][ks], st[km]); }
                if (need_mask) {
#pragma unroll
                    for (int km = 0; km < 4; ++km)
#pragma unroll
                        for (int r = 0; r < 4; ++r) { const int dq = (kp0 + 16 * km + 4 * g + r) - (qlat0 + 16 * qt + c16); if (dq > 128 || dq < -128) st[km][r] = -3.0e38f; } }
                float mx = fmaxf(fmaxf(fmaxf(st[0][0], st[0][1]), fmaxf(st[0][2], st[0][3])), fmaxf(fmaxf(st[1][0], st[1][1]), fmaxf(st[1][2], st[1][3])));
                mx = fmaxf(mx, fmaxf(fmaxf(fmaxf(st[2][0], st[2][1]), fmaxf(st[2][2], st[2][3])), fmaxf(fmaxf(st[3][0], st[3][1]), fmaxf(st[3][2], st[3][3]))));
                mx = fmaxf(mx, __shfl_xor(mx, 16)); mx = fmaxf(mx, __shfl_xor(mx, 32));
                const float mnew = fmaxf(mrun[qt], mx), alpha = __expf(mrun[qt] - mnew);
                float ps = 0.f;
#pragma unroll
                for (int km = 0; km < 4; ++km)
#pragma unroll
                    for (int r = 0; r < 4; ++r) { const float pv = __expf(st[km][r] - mnew); st[km][r] = pv; ps += pv; }
                ps += __shfl_xor(ps, 16); ps += __shfl_xor(ps, 32);
                lrun[qt] = lrun[qt] * alpha + ps; mrun[qt] = mnew;
#pragma unroll
                for (int ks2 = 0; ks2 < 2; ++ks2) { const unsigned w0 = pk2(st[2 * ks2][0], st[2 * ks2][1]), w1 = pk2(st[2 * ks2][2], st[2 * ks2][3]), w2 = pk2(st[2 * ks2 + 1][0], st[2 * ks2 + 1][1]), w3 = pk2(st[2 * ks2 + 1][2], st[2 * ks2 + 1][3]);
                    const v4u wv = (v4u){w0, w1, w2, w3}; pa[qt][ks2] = __builtin_bit_cast(bf16x8, wv); }
#pragma unroll
                for (int r = 0; r < 4; ++r) { const float ar = __shfl(alpha, (lane & 48) + 4 * g + r);
#pragma unroll
                    for (int nt = 0; nt < 4; ++nt) o[qt][nt][r] *= ar; }
            }
#pragma unroll
            for (int ks2 = 0; ks2 < 2; ++ks2) {
                bf16x8 vf[4];
#pragma unroll
                for (int nt = 0; nt < 4; ++nt) vf[nt] = frag_tr_perm(Vt, AT_LD, 32 * ks2, 16 * nt, lane);
#pragma unroll
                for (int qt = 0; qt < 2; ++qt)
#pragma unroll
                    for (int nt = 0; nt < 4; ++nt) o[qt][nt] = mma(pa[qt][ks2], vf[nt], o[qt][nt]); }
            LDS_FENCE();
            kt = kn;
        }
#pragma unroll
        for (int qt = 0; qt < 2; ++qt)
#pragma unroll
            for (int r = 0; r < 4; ++r) { const float inv = 1.f / __shfl(lrun[qt], (lane & 48) + 4 * g + r); bf16* orow = CAT + (size_t)(qrow0 + 16 * qt + 4 * g + r) * D + 512 + head * 64;
#pragma unroll
                for (int nt = 0; nt < 4; ++nt) orow[16 * nt + c16] = (bf16)f2bf(o[qt][nt][r] * inv); }
    }
}

__device__ __forceinline__ float wave_prefix_sum(float v) {
    v += __builtin_bit_cast(float, __builtin_amdgcn_update_dpp(0, __builtin_bit_cast(int, v), 0x111, 0xf, 0xf, true)); v += __builtin_bit_cast(float, __builtin_amdgcn_update_dpp(0, __builtin_bit_cast(int, v), 0x112, 0xf, 0xf, true));
    v += __builtin_bit_cast(float, __builtin_amdgcn_update_dpp(0, __builtin_bit_cast(int, v), 0x114, 0xf, 0xf, true)); v += __builtin_bit_cast(float, __builtin_amdgcn_update_dpp(0, __builtin_bit_cast(int, v), 0x118, 0xf, 0xf, true));
    v += __builtin_bit_cast(float, __builtin_amdgcn_update_dpp(0, __builtin_bit_cast(int, v), 0x142, 0xa, 0xf, false)); v += __builtin_bit_cast(float, __builtin_amdgcn_update_dpp(0, __builtin_bit_cast(int, v), 0x143, 0xc, 0xf, false));
    return v;
}
__device__ __forceinline__ float wave_prefix_max(float v) {
    const int ninf = (int)0xff800000u;
    v = fmaxf(v, __builtin_bit_cast(float, __builtin_amdgcn_update_dpp(ninf, __builtin_bit_cast(int, v), 0x111, 0xf, 0xf, false))); v = fmaxf(v, __builtin_bit_cast(float, __builtin_amdgcn_update_dpp(ninf, __builtin_bit_cast(int, v), 0x112, 0xf, 0xf, false)));
    v = fmaxf(v, __builtin_bit_cast(float, __builtin_amdgcn_update_dpp(ninf, __builtin_bit_cast(int, v), 0x114, 0xf, 0xf, false))); v = fmaxf(v, __builtin_bit_cast(float, __builtin_amdgcn_update_dpp(ninf, __builtin_bit_cast(int, v), 0x118, 0xf, 0xf, false)));
    v = fmaxf(v, __builtin_bit_cast(float, __builtin_amdgcn_update_dpp(ninf, __builtin_bit_cast(int, v), 0x142, 0xa, 0xf, false))); v = fmaxf(v, __builtin_bit_cast(float, __builtin_amdgcn_update_dpp(ninf, __builtin_bit_cast(int, v), 0x143, 0xc, 0xf, false)));
    return v;
}
__device__ __forceinline__ void mlstm_gate_scan(const float* GL  , const float* gate_b  , unsigned char* ws, int gw, int NGW, int lane) {
    float* BQ = (float*)(ws + WS_BQ); float* CQ = (float*)(ws + WS_CQ); float* EM = (float*)(ws + WS_EM); float* AI = (float*)(ws + WS_AI);
    float* AST = (float*)(ws + WS_AST); float* CL = (float*)(ws + WS_CL);
    for (int chain = gw; chain < 64; chain += NGW) {
        const int dir = chain >> 5, b = (chain >> 2) & 7, h = chain & 3;
        const float bi = gate_b[dir * 8 + h], bfg = gate_b[dir * 8 + 4 + h];
        float m_st = 0.f;
        float gi_n, gf_n;
        { const int j0 = dir == 0 ? 0 : 3; const int p0 = j0 * 64 + (dir == 0 ? lane : 63 - lane); const float* gr = GL + (size_t)(b * PB + p0) * 16 + dir * 8; gi_n = gr[h]; gf_n = gr[4 + h]; }
        for (int sc = 0; sc < NCH; ++sc) {
            const int j = dir == 0 ? sc : (sc < 4 ? 3 - sc : 71 - sc);
            const int p = j * 64 + (dir == 0 ? lane : 63 - lane);
            const float li = gi_n + bi, lf = logsigmoidf_(gf_n + bfg);
            if (sc + 1 < NCH) { const int sn = sc + 1; const int jn = dir == 0 ? sn : (sn < 4 ? 3 - sn : 71 - sn); const int pn = jn * 64 + (dir == 0 ? lane : 63 - lane);
                const float* gr = GL + (size_t)(b * PB + pn) * 16 + dir * 8; gi_n = gr[h]; gf_n = gr[4 + h]; }
            const float cum = wave_prefix_sum(lf);
            const float bb = li - cum; const float pm = wave_prefix_max(bb);
            const float c = fmaxf(m_st, pm);
            const size_t ti = (size_t)chain * PB + p;
            BQ[ti] = bb; CQ[ti] = c; EM[ti] = __expf(-(cum + c)); AI[ti] = __expf(m_st - c);
            const float cl = __builtin_bit_cast(float, __builtin_amdgcn_readlane(__builtin_bit_cast(int, c), 63)), tot = __builtin_bit_cast(float, __builtin_amdgcn_readlane(__builtin_bit_cast(int, cum), 63));
            if (lane == 0) { CL[chain * NCH + j] = cl; AST[chain * NCH + j] = __expf(m_st - cl); }
            m_st = tot + cl;
        }
    }
}


__device__ __forceinline__ float logsig_fast(float x) { return fminf(x, 0.f) - __logf(1.f + __expf(-fabsf(x))); }
__device__ __forceinline__ void gla_prep(bf16* P, bf16* QKR, const float* LOW  , const float* gate_up  , const float* gate_b  , unsigned char* ws,
                                         LAS unsigned char* lds, int vcu, int G, int tid, int dry) {
    float* ET = (float*)(ws + WS_ET);
    LAS float* lowt = (LAS float*)lds;
    LAS bf16* qs = (LAS bf16*)(lds + 8192);
    LAS bf16* ks = (LAS bf16*)(lds + 24576);
    LAS float* LA = (LAS float*)(lds + 40960);
    LAS float* HT = (LAS float*)(lds + 106496);
    const int dc = tid & 255, dir = dc >> 7, ch = dc & 127, half = tid >> 8;
    for (int item = vcu; item < NB * NCH * 4; item += G) {
        const int b = item / (NCH * 4), j = (item >> 2) % NCH, h = item & 3;
        const int row0 = b * PB + j * 64, c = h * 128 + ch;
        __syncthreads();
        for (int i = tid; i < 64 * 32; i += 512) lowt[i] = LOW[(size_t)row0 * 32 + i];
#pragma unroll
        for (int i = 0; i < 2; ++i) { const int cidx = tid + 512 * i, rr = cidx >> 4, c8 = cidx & 15; const bf16* src = P + (size_t)(row0 + rr) * N_C + h * 128 + c8 * 8;
            *(LAS v4u*)(qs + rr * 128 + c8 * 8) = *(const v4u*)src; *(LAS v4u*)(ks + rr * 128 + c8 * 8) = *(const v4u*)(src + 512); }
        float gu[16];
#pragma unroll
        for (int k = 0; k < 16; ++k) gu[k] = gate_up[(size_t)(dir * 16 + k) * 512 + c];
        const float gb = gate_b[dir * 512 + c];
        __syncthreads();
        float hsum = 0.f;
#pragma unroll 4
        for (int i = 0; i < 32; ++i) { const int t = half * 32 + i; float x = gb;
#pragma unroll
            for (int k = 0; k < 16; ++k) x += lowt[t * 32 + dir * 16 + k] * gu[k];
            const float la = logsig_fast(x) * (1.f / 16.f); LA[t * 256 + dc] = la; hsum += la; }
        HT[half * 256 + dc] = hsum;
        __syncthreads();
        float cum = (dir == 0) ? (half == 1 ? HT[dc] : 0.f) : (half == 0 ? HT[256 + dc] : 0.f);
#pragma unroll 4
        for (int i = 0; i < 32; ++i) { const int t = half * 32 + (dir == 0 ? i : 31 - i);
            cum += LA[t * 256 + dc];
            const float e = __expf(cum), ei = __expf(-cum);
            const size_t ro = (size_t)(row0 + t) * N_C;
            const float qv = bf2f(qs[t * 128 + ch]), kv = bf2f(ks[t * 128 + ch]);
            if (dir == 0) { if (!dry) { P[ro + c] = (bf16)f2bf(qv * e); P[ro + 512 + c] = (bf16)f2bf(kv * ei); } }
            else { QKR[(size_t)(row0 + t) * 1024 + c] = (bf16)f2bf(qv * e); QKR[(size_t)(row0 + t) * 1024 + 512 + c] = (bf16)f2bf(kv * ei); } }
        if (half == 0) ET[((size_t)((dir * 8 + b) * 4 + h) * NCH + j) * 128 + ch] = __expf(HT[dc] + HT[256 + dc]);
    }
}


__device__ __forceinline__ unsigned f2sort(float f) { const unsigned u = __builtin_bit_cast(unsigned, f); return (u & 0x80000000u) ? ~u : (u | 0x80000000u); }
__device__ __forceinline__ float sort2f(unsigned s) { const unsigned u = (s & 0x80000000u) ? (s & 0x7fffffffu) : ~s; return __builtin_bit_cast(float, u); }
template <int CTRL> __device__ __forceinline__ unsigned dppmov_u(unsigned x) { return (unsigned)__builtin_amdgcn_mov_dpp((int)x, CTRL, 0xf, 0xf, true); }
__device__ __forceinline__ unsigned gmax16(unsigned x) { unsigned y;
    y = dppmov_u<0xB1>(x); x = x > y ? x : y; y = dppmov_u<0x4E>(x); x = x > y ? x : y; y = dppmov_u<0x141>(x); x = x > y ? x : y; y = dppmov_u<0x128>(x); x = x > y ? x : y; return x; }
__device__ __forceinline__ float gsum16(float x) {
    x += __builtin_bit_cast(float, dppmov_u<0xB1>(__builtin_bit_cast(unsigned, x))); x += __builtin_bit_cast(float, dppmov_u<0x4E>(__builtin_bit_cast(unsigned, x)));
    x += __builtin_bit_cast(float, dppmov_u<0x141>(__builtin_bit_cast(unsigned, x))); x += __builtin_bit_cast(float, dppmov_u<0x128>(__builtin_bit_cast(unsigned, x))); return x; }
#define CSWAP(a, b) do { const unsigned hi_ = (a) > (b) ? (a) : (b), lo_ = (a) > (b) ? (b) : (a); (a) = hi_; (b) = lo_; } while (0)
__device__ __forceinline__ void peer_route(const bf16* Q, const bf16* KEYS, int* EID, float* GWT, int gw, int NGW, int lane, bool lat_only) {
    const int g = lane >> 4, c16 = lane & 15, gbase = lane & 48;
    const int nwi = (lat_only ? NB * SEQ / 16 : TT / 16) * 8;
    for (int wi = gw; wi < nwi; wi += NGW) {
        const int t0 = map_row((wi >> 3) * 16, lat_only), head = wi & 7;
        unsigned tops[2][4];
#pragma unroll
        for (int p = 0; p < 2; ++p) {
            const bf16* qrow = Q + (size_t)(t0 + c16) * 2048 + head * 256 + p * 128 + 8 * g;
            bf16x8 qf[4];
#pragma unroll
            for (int ks = 0; ks < 4; ++ks) qf[ks] = *(const bf16x8*)(qrow + 32 * ks);
            const bf16* kb = KEYS + (size_t)(head * 2 + p) * 128 * 128 + (size_t)c16 * 128 + 8 * g;
            unsigned key[8][4];
#pragma unroll
            for (int nt = 0; nt < 8; ++nt) { f32x4 s = (f32x4){0.f, 0.f, 0.f, 0.f};
#pragma unroll
                for (int ks = 0; ks < 4; ++ks) s = mma(qf[ks], *(const bf16x8*)(kb + (size_t)nt * 16 * 128 + 32 * ks), s);
#pragma unroll
                for (int r = 0; r < 4; ++r) key[nt][r] = (f2sort(s[r]) & ~127u) | (unsigned)(127 - (16 * nt + c16)); }
            unsigned kk[4][8];
#pragma unroll
            for (int r = 0; r < 4; ++r) {
#pragma unroll
                for (int nt = 0; nt < 8; ++nt) kk[r][nt] = key[nt][r];
                CSWAP(kk[r][0], kk[r][1]); CSWAP(kk[r][2], kk[r][3]); CSWAP(kk[r][4], kk[r][5]); CSWAP(kk[r][6], kk[r][7]); CSWAP(kk[r][0], kk[r][2]); CSWAP(kk[r][1], kk[r][3]); CSWAP(kk[r][4], kk[r][6]); CSWAP(kk[r][5], kk[r][7]);
                CSWAP(kk[r][1], kk[r][2]); CSWAP(kk[r][5], kk[r][6]); CSWAP(kk[r][0], kk[r][4]); CSWAP(kk[r][1], kk[r][5]); CSWAP(kk[r][2], kk[r][6]); CSWAP(kk[r][3], kk[r][7]); CSWAP(kk[r][2], kk[r][4]); CSWAP(kk[r][3], kk[r][5]);
                CSWAP(kk[r][1], kk[r][2]); CSWAP(kk[r][3], kk[r][4]); CSWAP(kk[r][5], kk[r][6]); }
            unsigned tt[4] = {0u, 0u, 0u, 0u};
#pragma unroll 2
            for (int rd = 0; rd < 16; ++rd) {
#pragma unroll
                for (int r = 0; r < 4; ++r) { const unsigned m = gmax16(kk[r][0]); const bool w = (kk[r][0] == m);
#pragma unroll
                    for (int q = 0; q < 7; ++q) kk[r][q] = w ? kk[r][q + 1] : kk[r][q];
                    kk[r][7] = w ? 0u : kk[r][7];
                    tt[r] = (c16 == rd) ? m : tt[r]; } }
#pragma unroll
            for (int r = 0; r < 4; ++r) tops[p][r] = tt[r];
        }
        float v0[4], s1v[4]; int ptr[4]; unsigned res[4];
#pragma unroll
        for (int r = 0; r < 4; ++r) { v0[r] = sort2f(tops[0][r] & ~127u); s1v[r] = sort2f((unsigned)__shfl((int)tops[1][r], gbase) & ~127u); ptr[r] = 0; res[r] = 0u; }
#pragma unroll 2
        for (int rd = 0; rd < 16; ++rd) {
#pragma unroll
            for (int r = 0; r < 4; ++r) {
                const unsigned ck = ptr[r] < 16 ? ((f2sort(v0[r] + s1v[r]) & ~255u) | (unsigned)((15 - c16) << 4) | (unsigned)(15 - ptr[r])) : 0u;
                const unsigned m = gmax16(ck);
                res[r] = (c16 == rd) ? m : res[r];
                if (ck == m) ++ptr[r];
                s1v[r] = sort2f((unsigned)__shfl((int)tops[1][r], gbase + (ptr[r] < 15 ? ptr[r] : 15)) & ~127u); } }
#pragma unroll
        for (int r = 0; r < 4; ++r) {
            const float val = sort2f(res[r] & ~255u); const int ii = 15 - (int)((res[r] >> 4) & 15u), jj = 15 - (int)(res[r] & 15u);
            const float mx = __shfl(val, gbase);
            const float ex = __expf(val - mx), sum = gsum16(ex);
            const unsigned i0 = 127u - ((unsigned)__shfl((int)tops[0][r], gbase + ii) & 127u), i1 = 127u - ((unsigned)__shfl((int)tops[1][r], gbase + jj) & 127u);
            const size_t o = (size_t)(t0 + 4 * g + r) * 128 + head * 16 + c16;
            EID[o] = (int)(i0 * 128u + i1); GWT[o] = ex / sum;
        }
    }
}

__device__ __forceinline__ void unpack8(const v4u w, float* o) { o[0] = bflo(w.x); o[1] = bfhi(w.x); o[2] = bflo(w.y); o[3] = bfhi(w.y); o[4] = bflo(w.z); o[5] = bfhi(w.z); o[6] = bflo(w.w); o[7] = bfhi(w.w); }
__device__ __forceinline__ int rev3(int x) { return ((x & 1) << 2) | (x & 2) | ((x >> 2) & 1); }
typedef int v8i __attribute__((ext_vector_type(8)));
constexpr int P1_SLOT = 528, P1_BUF = 16 * P1_SLOT, P1_HQ = 2 * P1_BUF, P1_DOTS = P1_HQ, P1_WAVE_LDS = P1_HQ + 3072;
__device__ __forceinline__ int p1_sigma(int j) { return j < 8 ? (j ^ 4) : j; }
__device__ __forceinline__ void peer_pass1(const bf16* HB, const int* EID, const float* GWT, const unsigned char* U4, const float* SUi, const float* SVi, float* COEF,
                                           LAS unsigned char* lds, int wave, int gw, int NGW, int lane, bool lat_only) {
    LAS unsigned char* wl = lds + wave * P1_WAVE_LDS;
    LAS float* dots = (LAS float*)(wl + P1_DOTS);
    const int n = lane & 15, g = lane >> 4;
    const int nrows = lat_only ? NB * SEQ : TT;
    const unsigned aoff = (unsigned)(p1_sigma(n) * P1_SLOT + 128 * g);
    const unsigned boff = (unsigned)(P1_HQ + (n < 6 ? 512 * n : 0) + 128 * g);
    const float wn = n == 0 ? 1.f : (n == 1 ? 0.25f : (n == 2 ? 0.0625f : (n == 3 ? 0.015625f : (n == 4 ? 0.00390625f : (n == 5 ? 0.0009765625f : 0.f)))));
    int ri = gw;
    if (ri >= nrows) return;
    int r = map_row(ri, lat_only);
    v4u hn0 = *(const v4u*)(HB + (size_t)r * D + 16 * lane), hn1 = *(const v4u*)(HB + (size_t)r * D + 16 * lane + 8);
    int eidAn = EID[(size_t)r * 128 + lane], eidBn = EID[(size_t)r * 128 + 64 + lane];
#define P1_DMA(src_e, base_, bufo_) do { int ids_[16]; _Pragma("unroll") for (int j_ = 0; j_ < 16; ++j_) ids_[j_] = __builtin_amdgcn_readlane((src_e), (base_) + j_); \
        if (lane < 32) { _Pragma("unroll") for (int j_ = 0; j_ < 16; ++j_) \
        __builtin_amdgcn_global_load_lds((const unsigned*)(U4 + (size_t)ids_[j_] * 512 + 16 * lane), (LAS unsigned*)(wl + (bufo_) + p1_sigma(j_) * P1_SLOT), 16, 0, 0); } } while (0)
    P1_DMA(eidAn, 0, 0); P1_DMA(eidAn, 16, P1_BUF);
    for (; ri < nrows; ri += NGW) {
        r = map_row(ri, lat_only);
        const int eidA = eidAn, eidB = eidBn;
        { float h[16]; unpack8(hn0, h); unpack8(hn1, h + 8);
#pragma unroll
          for (int part = 0; part < 6; ++part) {
              unsigned w[2];
#pragma unroll
              for (int d = 0; d < 2; ++d) { unsigned t = 0u;
                  t = __builtin_amdgcn_cvt_scalef32_pk_fp4_f32(t, h[8 * d], h[8 * d + 1], 1.0f, 0); t = __builtin_amdgcn_cvt_scalef32_pk_fp4_f32(t, h[8 * d + 2], h[8 * d + 3], 1.0f, 1);
                  t = __builtin_amdgcn_cvt_scalef32_pk_fp4_f32(t, h[8 * d + 4], h[8 * d + 5], 1.0f, 2); t = __builtin_amdgcn_cvt_scalef32_pk_fp4_f32(t, h[8 * d + 6], h[8 * d + 7], 1.0f, 3);
                  w[d] = t; }
              *(LAS v2u*)(wl + P1_HQ + 512 * part + 8 * lane) = (v2u){w[0], w[1]};
              if (part < 5) {
#pragma unroll
                  for (int d = 0; d < 2; ++d) {
                      const f32x2 q0 = __builtin_amdgcn_cvt_scalef32_pk_f32_fp4(w[d], 1.0f, 0), q1 = __builtin_amdgcn_cvt_scalef32_pk_f32_fp4(w[d], 1.0f, 1);
                      const f32x2 q2 = __builtin_amdgcn_cvt_scalef32_pk_f32_fp4(w[d], 1.0f, 2), q3 = __builtin_amdgcn_cvt_scalef32_pk_f32_fp4(w[d], 1.0f, 3);
                      h[8 * d] = (h[8 * d] - q0[0]) * 4.f; h[8 * d + 1] = (h[8 * d + 1] - q0[1]) * 4.f; h[8 * d + 2] = (h[8 * d + 2] - q1[0]) * 4.f; h[8 * d + 3] = (h[8 * d + 3] - q1[1]) * 4.f;
                      h[8 * d + 4] = (h[8 * d + 4] - q2[0]) * 4.f; h[8 * d + 5] = (h[8 * d + 5] - q2[1]) * 4.f; h[8 * d + 6] = (h[8 * d + 6] - q3[0]) * 4.f; h[8 * d + 7] = (h[8 * d + 7] - q3[1]) * 4.f; } } } }
        const float gwtA = GWT[(size_t)r * 128 + lane], gwtB = GWT[(size_t)r * 128 + 64 + lane];
        const float suA = SUi[eidA], suB = SUi[eidB], svA = SVi[eidA], svB = SVi[eidB];
        const int rin = ri + NGW; const bool more = rin < nrows; const int rn = map_row(more ? rin : ri, lat_only);
        hn0 = *(const v4u*)(HB + (size_t)rn * D + 16 * lane); hn1 = *(const v4u*)(HB + (size_t)rn * D + 16 * lane + 8);
        eidAn = EID[(size_t)rn * 128 + lane]; eidBn = EID[(size_t)rn * 128 + 64 + lane];
        LDS_FENCE();
        v4u bw[8];
#pragma unroll
        for (int c = 0; c < 8; ++c) bw[c] = *(LAS const v4u*)(wl + boff + 16 * c);
#pragma unroll 1
        for (int G = 0; G < 8; ++G) {
            if (G < 7 || more) asm volatile("s_waitcnt vmcnt(16)" ::: "memory"); else asm volatile("s_waitcnt vmcnt(0)" ::: "memory");
            const unsigned bufo = (G & 1) ? (unsigned)P1_BUF : 0u;
            v4u aw[8];
#pragma unroll
            for (int c = 0; c < 8; ++c) aw[c] = *(LAS const v4u*)(wl + bufo + aoff + 16 * c);
            asm volatile("s_waitcnt lgkmcnt(0)" ::: "memory");
            { const int srcsel = G < 2 ? eidA : (G < 6 ? eidB : eidAn); const int base = 16 * ((G + 2) & 3);
              if (G < 6 || more) { if (G & 1) P1_DMA(srcsel, base, P1_BUF); else P1_DMA(srcsel, base, 0); } }
            f32x4 acc = (f32x4){0.f, 0.f, 0.f, 0.f};
#pragma unroll
            for (int c = 0; c < 8; ++c) {
                const v8i A = (v8i){(int)aw[c].x, (int)aw[c].y, (int)aw[c].z, (int)aw[c].w, 0, 0, 0, 0};
                const v8i Bv = (v8i){(int)bw[c].x, (int)bw[c].y, (int)bw[c].z, (int)bw[c].w, 0, 0, 0, 0};
                acc = __builtin_amdgcn_mfma_scale_f32_16x16x128_f8f6f4(A, Bv, acc, 4, 4, 0, 0, 0, 0); }
            f32x4 dv;
#pragma unroll
            for (int k = 0; k < 4; ++k) dv[k] = gsum16(acc[k] * wn);
            if (n == 0) *(LAS f32x4*)(dots + 16 * G + 4 * g) = dv;
        }
        LDS_FENCE();
        { const float dot = dots[lane] * suA; COEF[(size_t)r * 128 + lane] = gwtA * 0.5f * dot * (1.f + erff(dot * 0.70710678118f)) * svA; }
        { const float dot = dots[64 + lane] * suB; COEF[(size_t)r * 128 + 64 + lane] = gwtB * 0.5f * dot * (1.f + erff(dot * 0.70710678118f)) * svB; }
    }
#undef P1_DMA
}
constexpr int P2_CPART = 16384, P2_CSTAGE = P2_CPART + 256, P2_FSTAGE = P2_CSTAGE + 512;
typedef int v2i __attribute__((ext_vector_type(2)));
template <bool USE_PEER>
__device__ __forceinline__ void peer_expert(const float* COEF, const int* EID, const unsigned char* V4,
                                            float* lat, float* ctx, const float* mod, const float* lnw, const float* lnb, LAS unsigned char* lds, int wave, int gw, int NGW, int lane, int dry, bool lat_only) {
    LAS unsigned char* wl = lds + wave * P1_WAVE_LDS;
    LAS float* cstage = (LAS float*)(wl + P2_CSTAGE); LAS float* fstage = (LAS float*)(wl + P2_FSTAGE);
    const int c = lane & 15, kb = lane >> 4, drow = lane >> 3, dpos = lane & 7, fk = (c >> 1) & 7;
    const unsigned trbase = (unsigned)((32 * kb + c) * 128);
    const int nrows = lat_only ? NB * SEQ : TT;
    int ri = gw;
    if (ri >= nrows) return;
    unsigned roff[16];
#define P2_ROFF(row_) do { _Pragma("unroll") for (int i_ = 0; i_ < 16; ++i_) roff[i_] = (unsigned)EID[(size_t)(row_) * 128 + 8 * i_ + drow] * 512u + 16u * (unsigned)(dpos ^ ((4 * i_ + (drow >> 1)) & 7)); } while (0)
    P2_ROFF(map_row(ri, lat_only));
#define P2_DMA(cqo_) do { _Pragma("unroll") for (int i_ = 0; i_ < 16; ++i_) \
        __builtin_amdgcn_global_load_lds((const unsigned*)(V4 + (size_t)(roff[i_] + (cqo_))), (LAS unsigned*)(wl + 1024 * i_), 16, 0, 0); } while (0)
    if (USE_PEER) P2_DMA(0u);
    for (; ri < nrows; ri += NGW) {
        const int r = map_row(ri, lat_only);
        const int b = r / PB, p = r - b * PB; float* xr = srow(lat, ctx, r); const float* mr = mod + (size_t)(p < LC ? 8 : b) * 6144;
        float f[16];
#pragma unroll
        for (int i = 0; i < 16; ++i) f[i] = 0.f;
        if (USE_PEER) {
        const int rin = ri + NGW; const bool more = rin < nrows; const int rn = map_row(more ? rin : ri, lat_only);
        const float cA = COEF[(size_t)r * 128 + lane], cB = COEF[(size_t)r * 128 + 64 + lane];
        float cm = fmaxf(fabsf(cA), fabsf(cB));
        cm = fmaxf(cm, dppmov_f<0xB1>(cm)); cm = fmaxf(cm, dppmov_f<0x4E>(cm)); cm = fmaxf(cm, dppmov_f<0x141>(cm)); cm = fmaxf(cm, dppmov_f<0x128>(cm)); cm = fmaxf(cm, __shfl_xor(cm, 16)); cm = fmaxf(cm, __shfl_xor(cm, 32));
        const float sc = cm > 0.f ? 6.0f / cm : 1.f, isc = cm > 0.f ? cm * (1.f / 6.0f) : 1.f;
        cstage[lane] = cA * sc; cstage[64 + lane] = cB * sc;
        LDS_FENCE();
        if (lane < 16) {
            float h[8]; { const f32x4 x0 = *(LAS const f32x4*)(cstage + 8 * lane), x1 = *(LAS const f32x4*)(cstage + 8 * lane + 4); h[0] = x0[0]; h[1] = x0[1]; h[2] = x0[2]; h[3] = x0[3]; h[4] = x1[0]; h[5] = x1[1]; h[6] = x1[2]; h[7] = x1[3]; }
#pragma unroll
            for (int part = 0; part < 4; ++part) {
                unsigned t = 0u;
                t = __builtin_amdgcn_cvt_scalef32_pk_fp4_f32(t, h[0], h[1], 1.0f, 0); t = __builtin_amdgcn_cvt_scalef32_pk_fp4_f32(t, h[2], h[3], 1.0f, 1);
                t = __builtin_amdgcn_cvt_scalef32_pk_fp4_f32(t, h[4], h[5], 1.0f, 2); t = __builtin_amdgcn_cvt_scalef32_pk_fp4_f32(t, h[6], h[7], 1.0f, 3);
                *(LAS unsigned*)(wl + P2_CPART + 64 * part + 4 * lane) = t;
                if (part < 3) { const f32x2 q0 = __builtin_amdgcn_cvt_scalef32_pk_f32_fp4(t, 1.0f, 0), q1 = __builtin_amdgcn_cvt_scalef32_pk_f32_fp4(t, 1.0f, 1), q2 = __builtin_amdgcn_cvt_scalef32_pk_f32_fp4(t, 1.0f, 2), q3 = __builtin_amdgcn_cvt_scalef32_pk_f32_fp4(t, 1.0f, 3);
                    h[0] = (h[0] - q0[0]) * 4.f; h[1] = (h[1] - q0[1]) * 4.f; h[2] = (h[2] - q1[0]) * 4.f; h[3] = (h[3] - q1[1]) * 4.f; h[4] = (h[4] - q2[0]) * 4.f; h[5] = (h[5] - q2[1]) * 4.f; h[6] = (h[6] - q3[0]) * 4.f; h[7] = (h[7] - q3[1]) * 4.f; } } }
        LDS_FENCE();
        v4u aw = (v4u){0u, 0u, 0u, 0u};
        if (c < 4) aw = *(LAS const v4u*)(wl + P2_CPART + 64 * c + 16 * kb);
        const v8i A = (v8i){(int)aw.x, (int)aw.y, (int)aw.z, (int)aw.w, 0, 0, 0, 0};
#pragma unroll 1
        for (int cq = 0; cq < 4; ++cq) {
            asm volatile("s_waitcnt vmcnt(0)" ::: "memory");
#define P2_TILES(t0_) do { v2i r1[8], r2[8]; \
            _Pragma("unroll") for (int t = 0; t < 8; ++t) { const unsigned a = trbase + 16u * (unsigned)((((t0_) + t) >> 1) ^ fk) + 8u * (unsigned)(t & 1); \
                r1[t] = __builtin_amdgcn_ds_read_tr4_b64_v2i32((LAS v2i*)(wl + a)); r2[t] = __builtin_amdgcn_ds_read_tr4_b64_v2i32((LAS v2i*)(wl + a + 2048)); } \
            if ((t0_) == 8) { asm volatile("s_waitcnt lgkmcnt(0)" ::: "memory");     \
                if (cq < 3) { P2_DMA(128u * (unsigned)(cq + 1)); if (cq == 2 && more) P2_ROFF(rn); } else if (more) P2_DMA(0u); } \
            _Pragma("unroll") for (int t = 0; t < 8; ++t) { \
                const v8i Bv = (v8i){r1[t].x, r1[t].y, r2[t].x, r2[t].y, 0, 0, 0, 0}; \
                const f32x4 d = __builtin_amdgcn_mfma_scale_f32_16x16x128_f8f6f4(A, Bv, (f32x4){0.f, 0.f, 0.f, 0.f}, 4, 4, 0, 0, 0, 0); \
                const float fv = (d[0] + 0.25f * d[1] + 0.0625f * d[2] + 0.015625f * d[3]) * isc; \
                if (kb == 0) fstage[16 * ((t0_) + t) + c] = fv; } } while (0)
            P2_TILES(0); P2_TILES(8);
#undef P2_TILES
            LDS_FENCE();
            const f32x4 fq = *(LAS const f32x4*)(fstage + 4 * lane);
            if (cq == 0) { f[0] = fq[0]; f[1] = fq[1]; f[2] = fq[2]; f[3] = fq[3]; } else if (cq == 1) { f[4] = fq[0]; f[5] = fq[1]; f[6] = fq[2]; f[7] = fq[3]; }
            else if (cq == 2) { f[8] = fq[0]; f[9] = fq[1]; f[10] = fq[2]; f[11] = fq[3]; } else { f[12] = fq[0]; f[13] = fq[1]; f[14] = fq[2]; f[15] = fq[3]; }
        }
        }
        float v[16]; float s = 0.f;
#pragma unroll
        for (int q = 0; q < 4; ++q) { const int cc = 256 * q + 4 * lane; const f32x4 x1 = *(const f32x4*)(xr + cc), g2 = *(const f32x4*)(mr + 5120 + cc);
#pragma unroll
            for (int i = 0; i < 4; ++i) { v[4 * q + i] = DN_ALPHA * x1[i] + g2[i] * f[4 * q + i]; s += v[4 * q + i]; } }
        const float mean = wave_sum(s) * (1.f / D); float s2 = 0.f;
#pragma unroll
        for (int i = 0; i < 16; ++i) { v[i] -= mean; s2 += v[i] * v[i]; }
        const float rstd = 1.f / sqrtf(wave_sum(s2) * (1.f / D) + LN_EPS);
#pragma unroll
        for (int q = 0; q < 4; ++q) { const int cc = 256 * q + 4 * lane; const f32x4 w = *(const f32x4*)(lnw + cc), bb2 = *(const f32x4*)(lnb + cc); f32x4 o;
#pragma unroll
            for (int i = 0; i < 4; ++i) o[i] = v[4 * q + i] * rstd * w[i] + bb2[i];
            if (!dry) *(f32x4*)(xr + cc) = o; }
    }
#undef P2_DMA
#undef P2_ROFF
}

__device__ __forceinline__ bf16* od_row_base(unsigned char* ws, int dir, int b) {
    if (dir == 0) return (bf16*)(ws + WS_ST) + (size_t)b * SEQ * 1024;
    return b < 7 ? (bf16*)(ws + WS_ST + 64 * MiB) + (size_t)b * SEQ * 1024 : (bf16*)(ws + WS_XC);
}
__device__ __forceinline__ void gla_fused_scan(const bf16* P, const bf16* QKR, unsigned char* ws, LAS unsigned char* lds, int vcu, int G, int wave, int lane, int tid, int dry) {
    const float* ET = (const float*)(ws + WS_ET);
    LAS bf16* Qt = (LAS bf16*)lds;
    LAS bf16* Kt = (LAS bf16*)(lds + 34816);
    LAS bf16* Vt = (LAS bf16*)(lds + 69632);
    LAS bf16* SL = (LAS bf16*)(lds + 88064);
    LAS bf16* Pw = (LAS bf16*)(lds + 122880 + wave * 2304);
    const int g = lane >> 4, c16 = lane & 15, mt = wave & 3, cw = wave >> 2;
    for (int item = vcu; item < 256; item += G) {
        const int dir = item >> 7, b = (item >> 4) & 7, h = (item >> 2) & 3, eb = item & 3;
        const bf16* qsrc = dir == 0 ? P + h * 128 : QKR + h * 128; const int qld = dir == 0 ? N_C : 1024;
        const bf16* vsrc = P + 1024 + h * 256 + 64 * eb;
        const float* etp = ET + ((size_t)((dir * 8 + b) * 4 + h) * NCH) * 128 + 16 * wave + c16;
        bf16* odb = od_row_base(ws, dir, b) + h * 256 + 64 * eb;
        f32x4 acc[4];
#pragma unroll
        for (int et = 0; et < 4; ++et) acc[et] = (f32x4){0.f, 0.f, 0.f, 0.f};
        v4u qreg[2][2], kreg[2][2], vreg[2]; float etn[2];
#define GLA_JOF(sc_) (dir == 0 ? (sc_) : ((sc_) < 4 ? 3 - (sc_) : 71 - (sc_)))
#define GLA_PREFETCH(sc0_) do { _Pragma("unroll") for (int u = 0; u < 2; ++u) { const int jj = GLA_JOF((sc0_) + u); const int row0 = b * PB + jj * 64; \
            _Pragma("unroll") for (int i = 0; i < 2; ++i) { const int cidx = tid + 512 * i, rr = cidx >> 4, ch = cidx & 15; const bf16* sp = qsrc + (size_t)(row0 + rr) * qld + ch * 8; qreg[u][i] = *(const v4u*)sp; kreg[u][i] = *(const v4u*)(sp + 512); } \
            vreg[u] = *(const v4u*)(vsrc + (size_t)(row0 + (tid >> 3)) * N_C + (tid & 7) * 8); etn[u] = etp[(size_t)jj * 128]; } } while (0)
        GLA_PREFETCH(0);
        unsigned opk[8]; int ojc = -1;
#pragma unroll
        for (int i = 0; i < 8; ++i) opk[i] = 0u;
        for (int sc = 0; sc < NCH; sc += 2) {
            const int ja = GLA_JOF(sc), jb = GLA_JOF(sc + 1);
            __syncthreads();
            if (ojc >= 4 && !dry) {
#pragma unroll
                for (int nt = 0; nt < 4; ++nt) { bf16* orow = odb + (size_t)((ojc - 4) * 64 + 16 * mt + 4 * g) * 1024 + 16 * nt + c16;
#pragma unroll
                    for (int r = 0; r < 4; ++r) orow[(size_t)r * 1024] = (bf16)((opk[2 * nt + (r >> 1)] >> (16 * (r & 1))) & 0xffffu); } }
#pragma unroll
            for (int u = 0; u < 2; ++u) {
#pragma unroll
                for (int i = 0; i < 2; ++i) { const int cidx = tid + 512 * i, rr = cidx >> 4, ch = cidx & 15; *(LAS v4u*)(Qt + u * 8704 + rr * 136 + ch * 8) = qreg[u][i]; *(LAS v4u*)(Kt + u * 8704 + rr * 136 + ch * 8) = kreg[u][i]; }
                *(LAS v4u*)(Vt + u * 4608 + (tid >> 3) * 72 + (tid & 7) * 8) = vreg[u]; }
#pragma unroll
            for (int et = 0; et < 4; ++et)
#pragma unroll
                for (int r = 0; r < 4; ++r) SL[(16 * et + 4 * g + r) * 136 + 16 * wave + c16] = (bf16)f2bf(acc[et][r]);
            const float et_a = etn[0], et_b = etn[1];
            if (sc + 2 < NCH) GLA_PREFETCH(sc + 2);
            __syncthreads();
#pragma unroll
            for (int ks = 0; ks < 2; ++ks) { const bf16x8 kb = frag_tr(Kt, 136, 32 * ks, 16 * wave, lane);
#pragma unroll
                for (int et = 0; et < 4; ++et) acc[et] = mma(frag_tr(Vt, 72, 32 * ks, 16 * et, lane), kb, acc[et]); }
#pragma unroll
            for (int et = 0; et < 4; ++et) { acc[et] = acc[et] * et_a;
#pragma unroll
                for (int r = 0; r < 4; ++r) SL[8704 + (16 * et + 4 * g + r) * 136 + 16 * wave + c16] = (bf16)f2bf(acc[et][r]); }
            __syncthreads();
            const int jc = cw == 0 ? ja : jb;
            ojc = jc;
            if (jc >= 4) {
                const LAS bf16* Qc = Qt + cw * 8704; const LAS bf16* Kc = Kt + cw * 8704; const LAS bf16* Vc = Vt + cw * 4608; const LAS bf16* Sc = SL + cw * 8704;
                bf16x8 qf[4];
#pragma unroll
                for (int ks = 0; ks < 4; ++ks) qf[ks] = frag_row(Qc, 136, 16 * mt, 32 * ks, lane);
                bf16x8 pa[2];
                { f32x4 st[4];
#pragma unroll
                  for (int ns = 0; ns < 4; ++ns) { st[ns] = (f32x4){0.f, 0.f, 0.f, 0.f};
#pragma unroll
                      for (int ks = 0; ks < 4; ++ks) st[ns] = mma(frag_row(Kc, 136, 16 * ns, 32 * ks, lane), qf[ks], st[ns]);
#pragma unroll
                      for (int r = 0; r < 4; ++r) { const int sidx = 16 * ns + 4 * g + r, t = 16 * mt + c16; const bool ok = dir == 0 ? (sidx <= t) : (sidx >= t); st[ns][r] = ok ? st[ns][r] : 0.f; } }
#pragma unroll
                  for (int ks2 = 0; ks2 < 2; ++ks2) { const v4u wv = (v4u){pk2(st[2 * ks2][0], st[2 * ks2][1]), pk2(st[2 * ks2][2], st[2 * ks2][3]), pk2(st[2 * ks2 + 1][0], st[2 * ks2 + 1][1]), pk2(st[2 * ks2 + 1][2], st[2 * ks2 + 1][3])};
                      pa[ks2] = __builtin_bit_cast(bf16x8, wv); } }
#pragma unroll
                for (int nt = 0; nt < 4; ++nt) { f32x4 a = (f32x4){0.f, 0.f, 0.f, 0.f};
#pragma unroll
                    for (int ks = 0; ks < 4; ++ks) a = mma(qf[ks], frag_row(Sc, 136, 16 * nt, 32 * ks, lane), a);
                    a = mma(pa[0], frag_tr_perm(Vc, 72, 0, 16 * nt, lane), a); a = mma(pa[1], frag_tr_perm(Vc, 72, 32, 16 * nt, lane), a);
                    opk[2 * nt] = pk2(a[0], a[1]); opk[2 * nt + 1] = pk2(a[2], a[3]); }
                LDS_FENCE();
            }
#pragma unroll
            for (int ks = 0; ks < 2; ++ks) { const bf16x8 kb = frag_tr(Kt + 8704, 136, 32 * ks, 16 * wave, lane);
#pragma unroll
                for (int et = 0; et < 4; ++et) acc[et] = mma(frag_tr(Vt + 4608, 72, 32 * ks, 16 * et, lane), kb, acc[et]); }
#pragma unroll
            for (int et = 0; et < 4; ++et) acc[et] = acc[et] * et_b;
        }
        if (ojc >= 4 && !dry) {
#pragma unroll
            for (int nt = 0; nt < 4; ++nt) { bf16* orow = odb + (size_t)((ojc - 4) * 64 + 16 * mt + 4 * g) * 1024 + 16 * nt + c16;
#pragma unroll
                for (int r = 0; r < 4; ++r) orow[(size_t)r * 1024] = (bf16)((opk[2 * nt + (r >> 1)] >> (16 * (r & 1))) & 0xffffu); } }
#undef GLA_PREFETCH
#undef GLA_JOF
    }
}
__device__ __forceinline__ void gla_merge(bf16* P, const float* norm_w, unsigned char* ws, int gw, int NGW, int lane, int dry) {
    for (int i = gw; i < NB * SEQ; i += NGW) {
        const int b = i >> 12, lp = i & 4095; const size_t r = (size_t)b * PB + LC + lp;
        const bf16* of = od_row_base(ws, 0, b) + (size_t)lp * 1024 + 16 * lane; const bf16* orv = od_row_base(ws, 1, b) + (size_t)lp * 1024 + 16 * lane;
        bf16* grow = P + r * N_C + 2048 + 16 * lane;
        float x[16], y[16], gg[16];
        unpack8(*(const v4u*)of, x); unpack8(*(const v4u*)(of + 8), x + 8); unpack8(*(const v4u*)orv, y); unpack8(*(const v4u*)(orv + 8), y + 8);
        unpack8(*(const v4u*)grow, gg); unpack8(*(const v4u*)(grow + 8), gg + 8);
        float ss = 0.f;
#pragma unroll
        for (int k = 0; k < 16; ++k) { x[k] += y[k]; ss += x[k] * x[k]; }
        ss = gsum16(ss);
        const float rn = 1.f / sqrtf(ss * (1.f / 256.f) + LN_EPS);
        unsigned ow[8];
#pragma unroll
        for (int k = 0; k < 8; ++k) { const float4 dummy = make_float4(0.f, 0.f, 0.f, 0.f); (void)dummy;
            const float a = x[2 * k] * rn * norm_w[16 * lane + 2 * k] * siluf_(gg[2 * k]), c = x[2 * k + 1] * rn * norm_w[16 * lane + 2 * k + 1] * siluf_(gg[2 * k + 1]); ow[k] = pk2(a, c); }
        if (!dry) { v4u o0, o1; o0.x = ow[0]; o0.y = ow[1]; o0.z = ow[2]; o0.w = ow[3]; o1.x = ow[4]; o1.y = ow[5]; o1.z = ow[6]; o1.w = ow[7]; *(v4u*)grow = o0; *(v4u*)(grow + 8) = o1; }
    }
}

__device__ __forceinline__ void mlstm_fused_scan(const bf16* P, unsigned char* ws, LAS unsigned char* lds, int vcu, int G, int wave, int lane, int tid) {
    const float* BQ = (const float*)(ws + WS_BQ); const float* CQ = (const float*)(ws + WS_CQ); const float* EM = (const float*)(ws + WS_EM); const float* AI = (const float*)(ws + WS_AI);
    const float* AST = (const float*)(ws + WS_AST); const float* CL = (const float*)(ws + WS_CL);
    LAS bf16* Qt = (LAS bf16*)lds;
    LAS bf16* Kt = (LAS bf16*)(lds + 17408);
    LAS bf16* Vt = (LAS bf16*)(lds + 34816);
    LAS bf16* Vw = (LAS bf16*)(lds + 41984);
    LAS bf16* CT = (LAS bf16*)(lds + 49152);
    LAS bf16* Pw = (LAS bf16*)(lds + 62208 + wave * 2304);
    const int g = lane >> 4, c16 = lane & 15, mt = wave & 3, hf = wave >> 2;
    const int vrow = tid < 256 ? (tid >> 2) : ((tid - 256) & 63), vch = tid & 3;
    for (int item = vcu; item < 256; item += G) {
        const int dir = item >> 7, b = (item >> 4) & 7, h = (item >> 2) & 3, eb = item & 3;
        const int chain = dir * 32 + b * 4 + h;
        const bf16* qsrc = P + h * 128; const bf16* vsrc = P + 1024 + h * 128 + 32 * eb;
        bf16* odb = (bf16*)(ws + WS_ST) + (size_t)dir * TT * 512 + h * 128 + 32 * eb;
        f32x4 acc[3];
#pragma unroll
        for (int et = 0; et < 3; ++et) acc[et] = (f32x4){0.f, 0.f, 0.f, 0.f};
        v4u qreg[2], kreg[2], vreg; float bqr, cln, astn, cqn; f32x4 bqn[4], ain, emn;
        { const int j0 = dir == 0 ? 0 : 3; const int row0 = b * PB + j0 * 64; const size_t tb = (size_t)chain * PB + j0 * 64;
#pragma unroll
          for (int i = 0; i < 2; ++i) { const int cidx = tid + 512 * i, rr = cidx >> 4, ch = cidx & 15; const bf16* s = qsrc + (size_t)(row0 + rr) * N_AB + ch * 8; qreg[i] = *(const v4u*)s; kreg[i] = *(const v4u*)(s + 512); }
          vreg = *(const v4u*)(vsrc + (size_t)(row0 + vrow) * N_AB + vch * 8); bqr = BQ[tb + vrow]; cln = CL[chain * NCH + j0]; astn = AST[chain * NCH + j0];
#pragma unroll
          for (int k = 0; k < 4; ++k) bqn[k] = *(const f32x4*)(BQ + tb + 16 * k + 4 * g);
          cqn = CQ[tb + 16 * mt + c16]; ain = *(const f32x4*)(AI + tb + 16 * mt + 4 * g); emn = *(const f32x4*)(EM + tb + 16 * mt + 4 * g); }
        for (int sc = 0; sc < NCH; ++sc) {
            const int j = dir == 0 ? sc : (sc < 4 ? 3 - sc : 71 - sc);
            __syncthreads();
#pragma unroll
            for (int i = 0; i < 2; ++i) { const int cidx = tid + 512 * i, rr = cidx >> 4, ch = cidx & 15; *(LAS v4u*)(Qt + rr * 136 + ch * 8) = qreg[i]; *(LAS v4u*)(Kt + rr * 136 + ch * 8) = kreg[i]; }
            { const float wsv = __expf(bqr - cln);
              if (tid < 256) { const v4u raw = vreg; v4u o;
                  o.x = pk2(bflo(raw.x) * wsv, bfhi(raw.x) * wsv); o.y = pk2(bflo(raw.y) * wsv, bfhi(raw.y) * wsv); o.z = pk2(bflo(raw.z) * wsv, bfhi(raw.z) * wsv); o.w = pk2(bflo(raw.w) * wsv, bfhi(raw.w) * wsv);
                  *(LAS v4u*)(Vt + vrow * 56 + vch * 8) = raw; *(LAS v4u*)(Vw + vrow * 56 + vch * 8) = o;
              } else if (tid < 320) { v4u o; o.x = 0x3f80u; o.y = 0u; o.z = 0u; o.w = 0u; *(LAS v4u*)(Vt + vrow * 56 + 32) = o; o.x = f2bf(wsv); *(LAS v4u*)(Vw + vrow * 56 + 32) = o;
                  o.x = 0u; *(LAS v4u*)(Vt + vrow * 56 + 40) = o; *(LAS v4u*)(Vw + vrow * 56 + 40) = o; } }
#pragma unroll
            for (int et = 0; et < 3; ++et)
#pragma unroll
                for (int r = 0; r < 4; ++r) CT[(16 * et + 4 * g + r) * 136 + 16 * wave + c16] = (bf16)f2bf(acc[et][r]);
            const float ast = astn, cqt = cqn; f32x4 bq[4]; const f32x4 ai = ain, em = emn;
#pragma unroll
            for (int k = 0; k < 4; ++k) bq[k] = bqn[k];
            if (sc + 1 < NCH) { const int sn = sc + 1; const int jn = dir == 0 ? sn : (sn < 4 ? 3 - sn : 71 - sn); const int row0 = b * PB + jn * 64; const size_t tb = (size_t)chain * PB + jn * 64;
#pragma unroll
                for (int i = 0; i < 2; ++i) { const int cidx = tid + 512 * i, rr = cidx >> 4, ch = cidx & 15; const bf16* s = qsrc + (size_t)(row0 + rr) * N_AB + ch * 8; qreg[i] = *(const v4u*)s; kreg[i] = *(const v4u*)(s + 512); }
                vreg = *(const v4u*)(vsrc + (size_t)(row0 + vrow) * N_AB + vch * 8); bqr = BQ[tb + vrow]; cln = CL[chain * NCH + jn]; astn = AST[chain * NCH + jn];
#pragma unroll
                for (int k = 0; k < 4; ++k) bqn[k] = *(const f32x4*)(BQ + tb + 16 * k + 4 * g);
                cqn = CQ[tb + 16 * mt + c16]; ain = *(const f32x4*)(AI + tb + 16 * mt + 4 * g); emn = *(const f32x4*)(EM + tb + 16 * mt + 4 * g); }
            __syncthreads();
            bf16x8 qf[4];
#pragma unroll
            for (int ks = 0; ks < 4; ++ks) qf[ks] = frag_row(Qt, 136, 16 * mt, 32 * ks, lane);
            bf16x8 pa[2];
            { f32x4 st[4];
#pragma unroll
              for (int ns = 0; ns < 4; ++ns) { st[ns] = (f32x4){0.f, 0.f, 0.f, 0.f};
#pragma unroll
                  for (int ks = 0; ks < 4; ++ks) st[ns] = mma(frag_row(Kt, 136, 16 * ns, 32 * ks, lane), qf[ks], st[ns]);
#pragma unroll
                  for (int r = 0; r < 4; ++r) { const int sidx = 16 * ns + 4 * g + r, t = 16 * mt + c16; const bool ok = dir == 0 ? (sidx <= t) : (sidx >= t);
                      st[ns][r] = ok ? st[ns][r] * __expf(bq[ns][r] - cqt) : 0.f; } }
#pragma unroll
              for (int ks2 = 0; ks2 < 2; ++ks2) { const v4u wv = (v4u){pk2(st[2 * ks2][0], st[2 * ks2][1]), pk2(st[2 * ks2][2], st[2 * ks2][3]), pk2(st[2 * ks2 + 1][0], st[2 * ks2 + 1][1]), pk2(st[2 * ks2 + 1][2], st[2 * ks2 + 1][3])};
                  pa[ks2] = __builtin_bit_cast(bf16x8, wv); } }
            f32x4 av, ad;
            { f32x4 a = (f32x4){0.f, 0.f, 0.f, 0.f}, d = (f32x4){0.f, 0.f, 0.f, 0.f};
#pragma unroll
              for (int ks = 0; ks < 4; ++ks) { a = mma(qf[ks], frag_row(CT, 136, 16 * hf, 32 * ks, lane), a); d = mma(qf[ks], frag_row(CT, 136, 32, 32 * ks, lane), d); }
#pragma unroll
              for (int r = 0; r < 4; ++r) { a[r] *= ai[r]; d[r] *= ai[r]; }
#pragma unroll
              for (int ks = 0; ks < 2; ++ks) { a = mma(pa[ks], frag_tr_perm(Vt, 56, 32 * ks, 16 * hf, lane), a); d = mma(pa[ks], frag_tr_perm(Vt, 56, 32 * ks, 32, lane), d); }
              av = a; ad = d; }
            { bf16* orow = odb + (size_t)(b * PB + j * 64 + 16 * mt + 4 * g) * 512 + 16 * hf + c16;
#pragma unroll
              for (int r = 0; r < 4; ++r) { const float den = __shfl(ad[r], lane & 48); orow[(size_t)r * 512] = (bf16)f2bf(av[r] / fmaxf(fabsf(den), em[r])); } }
#pragma unroll
            for (int et = 0; et < 3; ++et) acc[et] = acc[et] * ast;
#pragma unroll
            for (int ks = 0; ks < 2; ++ks) { const bf16x8 kb = frag_tr(Kt, 136, 32 * ks, 16 * wave, lane);
#pragma unroll
                for (int et = 0; et < 3; ++et) acc[et] = mma(frag_tr(Vw, 56, 32 * ks, 16 * et, lane), kb, acc[et]); }
        }
    }
}
__device__ __forceinline__ void mlstm_merge(const bf16* P, bf16* CAT, const float* norm_w, unsigned char* ws, int gw, int NGW, int lane) {
    const bf16* OD = (const bf16*)(ws + WS_ST);
    for (int r = gw; r < TT; r += NGW) {
        float x[8], y[8], og[8];
        unpack8(*(const v4u*)(OD + (size_t)r * 512 + 8 * lane), x); unpack8(*(const v4u*)(OD + (size_t)TT * 512 + (size_t)r * 512 + 8 * lane), y);
        unpack8(*(const v4u*)(P + (size_t)r * N_AB + 1536 + 8 * lane), og);
        float ss = 0.f;
#pragma unroll
        for (int k = 0; k < 8; ++k) { x[k] += y[k]; ss += x[k] * x[k]; }
        ss = gsum16(ss);
        const float rn = 1.f / sqrtf(ss * (1.f / 128.f) + LN_EPS);
        unsigned ow[4];
#pragma unroll
        for (int k = 0; k < 4; ++k) ow[k] = pk2(x[2 * k] * rn * norm_w[8 * lane + 2 * k] * sigmoidf_(og[2 * k]), x[2 * k + 1] * rn * norm_w[8 * lane + 2 * k + 1] * sigmoidf_(og[2 * k + 1]));
        v4u o; o.x = ow[0]; o.y = ow[1]; o.z = ow[2]; o.w = ow[3]; *(v4u*)(CAT + (size_t)r * D + 8 * lane) = o;
    }
}

#ifndef PHMASK
#define PHMASK 0xffffffffu
#endif
#define PH(k) ((PHMASK >> (k)) & 1u)
#ifndef REPMASK
#define REPMASK 0u
#endif
#define REPS(k) (1 + (int)((REPMASK >> (k)) & 1u))
#if REPMASK
#define DRYV(k) ({ int d_ = (rep_ + 1 < REPS(k)) ? 1 : 0; asm volatile("" : "+s"(d_)); d_; })
#else
#define DRYV(k) 0
#endif
#ifndef DBG_LEVEL
#define DBG_LEVEL 3
#endif
typedef const __attribute__((address_space(4))) Args* KArgsP;
__device__ __forceinline__ KArgsP kargs() { KArgsP p = (KArgsP)__builtin_amdgcn_kernarg_segment_ptr(); asm volatile("" : "+s"(p)); return p; }
#define WSP(off) (ws + (off))
__global__ void __launch_bounds__(512, 2) fwd_megakernel(Args A_unused) {
    extern __shared__ __attribute__((aligned(16))) unsigned char lds_raw[];
    LAS unsigned char* lds = (LAS unsigned char*)lds_raw;
    const int tid0 = threadIdx.x;
    const int G = gridDim.x; const int bx = blockIdx.x; const int vcu = (G % 8 == 0) ? (bx % 8) * (G / 8) + bx / 8 : bx;
    const int NGW = G * 8;
    volatile LAS unsigned* MISC = (volatile LAS unsigned*)(lds + MISC_OFF);
    if (tid0 < 16) MISC[tid0] = 0u;
    __syncthreads();
    XcdBarrier bar;
    { KArgsP ap = kargs(); bar = xcd_barrier_post((unsigned*)(ap->ws + WS_CTL) + 1024, MISC + 8); }
#define GRID_BAR() xcd_barrier(bar)
#define PROLOG KArgsP ap = kargs(); unsigned char* ws = ap->ws; (void)ws; int tid = tid0; asm volatile("" : "+v"(tid)); const int lane = tid & 63, wave = __builtin_amdgcn_readfirstlane(tid >> 6), gw = vcu * 8 + wave; (void)lane; (void)wave; (void)gw;

    if (PH(0)) for (int rep_ = 0; rep_ < REPS(0); ++rep_) { int tid = tid0; asm volatile("" : "+v"(tid)); const int lane = tid & 63, wave = __builtin_amdgcn_readfirstlane(tid >> 6); Args A; { KArgsP ap = kargs();
#pragma unroll
        for (int i = 0; i < 22; ++i) A.in[i] = ap->in[i];
        A.out = ap->out; A.ws = ap->ws; }
        p0_prologue(A, lds, vcu, G, wave, lane, tid); }
    GRID_BAR();

    if (PH(1)) for (int rep_ = 0; rep_ < REPS(1); ++rep_) { PROLOG h_phase<16>(ap->in[I_X], ap->in[I_CTX], (const float*)WSP(WS_MOD), (bf16*)WSP(WS_HB), (const float*)WSP(WS_WG), (float*)WSP(WS_GL), lds, vcu, G, wave, lane, tid); }
    GRID_BAR();
    if (PH(2)) for (int rep_ = 0; rep_ < REPS(2); ++rep_) { PROLOG pg8::Gemm g{(const bf16*)WSP(WS_HB), (const bf16*)WSP(WS_WAB), TT, N_AB, 1024, 1024, 1024}; pg8::StaticOrder S; S.init(TT, N_AB, G, bx);
      pg8::EpiBf16 E{(bf16*)WSP(WS_P), N_AB}; pg8::gemm_phase<pg8::EpiBf16, pg8::StaticOrder>(lds, g, S, E, tid); }
    GRID_BAR();
#if DBG_LEVEL >= 2
    if (PH(3)) for (int rep_ = 0; rep_ < REPS(3); ++rep_) { PROLOG mlstm_gate_scan((const float*)WSP(WS_GL), ap->in[I_ABGB], ws, gw, NGW, lane); }
    if (PH(4)) for (int rep_ = 0; rep_ < REPS(4); ++rep_) { PROLOG attn_phase((const bf16*)WSP(WS_P), (bf16*)WSP(WS_HB), ap->in[I_ABSINK], (const float*)WSP(WS_ROPE), lds, (unsigned*)WSP(WS_CTL) + 6144 + 64 * rep_, vcu, G, wave, lane, tid); }
    GRID_BAR();
    if (PH(5)) for (int rep_ = 0; rep_ < REPS(5); ++rep_) { PROLOG mlstm_fused_scan((const bf16*)WSP(WS_P), ws, lds, vcu, G, wave, lane, tid); }
    GRID_BAR();
    if (PH(6)) for (int rep_ = 0; rep_ < REPS(6); ++rep_) { PROLOG mlstm_merge((const bf16*)WSP(WS_P), (bf16*)WSP(WS_HB), ap->in[I_ABNW], ws, gw, NGW, lane); }
    GRID_BAR();
#endif
    if (PH(7)) for (int rep_ = 0; rep_ < REPS(7); ++rep_) { PROLOG pg8::Gemm g{(const bf16*)WSP(WS_HB), (const bf16*)WSP(WS_WABO), TT, 1024, 1024, 1024, 1024}; pg8::StaticOrder S; S.init(TT, 1024, G, bx);
      pg8::EpiBf16 E{(bf16*)WSP(WS_P), 1024}; pg8::gemm_phase<pg8::EpiBf16, pg8::StaticOrder>(lds, g, S, E, tid); }
    GRID_BAR();
    if (PH(8)) for (int rep_ = 0; rep_ < REPS(8); ++rep_) { PROLOG ln_phase(ap->in[I_X], ap->in[I_CTX], ap->out, (float*)WSP(WS_XC), (const bf16*)WSP(WS_P), (const float*)WSP(WS_MOD), ap->in[I_LNW], ap->in[I_LNB], (bf16*)WSP(WS_HB), gw, NGW, lane, DRYV(8), false); }
    GRID_BAR();
#if DBG_LEVEL >= 3
    if (PH(9)) for (int rep_ = 0; rep_ < REPS(9); ++rep_) { PROLOG pg8::Gemm g{(const bf16*)WSP(WS_HB), (const bf16*)WSP(WS_WQ0), TT, 2048, 1024, 1024, 1024}; pg8::StaticOrder S; S.init(TT, 2048, G, bx);
      pg8::EpiBf16 E{(bf16*)WSP(WS_P), 2048}; pg8::gemm_phase<pg8::EpiBf16, pg8::StaticOrder>(lds, g, S, E, tid); }
    GRID_BAR();
    if (PH(10)) for (int rep_ = 0; rep_ < REPS(10); ++rep_) { PROLOG peer_route((const bf16*)WSP(WS_P), (const bf16*)WSP(WS_KEYS), (int*)WSP(WS_ST), (float*)WSP(WS_ST + 17 * MiB), gw, NGW, lane, false); }
    GRID_BAR();
#endif
    if (PH(11)) for (int rep_ = 0; rep_ < REPS(22); ++rep_) { PROLOG peer_pass1((const bf16*)WSP(WS_HB), (const int*)WSP(WS_ST), (const float*)WSP(WS_ST + 17 * MiB), WSP(WS_U), (const float*)WSP(WS_SCL), (const float*)WSP(WS_SCL) + 2 * NEXP, (float*)WSP(WS_ST + 34 * MiB), lds, wave, gw, NGW, lane, false); }
    if (PH(11)) for (int rep_ = 0; rep_ < REPS(11); ++rep_) { PROLOG peer_expert<(DBG_LEVEL >= 3)>((const float*)WSP(WS_ST + 34 * MiB), (const int*)WSP(WS_ST), WSP(WS_V),
        ap->out, (float*)WSP(WS_XC), (const float*)WSP(WS_MOD), ap->in[I_LNW] + 1024, ap->in[I_LNB] + 1024, lds, wave, gw, NGW, lane, DRYV(11), false); }
    GRID_BAR();

    if (PH(12)) for (int rep_ = 0; rep_ < REPS(12); ++rep_) { PROLOG h_phase<32>(ap->out, (const float*)WSP(WS_XC), (const float*)WSP(WS_MOD) + 9 * 6144, (bf16*)WSP(WS_HB), (const float*)WSP(WS_WLOW), (float*)WSP(WS_GL), lds, vcu, G, wave, lane, tid);
 }
    GRID_BAR();
    if (PH(13)) for (int rep_ = 0; rep_ < REPS(13); ++rep_) { PROLOG pg8::Gemm g{(const bf16*)WSP(WS_HB), (const bf16*)WSP(WS_WC), TT, N_C, 1024, 1024, 1024}; pg8::StaticOrder S; S.init(TT, N_C, G, bx);
      pg8::EpiBf16 E{(bf16*)WSP(WS_P), N_C}; pg8::gemm_phase<pg8::EpiBf16, pg8::StaticOrder>(lds, g, S, E, tid); }
    GRID_BAR();
#if DBG_LEVEL >= 2
    if (PH(14)) for (int rep_ = 0; rep_ < REPS(14); ++rep_) { PROLOG gla_prep((bf16*)WSP(WS_P), (bf16*)WSP(WS_HB), (const float*)WSP(WS_GL), ap->in[I_GGUP], ap->in[I_GGB], ws, lds, vcu, G, tid, DRYV(14)); }
    GRID_BAR();
    if (PH(15)) for (int rep_ = 0; rep_ < REPS(15); ++rep_) { PROLOG gla_fused_scan((const bf16*)WSP(WS_P), (const bf16*)WSP(WS_HB), ws, lds, vcu, G, wave, lane, tid, DRYV(15)); }
    GRID_BAR();
    if (PH(16)) for (int rep_ = 0; rep_ < REPS(16); ++rep_) { PROLOG gla_merge((bf16*)WSP(WS_P), ap->in[I_GNW], ws, gw, NGW, lane, DRYV(16)); }
    GRID_BAR();
#endif
    if (PH(17)) for (int rep_ = 0; rep_ < REPS(17); ++rep_) { PROLOG pg8::Gemm g{(const bf16*)WSP(WS_P) + 2048, (const bf16*)WSP(WS_WCO), TT, 1024, 1024, N_C, 1024}; pg8::LatOrder S; S.init(NB * SEQ, 1024, G, bx);
      pg8::EpiBf16 E{(bf16*)WSP(WS_HB), 1024}; pg8::gemm_phase<pg8::EpiBf16, pg8::LatOrder>(lds, g, S, E, tid); }
    GRID_BAR();
    if (PH(18)) for (int rep_ = 0; rep_ < REPS(18); ++rep_) { PROLOG ln_phase(ap->out, (const float*)WSP(WS_XC), ap->out, (float*)WSP(WS_XC), (const bf16*)WSP(WS_HB), (const float*)WSP(WS_MOD) + 9 * 6144, ap->in[I_LNW] + 2048, ap->in[I_LNB] + 2048, (bf16*)WSP(WS_HB), gw, NGW, lane, DRYV(18), true); }
    GRID_BAR();
#if DBG_LEVEL >= 3
    if (PH(19)) for (int rep_ = 0; rep_ < REPS(19); ++rep_) { PROLOG pg8::Gemm g{(const bf16*)WSP(WS_HB), (const bf16*)WSP(WS_WQ1), TT, 2048, 1024, 1024, 1024}; pg8::LatOrder S; S.init(NB * SEQ, 2048, G, bx);
      pg8::EpiBf16 E{(bf16*)WSP(WS_P), 2048}; pg8::gemm_phase<pg8::EpiBf16, pg8::LatOrder>(lds, g, S, E, tid); }
    GRID_BAR();
    if (PH(20)) for (int rep_ = 0; rep_ < REPS(20); ++rep_) { PROLOG peer_route((const bf16*)WSP(WS_P), (const bf16*)WSP(WS_KEYS) + (size_t)8 * 2 * 128 * 128, (int*)WSP(WS_ST), (float*)WSP(WS_ST + 17 * MiB), gw, NGW, lane, true); }
    GRID_BAR();
#endif
    if (PH(21)) for (int rep_ = 0; rep_ < REPS(22); ++rep_) { PROLOG peer_pass1((const bf16*)WSP(WS_HB), (const int*)WSP(WS_ST), (const float*)WSP(WS_ST + 17 * MiB), WSP(WS_U) + (size_t)NEXP * 512, (const float*)WSP(WS_SCL) + NEXP, (const float*)WSP(WS_SCL) + 3 * NEXP, (float*)WSP(WS_ST + 34 * MiB), lds, wave, gw, NGW, lane, true); }
    if (PH(21)) for (int rep_ = 0; rep_ < REPS(21); ++rep_) { PROLOG peer_expert<(DBG_LEVEL >= 3)>((const float*)WSP(WS_ST + 34 * MiB), (const int*)WSP(WS_ST), WSP(WS_V) + (size_t)NEXP * 512,
        ap->out, (float*)WSP(WS_XC), (const float*)WSP(WS_MOD) + 9 * 6144, ap->in[I_LNW] + 3072, ap->in[I_LNB] + 3072, lds, wave, gw, NGW, lane, DRYV(21), true); }
}

extern "C" void kernel_launch(void* const* d_in, const int* in_sizes, int n_in, void* d_out, int out_size, void* d_ws, size_t ws_size, hipStream_t stream) {
    static int grid = 0;
    if (grid == 0) {
        if (n_in != 22 || out_size != NB * SEQ * D || ws_size < 512 * MiB) { fprintf(stderr, "kernel_launch: unexpected shapes: n_in %d out %d ws %zu (need %zu)\n", n_in, out_size, ws_size, (size_t)WS_END); grid = -1; return; }
        int dev = 0, cus = 0, per_cu = 0;
        if (hipGetDevice(&dev) != hipSuccess || hipDeviceGetAttribute(&cus, hipDeviceAttributeMultiprocessorCount, dev) != hipSuccess) { grid = -1; return; }
        if (hipFuncSetAttribute((const void*)fwd_megakernel, hipFuncAttributeMaxDynamicSharedMemorySize, LDS_BYTES) != hipSuccess) { fprintf(stderr, "kernel_launch: hipFuncSetAttribute failed\n"); grid = -1; return; }
        if (hipOccupancyMaxActiveBlocksPerMultiprocessor(&per_cu, (const void*)fwd_megakernel, 512, LDS_BYTES) != hipSuccess || per_cu < 1) { fprintf(stderr, "kernel_launch: occupancy query says %d blocks per CU\n", per_cu); }
        (void)hipGetLastError();
        grid = cus;
        fprintf(stderr, "kernel_launch: grid %d, per_cu %d, ws %zu\n", grid, per_cu, ws_size);
    }
    if (grid < 0) return;
    if (hipMemsetAsync((char*)d_ws + WS_CTL, 0, CTL_ZERO_BYTES, stream) != hipSuccess) return;
    Args a{};
    for (int i = 0; i < 22; ++i) a.in[i] = (const float*)d_in[i];
    a.out = (float*)d_out; a.ws = (unsigned char*)d_ws;
    hipLaunchKernelGGL(fwd_megakernel, dim3(grid), dim3(512), LDS_BYTES, stream, a);
}
```

```cpp
#include <hip/hip_runtime.h>
#include <cstdio>
#include <cstdint>

#define GAS __attribute__((address_space(1)))
#define LAS __attribute__((address_space(3)))
typedef unsigned short bf16;
typedef unsigned v4u __attribute__((ext_vector_type(4)));
typedef unsigned v2u __attribute__((ext_vector_type(2)));
typedef float f32x4 __attribute__((ext_vector_type(4)));
typedef float f32x2 __attribute__((ext_vector_type(2)));
typedef short bf16x8 __attribute__((ext_vector_type(8)));
typedef short s16x4 __attribute__((ext_vector_type(4)));
typedef GAS unsigned gu32;
#define RLX_AGENT __ATOMIC_RELAXED, __HIP_MEMORY_SCOPE_AGENT

constexpr int NB = 8, SEQ = 4096, LC = 256, D = 1024;
constexpr int PB = LC + SEQ;
constexpr int TT = NB * PB;
constexpr int NCH = PB / 64;
constexpr int N_AB = 2816;
constexpr int N_C = 3072;
constexpr float LN_EPS = 1e-5f;
constexpr float DN_ALPHA = 1.41421356237f;
constexpr int NEXP = 16384;
__device__ __forceinline__ int map_row(int i, bool lat_only) { return lat_only ? (i >> 12) * 4352 + 256 + (i & 4095) : i; }

constexpr size_t MiB = 1u << 20;
constexpr size_t WS_CTL = 0, CTL_ZERO_BYTES = 64 * 1024;
constexpr size_t WS_MOD = 1 * MiB;
constexpr size_t WS_ROPE = 2 * MiB;
constexpr size_t WS_WG = 2 * MiB + 64 * 1024;
constexpr size_t WS_WLOW = 2 * MiB + 128 * 1024;
constexpr size_t WS_SCL = 3 * MiB;
constexpr size_t WS_BQ = 4 * MiB, WS_CQ = WS_BQ + 1200 * 1024, WS_EM = WS_CQ + 1200 * 1024, WS_AI = WS_EM + 1200 * 1024;
constexpr size_t WS_AST = WS_AI + 1200 * 1024, WS_CL = WS_AST + 32 * 1024;
constexpr size_t WS_ET = 10 * MiB;
constexpr size_t WS_GL = 13 * MiB;
constexpr size_t WS_WAB = 20 * MiB, WS_WABO = 26 * MiB, WS_WC = 28 * MiB, WS_WCO = 34 * MiB, WS_WQ0 = 36 * MiB, WS_WQ1 = 40 * MiB, WS_KEYS = 44 * MiB;
constexpr size_t WS_NST = 45 * MiB;
constexpr size_t WS_XC = 48 * MiB;
constexpr size_t WS_U = 56 * MiB, WS_V = 88 * MiB;
constexpr size_t WS_HB = 120 * MiB;
constexpr size_t WS_P = 188 * MiB;
constexpr size_t WS_ST = 392 * MiB;
constexpr size_t WS_END = 460 * MiB;

constexpr int LDS_BYTES = 163840;
constexpr int MISC_OFF = LDS_BYTES - 64;

__device__ __forceinline__ unsigned f2bf(float f) { unsigned u = __builtin_bit_cast(unsigned, f); return (u + 0x7fffu + ((u >> 16) & 1u)) >> 16; }
__device__ __forceinline__ unsigned pk2(float lo, float hi) { return f2bf(lo) | (f2bf(hi) << 16); }
__device__ __forceinline__ float bflo(unsigned w) { return __builtin_bit_cast(float, w << 16); }
__device__ __forceinline__ float bfhi(unsigned w) { return __builtin_bit_cast(float, w & 0xffff0000u); }
__device__ __forceinline__ float bf2f(bf16 b) { return __builtin_bit_cast(float, (unsigned)b << 16); }
template <int CTRL> __device__ __forceinline__ float dppmov_f(float x) { return __builtin_bit_cast(float, __builtin_amdgcn_mov_dpp(__builtin_bit_cast(int, x), CTRL, 0xf, 0xf, true)); }
__device__ __forceinline__ float wave_sum(float v) {
    v += dppmov_f<0xB1>(v); v += dppmov_f<0x4E>(v); v += dppmov_f<0x141>(v); v += dppmov_f<0x128>(v);
    v += __shfl_xor(v, 16); v += __shfl_xor(v, 32);
    return v;
}
__device__ __forceinline__ float sigmoidf_(float x) { return 1.f / (1.f + __expf(-x)); }
__device__ __forceinline__ float logsigmoidf_(float x) { return fminf(x, 0.f) - log1pf(__expf(-fabsf(x))); }
__device__ __forceinline__ float siluf_(float x) { return x / (1.f + __expf(-x)); }

namespace pg8 {
#define PG8_LAS __attribute__((address_space(3)))
typedef unsigned short bf16_t;
typedef short bf16x8 __attribute__((ext_vector_type(8)));
typedef float f32x4 __attribute__((ext_vector_type(4)));
typedef unsigned u32x4 __attribute__((ext_vector_type(4)));
constexpr int BM = 256, BK = 64, HALF = 128, HTB = HALF * BK * 2  , STAGE_BYTES = 8 * HTB, NXCD = 8, WGM = 8;

__host__ __device__ __forceinline__ int lds_byte(int r, int c) { const int st = (r >> 4) * 2 + (c >> 5), rr = r & 15, cc = c & 31, ob = rr * 64 + cc * 2; return st * 1024 + (ob ^ (((ob >> 9) & 1) << 5)); }
__host__ __device__ __forceinline__ void stage_rc(int b, int& R, int& C) { const int st = b / 1024, sb = b % 1024, swz = sb ^ (((sb >> 9) & 1) << 5); R = (st >> 1) * 16 + swz / 64; C = (st & 1) * 32 + (swz % 64) / 2; }
__host__ __device__ __forceinline__ int perm32(int rho) { const int n = rho >> 4, i = rho & 15; return 8 * (i >> 2) + 4 * n + (i & 3); }

struct Unit { int pm, pn; };
struct Gemm { const bf16_t* A; const bf16_t* Bt; int M, N, K, lda, ldb; };

struct StaticOrder {
    int nM, nN, nwg, G, c;
    __host__ __device__ void init(int M, int N, int G_, int c_) { nM = M / BM; nN = N / BM; nwg = nM * nN; G = G_; c = c_; }
    __host__ __device__ bool next(int i, Unit& u) const {
        const long L = (long)i * G + c; if (L >= nwg) return false;
        int wgid = (int)L; { const int q = nwg / NXCD, r = nwg % NXCD, xcd = wgid % NXCD, off = wgid / NXCD; wgid = (xcd < r ? xcd * (q + 1) : r * (q + 1) + (xcd - r) * q) + off; }
        const int nig = WGM * nN, gid = wgid / nig, fm = gid * WGM, gsz = (nM - fm) < WGM ? (nM - fm) : WGM;
        u.pm = fm + ((wgid % nig) % gsz); u.pn = (wgid % nig) / gsz; return true;
    }
    __device__ __forceinline__ void a_ready(const Unit&) const {}
    __device__ __forceinline__ void done(const Unit&) const {}
};

struct LatOrder : StaticOrder {
    __host__ __device__ bool next(int i, Unit& u) const { if (!StaticOrder::next(i, u)) return false; u.pm = (u.pm >> 4) * 17 + 1 + (u.pm & 15); return true; }
};
__device__ __forceinline__ unsigned cvt_pk_bf16(float lo, float hi) { unsigned r; asm volatile("v_cvt_pk_bf16_f32 %0, %1, %2" : "=v"(r) : "v"(lo), "v"(hi)); return r; }
struct EpiBf16 {
    static constexpr bool PERM = true, AFTER_DRAIN = false;
    bf16_t* O; int ldc;
    __device__ __forceinline__ void operator()(const f32x4 (&acc)[2][2][4][2], const Unit& u, int wr, int wc, int fr, int fq) const {
        const int row0 = u.pm * BM + wr * 64 + fr; const int col0 = u.pn * BM + wc * 32 + 8 * fq;
#pragma unroll
        for (int ai = 0; ai < 2; ++ai)
#pragma unroll
            for (int m = 0; m < 4; ++m) { bf16_t* rowp = O + (size_t)(row0 + ai * HALF + m * 16) * ldc + col0;
#pragma unroll
                for (int bj = 0; bj < 2; ++bj) { const f32x4 v0 = acc[ai][bj][m][0], v1 = acc[ai][bj][m][1];
                    u32x4 w; w.x = cvt_pk_bf16(v0[0], v0[1]); w.y = cvt_pk_bf16(v0[2], v0[3]); w.z = cvt_pk_bf16(v1[0], v1[1]); w.w = cvt_pk_bf16(v1[2], v1[3]);
                    *(u32x4*)(rowp + bj * HALF) = w; } }
    }
};
struct EpiResid {
    static constexpr bool PERM = false, AFTER_DRAIN = false;
    const float* src_lat; const float* src_ctx; float* dst_lat; float* dst_ctx; const float* gate; float gscale; int dry;
    __device__ __forceinline__ void operator()(const f32x4 (&acc)[2][2][4][2], const Unit& u, int wr, int wc, int fr, int fq) const {
        const int b = u.pm / 17, tb = u.pm - b * 17;
        const float* sbase; float* dbase; const float* gr;
        if (tb == 0) { sbase = src_ctx + (size_t)b * 256 * 1024; dbase = dst_ctx + (size_t)b * 256 * 1024; gr = gate + 8 * 6144; }
        else { sbase = src_lat + ((size_t)b * 4096 + (size_t)(tb - 1) * 256) * 1024; dbase = dst_lat + ((size_t)b * 4096 + (size_t)(tb - 1) * 256) * 1024; gr = gate + b * 6144; }
        const int row0 = wr * 64 + fr, col0 = u.pn * BM + wc * 32 + 4 * fq;
        f32x4 gv[2][2];
#pragma unroll
        for (int bj = 0; bj < 2; ++bj)
#pragma unroll
            for (int n = 0; n < 2; ++n) gv[bj][n] = *(const f32x4*)(gr + col0 + bj * HALF + n * 16) * gscale;
#pragma unroll
        for (int ai = 0; ai < 2; ++ai)
#pragma unroll
            for (int mp = 0; mp < 2; ++mp) {
                f32x4 sv[2][2][2];
#pragma unroll
                for (int mm = 0; mm < 2; ++mm) { const size_t off = (size_t)(row0 + ai * HALF + (2 * mp + mm) * 16) * 1024 + col0;
#pragma unroll
                    for (int bj = 0; bj < 2; ++bj)
#pragma unroll
                        for (int n = 0; n < 2; ++n) sv[mm][bj][n] = __builtin_nontemporal_load((const f32x4*)(sbase + off + bj * HALF + n * 16)); }
                asm volatile("" ::: "memory");
#pragma unroll
                for (int mm = 0; mm < 2; ++mm) { const int m = 2 * mp + mm; const size_t off = (size_t)(row0 + ai * HALF + m * 16) * 1024 + col0;
#pragma unroll
                    for (int bj = 0; bj < 2; ++bj)
#pragma unroll
                        for (int n = 0; n < 2; ++n) { const f32x4 ov = sv[mm][bj][n] * 1.41421356237f + gv[bj][n] * acc[ai][bj][m][n]; if (!dry) *(f32x4*)(dbase + off + bj * HALF + n * 16) = ov; } }
                asm volatile("" ::: "memory");
            }
    }
};

template <class Epi, class Sched>
__device__ __forceinline__ void gemm_phase(PG8_LAS unsigned char* lds, const Gemm g, const Sched& S, const Epi& E, const int tid_in) {
    const int tid = tid_in, wid = __builtin_amdgcn_readfirstlane(tid >> 6), lane = tid & 63, wr = wid >> 2, wc = wid & 3, fr = lane & 15, fq = lane >> 4;
    const int K = g.K, nt = K / BK;
    unsigned voffA[2], voffB[2];
#pragma unroll
    for (int i = 0; i < 2; ++i) { int R, C; stage_rc(tid * 16 + i * 8192, R, C); const int Rb = Epi::PERM ? ((R & ~31) + perm32(R & 31)) : R;
        voffA[i] = (unsigned)(R * g.lda + C) * 2u; voffB[i] = (unsigned)(Rb * g.ldb + C) * 2u; }
    const size_t kstep = (size_t)(BK * 2);
    const size_t hstepA = (size_t)HALF * g.lda * 2, hstepB = (size_t)HALF * g.ldb * 2;
    const size_t tstepA = 2 * hstepA, tstepB = 2 * hstepB;
    const unsigned ldsw = (unsigned)wid * 1024u;
    const int aoff = lds_byte(wr * 64 + fr, fq * 8), boff = lds_byte(wc * 32 + fr, fq * 8);
#define PG8_SA(b, h) (((b) * 2 + (h)) * HTB)
#define PG8_SB(b, h) ((4 + (b) * 2 + (h)) * HTB)
#define PG8_STAGE(bufoff, gbase, voff) do { _Pragma("unroll") for (int _i = 0; _i < 2; ++_i) \
        __builtin_amdgcn_global_load_lds((const unsigned*)((const char*)(gbase) + (voff)[_i]), (PG8_LAS unsigned*)(lds + (bufoff) + ldsw + _i * 8192), 16, 0, 0); } while (0)
#define PG8_LDA(dst, b, h) do { _Pragma("unroll") for (int m = 0; m < 4; ++m) _Pragma("unroll") for (int k = 0; k < 2; ++k) dst[m][k] = *(const PG8_LAS bf16x8*)(lds + PG8_SA(b, h) + aoff + m * 2048 + k * 1024); } while (0)
#define PG8_LDB(dst, b, h) do { _Pragma("unroll") for (int n = 0; n < 2; ++n) _Pragma("unroll") for (int k = 0; k < 2; ++k) dst[n][k] = *(const PG8_LAS bf16x8*)(lds + PG8_SB(b, h) + boff + n * 2048 + k * 1024); } while (0)
#define PG8_MMA(ai, bj, At, Bt) do { __builtin_amdgcn_s_setprio(1); _Pragma("unroll") for (int m = 0; m < 4; ++m) _Pragma("unroll") for (int n = 0; n < 2; ++n) _Pragma("unroll") for (int k = 0; k < 2; ++k) \
        acc[ai][bj][m][n] = __builtin_amdgcn_mfma_f32_16x16x32_bf16(Bt[n][k], At[m][k], acc[ai][bj][m][n], 0, 0, 0); __builtin_amdgcn_s_setprio(0); } while (0)
#define PG8_WAIT_V(n) asm volatile("s_waitcnt vmcnt(" #n ")" ::: "memory")
#define PG8_WAIT_L(n) asm volatile("s_waitcnt lgkmcnt(" #n ")" ::: "memory")
#define PG8_BAR __builtin_amdgcn_s_barrier()
#define PG8_SCHED __builtin_amdgcn_sched_barrier(0)
    Unit cur, nxt; int ui = 0;
    if (!S.next(0, cur)) return;
    f32x4 acc[2][2][4][2];
#pragma unroll
    for (int a = 0; a < 2; ++a)
#pragma unroll
        for (int b = 0; b < 2; ++b)
#pragma unroll
            for (int m = 0; m < 4; ++m)
#pragma unroll
                for (int n = 0; n < 2; ++n) acc[a][b][m][n] = (f32x4){0.f, 0.f, 0.f, 0.f};
    bf16x8 At[4][2], B0[2][2], B1[2][2];
    const char* cA = (const char*)g.A + (size_t)cur.pm * tstepA; const char* cB = (const char*)g.Bt + (size_t)cur.pn * tstepB;
    S.a_ready(cur);
    PG8_STAGE(PG8_SB(0, 0), cB, voffB); PG8_STAGE(PG8_SA(0, 0), cA, voffA); PG8_STAGE(PG8_SB(0, 1), cB + hstepB, voffB); PG8_STAGE(PG8_SA(0, 1), cA + hstepA, voffA);
    if (wr == 1) PG8_BAR;
    PG8_WAIT_V(4); PG8_BAR;
    PG8_STAGE(PG8_SB(1, 0), cB + kstep, voffB); PG8_STAGE(PG8_SA(1, 0), cA + kstep, voffA); PG8_STAGE(PG8_SB(1, 1), cB + hstepB + kstep, voffB);
    PG8_WAIT_V(6); PG8_BAR;
    for (;;) {
        const bool has_next = S.next(ui + 1, nxt);
        const char* nA = has_next ? (const char*)g.A + (size_t)nxt.pm * tstepA : cA; const char* nB = has_next ? (const char*)g.Bt + (size_t)nxt.pn * tstepB : cB;
        for (int t = 0; t < nt; t += 2) {
            const bool last = (t == nt - 2);
            const char* a1 = cA + (size_t)(t + 1) * kstep;
            const char* a2 = last ? nA : cA + (size_t)(t + 2) * kstep; const char* b2 = last ? nB : cB + (size_t)(t + 2) * kstep;
            const char* a3 = a2 + kstep; const char* b3 = b2 + kstep;
            if (last && has_next) S.a_ready(nxt);
            PG8_LDB(B0, 0, 0); PG8_SCHED; PG8_LDA(At, 0, 0); PG8_STAGE(PG8_SA(1, 1), a1 + hstepA, voffA);
            PG8_WAIT_L(8); PG8_BAR; PG8_WAIT_L(0); PG8_MMA(0, 0, At, B0); PG8_BAR; PG8_SCHED;
            PG8_LDB(B1, 0, 1); PG8_STAGE(PG8_SB(0, 0), b2, voffB);
            PG8_BAR; PG8_WAIT_L(0); PG8_MMA(0, 1, At, B1); PG8_BAR;
            PG8_LDA(At, 0, 1); PG8_STAGE(PG8_SA(0, 0), a2, voffA);
            PG8_BAR; PG8_WAIT_L(0); PG8_MMA(1, 0, At, B0); PG8_BAR; PG8_SCHED;
            PG8_STAGE(PG8_SB(0, 1), b2 + hstepB, voffB);
            PG8_WAIT_V(6); PG8_BAR; PG8_MMA(1, 1, At, B1); PG8_BAR;
            PG8_LDB(B0, 1, 0); PG8_SCHED; PG8_LDA(At, 1, 0); PG8_STAGE(PG8_SA(0, 1), a2 + hstepA, voffA);
            PG8_WAIT_L(8); PG8_BAR; PG8_WAIT_L(0); PG8_MMA(0, 0, At, B0); PG8_BAR; PG8_SCHED;
            PG8_LDB(B1, 1, 1); PG8_STAGE(PG8_SB(1, 0), b3, voffB);
            PG8_BAR; PG8_WAIT_L(0); PG8_MMA(0, 1, At, B1); PG8_BAR;
            PG8_LDA(At, 1, 1); PG8_STAGE(PG8_SA(1, 0), a3, voffA);
            PG8_BAR; PG8_WAIT_L(0); PG8_MMA(1, 0, At, B0); PG8_BAR; PG8_SCHED;
            PG8_STAGE(PG8_SB(1, 1), b3 + hstepB, voffB);
            PG8_WAIT_V(6); PG8_BAR; PG8_MMA(1, 1, At, B1); PG8_BAR;
        }
        if constexpr (!Epi::AFTER_DRAIN) { E(acc, cur, wr, wc, fr, fq); S.done(cur); }
        if (!has_next) break;
#pragma unroll
        for (int a = 0; a < 2; ++a)
#pragma unroll
            for (int b = 0; b < 2; ++b)
#pragma unroll
                for (int m = 0; m < 4; ++m)
#pragma unroll
                    for (int n = 0; n < 2; ++n) acc[a][b][m][n] = (f32x4){0.f, 0.f, 0.f, 0.f};
        cur = nxt; cA = nA; cB = nB; ++ui;
    }
    PG8_WAIT_V(0);
    if (wr == 0) PG8_BAR;
    PG8_BAR;
    if constexpr (Epi::AFTER_DRAIN) { E.fused(acc, cur, wr, wc, fr, fq, lds, wid, lane); S.done(cur); }
#undef PG8_SA
#undef PG8_SB
#undef PG8_STAGE
#undef PG8_LDA
#undef PG8_LDB
#undef PG8_MMA
#undef PG8_WAIT_V
#undef PG8_WAIT_L
#undef PG8_BAR
#undef PG8_SCHED
}
}

#define XB_TMO      128
#define XB_XCNT(j)  (256  + 64 * (j))
#define XB_XSUB(j)  (1280 + 64 * (j))
#define XB_XGEN(j)  (2304 + 64 * (j))
#define XB_TOP      3328
#define XB_TOPGEN   3392
#define XCD_BAR_WORDS 3456
#define XB_SPIN_CAP (1u << 18)

__device__ __forceinline__ unsigned xb_ld(unsigned* p)              { return __hip_atomic_load(p, __ATOMIC_RELAXED, __HIP_MEMORY_SCOPE_AGENT); }
__device__ __forceinline__ unsigned xb_add(unsigned* p, unsigned v) { return __hip_atomic_fetch_add(p, v, __ATOMIC_RELAXED, __HIP_MEMORY_SCOPE_AGENT); }
__device__ __forceinline__ unsigned xb_xcc_id() { return (unsigned)__builtin_amdgcn_s_getreg((3 << 11) | 20) & 0xFu; }
#define XB_SPIN(cond, bar) do { unsigned _sp = 0; while (cond) { __builtin_amdgcn_s_sleep(1); \
    if ((++_sp & 255u) == 0u) { if (xb_ld(&(bar)[XB_TMO])) break; if (_sp > XB_SPIN_CAP) { atomicAdd(&(bar)[XB_TMO], 1u); break; } } } } while (0)

struct XcdBarrier {
    unsigned* bar; unsigned x;
    volatile LAS unsigned* st;
};

__device__ __forceinline__ XcdBarrier xcd_barrier_post(unsigned* bar, volatile LAS unsigned* st) {
    XcdBarrier b; b.bar = bar; b.x = xb_xcc_id(); b.st = st;
    if (threadIdx.x == 0) (void)xb_add(&bar[XB_XCNT(b.x)], 1u);
    return b;
}
__device__ __forceinline__ void xcd_barrier_complete(unsigned* bar, unsigned x, unsigned& nloc, unsigned& nx) {
    const unsigned G = gridDim.x * gridDim.y * gridDim.z;
    unsigned sum, cnt, mine, sp = 0u;
    for (;;) {
        sum = 0u; cnt = 0u; mine = 0u;
#pragma unroll
        for (unsigned j = 0; j < 16; ++j) { const unsigned c = xb_ld(&bar[XB_XCNT(j)]); sum += c; cnt += (c > 0u) ? 1u : 0u; mine = (j == x) ? c : mine; }
        if (sum == G) break;
        __builtin_amdgcn_s_sleep(1);
        if ((++sp & 255u) == 0u) { if (xb_ld(&bar[XB_TMO])) break; if (sp > XB_SPIN_CAP) { atomicAdd(&bar[XB_TMO], 1u); break; } }
    }
    nloc = mine > 0u ? mine : 1u; nx = cnt > 0u ? cnt : 1u;
}

__device__ __forceinline__ void xcd_barrier(const XcdBarrier& b) {
    asm volatile("s_waitcnt vmcnt(0)" ::: "memory");
    __syncthreads();
    if (threadIdx.x == 0) {
        unsigned* bar = b.bar;
        __builtin_amdgcn_s_waitcnt(0);
        unsigned nloc = b.st[0], nx = b.st[1];
        if (nloc == 0u) { xcd_barrier_complete(bar, b.x, nloc, nx); b.st[0] = nloc; b.st[1] = nx; }
        const unsigned old = xb_add(&bar[XB_XSUB(b.x)], 1u);
        const unsigned gen = old / nloc;
        if (old + 1u == (gen + 1u) * nloc) {
            __builtin_amdgcn_fence(__ATOMIC_RELEASE, "agent");
            asm volatile("s_waitcnt vmcnt(0)" ::: "memory");
            const unsigned og = xb_add(&bar[XB_TOP], 1u);
            const unsigned tg = og / nx;
            if (og + 1u == (tg + 1u) * nx) xb_add(&bar[XB_TOPGEN], 1u);
            else XB_SPIN(xb_ld(&bar[XB_TOPGEN]) == tg, bar);
            __builtin_amdgcn_fence(__ATOMIC_ACQUIRE, "agent");
            xb_add(&bar[XB_XGEN(b.x)], 1u);
            asm volatile("s_waitcnt vmcnt(0)" ::: "memory");
        } else {
            XB_SPIN(xb_ld(&bar[XB_XGEN(b.x)]) == gen, bar);
            __builtin_amdgcn_fence(__ATOMIC_ACQUIRE, "agent");
            asm volatile("s_waitcnt vmcnt(0)" ::: "memory");
        }
    }
    __syncthreads();
}


__device__ __forceinline__ f32x4 mma(bf16x8 a, bf16x8 b, f32x4 c) { return __builtin_amdgcn_mfma_f32_16x16x32_bf16(a, b, c, 0, 0, 0); }
__device__ __forceinline__ bf16x8 frag_row(const LAS bf16* t, int ld, int r0, int c0, int lane) {
    return *(const LAS bf16x8*)(t + (r0 + (lane & 15)) * ld + c0 + 8 * (lane >> 4));
}
__device__ __forceinline__ bf16x8 frag_tr(const LAS bf16* t, int ld, int r0, int c0, int lane) {
    const int g = lane >> 4, q = (lane & 15) >> 2, p = lane & 3;
    const LAS bf16* a = t + (r0 + 8 * g + q) * ld + c0 + 4 * p;
    const s16x4 lo = __builtin_amdgcn_ds_read_tr16_b64_v4i16((LAS s16x4*)a);
    const s16x4 hi = __builtin_amdgcn_ds_read_tr16_b64_v4i16((LAS s16x4*)(a + 4 * ld));
    return (bf16x8){lo[0], lo[1], lo[2], lo[3], hi[0], hi[1], hi[2], hi[3]};
}
#define LDS_FENCE() do { asm volatile("s_waitcnt lgkmcnt(0)" ::: "memory"); __builtin_amdgcn_wave_barrier(); } while (0)

struct Args {
    const float* in[22]; float* out; unsigned char* ws;
};
enum { I_X = 0, I_C, I_CTX, I_CCTX, I_WMOD, I_BMOD, I_LNW, I_LNB, I_ABWIN, I_ABGB, I_ABNW, I_ABSINK, I_ABWOUT, I_GWIN, I_GGUP, I_GGB, I_GNW, I_GWOUT, I_PWQ, I_PKEYS, I_PU, I_PV };

__device__ __forceinline__ const float* srow_c(const float* lat, const float* ctx, int r) { const int b = r / PB, p = r - b * PB; return p < LC ? ctx + (size_t)(b * LC + p) * D : lat + (size_t)(b * SEQ + p - LC) * D; }
__device__ __forceinline__ float* srow(float* lat, float* ctx, int r) { const int b = r / PB, p = r - b * PB; return p < LC ? ctx + (size_t)(b * LC + p) * D : lat + (size_t)(b * SEQ + p - LC) * D; }

__device__ __forceinline__ void p0_transpose_item(const float* W, int K, int ldw, int c0, int ncols, bf16* WT, int row_off, LAS float* scr, int item, int lane,
                                                  int s0lo, int s0hi, float s0, int s1lo, int s1hi, float s1) {
    const int nblk = ncols / 32, kb = item / nblk, nb = item % nblk, k0 = 64 * kb, n0 = 32 * nb;
#pragma unroll 8
    for (int i = 0; i < 32; ++i) { const int kk = 2 * i + (lane >> 5); scr[kk * 33 + (lane & 31)] = W[(size_t)(k0 + kk) * ldw + c0 + n0 + (lane & 31)]; }
    asm volatile("s_waitcnt lgkmcnt(0)" ::: "memory");
    const int c = lane & 7;
#pragma unroll
    for (int j = 0; j < 4; ++j) { const int n = (lane >> 3) + 8 * j; const LAS float* s = scr + (8 * c) * 33 + n;
        const int dr = row_off + n0 + n; float sc = 1.f; if (dr >= s0lo && dr < s0hi) sc = s0; if (dr >= s1lo && dr < s1hi) sc = s1;
        v4u o; o.x = pk2(s[0 * 33] * sc, s[1 * 33] * sc); o.y = pk2(s[2 * 33] * sc, s[3 * 33] * sc); o.z = pk2(s[4 * 33] * sc, s[5 * 33] * sc); o.w = pk2(s[6 * 33] * sc, s[7 * 33] * sc);
        *(v4u*)(WT + (size_t)dr * K + k0 + 8 * c) = o; }
    asm volatile("s_waitcnt lgkmcnt(0)" ::: "memory");
}
__device__ __forceinline__ void cvt_f32_bf16(const float* src, bf16* dst, size_t n, int gtid, int gthreads) {
    const size_t nch = n / 8;
    for (size_t i = gtid; i < nch; i += gthreads) { const f32x4 a = *(const f32x4*)(src + i * 8), b = *(const f32x4*)(src + i * 8 + 4);
        v4u o; o.x = pk2(a[0], a[1]); o.y = pk2(a[2], a[3]); o.z = pk2(b[0], b[1]); o.w = pk2(b[2], b[3]); *(v4u*)(dst + i * 8) = o; }
}
__device__ __forceinline__ void cvt_rows_fp4(const float* src, unsigned char* dst, float* inv, int nrows, int gw, int NGW, int lane) {
    const int hl = lane & 31, hh = lane >> 5;
    for (int r2 = gw; r2 < nrows / 2; r2 += NGW) {
        const int r = 2 * r2 + hh; const float* sp = src + (size_t)r * 1024 + 32 * hl;
        f32x4 x[8]; float m = 0.f;
#pragma unroll
        for (int q = 0; q < 8; ++q) { x[q] = *(const f32x4*)(sp + 4 * q); m = fmaxf(m, fmaxf(fmaxf(fabsf(x[q][0]), fabsf(x[q][1])), fmaxf(fabsf(x[q][2]), fabsf(x[q][3])))); }
        m = fmaxf(m, dppmov_f<0xB1>(m)); m = fmaxf(m, dppmov_f<0x4E>(m)); m = fmaxf(m, dppmov_f<0x141>(m)); m = fmaxf(m, dppmov_f<0x128>(m)); m = fmaxf(m, __shfl_xor(m, 16));
        const float sc = m > 0.f ? 6.0f / m : 1.f;
        unsigned w[4];
#pragma unroll
        for (int d = 0; d < 4; ++d) { unsigned t = 0u;
            t = __builtin_amdgcn_cvt_scalef32_pk_fp4_f32(t, x[2 * d][0] * sc, x[2 * d][1] * sc, 1.0f, 0); t = __builtin_amdgcn_cvt_scalef32_pk_fp4_f32(t, x[2 * d][2] * sc, x[2 * d][3] * sc, 1.0f, 1);
            t = __builtin_amdgcn_cvt_scalef32_pk_fp4_f32(t, x[2 * d + 1][0] * sc, x[2 * d + 1][1] * sc, 1.0f, 2); t = __builtin_amdgcn_cvt_scalef32_pk_fp4_f32(t, x[2 * d + 1][2] * sc, x[2 * d + 1][3] * sc, 1.0f, 3);
            w[d] = t; }
        *(v4u*)(dst + (size_t)r * 512 + 16 * hl) = (v4u){w[0], w[1], w[2], w[3]};
        if (hl == 0) inv[r] = m > 0.f ? m / 6.0f : 1.f;
    }
}
__device__ __forceinline__ void p0_prologue(const Args& A, LAS unsigned char* lds, int vcu, int G, int wave, int lane, int tid) {
    unsigned char* ws = A.ws;
    const int gw = vcu * 8 + wave, NGW = G * 8, gtid = vcu * 512 + tid, gthreads = G * 512;
    LAS float* sil = (LAS float*)lds;
    for (int i = tid; i < 9 * 1024; i += 512) { const float v = i < 8192 ? A.in[I_C][i] : A.in[I_CCTX][i - 8192]; sil[i] = siluf_(v); }
    __syncthreads();
    float* MOD = (float*)(ws + WS_MOD);
    LAS float* part = (LAS float*)(lds + 40960);
    for (int it = vcu; it < 2 * 96; it += G) {
        const int l = it / 96, n = (it % 96) * 64 + lane; const float* wm = A.in[I_WMOD] + (size_t)l * 1024 * 6144 + (size_t)(128 * wave) * 6144 + n;
        float acc[9];
#pragma unroll
        for (int r = 0; r < 9; ++r) acc[r] = 0.f;
#pragma unroll 8
        for (int k = 0; k < 128; ++k) { const float w = wm[(size_t)k * 6144];
#pragma unroll
            for (int r = 0; r < 9; ++r) acc[r] += sil[r * 1024 + 128 * wave + k] * w; }
        __syncthreads();
#pragma unroll
        for (int r = 0; r < 9; ++r) part[(wave * 9 + r) * 64 + lane] = acc[r];
        __syncthreads();
        for (int i = tid; i < 9 * 64; i += 512) { float sum = 0.f;
#pragma unroll
            for (int w8 = 0; w8 < 8; ++w8) sum += part[w8 * 576 + i];
            const int r = i >> 6, c = (it % 96) * 64 + (i & 63); MOD[(size_t)(l * 9 + r) * 6144 + c] = sum + A.in[I_BMOD][l * 6144 + c]; }
    }
    __syncthreads();
    LAS float* scr = (LAS float*)(lds + 40960 + wave * 8704);
    constexpr int I_AB1 = 16 * 64, I_AB2 = 16 * 24, I_ABO = 16 * 32, I_C1 = 16 * 96, I_CO = 16 * 32, I_Q = 16 * 64;
    constexpr int NITEMS = I_AB1 + I_AB2 + I_ABO + I_C1 + I_CO + 2 * I_Q;
    const float rs128 = 0.08838834764831845f;
    for (int it = gw; it < NITEMS; it += NGW) {
        int r = it;
        if (r < I_AB1) { p0_transpose_item(A.in[I_ABWIN], 1024, 2832, 0, 2048, (bf16*)(ws + WS_WAB), 0, scr, r, lane, 512, 1024, rs128, 0, 0, 1.f); continue; } r -= I_AB1;
        if (r < I_AB2) { p0_transpose_item(A.in[I_ABWIN], 1024, 2832, 2064, 768, (bf16*)(ws + WS_WAB), 2048, scr, r, lane, 2048, 2560, 0.125f, 0, 0, 1.f); continue; } r -= I_AB2;
        if (r < I_ABO) { p0_transpose_item(A.in[I_ABWOUT], 1024, 1024, 0, 1024, (bf16*)(ws + WS_WABO), 0, scr, r, lane, 0, 0, 1.f, 0, 0, 1.f); continue; } r -= I_ABO;
        if (r < I_C1) { p0_transpose_item(A.in[I_GWIN], 1024, 3104, 0, 3072, (bf16*)(ws + WS_WC), 0, scr, r, lane, 0, 512, rs128, 0, 0, 1.f); continue; } r -= I_C1;
        if (r < I_CO) { p0_transpose_item(A.in[I_GWOUT], 1024, 1024, 0, 1024, (bf16*)(ws + WS_WCO), 0, scr, r, lane, 0, 0, 1.f, 0, 0, 1.f); continue; } r -= I_CO;
        if (r < I_Q) { p0_transpose_item(A.in[I_PWQ], 1024, 2048, 0, 2048, (bf16*)(ws + WS_WQ0), 0, scr, r, lane, 0, 0, 1.f, 0, 0, 1.f); continue; } r -= I_Q;
        p0_transpose_item(A.in[I_PWQ] + (size_t)1024 * 2048, 1024, 2048, 0, 2048, (bf16*)(ws + WS_WQ1), 0, scr, r, lane, 0, 0, 1.f, 0, 0, 1.f);
    }
    for (int i = gtid; i < 16 * 1024; i += gthreads) { const int g = i >> 10, k = i & 1023; ((float*)(ws + WS_WG))[i] = A.in[I_ABWIN][(size_t)k * 2832 + 2048 + g]; }
    for (int i = gtid; i < 32 * 1024; i += gthreads) { const int g = i >> 10, k = i & 1023; ((float*)(ws + WS_WLOW))[i] = A.in[I_GWIN][(size_t)k * 3104 + 3072 + g]; }
    for (int i = gtid; i < 64 * 16; i += gthreads) { const int pos = i >> 4, f = i & 15; const float inv = powf(10000.f, -(float)f / 16.f); const float ang = (float)pos * inv;
        ((float*)(ws + WS_ROPE))[2 * i] = cosf(ang); ((float*)(ws + WS_ROPE))[2 * i + 1] = sinf(ang); }
    cvt_f32_bf16(A.in[I_PKEYS], (bf16*)(ws + WS_KEYS), (size_t)2 * 8 * 2 * 128 * 128, gtid, gthreads);
    cvt_rows_fp4(A.in[I_PU], ws + WS_U, (float*)(ws + WS_SCL), 2 * NEXP, gw, NGW, lane);
    cvt_rows_fp4(A.in[I_PV], ws + WS_V, (float*)(ws + WS_SCL) + 2 * NEXP, 2 * NEXP, gw, NGW, lane);
}

__device__ __forceinline__ void split8(const float* v, bf16x8& hi, bf16x8& lo) {
#pragma unroll
    for (int j = 0; j < 8; ++j) { const unsigned h = f2bf(v[j]); const float hf = __builtin_bit_cast(float, h << 16); hi[j] = (short)h; lo[j] = (short)f2bf(v[j] - hf); }
}
template <int NG>
__device__ __forceinline__ void h_phase(const float* lat, const float* ctx, const float* mod  , bf16* HB, const float* WGT, float* GL, LAS unsigned char* lds, int vcu, int G, int wave, int lane, int tid) {
    constexpr int NT = NG / 16;
    LAS float* part = (LAS float*)lds;
    const int g = lane >> 4, c16 = lane & 15;
    bf16x8 bhi[NT][4], blo[NT][4];
#pragma unroll
    for (int nt = 0; nt < NT; ++nt)
#pragma unroll
        for (int ks = 0; ks < 4; ++ks) { const float* wp = WGT + (size_t)(16 * nt + c16) * 1024 + 128 * wave + 32 * ks + 8 * g;
            const f32x4 w0 = *(const f32x4*)wp, w1 = *(const f32x4*)(wp + 4); const float wv[8] = {w0[0], w0[1], w0[2], w0[3], w1[0], w1[1], w1[2], w1[3]}; split8(wv, bhi[nt][ks], blo[nt][ks]); }
    for (int tile = vcu; tile < TT / 16; tile += G) {
        const int r0 = tile * 16, b = r0 / PB, p0 = r0 - b * PB; const float* mr = mod + (size_t)(p0 < LC ? 8 : b) * 6144 + 128 * wave + 8 * g;
        const int row = r0 + c16; const float* xr = srow_c(lat, ctx, row) + 128 * wave + 8 * g;
        f32x4 xa[4][2], sha[4][2], sca[4][2];
#pragma unroll
        for (int ks = 0; ks < 4; ++ks)
#pragma unroll
            for (int q = 0; q < 2; ++q) { xa[ks][q] = *(const f32x4*)(xr + 32 * ks + 4 * q); sha[ks][q] = *(const f32x4*)(mr + 32 * ks + 4 * q); sca[ks][q] = *(const f32x4*)(mr + 1024 + 32 * ks + 4 * q); }
        f32x4 acc[NT];
#pragma unroll
        for (int nt = 0; nt < NT; ++nt) acc[nt] = (f32x4){0.f, 0.f, 0.f, 0.f};
#pragma unroll
        for (int ks = 0; ks < 4; ++ks) {
            float hv[8];
#pragma unroll
            for (int q = 0; q < 2; ++q)
#pragma unroll
                for (int i = 0; i < 4; ++i) hv[4 * q + i] = xa[ks][q][i] * (sca[ks][q][i] + 1.0f) + sha[ks][q][i];
            bf16x8 ahi, alo; split8(hv, ahi, alo);
            *(bf16x8*)(HB + (size_t)row * D + 128 * wave + 32 * ks + 8 * g) = ahi;
#pragma unroll
            for (int nt = 0; nt < NT; ++nt) { acc[nt] = mma(ahi, bhi[nt][ks], acc[nt]); acc[nt] = mma(ahi, blo[nt][ks], acc[nt]); acc[nt] = mma(alo, bhi[nt][ks], acc[nt]); }
        }
        __syncthreads();
#pragma unroll
        for (int nt = 0; nt < NT; ++nt)
#pragma unroll
            for (int r = 0; r < 4; ++r) part[(wave * 16 + 4 * g + r) * NG + 16 * nt + c16] = acc[nt][r];
        __syncthreads();
        for (int i = tid; i < 16 * NG; i += 512) { float sum = 0.f;
#pragma unroll
            for (int w8 = 0; w8 < 8; ++w8) sum += part[w8 * 16 * NG + i];
            GL[(size_t)r0 * NG + i] = sum; }
    }
}

__device__ __forceinline__ void ln_row(const float* sr, float* xr, const bf16* yrow, const float* mr, const float* lnw, const float* lnb, bf16* hrow, int lane, int dry, bool active) {
    f32x4 v[4]; float s = 0.f;
#pragma unroll
    for (int j = 0; j < 4; ++j) { const int c = 4 * lane + 256 * j; const f32x4 x = *(const f32x4*)(sr + c), g1 = *(const f32x4*)(mr + 2048 + c); const v2u yw = *(const v2u*)(yrow + c);
        v[j][0] = DN_ALPHA * x[0] + g1[0] * bflo(yw.x); v[j][1] = DN_ALPHA * x[1] + g1[1] * bfhi(yw.x); v[j][2] = DN_ALPHA * x[2] + g1[2] * bflo(yw.y); v[j][3] = DN_ALPHA * x[3] + g1[3] * bfhi(yw.y);
        s += (v[j][0] + v[j][1]) + (v[j][2] + v[j][3]); }
    const float mean = wave_sum(s) * (1.f / D); float s2 = 0.f;
#pragma unroll
    for (int j = 0; j < 4; ++j) { v[j] = v[j] - mean; s2 += (v[j][0] * v[j][0] + v[j][1] * v[j][1]) + (v[j][2] * v[j][2] + v[j][3] * v[j][3]); }
    const float rstd = 1.f / sqrtf(wave_sum(s2) * (1.f / D) + LN_EPS);
    if (active) {
#pragma unroll
    for (int j = 0; j < 4; ++j) { const int c = 4 * lane + 256 * j; const f32x4 w = *(const f32x4*)(lnw + c), bb = *(const f32x4*)(lnb + c);
        const f32x4 x1 = v[j] * rstd * w + bb; if (!dry) *(f32x4*)(xr + c) = x1;
        const f32x4 sh = *(const f32x4*)(mr + 3072 + c), sc = *(const f32x4*)(mr + 4096 + c); const f32x4 hp = x1 * (sc + 1.0f) + sh;
        v2u o; o.x = pk2(hp[0], hp[1]); o.y = pk2(hp[2], hp[3]); if (!dry) *(v2u*)(hrow + c) = o; }
    }
}
__device__ __forceinline__ void ln_phase(const float* slat, const float* sctx, float* lat, float* ctx, const bf16* Y, const float* mod, const float* lnw, const float* lnb, bf16* HB, int gw, int NGW, int lane, int dry, bool lat_only) {
    const int nrows = lat_only ? NB * SEQ : TT;
    for (int i0 = gw; i0 < nrows; i0 += 2 * NGW) {
        const int i1 = i0 + NGW; const bool has1 = i1 < nrows; const int r0 = map_row(i0, lat_only), r1c = map_row(has1 ? i1 : i0, lat_only);
        const int b0 = r0 / PB, p0 = r0 - b0 * PB, b1 = r1c / PB, p1 = r1c - b1 * PB;
        ln_row(srow_c(slat, sctx, r0), srow(lat, ctx, r0), Y + (size_t)r0 * D, mod + (size_t)(p0 < LC ? 8 : b0) * 6144, lnw, lnb, HB + (size_t)r0 * D, lane, dry, true);
        ln_row(srow_c(slat, sctx, r1c), srow(lat, ctx, r1c), Y + (size_t)r1c * D, mod + (size_t)(p1 < LC ? 8 : b1) * 6144, lnw, lnb, HB + (size_t)r1c * D, lane, dry, has1);
    }
}

constexpr int AT_LD = 72;
__device__ __forceinline__ bf16x8 frag_tr_perm(const LAS bf16* t, int ld, int r0, int c0, int lane) {
    const int g = lane >> 4, q = (lane & 15) >> 2, p = lane & 3;
    const LAS bf16* a = t + (r0 + 4 * g + q) * ld + c0 + 4 * p;
    const s16x4 lo = __builtin_amdgcn_ds_read_tr16_b64_v4i16((LAS s16x4*)a);
    const s16x4 hi = __builtin_amdgcn_ds_read_tr16_b64_v4i16((LAS s16x4*)(a + 16 * ld));
    return (bf16x8){lo[0], lo[1], lo[2], lo[3], hi[0], hi[1], hi[2], hi[3]};
}
__device__ __forceinline__ void attn_phase(const bf16* P, bf16* CAT, const float* sink, const float* ropetab, LAS unsigned char* lds, unsigned* qctr, int vcu, int G, int wave, int lane, int tid) {
    LAS bf16* Kt = (LAS bf16*)lds;
    LAS bf16* Vt = (LAS bf16*)(lds + 9216);
    LAS bf16* Qw = (LAS bf16*)(lds + 18432 + wave * 4608);
    const int g = lane >> 4, c16 = lane & 15;
    volatile LAS int* qslot = (volatile LAS int*)(lds + MISC_OFF) + 12;
    for (;;) {
        if (tid == 0) *qslot = (int)__hip_atomic_fetch_add(qctr, 1u, __ATOMIC_RELAXED, __HIP_MEMORY_SCOPE_AGENT);
        __syncthreads();
        const int item = *qslot;
        if (item >= 1024 + 64) break;
        const bool is_ctx = item >= 1024;
        int b, hk, nb;
        if (!is_ctx) { b = item >> 7; hk = (item >> 6) & 1; nb = item & 63; } else { const int it = item - 1024; b = it >> 3; hk = (it >> 2) & 1; nb = it & 3; }
        const int head = hk * 4 + (wave >> 1);
        const int qrow0 = b * PB + (is_ctx ? 0 : LC) + nb * 64 + (wave & 1) * 32;
        const int qlat0 = nb * 64 + (wave & 1) * 32;
        __syncthreads();
#pragma unroll
        for (int i = 0; i < 4; ++i) { const int cidx = lane + 64 * i, rr = cidx >> 3, ch = cidx & 7;
            const v4u raw = *(const v4u*)(P + (size_t)(qrow0 + rr) * N_AB + 2048 + head * 64 + ch * 8); v4u o = raw;
            if (!is_ctx) { const int tl = qlat0 + rr; const int pos = (ch < 4) ? (tl >> 6) : (tl & 63); const float* tb = ropetab + (size_t)(pos * 16 + (ch & 3) * 4) * 2;
                const unsigned wv[4] = {raw.x, raw.y, raw.z, raw.w}; unsigned ov[4];
#pragma unroll
                for (int k = 0; k < 4; ++k) { const float x1 = bflo(wv[k]), x2 = bfhi(wv[k]), c = tb[2 * k], s = tb[2 * k + 1]; ov[k] = pk2(x1 * c - x2 * s, x1 * s + x2 * c); }
                o.x = ov[0]; o.y = ov[1]; o.z = ov[2]; o.w = ov[3]; }
            *(LAS v4u*)(Qw + rr * AT_LD + ch * 8) = o; }
        LDS_FENCE();
        bf16x8 qf[2][2];
#pragma unroll
        for (int mt = 0; mt < 2; ++mt)
#pragma unroll
            for (int ks = 0; ks < 2; ++ks) qf[mt][ks] = frag_row(Qw, AT_LD, 16 * mt, 32 * ks, lane);
        LDS_FENCE();
        f32x4 o[2][4]; float mrun[2], lrun[2];
        const float sk = sink[head];
#pragma unroll
        for (int qt = 0; qt < 2; ++qt) { mrun[qt] = sk; lrun[qt] = 1.f; }
#pragma unroll
        for (int qt = 0; qt < 2; ++qt)
#pragma unroll
            for (int nt = 0; nt < 4; ++nt) o[qt][nt] = (f32x4){0.f, 0.f, 0.f, 0.f};
        const int nkt = is_ctx ? 4 : 9;
        const int srr = tid >> 3, sch = tid & 7;
        int kt = 0; f32x2 trope[4];
#pragma unroll
        for (int i = 0; i < 4; ++i) trope[i] = (f32x2){1.f, 0.f};
        v4u kraw = *(const v4u*)(P + (size_t)(b * PB + srr) * N_AB + 2560 + hk * 64 + sch * 8), vraw = *(const v4u*)(P + (size_t)(b * PB + srr) * N_AB + 2688 + hk * 64 + sch * 8);
        while (kt < nkt) {
            const int kp0 = nb * 64 - 128 + 64 * (kt - 4);
            int kn = kt + 1;
            while (kn < nkt && kn >= 4 && ((nb * 64 - 128 + 64 * (kn - 4)) < 0 || (nb * 64 - 128 + 64 * (kn - 4)) >= SEQ)) ++kn;
            __syncthreads();
            { v4u o = kraw;
              if (kt >= 4) { const unsigned wv[4] = {kraw.x, kraw.y, kraw.z, kraw.w}; unsigned ov[4];
#pragma unroll
                  for (int i = 0; i < 4; ++i) { const float x1 = bflo(wv[i]), x2 = bfhi(wv[i]), c = trope[i][0], sn = trope[i][1]; ov[i] = pk2(x1 * c - x2 * sn, x1 * sn + x2 * c); }
                  o.x = ov[0]; o.y = ov[1]; o.z = ov[2]; o.w = ov[3]; }
              *(LAS v4u*)(Kt + srr * AT_LD + sch * 8) = o; *(LAS v4u*)(Vt + srr * AT_LD + sch * 8) = vraw; }
            if (kn < nkt) { const int kpn = nb * 64 - 128 + 64 * (kn - 4); const int krn = b * PB + (kn < 4 ? 64 * kn : LC + kpn);
                kraw = *(const v4u*)(P + (size_t)(krn + srr) * N_AB + 2560 + hk * 64 + sch * 8); vraw = *(const v4u*)(P + (size_t)(krn + srr) * N_AB + 2688 + hk * 64 + sch * 8);
                if (kn >= 4) { const int tl = kpn + srr; const int pos = (sch < 4) ? (tl >> 6) : (tl & 63); const f32x2* tb = (const f32x2*)(ropetab + (size_t)(pos * 16 + (sch & 3) * 4) * 2);
#pragma unroll
                    for (int i = 0; i < 4; ++i) trope[i] = tb[i]; } }
            __syncthreads();
            const bool need_mask = (kt == 4) || (kt == 8);
            bf16x8 kf[4][2];
#pragma unroll
            for (int km = 0; km < 4; ++km)
#pragma unroll
                for (int ks = 0; ks < 2; ++ks) kf[km][ks] = frag_row(Kt, AT_LD, 16 * km, 32 * ks, lane);
            bf16x8 pa[2][2];
#pragma unroll
            for (int qt = 0; qt < 2; ++qt) {
                f32x4 st[4];
#pragma unroll
                for (int km = 0; km < 4; ++km) { st[km] = (f32x4){0.f, 0.f, 0.f, 0.f};
#pragma unroll
                    for (int ks = 0; ks < 2; ++ks) st[km] = mma(kf[km][ks], qf[qt][ks], st[km]); }
                if (need_mask) {
#pragma unroll
                    for (int km = 0; km < 4; ++km)
#pragma unroll
                        for (int r = 0; r < 4; ++r) { const int dq = (kp0 + 16 * km + 4 * g + r) - (qlat0 + 16 * qt + c16); if (dq > 128 || dq < -128) st[km][r] = -3.0e38f; } }
                float mx = fmaxf(fmaxf(fmaxf(st[0][0], st[0][1]), fmaxf(st[0][2], st[0][3])), fmaxf(fmaxf(st[1][0], st[1][1]), fmaxf(st[1][2], st[1][3])));
                mx = fmaxf(mx, fmaxf(fmaxf(fmaxf(st[2][0], st[2][1]), fmaxf(st[2][2], st[2][3])), fmaxf(fmaxf(st[3][0], st[3][1]), fmaxf(st[3][2], st[3][3]))));
                mx = fmaxf(mx, __shfl_xor(mx, 16)); mx = fmaxf(mx, __shfl_xor(mx, 32));
                const float mnew = fmaxf(mrun[qt], mx), alpha = __expf(mrun[qt] - mnew);
                float ps = 0.f;
#pragma unroll
                for (int km = 0; km < 4; ++km)
#pragma unroll
                    for (int r = 0; r < 4; ++r) { const float pv = __expf(st[km][r] - mnew); st[km][r] = pv; ps += pv; }
                ps += __shfl_xor(ps, 16); ps += __shfl_xor(ps, 32);
                lrun[qt] = lrun[qt] * alpha + ps; mrun[qt] = mnew;
#pragma unroll
                for (int ks2 = 0; ks2 < 2; ++ks2) { const unsigned w0 = pk2(st[2 * ks2][0], st[2 * ks2][1]), w1 = pk2(st[2 * ks2][2], st[2 * ks2][3]), w2 = pk2(st[2 * ks2 + 1][0], st[2 * ks2 + 1][1]), w3 = pk2(st[2 * ks2 + 1][2], st[2 * ks2 + 1][3]);
                    const v4u wv = (v4u){w0, w1, w2, w3}; pa[qt][ks2] = __builtin_bit_cast(bf16x8, wv); }
#pragma unroll
                for (int r = 0; r < 4; ++r) { const float ar = __shfl(alpha, (lane & 48) + 4 * g + r);
#pragma unroll
                    for (int nt = 0; nt < 4; ++nt) o[qt][nt][r] *= ar; }
            }
#pragma unroll
            for (int ks2 = 0; ks2 < 2; ++ks2) {
                bf16x8 vf[4];
#pragma unroll
                for (int nt = 0; nt < 4; ++nt) vf[nt] = frag_tr_perm(Vt, AT_LD, 32 * ks2, 16 * nt, lane);
#pragma unroll
                for (int qt = 0; qt < 2; ++qt)
#pragma unroll
                    for (int nt = 0; nt < 4; ++nt) o[qt][nt] = mma(pa[qt][ks2], vf[nt], o[qt][nt]); }
            LDS_FENCE();
            kt = kn;
        }
#pragma unroll
        for (int qt = 0; qt < 2; ++qt)
#pragma unroll
            for (int r = 0; r < 4; ++r) { const float inv = 1.f / __shfl(lrun[qt], (lane & 48) + 4 * g + r); bf16* orow = CAT + (size_t)(qrow0 + 16 * qt + 4 * g + r) * D + 512 + head * 64;
#pragma unroll
                for (int nt = 0; nt < 4; ++nt) orow[16 * nt + c16] = (bf16)f2bf(o[qt][nt][r] * inv); }
    }
}

__device__ __forceinline__ float wave_prefix_sum(float v) {
    v += __builtin_bit_cast(float, __builtin_amdgcn_update_dpp(0, __builtin_bit_cast(int, v), 0x111, 0xf, 0xf, true)); v += __builtin_bit_cast(float, __builtin_amdgcn_update_dpp(0, __builtin_bit_cast(int, v), 0x112, 0xf, 0xf, true));
    v += __builtin_bit_cast(float, __builtin_amdgcn_update_dpp(0, __builtin_bit_cast(int, v), 0x114, 0xf, 0xf, true)); v += __builtin_bit_cast(float, __builtin_amdgcn_update_dpp(0, __builtin_bit_cast(int, v), 0x118, 0xf, 0xf, true));
    v += __builtin_bit_cast(float, __builtin_amdgcn_update_dpp(0, __builtin_bit_cast(int, v), 0x142, 0xa, 0xf, false)); v += __builtin_bit_cast(float, __builtin_amdgcn_update_dpp(0, __builtin_bit_cast(int, v), 0x143, 0xc, 0xf, false));
    return v;
}
__device__ __forceinline__ float wave_prefix_max(float v) {
    const int ninf = (int)0xff800000u;
    v = fmaxf(v, __builtin_bit_cast(float, __builtin_amdgcn_update_dpp(ninf, __builtin_bit_cast(int, v), 0x111, 0xf, 0xf, false))); v = fmaxf(v, __builtin_bit_cast(float, __builtin_amdgcn_update_dpp(ninf, __builtin_bit_cast(int, v), 0x112, 0xf, 0xf, false)));
    v = fmaxf(v, __builtin_bit_cast(float, __builtin_amdgcn_update_dpp(ninf, __builtin_bit_cast(int, v), 0x114, 0xf, 0xf, false))); v = fmaxf(v, __builtin_bit_cast(float, __builtin_amdgcn_update_dpp(ninf, __builtin_bit_cast(int, v), 0x118, 0xf, 0xf, false)));
    v = fmaxf(v, __builtin_bit_cast(float, __builtin_amdgcn_update_dpp(ninf, __builtin_bit_cast(int, v), 0x142, 0xa, 0xf, false))); v = fmaxf(v, __builtin_bit_cast(float, __builtin_amdgcn_update_dpp(ninf, __builtin_bit_cast(int, v), 0x143, 0xc, 0xf, false)));
    return v;
}
__device__ __forceinline__ void mlstm_gate_scan(const float* GL  , const float* gate_b  , unsigned char* ws, int gw, int NGW, int lane) {
    float* BQ = (float*)(ws + WS_BQ); float* CQ = (float*)(ws + WS_CQ); float* EM = (float*)(ws + WS_EM); float* AI = (float*)(ws + WS_AI);
    float* AST = (float*)(ws + WS_AST); float* CL = (float*)(ws + WS_CL);
    for (int chain = gw; chain < 64; chain += NGW) {
        const int dir = chain >> 5, b = (chain >> 2) & 7, h = chain & 3;
        const float bi = gate_b[dir * 8 + h], bfg = gate_b[dir * 8 + 4 + h];
        float m_st = 0.f;
        float gi_n, gf_n;
        { const int j0 = dir == 0 ? 0 : 3; const int p0 = j0 * 64 + (dir == 0 ? lane : 63 - lane); const float* gr = GL + (size_t)(b * PB + p0) * 16 + dir * 8; gi_n = gr[h]; gf_n = gr[4 + h]; }
        for (int sc = 0; sc < NCH; ++sc) {
            const int j = dir == 0 ? sc : (sc < 4 ? 3 - sc : 71 - sc);
            const int p = j * 64 + (dir == 0 ? lane : 63 - lane);
            const float li = gi_n + bi, lf = logsigmoidf_(gf_n + bfg);
            if (sc + 1 < NCH) { const int sn = sc + 1; const int jn = dir == 0 ? sn : (sn < 4 ? 3 - sn : 71 - sn); const int pn = jn * 64 + (dir == 0 ? lane : 63 - lane);
                const float* gr = GL + (size_t)(b * PB + pn) * 16 + dir * 8; gi_n = gr[h]; gf_n = gr[4 + h]; }
            const float cum = wave_prefix_sum(lf);
            const float bb = li - cum; const float pm = wave_prefix_max(bb);
            const float c = fmaxf(m_st, pm);
            const size_t ti = (size_t)chain * PB + p;
            BQ[ti] = bb; CQ[ti] = c; EM[ti] = __expf(-(cum + c)); AI[ti] = __expf(m_st - c);
            const float cl = __builtin_bit_cast(float, __builtin_amdgcn_readlane(__builtin_bit_cast(int, c), 63)), tot = __builtin_bit_cast(float, __builtin_amdgcn_readlane(__builtin_bit_cast(int, cum), 63));
            if (lane == 0) { CL[chain * NCH + j] = cl; AST[chain * NCH + j] = __expf(m_st - cl); }
            m_st = tot + cl;
        }
    }
}


__device__ __forceinline__ float logsig_fast(float x) { return fminf(x, 0.f) - __logf(1.f + __expf(-fabsf(x))); }
__device__ __forceinline__ void gla_prep(bf16* P, bf16* QKR, const float* LOW  , const float* gate_up  , const float* gate_b  , unsigned char* ws,
                                         LAS unsigned char* lds, int vcu, int G, int tid, int dry) {
    float* ET = (float*)(ws + WS_ET);
    LAS float* lowt = (LAS float*)lds;
    LAS bf16* qs = (LAS bf16*)(lds + 8192);
    LAS bf16* ks = (LAS bf16*)(lds + 24576);
    LAS float* LA = (LAS float*)(lds + 40960);
    LAS float* HT = (LAS float*)(lds + 106496);
    const int dc = tid & 255, dir = dc >> 7, ch = dc & 127, half = tid >> 8;
    for (int item = vcu; item < NB * NCH * 4; item += G) {
        const int b = item / (NCH * 4), j = (item >> 2) % NCH, h = item & 3;
        const int row0 = b * PB + j * 64, c = h * 128 + ch;
        __syncthreads();
        for (int i = tid; i < 64 * 32; i += 512) lowt[i] = LOW[(size_t)row0 * 32 + i];
#pragma unroll
        for (int i = 0; i < 2; ++i) { const int cidx = tid + 512 * i, rr = cidx >> 4, c8 = cidx & 15; const bf16* src = P + (size_t)(row0 + rr) * N_C + h * 128 + c8 * 8;
            *(LAS v4u*)(qs + rr * 128 + c8 * 8) = *(const v4u*)src; *(LAS v4u*)(ks + rr * 128 + c8 * 8) = *(const v4u*)(src + 512); }
        float gu[16];
#pragma unroll
        for (int k = 0; k < 16; ++k) gu[k] = gate_up[(size_t)(dir * 16 + k) * 512 + c];
        const float gb = gate_b[dir * 512 + c];
        __syncthreads();
        float hsum = 0.f;
#pragma unroll 4
        for (int i = 0; i < 32; ++i) { const int t = half * 32 + i; float x = gb;
#pragma unroll
            for (int k = 0; k < 16; ++k) x += lowt[t * 32 + dir * 16 + k] * gu[k];
            const float la = logsig_fast(x) * (1.f / 16.f); LA[t * 256 + dc] = la; hsum += la; }
        HT[half * 256 + dc] = hsum;
        __syncthreads();
        float cum = (dir == 0) ? (half == 1 ? HT[dc] : 0.f) : (half == 0 ? HT[256 + dc] : 0.f);
#pragma unroll 4
        for (int i = 0; i < 32; ++i) { const int t = half * 32 + (dir == 0 ? i : 31 - i);
            cum += LA[t * 256 + dc];
            const float e = __expf(cum), ei = __expf(-cum);
            const size_t ro = (size_t)(row0 + t) * N_C;
            const float qv = bf2f(qs[t * 128 + ch]), kv = bf2f(ks[t * 128 + ch]);
            if (dir == 0) { if (!dry) { P[ro + c] = (bf16)f2bf(qv * e); P[ro + 512 + c] = (bf16)f2bf(kv * ei); } }
            else { QKR[(size_t)(row0 + t) * 1024 + c] = (bf16)f2bf(qv * e); QKR[(size_t)(row0 + t) * 1024 + 512 + c] = (bf16)f2bf(kv * ei); } }
        if (half == 0) ET[((size_t)((dir * 8 + b) * 4 + h) * NCH + j) * 128 + ch] = __expf(HT[dc] + HT[256 + dc]);
    }
}


__device__ __forceinline__ unsigned f2sort(float f) { const unsigned u = __builtin_bit_cast(unsigned, f); return (u & 0x80000000u) ? ~u : (u | 0x80000000u); }
__device__ __forceinline__ float sort2f(unsigned s) { const unsigned u = (s & 0x80000000u) ? (s & 0x7fffffffu) : ~s; return __builtin_bit_cast(float, u); }
template <int CTRL> __device__ __forceinline__ unsigned dppmov_u(unsigned x) { return (unsigned)__builtin_amdgcn_mov_dpp((int)x, CTRL, 0xf, 0xf, true); }
__device__ __forceinline__ unsigned gmax16(unsigned x) { unsigned y;
    y = dppmov_u<0xB1>(x); x = x > y ? x : y; y = dppmov_u<0x4E>(x); x = x > y ? x : y; y = dppmov_u<0x141>(x); x = x > y ? x : y; y = dppmov_u<0x128>(x); x = x > y ? x : y; return x; }
__device__ __forceinline__ float gsum16(float x) {
    x += __builtin_bit_cast(float, dppmov_u<0xB1>(__builtin_bit_cast(unsigned, x))); x += __builtin_bit_cast(float, dppmov_u<0x4E>(__builtin_bit_cast(unsigned, x)));
    x += __builtin_bit_cast(float, dppmov_u<0x141>(__builtin_bit_cast(unsigned, x))); x += __builtin_bit_cast(float, dppmov_u<0x128>(__builtin_bit_cast(unsigned, x))); return x; }
#define CSWAP(a, b) do { const unsigned hi_ = (a) > (b) ? (a) : (b), lo_ = (a) > (b) ? (b) : (a); (a) = hi_; (b) = lo_; } while (0)
__device__ __forceinline__ void peer_route(const bf16* Q, const bf16* KEYS, int* EID, float* GWT, int gw, int NGW, int lane, bool lat_only) {
    const int g = lane >> 4, c16 = lane & 15, gbase = lane & 48;
    const int nwi = (lat_only ? NB * SEQ / 16 : TT / 16) * 8;
    const unsigned tw = (c16 == 0 ? 0x03020100u : (c16 == 1 ? 0x07060504u : (c16 == 2 ? 0x0b0a0908u : (c16 == 3 ? 0x0f0e0d0cu : (c16 == 4 ? 0x13121110u : (c16 == 5 ? 0x17161514u : (c16 == 6 ? 0x23222120u : (c16 == 7 ? 0x32313024u : (c16 == 8 ? 0x42414033u : (c16 == 9 ? 0x61605150u : (c16 == 10 ? 0x90807170u : (c16 == 11 ? 0xd0c0b0a0u : (c16 == 12 ? 0xfffff0e0u : 0xffffffffu)))))))))))));
    for (int wi = gw; wi < nwi; wi += NGW) {
        const int t0 = map_row((wi >> 3) * 16, lat_only), head = wi & 7;
        unsigned tops[2][4];
#pragma unroll
        for (int p = 0; p < 2; ++p) {
            const bf16* qrow = Q + (size_t)(t0 + c16) * 2048 + head * 256 + p * 128 + 8 * g;
            bf16x8 qf[4];
#pragma unroll
            for (int ks = 0; ks < 4; ++ks) qf[ks] = *(const bf16x8*)(qrow + 32 * ks);
            const bf16* kb = KEYS + (size_t)(head * 2 + p) * 128 * 128 + (size_t)c16 * 128 + 8 * g;
            unsigned key[8][4];
#pragma unroll
            for (int nt = 0; nt < 8; ++nt) { f32x4 s = (f32x4){0.f, 0.f, 0.f, 0.f};
#pragma unroll
                for (int ks = 0; ks < 4; ++ks) s = mma(qf[ks], *(const bf16x8*)(kb + (size_t)nt * 16 * 128 + 32 * ks), s);
#pragma unroll
                for (int r = 0; r < 4; ++r) key[nt][r] = (f2sort(s[r]) & ~127u) | (unsigned)(127 - (16 * nt + c16)); }
            unsigned kk[4][8];
#pragma unroll
            for (int r = 0; r < 4; ++r) {
#pragma unroll
                for (int nt = 0; nt < 8; ++nt) kk[r][nt] = key[nt][r];
                CSWAP(kk[r][0], kk[r][1]); CSWAP(kk[r][2], kk[r][3]); CSWAP(kk[r][4], kk[r][5]); CSWAP(kk[r][6], kk[r][7]); CSWAP(kk[r][0], kk[r][2]); CSWAP(kk[r][1], kk[r][3]); CSWAP(kk[r][4], kk[r][6]); CSWAP(kk[r][5], kk[r][7]);
                CSWAP(kk[r][1], kk[r][2]); CSWAP(kk[r][5], kk[r][6]); CSWAP(kk[r][0], kk[r][4]); CSWAP(kk[r][1], kk[r][5]); CSWAP(kk[r][2], kk[r][6]); CSWAP(kk[r][3], kk[r][7]); CSWAP(kk[r][2], kk[r][4]); CSWAP(kk[r][3], kk[r][5]);
                CSWAP(kk[r][1], kk[r][2]); CSWAP(kk[r][3], kk[r][4]); CSWAP(kk[r][5], kk[r][6]); }
            unsigned tt[4] = {0u, 0u, 0u, 0u};
#pragma unroll 2
            for (int rd = 0; rd < 16; ++rd) {
#pragma unroll
                for (int r = 0; r < 4; ++r) { const unsigned m = gmax16(kk[r][0]); const bool w = (kk[r][0] == m);
#pragma unroll
                    for (int q = 0; q < 7; ++q) kk[r][q] = w ? kk[r][q + 1] : kk[r][q];
                    kk[r][7] = w ? 0u : kk[r][7];
                    tt[r] = (c16 == rd) ? m : tt[r]; } }
#pragma unroll
            for (int r = 0; r < 4; ++r) tops[p][r] = tt[r];
        }
        unsigned res[4]; unsigned kq[4][4];
#pragma unroll
        for (int r = 0; r < 4; ++r) { res[r] = 0u;
#pragma unroll
            for (int sl = 0; sl < 4; ++sl) { const unsigned byte = (tw >> (8 * sl)) & 255u; const int ii = (int)(byte >> 4), jj = (int)(byte & 15u);
                const float a = sort2f((unsigned)__shfl((int)tops[0][r], gbase + ii) & ~127u), bq = sort2f((unsigned)__shfl((int)tops[1][r], gbase + jj) & ~127u);
                kq[r][sl] = byte == 255u ? 0u : ((f2sort(a + bq) & ~255u) | (unsigned)((15 - ii) << 4) | (unsigned)(15 - jj)); }
            CSWAP(kq[r][0], kq[r][1]); CSWAP(kq[r][2], kq[r][3]); CSWAP(kq[r][0], kq[r][2]); CSWAP(kq[r][1], kq[r][3]); CSWAP(kq[r][1], kq[r][2]); }
#pragma unroll 2
        for (int rd = 0; rd < 16; ++rd) {
#pragma unroll
            for (int r = 0; r < 4; ++r) { const unsigned m = gmax16(kq[r][0]); const bool w = (kq[r][0] == m);
                kq[r][0] = w ? kq[r][1] : kq[r][0]; kq[r][1] = w ? kq[r][2] : kq[r][1]; kq[r][2] = w ? kq[r][3] : kq[r][2]; kq[r][3] = w ? 0u : kq[r][3];
                res[r] = (c16 == rd) ? m : res[r]; } }
#pragma unroll
        for (int r = 0; r < 4; ++r) {
            const float val = sort2f(res[r] & ~255u); const int ii = 15 - (int)((res[r] >> 4) & 15u), jj = 15 - (int)(res[r] & 15u);
            const float mx = __shfl(val, gbase);
            const float ex = __expf(val - mx), sum = gsum16(ex);
            const unsigned i0 = 127u - ((unsigned)__shfl((int)tops[0][r], gbase + ii) & 127u), i1 = 127u - ((unsigned)__shfl((int)tops[1][r], gbase + jj) & 127u);
            const size_t o = (size_t)(t0 + 4 * g + r) * 128 + head * 16 + c16;
            EID[o] = (int)(i0 * 128u + i1); GWT[o] = ex / sum;
        }
    }
}

__device__ __forceinline__ void unpack8(const v4u w, float* o) { o[0] = bflo(w.x); o[1] = bfhi(w.x); o[2] = bflo(w.y); o[3] = bfhi(w.y); o[4] = bflo(w.z); o[5] = bfhi(w.z); o[6] = bflo(w.w); o[7] = bfhi(w.w); }
typedef int v8i __attribute__((ext_vector_type(8)));
constexpr int P1_SLOT = 528, P1_BUF = 16 * P1_SLOT, P1_HQ = 2 * P1_BUF, P1_DOTS = P1_HQ, P1_WAVE_LDS = P1_HQ + 3072;
__device__ __forceinline__ int p1_sigma(int j) { return j < 8 ? (j ^ 4) : j; }
__device__ __forceinline__ void peer_pass1(const bf16* HB, const int* EID, const float* GWT, const unsigned char* U4, const float* SUi, const float* SVi, float* COEF,
                                           LAS unsigned char* lds, int wave, int gw, int NGW, int lane, bool lat_only) {
    LAS unsigned char* wl = lds + wave * P1_WAVE_LDS;
    LAS float* dots = (LAS float*)(wl + P1_DOTS);
    const int n = lane & 15, g = lane >> 4;
    const int nrows = lat_only ? NB * SEQ : TT;
    const unsigned aoff = (unsigned)(p1_sigma(n) * P1_SLOT + 128 * g);
    const unsigned boff = (unsigned)(P1_HQ + (n < 6 ? 512 * n : 0) + 128 * g);
    const float wn = n == 0 ? 1.f : (n == 1 ? 0.25f : (n == 2 ? 0.0625f : (n == 3 ? 0.015625f : (n == 4 ? 0.00390625f : (n == 5 ? 0.0009765625f : 0.f)))));
    int ri = gw;
    if (ri >= nrows) return;
    int r = map_row(ri, lat_only);
    v4u hn0 = *(const v4u*)(HB + (size_t)r * D + 16 * lane), hn1 = *(const v4u*)(HB + (size_t)r * D + 16 * lane + 8);
    int eidAn = EID[(size_t)r * 128 + lane], eidBn = EID[(size_t)r * 128 + 64 + lane];
#define P1_DMA(src_e, base_, bufo_) do { int ids_[16]; _Pragma("unroll") for (int j_ = 0; j_ < 16; ++j_) ids_[j_] = __builtin_amdgcn_readlane((src_e), (base_) + j_); \
        if (lane < 32) { _Pragma("unroll") for (int j_ = 0; j_ < 16; ++j_) \
        __builtin_amdgcn_global_load_lds((const unsigned*)(U4 + (size_t)ids_[j_] * 512 + 16 * lane), (LAS unsigned*)(wl + (bufo_) + p1_sigma(j_) * P1_SLOT), 16, 0, 0); } } while (0)
    P1_DMA(eidAn, 0, 0); P1_DMA(eidAn, 16, P1_BUF);
    for (; ri < nrows; ri += NGW) {
        r = map_row(ri, lat_only);
        const int eidA = eidAn, eidB = eidBn;
        { float h[16]; unpack8(hn0, h); unpack8(hn1, h + 8);
#pragma unroll
          for (int part = 0; part < 6; ++part) {
              unsigned w[2];
#pragma unroll
              for (int d = 0; d < 2; ++d) { unsigned t = 0u;
                  t = __builtin_amdgcn_cvt_scalef32_pk_fp4_f32(t, h[8 * d], h[8 * d + 1], 1.0f, 0); t = __builtin_amdgcn_cvt_scalef32_pk_fp4_f32(t, h[8 * d + 2], h[8 * d + 3], 1.0f, 1);
                  t = __builtin_amdgcn_cvt_scalef32_pk_fp4_f32(t, h[8 * d + 4], h[8 * d + 5], 1.0f, 2); t = __builtin_amdgcn_cvt_scalef32_pk_fp4_f32(t, h[8 * d + 6], h[8 * d + 7], 1.0f, 3);
                  w[d] = t; }
              *(LAS v2u*)(wl + P1_HQ + 512 * part + 8 * lane) = (v2u){w[0], w[1]};
              if (part < 5) {
#pragma unroll
                  for (int d = 0; d < 2; ++d) {
                      const f32x2 q0 = __builtin_amdgcn_cvt_scalef32_pk_f32_fp4(w[d], 1.0f, 0), q1 = __builtin_amdgcn_cvt_scalef32_pk_f32_fp4(w[d], 1.0f, 1);
                      const f32x2 q2 = __builtin_amdgcn_cvt_scalef32_pk_f32_fp4(w[d], 1.0f, 2), q3 = __builtin_amdgcn_cvt_scalef32_pk_f32_fp4(w[d], 1.0f, 3);
                      h[8 * d] = (h[8 * d] - q0[0]) * 4.f; h[8 * d + 1] = (h[8 * d + 1] - q0[1]) * 4.f; h[8 * d + 2] = (h[8 * d + 2] - q1[0]) * 4.f; h[8 * d + 3] = (h[8 * d + 3] - q1[1]) * 4.f;
                      h[8 * d + 4] = (h[8 * d + 4] - q2[0]) * 4.f; h[8 * d + 5] = (h[8 * d + 5] - q2[1]) * 4.f; h[8 * d + 6] = (h[8 * d + 6] - q3[0]) * 4.f; h[8 * d + 7] = (h[8 * d + 7] - q3[1]) * 4.f; } } } }
        const float gwtA = GWT[(size_t)r * 128 + lane], gwtB = GWT[(size_t)r * 128 + 64 + lane];
        const float suA = SUi[eidA], suB = SUi[eidB], svA = SVi[eidA], svB = SVi[eidB];
        const int rin = ri + NGW; const bool more = rin < nrows; const int rn = map_row(more ? rin : ri, lat_only);
        hn0 = *(const v4u*)(HB + (size_t)rn * D + 16 * lane); hn1 = *(const v4u*)(HB + (size_t)rn * D + 16 * lane + 8);
        eidAn = EID[(size_t)rn * 128 + lane]; eidBn = EID[(size_t)rn * 128 + 64 + lane];
        LDS_FENCE();
        v4u bw[8];
#pragma unroll
        for (int c = 0; c < 8; ++c) bw[c] = *(LAS const v4u*)(wl + boff + 16 * c);
#pragma unroll 1
        for (int G = 0; G < 8; ++G) {
            if (G < 7 || more) asm volatile("s_waitcnt vmcnt(16)" ::: "memory"); else asm volatile("s_waitcnt vmcnt(0)" ::: "memory");
            const unsigned bufo = (G & 1) ? (unsigned)P1_BUF : 0u;
            v4u aw[8];
#pragma unroll
            for (int c = 0; c < 8; ++c) aw[c] = *(LAS const v4u*)(wl + bufo + aoff + 16 * c);
            asm volatile("s_waitcnt lgkmcnt(0)" ::: "memory");
            { const int srcsel = G < 2 ? eidA : (G < 6 ? eidB : eidAn); const int base = 16 * ((G + 2) & 3);
              if (G < 6 || more) { if (G & 1) P1_DMA(srcsel, base, P1_BUF); else P1_DMA(srcsel, base, 0); } }
            f32x4 acc = (f32x4){0.f, 0.f, 0.f, 0.f};
#pragma unroll
            for (int c = 0; c < 8; ++c) {
                const v8i A = (v8i){(int)aw[c].x, (int)aw[c].y, (int)aw[c].z, (int)aw[c].w, 0, 0, 0, 0};
                const v8i Bv = (v8i){(int)bw[c].x, (int)bw[c].y, (int)bw[c].z, (int)bw[c].w, 0, 0, 0, 0};
                acc = __builtin_amdgcn_mfma_scale_f32_16x16x128_f8f6f4(A, Bv, acc, 4, 4, 0, 0, 0, 0); }
            f32x4 dv;
#pragma unroll
            for (int k = 0; k < 4; ++k) dv[k] = gsum16(acc[k] * wn);
            if (n == 0) *(LAS f32x4*)(dots + 16 * G + 4 * g) = dv;
        }
        LDS_FENCE();
        { const float dot = dots[lane] * suA; COEF[(size_t)r * 128 + lane] = gwtA * 0.5f * dot * (1.f + erff(dot * 0.70710678118f)) * svA; }
        { const float dot = dots[64 + lane] * suB; COEF[(size_t)r * 128 + 64 + lane] = gwtB * 0.5f * dot * (1.f + erff(dot * 0.70710678118f)) * svB; }
    }
#undef P1_DMA
}
constexpr int P2_CPART = 16384, P2_CSTAGE = P2_CPART + 256, P2_FSTAGE = P2_CSTAGE + 512;
typedef int v2i __attribute__((ext_vector_type(2)));
template <bool USE_PEER>
__device__ __forceinline__ void peer_expert(const float* COEF, const int* EID, const unsigned char* V4,
                                            float* lat, float* ctx, const float* mod, const float* lnw, const float* lnb, LAS unsigned char* lds, int wave, int gw, int NGW, int lane, int dry, bool lat_only) {
    LAS unsigned char* wl = lds + wave * P1_WAVE_LDS;
    LAS float* cstage = (LAS float*)(wl + P2_CSTAGE); LAS float* fstage = (LAS float*)(wl + P2_FSTAGE);
    const int c = lane & 15, kb = lane >> 4, drow = lane >> 3, dpos = lane & 7, fk = (c >> 1) & 7;
    const unsigned trbase = (unsigned)((32 * kb + c) * 128);
    const int nrows = lat_only ? NB * SEQ : TT;
    int ri = gw;
    if (ri >= nrows) return;
    unsigned roff[16];
#define P2_ROFF(row_) do { _Pragma("unroll") for (int i_ = 0; i_ < 16; ++i_) roff[i_] = (unsigned)EID[(size_t)(row_) * 128 + 8 * i_ + drow] * 512u + 16u * (unsigned)(dpos ^ ((4 * i_ + (drow >> 1)) & 7)); } while (0)
    P2_ROFF(map_row(ri, lat_only));
#define P2_DMA(cqo_) do { _Pragma("unroll") for (int i_ = 0; i_ < 16; ++i_) \
        __builtin_amdgcn_global_load_lds((const unsigned*)(V4 + (size_t)(roff[i_] + (cqo_))), (LAS unsigned*)(wl + 1024 * i_), 16, 0, 0); } while (0)
    if (USE_PEER) P2_DMA(0u);
    for (; ri < nrows; ri += NGW) {
        const int r = map_row(ri, lat_only);
        const int b = r / PB, p = r - b * PB; float* xr = srow(lat, ctx, r); const float* mr = mod + (size_t)(p < LC ? 8 : b) * 6144;
        float f[16];
#pragma unroll
        for (int i = 0; i < 16; ++i) f[i] = 0.f;
        if (USE_PEER) {
        const int rin = ri + NGW; const bool more = rin < nrows; const int rn = map_row(more ? rin : ri, lat_only);
        const float cA = COEF[(size_t)r * 128 + lane], cB = COEF[(size_t)r * 128 + 64 + lane];
        float cm = fmaxf(fabsf(cA), fabsf(cB));
        cm = fmaxf(cm, dppmov_f<0xB1>(cm)); cm = fmaxf(cm, dppmov_f<0x4E>(cm)); cm = fmaxf(cm, dppmov_f<0x141>(cm)); cm = fmaxf(cm, dppmov_f<0x128>(cm)); cm = fmaxf(cm, __shfl_xor(cm, 16)); cm = fmaxf(cm, __shfl_xor(cm, 32));
        const float sc = cm > 0.f ? 6.0f / cm : 1.f, isc = cm > 0.f ? cm * (1.f / 6.0f) : 1.f;
        cstage[lane] = cA * sc; cstage[64 + lane] = cB * sc;
        LDS_FENCE();
        if (lane < 16) {
            float h[8]; { const f32x4 x0 = *(LAS const f32x4*)(cstage + 8 * lane), x1 = *(LAS const f32x4*)(cstage + 8 * lane + 4); h[0] = x0[0]; h[1] = x0[1]; h[2] = x0[2]; h[3] = x0[3]; h[4] = x1[0]; h[5] = x1[1]; h[6] = x1[2]; h[7] = x1[3]; }
#pragma unroll
            for (int part = 0; part < 4; ++part) {
                unsigned t = 0u;
                t = __builtin_amdgcn_cvt_scalef32_pk_fp4_f32(t, h[0], h[1], 1.0f, 0); t = __builtin_amdgcn_cvt_scalef32_pk_fp4_f32(t, h[2], h[3], 1.0f, 1);
                t = __builtin_amdgcn_cvt_scalef32_pk_fp4_f32(t, h[4], h[5], 1.0f, 2); t = __builtin_amdgcn_cvt_scalef32_pk_fp4_f32(t, h[6], h[7], 1.0f, 3);
                *(LAS unsigned*)(wl + P2_CPART + 64 * part + 4 * lane) = t;
                if (part < 3) { const f32x2 q0 = __builtin_amdgcn_cvt_scalef32_pk_f32_fp4(t, 1.0f, 0), q1 = __builtin_amdgcn_cvt_scalef32_pk_f32_fp4(t, 1.0f, 1), q2 = __builtin_amdgcn_cvt_scalef32_pk_f32_fp4(t, 1.0f, 2), q3 = __builtin_amdgcn_cvt_scalef32_pk_f32_fp4(t, 1.0f, 3);
                    h[0] = (h[0] - q0[0]) * 4.f; h[1] = (h[1] - q0[1]) * 4.f; h[2] = (h[2] - q1[0]) * 4.f; h[3] = (h[3] - q1[1]) * 4.f; h[4] = (h[4] - q2[0]) * 4.f; h[5] = (h[5] - q2[1]) * 4.f; h[6] = (h[6] - q3[0]) * 4.f; h[7] = (h[7] - q3[1]) * 4.f; } } }
        LDS_FENCE();
        v4u aw = (v4u){0u, 0u, 0u, 0u};
        if (c < 4) aw = *(LAS const v4u*)(wl + P2_CPART + 64 * c + 16 * kb);
        const v8i A = (v8i){(int)aw.x, (int)aw.y, (int)aw.z, (int)aw.w, 0, 0, 0, 0};
#pragma unroll 1
        for (int cq = 0; cq < 4; ++cq) {
            asm volatile("s_waitcnt vmcnt(0)" ::: "memory");
#define P2_TILES(t0_) do { v2i r1[8], r2[8]; \
            _Pragma("unroll") for (int t = 0; t < 8; ++t) { const unsigned a = trbase + 16u * (unsigned)((((t0_) + t) >> 1) ^ fk) + 8u * (unsigned)(t & 1); \
                r1[t] = __builtin_amdgcn_ds_read_tr4_b64_v2i32((LAS v2i*)(wl + a)); r2[t] = __builtin_amdgcn_ds_read_tr4_b64_v2i32((LAS v2i*)(wl + a + 2048)); } \
            if ((t0_) == 8) { asm volatile("s_waitcnt lgkmcnt(0)" ::: "memory");     \
                if (cq < 3) { P2_DMA(128u * (unsigned)(cq + 1)); if (cq == 2 && more) P2_ROFF(rn); } else if (more) P2_DMA(0u); } \
            _Pragma("unroll") for (int t = 0; t < 8; ++t) { \
                const v8i Bv = (v8i){r1[t].x, r1[t].y, r2[t].x, r2[t].y, 0, 0, 0, 0}; \
                const f32x4 d = __builtin_amdgcn_mfma_scale_f32_16x16x128_f8f6f4(A, Bv, (f32x4){0.f, 0.f, 0.f, 0.f}, 4, 4, 0, 0, 0, 0); \
                const float fv = (d[0] + 0.25f * d[1] + 0.0625f * d[2] + 0.015625f * d[3]) * isc; \
                if (kb == 0) fstage[16 * ((t0_) + t) + c] = fv; } } while (0)
            P2_TILES(0); P2_TILES(8);
#undef P2_TILES
            LDS_FENCE();
            const f32x4 fq = *(LAS const f32x4*)(fstage + 4 * lane);
            if (cq == 0) { f[0] = fq[0]; f[1] = fq[1]; f[2] = fq[2]; f[3] = fq[3]; } else if (cq == 1) { f[4] = fq[0]; f[5] = fq[1]; f[6] = fq[2]; f[7] = fq[3]; }
            else if (cq == 2) { f[8] = fq[0]; f[9] = fq[1]; f[10] = fq[2]; f[11] = fq[3]; } else { f[12] = fq[0]; f[13] = fq[1]; f[14] = fq[2]; f[15] = fq[3]; }
        }
        }
        float v[16]; float s = 0.f;
#pragma unroll
        for (int q = 0; q < 4; ++q) { const int cc = 256 * q + 4 * lane; const f32x4 x1 = *(const f32x4*)(xr + cc), g2 = *(const f32x4*)(mr + 5120 + cc);
#pragma unroll
            for (int i = 0; i < 4; ++i) { v[4 * q + i] = DN_ALPHA * x1[i] + g2[i] * f[4 * q + i]; s += v[4 * q + i]; } }
        const float mean = wave_sum(s) * (1.f / D); float s2 = 0.f;
#pragma unroll
        for (int i = 0; i < 16; ++i) { v[i] -= mean; s2 += v[i] * v[i]; }
        const float rstd = 1.f / sqrtf(wave_sum(s2) * (1.f / D) + LN_EPS);
#pragma unroll
        for (int q = 0; q < 4; ++q) { const int cc = 256 * q + 4 * lane; const f32x4 w = *(const f32x4*)(lnw + cc), bb2 = *(const f32x4*)(lnb + cc); f32x4 o;
#pragma unroll
            for (int i = 0; i < 4; ++i) o[i] = v[4 * q + i] * rstd * w[i] + bb2[i];
            if (!dry) *(f32x4*)(xr + cc) = o; }
    }
#undef P2_DMA
#undef P2_ROFF
}

__device__ __forceinline__ bf16* od_row_base(unsigned char* ws, int dir, int b) {
    if (dir == 0) return (bf16*)(ws + WS_ST) + (size_t)b * SEQ * 1024;
    return b < 7 ? (bf16*)(ws + WS_ST + 64 * MiB) + (size_t)b * SEQ * 1024 : (bf16*)(ws + WS_XC);
}
__device__ __forceinline__ void gla_fused_scan(const bf16* P, const bf16* QKR, unsigned char* ws, LAS unsigned char* lds, int vcu, int G, int wave, int lane, int tid, int dry) {
    const float* ET = (const float*)(ws + WS_ET);
    LAS bf16* Qt = (LAS bf16*)lds;
    LAS bf16* Kt = (LAS bf16*)(lds + 34816);
    LAS bf16* Vt = (LAS bf16*)(lds + 69632);
    LAS bf16* SL = (LAS bf16*)(lds + 88064);
    LAS bf16* Pw = (LAS bf16*)(lds + 122880 + wave * 2304);
    const int g = lane >> 4, c16 = lane & 15, mt = wave & 3, cw = wave >> 2;
    for (int item = vcu; item < 256; item += G) {
        const int dir = item >> 7, b = (item >> 4) & 7, h = (item >> 2) & 3, eb = item & 3;
        const bf16* qsrc = dir == 0 ? P + h * 128 : QKR + h * 128; const int qld = dir == 0 ? N_C : 1024;
        const bf16* vsrc = P + 1024 + h * 256 + 64 * eb;
        const float* etp = ET + ((size_t)((dir * 8 + b) * 4 + h) * NCH) * 128 + 16 * wave + c16;
        bf16* odb = od_row_base(ws, dir, b) + h * 256 + 64 * eb;
        f32x4 acc[4];
#pragma unroll
        for (int et = 0; et < 4; ++et) acc[et] = (f32x4){0.f, 0.f, 0.f, 0.f};
        v4u qreg[2][2], kreg[2][2], vreg[2]; float etn[2];
#define GLA_JOF(sc_) (dir == 0 ? (sc_) : ((sc_) < 4 ? 3 - (sc_) : 71 - (sc_)))
#define GLA_PREFETCH(sc0_) do { _Pragma("unroll") for (int u = 0; u < 2; ++u) { const int jj = GLA_JOF((sc0_) + u); const int row0 = b * PB + jj * 64; \
            _Pragma("unroll") for (int i = 0; i < 2; ++i) { const int cidx = tid + 512 * i, rr = cidx >> 4, ch = cidx & 15; const bf16* sp = qsrc + (size_t)(row0 + rr) * qld + ch * 8; qreg[u][i] = *(const v4u*)sp; kreg[u][i] = *(const v4u*)(sp + 512); } \
            vreg[u] = *(const v4u*)(vsrc + (size_t)(row0 + (tid >> 3)) * N_C + (tid & 7) * 8); etn[u] = etp[(size_t)jj * 128]; } } while (0)
        GLA_PREFETCH(0);
        unsigned opk[8]; int ojc = -1;
#pragma unroll
        for (int i = 0; i < 8; ++i) opk[i] = 0u;
        for (int sc = 0; sc < NCH; sc += 2) {
            const int ja = GLA_JOF(sc), jb = GLA_JOF(sc + 1);
            __syncthreads();
            if (ojc >= 4 && !dry) {
#pragma unroll
                for (int nt = 0; nt < 4; ++nt) { bf16* orow = odb + (size_t)((ojc - 4) * 64 + 16 * mt + 4 * g) * 1024 + 16 * nt + c16;
#pragma unroll
                    for (int r = 0; r < 4; ++r) orow[(size_t)r * 1024] = (bf16)((opk[2 * nt + (r >> 1)] >> (16 * (r & 1))) & 0xffffu); } }
#pragma unroll
            for (int u = 0; u < 2; ++u) {
#pragma unroll
                for (int i = 0; i < 2; ++i) { const int cidx = tid + 512 * i, rr = cidx >> 4, ch = cidx & 15; *(LAS v4u*)(Qt + u * 8704 + rr * 136 + ch * 8) = qreg[u][i]; *(LAS v4u*)(Kt + u * 8704 + rr * 136 + ch * 8) = kreg[u][i]; }
                *(LAS v4u*)(Vt + u * 4608 + (tid >> 3) * 72 + (tid & 7) * 8) = vreg[u]; }
#pragma unroll
            for (int et = 0; et < 4; ++et)
#pragma unroll
                for (int r = 0; r < 4; ++r) SL[(16 * et + 4 * g + r) * 136 + 16 * wave + c16] = (bf16)f2bf(acc[et][r]);
            const float et_a = etn[0], et_b = etn[1];
            if (sc + 2 < NCH) GLA_PREFETCH(sc + 2);
            __syncthreads();
#pragma unroll
            for (int ks = 0; ks < 2; ++ks) { const bf16x8 kb = frag_tr(Kt, 136, 32 * ks, 16 * wave, lane);
#pragma unroll
                for (int et = 0; et < 4; ++et) acc[et] = mma(frag_tr(Vt, 72, 32 * ks, 16 * et, lane), kb, acc[et]); }
#pragma unroll
            for (int et = 0; et < 4; ++et) { acc[et] = acc[et] * et_a;
#pragma unroll
                for (int r = 0; r < 4; ++r) SL[8704 + (16 * et + 4 * g + r) * 136 + 16 * wave + c16] = (bf16)f2bf(acc[et][r]); }
            __syncthreads();
            const int jc = cw == 0 ? ja : jb;
            ojc = jc;
            if (jc >= 4) {
                const LAS bf16* Qc = Qt + cw * 8704; const LAS bf16* Kc = Kt + cw * 8704; const LAS bf16* Vc = Vt + cw * 4608; const LAS bf16* Sc = SL + cw * 8704;
                bf16x8 qf[4];
#pragma unroll
                for (int ks = 0; ks < 4; ++ks) qf[ks] = frag_row(Qc, 136, 16 * mt, 32 * ks, lane);
                bf16x8 pa[2];
                { f32x4 st[4];
#pragma unroll
                  for (int ns = 0; ns < 4; ++ns) { st[ns] = (f32x4){0.f, 0.f, 0.f, 0.f};
#pragma unroll
                      for (int ks = 0; ks < 4; ++ks) st[ns] = mma(frag_row(Kc, 136, 16 * ns, 32 * ks, lane), qf[ks], st[ns]);
#pragma unroll
                      for (int r = 0; r < 4; ++r) { const int sidx = 16 * ns + 4 * g + r, t = 16 * mt + c16; const bool ok = dir == 0 ? (sidx <= t) : (sidx >= t); st[ns][r] = ok ? st[ns][r] : 0.f; } }
#pragma unroll
                  for (int ks2 = 0; ks2 < 2; ++ks2) { const v4u wv = (v4u){pk2(st[2 * ks2][0], st[2 * ks2][1]), pk2(st[2 * ks2][2], st[2 * ks2][3]), pk2(st[2 * ks2 + 1][0], st[2 * ks2 + 1][1]), pk2(st[2 * ks2 + 1][2], st[2 * ks2 + 1][3])};
                      pa[ks2] = __builtin_bit_cast(bf16x8, wv); } }
#pragma unroll
                for (int nt = 0; nt < 4; ++nt) { f32x4 a = (f32x4){0.f, 0.f, 0.f, 0.f};
#pragma unroll
                    for (int ks = 0; ks < 4; ++ks) a = mma(qf[ks], frag_row(Sc, 136, 16 * nt, 32 * ks, lane), a);
                    a = mma(pa[0], frag_tr_perm(Vc, 72, 0, 16 * nt, lane), a); a = mma(pa[1], frag_tr_perm(Vc, 72, 32, 16 * nt, lane), a);
                    opk[2 * nt] = pk2(a[0], a[1]); opk[2 * nt + 1] = pk2(a[2], a[3]); }
                LDS_FENCE();
            }
#pragma unroll
            for (int ks = 0; ks < 2; ++ks) { const bf16x8 kb = frag_tr(Kt + 8704, 136, 32 * ks, 16 * wave, lane);
#pragma unroll
                for (int et = 0; et < 4; ++et) acc[et] = mma(frag_tr(Vt + 4608, 72, 32 * ks, 16 * et, lane), kb, acc[et]); }
#pragma unroll
            for (int et = 0; et < 4; ++et) acc[et] = acc[et] * et_b;
        }
        if (ojc >= 4 && !dry) {
#pragma unroll
            for (int nt = 0; nt < 4; ++nt) { bf16* orow = odb + (size_t)((ojc - 4) * 64 + 16 * mt + 4 * g) * 1024 + 16 * nt + c16;
#pragma unroll
                for (int r = 0; r < 4; ++r) orow[(size_t)r * 1024] = (bf16)((opk[2 * nt + (r >> 1)] >> (16 * (r & 1))) & 0xffffu); } }
#undef GLA_PREFETCH
#undef GLA_JOF
    }
}
__device__ __forceinline__ void gla_merge(bf16* P, const float* norm_w, unsigned char* ws, int gw, int NGW, int lane, int dry) {
    for (int i = gw; i < NB * SEQ; i += NGW) {
        const int b = i >> 12, lp = i & 4095; const size_t r = (size_t)b * PB + LC + lp;
        const bf16* of = od_row_base(ws, 0, b) + (size_t)lp * 1024 + 16 * lane; const bf16* orv = od_row_base(ws, 1, b) + (size_t)lp * 1024 + 16 * lane;
        bf16* grow = P + r * N_C + 2048 + 16 * lane;
        float x[16], y[16], gg[16];
        unpack8(*(const v4u*)of, x); unpack8(*(const v4u*)(of + 8), x + 8); unpack8(*(const v4u*)orv, y); unpack8(*(const v4u*)(orv + 8), y + 8);
        unpack8(*(const v4u*)grow, gg); unpack8(*(const v4u*)(grow + 8), gg + 8);
        float ss = 0.f;
#pragma unroll
        for (int k = 0; k < 16; ++k) { x[k] += y[k]; ss += x[k] * x[k]; }
        ss = gsum16(ss);
        const float rn = 1.f / sqrtf(ss * (1.f / 256.f) + LN_EPS);
        unsigned ow[8];
#pragma unroll
        for (int k = 0; k < 8; ++k) { const float4 dummy = make_float4(0.f, 0.f, 0.f, 0.f); (void)dummy;
            const float a = x[2 * k] * rn * norm_w[16 * lane + 2 * k] * siluf_(gg[2 * k]), c = x[2 * k + 1] * rn * norm_w[16 * lane + 2 * k + 1] * siluf_(gg[2 * k + 1]); ow[k] = pk2(a, c); }
        if (!dry) { v4u o0, o1; o0.x = ow[0]; o0.y = ow[1]; o0.z = ow[2]; o0.w = ow[3]; o1.x = ow[4]; o1.y = ow[5]; o1.z = ow[6]; o1.w = ow[7]; *(v4u*)grow = o0; *(v4u*)(grow + 8) = o1; }
    }
}

__device__ __forceinline__ void mlstm_fused_scan(const bf16* P, unsigned char* ws, LAS unsigned char* lds, int vcu, int G, int wave, int lane, int tid) {
    const float* BQ = (const float*)(ws + WS_BQ); const float* CQ = (const float*)(ws + WS_CQ); const float* EM = (const float*)(ws + WS_EM); const float* AI = (const float*)(ws + WS_AI);
    const float* AST = (const float*)(ws + WS_AST); const float* CL = (const float*)(ws + WS_CL);
    LAS bf16* Qt = (LAS bf16*)lds;
    LAS bf16* Kt = (LAS bf16*)(lds + 17408);
    LAS bf16* Vt = (LAS bf16*)(lds + 34816);
    LAS bf16* Vw = (LAS bf16*)(lds + 41984);
    LAS bf16* CT = (LAS bf16*)(lds + 49152);
    LAS bf16* Pw = (LAS bf16*)(lds + 62208 + wave * 2304);
    const int g = lane >> 4, c16 = lane & 15, mt = wave & 3, hf = wave >> 2;
    const int vrow = tid < 256 ? (tid >> 2) : ((tid - 256) & 63), vch = tid & 3;
    for (int item = vcu; item < 256; item += G) {
        const int dir = item >> 7, b = (item >> 4) & 7, h = (item >> 2) & 3, eb = item & 3;
        const int chain = dir * 32 + b * 4 + h;
        const bf16* qsrc = P + h * 128; const bf16* vsrc = P + 1024 + h * 128 + 32 * eb;
        bf16* odb = (bf16*)(ws + WS_ST) + (size_t)dir * TT * 512 + h * 128 + 32 * eb;
        f32x4 acc[3];
#pragma unroll
        for (int et = 0; et < 3; ++et) acc[et] = (f32x4){0.f, 0.f, 0.f, 0.f};
        v4u qreg[2], kreg[2], vreg; float bqr, cln, astn, cqn; f32x4 bqn[4], ain, emn;
        { const int j0 = dir == 0 ? 0 : 3; const int row0 = b * PB + j0 * 64; const size_t tb = (size_t)chain * PB + j0 * 64;
#pragma unroll
          for (int i = 0; i < 2; ++i) { const int cidx = tid + 512 * i, rr = cidx >> 4, ch = cidx & 15; const bf16* s = qsrc + (size_t)(row0 + rr) * N_AB + ch * 8; qreg[i] = *(const v4u*)s; kreg[i] = *(const v4u*)(s + 512); }
          vreg = *(const v4u*)(vsrc + (size_t)(row0 + vrow) * N_AB + vch * 8); bqr = BQ[tb + vrow]; cln = CL[chain * NCH + j0]; astn = AST[chain * NCH + j0];
#pragma unroll
          for (int k = 0; k < 4; ++k) bqn[k] = *(const f32x4*)(BQ + tb + 16 * k + 4 * g);
          cqn = CQ[tb + 16 * mt + c16]; ain = *(const f32x4*)(AI + tb + 16 * mt + 4 * g); emn = *(const f32x4*)(EM + tb + 16 * mt + 4 * g); }
        for (int sc = 0; sc < NCH; ++sc) {
            const int j = dir == 0 ? sc : (sc < 4 ? 3 - sc : 71 - sc);
            __syncthreads();
#pragma unroll
            for (int i = 0; i < 2; ++i) { const int cidx = tid + 512 * i, rr = cidx >> 4, ch = cidx & 15; *(LAS v4u*)(Qt + rr * 136 + ch * 8) = qreg[i]; *(LAS v4u*)(Kt + rr * 136 + ch * 8) = kreg[i]; }
            { const float wsv = __expf(bqr - cln);
              if (tid < 256) { const v4u raw = vreg; v4u o;
                  o.x = pk2(bflo(raw.x) * wsv, bfhi(raw.x) * wsv); o.y = pk2(bflo(raw.y) * wsv, bfhi(raw.y) * wsv); o.z = pk2(bflo(raw.z) * wsv, bfhi(raw.z) * wsv); o.w = pk2(bflo(raw.w) * wsv, bfhi(raw.w) * wsv);
                  *(LAS v4u*)(Vt + vrow * 56 + vch * 8) = raw; *(LAS v4u*)(Vw + vrow * 56 + vch * 8) = o;
              } else if (tid < 320) { v4u o; o.x = 0x3f80u; o.y = 0u; o.z = 0u; o.w = 0u; *(LAS v4u*)(Vt + vrow * 56 + 32) = o; o.x = f2bf(wsv); *(LAS v4u*)(Vw + vrow * 56 + 32) = o;
                  o.x = 0u; *(LAS v4u*)(Vt + vrow * 56 + 40) = o; *(LAS v4u*)(Vw + vrow * 56 + 40) = o; } }
#pragma unroll
            for (int et = 0; et < 3; ++et)
#pragma unroll
                for (int r = 0; r < 4; ++r) CT[(16 * et + 4 * g + r) * 136 + 16 * wave + c16] = (bf16)f2bf(acc[et][r]);
            const float ast = astn, cqt = cqn; f32x4 bq[4]; const f32x4 ai = ain, em = emn;
#pragma unroll
            for (int k = 0; k < 4; ++k) bq[k] = bqn[k];
            if (sc + 1 < NCH) { const int sn = sc + 1; const int jn = dir == 0 ? sn : (sn < 4 ? 3 - sn : 71 - sn); const int row0 = b * PB + jn * 64; const size_t tb = (size_t)chain * PB + jn * 64;
#pragma unroll
                for (int i = 0; i < 2; ++i) { const int cidx = tid + 512 * i, rr = cidx >> 4, ch = cidx & 15; const bf16* s = qsrc + (size_t)(row0 + rr) * N_AB + ch * 8; qreg[i] = *(const v4u*)s; kreg[i] = *(const v4u*)(s + 512); }
                vreg = *(const v4u*)(vsrc + (size_t)(row0 + vrow) * N_AB + vch * 8); bqr = BQ[tb + vrow]; cln = CL[chain * NCH + jn]; astn = AST[chain * NCH + jn];
#pragma unroll
                for (int k = 0; k < 4; ++k) bqn[k] = *(const f32x4*)(BQ + tb + 16 * k + 4 * g);
                cqn = CQ[tb + 16 * mt + c16]; ain = *(const f32x4*)(AI + tb + 16 * mt + 4 * g); emn = *(const f32x4*)(EM + tb + 16 * mt + 4 * g); }
            __syncthreads();
            bf16x8 qf[4];
#pragma unroll
            for (int ks = 0; ks < 4; ++ks) qf[ks] = frag_row(Qt, 136, 16 * mt, 32 * ks, lane);
            bf16x8 pa[2];
            { f32x4 st[4];
#pragma unroll
              for (int ns = 0; ns < 4; ++ns) { st[ns] = (f32x4){0.f, 0.f, 0.f, 0.f};
#pragma unroll
                  for (int ks = 0; ks < 4; ++ks) st[ns] = mma(frag_row(Kt, 136, 16 * ns, 32 * ks, lane), qf[ks], st[ns]);
#pragma unroll
                  for (int r = 0; r < 4; ++r) { const int sidx = 16 * ns + 4 * g + r, t = 16 * mt + c16; const bool ok = dir == 0 ? (sidx <= t) : (sidx >= t);
                      st[ns][r] = ok ? st[ns][r] * __expf(bq[ns][r] - cqt) : 0.f; } }
#pragma unroll
              for (int ks2 = 0; ks2 < 2; ++ks2) { const v4u wv = (v4u){pk2(st[2 * ks2][0], st[2 * ks2][1]), pk2(st[2 * ks2][2], st[2 * ks2][3]), pk2(st[2 * ks2 + 1][0], st[2 * ks2 + 1][1]), pk2(st[2 * ks2 + 1][2], st[2 * ks2 + 1][3])};
                  pa[ks2] = __builtin_bit_cast(bf16x8, wv); } }
            f32x4 av, ad;
            { f32x4 a = (f32x4){0.f, 0.f, 0.f, 0.f}, d = (f32x4){0.f, 0.f, 0.f, 0.f};
#pragma unroll
              for (int ks = 0; ks < 4; ++ks) { a = mma(qf[ks], frag_row(CT, 136, 16 * hf, 32 * ks, lane), a); d = mma(qf[ks], frag_row(CT, 136, 32, 32 * ks, lane), d); }
#pragma unroll
              for (int r = 0; r < 4; ++r) { a[r] *= ai[r]; d[r] *= ai[r]; }
#pragma unroll
              for (int ks = 0; ks < 2; ++ks) { a = mma(pa[ks], frag_tr_perm(Vt, 56, 32 * ks, 16 * hf, lane), a); d = mma(pa[ks], frag_tr_perm(Vt, 56, 32 * ks, 32, lane), d); }
              av = a; ad = d; }
            { bf16* orow = odb + (size_t)(b * PB + j * 64 + 16 * mt + 4 * g) * 512 + 16 * hf + c16;
#pragma unroll
              for (int r = 0; r < 4; ++r) { const float den = __shfl(ad[r], lane & 48); orow[(size_t)r * 512] = (bf16)f2bf(av[r] / fmaxf(fabsf(den), em[r])); } }
#pragma unroll
            for (int et = 0; et < 3; ++et) acc[et] = acc[et] * ast;
#pragma unroll
            for (int ks = 0; ks < 2; ++ks) { const bf16x8 kb = frag_tr(Kt, 136, 32 * ks, 16 * wave, lane);
#pragma unroll
                for (int et = 0; et < 3; ++et) acc[et] = mma(frag_tr(Vw, 56, 32 * ks, 16 * et, lane), kb, acc[et]); }
        }
    }
}
__device__ __forceinline__ void mlstm_merge(const bf16* P, bf16* CAT, const float* norm_w, unsigned char* ws, int gw, int NGW, int lane) {
    const bf16* OD = (const bf16*)(ws + WS_ST);
    for (int r = gw; r < TT; r += NGW) {
        float x[8], y[8], og[8];
        unpack8(*(const v4u*)(OD + (size_t)r * 512 + 8 * lane), x); unpack8(*(const v4u*)(OD + (size_t)TT * 512 + (size_t)r * 512 + 8 * lane), y);
        unpack8(*(const v4u*)(P + (size_t)r * N_AB + 1536 + 8 * lane), og);
        float ss = 0.f;
#pragma unroll
        for (int k = 0; k < 8; ++k) { x[k] += y[k]; ss += x[k] * x[k]; }
        ss = gsum16(ss);
        const float rn = 1.f / sqrtf(ss * (1.f / 128.f) + LN_EPS);
        unsigned ow[4];
#pragma unroll
        for (int k = 0; k < 4; ++k) ow[k] = pk2(x[2 * k] * rn * norm_w[8 * lane + 2 * k] * sigmoidf_(og[2 * k]), x[2 * k + 1] * rn * norm_w[8 * lane + 2 * k + 1] * sigmoidf_(og[2 * k + 1]));
        v4u o; o.x = ow[0]; o.y = ow[1]; o.z = ow[2]; o.w = ow[3]; *(v4u*)(CAT + (size_t)r * D + 8 * lane) = o;
    }
}

#ifndef PHMASK
#define PHMASK 0xffffffffu
#endif
#define PH(k) ((PHMASK >> (k)) & 1u)
#ifndef REPMASK
#define REPMASK 0u
#endif
#define REPS(k) (1 + (int)((REPMASK >> (k)) & 1u))
#if REPMASK
#define DRYV(k) ({ int d_ = (rep_ + 1 < REPS(k)) ? 1 : 0; asm volatile("" : "+s"(d_)); d_; })
#else
#define DRYV(k) 0
#endif
#ifndef DBG_LEVEL
#define DBG_LEVEL 3
#endif
typedef const __attribute__((address_space(4))) Args* KArgsP;
__device__ __forceinline__ KArgsP kargs() { KArgsP p = (KArgsP)__builtin_amdgcn_kernarg_segment_ptr(); asm volatile("" : "+s"(p)); return p; }
#define WSP(off) (ws + (off))
__global__ void __launch_bounds__(512, 2) fwd_megakernel(Args A_unused) {
    extern __shared__ __attribute__((aligned(16))) unsigned char lds_raw[];
    LAS unsigned char* lds = (LAS unsigned char*)lds_raw;
    const int tid0 = threadIdx.x;
    const int G = gridDim.x; const int bx = blockIdx.x; const int vcu = (G % 8 == 0) ? (bx % 8) * (G / 8) + bx / 8 : bx;
    const int NGW = G * 8;
    volatile LAS unsigned* MISC = (volatile LAS unsigned*)(lds + MISC_OFF);
    if (tid0 < 16) MISC[tid0] = 0u;
    __syncthreads();
    XcdBarrier bar;
    { KArgsP ap = kargs(); bar = xcd_barrier_post((unsigned*)(ap->ws + WS_CTL) + 1024, MISC + 8); }
#define GRID_BAR() xcd_barrier(bar)
#define PROLOG KArgsP ap = kargs(); unsigned char* ws = ap->ws; (void)ws; int tid = tid0; asm volatile("" : "+v"(tid)); const int lane = tid & 63, wave = __builtin_amdgcn_readfirstlane(tid >> 6), gw = vcu * 8 + wave; (void)lane; (void)wave; (void)gw;

    if (PH(0)) for (int rep_ = 0; rep_ < REPS(0); ++rep_) { int tid = tid0; asm volatile("" : "+v"(tid)); const int lane = tid & 63, wave = __builtin_amdgcn_readfirstlane(tid >> 6); Args A; { KArgsP ap = kargs();
#pragma unroll
        for (int i = 0; i < 22; ++i) A.in[i] = ap->in[i];
        A.out = ap->out; A.ws = ap->ws; }
        p0_prologue(A, lds, vcu, G, wave, lane, tid); }
    GRID_BAR();

    if (PH(1)) for (int rep_ = 0; rep_ < REPS(1); ++rep_) { PROLOG h_phase<16>(ap->in[I_X], ap->in[I_CTX], (const float*)WSP(WS_MOD), (bf16*)WSP(WS_HB), (const float*)WSP(WS_WG), (float*)WSP(WS_GL), lds, vcu, G, wave, lane, tid); }
    GRID_BAR();
    if (PH(2)) for (int rep_ = 0; rep_ < REPS(2); ++rep_) { PROLOG pg8::Gemm g{(const bf16*)WSP(WS_HB), (const bf16*)WSP(WS_WAB), TT, N_AB, 1024, 1024, 1024}; pg8::StaticOrder S; S.init(TT, N_AB, G, bx);
      pg8::EpiBf16 E{(bf16*)WSP(WS_P), N_AB}; pg8::gemm_phase<pg8::EpiBf16, pg8::StaticOrder>(lds, g, S, E, tid); }
    GRID_BAR();
#if DBG_LEVEL >= 2
    if (PH(3)) for (int rep_ = 0; rep_ < REPS(3); ++rep_) { PROLOG mlstm_gate_scan((const float*)WSP(WS_GL), ap->in[I_ABGB], ws, gw, NGW, lane); }
    if (PH(4)) for (int rep_ = 0; rep_ < REPS(4); ++rep_) { PROLOG attn_phase((const bf16*)WSP(WS_P), (bf16*)WSP(WS_HB), ap->in[I_ABSINK], (const float*)WSP(WS_ROPE), lds, (unsigned*)WSP(WS_CTL) + 6144 + 64 * rep_, vcu, G, wave, lane, tid); }
    GRID_BAR();
    if (PH(5)) for (int rep_ = 0; rep_ < REPS(5); ++rep_) { PROLOG mlstm_fused_scan((const bf16*)WSP(WS_P), ws, lds, vcu, G, wave, lane, tid); }
    GRID_BAR();
    if (PH(6)) for (int rep_ = 0; rep_ < REPS(6); ++rep_) { PROLOG mlstm_merge((const bf16*)WSP(WS_P), (bf16*)WSP(WS_HB), ap->in[I_ABNW], ws, gw, NGW, lane); }
    GRID_BAR();
#endif
    if (PH(7)) for (int rep_ = 0; rep_ < REPS(7); ++rep_) { PROLOG pg8::Gemm g{(const bf16*)WSP(WS_HB), (const bf16*)WSP(WS_WABO), TT, 1024, 1024, 1024, 1024}; pg8::StaticOrder S; S.init(TT, 1024, G, bx);
      pg8::EpiBf16 E{(bf16*)WSP(WS_P), 1024}; pg8::gemm_phase<pg8::EpiBf16, pg8::StaticOrder>(lds, g, S, E, tid); }
    GRID_BAR();
    if (PH(8)) for (int rep_ = 0; rep_ < REPS(8); ++rep_) { PROLOG ln_phase(ap->in[I_X], ap->in[I_CTX], ap->out, (float*)WSP(WS_XC), (const bf16*)WSP(WS_P), (const float*)WSP(WS_MOD), ap->in[I_LNW], ap->in[I_LNB], (bf16*)WSP(WS_HB), gw, NGW, lane, DRYV(8), false); }
    GRID_BAR();
#if DBG_LEVEL >= 3
    if (PH(9)) for (int rep_ = 0; rep_ < REPS(9); ++rep_) { PROLOG pg8::Gemm g{(const bf16*)WSP(WS_HB), (const bf16*)WSP(WS_WQ0), TT, 2048, 1024, 1024, 1024}; pg8::StaticOrder S; S.init(TT, 2048, G, bx);
      pg8::EpiBf16 E{(bf16*)WSP(WS_P), 2048}; pg8::gemm_phase<pg8::EpiBf16, pg8::StaticOrder>(lds, g, S, E, tid); }
    GRID_BAR();
    if (PH(10)) for (int rep_ = 0; rep_ < REPS(10); ++rep_) { PROLOG peer_route((const bf16*)WSP(WS_P), (const bf16*)WSP(WS_KEYS), (int*)WSP(WS_ST), (float*)WSP(WS_ST + 17 * MiB), gw, NGW, lane, false); }
    GRID_BAR();
#endif
    if (PH(11)) for (int rep_ = 0; rep_ < REPS(22); ++rep_) { PROLOG peer_pass1((const bf16*)WSP(WS_HB), (const int*)WSP(WS_ST), (const float*)WSP(WS_ST + 17 * MiB), WSP(WS_U), (const float*)WSP(WS_SCL), (const float*)WSP(WS_SCL) + 2 * NEXP, (float*)WSP(WS_ST + 34 * MiB), lds, wave, gw, NGW, lane, false); }
    if (PH(11)) for (int rep_ = 0; rep_ < REPS(11); ++rep_) { PROLOG peer_expert<(DBG_LEVEL >= 3)>((const float*)WSP(WS_ST + 34 * MiB), (const int*)WSP(WS_ST), WSP(WS_V),
        ap->out, (float*)WSP(WS_XC), (const float*)WSP(WS_MOD), ap->in[I_LNW] + 1024, ap->in[I_LNB] + 1024, lds, wave, gw, NGW, lane, DRYV(11), false); }
    GRID_BAR();

    if (PH(12)) for (int rep_ = 0; rep_ < REPS(12); ++rep_) { PROLOG h_phase<32>(ap->out, (const float*)WSP(WS_XC), (const float*)WSP(WS_MOD) + 9 * 6144, (bf16*)WSP(WS_HB), (const float*)WSP(WS_WLOW), (float*)WSP(WS_GL), lds, vcu, G, wave, lane, tid);
 }
    GRID_BAR();
    if (PH(13)) for (int rep_ = 0; rep_ < REPS(13); ++rep_) { PROLOG pg8::Gemm g{(const bf16*)WSP(WS_HB), (const bf16*)WSP(WS_WC), TT, N_C, 1024, 1024, 1024}; pg8::StaticOrder S; S.init(TT, N_C, G, bx);
      pg8::EpiBf16 E{(bf16*)WSP(WS_P), N_C}; pg8::gemm_phase<pg8::EpiBf16, pg8::StaticOrder>(lds, g, S, E, tid); }
    GRID_BAR();
#if DBG_LEVEL >= 2
    if (PH(14)) for (int rep_ = 0; rep_ < REPS(14); ++rep_) { PROLOG gla_prep((bf16*)WSP(WS_P), (bf16*)WSP(WS_HB), (const float*)WSP(WS_GL), ap->in[I_GGUP], ap->in[I_GGB], ws, lds, vcu, G, tid, DRYV(14)); }
    GRID_BAR();
    if (PH(15)) for (int rep_ = 0; rep_ < REPS(15); ++rep_) { PROLOG gla_fused_scan((const bf16*)WSP(WS_P), (const bf16*)WSP(WS_HB), ws, lds, vcu, G, wave, lane, tid, DRYV(15)); }
    GRID_BAR();
    if (PH(16)) for (int rep_ = 0; rep_ < REPS(16); ++rep_) { PROLOG gla_merge((bf16*)WSP(WS_P), ap->in[I_GNW], ws, gw, NGW, lane, DRYV(16)); }
    GRID_BAR();
#endif
    if (PH(17)) for (int rep_ = 0; rep_ < REPS(17); ++rep_) { PROLOG pg8::Gemm g{(const bf16*)WSP(WS_P) + 2048, (const bf16*)WSP(WS_WCO), TT, 1024, 1024, N_C, 1024}; pg8::LatOrder S; S.init(NB * SEQ, 1024, G, bx);
      pg8::EpiBf16 E{(bf16*)WSP(WS_HB), 1024}; pg8::gemm_phase<pg8::EpiBf16, pg8::LatOrder>(lds, g, S, E, tid); }
    GRID_BAR();
    if (PH(18)) for (int rep_ = 0; rep_ < REPS(18); ++rep_) { PROLOG ln_phase(ap->out, (const float*)WSP(WS_XC), ap->out, (float*)WSP(WS_XC), (const bf16*)WSP(WS_HB), (const float*)WSP(WS_MOD) + 9 * 6144, ap->in[I_LNW] + 2048, ap->in[I_LNB] + 2048, (bf16*)WSP(WS_HB), gw, NGW, lane, DRYV(18), true); }
    GRID_BAR();
#if DBG_LEVEL >= 3
    if (PH(19)) for (int rep_ = 0; rep_ < REPS(19); ++rep_) { PROLOG pg8::Gemm g{(const bf16*)WSP(WS_HB), (const bf16*)WSP(WS_WQ1), TT, 2048, 1024, 1024, 1024}; pg8::LatOrder S; S.init(NB * SEQ, 2048, G, bx);
      pg8::EpiBf16 E{(bf16*)WSP(WS_P), 2048}; pg8::gemm_phase<pg8::EpiBf16, pg8::LatOrder>(lds, g, S, E, tid); }
    GRID_BAR();
    if (PH(20)) for (int rep_ = 0; rep_ < REPS(20); ++rep_) { PROLOG peer_route((const bf16*)WSP(WS_P), (const bf16*)WSP(WS_KEYS) + (size_t)8 * 2 * 128 * 128, (int*)WSP(WS_ST), (float*)WSP(WS_ST + 17 * MiB), gw, NGW, lane, true); }
    GRID_BAR();
#endif
    if (PH(21)) for (int rep_ = 0; rep_ < REPS(22); ++rep_) { PROLOG peer_pass1((const bf16*)WSP(WS_HB), (const int*)WSP(WS_ST), (const float*)WSP(WS_ST + 17 * MiB), WSP(WS_U) + (size_t)NEXP * 512, (const float*)WSP(WS_SCL) + NEXP, (const float*)WSP(WS_SCL) + 3 * NEXP, (float*)WSP(WS_ST + 34 * MiB), lds, wave, gw, NGW, lane, true); }
    if (PH(21)) for (int rep_ = 0; rep_ < REPS(21); ++rep_) { PROLOG peer_expert<(DBG_LEVEL >= 3)>((const float*)WSP(WS_ST + 34 * MiB), (const int*)WSP(WS_ST), WSP(WS_V) + (size_t)NEXP * 512,
        ap->out, (float*)WSP(WS_XC), (const float*)WSP(WS_MOD) + 9 * 6144, ap->in[I_LNW] + 3072, ap->in[I_LNB] + 3072, lds, wave, gw, NGW, lane, DRYV(21), true); }
}

extern "C" void kernel_launch(void* const* d_in, const int* in_sizes, int n_in, void* d_out, int out_size, void* d_ws, size_t ws_size, hipStream_t stream) {
    static int grid = 0;
    if (grid == 0) {
        if (n_in != 22 || out_size != NB * SEQ * D || ws_size < 512 * MiB) { fprintf(stderr, "kernel_launch: unexpected shapes: n_in %d out %d ws %zu (need %zu)\n", n_in, out_size, ws_size, (size_t)WS_END); grid = -1; return; }
        int dev = 0, cus = 0, per_cu = 0;
        if (hipGetDevice(&dev) != hipSuccess || hipDeviceGetAttribute(&cus, hipDeviceAttributeMultiprocessorCount, dev) != hipSuccess) { grid = -1; return; }
        if (hipFuncSetAttribute((const void*)fwd_megakernel, hipFuncAttributeMaxDynamicSharedMemorySize, LDS_BYTES) != hipSuccess) { fprintf(stderr, "kernel_launch: hipFuncSetAttribute failed\n"); grid = -1; return; }
        if (hipOccupancyMaxActiveBlocksPerMultiprocessor(&per_cu, (const void*)fwd_megakernel, 512, LDS_BYTES) != hipSuccess || per_cu < 1) { fprintf(stderr, "kernel_launch: occupancy query says %d blocks per CU\n", per_cu); }
        (void)hipGetLastError();
        grid = cus;
        fprintf(stderr, "kernel_launch: grid %d, per_cu %d, ws %zu\n", grid, per_cu, ws_size);
    }
    if (grid < 0) return;
    if (hipMemsetAsync((char*)d_ws + WS_CTL, 0, CTL_ZERO_BYTES, stream) != hipSuccess) return;
    Args a{};
    for (int i = 0; i < 22; ++i) a.in[i] = (const float*)d_in[i];
    a.out = (float*)d_out; a.ws = (unsigned char*)d_ws;
    hipLaunchKernelGGL(fwd_megakernel, dim3(grid), dim3(512), LDS_BYTES, stream, a);
}
```

```cpp
#include <hip/hip_runtime.h>
#include <cstdio>
#include <cstdint>

#define GAS __attribute__((address_space(1)))
#define LAS __attribute__((address_space(3)))
typedef unsigned short bf16;
typedef unsigned v4u __attribute__((ext_vector_type(4)));
typedef unsigned v2u __attribute__((ext_vector_type(2)));
typedef float f32x4 __attribute__((ext_vector_type(4)));
typedef float f32x2 __attribute__((ext_vector_type(2)));
typedef short bf16x8 __attribute__((ext_vector_type(8)));
typedef short s16x4 __attribute__((ext_vector_type(4)));
typedef GAS unsigned gu32;
#define RLX_AGENT __ATOMIC_RELAXED, __HIP_MEMORY_SCOPE_AGENT

constexpr int NB = 8, SEQ = 4096, LC = 256, D = 1024;
constexpr int PB = LC + SEQ;
constexpr int TT = NB * PB;
constexpr int NCH = PB / 64;
constexpr int N_AB = 2816;
constexpr int N_C = 3072;
constexpr float LN_EPS = 1e-5f;
constexpr float DN_ALPHA = 1.41421356237f;
constexpr int NEXP = 16384;
__device__ __forceinline__ int map_row(int i, bool lat_only) { return lat_only ? (i >> 12) * 4352 + 256 + (i & 4095) : i; }

constexpr size_t MiB = 1u << 20;
constexpr size_t WS_CTL = 0, CTL_ZERO_BYTES = 64 * 1024;
constexpr size_t WS_MOD = 1 * MiB;
constexpr size_t WS_ROPE = 2 * MiB;
constexpr size_t WS_WG = 2 * MiB + 64 * 1024;
constexpr size_t WS_WLOW = 2 * MiB + 128 * 1024;
constexpr size_t WS_SCL = 3 * MiB;
constexpr size_t WS_BQ = 4 * MiB, WS_CQ = WS_BQ + 1200 * 1024, WS_EM = WS_CQ + 1200 * 1024, WS_AI = WS_EM + 1200 * 1024;
constexpr size_t WS_AST = WS_AI + 1200 * 1024, WS_CL = WS_AST + 32 * 1024;
constexpr size_t WS_ET = 10 * MiB;
constexpr size_t WS_GL = 13 * MiB;
constexpr size_t WS_WAB = 20 * MiB, WS_WABO = 26 * MiB, WS_WC = 28 * MiB, WS_WCO = 34 * MiB, WS_WQ0 = 36 * MiB, WS_WQ1 = 40 * MiB, WS_KEYS = 44 * MiB;
constexpr size_t WS_NST = 45 * MiB;
constexpr size_t WS_XC = 48 * MiB;
constexpr size_t WS_U = 56 * MiB, WS_V = 88 * MiB;
constexpr size_t WS_HB = 120 * MiB;
constexpr size_t WS_P = 188 * MiB;
constexpr size_t WS_ST = 392 * MiB;
constexpr size_t WS_END = 460 * MiB;

constexpr int LDS_BYTES = 163840;
constexpr int MISC_OFF = LDS_BYTES - 64;

__device__ __forceinline__ unsigned f2bf(float f) { unsigned u = __builtin_bit_cast(unsigned, f); return (u + 0x7fffu + ((u >> 16) & 1u)) >> 16; }
__device__ __forceinline__ unsigned pk2(float lo, float hi) { return f2bf(lo) | (f2bf(hi) << 16); }
__device__ __forceinline__ float bflo(unsigned w) { return __builtin_bit_cast(float, w << 16); }
__device__ __forceinline__ float bfhi(unsigned w) { return __builtin_bit_cast(float, w & 0xffff0000u); }
__device__ __forceinline__ float bf2f(bf16 b) { return __builtin_bit_cast(float, (unsigned)b << 16); }
template <int CTRL> __device__ __forceinline__ float dppmov_f(float x) { return __builtin_bit_cast(float, __builtin_amdgcn_mov_dpp(__builtin_bit_cast(int, x), CTRL, 0xf, 0xf, true)); }
__device__ __forceinline__ float wave_sum(float v) {
    v += dppmov_f<0xB1>(v); v += dppmov_f<0x4E>(v); v += dppmov_f<0x141>(v); v += dppmov_f<0x128>(v);
    v += __shfl_xor(v, 16); v += __shfl_xor(v, 32);
    return v;
}
__device__ __forceinline__ float sigmoidf_(float x) { return 1.f / (1.f + __expf(-x)); }
__device__ __forceinline__ float logsigmoidf_(float x) { return fminf(x, 0.f) - log1pf(__expf(-fabsf(x))); }
__device__ __forceinline__ float siluf_(float x) { return x / (1.f + __expf(-x)); }

namespace pg8 {
#define PG8_LAS __attribute__((address_space(3)))
typedef unsigned short bf16_t;
typedef short bf16x8 __attribute__((ext_vector_type(8)));
typedef float f32x4 __attribute__((ext_vector_type(4)));
typedef unsigned u32x4 __attribute__((ext_vector_type(4)));
constexpr int BM = 256, BK = 64, HALF = 128, HTB = HALF * BK * 2  , STAGE_BYTES = 8 * HTB, NXCD = 8, WGM = 8;

__host__ __device__ __forceinline__ int lds_byte(int r, int c) { const int st = (r >> 4) * 2 + (c >> 5), rr = r & 15, cc = c & 31, ob = rr * 64 + cc * 2; return st * 1024 + (ob ^ (((ob >> 9) & 1) << 5)); }
__host__ __device__ __forceinline__ void stage_rc(int b, int& R, int& C) { const int st = b / 1024, sb = b % 1024, swz = sb ^ (((sb >> 9) & 1) << 5); R = (st >> 1) * 16 + swz / 64; C = (st & 1) * 32 + (swz % 64) / 2; }
__host__ __device__ __forceinline__ int perm32(int rho) { const int n = rho >> 4, i = rho & 15; return 8 * (i >> 2) + 4 * n + (i & 3); }

struct Unit { int pm, pn; };
struct Gemm { const bf16_t* A; const bf16_t* Bt; int M, N, K, lda, ldb; };

struct StaticOrder {
    int nM, nN, nwg, G, c;
    __host__ __device__ void init(int M, int N, int G_, int c_) { nM = M / BM; nN = N / BM; nwg = nM * nN; G = G_; c = c_; }
    __host__ __device__ bool next(int i, Unit& u) const {
        const long L = (long)i * G + c; if (L >= nwg) return false;
        int wgid = (int)L; { const int q = nwg / NXCD, r = nwg % NXCD, xcd = wgid % NXCD, off = wgid / NXCD; wgid = (xcd < r ? xcd * (q + 1) : r * (q + 1) + (xcd - r) * q) + off; }
        const int nig = WGM * nN, gid = wgid / nig, fm = gid * WGM, gsz = (nM - fm) < WGM ? (nM - fm) : WGM;
        u.pm = fm + ((wgid % nig) % gsz); u.pn = (wgid % nig) / gsz; return true;
    }
    __device__ __forceinline__ void a_ready(const Unit&) const {}
    __device__ __forceinline__ void done(const Unit&) const {}
};

struct LatOrder : StaticOrder {
    __host__ __device__ bool next(int i, Unit& u) const { if (!StaticOrder::next(i, u)) return false; u.pm = (u.pm >> 4) * 17 + 1 + (u.pm & 15); return true; }
};
__device__ __forceinline__ unsigned cvt_pk_bf16(float lo, float hi) { unsigned r; asm volatile("v_cvt_pk_bf16_f32 %0, %1, %2" : "=v"(r) : "v"(lo), "v"(hi)); return r; }
struct EpiBf16 {
    static constexpr bool PERM = true, AFTER_DRAIN = false;
    bf16_t* O; int ldc;
    __device__ __forceinline__ void operator()(const f32x4 (&acc)[2][2][4][2], const Unit& u, int wr, int wc, int fr, int fq) const {
        const int row0 = u.pm * BM + wr * 64 + fr; const int col0 = u.pn * BM + wc * 32 + 8 * fq;
#pragma unroll
        for (int ai = 0; ai < 2; ++ai)
#pragma unroll
            for (int m = 0; m < 4; ++m) { bf16_t* rowp = O + (size_t)(row0 + ai * HALF + m * 16) * ldc + col0;
#pragma unroll
                for (int bj = 0; bj < 2; ++bj) { const f32x4 v0 = acc[ai][bj][m][0], v1 = acc[ai][bj][m][1];
                    u32x4 w; w.x = cvt_pk_bf16(v0[0], v0[1]); w.y = cvt_pk_bf16(v0[2], v0[3]); w.z = cvt_pk_bf16(v1[0], v1[1]); w.w = cvt_pk_bf16(v1[2], v1[3]);
                    *(u32x4*)(rowp + bj * HALF) = w; } }
    }
};
struct EpiResid {
    static constexpr bool PERM = false, AFTER_DRAIN = false;
    const float* src_lat; const float* src_ctx; float* dst_lat; float* dst_ctx; const float* gate; float gscale; int dry;
    __device__ __forceinline__ void operator()(const f32x4 (&acc)[2][2][4][2], const Unit& u, int wr, int wc, int fr, int fq) const {
        const int b = u.pm / 17, tb = u.pm - b * 17;
        const float* sbase; float* dbase; const float* gr;
        if (tb == 0) { sbase = src_ctx + (size_t)b * 256 * 1024; dbase = dst_ctx + (size_t)b * 256 * 1024; gr = gate + 8 * 6144; }
        else { sbase = src_lat + ((size_t)b * 4096 + (size_t)(tb - 1) * 256) * 1024; dbase = dst_lat + ((size_t)b * 4096 + (size_t)(tb - 1) * 256) * 1024; gr = gate + b * 6144; }
        const int row0 = wr * 64 + fr, col0 = u.pn * BM + wc * 32 + 4 * fq;
        f32x4 gv[2][2];
#pragma unroll
        for (int bj = 0; bj < 2; ++bj)
#pragma unroll
            for (int n = 0; n < 2; ++n) gv[bj][n] = *(const f32x4*)(gr + col0 + bj * HALF + n * 16) * gscale;
#pragma unroll
        for (int ai = 0; ai < 2; ++ai)
#pragma unroll
            for (int mp = 0; mp < 2; ++mp) {
                f32x4 sv[2][2][2];
#pragma unroll
                for (int mm = 0; mm < 2; ++mm) { const size_t off = (size_t)(row0 + ai * HALF + (2 * mp + mm) * 16) * 1024 + col0;
#pragma unroll
                    for (int bj = 0; bj < 2; ++bj)
#pragma unroll
                        for (int n = 0; n < 2; ++n) sv[mm][bj][n] = __builtin_nontemporal_load((const f32x4*)(sbase + off + bj * HALF + n * 16)); }
                asm volatile("" ::: "memory");
#pragma unroll
                for (int mm = 0; mm < 2; ++mm) { const int m = 2 * mp + mm; const size_t off = (size_t)(row0 + ai * HALF + m * 16) * 1024 + col0;
#pragma unroll
                    for (int bj = 0; bj < 2; ++bj)
#pragma unroll
                        for (int n = 0; n < 2; ++n) { const f32x4 ov = sv[mm][bj][n] * 1.41421356237f + gv[bj][n] * acc[ai][bj][m][n]; if (!dry) *(f32x4*)(dbase + off + bj * HALF + n * 16) = ov; } }
                asm volatile("" ::: "memory");
            }
    }
};

template <class Epi, class Sched>
__device__ __forceinline__ void gemm_phase(PG8_LAS unsigned char* lds, const Gemm g, const Sched& S, const Epi& E, const int tid_in) {
    const int tid = tid_in, wid = __builtin_amdgcn_readfirstlane(tid >> 6), lane = tid & 63, wr = wid >> 2, wc = wid & 3, fr = lane & 15, fq = lane >> 4;
    const int K = g.K, nt = K / BK;
    unsigned voffA[2], voffB[2];
#pragma unroll
    for (int i = 0; i < 2; ++i) { int R, C; stage_rc(tid * 16 + i * 8192, R, C); const int Rb = Epi::PERM ? ((R & ~31) + perm32(R & 31)) : R;
        voffA[i] = (unsigned)(R * g.lda + C) * 2u; voffB[i] = (unsigned)(Rb * g.ldb + C) * 2u; }
    const size_t kstep = (size_t)(BK * 2);
    const size_t hstepA = (size_t)HALF * g.lda * 2, hstepB = (size_t)HALF * g.ldb * 2;
    const size_t tstepA = 2 * hstepA, tstepB = 2 * hstepB;
    const unsigned ldsw = (unsigned)wid * 1024u;
    const int aoff = lds_byte(wr * 64 + fr, fq * 8), boff = lds_byte(wc * 32 + fr, fq * 8);
#define PG8_SA(b, h) (((b) * 2 + (h)) * HTB)
#define PG8_SB(b, h) ((4 + (b) * 2 + (h)) * HTB)
#define PG8_STAGE(bufoff, gbase, voff) do { _Pragma("unroll") for (int _i = 0; _i < 2; ++_i) \
        __builtin_amdgcn_global_load_lds((const unsigned*)((const char*)(gbase) + (voff)[_i]), (PG8_LAS unsigned*)(lds + (bufoff) + ldsw + _i * 8192), 16, 0, 0); } while (0)
#define PG8_LDA(dst, b, h) do { _Pragma("unroll") for (int m = 0; m < 4; ++m) _Pragma("unroll") for (int k = 0; k < 2; ++k) dst[m][k] = *(const PG8_LAS bf16x8*)(lds + PG8_SA(b, h) + aoff + m * 2048 + k * 1024); } while (0)
#define PG8_LDB(dst, b, h) do { _Pragma("unroll") for (int n = 0; n < 2; ++n) _Pragma("unroll") for (int k = 0; k < 2; ++k) dst[n][k] = *(const PG8_LAS bf16x8*)(lds + PG8_SB(b, h) + boff + n * 2048 + k * 1024); } while (0)
#define PG8_MMA(ai, bj, At, Bt) do { __builtin_amdgcn_s_setprio(1); _Pragma("unroll") for (int m = 0; m < 4; ++m) _Pragma("unroll") for (int n = 0; n < 2; ++n) _Pragma("unroll") for (int k = 0; k < 2; ++k) \
        acc[ai][bj][m][n] = __builtin_amdgcn_mfma_f32_16x16x32_bf16(Bt[n][k], At[m][k], acc[ai][bj][m][n], 0, 0, 0); __builtin_amdgcn_s_setprio(0); } while (0)
#define PG8_WAIT_V(n) asm volatile("s_waitcnt vmcnt(" #n ")" ::: "memory")
#define PG8_WAIT_L(n) asm volatile("s_waitcnt lgkmcnt(" #n ")" ::: "memory")
#define PG8_BAR __builtin_amdgcn_s_barrier()
#define PG8_SCHED __builtin_amdgcn_sched_barrier(0)
    Unit cur, nxt; int ui = 0;
    if (!S.next(0, cur)) return;
    f32x4 acc[2][2][4][2];
#pragma unroll
    for (int a = 0; a < 2; ++a)
#pragma unroll
        for (int b = 0; b < 2; ++b)
#pragma unroll
            for (int m = 0; m < 4; ++m)
#pragma unroll
                for (int n = 0; n < 2; ++n) acc[a][b][m][n] = (f32x4){0.f, 0.f, 0.f, 0.f};
    bf16x8 At[4][2], B0[2][2], B1[2][2];
    const char* cA = (const char*)g.A + (size_t)cur.pm * tstepA; const char* cB = (const char*)g.Bt + (size_t)cur.pn * tstepB;
    S.a_ready(cur);
    PG8_STAGE(PG8_SB(0, 0), cB, voffB); PG8_STAGE(PG8_SA(0, 0), cA, voffA); PG8_STAGE(PG8_SB(0, 1), cB + hstepB, voffB); PG8_STAGE(PG8_SA(0, 1), cA + hstepA, voffA);
    if (wr == 1) PG8_BAR;
    PG8_WAIT_V(4); PG8_BAR;
    PG8_STAGE(PG8_SB(1, 0), cB + kstep, voffB); PG8_STAGE(PG8_SA(1, 0), cA + kstep, voffA); PG8_STAGE(PG8_SB(1, 1), cB + hstepB + kstep, voffB);
    PG8_WAIT_V(6); PG8_BAR;
    for (;;) {
        const bool has_next = S.next(ui + 1, nxt);
        const char* nA = has_next ? (const char*)g.A + (size_t)nxt.pm * tstepA : cA; const char* nB = has_next ? (const char*)g.Bt + (size_t)nxt.pn * tstepB : cB;
        for (int t = 0; t < nt; t += 2) {
            const bool last = (t == nt - 2);
            const char* a1 = cA + (size_t)(t + 1) * kstep;
            const char* a2 = last ? nA : cA + (size_t)(t + 2) * kstep; const char* b2 = last ? nB : cB + (size_t)(t + 2) * kstep;
            const char* a3 = a2 + kstep; const char* b3 = b2 + kstep;
            if (last && has_next) S.a_ready(nxt);
            PG8_LDB(B0, 0, 0); PG8_SCHED; PG8_LDA(At, 0, 0); PG8_STAGE(PG8_SA(1, 1), a1 + hstepA, voffA);
            PG8_WAIT_L(8); PG8_BAR; PG8_WAIT_L(0); PG8_MMA(0, 0, At, B0); PG8_BAR; PG8_SCHED;
            PG8_LDB(B1, 0, 1); PG8_STAGE(PG8_SB(0, 0), b2, voffB);
            PG8_BAR; PG8_WAIT_L(0); PG8_MMA(0, 1, At, B1); PG8_BAR;
            PG8_LDA(At, 0, 1); PG8_STAGE(PG8_SA(0, 0), a2, voffA);
            PG8_BAR; PG8_WAIT_L(0); PG8_MMA(1, 0, At, B0); PG8_BAR; PG8_SCHED;
            PG8_STAGE(PG8_SB(0, 1), b2 + hstepB, voffB);
            PG8_WAIT_V(6); PG8_BAR; PG8_MMA(1, 1, At, B1); PG8_BAR;
            PG8_LDB(B0, 1, 0); PG8_SCHED; PG8_LDA(At, 1, 0); PG8_STAGE(PG8_SA(0, 1), a2 + hstepA, voffA);
            PG8_WAIT_L(8); PG8_BAR; PG8_WAIT_L(0); PG8_MMA(0, 0, At, B0); PG8_BAR; PG8_SCHED;
            PG8_LDB(B1, 1, 1); PG8_STAGE(PG8_SB(1, 0), b3, voffB);
            PG8_BAR; PG8_WAIT_L(0); PG8_MMA(0, 1, At, B1); PG8_BAR;
            PG8_LDA(At, 1, 1); PG8_STAGE(PG8_SA(1, 0), a3, voffA);
            PG8_BAR; PG8_WAIT_L(0); PG8_MMA(1, 0, At, B0); PG8_BAR; PG8_SCHED;
            PG8_STAGE(PG8_SB(1, 1), b3 + hstepB, voffB);
            PG8_WAIT_V(6); PG8_BAR; PG8_MMA(1, 1, At, B1); PG8_BAR;
        }
        if constexpr (!Epi::AFTER_DRAIN) { E(acc, cur, wr, wc, fr, fq); S.done(cur); }
        if (!has_next) break;
#pragma unroll
        for (int a = 0; a < 2; ++a)
#pragma unroll
            for (int b = 0; b < 2; ++b)
#pragma unroll
                for (int m = 0; m < 4; ++m)
#pragma unroll
                    for (int n = 0; n < 2; ++n) acc[a][b][m][n] = (f32x4){0.f, 0.f, 0.f, 0.f};
        cur = nxt; cA = nA; cB = nB; ++ui;
    }
    PG8_WAIT_V(0);
    if (wr == 0) PG8_BAR;
    PG8_BAR;
    if constexpr (Epi::AFTER_DRAIN) { E.fused(acc, cur, wr, wc, fr, fq, lds, wid, lane); S.done(cur); }
#undef PG8_SA
#undef PG8_SB
#undef PG8_STAGE
#undef PG8_LDA
#undef PG8_LDB
#undef PG8_MMA
#undef PG8_WAIT_V
#undef PG8_WAIT_L
#undef PG8_BAR
#undef PG8_SCHED
}
}

#define XB_TMO      128
#define XB_XCNT(j)  (256  + 64 * (j))
#define XB_XSUB(j)  (1280 + 64 * (j))
#define XB_XGEN(j)  (2304 + 64 * (j))
#define XB_TOP      3328
#define XB_TOPGEN   3392
#define XCD_BAR_WORDS 3456
#define XB_SPIN_CAP (1u << 18)

__device__ __forceinline__ unsigned xb_ld(unsigned* p)              { return __hip_atomic_load(p, __ATOMIC_RELAXED, __HIP_MEMORY_SCOPE_AGENT); }
__device__ __forceinline__ unsigned xb_add(unsigned* p, unsigned v) { return __hip_atomic_fetch_add(p, v, __ATOMIC_RELAXED, __HIP_MEMORY_SCOPE_AGENT); }
__device__ __forceinline__ unsigned xb_xcc_id() { return (unsigned)__builtin_amdgcn_s_getreg((3 << 11) | 20) & 0xFu; }
#define XB_SPIN(cond, bar) do { unsigned _sp = 0; while (cond) { __builtin_amdgcn_s_sleep(1); \
    if ((++_sp & 255u) == 0u) { if (xb_ld(&(bar)[XB_TMO])) break; if (_sp > XB_SPIN_CAP) { atomicAdd(&(bar)[XB_TMO], 1u); break; } } } } while (0)

struct XcdBarrier {
    unsigned* bar; unsigned x;
    volatile LAS unsigned* st;
};

__device__ __forceinline__ XcdBarrier xcd_barrier_post(unsigned* bar, volatile LAS unsigned* st) {
    XcdBarrier b; b.bar = bar; b.x = xb_xcc_id(); b.st = st;
    if (threadIdx.x == 0) (void)xb_add(&bar[XB_XCNT(b.x)], 1u);
    return b;
}
__device__ __forceinline__ void xcd_barrier_complete(unsigned* bar, unsigned x, unsigned& nloc, unsigned& nx) {
    const unsigned G = gridDim.x * gridDim.y * gridDim.z;
    unsigned sum, cnt, mine, sp = 0u;
    for (;;) {
        sum = 0u; cnt = 0u; mine = 0u;
#pragma unroll
        for (unsigned j = 0; j < 16; ++j) { const unsigned c = xb_ld(&bar[XB_XCNT(j)]); sum += c; cnt += (c > 0u) ? 1u : 0u; mine = (j == x) ? c : mine; }
        if (sum == G) break;
        __builtin_amdgcn_s_sleep(1);
        if ((++sp & 255u) == 0u) { if (xb_ld(&bar[XB_TMO])) break; if (sp > XB_SPIN_CAP) { atomicAdd(&bar[XB_TMO], 1u); break; } }
    }
    nloc = mine > 0u ? mine : 1u; nx = cnt > 0u ? cnt : 1u;
}

__device__ __forceinline__ void xcd_barrier(const XcdBarrier& b) {
    asm volatile("s_waitcnt vmcnt(0)" ::: "memory");
    __syncthreads();
    if (threadIdx.x == 0) {
        unsigned* bar = b.bar;
        __builtin_amdgcn_s_waitcnt(0);
        unsigned nloc = b.st[0], nx = b.st[1];
        if (nloc == 0u) { xcd_barrier_complete(bar, b.x, nloc, nx); b.st[0] = nloc; b.st[1] = nx; }
        const unsigned old = xb_add(&bar[XB_XSUB(b.x)], 1u);
        const unsigned gen = old / nloc;
        if (old + 1u == (gen + 1u) * nloc) {
            __builtin_amdgcn_fence(__ATOMIC_RELEASE, "agent");
            asm volatile("s_waitcnt vmcnt(0)" ::: "memory");
            const unsigned og = xb_add(&bar[XB_TOP], 1u);
            const unsigned tg = og / nx;
            if (og + 1u == (tg + 1u) * nx) xb_add(&bar[XB_TOPGEN], 1u);
            else XB_SPIN(xb_ld(&bar[XB_TOPGEN]) == tg, bar);
            __builtin_amdgcn_fence(__ATOMIC_ACQUIRE, "agent");
            xb_add(&bar[XB_XGEN(b.x)], 1u);
            asm volatile("s_waitcnt vmcnt(0)" ::: "memory");
        } else {
            XB_SPIN(xb_ld(&bar[XB_XGEN(b.x)]) == gen, bar);
            __builtin_amdgcn_fence(__ATOMIC_ACQUIRE, "agent");
            asm volatile("s_waitcnt vmcnt(0)" ::: "memory");
        }
    }
    __syncthreads();
}


__device__ __forceinline__ f32x4 mma(bf16x8 a, bf16x8 b, f32x4 c) { return __builtin_amdgcn_mfma_f32_16x16x32_bf16(a, b, c, 0, 0, 0); }
__device__ __forceinline__ bf16x8 frag_row(const LAS bf16* t, int ld, int r0, int c0, int lane) {
    return *(const LAS bf16x8*)(t + (r0 + (lane & 15)) * ld + c0 + 8 * (lane >> 4));
}
__device__ __forceinline__ bf16x8 frag_tr(const LAS bf16* t, int ld, int r0, int c0, int lane) {
    const int g = lane >> 4, q = (lane & 15) >> 2, p = lane & 3;
    const LAS bf16* a = t + (r0 + 8 * g + q) * ld + c0 + 4 * p;
    const s16x4 lo = __builtin_amdgcn_ds_read_tr16_b64_v4i16((LAS s16x4*)a);
    const s16x4 hi = __builtin_amdgcn_ds_read_tr16_b64_v4i16((LAS s16x4*)(a + 4 * ld));
    return (bf16x8){lo[0], lo[1], lo[2], lo[3], hi[0], hi[1], hi[2], hi[3]};
}
#define LDS_FENCE() do { asm volatile("s_waitcnt lgkmcnt(0)" ::: "memory"); __builtin_amdgcn_wave_barrier(); } while (0)

struct Args {
    const float* in[22]; float* out; unsigned char* ws;
};
enum { I_X = 0, I_C, I_CTX, I_CCTX, I_WMOD, I_BMOD, I_LNW, I_LNB, I_ABWIN, I_ABGB, I_ABNW, I_ABSINK, I_ABWOUT, I_GWIN, I_GGUP, I_GGB, I_GNW, I_GWOUT, I_PWQ, I_PKEYS, I_PU, I_PV };

__device__ __forceinline__ const float* srow_c(const float* lat, const float* ctx, int r) { const int b = r / PB, p = r - b * PB; return p < LC ? ctx + (size_t)(b * LC + p) * D : lat + (size_t)(b * SEQ + p - LC) * D; }
__device__ __forceinline__ float* srow(float* lat, float* ctx, int r) { const int b = r / PB, p = r - b * PB; return p < LC ? ctx + (size_t)(b * LC + p) * D : lat + (size_t)(b * SEQ + p - LC) * D; }

__device__ __forceinline__ void p0_transpose_item(const float* W, int K, int ldw, int c0, int ncols, bf16* WT, int row_off, LAS float* scr, int item, int lane,
                                                  int s0lo, int s0hi, float s0, int s1lo, int s1hi, float s1) {
    const int nblk = ncols / 32, kb = item / nblk, nb = item % nblk, k0 = 64 * kb, n0 = 32 * nb;
#pragma unroll 8
    for (int i = 0; i < 32; ++i) { const int kk = 2 * i + (lane >> 5); scr[kk * 33 + (lane & 31)] = W[(size_t)(k0 + kk) * ldw + c0 + n0 + (lane & 31)]; }
    asm volatile("s_waitcnt lgkmcnt(0)" ::: "memory");
    const int c = lane & 7;
#pragma unroll
    for (int j = 0; j < 4; ++j) { const int n = (lane >> 3) + 8 * j; const LAS float* s = scr + (8 * c) * 33 + n;
        const int dr = row_off + n0 + n; float sc = 1.f; if (dr >= s0lo && dr < s0hi) sc = s0; if (dr >= s1lo && dr < s1hi) sc = s1;
        v4u o; o.x = pk2(s[0 * 33] * sc, s[1 * 33] * sc); o.y = pk2(s[2 * 33] * sc, s[3 * 33] * sc); o.z = pk2(s[4 * 33] * sc, s[5 * 33] * sc); o.w = pk2(s[6 * 33] * sc, s[7 * 33] * sc);
        *(v4u*)(WT + (size_t)dr * K + k0 + 8 * c) = o; }
    asm volatile("s_waitcnt lgkmcnt(0)" ::: "memory");
}
__device__ __forceinline__ void cvt_f32_bf16(const float* src, bf16* dst, size_t n, int gtid, int gthreads) {
    const size_t nch = n / 8;
    for (size_t i = gtid; i < nch; i += gthreads) { const f32x4 a = *(const f32x4*)(src + i * 8), b = *(const f32x4*)(src + i * 8 + 4);
        v4u o; o.x = pk2(a[0], a[1]); o.y = pk2(a[2], a[3]); o.z = pk2(b[0], b[1]); o.w = pk2(b[2], b[3]); *(v4u*)(dst + i * 8) = o; }
}
__device__ __forceinline__ void cvt_rows_fp4(const float* src, unsigned char* dst, float* inv, int nrows, int gw, int NGW, int lane) {
    const int hl = lane & 31, hh = lane >> 5;
    for (int r2 = gw; r2 < nrows / 2; r2 += NGW) {
        const int r = 2 * r2 + hh; const float* sp = src + (size_t)r * 1024 + 32 * hl;
        f32x4 x[8]; float m = 0.f;
#pragma unroll
        for (int q = 0; q < 8; ++q) { x[q] = *(const f32x4*)(sp + 4 * q); m = fmaxf(m, fmaxf(fmaxf(fabsf(x[q][0]), fabsf(x[q][1])), fmaxf(fabsf(x[q][2]), fabsf(x[q][3])))); }
        m = fmaxf(m, dppmov_f<0xB1>(m)); m = fmaxf(m, dppmov_f<0x4E>(m)); m = fmaxf(m, dppmov_f<0x141>(m)); m = fmaxf(m, dppmov_f<0x128>(m)); m = fmaxf(m, __shfl_xor(m, 16));
        const float sc = m > 0.f ? 6.0f / m : 1.f;
        unsigned w[4];
#pragma unroll
        for (int d = 0; d < 4; ++d) { unsigned t = 0u;
            t = __builtin_amdgcn_cvt_scalef32_pk_fp4_f32(t, x[2 * d][0] * sc, x[2 * d][1] * sc, 1.0f, 0); t = __builtin_amdgcn_cvt_scalef32_pk_fp4_f32(t, x[2 * d][2] * sc, x[2 * d][3] * sc, 1.0f, 1);
            t = __builtin_amdgcn_cvt_scalef32_pk_fp4_f32(t, x[2 * d + 1][0] * sc, x[2 * d + 1][1] * sc, 1.0f, 2); t = __builtin_amdgcn_cvt_scalef32_pk_fp4_f32(t, x[2 * d + 1][2] * sc, x[2 * d + 1][3] * sc, 1.0f, 3);
            w[d] = t; }
        *(v4u*)(dst + (size_t)r * 512 + 16 * hl) = (v4u){w[0], w[1], w[2], w[3]};
        if (hl == 0) inv[r] = m > 0.f ? m / 6.0f : 1.f;
    }
}
__device__ __forceinline__ void p0_prologue(const Args& A, LAS unsigned char* lds, int vcu, int G, int wave, int lane, int tid) {
    unsigned char* ws = A.ws;
    const int gw = vcu * 8 + wave, NGW = G * 8, gtid = vcu * 512 + tid, gthreads = G * 512;
    LAS float* sil = (LAS float*)lds;
    for (int i = tid; i < 9 * 1024; i += 512) { const float v = i < 8192 ? A.in[I_C][i] : A.in[I_CCTX][i - 8192]; sil[i] = siluf_(v); }
    __syncthreads();
    float* MOD = (float*)(ws + WS_MOD);
    LAS float* part = (LAS float*)(lds + 40960);
    for (int it = vcu; it < 2 * 96; it += G) {
        const int l = it / 96, n = (it % 96) * 64 + lane; const float* wm = A.in[I_WMOD] + (size_t)l * 1024 * 6144 + (size_t)(128 * wave) * 6144 + n;
        float acc[9];
#pragma unroll
        for (int r = 0; r < 9; ++r) acc[r] = 0.f;
#pragma unroll 8
        for (int k = 0; k < 128; ++k) { const float w = wm[(size_t)k * 6144];
#pragma unroll
            for (int r = 0; r < 9; ++r) acc[r] += sil[r * 1024 + 128 * wave + k] * w; }
        __syncthreads();
#pragma unroll
        for (int r = 0; r < 9; ++r) part[(wave * 9 + r) * 64 + lane] = acc[r];
        __syncthreads();
        for (int i = tid; i < 9 * 64; i += 512) { float sum = 0.f;
#pragma unroll
            for (int w8 = 0; w8 < 8; ++w8) sum += part[w8 * 576 + i];
            const int r = i >> 6, c = (it % 96) * 64 + (i & 63); MOD[(size_t)(l * 9 + r) * 6144 + c] = sum + A.in[I_BMOD][l * 6144 + c]; }
    }
    __syncthreads();
    LAS float* scr = (LAS float*)(lds + 40960 + wave * 8704);
    constexpr int I_AB1 = 16 * 64, I_AB2 = 16 * 24, I_ABO = 16 * 32, I_C1 = 16 * 96, I_CO = 16 * 32, I_Q = 16 * 64;
    constexpr int NITEMS = I_AB1 + I_AB2 + I_ABO + I_C1 + I_CO + 2 * I_Q;
    const float rs128 = 0.08838834764831845f;
    for (int it = gw; it < NITEMS; it += NGW) {
        int r = it;
        if (r < I_AB1) { p0_transpose_item(A.in[I_ABWIN], 1024, 2832, 0, 2048, (bf16*)(ws + WS_WAB), 0, scr, r, lane, 512, 1024, rs128, 0, 0, 1.f); continue; } r -= I_AB1;
        if (r < I_AB2) { p0_transpose_item(A.in[I_ABWIN], 1024, 2832, 2064, 768, (bf16*)(ws + WS_WAB), 2048, scr, r, lane, 2048, 2560, 0.125f, 0, 0, 1.f); continue; } r -= I_AB2;
        if (r < I_ABO) { p0_transpose_item(A.in[I_ABWOUT], 1024, 1024, 0, 1024, (bf16*)(ws + WS_WABO), 0, scr, r, lane, 0, 0, 1.f, 0, 0, 1.f); continue; } r -= I_ABO;
        if (r < I_C1) { p0_transpose_item(A.in[I_GWIN], 1024, 3104, 0, 3072, (bf16*)(ws + WS_WC), 0, scr, r, lane, 0, 512, rs128, 0, 0, 1.f); continue; } r -= I_C1;
        if (r < I_CO) { p0_transpose_item(A.in[I_GWOUT], 1024, 1024, 0, 1024, (bf16*)(ws + WS_WCO), 0, scr, r, lane, 0, 0, 1.f, 0, 0, 1.f); continue; } r -= I_CO;
        if (r < I_Q) { p0_transpose_item(A.in[I_PWQ], 1024, 2048, 0, 2048, (bf16*)(ws + WS_WQ0), 0, scr, r, lane, 0, 0, 1.f, 0, 0, 1.f); continue; } r -= I_Q;
        p0_transpose_item(A.in[I_PWQ] + (size_t)1024 * 2048, 1024, 2048, 0, 2048, (bf16*)(ws + WS_WQ1), 0, scr, r, lane, 0, 0, 1.f, 0, 0, 1.f);
    }
    for (int i = gtid; i < 16 * 1024; i += gthreads) { const int g = i >> 10, k = i & 1023; ((float*)(ws + WS_WG))[i] = A.in[I_ABWIN][(size_t)k * 2832 + 2048 + g]; }
    for (int i = gtid; i < 32 * 1024; i += gthreads) { const int g = i >> 10, k = i & 1023; ((float*)(ws + WS_WLOW))[i] = A.in[I_GWIN][(size_t)k * 3104 + 3072 + g]; }
    for (int i = gtid; i < 64 * 16; i += gthreads) { const int pos = i >> 4, f = i & 15; const float inv = powf(10000.f, -(float)f / 16.f); const float ang = (float)pos * inv;
        ((float*)(ws + WS_ROPE))[2 * i] = cosf(ang); ((float*)(ws + WS_ROPE))[2 * i + 1] = sinf(ang); }
    cvt_f32_bf16(A.in[I_PKEYS], (bf16*)(ws + WS_KEYS), (size_t)2 * 8 * 2 * 128 * 128, gtid, gthreads);
    cvt_rows_fp4(A.in[I_PU], ws + WS_U, (float*)(ws + WS_SCL), 2 * NEXP, gw, NGW, lane);
    cvt_rows_fp4(A.in[I_PV], ws + WS_V, (float*)(ws + WS_SCL) + 2 * NEXP, 2 * NEXP, gw, NGW, lane);
}

__device__ __forceinline__ void split8(const float* v, bf16x8& hi, bf16x8& lo) {
#pragma unroll
    for (int j = 0; j < 8; ++j) { const unsigned h = f2bf(v[j]); const float hf = __builtin_bit_cast(float, h << 16); hi[j] = (short)h; lo[j] = (short)f2bf(v[j] - hf); }
}
template <int NG>
__device__ __forceinline__ void h_phase(const float* lat, const float* ctx, const float* mod  , bf16* HB, const float* WGT, float* GL, LAS unsigned char* lds, int vcu, int G, int wave, int lane, int tid) {
    constexpr int NT = NG / 16;
    LAS float* part = (LAS float*)lds;
    const int g = lane >> 4, c16 = lane & 15;
    bf16x8 bhi[NT][4], blo[NT][4];
#pragma unroll
    for (int nt = 0; nt < NT; ++nt)
#pragma unroll
        for (int ks = 0; ks < 4; ++ks) { const float* wp = WGT + (size_t)(16 * nt + c16) * 1024 + 128 * wave + 32 * ks + 8 * g;
            const f32x4 w0 = *(const f32x4*)wp, w1 = *(const f32x4*)(wp + 4); const float wv[8] = {w0[0], w0[1], w0[2], w0[3], w1[0], w1[1], w1[2], w1[3]}; split8(wv, bhi[nt][ks], blo[nt][ks]); }
    for (int tile = vcu; tile < TT / 16; tile += G) {
        const int r0 = tile * 16, b = r0 / PB, p0 = r0 - b * PB; const float* mr = mod + (size_t)(p0 < LC ? 8 : b) * 6144 + 128 * wave + 8 * g;
        const int row = r0 + c16; const float* xr = srow_c(lat, ctx, row) + 128 * wave + 8 * g;
        f32x4 xa[4][2], sha[4][2], sca[4][2];
#pragma unroll
        for (int ks = 0; ks < 4; ++ks)
#pragma unroll
            for (int q = 0; q < 2; ++q) { xa[ks][q] = *(const f32x4*)(xr + 32 * ks + 4 * q); sha[ks][q] = *(const f32x4*)(mr + 32 * ks + 4 * q); sca[ks][q] = *(const f32x4*)(mr + 1024 + 32 * ks + 4 * q); }
        f32x4 acc[NT];
#pragma unroll
        for (int nt = 0; nt < NT; ++nt) acc[nt] = (f32x4){0.f, 0.f, 0.f, 0.f};
#pragma unroll
        for (int ks = 0; ks < 4; ++ks) {
            float hv[8];
#pragma unroll
            for (int q = 0; q < 2; ++q)
#pragma unroll
                for (int i = 0; i < 4; ++i) hv[4 * q + i] = xa[ks][q][i] * (sca[ks][q][i] + 1.0f) + sha[ks][q][i];
            bf16x8 ahi, alo; split8(hv, ahi, alo);
            *(bf16x8*)(HB + (size_t)row * D + 128 * wave + 32 * ks + 8 * g) = ahi;
#pragma unroll
            for (int nt = 0; nt < NT; ++nt) { acc[nt] = mma(ahi, bhi[nt][ks], acc[nt]); acc[nt] = mma(ahi, blo[nt][ks], acc[nt]); acc[nt] = mma(alo, bhi[nt][ks], acc[nt]); }
        }
        __syncthreads();
#pragma unroll
        for (int nt = 0; nt < NT; ++nt)
#pragma unroll
            for (int r = 0; r < 4; ++r) part[(wave * 16 + 4 * g + r) * NG + 16 * nt + c16] = acc[nt][r];
        __syncthreads();
        for (int i = tid; i < 16 * NG; i += 512) { float sum = 0.f;
#pragma unroll
            for (int w8 = 0; w8 < 8; ++w8) sum += part[w8 * 16 * NG + i];
            GL[(size_t)r0 * NG + i] = sum; }
    }
}

__device__ __forceinline__ void ln_row(const float* sr, float* xr, const bf16* yrow, const float* mr, const float* lnw, const float* lnb, bf16* hrow, int lane, int dry, bool active) {
    f32x4 v[4]; float s = 0.f;
#pragma unroll
    for (int j = 0; j < 4; ++j) { const int c = 4 * lane + 256 * j; const f32x4 x = *(const f32x4*)(sr + c), g1 = *(const f32x4*)(mr + 2048 + c); const v2u yw = *(const v2u*)(yrow + c);
        v[j][0] = DN_ALPHA * x[0] + g1[0] * bflo(yw.x); v[j][1] = DN_ALPHA * x[1] + g1[1] * bfhi(yw.x); v[j][2] = DN_ALPHA * x[2] + g1[2] * bflo(yw.y); v[j][3] = DN_ALPHA * x[3] + g1[3] * bfhi(yw.y);
        s += (v[j][0] + v[j][1]) + (v[j][2] + v[j][3]); }
    const float mean = wave_sum(s) * (1.f / D); float s2 = 0.f;
#pragma unroll
    for (int j = 0; j < 4; ++j) { v[j] = v[j] - mean; s2 += (v[j][0] * v[j][0] + v[j][1] * v[j][1]) + (v[j][2] * v[j][2] + v[j][3] * v[j][3]); }
    const float rstd = 1.f / sqrtf(wave_sum(s2) * (1.f / D) + LN_EPS);
    if (active) {
#pragma unroll
    for (int j = 0; j < 4; ++j) { const int c = 4 * lane + 256 * j; const f32x4 w = *(const f32x4*)(lnw + c), bb = *(const f32x4*)(lnb + c);
        const f32x4 x1 = v[j] * rstd * w + bb; if (!dry) *(f32x4*)(xr + c) = x1;
        const f32x4 sh = *(const f32x4*)(mr + 3072 + c), sc = *(const f32x4*)(mr + 4096 + c); const f32x4 hp = x1 * (sc + 1.0f) + sh;
        v2u o; o.x = pk2(hp[0], hp[1]); o.y = pk2(hp[2], hp[3]); if (!dry) *(v2u*)(hrow + c) = o; }
    }
}
__device__ __forceinline__ void ln_phase(const float* slat, const float* sctx, float* lat, float* ctx, const bf16* Y, const float* mod, const float* lnw, const float* lnb, bf16* HB, int gw, int NGW, int lane, int dry, bool lat_only) {
    const int nrows = lat_only ? NB * SEQ : TT;
    for (int i0 = gw; i0 < nrows; i0 += 2 * NGW) {
        const int i1 = i0 + NGW; const bool has1 = i1 < nrows; const int r0 = map_row(i0, lat_only), r1c = map_row(has1 ? i1 : i0, lat_only);
        const int b0 = r0 / PB, p0 = r0 - b0 * PB, b1 = r1c / PB, p1 = r1c - b1 * PB;
        ln_row(srow_c(slat, sctx, r0), srow(lat, ctx, r0), Y + (size_t)r0 * D, mod + (size_t)(p0 < LC ? 8 : b0) * 6144, lnw, lnb, HB + (size_t)r0 * D, lane, dry, true);
        ln_row(srow_c(slat, sctx, r1c), srow(lat, ctx, r1c), Y + (size_t)r1c * D, mod + (size_t)(p1 < LC ? 8 : b1) * 6144, lnw, lnb, HB + (size_t)r1c * D, lane, dry, has1);
    }
}

constexpr int AT_LD = 72;
__device__ __forceinline__ bf16x8 frag_tr_perm(const LAS bf16* t, int ld, int r0, int c0, int lane) {
    const int g = lane >> 4, q = (lane & 15) >> 2, p = lane & 3;
    const LAS bf16* a = t + (r0 + 4 * g + q) * ld + c0 + 4 * p;
    const s16x4 lo = __builtin_amdgcn_ds_read_tr16_b64_v4i16((LAS s16x4*)a);
    const s16x4 hi = __builtin_amdgcn_ds_read_tr16_b64_v4i16((LAS s16x4*)(a + 16 * ld));
    return (bf16x8){lo[0], lo[1], lo[2], lo[3], hi[0], hi[1], hi[2], hi[3]};
}
__device__ __forceinline__ void attn_phase(const bf16* P, bf16* CAT, const float* sink, const float* ropetab, LAS unsigned char* lds, unsigned* qctr, int vcu, int G, int wave, int lane, int tid) {
    LAS bf16* Kt = (LAS bf16*)lds;
    LAS bf16* Vt = (LAS bf16*)(lds + 9216);
    LAS bf16* Qw = (LAS bf16*)(lds + 18432 + wave * 4608);
    const int g = lane >> 4, c16 = lane & 15;
    volatile LAS int* qslot = (volatile LAS int*)(lds + MISC_OFF) + 12;
    for (;;) {
        if (tid == 0) *qslot = (int)__hip_atomic_fetch_add(qctr, 1u, __ATOMIC_RELAXED, __HIP_MEMORY_SCOPE_AGENT);
        __syncthreads();
        const int item = *qslot;
        if (item >= 1024 + 64) break;
        const bool is_ctx = item >= 1024;
        int b, hk, nb;
        if (!is_ctx) { b = item >> 7; hk = (item >> 6) & 1; nb = item & 63; } else { const int it = item - 1024; b = it >> 3; hk = (it >> 2) & 1; nb = it & 3; }
        const int head = hk * 4 + (wave >> 1);
        const int qrow0 = b * PB + (is_ctx ? 0 : LC) + nb * 64 + (wave & 1) * 32;
        const int qlat0 = nb * 64 + (wave & 1) * 32;
        __syncthreads();
#pragma unroll
        for (int i = 0; i < 4; ++i) { const int cidx = lane + 64 * i, rr = cidx >> 3, ch = cidx & 7;
            const v4u raw = *(const v4u*)(P + (size_t)(qrow0 + rr) * N_AB + 2048 + head * 64 + ch * 8); v4u o = raw;
            if (!is_ctx) { const int tl = qlat0 + rr; const int pos = (ch < 4) ? (tl >> 6) : (tl & 63); const float* tb = ropetab + (size_t)(pos * 16 + (ch & 3) * 4) * 2;
                const unsigned wv[4] = {raw.x, raw.y, raw.z, raw.w}; unsigned ov[4];
#pragma unroll
                for (int k = 0; k < 4; ++k) { const float x1 = bflo(wv[k]), x2 = bfhi(wv[k]), c = tb[2 * k], s = tb[2 * k + 1]; ov[k] = pk2(x1 * c - x2 * s, x1 * s + x2 * c); }
                o.x = ov[0]; o.y = ov[1]; o.z = ov[2]; o.w = ov[3]; }
            *(LAS v4u*)(Qw + rr * AT_LD + ch * 8) = o; }
        LDS_FENCE();
        bf16x8 qf[2][2];
#pragma unroll
        for (int mt = 0; mt < 2; ++mt)
#pragma unroll
            for (int ks = 0; ks < 2; ++ks) qf[mt][ks] = frag_row(Qw, AT_LD, 16 * mt, 32 * ks, lane);
        LDS_FENCE();
        f32x4 o[2][4]; float mrun[2], lrun[2];
        const float sk = sink[head];
#pragma unroll
        for (int qt = 0; qt < 2; ++qt) { mrun[qt] = sk; lrun[qt] = 1.f; }
#pragma unroll
        for (int qt = 0; qt < 2; ++qt)
#pragma unroll
            for (int nt = 0; nt < 4; ++nt) o[qt][nt] = (f32x4){0.f, 0.f, 0.f, 0.f};
        const int nkt = is_ctx ? 4 : 9;
        const int srr = tid >> 3, sch = tid & 7;
        int kt = 0; f32x2 trope[4];
#pragma unroll
        for (int i = 0; i < 4; ++i) trope[i] = (f32x2){1.f, 0.f};
        v4u kraw = *(const v4u*)(P + (size_t)(b * PB + srr) * N_AB + 2560 + hk * 64 + sch * 8), vraw = *(const v4u*)(P + (size_t)(b * PB + srr) * N_AB + 2688 + hk * 64 + sch * 8);
        while (kt < nkt) {
            const int kp0 = nb * 64 - 128 + 64 * (kt - 4);
            int kn = kt + 1;
            while (kn < nkt && kn >= 4 && ((nb * 64 - 128 + 64 * (kn - 4)) < 0 || (nb * 64 - 128 + 64 * (kn - 4)) >= SEQ)) ++kn;
            __syncthreads();
            { v4u o = kraw;
              if (kt >= 4) { const unsigned wv[4] = {kraw.x, kraw.y, kraw.z, kraw.w}; unsigned ov[4];
#pragma unroll
                  for (int i = 0; i < 4; ++i) { const float x1 = bflo(wv[i]), x2 = bfhi(wv[i]), c = trope[i][0], sn = trope[i][1]; ov[i] = pk2(x1 * c - x2 * sn, x1 * sn + x2 * c); }
                  o.x = ov[0]; o.y = ov[1]; o.z = ov[2]; o.w = ov[3]; }
              *(LAS v4u*)(Kt + srr * AT_LD + sch * 8) = o; *(LAS v4u*)(Vt + srr * AT_LD + sch * 8) = vraw; }
            if (kn < nkt) { const int kpn = nb * 64 - 128 + 64 * (kn - 4); const int krn = b * PB + (kn < 4 ? 64 * kn : LC + kpn);
                kraw = *(const v4u*)(P + (size_t)(krn + srr) * N_AB + 2560 + hk * 64 + sch * 8); vraw = *(const v4u*)(P + (size_t)(krn + srr) * N_AB + 2688 + hk * 64 + sch * 8);
                if (kn >= 4) { const int tl = kpn + srr; const int pos = (sch < 4) ? (tl >> 6) : (tl & 63); const f32x2* tb = (const f32x2*)(ropetab + (size_t)(pos * 16 + (sch & 3) * 4) * 2);
#pragma unroll
                    for (int i = 0; i < 4; ++i) trope[i] = tb[i]; } }
            __syncthreads();
            const bool need_mask = (kt == 4) || (kt == 8);
            bf16x8 kf[4][2];
#pragma unroll
            for (int km = 0; km < 4; ++km)
#pragma unroll
                for (int ks = 0; ks < 2; ++ks) kf[km][ks] = frag_row(Kt, AT_LD, 16 * km, 32 * ks, lane);
            bf16x8 pa[2][2];
#pragma unroll
            for (int qt = 0; qt < 2; ++qt) {
                f32x4 st[4];
#pragma unroll
                for (int km = 0; km < 4; ++km) { st[km] = (f32x4){0.f, 0.f, 0.f, 0.f};
#pragma unroll
                    for (int ks = 0; ks < 2; ++ks) st[km] = mma(kf[km][ks], qf[qt][ks], st[km]); }
                if (need_mask) {
#pragma unroll
                    for (int km = 0; km < 4; ++km)
#pragma unroll
                        for (int r = 0; r < 4; ++r) { const int dq = (kp0 + 16 * km + 4 * g + r) - (qlat0 + 16 * qt + c16); if (dq > 128 || dq < -128) st[km][r] = -3.0e38f; } }
                float mx = fmaxf(fmaxf(fmaxf(st[0][0], st[0][1]), fmaxf(st[0][2], st[0][3])), fmaxf(fmaxf(st[1][0], st[1][1]), fmaxf(st[1][2], st[1][3])));
                mx = fmaxf(mx, fmaxf(fmaxf(fmaxf(st[2][0], st[2][1]), fmaxf(st[2][2], st[2][3])), fmaxf(fmaxf(st[3][0], st[3][1]), fmaxf(st[3][2], st[3][3]))));
                mx = fmaxf(mx, __shfl_xor(mx, 16)); mx = fmaxf(mx, __shfl_xor(mx, 32));
                const float mnew = fmaxf(mrun[qt], mx), alpha = __expf(mrun[qt] - mnew);
                float ps = 0.f;
#pragma unroll
                for (int km = 0; km < 4; ++km)
#pragma unroll
                    for (int r = 0; r < 4; ++r) { const float pv = __expf(st[km][r] - mnew); st[km][r] = pv; ps += pv; }
                ps += __shfl_xor(ps, 16); ps += __shfl_xor(ps, 32);
                lrun[qt] = lrun[qt] * alpha + ps; mrun[qt] = mnew;
#pragma unroll
                for (int ks2 = 0; ks2 < 2; ++ks2) { const unsigned w0 = pk2(st[2 * ks2][0], st[2 * ks2][1]), w1 = pk2(st[2 * ks2][2], st[2 * ks2][3]), w2 = pk2(st[2 * ks2 + 1][0], st[2 * ks2 + 1][1]), w3 = pk2(st[2 * ks2 + 1][2], st[2 * ks2 + 1][3]);
                    const v4u wv = (v4u){w0, w1, w2, w3}; pa[qt][ks2] = __builtin_bit_cast(bf16x8, wv); }
#pragma unroll
                for (int r = 0; r < 4; ++r) { const float ar = __shfl(alpha, (lane & 48) + 4 * g + r);
#pragma unroll
                    for (int nt = 0; nt < 4; ++nt) o[qt][nt][r] *= ar; }
            }
#pragma unroll
            for (int ks2 = 0; ks2 < 2; ++ks2) {
                bf16x8 vf[4];
#pragma unroll
                for (int nt = 0; nt < 4; ++nt) vf[nt] = frag_tr_perm(Vt, AT_LD, 32 * ks2, 16 * nt, lane);
#pragma unroll
                for (int qt = 0; qt < 2; ++qt)
#pragma unroll
                    for (int nt = 0; nt < 4; ++nt) o[qt][nt] = mma(pa[qt][ks2], vf[nt], o[qt][nt]); }
            LDS_FENCE();
            kt = kn;
        }
#pragma unroll
        for (int qt = 0; qt < 2; ++qt)
#pragma unroll
            for (int r = 0; r < 4; ++r) { const float inv = 1.f / __shfl(lrun[qt], (lane & 48) + 4 * g + r); bf16* orow = CAT + (size_t)(qrow0 + 16 * qt + 4 * g + r) * D + 512 + head * 64;
#pragma unroll
                for (int nt = 0; nt < 4; ++nt) orow[16 * nt + c16] = (bf16)f2bf(o[qt][nt][r] * inv); }
    }
}

__device__ __forceinline__ float wave_prefix_sum(float v) {
    v += __builtin_bit_cast(float, __builtin_amdgcn_update_dpp(0, __builtin_bit_cast(int, v), 0x111, 0xf, 0xf, true)); v += __builtin_bit_cast(float, __builtin_amdgcn_update_dpp(0, __builtin_bit_cast(int, v), 0x112, 0xf, 0xf, true));
    v += __builtin_bit_cast(float, __builtin_amdgcn_update_dpp(0, __builtin_bit_cast(int, v), 0x114, 0xf, 0xf, true)); v += __builtin_bit_cast(float, __builtin_amdgcn_update_dpp(0, __builtin_bit_cast(int, v), 0x118, 0xf, 0xf, true));
    v += __builtin_bit_cast(float, __builtin_amdgcn_update_dpp(0, __builtin_bit_cast(int, v), 0x142, 0xa, 0xf, false)); v += __builtin_bit_cast(float, __builtin_amdgcn_update_dpp(0, __builtin_bit_cast(int, v), 0x143, 0xc, 0xf, false));
    return v;
}
__device__ __forceinline__ float wave_prefix_max(float v) {
    const int ninf = (int)0xff800000u;
    v = fmaxf(v, __builtin_bit_cast(float, __builtin_amdgcn_update_dpp(ninf, __builtin_bit_cast(int, v), 0x111, 0xf, 0xf, false))); v = fmaxf(v, __builtin_bit_cast(float, __builtin_amdgcn_update_dpp(ninf, __builtin_bit_cast(int, v), 0x112, 0xf, 0xf, false)));
    v = fmaxf(v, __builtin_bit_cast(float, __builtin_amdgcn_update_dpp(ninf, __builtin_bit_cast(int, v), 0x114, 0xf, 0xf, false))); v = fmaxf(v, __builtin_bit_cast(float, __builtin_amdgcn_update_dpp(ninf, __builtin_bit_cast(int, v), 0x118, 0xf, 0xf, false)));
    v = fmaxf(v, __builtin_bit_cast(float, __builtin_amdgcn_update_dpp(ninf, __builtin_bit_cast(int, v), 0x142, 0xa, 0xf, false))); v = fmaxf(v, __builtin_bit_cast(float, __builtin_amdgcn_update_dpp(ninf, __builtin_bit_cast(int, v), 0x143, 0xc, 0xf, false)));
    return v;
}
__device__ __forceinline__ void mlstm_gate_scan(const float* GL  , const float* gate_b  , unsigned char* ws, int gw, int NGW, int lane) {
    float* BQ = (float*)(ws + WS_BQ); float* CQ = (float*)(ws + WS_CQ); float* EM = (float*)(ws + WS_EM); float* AI = (float*)(ws + WS_AI);
    float* AST = (float*)(ws + WS_AST); float* CL = (float*)(ws + WS_CL);
    for (int chain = gw; chain < 64; chain += NGW) {
        const int dir = chain >> 5, b = (chain >> 2) & 7, h = chain & 3;
        const float bi = gate_b[dir * 8 + h], bfg = gate_b[dir * 8 + 4 + h];
        float m_st = 0.f;
        float gi_n, gf_n;
        { const int j0 = dir == 0 ? 0 : 3; const int p0 = j0 * 64 + (dir == 0 ? lane : 63 - lane); const float* gr = GL + (size_t)(b * PB + p0) * 16 + dir * 8; gi_n = gr[h]; gf_n = gr[4 + h]; }
        for (int sc = 0; sc < NCH; ++sc) {
            const int j = dir == 0 ? sc : (sc < 4 ? 3 - sc : 71 - sc);
            const int p = j * 64 + (dir == 0 ? lane : 63 - lane);
            const float li = gi_n + bi, lf = logsigmoidf_(gf_n + bfg);
            if (sc + 1 < NCH) { const int sn = sc + 1; const int jn = dir == 0 ? sn : (sn < 4 ? 3 - sn : 71 - sn); const int pn = jn * 64 + (dir == 0 ? lane : 63 - lane);
                const float* gr = GL + (size_t)(b * PB + pn) * 16 + dir * 8; gi_n = gr[h]; gf_n = gr[4 + h]; }
            const float cum = wave_prefix_sum(lf);
            const float bb = li - cum; const float pm = wave_prefix_max(bb);
            const float c = fmaxf(m_st, pm);
            const size_t ti = (size_t)chain * PB + p;
            BQ[ti] = bb; CQ[ti] = c; EM[ti] = __expf(-(cum + c)); AI[ti] = __expf(m_st - c);
            const float cl = __builtin_bit_cast(float, __builtin_amdgcn_readlane(__builtin_bit_cast(int, c), 63)), tot = __builtin_bit_cast(float, __builtin_amdgcn_readlane(__builtin_bit_cast(int, cum), 63));
            if (lane == 0) { CL[chain * NCH + j] = cl; AST[chain * NCH + j] = __expf(m_st - cl); }
            m_st = tot + cl;
        }
    }
}


__device__ __forceinline__ float logsig_fast(float x) { return fminf(x, 0.f) - __logf(1.f + __expf(-fabsf(x))); }
__device__ __forceinline__ void gla_prep(bf16* P, bf16* QKR, const float* LOW  , const float* gate_up  , const float* gate_b  , unsigned char* ws,
                                         LAS unsigned char* lds, int vcu, int G, int tid, int dry) {
    float* ET = (float*)(ws + WS_ET);
    LAS float* lowt = (LAS float*)lds;
    LAS bf16* qs = (LAS bf16*)(lds + 8192);
    LAS bf16* ks = (LAS bf16*)(lds + 24576);
    LAS float* LA = (LAS float*)(lds + 40960);
    LAS float* HT = (LAS float*)(lds + 106496);
    const int dc = tid & 255, dir = dc >> 7, ch = dc & 127, half = tid >> 8;
    for (int item = vcu; item < NB * NCH * 4; item += G) {
        const int b = item / (NCH * 4), j = (item >> 2) % NCH, h = item & 3;
        const int row0 = b * PB + j * 64, c = h * 128 + ch;
        __syncthreads();
        for (int i = tid; i < 64 * 32; i += 512) lowt[i] = LOW[(size_t)row0 * 32 + i];
#pragma unroll
        for (int i = 0; i < 2; ++i) { const int cidx = tid + 512 * i, rr = cidx >> 4, c8 = cidx & 15; const bf16* src = P + (size_t)(row0 + rr) * N_C + h * 128 + c8 * 8;
            *(LAS v4u*)(qs + rr * 128 + c8 * 8) = *(const v4u*)src; *(LAS v4u*)(ks + rr * 128 + c8 * 8) = *(const v4u*)(src + 512); }
        float gu[16];
#pragma unroll
        for (int k = 0; k < 16; ++k) gu[k] = gate_up[(size_t)(dir * 16 + k) * 512 + c];
        const float gb = gate_b[dir * 512 + c];
        __syncthreads();
        float hsum = 0.f;
#pragma unroll 4
        for (int i = 0; i < 32; ++i) { const int t = half * 32 + i; float x = gb;
#pragma unroll
            for (int k = 0; k < 16; ++k) x += lowt[t * 32 + dir * 16 + k] * gu[k];
            const float la = logsig_fast(x) * (1.f / 16.f); LA[t * 256 + dc] = la; hsum += la; }
        HT[half * 256 + dc] = hsum;
        __syncthreads();
        float cum = (dir == 0) ? (half == 1 ? HT[dc] : 0.f) : (half == 0 ? HT[256 + dc] : 0.f);
#pragma unroll 4
        for (int i = 0; i < 32; ++i) { const int t = half * 32 + (dir == 0 ? i : 31 - i);
            cum += LA[t * 256 + dc];
            const float e = __expf(cum), ei = __expf(-cum);
            const size_t ro = (size_t)(row0 + t) * N_C;
            const float qv = bf2f(qs[t * 128 + ch]), kv = bf2f(ks[t * 128 + ch]);
            if (dir == 0) { if (!dry) { P[ro + c] = (bf16)f2bf(qv * e); P[ro + 512 + c] = (bf16)f2bf(kv * ei); } }
            else { QKR[(size_t)(row0 + t) * 1024 + c] = (bf16)f2bf(qv * e); QKR[(size_t)(row0 + t) * 1024 + 512 + c] = (bf16)f2bf(kv * ei); } }
        if (half == 0) ET[((size_t)((dir * 8 + b) * 4 + h) * NCH + j) * 128 + ch] = __expf(HT[dc] + HT[256 + dc]);
    }
}


__device__ __forceinline__ unsigned f2sort(float f) { const unsigned u = __builtin_bit_cast(unsigned, f); return (u & 0x80000000u) ? ~u : (u | 0x80000000u); }
__device__ __forceinline__ float sort2f(unsigned s) { const unsigned u = (s & 0x80000000u) ? (s & 0x7fffffffu) : ~s; return __builtin_bit_cast(float, u); }
template <int CTRL> __device__ __forceinline__ unsigned dppmov_u(unsigned x) { return (unsigned)__builtin_amdgcn_mov_dpp((int)x, CTRL, 0xf, 0xf, true); }
__device__ __forceinline__ unsigned gmax16(unsigned x) { unsigned y;
    y = dppmov_u<0xB1>(x); x = x > y ? x : y; y = dppmov_u<0x4E>(x); x = x > y ? x : y; y = dppmov_u<0x141>(x); x = x > y ? x : y; y = dppmov_u<0x128>(x); x = x > y ? x : y; return x; }
__device__ __forceinline__ float gsum16(float x) {
    x += __builtin_bit_cast(float, dppmov_u<0xB1>(__builtin_bit_cast(unsigned, x))); x += __builtin_bit_cast(float, dppmov_u<0x4E>(__builtin_bit_cast(unsigned, x)));
    x += __builtin_bit_cast(float, dppmov_u<0x141>(__builtin_bit_cast(unsigned, x))); x += __builtin_bit_cast(float, dppmov_u<0x128>(__builtin_bit_cast(unsigned, x))); return x; }
#define CSWAP(a, b) do { const unsigned hi_ = (a) > (b) ? (a) : (b), lo_ = (a) > (b) ? (b) : (a); (a) = hi_; (b) = lo_; } while (0)
__device__ __forceinline__ void peer_route(const bf16* Q, const bf16* KEYS, int* EID, float* GWT, int gw, int NGW, int lane, bool lat_only) {
    const int g = lane >> 4, c16 = lane & 15, gbase = lane & 48;
    const int nwi = (lat_only ? NB * SEQ / 16 : TT / 16) * 8;
    const unsigned tw = (c16 == 0 ? 0x03020100u : (c16 == 1 ? 0x07060504u : (c16 == 2 ? 0x0b0a0908u : (c16 == 3 ? 0x0f0e0d0cu : (c16 == 4 ? 0x13121110u : (c16 == 5 ? 0x17161514u : (c16 == 6 ? 0x23222120u : (c16 == 7 ? 0x32313024u : (c16 == 8 ? 0x42414033u : (c16 == 9 ? 0x61605150u : (c16 == 10 ? 0x90807170u : (c16 == 11 ? 0xd0c0b0a0u : (c16 == 12 ? 0xfffff0e0u : 0xffffffffu)))))))))))));
    for (int wi = gw; wi < nwi; wi += NGW) {
        const int t0 = map_row((wi >> 3) * 16, lat_only), head = wi & 7;
        unsigned tops[2][4];
#pragma unroll
        for (int p = 0; p < 2; ++p) {
            const bf16* qrow = Q + (size_t)(t0 + c16) * 2048 + head * 256 + p * 128 + 8 * g;
            bf16x8 qf[4];
#pragma unroll
            for (int ks = 0; ks < 4; ++ks) qf[ks] = *(const bf16x8*)(qrow + 32 * ks);
            const bf16* kb = KEYS + (size_t)(head * 2 + p) * 128 * 128 + (size_t)c16 * 128 + 8 * g;
            unsigned key[8][4];
#pragma unroll
            for (int nt = 0; nt < 8; ++nt) { f32x4 s = (f32x4){0.f, 0.f, 0.f, 0.f};
#pragma unroll
                for (int ks = 0; ks < 4; ++ks) s = mma(qf[ks], *(const bf16x8*)(kb + (size_t)nt * 16 * 128 + 32 * ks), s);
#pragma unroll
                for (int r = 0; r < 4; ++r) key[nt][r] = (f2sort(s[r]) & ~127u) | (unsigned)(127 - (16 * nt + c16)); }
            unsigned kk[4][8];
#pragma unroll
            for (int r = 0; r < 4; ++r) {
#pragma unroll
                for (int nt = 0; nt < 8; ++nt) kk[r][nt] = key[nt][r];
                CSWAP(kk[r][0], kk[r][1]); CSWAP(kk[r][2], kk[r][3]); CSWAP(kk[r][4], kk[r][5]); CSWAP(kk[r][6], kk[r][7]); CSWAP(kk[r][0], kk[r][2]); CSWAP(kk[r][1], kk[r][3]); CSWAP(kk[r][4], kk[r][6]); CSWAP(kk[r][5], kk[r][7]);
                CSWAP(kk[r][1], kk[r][2]); CSWAP(kk[r][5], kk[r][6]); CSWAP(kk[r][0], kk[r][4]); CSWAP(kk[r][1], kk[r][5]); CSWAP(kk[r][2], kk[r][6]); CSWAP(kk[r][3], kk[r][7]); CSWAP(kk[r][2], kk[r][4]); CSWAP(kk[r][3], kk[r][5]);
                CSWAP(kk[r][1], kk[r][2]); CSWAP(kk[r][3], kk[r][4]); CSWAP(kk[r][5], kk[r][6]); }
            unsigned tt[4] = {0u, 0u, 0u, 0u};
#pragma unroll 2
            for (int rd = 0; rd < 16; ++rd) {
#pragma unroll
                for (int r = 0; r < 4; ++r) { const unsigned m = gmax16(kk[r][0]); const bool w = (kk[r][0] == m);
#pragma unroll
                    for (int q = 0; q < 7; ++q) kk[r][q] = w ? kk[r][q + 1] : kk[r][q];
                    kk[r][7] = w ? 0u : kk[r][7];
                    tt[r] = (c16 == rd) ? m : tt[r]; } }
#pragma unroll
            for (int r = 0; r < 4; ++r) tops[p][r] = tt[r];
        }
        unsigned res[4]; unsigned kq[4][4];
#pragma unroll
        for (int r = 0; r < 4; ++r) { res[r] = 0u;
#pragma unroll
            for (int sl = 0; sl < 4; ++sl) { const unsigned byte = (tw >> (8 * sl)) & 255u; const int ii = (int)(byte >> 4), jj = (int)(byte & 15u);
                const float a = sort2f((unsigned)__shfl((int)tops[0][r], gbase + ii) & ~127u), bq = sort2f((unsigned)__shfl((int)tops[1][r], gbase + jj) & ~127u);
                kq[r][sl] = byte == 255u ? 0u : ((f2sort(a + bq) & ~255u) | (unsigned)((15 - ii) << 4) | (unsigned)(15 - jj)); }
            CSWAP(kq[r][0], kq[r][1]); CSWAP(kq[r][2], kq[r][3]); CSWAP(kq[r][0], kq[r][2]); CSWAP(kq[r][1], kq[r][3]); CSWAP(kq[r][1], kq[r][2]); }
#pragma unroll 2
        for (int rd = 0; rd < 16; ++rd) {
#pragma unroll
            for (int r = 0; r < 4; ++r) { const unsigned m = gmax16(kq[r][0]); const bool w = (kq[r][0] == m);
                kq[r][0] = w ? kq[r][1] : kq[r][0]; kq[r][1] = w ? kq[r][2] : kq[r][1]; kq[r][2] = w ? kq[r][3] : kq[r][2]; kq[r][3] = w ? 0u : kq[r][3];
                res[r] = (c16 == rd) ? m : res[r]; } }
#pragma unroll
        for (int r = 0; r < 4; ++r) {
            const float val = sort2f(res[r] & ~255u); const int ii = 15 - (int)((res[r] >> 4) & 15u), jj = 15 - (int)(res[r] & 15u);
            const float mx = __shfl(val, gbase);
            const float ex = __expf(val - mx), sum = gsum16(ex);
            const unsigned i0 = 127u - ((unsigned)__shfl((int)tops[0][r], gbase + ii) & 127u), i1 = 127u - ((unsigned)__shfl((int)tops[1][r], gbase + jj) & 127u);
            const size_t o = (size_t)(t0 + 4 * g + r) * 128 + head * 16 + c16;
            EID[o] = (int)(i0 * 128u + i1); GWT[o] = ex / sum;
        }
    }
}

__device__ __forceinline__ void unpack8(const v4u w, float* o) { o[0] = bflo(w.x); o[1] = bfhi(w.x); o[2] = bflo(w.y); o[3] = bfhi(w.y); o[4] = bflo(w.z); o[5] = bfhi(w.z); o[6] = bflo(w.w); o[7] = bfhi(w.w); }
typedef int v8i __attribute__((ext_vector_type(8)));
constexpr int P1_PAIR = 1040, P1_BUF = 8 * P1_PAIR, P1_HQ = 2 * P1_BUF, P1_DOTS = P1_HQ, P1_WAVE_LDS = 19968;
__device__ __forceinline__ int p1_pair(int m) { return m < 4 ? m : (m < 12 ? m - 4 : m - 8); }
__device__ __forceinline__ int p1_exp(int m) { return m < 4 ? 2 * m : (m < 12 ? 2 * (m - 4) + 1 : 2 * (m - 8)); }
__device__ __forceinline__ void peer_pass1(const bf16* HB, const int* EID, const float* GWT, const unsigned char* U4, const float* SUi, const float* SVi, float* COEF,
                                           LAS unsigned char* lds, int wave, int gw, int NGW, int lane, bool lat_only) {
    LAS unsigned char* wl = lds + wave * P1_WAVE_LDS;
    LAS float* dots = (LAS float*)(wl + P1_DOTS);
    const int n = lane & 15, g = lane >> 4;
    const int nrows = lat_only ? NB * SEQ : TT;
    const unsigned aoff = (unsigned)(p1_pair(n) * P1_PAIR + ((n >= 4 && n < 12) ? 512 : 0) + 128 * g);
    const unsigned boff = (unsigned)(P1_HQ + (n < 6 ? 512 * n : 0) + 128 * g);
    const float wn = n == 0 ? 1.f : (n == 1 ? 0.25f : (n == 2 ? 0.0625f : (n == 3 ? 0.015625f : (n == 4 ? 0.00390625f : (n == 5 ? 0.0009765625f : 0.f)))));
    int ri = gw;
    if (ri >= nrows) return;
    int r = map_row(ri, lat_only);
    v4u hn0 = *(const v4u*)(HB + (size_t)r * D + 16 * lane), hn1 = *(const v4u*)(HB + (size_t)r * D + 16 * lane + 8);
    int eidAn = EID[(size_t)r * 128 + lane], eidBn = EID[(size_t)r * 128 + 64 + lane];
#define P1_DMA(src_e, base_, bufo_) do { _Pragma("unroll") for (int p_ = 0; p_ < 8; ++p_) { \
        const int ia_ = __builtin_amdgcn_readlane((src_e), (base_) + 2 * p_), ib_ = __builtin_amdgcn_readlane((src_e), (base_) + 2 * p_ + 1); const int id_ = lane < 32 ? ia_ : ib_; \
        __builtin_amdgcn_global_load_lds((const unsigned*)(U4 + (size_t)id_ * 512 + 16 * (lane & 31)), (LAS unsigned*)(wl + (bufo_) + p_ * P1_PAIR), 16, 0, 0); } } while (0)
    P1_DMA(eidAn, 0, 0); P1_DMA(eidAn, 16, P1_BUF);
    for (; ri < nrows; ri += NGW) {
        r = map_row(ri, lat_only);
        const int eidA = eidAn, eidB = eidBn;
        { float h[16]; unpack8(hn0, h); unpack8(hn1, h + 8);
#pragma unroll
          for (int part = 0; part < 6; ++part) {
              unsigned w[2];
#pragma unroll
              for (int d = 0; d < 2; ++d) { unsigned t = 0u;
                  t = __builtin_amdgcn_cvt_scalef32_pk_fp4_f32(t, h[8 * d], h[8 * d + 1], 1.0f, 0); t = __builtin_amdgcn_cvt_scalef32_pk_fp4_f32(t, h[8 * d + 2], h[8 * d + 3], 1.0f, 1);
                  t = __builtin_amdgcn_cvt_scalef32_pk_fp4_f32(t, h[8 * d + 4], h[8 * d + 5], 1.0f, 2); t = __builtin_amdgcn_cvt_scalef32_pk_fp4_f32(t, h[8 * d + 6], h[8 * d + 7], 1.0f, 3);
                  w[d] = t; }
              *(LAS v2u*)(wl + P1_HQ + 512 * part + 8 * lane) = (v2u){w[0], w[1]};
              if (part < 5) {
#pragma unroll
                  for (int d = 0; d < 2; ++d) {
                      const f32x2 q0 = __builtin_amdgcn_cvt_scalef32_pk_f32_fp4(w[d], 1.0f, 0), q1 = __builtin_amdgcn_cvt_scalef32_pk_f32_fp4(w[d], 1.0f, 1);
                      const f32x2 q2 = __builtin_amdgcn_cvt_scalef32_pk_f32_fp4(w[d], 1.0f, 2), q3 = __builtin_amdgcn_cvt_scalef32_pk_f32_fp4(w[d], 1.0f, 3);
                      h[8 * d] = (h[8 * d] - q0[0]) * 4.f; h[8 * d + 1] = (h[8 * d + 1] - q0[1]) * 4.f; h[8 * d + 2] = (h[8 * d + 2] - q1[0]) * 4.f; h[8 * d + 3] = (h[8 * d + 3] - q1[1]) * 4.f;
                      h[8 * d + 4] = (h[8 * d + 4] - q2[0]) * 4.f; h[8 * d + 5] = (h[8 * d + 5] - q2[1]) * 4.f; h[8 * d + 6] = (h[8 * d + 6] - q3[0]) * 4.f; h[8 * d + 7] = (h[8 * d + 7] - q3[1]) * 4.f; } } } }
        const float gwtA = GWT[(size_t)r * 128 + lane], gwtB = GWT[(size_t)r * 128 + 64 + lane];
        const float suA = SUi[eidA], suB = SUi[eidB], svA = SVi[eidA], svB = SVi[eidB];
        const int rin = ri + NGW; const bool more = rin < nrows; const int rn = map_row(more ? rin : ri, lat_only);
        hn0 = *(const v4u*)(HB + (size_t)rn * D + 16 * lane); hn1 = *(const v4u*)(HB + (size_t)rn * D + 16 * lane + 8);
        eidAn = EID[(size_t)rn * 128 + lane]; eidBn = EID[(size_t)rn * 128 + 64 + lane];
        LDS_FENCE();
        v4u bw[8];
#pragma unroll
        for (int c = 0; c < 8; ++c) bw[c] = *(LAS const v4u*)(wl + boff + 16 * c);
#pragma unroll 1
        for (int G = 0; G < 8; ++G) {
            if (G < 7 || more) asm volatile("s_waitcnt vmcnt(8)" ::: "memory"); else asm volatile("s_waitcnt vmcnt(0)" ::: "memory");
            const unsigned bufo = (G & 1) ? (unsigned)P1_BUF : 0u;
            v4u aw[8];
#pragma unroll
            for (int c = 0; c < 8; ++c) aw[c] = *(LAS const v4u*)(wl + bufo + aoff + 16 * c);
            asm volatile("s_waitcnt lgkmcnt(0)" ::: "memory");
            { const int srcsel = G < 2 ? eidA : (G < 6 ? eidB : eidAn); const int base = 16 * ((G + 2) & 3);
              if (G < 6 || more) { if (G & 1) P1_DMA(srcsel, base, P1_BUF); else P1_DMA(srcsel, base, 0); } }
            f32x4 acc = (f32x4){0.f, 0.f, 0.f, 0.f};
#pragma unroll
            for (int c = 0; c < 8; ++c) {
                const v8i A = (v8i){(int)aw[c].x, (int)aw[c].y, (int)aw[c].z, (int)aw[c].w, 0, 0, 0, 0};
                const v8i Bv = (v8i){(int)bw[c].x, (int)bw[c].y, (int)bw[c].z, (int)bw[c].w, 0, 0, 0, 0};
                acc = __builtin_amdgcn_mfma_scale_f32_16x16x128_f8f6f4(A, Bv, acc, 4, 4, 0, 0, 0, 0); }
            f32x4 dv;
#pragma unroll
            for (int k = 0; k < 4; ++k) dv[k] = gsum16(acc[k] * wn);
            if (n == 0) { LAS float* dp = dots + 16 * G + p1_exp(4 * g); dp[0] = dv[0]; dp[2] = dv[1]; dp[4] = dv[2]; dp[6] = dv[3]; }
        }
        LDS_FENCE();
        { const float dot = dots[lane] * suA; COEF[(size_t)r * 128 + lane] = gwtA * 0.5f * dot * (1.f + erff(dot * 0.70710678118f)) * svA; }
        { const float dot = dots[64 + lane] * suB; COEF[(size_t)r * 128 + 64 + lane] = gwtB * 0.5f * dot * (1.f + erff(dot * 0.70710678118f)) * svB; }
    }
#undef P1_DMA
}
constexpr int P2_CPART = 16384, P2_CSTAGE = P2_CPART + 256, P2_FSTAGE = P2_CSTAGE + 512;
typedef int v2i __attribute__((ext_vector_type(2)));
template <bool USE_PEER>
__device__ __forceinline__ void peer_expert(const float* COEF, const int* EID, const unsigned char* V4,
                                            float* lat, float* ctx, const float* mod, const float* lnw, const float* lnb, LAS unsigned char* lds, int wave, int gw, int NGW, int lane, int dry, bool lat_only) {
    LAS unsigned char* wl = lds + wave * P1_WAVE_LDS;
    LAS float* cstage = (LAS float*)(wl + P2_CSTAGE); LAS float* fstage = (LAS float*)(wl + P2_FSTAGE);
    const int c = lane & 15, kb = lane >> 4, drow = lane >> 3, dpos = lane & 7, fk = (c >> 1) & 7;
    const unsigned trbase = (unsigned)((32 * kb + c) * 128);
    const int nrows = lat_only ? NB * SEQ : TT;
    int ri = gw;
    if (ri >= nrows) return;
    unsigned roff[16];
#define P2_ROFF(row_) do { _Pragma("unroll") for (int i_ = 0; i_ < 16; ++i_) roff[i_] = (unsigned)EID[(size_t)(row_) * 128 + 8 * i_ + drow] * 512u + 16u * (unsigned)(dpos ^ ((4 * i_ + (drow >> 1)) & 7)); } while (0)
    P2_ROFF(map_row(ri, lat_only));
#define P2_DMA(cqo_) do { _Pragma("unroll") for (int i_ = 0; i_ < 16; ++i_) \
        __builtin_amdgcn_global_load_lds((const unsigned*)(V4 + (size_t)(roff[i_] + (cqo_))), (LAS unsigned*)(wl + 1024 * i_), 16, 0, 0); } while (0)
    if (USE_PEER) P2_DMA(0u);
    for (; ri < nrows; ri += NGW) {
        const int r = map_row(ri, lat_only);
        const int b = r / PB, p = r - b * PB; float* xr = srow(lat, ctx, r); const float* mr = mod + (size_t)(p < LC ? 8 : b) * 6144;
        float f[16];
#pragma unroll
        for (int i = 0; i < 16; ++i) f[i] = 0.f;
        if (USE_PEER) {
        const int rin = ri + NGW; const bool more = rin < nrows; const int rn = map_row(more ? rin : ri, lat_only);
        const float cA = COEF[(size_t)r * 128 + lane], cB = COEF[(size_t)r * 128 + 64 + lane];
        float cm = fmaxf(fabsf(cA), fabsf(cB));
        cm = fmaxf(cm, dppmov_f<0xB1>(cm)); cm = fmaxf(cm, dppmov_f<0x4E>(cm)); cm = fmaxf(cm, dppmov_f<0x141>(cm)); cm = fmaxf(cm, dppmov_f<0x128>(cm)); cm = fmaxf(cm, __shfl_xor(cm, 16)); cm = fmaxf(cm, __shfl_xor(cm, 32));
        const float sc = cm > 0.f ? 6.0f / cm : 1.f, isc = cm > 0.f ? cm * (1.f / 6.0f) : 1.f;
        cstage[lane] = cA * sc; cstage[64 + lane] = cB * sc;
        LDS_FENCE();
        if (lane < 16) {
            float h[8]; { const f32x4 x0 = *(LAS const f32x4*)(cstage + 8 * lane), x1 = *(LAS const f32x4*)(cstage + 8 * lane + 4); h[0] = x0[0]; h[1] = x0[1]; h[2] = x0[2]; h[3] = x0[3]; h[4] = x1[0]; h[5] = x1[1]; h[6] = x1[2]; h[7] = x1[3]; }
#pragma unroll
            for (int part = 0; part < 4; ++part) {
                unsigned t = 0u;
                t = __builtin_amdgcn_cvt_scalef32_pk_fp4_f32(t, h[0], h[1], 1.0f, 0); t = __builtin_amdgcn_cvt_scalef32_pk_fp4_f32(t, h[2], h[3], 1.0f, 1);
                t = __builtin_amdgcn_cvt_scalef32_pk_fp4_f32(t, h[4], h[5], 1.0f, 2); t = __builtin_amdgcn_cvt_scalef32_pk_fp4_f32(t, h[6], h[7], 1.0f, 3);
                *(LAS unsigned*)(wl + P2_CPART + 64 * part + 4 * lane) = t;
                if (part < 3) { const f32x2 q0 = __builtin_amdgcn_cvt_scalef32_pk_f32_fp4(t, 1.0f, 0), q1 = __builtin_amdgcn_cvt_scalef32_pk_f32_fp4(t, 1.0f, 1), q2 = __builtin_amdgcn_cvt_scalef32_pk_f32_fp4(t, 1.0f, 2), q3 = __builtin_amdgcn_cvt_scalef32_pk_f32_fp4(t, 1.0f, 3);
                    h[0] = (h[0] - q0[0]) * 4.f; h[1] = (h[1] - q0[1]) * 4.f; h[2] = (h[2] - q1[0]) * 4.f; h[3] = (h[3] - q1[1]) * 4.f; h[4] = (h[4] - q2[0]) * 4.f; h[5] = (h[5] - q2[1]) * 4.f; h[6] = (h[6] - q3[0]) * 4.f; h[7] = (h[7] - q3[1]) * 4.f; } } }
        LDS_FENCE();
        v4u aw = (v4u){0u, 0u, 0u, 0u};
        if (c < 4) aw = *(LAS const v4u*)(wl + P2_CPART + 64 * c + 16 * kb);
        const v8i A = (v8i){(int)aw.x, (int)aw.y, (int)aw.z, (int)aw.w, 0, 0, 0, 0};
#pragma unroll 1
        for (int cq = 0; cq < 4; ++cq) {
            asm volatile("s_waitcnt vmcnt(0)" ::: "memory");
#define P2_TILES(t0_) do { v2i r1[8], r2[8]; \
            _Pragma("unroll") for (int t = 0; t < 8; ++t) { const unsigned a = trbase + 16u * (unsigned)((((t0_) + t) >> 1) ^ fk) + 8u * (unsigned)(t & 1); \
                r1[t] = __builtin_amdgcn_ds_read_tr4_b64_v2i32((LAS v2i*)(wl + a)); r2[t] = __builtin_amdgcn_ds_read_tr4_b64_v2i32((LAS v2i*)(wl + a + 2048)); } \
            if ((t0_) == 8) { asm volatile("s_waitcnt lgkmcnt(0)" ::: "memory");     \
                if (cq < 3) { P2_DMA(128u * (unsigned)(cq + 1)); if (cq == 2 && more) P2_ROFF(rn); } else if (more) P2_DMA(0u); } \
            _Pragma("unroll") for (int t = 0; t < 8; ++t) { \
                const v8i Bv = (v8i){r1[t].x, r1[t].y, r2[t].x, r2[t].y, 0, 0, 0, 0}; \
                const f32x4 d = __builtin_amdgcn_mfma_scale_f32_16x16x128_f8f6f4(A, Bv, (f32x4){0.f, 0.f, 0.f, 0.f}, 4, 4, 0, 0, 0, 0); \
                const float fv = (d[0] + 0.25f * d[1] + 0.0625f * d[2] + 0.015625f * d[3]) * isc; \
                if (kb == 0) fstage[16 * ((t0_) + t) + c] = fv; } } while (0)
            P2_TILES(0); P2_TILES(8);
#undef P2_TILES
            LDS_FENCE();
            const f32x4 fq = *(LAS const f32x4*)(fstage + 4 * lane);
            if (cq == 0) { f[0] = fq[0]; f[1] = fq[1]; f[2] = fq[2]; f[3] = fq[3]; } else if (cq == 1) { f[4] = fq[0]; f[5] = fq[1]; f[6] = fq[2]; f[7] = fq[3]; }
            else if (cq == 2) { f[8] = fq[0]; f[9] = fq[1]; f[10] = fq[2]; f[11] = fq[3]; } else { f[12] = fq[0]; f[13] = fq[1]; f[14] = fq[2]; f[15] = fq[3]; }
        }
        }
        float v[16]; float s = 0.f;
#pragma unroll
        for (int q = 0; q < 4; ++q) { const int cc = 256 * q + 4 * lane; const f32x4 x1 = *(const f32x4*)(xr + cc), g2 = *(const f32x4*)(mr + 5120 + cc);
#pragma unroll
            for (int i = 0; i < 4; ++i) { v[4 * q + i] = DN_ALPHA * x1[i] + g2[i] * f[4 * q + i]; s += v[4 * q + i]; } }
        const float mean = wave_sum(s) * (1.f / D); float s2 = 0.f;
#pragma unroll
        for (int i = 0; i < 16; ++i) { v[i] -= mean; s2 += v[i] * v[i]; }
        const float rstd = 1.f / sqrtf(wave_sum(s2) * (1.f / D) + LN_EPS);
#pragma unroll
        for (int q = 0; q < 4; ++q) { const int cc = 256 * q + 4 * lane; const f32x4 w = *(const f32x4*)(lnw + cc), bb2 = *(const f32x4*)(lnb + cc); f32x4 o;
#pragma unroll
            for (int i = 0; i < 4; ++i) o[i] = v[4 * q + i] * rstd * w[i] + bb2[i];
            if (!dry) *(f32x4*)(xr + cc) = o; }
    }
#undef P2_DMA
#undef P2_ROFF
}

__device__ __forceinline__ bf16* od_row_base(unsigned char* ws, int dir, int b) {
    if (dir == 0) return (bf16*)(ws + WS_ST) + (size_t)b * SEQ * 1024;
    return b < 7 ? (bf16*)(ws + WS_ST + 64 * MiB) + (size_t)b * SEQ * 1024 : (bf16*)(ws + WS_XC);
}
__device__ __forceinline__ void gla_fused_scan(const bf16* P, const bf16* QKR, unsigned char* ws, LAS unsigned char* lds, int vcu, int G, int wave, int lane, int tid, int dry) {
    const float* ET = (const float*)(ws + WS_ET);
    LAS bf16* Qt = (LAS bf16*)lds;
    LAS bf16* Kt = (LAS bf16*)(lds + 34816);
    LAS bf16* Vt = (LAS bf16*)(lds + 69632);
    LAS bf16* SL = (LAS bf16*)(lds + 88064);
    LAS bf16* Pw = (LAS bf16*)(lds + 122880 + wave * 2304);
    const int g = lane >> 4, c16 = lane & 15, mt = wave & 3, cw = wave >> 2;
    for (int item = vcu; item < 256; item += G) {
        const int dir = item >> 7, b = (item >> 4) & 7, h = (item >> 2) & 3, eb = item & 3;
        const bf16* qsrc = dir == 0 ? P + h * 128 : QKR + h * 128; const int qld = dir == 0 ? N_C : 1024;
        const bf16* vsrc = P + 1024 + h * 256 + 64 * eb;
        const float* etp = ET + ((size_t)((dir * 8 + b) * 4 + h) * NCH) * 128 + 16 * wave + c16;
        bf16* odb = od_row_base(ws, dir, b) + h * 256 + 64 * eb;
        f32x4 acc[4];
#pragma unroll
        for (int et = 0; et < 4; ++et) acc[et] = (f32x4){0.f, 0.f, 0.f, 0.f};
        v4u qreg[2][2], kreg[2][2], vreg[2]; float etn[2];
#define GLA_JOF(sc_) (dir == 0 ? (sc_) : ((sc_) < 4 ? 3 - (sc_) : 71 - (sc_)))
#define GLA_PREFETCH(sc0_) do { _Pragma("unroll") for (int u = 0; u < 2; ++u) { const int jj = GLA_JOF((sc0_) + u); const int row0 = b * PB + jj * 64; \
            _Pragma("unroll") for (int i = 0; i < 2; ++i) { const int cidx = tid + 512 * i, rr = cidx >> 4, ch = cidx & 15; const bf16* sp = qsrc + (size_t)(row0 + rr) * qld + ch * 8; qreg[u][i] = *(const v4u*)sp; kreg[u][i] = *(const v4u*)(sp + 512); } \
            vreg[u] = *(const v4u*)(vsrc + (size_t)(row0 + (tid >> 3)) * N_C + (tid & 7) * 8); etn[u] = etp[(size_t)jj * 128]; } } while (0)
        GLA_PREFETCH(0);
        unsigned opk[8]; int ojc = -1;
#pragma unroll
        for (int i = 0; i < 8; ++i) opk[i] = 0u;
        for (int sc = 0; sc < NCH; sc += 2) {
            const int ja = GLA_JOF(sc), jb = GLA_JOF(sc + 1);
            __syncthreads();
            if (ojc >= 4 && !dry) {
#pragma unroll
                for (int nt = 0; nt < 4; ++nt) { bf16* orow = odb + (size_t)((ojc - 4) * 64 + 16 * mt + 4 * g) * 1024 + 16 * nt + c16;
#pragma unroll
                    for (int r = 0; r < 4; ++r) orow[(size_t)r * 1024] = (bf16)((opk[2 * nt + (r >> 1)] >> (16 * (r & 1))) & 0xffffu); } }
#pragma unroll
            for (int u = 0; u < 2; ++u) {
#pragma unroll
                for (int i = 0; i < 2; ++i) { const int cidx = tid + 512 * i, rr = cidx >> 4, ch = cidx & 15; *(LAS v4u*)(Qt + u * 8704 + rr * 136 + ch * 8) = qreg[u][i]; *(LAS v4u*)(Kt + u * 8704 + rr * 136 + ch * 8) = kreg[u][i]; }
                *(LAS v4u*)(Vt + u * 4608 + (tid >> 3) * 72 + (tid & 7) * 8) = vreg[u]; }
#pragma unroll
            for (int et = 0; et < 4; ++et)
#pragma unroll
                for (int r = 0; r < 4; ++r) SL[(16 * et + 4 * g + r) * 136 + 16 * wave + c16] = (bf16)f2bf(acc[et][r]);
            const float et_a = etn[0], et_b = etn[1];
            if (sc + 2 < NCH) GLA_PREFETCH(sc + 2);
            __syncthreads();
#pragma unroll
            for (int ks = 0; ks < 2; ++ks) { const bf16x8 kb = frag_tr(Kt, 136, 32 * ks, 16 * wave, lane);
#pragma unroll
                for (int et = 0; et < 4; ++et) acc[et] = mma(frag_tr(Vt, 72, 32 * ks, 16 * et, lane), kb, acc[et]); }
#pragma unroll
            for (int et = 0; et < 4; ++et) { acc[et] = acc[et] * et_a;
#pragma unroll
                for (int r = 0; r < 4; ++r) SL[8704 + (16 * et + 4 * g + r) * 136 + 16 * wave + c16] = (bf16)f2bf(acc[et][r]); }
            __syncthreads();
            const int jc = cw == 0 ? ja : jb;
            ojc = jc;
            if (jc >= 4) {
                const LAS bf16* Qc = Qt + cw * 8704; const LAS bf16* Kc = Kt + cw * 8704; const LAS bf16* Vc = Vt + cw * 4608; const LAS bf16* Sc = SL + cw * 8704;
                bf16x8 qf[4];
#pragma unroll
                for (int ks = 0; ks < 4; ++ks) qf[ks] = frag_row(Qc, 136, 16 * mt, 32 * ks, lane);
                bf16x8 pa[2];
                { f32x4 st[4];
#pragma unroll
                  for (int ns = 0; ns < 4; ++ns) { st[ns] = (f32x4){0.f, 0.f, 0.f, 0.f};
#pragma unroll
                      for (int ks = 0; ks < 4; ++ks) st[ns] = mma(frag_row(Kc, 136, 16 * ns, 32 * ks, lane), qf[ks], st[ns]);
#pragma unroll
                      for (int r = 0; r < 4; ++r) { const int sidx = 16 * ns + 4 * g + r, t = 16 * mt + c16; const bool ok = dir == 0 ? (sidx <= t) : (sidx >= t); st[ns][r] = ok ? st[ns][r] : 0.f; } }
#pragma unroll
                  for (int ks2 = 0; ks2 < 2; ++ks2) { const v4u wv = (v4u){pk2(st[2 * ks2][0], st[2 * ks2][1]), pk2(st[2 * ks2][2], st[2 * ks2][3]), pk2(st[2 * ks2 + 1][0], st[2 * ks2 + 1][1]), pk2(st[2 * ks2 + 1][2], st[2 * ks2 + 1][3])};
                      pa[ks2] = __builtin_bit_cast(bf16x8, wv); } }
#pragma unroll
                for (int nt = 0; nt < 4; ++nt) { f32x4 a = (f32x4){0.f, 0.f, 0.f, 0.f};
#pragma unroll
                    for (int ks = 0; ks < 4; ++ks) a = mma(qf[ks], frag_row(Sc, 136, 16 * nt, 32 * ks, lane), a);
                    a = mma(pa[0], frag_tr_perm(Vc, 72, 0, 16 * nt, lane), a); a = mma(pa[1], frag_tr_perm(Vc, 72, 32, 16 * nt, lane), a);
                    opk[2 * nt] = pk2(a[0], a[1]); opk[2 * nt + 1] = pk2(a[2], a[3]); }
                LDS_FENCE();
            }
#pragma unroll
            for (int ks = 0; ks < 2; ++ks) { const bf16x8 kb = frag_tr(Kt + 8704, 136, 32 * ks, 16 * wave, lane);
#pragma unroll
                for (int et = 0; et < 4; ++et) acc[et] = mma(frag_tr(Vt + 4608, 72, 32 * ks, 16 * et, lane), kb, acc[et]); }
#pragma unroll
            for (int et = 0; et < 4; ++et) acc[et] = acc[et] * et_b;
        }
        if (ojc >= 4 && !dry) {
#pragma unroll
            for (int nt = 0; nt < 4; ++nt) { bf16* orow = odb + (size_t)((ojc - 4) * 64 + 16 * mt + 4 * g) * 1024 + 16 * nt + c16;
#pragma unroll
                for (int r = 0; r < 4; ++r) orow[(size_t)r * 1024] = (bf16)((opk[2 * nt + (r >> 1)] >> (16 * (r & 1))) & 0xffffu); } }
#undef GLA_PREFETCH
#undef GLA_JOF
    }
}
__device__ __forceinline__ void gla_merge(bf16* P, const float* norm_w, unsigned char* ws, int gw, int NGW, int lane, int dry) {
    for (int i = gw; i < NB * SEQ; i += NGW) {
        const int b = i >> 12, lp = i & 4095; const size_t r = (size_t)b * PB + LC + lp;
        const bf16* of = od_row_base(ws, 0, b) + (size_t)lp * 1024 + 16 * lane; const bf16* orv = od_row_base(ws, 1, b) + (size_t)lp * 1024 + 16 * lane;
        bf16* grow = P + r * N_C + 2048 + 16 * lane;
        float x[16], y[16], gg[16];
        unpack8(*(const v4u*)of, x); unpack8(*(const v4u*)(of + 8), x + 8); unpack8(*(const v4u*)orv, y); unpack8(*(const v4u*)(orv + 8), y + 8);
        unpack8(*(const v4u*)grow, gg); unpack8(*(const v4u*)(grow + 8), gg + 8);
        float ss = 0.f;
#pragma unroll
        for (int k = 0; k < 16; ++k) { x[k] += y[k]; ss += x[k] * x[k]; }
        ss = gsum16(ss);
        const float rn = 1.f / sqrtf(ss * (1.f / 256.f) + LN_EPS);
        unsigned ow[8];
#pragma unroll
        for (int k = 0; k < 8; ++k) { const float4 dummy = make_float4(0.f, 0.f, 0.f, 0.f); (void)dummy;
            const float a = x[2 * k] * rn * norm_w[16 * lane + 2 * k] * siluf_(gg[2 * k]), c = x[2 * k + 1] * rn * norm_w[16 * lane + 2 * k + 1] * siluf_(gg[2 * k + 1]); ow[k] = pk2(a, c); }
        if (!dry) { v4u o0, o1; o0.x = ow[0]; o0.y = ow[1]; o0.z = ow[2]; o0.w = ow[3]; o1.x = ow[4]; o1.y = ow[5]; o1.z = ow[6]; o1.w = ow[7]; *(v4u*)grow = o0; *(v4u*)(grow + 8) = o1; }
    }
}

__device__ __forceinline__ void mlstm_fused_scan(const bf16* P, unsigned char* ws, LAS unsigned char* lds, int vcu, int G, int wave, int lane, int tid) {
    const float* BQ = (const float*)(ws + WS_BQ); const float* CQ = (const float*)(ws + WS_CQ); const float* EM = (const float*)(ws + WS_EM); const float* AI = (const float*)(ws + WS_AI);
    const float* AST = (const float*)(ws + WS_AST); const float* CL = (const float*)(ws + WS_CL);
    LAS bf16* Qt = (LAS bf16*)lds;
    LAS bf16* Kt = (LAS bf16*)(lds + 17408);
    LAS bf16* Vt = (LAS bf16*)(lds + 34816);
    LAS bf16* Vw = (LAS bf16*)(lds + 41984);
    LAS bf16* CT = (LAS bf16*)(lds + 49152);
    LAS bf16* Pw = (LAS bf16*)(lds + 62208 + wave * 2304);
    const int g = lane >> 4, c16 = lane & 15, mt = wave & 3, hf = wave >> 2;
    const int vrow = tid < 256 ? (tid >> 2) : ((tid - 256) & 63), vch = tid & 3;
    for (int item = vcu; item < 256; item += G) {
        const int dir = item >> 7, b = (item >> 4) & 7, h = (item >> 2) & 3, eb = item & 3;
        const int chain = dir * 32 + b * 4 + h;
        const bf16* qsrc = P + h * 128; const bf16* vsrc = P + 1024 + h * 128 + 32 * eb;
        bf16* odb = (bf16*)(ws + WS_ST) + (size_t)dir * TT * 512 + h * 128 + 32 * eb;
        f32x4 acc[3];
#pragma unroll
        for (int et = 0; et < 3; ++et) acc[et] = (f32x4){0.f, 0.f, 0.f, 0.f};
        v4u qreg[2], kreg[2], vreg; float bqr, cln, astn, cqn; f32x4 bqn[4], ain, emn;
        { const int j0 = dir == 0 ? 0 : 3; const int row0 = b * PB + j0 * 64; const size_t tb = (size_t)chain * PB + j0 * 64;
#pragma unroll
          for (int i = 0; i < 2; ++i) { const int cidx = tid + 512 * i, rr = cidx >> 4, ch = cidx & 15; const bf16* s = qsrc + (size_t)(row0 + rr) * N_AB + ch * 8; qreg[i] = *(const v4u*)s; kreg[i] = *(const v4u*)(s + 512); }
          vreg = *(const v4u*)(vsrc + (size_t)(row0 + vrow) * N_AB + vch * 8); bqr = BQ[tb + vrow]; cln = CL[chain * NCH + j0]; astn = AST[chain * NCH + j0];
#pragma unroll
          for (int k = 0; k < 4; ++k) bqn[k] = *(const f32x4*)(BQ + tb + 16 * k + 4 * g);
          cqn = CQ[tb + 16 * mt + c16]; ain = *(const f32x4*)(AI + tb + 16 * mt + 4 * g); emn = *(const f32x4*)(EM + tb + 16 * mt + 4 * g); }
        for (int sc = 0; sc < NCH; ++sc) {
            const int j = dir == 0 ? sc : (sc < 4 ? 3 - sc : 71 - sc);
            __syncthreads();
#pragma unroll
            for (int i = 0; i < 2; ++i) { const int cidx = tid + 512 * i, rr = cidx >> 4, ch = cidx & 15; *(LAS v4u*)(Qt + rr * 136 + ch * 8) = qreg[i]; *(LAS v4u*)(Kt + rr * 136 + ch * 8) = kreg[i]; }
            { const float wsv = __expf(bqr - cln);
              if (tid < 256) { const v4u raw = vreg; v4u o;
                  o.x = pk2(bflo(raw.x) * wsv, bfhi(raw.x) * wsv); o.y = pk2(bflo(raw.y) * wsv, bfhi(raw.y) * wsv); o.z = pk2(bflo(raw.z) * wsv, bfhi(raw.z) * wsv); o.w = pk2(bflo(raw.w) * wsv, bfhi(raw.w) * wsv);
                  *(LAS v4u*)(Vt + vrow * 56 + vch * 8) = raw; *(LAS v4u*)(Vw + vrow * 56 + vch * 8) = o;
              } else if (tid < 320) { v4u o; o.x = 0x3f80u; o.y = 0u; o.z = 0u; o.w = 0u; *(LAS v4u*)(Vt + vrow * 56 + 32) = o; o.x = f2bf(wsv); *(LAS v4u*)(Vw + vrow * 56 + 32) = o;
                  o.x = 0u; *(LAS v4u*)(Vt + vrow * 56 + 40) = o; *(LAS v4u*)(Vw + vrow * 56 + 40) = o; } }
#pragma unroll
            for (int et = 0; et < 3; ++et)
#pragma unroll
                for (int r = 0; r < 4; ++r) CT[(16 * et + 4 * g + r) * 136 + 16 * wave + c16] = (bf16)f2bf(acc[et][r]);
            const float ast = astn, cqt = cqn; f32x4 bq[4]; const f32x4 ai = ain, em = emn;
#pragma unroll
            for (int k = 0; k < 4; ++k) bq[k] = bqn[k];
            if (sc + 1 < NCH) { const int sn = sc + 1; const int jn = dir == 0 ? sn : (sn < 4 ? 3 - sn : 71 - sn); const int row0 = b * PB + jn * 64; const size_t tb = (size_t)chain * PB + jn * 64;
#pragma unroll
                for (int i = 0; i < 2; ++i) { const int cidx = tid + 512 * i, rr = cidx >> 4, ch = cidx & 15; const bf16* s = qsrc + (size_t)(row0 + rr) * N_AB + ch * 8; qreg[i] = *(const v4u*)s; kreg[i] = *(const v4u*)(s + 512); }
                vreg = *(const v4u*)(vsrc + (size_t)(row0 + vrow) * N_AB + vch * 8); bqr = BQ[tb + vrow]; cln = CL[chain * NCH + jn]; astn = AST[chain * NCH + jn];
#pragma unroll
                for (int k = 0; k < 4; ++k) bqn[k] = *(const f32x4*)(BQ + tb + 16 * k + 4 * g);
                cqn = CQ[tb + 16 * mt + c16]; ain = *(const f32x4*)(AI + tb + 16 * mt + 4 * g); emn = *(const f32x4*)(EM + tb + 16 * mt + 4 * g); }
            __syncthreads();
            bf16x8 qf[4];
#pragma unroll
            for (int ks = 0; ks < 4; ++ks) qf[ks] = frag_row(Qt, 136, 16 * mt, 32 * ks, lane);
            bf16x8 pa[2];
            { f32x4 st[4];
#pragma unroll
              for (int ns = 0; ns < 4; ++ns) { st[ns] = (f32x4){0.f, 0.f, 0.f, 0.f};
#pragma unroll
                  for (int ks = 0; ks < 4; ++ks) st[ns] = mma(frag_row(Kt, 136, 16 * ns, 32 * ks, lane), qf[ks], st[ns]);
#pragma unroll
                  for (int r = 0; r < 4; ++r) { const int sidx = 16 * ns + 4 * g + r, t = 16 * mt + c16; const bool ok = dir == 0 ? (sidx <= t) : (sidx >= t);
                      st[ns][r] = ok ? st[ns][r] * __expf(bq[ns][r] - cqt) : 0.f; } }
#pragma unroll
              for (int ks2 = 0; ks2 < 2; ++ks2) { const v4u wv = (v4u){pk2(st[2 * ks2][0], st[2 * ks2][1]), pk2(st[2 * ks2][2], st[2 * ks2][3]), pk2(st[2 * ks2 + 1][0], st[2 * ks2 + 1][1]), pk2(st[2 * ks2 + 1][2], st[2 * ks2 + 1][3])};
                  pa[ks2] = __builtin_bit_cast(bf16x8, wv); } }
            f32x4 av, ad;
            { f32x4 a = (f32x4){0.f, 0.f, 0.f, 0.f}, d = (f32x4){0.f, 0.f, 0.f, 0.f};
#pragma unroll
              for (int ks = 0; ks < 4; ++ks) { a = mma(qf[ks], frag_row(CT, 136, 16 * hf, 32 * ks, lane), a); d = mma(qf[ks], frag_row(CT, 136, 32, 32 * ks, lane), d); }
#pragma unroll
              for (int r = 0; r < 4; ++r) { a[r] *= ai[r]; d[r] *= ai[r]; }
#pragma unroll
              for (int ks = 0; ks < 2; ++ks) { a = mma(pa[ks], frag_tr_perm(Vt, 56, 32 * ks, 16 * hf, lane), a); d = mma(pa[ks], frag_tr_perm(Vt, 56, 32 * ks, 32, lane), d); }
              av = a; ad = d; }
            { bf16* orow = odb + (size_t)(b * PB + j * 64 + 16 * mt + 4 * g) * 512 + 16 * hf + c16;
#pragma unroll
              for (int r = 0; r < 4; ++r) { const float den = __shfl(ad[r], lane & 48); orow[(size_t)r * 512] = (bf16)f2bf(av[r] / fmaxf(fabsf(den), em[r])); } }
#pragma unroll
            for (int et = 0; et < 3; ++et) acc[et] = acc[et] * ast;
#pragma unroll
            for (int ks = 0; ks < 2; ++ks) { const bf16x8 kb = frag_tr(Kt, 136, 32 * ks, 16 * wave, lane);
#pragma unroll
                for (int et = 0; et < 3; ++et) acc[et] = mma(frag_tr(Vw, 56, 32 * ks, 16 * et, lane), kb, acc[et]); }
        }
    }
}
__device__ __forceinline__ void mlstm_merge(const bf16* P, bf16* CAT, const float* norm_w, unsigned char* ws, int gw, int NGW, int lane) {
    const bf16* OD = (const bf16*)(ws + WS_ST);
    for (int r = gw; r < TT; r += NGW) {
        float x[8], y[8], og[8];
        unpack8(*(const v4u*)(OD + (size_t)r * 512 + 8 * lane), x); unpack8(*(const v4u*)(OD + (size_t)TT * 512 + (size_t)r * 512 + 8 * lane), y);
        unpack8(*(const v4u*)(P + (size_t)r * N_AB + 1536 + 8 * lane), og);
        float ss = 0.f;
#pragma unroll
        for (int k = 0; k < 8; ++k) { x[k] += y[k]; ss += x[k] * x[k]; }
        ss = gsum16(ss);
        const float rn = 1.f / sqrtf(ss * (1.f / 128.f) + LN_EPS);
        unsigned ow[4];
#pragma unroll
        for (int k = 0; k < 4; ++k) ow[k] = pk2(x[2 * k] * rn * norm_w[8 * lane + 2 * k] * sigmoidf_(og[2 * k]), x[2 * k + 1] * rn * norm_w[8 * lane + 2 * k + 1] * sigmoidf_(og[2 * k + 1]));
        v4u o; o.x = ow[0]; o.y = ow[1]; o.z = ow[2]; o.w = ow[3]; *(v4u*)(CAT + (size_t)r * D + 8 * lane) = o;
    }
}

#ifndef PHMASK
#define PHMASK 0xffffffffu
#endif
#define PH(k) ((PHMASK >> (k)) & 1u)
#ifndef REPMASK
#define REPMASK 0u
#endif
#define REPS(k) (1 + (int)((REPMASK >> (k)) & 1u))
#if REPMASK
#define DRYV(k) ({ int d_ = (rep_ + 1 < REPS(k)) ? 1 : 0; asm volatile("" : "+s"(d_)); d_; })
#else
#define DRYV(k) 0
#endif
#ifndef DBG_LEVEL
#define DBG_LEVEL 3
#endif
typedef const __attribute__((address_space(4))) Args* KArgsP;
__device__ __forceinline__ KArgsP kargs() { KArgsP p = (KArgsP)__builtin_amdgcn_kernarg_segment_ptr(); asm volatile("" : "+s"(p)); return p; }
#define WSP(off) (ws + (off))
__global__ void __launch_bounds__(512, 2) fwd_megakernel(Args A_unused) {
    extern __shared__ __attribute__((aligned(16))) unsigned char lds_raw[];
    LAS unsigned char* lds = (LAS unsigned char*)lds_raw;
    const int tid0 = threadIdx.x;
    const int G = gridDim.x; const int bx = blockIdx.x; const int vcu = (G % 8 == 0) ? (bx % 8) * (G / 8) + bx / 8 : bx;
    const int NGW = G * 8;
    volatile LAS unsigned* MISC = (volatile LAS unsigned*)(lds + MISC_OFF);
    if (tid0 < 16) MISC[tid0] = 0u;
    __syncthreads();
    XcdBarrier bar;
    { KArgsP ap = kargs(); bar = xcd_barrier_post((unsigned*)(ap->ws + WS_CTL) + 1024, MISC + 8); }
#define GRID_BAR() xcd_barrier(bar)
#define PROLOG KArgsP ap = kargs(); unsigned char* ws = ap->ws; (void)ws; int tid = tid0; asm volatile("" : "+v"(tid)); const int lane = tid & 63, wave = __builtin_amdgcn_readfirstlane(tid >> 6), gw = vcu * 8 + wave; (void)lane; (void)wave; (void)gw;

    if (PH(0)) for (int rep_ = 0; rep_ < REPS(0); ++rep_) { int tid = tid0; asm volatile("" : "+v"(tid)); const int lane = tid & 63, wave = __builtin_amdgcn_readfirstlane(tid >> 6); Args A; { KArgsP ap = kargs();
#pragma unroll
        for (int i = 0; i < 22; ++i) A.in[i] = ap->in[i];
        A.out = ap->out; A.ws = ap->ws; }
        p0_prologue(A, lds, vcu, G, wave, lane, tid); }
    GRID_BAR();

    if (PH(1)) for (int rep_ = 0; rep_ < REPS(1); ++rep_) { PROLOG h_phase<16>(ap->in[I_X], ap->in[I_CTX], (const float*)WSP(WS_MOD), (bf16*)WSP(WS_HB), (const float*)WSP(WS_WG), (float*)WSP(WS_GL), lds, vcu, G, wave, lane, tid); }
    GRID_BAR();
    if (PH(2)) for (int rep_ = 0; rep_ < REPS(2); ++rep_) { PROLOG pg8::Gemm g{(const bf16*)WSP(WS_HB), (const bf16*)WSP(WS_WAB), TT, N_AB, 1024, 1024, 1024}; pg8::StaticOrder S; S.init(TT, N_AB, G, bx);
      pg8::EpiBf16 E{(bf16*)WSP(WS_P), N_AB}; pg8::gemm_phase<pg8::EpiBf16, pg8::StaticOrder>(lds, g, S, E, tid); }
    GRID_BAR();
#if DBG_LEVEL >= 2
    if (PH(3)) for (int rep_ = 0; rep_ < REPS(3); ++rep_) { PROLOG mlstm_gate_scan((const float*)WSP(WS_GL), ap->in[I_ABGB], ws, gw, NGW, lane); }
    if (PH(4)) for (int rep_ = 0; rep_ < REPS(4); ++rep_) { PROLOG attn_phase((const bf16*)WSP(WS_P), (bf16*)WSP(WS_HB), ap->in[I_ABSINK], (const float*)WSP(WS_ROPE), lds, (unsigned*)WSP(WS_CTL) + 6144 + 64 * rep_, vcu, G, wave, lane, tid); }
    GRID_BAR();
    if (PH(5)) for (int rep_ = 0; rep_ < REPS(5); ++rep_) { PROLOG mlstm_fused_scan((const bf16*)WSP(WS_P), ws, lds, vcu, G, wave, lane, tid); }
    GRID_BAR();
    if (PH(6)) for (int rep_ = 0; rep_ < REPS(6); ++rep_) { PROLOG mlstm_merge((const bf16*)WSP(WS_P), (bf16*)WSP(WS_HB), ap->in[I_ABNW], ws, gw, NGW, lane); }
    GRID_BAR();
#endif
    if (PH(7)) for (int rep_ = 0; rep_ < REPS(7); ++rep_) { PROLOG pg8::Gemm g{(const bf16*)WSP(WS_HB), (const bf16*)WSP(WS_WABO), TT, 1024, 1024, 1024, 1024}; pg8::StaticOrder S; S.init(TT, 1024, G, bx);
      pg8::EpiBf16 E{(bf16*)WSP(WS_P), 1024}; pg8::gemm_phase<pg8::EpiBf16, pg8::StaticOrder>(lds, g, S, E, tid); }
    GRID_BAR();
    if (PH(8)) for (int rep_ = 0; rep_ < REPS(8); ++rep_) { PROLOG ln_phase(ap->in[I_X], ap->in[I_CTX], ap->out, (float*)WSP(WS_XC), (const bf16*)WSP(WS_P), (const float*)WSP(WS_MOD), ap->in[I_LNW], ap->in[I_LNB], (bf16*)WSP(WS_HB), gw, NGW, lane, DRYV(8), false); }
    GRID_BAR();
#if DBG_LEVEL >= 3
    if (PH(9)) for (int rep_ = 0; rep_ < REPS(9); ++rep_) { PROLOG pg8::Gemm g{(const bf16*)WSP(WS_HB), (const bf16*)WSP(WS_WQ0), TT, 2048, 1024, 1024, 1024}; pg8::StaticOrder S; S.init(TT, 2048, G, bx);
      pg8::EpiBf16 E{(bf16*)WSP(WS_P), 2048}; pg8::gemm_phase<pg8::EpiBf16, pg8::StaticOrder>(lds, g, S, E, tid); }
    GRID_BAR();
    if (PH(10)) for (int rep_ = 0; rep_ < REPS(10); ++rep_) { PROLOG peer_route((const bf16*)WSP(WS_P), (const bf16*)WSP(WS_KEYS), (int*)WSP(WS_ST), (float*)WSP(WS_ST + 17 * MiB), gw, NGW, lane, false); }
    GRID_BAR();
#endif
    if (PH(11)) for (int rep_ = 0; rep_ < REPS(22); ++rep_) { PROLOG peer_pass1((const bf16*)WSP(WS_HB), (const int*)WSP(WS_ST), (const float*)WSP(WS_ST + 17 * MiB), WSP(WS_U), (const float*)WSP(WS_SCL), (const float*)WSP(WS_SCL) + 2 * NEXP, (float*)WSP(WS_ST + 34 * MiB), lds, wave, gw, NGW, lane, false); }
    if (PH(11)) for (int rep_ = 0; rep_ < REPS(11); ++rep_) { PROLOG peer_expert<(DBG_LEVEL >= 3)>((const float*)WSP(WS_ST + 34 * MiB), (const int*)WSP(WS_ST), WSP(WS_V),
        ap->out, (float*)WSP(WS_XC), (const float*)WSP(WS_MOD), ap->in[I_LNW] + 1024, ap->in[I_LNB] + 1024, lds, wave, gw, NGW, lane, DRYV(11), false); }
    GRID_BAR();

    if (PH(12)) for (int rep_ = 0; rep_ < REPS(12); ++rep_) { PROLOG h_phase<32>(ap->out, (const float*)WSP(WS_XC), (const float*)WSP(WS_MOD) + 9 * 6144, (bf16*)WSP(WS_HB), (const float*)WSP(WS_WLOW), (float*)WSP(WS_GL), lds, vcu, G, wave, lane, tid);
 }
    GRID_BAR();
    if (PH(13)) for (int rep_ = 0; rep_ < REPS(13); ++rep_) { PROLOG pg8::Gemm g{(const bf16*)WSP(WS_HB), (const bf16*)WSP(WS_WC), TT, N_C, 1024, 1024, 1024}; pg8::StaticOrder S; S.init(TT, N_C, G, bx);
      pg8::EpiBf16 E{(bf16*)WSP(WS_P), N_C}; pg8::gemm_phase<pg8::EpiBf16, pg8::StaticOrder>(lds, g, S, E, tid); }
    GRID_BAR();
#if DBG_LEVEL >= 2
    if (PH(14)) for (int rep_ = 0; rep_ < REPS(14); ++rep_) { PROLOG gla_prep((bf16*)WSP(WS_P), (bf16*)WSP(WS_HB), (const float*)WSP(WS_GL), ap->in[I_GGUP], ap->in[I_GGB], ws, lds, vcu, G, tid, DRYV(14)); }
    GRID_BAR();
    if (PH(15)) for (int rep_ = 0; rep_ < REPS(15); ++rep_) { PROLOG gla_fused_scan((const bf16*)WSP(WS_P), (const bf16*)WSP(WS_HB), ws, lds, vcu, G, wave, lane, tid, DRYV(15)); }
    GRID_BAR();
    if (PH(16)) for (int rep_ = 0; rep_ < REPS(16); ++rep_) { PROLOG gla_merge((bf16*)WSP(WS_P), ap->in[I_GNW], ws, gw, NGW, lane, DRYV(16)); }
    GRID_BAR();
#endif
    if (PH(17)) for (int rep_ = 0; rep_ < REPS(17); ++rep_) { PROLOG pg8::Gemm g{(const bf16*)WSP(WS_P) + 2048, (const bf16*)WSP(WS_WCO), TT, 1024, 1024, N_C, 1024}; pg8::LatOrder S; S.init(NB * SEQ, 1024, G, bx);
      pg8::EpiBf16 E{(bf16*)WSP(WS_HB), 1024}; pg8::gemm_phase<pg8::EpiBf16, pg8::LatOrder>(lds, g, S, E, tid); }
    GRID_BAR();
    if (PH(18)) for (int rep_ = 0; rep_ < REPS(18); ++rep_) { PROLOG ln_phase(ap->out, (const float*)WSP(WS_XC), ap->out, (float*)WSP(WS_XC), (const bf16*)WSP(WS_HB), (const float*)WSP(WS_MOD) + 9 * 6144, ap->in[I_LNW] + 2048, ap->in[I_LNB] + 2048, (bf16*)WSP(WS_HB), gw, NGW, lane, DRYV(18), true); }
    GRID_BAR();
#if DBG_LEVEL >= 3
    if (PH(19)) for (int rep_ = 0; rep_ < REPS(19); ++rep_) { PROLOG pg8::Gemm g{(const bf16*)WSP(WS_HB), (const bf16*)WSP(WS_WQ1), TT, 2048, 1024, 1024, 1024}; pg8::LatOrder S; S.init(NB * SEQ, 2048, G, bx);
      pg8::EpiBf16 E{(bf16*)WSP(WS_P), 2048}; pg8::gemm_phase<pg8::EpiBf16, pg8::LatOrder>(lds, g, S, E, tid); }
    GRID_BAR();
    if (PH(20)) for (int rep_ = 0; rep_ < REPS(20); ++rep_) { PROLOG peer_route((const bf16*)WSP(WS_P), (const bf16*)WSP(WS_KEYS) + (size_t)8 * 2 * 128 * 128, (int*)WSP(WS_ST), (float*)WSP(WS_ST + 17 * MiB), gw, NGW, lane, true); }
    GRID_BAR();
#endif
    if (PH(21)) for (int rep_ = 0; rep_ < REPS(22); ++rep_) { PROLOG peer_pass1((const bf16*)WSP(WS_HB), (const int*)WSP(WS_ST), (const float*)WSP(WS_ST + 17 * MiB), WSP(WS_U) + (size_t)NEXP * 512, (const float*)WSP(WS_SCL) + NEXP, (const float*)WSP(WS_SCL) + 3 * NEXP, (float*)WSP(WS_ST + 34 * MiB), lds, wave, gw, NGW, lane, true); }
    if (PH(21)) for (int rep_ = 0; rep_ < REPS(21); ++rep_) { PROLOG peer_expert<(DBG_LEVEL >= 3)>((const float*)WSP(WS_ST + 34 * MiB), (const int*)WSP(WS_ST), WSP(WS_V) + (size_t)NEXP * 512,
        ap->out, (float*)WSP(WS_XC), (const float*)WSP(WS_MOD) + 9 * 6144, ap->in[I_LNW] + 3072, ap->in[I_LNB] + 3072, lds, wave, gw, NGW, lane, DRYV(21), true); }
}

extern "C" void kernel_launch(void* const* d_in, const int* in_sizes, int n_in, void* d_out, int out_size, void* d_ws, size_t ws_size, hipStream_t stream) {
    static int grid = 0;
    if (grid == 0) {
        if (n_in != 22 || out_size != NB * SEQ * D || ws_size < 512 * MiB) { fprintf(stderr, "kernel_launch: unexpected shapes: n_in %d out %d ws %zu (need %zu)\n", n_in, out_size, ws_size, (size_t)WS_END); grid = -1; return; }
        int dev = 0, cus = 0, per_cu = 0;
        if (hipGetDevice(&dev) != hipSuccess || hipDeviceGetAttribute(&cus, hipDeviceAttributeMultiprocessorCount, dev) != hipSuccess) { grid = -1; return; }
        if (hipFuncSetAttribute((const void*)fwd_megakernel, hipFuncAttributeMaxDynamicSharedMemorySize, LDS_BYTES) != hipSuccess) { fprintf(stderr, "kernel_launch: hipFuncSetAttribute failed\n"); grid = -1; return; }
        if (hipOccupancyMaxActiveBlocksPerMultiprocessor(&per_cu, (const void*)fwd_megakernel, 512, LDS_BYTES) != hipSuccess || per_cu < 1) { fprintf(stderr, "kernel_launch: occupancy query says %d blocks per CU\n", per_cu); }
        (void)hipGetLastError();
        grid = cus;
        fprintf(stderr, "kernel_launch: grid %d, per_cu %d, ws %zu\n", grid, per_cu, ws_size);
    }
    if (grid < 0) return;
    if (hipMemsetAsync((char*)d_ws + WS_CTL, 0, CTL_ZERO_BYTES, stream) != hipSuccess) return;
    Args a{};
    for (int i = 0; i < 22; ++i) a.in[i] = (const float*)d_in[i];
    a.out = (float*)d_out; a.ws = (unsigned char*)d_ws;
    hipLaunchKernelGGL(fwd_megakernel, dim3(grid), dim3(512), LDS_BYTES, stream, a);
}
```

```cpp
#include <hip/hip_runtime.h>
#include <cstdio>
#include <cstdint>

#define GAS __attribute__((address_space(1)))
#define LAS __attribute__((address_space(3)))
typedef unsigned short bf16;
typedef unsigned v4u __attribute__((ext_vector_type(4)));
typedef unsigned v2u __attribute__((ext_vector_type(2)));
typedef float f32x4 __attribute__((ext_vector_type(4)));
typedef float f32x2 __attribute__((ext_vector_type(2)));
typedef short bf16x8 __attribute__((ext_vector_type(8)));
typedef short s16x4 __attribute__((ext_vector_type(4)));
typedef GAS unsigned gu32;
#define RLX_AGENT __ATOMIC_RELAXED, __HIP_MEMORY_SCOPE_AGENT

constexpr int NB = 8, SEQ = 4096, LC = 256, D = 1024;
constexpr int PB = LC + SEQ;
constexpr int TT = NB * PB;
constexpr int NCH = PB / 64;
constexpr int N_AB = 2816;
constexpr int N_C = 3072;
constexpr float LN_EPS = 1e-5f;
constexpr float DN_ALPHA = 1.41421356237f;
constexpr int NEXP = 16384;
__device__ __forceinline__ int map_row(int i, bool lat_only) { return lat_only ? (i >> 12) * 4352 + 256 + (i & 4095) : i; }

constexpr size_t MiB = 1u << 20;
constexpr size_t WS_CTL = 0, CTL_ZERO_BYTES = 64 * 1024;
constexpr size_t WS_MOD = 1 * MiB;
constexpr size_t WS_ROPE = 2 * MiB;
constexpr size_t WS_WG = 2 * MiB + 64 * 1024;
constexpr size_t WS_WLOW = 2 * MiB + 128 * 1024;
constexpr size_t WS_SCL = 3 * MiB;
constexpr size_t WS_BQ = 4 * MiB, WS_CQ = WS_BQ + 1200 * 1024, WS_EM = WS_CQ + 1200 * 1024, WS_AI = WS_EM + 1200 * 1024;
constexpr size_t WS_AST = WS_AI + 1200 * 1024, WS_CL = WS_AST + 32 * 1024;
constexpr size_t WS_ET = 10 * MiB;
constexpr size_t WS_GL = 13 * MiB;
constexpr size_t WS_WAB = 20 * MiB, WS_WABO = 26 * MiB, WS_WC = 28 * MiB, WS_WCO = 34 * MiB, WS_WQ0 = 36 * MiB, WS_WQ1 = 40 * MiB, WS_KEYS = 44 * MiB;
constexpr size_t WS_NST = 45 * MiB;
constexpr size_t WS_XC = 48 * MiB;
constexpr size_t WS_U = 56 * MiB, WS_V = 88 * MiB;
constexpr size_t WS_HB = 120 * MiB;
constexpr size_t WS_P = 188 * MiB;
constexpr size_t WS_ST = 392 * MiB;
constexpr size_t WS_END = 460 * MiB;

constexpr int LDS_BYTES = 163840;
constexpr int MISC_OFF = LDS_BYTES - 64;

__device__ __forceinline__ unsigned f2bf(float f) { unsigned u = __builtin_bit_cast(unsigned, f); return (u + 0x7fffu + ((u >> 16) & 1u)) >> 16; }
__device__ __forceinline__ unsigned pk2(float lo, float hi) { return f2bf(lo) | (f2bf(hi) << 16); }
__device__ __forceinline__ float bflo(unsigned w) { return __builtin_bit_cast(float, w << 16); }
__device__ __forceinline__ float bfhi(unsigned w) { return __builtin_bit_cast(float, w & 0xffff0000u); }
__device__ __forceinline__ float bf2f(bf16 b) { return __builtin_bit_cast(float, (unsigned)b << 16); }
template <int CTRL> __device__ __forceinline__ float dppmov_f(float x) { return __builtin_bit_cast(float, __builtin_amdgcn_mov_dpp(__builtin_bit_cast(int, x), CTRL, 0xf, 0xf, true)); }
__device__ __forceinline__ float wave_sum(float v) {
    v += dppmov_f<0xB1>(v); v += dppmov_f<0x4E>(v); v += dppmov_f<0x141>(v); v += dppmov_f<0x128>(v);
    v += __shfl_xor(v, 16); v += __shfl_xor(v, 32);
    return v;
}
__device__ __forceinline__ float sigmoidf_(float x) { return 1.f / (1.f + __expf(-x)); }
__device__ __forceinline__ float logsigmoidf_(float x) { return fminf(x, 0.f) - log1pf(__expf(-fabsf(x))); }
__device__ __forceinline__ float siluf_(float x) { return x / (1.f + __expf(-x)); }

namespace pg8 {
#define PG8_LAS __attribute__((address_space(3)))
typedef unsigned short bf16_t;
typedef short bf16x8 __attribute__((ext_vector_type(8)));
typedef float f32x4 __attribute__((ext_vector_type(4)));
typedef unsigned u32x4 __attribute__((ext_vector_type(4)));
constexpr int BM = 256, BK = 64, HALF = 128, HTB = HALF * BK * 2  , STAGE_BYTES = 8 * HTB, NXCD = 8, WGM = 8;

__host__ __device__ __forceinline__ int lds_byte(int r, int c) { const int st = (r >> 4) * 2 + (c >> 5), rr = r & 15, cc = c & 31, ob = rr * 64 + cc * 2; return st * 1024 + (ob ^ (((ob >> 9) & 1) << 5)); }
__host__ __device__ __forceinline__ void stage_rc(int b, int& R, int& C) { const int st = b / 1024, sb = b % 1024, swz = sb ^ (((sb >> 9) & 1) << 5); R = (st >> 1) * 16 + swz / 64; C = (st & 1) * 32 + (swz % 64) / 2; }
__host__ __device__ __forceinline__ int perm32(int rho) { const int n = rho >> 4, i = rho & 15; return 8 * (i >> 2) + 4 * n + (i & 3); }

struct Unit { int pm, pn; };
struct Gemm { const bf16_t* A; const bf16_t* Bt; int M, N, K, lda, ldb; };

struct StaticOrder {
    int nM, nN, nwg, G, c;
    __host__ __device__ void init(int M, int N, int G_, int c_) { nM = M / BM; nN = N / BM; nwg = nM * nN; G = G_; c = c_; }
    __host__ __device__ bool next(int i, Unit& u) const {
        const long L = (long)i * G + c; if (L >= nwg) return false;
        int wgid = (int)L; { const int q = nwg / NXCD, r = nwg % NXCD, xcd = wgid % NXCD, off = wgid / NXCD; wgid = (xcd < r ? xcd * (q + 1) : r * (q + 1) + (xcd - r) * q) + off; }
        const int nig = WGM * nN, gid = wgid / nig, fm = gid * WGM, gsz = (nM - fm) < WGM ? (nM - fm) : WGM;
        u.pm = fm + ((wgid % nig) % gsz); u.pn = (wgid % nig) / gsz; return true;
    }
    __device__ __forceinline__ void a_ready(const Unit&) const {}
    __device__ __forceinline__ void done(const Unit&) const {}
};

struct LatOrder : StaticOrder {
    __host__ __device__ bool next(int i, Unit& u) const { if (!StaticOrder::next(i, u)) return false; u.pm = (u.pm >> 4) * 17 + 1 + (u.pm & 15); return true; }
};
__device__ __forceinline__ unsigned cvt_pk_bf16(float lo, float hi) { unsigned r; asm volatile("v_cvt_pk_bf16_f32 %0, %1, %2" : "=v"(r) : "v"(lo), "v"(hi)); return r; }
struct EpiBf16 {
    static constexpr bool PERM = true, AFTER_DRAIN = false;
    bf16_t* O; int ldc;
    __device__ __forceinline__ void operator()(const f32x4 (&acc)[2][2][4][2], const Unit& u, int wr, int wc, int fr, int fq) const {
        const int row0 = u.pm * BM + wr * 64 + fr; const int col0 = u.pn * BM + wc * 32 + 8 * fq;
#pragma unroll
        for (int ai = 0; ai < 2; ++ai)
#pragma unroll
            for (int m = 0; m < 4; ++m) { bf16_t* rowp = O + (size_t)(row0 + ai * HALF + m * 16) * ldc + col0;
#pragma unroll
                for (int bj = 0; bj < 2; ++bj) { const f32x4 v0 = acc[ai][bj][m][0], v1 = acc[ai][bj][m][1];
                    u32x4 w; w.x = cvt_pk_bf16(v0[0], v0[1]); w.y = cvt_pk_bf16(v0[2], v0[3]); w.z = cvt_pk_bf16(v1[0], v1[1]); w.w = cvt_pk_bf16(v1[2], v1[3]);
                    *(u32x4*)(rowp + bj * HALF) = w; } }
    }
};
struct EpiResid {
    static constexpr bool PERM = false, AFTER_DRAIN = false;
    const float* src_lat; const float* src_ctx; float* dst_lat; float* dst_ctx; const float* gate; float gscale; int dry;
    __device__ __forceinline__ void operator()(const f32x4 (&acc)[2][2][4][2], const Unit& u, int wr, int wc, int fr, int fq) const {
        const int b = u.pm / 17, tb = u.pm - b * 17;
        const float* sbase; float* dbase; const float* gr;
        if (tb == 0) { sbase = src_ctx + (size_t)b * 256 * 1024; dbase = dst_ctx + (size_t)b * 256 * 1024; gr = gate + 8 * 6144; }
        else { sbase = src_lat + ((size_t)b * 4096 + (size_t)(tb - 1) * 256) * 1024; dbase = dst_lat + ((size_t)b * 4096 + (size_t)(tb - 1) * 256) * 1024; gr = gate + b * 6144; }
        const int row0 = wr * 64 + fr, col0 = u.pn * BM + wc * 32 + 4 * fq;
        f32x4 gv[2][2];
#pragma unroll
        for (int bj = 0; bj < 2; ++bj)
#pragma unroll
            for (int n = 0; n < 2; ++n) gv[bj][n] = *(const f32x4*)(gr + col0 + bj * HALF + n * 16) * gscale;
#pragma unroll
        for (int ai = 0; ai < 2; ++ai)
#pragma unroll
            for (int mp = 0; mp < 2; ++mp) {
                f32x4 sv[2][2][2];
#pragma unroll
                for (int mm = 0; mm < 2; ++mm) { const size_t off = (size_t)(row0 + ai * HALF + (2 * mp + mm) * 16) * 1024 + col0;
#pragma unroll
                    for (int bj = 0; bj < 2; ++bj)
#pragma unroll
                        for (int n = 0; n < 2; ++n) sv[mm][bj][n] = __builtin_nontemporal_load((const f32x4*)(sbase + off + bj * HALF + n * 16)); }
                asm volatile("" ::: "memory");
#pragma unroll
                for (int mm = 0; mm < 2; ++mm) { const int m = 2 * mp + mm; const size_t off = (size_t)(row0 + ai * HALF + m * 16) * 1024 + col0;
#pragma unroll
                    for (int bj = 0; bj < 2; ++bj)
#pragma unroll
                        for (int n = 0; n < 2; ++n) { const f32x4 ov = sv[mm][bj][n] * 1.41421356237f + gv[bj][n] * acc[ai][bj][m][n]; if (!dry) *(f32x4*)(dbase + off + bj * HALF + n * 16) = ov; } }
                asm volatile("" ::: "memory");
            }
    }
};

template <class Epi, class Sched>
__device__ __forceinline__ void gemm_phase(PG8_LAS unsigned char* lds, const Gemm g, const Sched& S, const Epi& E, const int tid_in) {
    const int tid = tid_in, wid = __builtin_amdgcn_readfirstlane(tid >> 6), lane = tid & 63, wr = wid >> 2, wc = wid & 3, fr = lane & 15, fq = lane >> 4;
    const int K = g.K, nt = K / BK;
    unsigned voffA[2], voffB[2];
#pragma unroll
    for (int i = 0; i < 2; ++i) { int R, C; stage_rc(tid * 16 + i * 8192, R, C); const int Rb = Epi::PERM ? ((R & ~31) + perm32(R & 31)) : R;
        voffA[i] = (unsigned)(R * g.lda + C) * 2u; voffB[i] = (unsigned)(Rb * g.ldb + C) * 2u; }
    const size_t kstep = (size_t)(BK * 2);
    const size_t hstepA = (size_t)HALF * g.lda * 2, hstepB = (size_t)HALF * g.ldb * 2;
    const size_t tstepA = 2 * hstepA, tstepB = 2 * hstepB;
    const unsigned ldsw = (unsigned)wid * 1024u;
    const int aoff = lds_byte(wr * 64 + fr, fq * 8), boff = lds_byte(wc * 32 + fr, fq * 8);
#define PG8_SA(b, h) (((b) * 2 + (h)) * HTB)
#define PG8_SB(b, h) ((4 + (b) * 2 + (h)) * HTB)
#define PG8_STAGE(bufoff, gbase, voff) do { _Pragma("unroll") for (int _i = 0; _i < 2; ++_i) \
        __builtin_amdgcn_global_load_lds((const unsigned*)((const char*)(gbase) + (voff)[_i]), (PG8_LAS unsigned*)(lds + (bufoff) + ldsw + _i * 8192), 16, 0, 0); } while (0)
#define PG8_LDA(dst, b, h) do { _Pragma("unroll") for (int m = 0; m < 4; ++m) _Pragma("unroll") for (int k = 0; k < 2; ++k) dst[m][k] = *(const PG8_LAS bf16x8*)(lds + PG8_SA(b, h) + aoff + m * 2048 + k * 1024); } while (0)
#define PG8_LDB(dst, b, h) do { _Pragma("unroll") for (int n = 0; n < 2; ++n) _Pragma("unroll") for (int k = 0; k < 2; ++k) dst[n][k] = *(const PG8_LAS bf16x8*)(lds + PG8_SB(b, h) + boff + n * 2048 + k * 1024); } while (0)
#define PG8_MMA(ai, bj, At, Bt) do { __builtin_amdgcn_s_setprio(1); _Pragma("unroll") for (int m = 0; m < 4; ++m) _Pragma("unroll") for (int n = 0; n < 2; ++n) _Pragma("unroll") for (int k = 0; k < 2; ++k) \
        acc[ai][bj][m][n] = __builtin_amdgcn_mfma_f32_16x16x32_bf16(Bt[n][k], At[m][k], acc[ai][bj][m][n], 0, 0, 0); __builtin_amdgcn_s_setprio(0); } while (0)
#define PG8_WAIT_V(n) asm volatile("s_waitcnt vmcnt(" #n ")" ::: "memory")
#define PG8_WAIT_L(n) asm volatile("s_waitcnt lgkmcnt(" #n ")" ::: "memory")
#define PG8_BAR __builtin_amdgcn_s_barrier()
#define PG8_SCHED __builtin_amdgcn_sched_barrier(0)
    Unit cur, nxt; int ui = 0;
    if (!S.next(0, cur)) return;
    f32x4 acc[2][2][4][2];
#pragma unroll
    for (int a = 0; a < 2; ++a)
#pragma unroll
        for (int b = 0; b < 2; ++b)
#pragma unroll
            for (int m = 0; m < 4; ++m)
#pragma unroll
                for (int n = 0; n < 2; ++n) acc[a][b][m][n] = (f32x4){0.f, 0.f, 0.f, 0.f};
    bf16x8 At[4][2], B0[2][2], B1[2][2];
    const char* cA = (const char*)g.A + (size_t)cur.pm * tstepA; const char* cB = (const char*)g.Bt + (size_t)cur.pn * tstepB;
    S.a_ready(cur);
    PG8_STAGE(PG8_SB(0, 0), cB, voffB); PG8_STAGE(PG8_SA(0, 0), cA, voffA); PG8_STAGE(PG8_SB(0, 1), cB + hstepB, voffB); PG8_STAGE(PG8_SA(0, 1), cA + hstepA, voffA);
    if (wr == 1) PG8_BAR;
    PG8_WAIT_V(4); PG8_BAR;
    PG8_STAGE(PG8_SB(1, 0), cB + kstep, voffB); PG8_STAGE(PG8_SA(1, 0), cA + kstep, voffA); PG8_STAGE(PG8_SB(1, 1), cB + hstepB + kstep, voffB);
    PG8_WAIT_V(6); PG8_BAR;
    for (;;) {
        const bool has_next = S.next(ui + 1, nxt);
        const char* nA = has_next ? (const char*)g.A + (size_t)nxt.pm * tstepA : cA; const char* nB = has_next ? (const char*)g.Bt + (size_t)nxt.pn * tstepB : cB;
        for (int t = 0; t < nt; t += 2) {
            const bool last = (t == nt - 2);
            const char* a1 = cA + (size_t)(t + 1) * kstep;
            const char* a2 = last ? nA : cA + (size_t)(t + 2) * kstep; const char* b2 = last ? nB : cB + (size_t)(t + 2) * kstep;
            const char* a3 = a2 + kstep; const char* b3 = b2 + kstep;
            if (last && has_next) S.a_ready(nxt);
            PG8_LDB(B0, 0, 0); PG8_SCHED; PG8_LDA(At, 0, 0); PG8_STAGE(PG8_SA(1, 1), a1 + hstepA, voffA);
            PG8_WAIT_L(8); PG8_BAR; PG8_WAIT_L(0); PG8_MMA(0, 0, At, B0); PG8_BAR; PG8_SCHED;
            PG8_LDB(B1, 0, 1); PG8_STAGE(PG8_SB(0, 0), b2, voffB);
            PG8_BAR; PG8_WAIT_L(0); PG8_MMA(0, 1, At, B1); PG8_BAR;
            PG8_LDA(At, 0, 1); PG8_STAGE(PG8_SA(0, 0), a2, voffA);
            PG8_BAR; PG8_WAIT_L(0); PG8_MMA(1, 0, At, B0); PG8_BAR; PG8_SCHED;
            PG8_STAGE(PG8_SB(0, 1), b2 + hstepB, voffB);
            PG8_WAIT_V(6); PG8_BAR; PG8_MMA(1, 1, At, B1); PG8_BAR;
            PG8_LDB(B0, 1, 0); PG8_SCHED; PG8_LDA(At, 1, 0); PG8_STAGE(PG8_SA(0, 1), a2 + hstepA, voffA);
            PG8_WAIT_L(8); PG8_BAR; PG8_WAIT_L(0); PG8_MMA(0, 0, At, B0); PG8_BAR; PG8_SCHED;
            PG8_LDB(B1, 1, 1); PG8_STAGE(PG8_SB(1, 0), b3, voffB);
            PG8_BAR; PG8_WAIT_L(0); PG8_MMA(0, 1, At, B1); PG8_BAR;
            PG8_LDA(At, 1, 1); PG8_STAGE(PG8_SA(1, 0), a3, voffA);
            PG8_BAR; PG8_WAIT_L(0); PG8_MMA(1, 0, At, B0); PG8_BAR; PG8_SCHED;
            PG8_STAGE(PG8_SB(1, 1), b3 + hstepB, voffB);
            PG8_WAIT_V(6); PG8_BAR; PG8_MMA(1, 1, At, B1); PG8_BAR;
        }
        if constexpr (!Epi::AFTER_DRAIN) { E(acc, cur, wr, wc, fr, fq); S.done(cur); }
        if (!has_next) break;
#pragma unroll
        for (int a = 0; a < 2; ++a)
#pragma unroll
            for (int b = 0; b < 2; ++b)
#pragma unroll
                for (int m = 0; m < 4; ++m)
#pragma unroll
                    for (int n = 0; n < 2; ++n) acc[a][b][m][n] = (f32x4){0.f, 0.f, 0.f, 0.f};
        cur = nxt; cA = nA; cB = nB; ++ui;
    }
    PG8_WAIT_V(0);
    if (wr == 0) PG8_BAR;
    PG8_BAR;
    if constexpr (Epi::AFTER_DRAIN) { E.fused(acc, cur, wr, wc, fr, fq, lds, wid, lane); S.done(cur); }
#undef PG8_SA
#undef PG8_SB
#undef PG8_STAGE
#undef PG8_LDA
#undef PG8_LDB
#undef PG8_MMA
#undef PG8_WAIT_V
#undef PG8_WAIT_L
#undef PG8_BAR
#undef PG8_SCHED
}
}

#define XB_TMO      128
#define XB_XCNT(j)  (256  + 64 * (j))
#define XB_XSUB(j)  (1280 + 64 * (j))
#define XB_XGEN(j)  (2304 + 64 * (j))
#define XB_TOP      3328
#define XB_TOPGEN   3392
#define XCD_BAR_WORDS 3456
#define XB_SPIN_CAP (1u << 18)

__device__ __forceinline__ unsigned xb_ld(unsigned* p)              { return __hip_atomic_load(p, __ATOMIC_RELAXED, __HIP_MEMORY_SCOPE_AGENT); }
__device__ __forceinline__ unsigned xb_add(unsigned* p, unsigned v) { return __hip_atomic_fetch_add(p, v, __ATOMIC_RELAXED, __HIP_MEMORY_SCOPE_AGENT); }
__device__ __forceinline__ unsigned xb_xcc_id() { return (unsigned)__builtin_amdgcn_s_getreg((3 << 11) | 20) & 0xFu; }
#define XB_SPIN(cond, bar) do { unsigned _sp = 0; while (cond) { __builtin_amdgcn_s_sleep(1); \
    if ((++_sp & 255u) == 0u) { if (xb_ld(&(bar)[XB_TMO])) break; if (_sp > XB_SPIN_CAP) { atomicAdd(&(bar)[XB_TMO], 1u); break; } } } } while (0)

struct XcdBarrier {
    unsigned* bar; unsigned x;
    volatile LAS unsigned* st;
};

__device__ __forceinline__ XcdBarrier xcd_barrier_post(unsigned* bar, volatile LAS unsigned* st) {
    XcdBarrier b; b.bar = bar; b.x = xb_xcc_id(); b.st = st;
    if (threadIdx.x == 0) (void)xb_add(&bar[XB_XCNT(b.x)], 1u);
    return b;
}
__device__ __forceinline__ void xcd_barrier_complete(unsigned* bar, unsigned x, unsigned& nloc, unsigned& nx) {
    const unsigned G = gridDim.x * gridDim.y * gridDim.z;
    unsigned sum, cnt, mine, sp = 0u;
    for (;;) {
        sum = 0u; cnt = 0u; mine = 0u;
#pragma unroll
        for (unsigned j = 0; j < 16; ++j) { const unsigned c = xb_ld(&bar[XB_XCNT(j)]); sum += c; cnt += (c > 0u) ? 1u : 0u; mine = (j == x) ? c : mine; }
        if (sum == G) break;
        __builtin_amdgcn_s_sleep(1);
        if ((++sp & 255u) == 0u) { if (xb_ld(&bar[XB_TMO])) break; if (sp > XB_SPIN_CAP) { atomicAdd(&bar[XB_TMO], 1u); break; } }
    }
    nloc = mine > 0u ? mine : 1u; nx = cnt > 0u ? cnt : 1u;
}

__device__ __forceinline__ void xcd_barrier(const XcdBarrier& b) {
    asm volatile("s_waitcnt vmcnt(0)" ::: "memory");
    __syncthreads();
    if (threadIdx.x == 0) {
        unsigned* bar = b.bar;
        __builtin_amdgcn_s_waitcnt(0);
        unsigned nloc = b.st[0], nx = b.st[1];
        if (nloc == 0u) { xcd_barrier_complete(bar, b.x, nloc, nx); b.st[0] = nloc; b.st[1] = nx; }
        const unsigned old = xb_add(&bar[XB_XSUB(b.x)], 1u);
        const unsigned gen = old / nloc;
        if (old + 1u == (gen + 1u) * nloc) {
            __builtin_amdgcn_fence(__ATOMIC_RELEASE, "agent");
            asm volatile("s_waitcnt vmcnt(0)" ::: "memory");
            const unsigned og = xb_add(&bar[XB_TOP], 1u);
            const unsigned tg = og / nx;
            if (og + 1u == (tg + 1u) * nx) xb_add(&bar[XB_TOPGEN], 1u);
            else XB_SPIN(xb_ld(&bar[XB_TOPGEN]) == tg, bar);
            __builtin_amdgcn_fence(__ATOMIC_ACQUIRE, "agent");
            xb_add(&bar[XB_XGEN(b.x)], 1u);
            asm volatile("s_waitcnt vmcnt(0)" ::: "memory");
        } else {
            XB_SPIN(xb_ld(&bar[XB_XGEN(b.x)]) == gen, bar);
            __builtin_amdgcn_fence(__ATOMIC_ACQUIRE, "agent");
            asm volatile("s_waitcnt vmcnt(0)" ::: "memory");
        }
    }
    __syncthreads();
}


__device__ __forceinline__ f32x4 mma(bf16x8 a, bf16x8 b, f32x4 c) { return __builtin_amdgcn_mfma_f32_16x16x32_bf16(a, b, c, 0, 0, 0); }
__device__ __forceinline__ bf16x8 frag_row(const LAS bf16* t, int ld, int r0, int c0, int lane) {
    return *(const LAS bf16x8*)(t + (r0 + (lane & 15)) * ld + c0 + 8 * (lane >> 4));
}
__device__ __forceinline__ bf16x8 frag_tr(const LAS bf16* t, int ld, int r0, int c0, int lane) {
    const int g = lane >> 4, q = (lane & 15) >> 2, p = lane & 3;
    const LAS bf16* a = t + (r0 + 8 * g + q) * ld + c0 + 4 * p;
    const s16x4 lo = __builtin_amdgcn_ds_read_tr16_b64_v4i16((LAS s16x4*)a);
    const s16x4 hi = __builtin_amdgcn_ds_read_tr16_b64_v4i16((LAS s16x4*)(a + 4 * ld));
    return (bf16x8){lo[0], lo[1], lo[2], lo[3], hi[0], hi[1], hi[2], hi[3]};
}
#define LDS_FENCE() do { asm volatile("s_waitcnt lgkmcnt(0)" ::: "memory"); __builtin_amdgcn_wave_barrier(); } while (0)

struct Args {
    const float* in[22]; float* out; unsigned char* ws;
};
enum { I_X = 0, I_C, I_CTX, I_CCTX, I_WMOD, I_BMOD, I_LNW, I_LNB, I_ABWIN, I_ABGB, I_ABNW, I_ABSINK, I_ABWOUT, I_GWIN, I_GGUP, I_GGB, I_GNW, I_GWOUT, I_PWQ, I_PKEYS, I_PU, I_PV };

__device__ __forceinline__ const float* srow_c(const float* lat, const float* ctx, int r) { const int b = r / PB, p = r - b * PB; return p < LC ? ctx + (size_t)(b * LC + p) * D : lat + (size_t)(b * SEQ + p - LC) * D; }
__device__ __forceinline__ float* srow(float* lat, float* ctx, int r) { const int b = r / PB, p = r - b * PB; return p < LC ? ctx + (size_t)(b * LC + p) * D : lat + (size_t)(b * SEQ + p - LC) * D; }

__device__ __forceinline__ void p0_transpose_item(const float* W, int K, int ldw, int c0, int ncols, bf16* WT, int row_off, LAS float* scr, int item, int lane,
                                                  int s0lo, int s0hi, float s0, int s1lo, int s1hi, float s1) {
    const int nblk = ncols / 32, kb = item / nblk, nb = item % nblk, k0 = 64 * kb, n0 = 32 * nb;
#pragma unroll 8
    for (int i = 0; i < 32; ++i) { const int kk = 2 * i + (lane >> 5); scr[kk * 33 + (lane & 31)] = W[(size_t)(k0 + kk) * ldw + c0 + n0 + (lane & 31)]; }
    asm volatile("s_waitcnt lgkmcnt(0)" ::: "memory");
    const int c = lane & 7;
#pragma unroll
    for (int j = 0; j < 4; ++j) { const int n = (lane >> 3) + 8 * j; const LAS float* s = scr + (8 * c) * 33 + n;
        const int dr = row_off + n0 + n; float sc = 1.f; if (dr >= s0lo && dr < s0hi) sc = s0; if (dr >= s1lo && dr < s1hi) sc = s1;
        v4u o; o.x = pk2(s[0 * 33] * sc, s[1 * 33] * sc); o.y = pk2(s[2 * 33] * sc, s[3 * 33] * sc); o.z = pk2(s[4 * 33] * sc, s[5 * 33] * sc); o.w = pk2(s[6 * 33] * sc, s[7 * 33] * sc);
        *(v4u*)(WT + (size_t)dr * K + k0 + 8 * c) = o; }
    asm volatile("s_waitcnt lgkmcnt(0)" ::: "memory");
}
__device__ __forceinline__ void cvt_f32_bf16(const float* src, bf16* dst, size_t n, int gtid, int gthreads) {
    const size_t nch = n / 8;
    for (size_t i = gtid; i < nch; i += gthreads) { const f32x4 a = *(const f32x4*)(src + i * 8), b = *(const f32x4*)(src + i * 8 + 4);
        v4u o; o.x = pk2(a[0], a[1]); o.y = pk2(a[2], a[3]); o.z = pk2(b[0], b[1]); o.w = pk2(b[2], b[3]); *(v4u*)(dst + i * 8) = o; }
}
__device__ __forceinline__ void cvt_rows_fp4(const float* src, unsigned char* dst, float* inv, int nrows, int gw, int NGW, int lane) {
    const int hl = lane & 31, hh = lane >> 5;
    for (int r2 = gw; r2 < nrows / 2; r2 += NGW) {
        const int r = 2 * r2 + hh; const float* sp = src + (size_t)r * 1024 + 32 * hl;
        f32x4 x[8]; float m = 0.f;
#pragma unroll
        for (int q = 0; q < 8; ++q) { x[q] = *(const f32x4*)(sp + 4 * q); m = fmaxf(m, fmaxf(fmaxf(fabsf(x[q][0]), fabsf(x[q][1])), fmaxf(fabsf(x[q][2]), fabsf(x[q][3])))); }
        m = fmaxf(m, dppmov_f<0xB1>(m)); m = fmaxf(m, dppmov_f<0x4E>(m)); m = fmaxf(m, dppmov_f<0x141>(m)); m = fmaxf(m, dppmov_f<0x128>(m)); m = fmaxf(m, __shfl_xor(m, 16));
        const float sc = m > 0.f ? 6.0f / m : 1.f;
        unsigned w[4];
#pragma unroll
        for (int d = 0; d < 4; ++d) { unsigned t = 0u;
            t = __builtin_amdgcn_cvt_scalef32_pk_fp4_f32(t, x[2 * d][0] * sc, x[2 * d][1] * sc, 1.0f, 0); t = __builtin_amdgcn_cvt_scalef32_pk_fp4_f32(t, x[2 * d][2] * sc, x[2 * d][3] * sc, 1.0f, 1);
            t = __builtin_amdgcn_cvt_scalef32_pk_fp4_f32(t, x[2 * d + 1][0] * sc, x[2 * d + 1][1] * sc, 1.0f, 2); t = __builtin_amdgcn_cvt_scalef32_pk_fp4_f32(t, x[2 * d + 1][2] * sc, x[2 * d + 1][3] * sc, 1.0f, 3);
            w[d] = t; }
        *(v4u*)(dst + (size_t)r * 512 + 16 * hl) = (v4u){w[0], w[1], w[2], w[3]};
        if (hl == 0) inv[r] = m > 0.f ? m / 6.0f : 1.f;
    }
}
__device__ __forceinline__ void p0_prologue(const Args& A, LAS unsigned char* lds, int vcu, int G, int wave, int lane, int tid) {
    unsigned char* ws = A.ws;
    const int gw = vcu * 8 + wave, NGW = G * 8, gtid = vcu * 512 + tid, gthreads = G * 512;
    LAS float* sil = (LAS float*)lds;
    for (int i = tid; i < 9 * 1024; i += 512) { const float v = i < 8192 ? A.in[I_C][i] : A.in[I_CCTX][i - 8192]; sil[i] = siluf_(v); }
    __syncthreads();
    float* MOD = (float*)(ws + WS_MOD);
    LAS float* part = (LAS float*)(lds + 40960);
    for (int it = vcu; it < 2 * 96; it += G) {
        const int l = it / 96, n = (it % 96) * 64 + lane; const float* wm = A.in[I_WMOD] + (size_t)l * 1024 * 6144 + (size_t)(128 * wave) * 6144 + n;
        float acc[9];
#pragma unroll
        for (int r = 0; r < 9; ++r) acc[r] = 0.f;
#pragma unroll 8
        for (int k = 0; k < 128; ++k) { const float w = wm[(size_t)k * 6144];
#pragma unroll
            for (int r = 0; r < 9; ++r) acc[r] += sil[r * 1024 + 128 * wave + k] * w; }
        __syncthreads();
#pragma unroll
        for (int r = 0; r < 9; ++r) part[(wave * 9 + r) * 64 + lane] = acc[r];
        __syncthreads();
        for (int i = tid; i < 9 * 64; i += 512) { float sum = 0.f;
#pragma unroll
            for (int w8 = 0; w8 < 8; ++w8) sum += part[w8 * 576 + i];
            const int r = i >> 6, c = (it % 96) * 64 + (i & 63); MOD[(size_t)(l * 9 + r) * 6144 + c] = sum + A.in[I_BMOD][l * 6144 + c]; }
    }
    __syncthreads();
    LAS float* scr = (LAS float*)(lds + 40960 + wave * 8704);
    constexpr int I_AB1 = 16 * 64, I_AB2 = 16 * 24, I_ABO = 16 * 32, I_C1 = 16 * 96, I_CO = 16 * 32, I_Q = 16 * 64;
    constexpr int NITEMS = I_AB1 + I_AB2 + I_ABO + I_C1 + I_CO + 2 * I_Q;
    const float rs128 = 0.08838834764831845f;
    for (int it = gw; it < NITEMS; it += NGW) {
        int r = it;
        if (r < I_AB1) { p0_transpose_item(A.in[I_ABWIN], 1024, 2832, 0, 2048, (bf16*)(ws + WS_WAB), 0, scr, r, lane, 512, 1024, rs128, 0, 0, 1.f); continue; } r -= I_AB1;
        if (r < I_AB2) { p0_transpose_item(A.in[I_ABWIN], 1024, 2832, 2064, 768, (bf16*)(ws + WS_WAB), 2048, scr, r, lane, 2048, 2560, 0.125f, 0, 0, 1.f); continue; } r -= I_AB2;
        if (r < I_ABO) { p0_transpose_item(A.in[I_ABWOUT], 1024, 1024, 0, 1024, (bf16*)(ws + WS_WABO), 0, scr, r, lane, 0, 0, 1.f, 0, 0, 1.f); continue; } r -= I_ABO;
        if (r < I_C1) { p0_transpose_item(A.in[I_GWIN], 1024, 3104, 0, 3072, (bf16*)(ws + WS_WC), 0, scr, r, lane, 0, 512, rs128, 0, 0, 1.f); continue; } r -= I_C1;
        if (r < I_CO) { p0_transpose_item(A.in[I_GWOUT], 1024, 1024, 0, 1024, (bf16*)(ws + WS_WCO), 0, scr, r, lane, 0, 0, 1.f, 0, 0, 1.f); continue; } r -= I_CO;
        if (r < I_Q) { p0_transpose_item(A.in[I_PWQ], 1024, 2048, 0, 2048, (bf16*)(ws + WS_WQ0), 0, scr, r, lane, 0, 0, 1.f, 0, 0, 1.f); continue; } r -= I_Q;
        p0_transpose_item(A.in[I_PWQ] + (size_t)1024 * 2048, 1024, 2048, 0, 2048, (bf16*)(ws + WS_WQ1), 0, scr, r, lane, 0, 0, 1.f, 0, 0, 1.f);
    }
    for (int i = gtid; i < 16 * 1024; i += gthreads) { const int g = i >> 10, k = i & 1023; ((float*)(ws + WS_WG))[i] = A.in[I_ABWIN][(size_t)k * 2832 + 2048 + g]; }
    for (int i = gtid; i < 32 * 1024; i += gthreads) { const int g = i >> 10, k = i & 1023; ((float*)(ws + WS_WLOW))[i] = A.in[I_GWIN][(size_t)k * 3104 + 3072 + g]; }
    for (int i = gtid; i < 64 * 16; i += gthreads) { const int pos = i >> 4, f = i & 15; const float inv = powf(10000.f, -(float)f / 16.f); const float ang = (float)pos * inv;
        ((float*)(ws + WS_ROPE))[2 * i] = cosf(ang); ((float*)(ws + WS_ROPE))[2 * i + 1] = sinf(ang); }
    for (int i = gtid; i < 2 * 8 * 2 * 128 * 16; i += gthreads) { const int mat = i >> 11, n = (i >> 4) & 127, kc = i & 15;
        const f32x4 a = *(const f32x4*)(A.in[I_PKEYS] + (size_t)i * 8), b = *(const f32x4*)(A.in[I_PKEYS] + (size_t)i * 8 + 4);
        v4u o; o.x = pk2(a[0], a[1]); o.y = pk2(a[2], a[3]); o.z = pk2(b[0], b[1]); o.w = pk2(b[2], b[3]);
        *(v4u*)((bf16*)(ws + WS_KEYS) + ((size_t)mat * 2048 + (size_t)(((n >> 4) * 4 + (kc >> 2)) * 64 + 16 * (kc & 3) + (n & 15))) * 8) = o; }
    cvt_rows_fp4(A.in[I_PU], ws + WS_U, (float*)(ws + WS_SCL), 2 * NEXP, gw, NGW, lane);
    cvt_rows_fp4(A.in[I_PV], ws + WS_V, (float*)(ws + WS_SCL) + 2 * NEXP, 2 * NEXP, gw, NGW, lane);
}

__device__ __forceinline__ void split8(const float* v, bf16x8& hi, bf16x8& lo) {
#pragma unroll
    for (int j = 0; j < 8; ++j) { const unsigned h = f2bf(v[j]); const float hf = __builtin_bit_cast(float, h << 16); hi[j] = (short)h; lo[j] = (short)f2bf(v[j] - hf); }
}
template <int NG>
__device__ __forceinline__ void h_phase(const float* lat, const float* ctx, const float* mod  , bf16* HB, const float* WGT, float* GL, LAS unsigned char* lds, int vcu, int G, int wave, int lane, int tid) {
    constexpr int NT = NG / 16;
    LAS float* part = (LAS float*)lds;
    const int g = lane >> 4, c16 = lane & 15;
    bf16x8 bhi[NT][4], blo[NT][4];
#pragma unroll
    for (int nt = 0; nt < NT; ++nt)
#pragma unroll
        for (int ks = 0; ks < 4; ++ks) { const float* wp = WGT + (size_t)(16 * nt + c16) * 1024 + 128 * wave + 32 * ks + 8 * g;
            const f32x4 w0 = *(const f32x4*)wp, w1 = *(const f32x4*)(wp + 4); const float wv[8] = {w0[0], w0[1], w0[2], w0[3], w1[0], w1[1], w1[2], w1[3]}; split8(wv, bhi[nt][ks], blo[nt][ks]); }
    for (int tile = vcu; tile < TT / 16; tile += G) {
        const int r0 = tile * 16, b = r0 / PB, p0 = r0 - b * PB; const float* mr = mod + (size_t)(p0 < LC ? 8 : b) * 6144 + 128 * wave + 8 * g;
        const int row = r0 + c16; const float* xr = srow_c(lat, ctx, row) + 128 * wave + 8 * g;
        f32x4 xa[4][2], sha[4][2], sca[4][2];
#pragma unroll
        for (int ks = 0; ks < 4; ++ks)
#pragma unroll
            for (int q = 0; q < 2; ++q) { xa[ks][q] = *(const f32x4*)(xr + 32 * ks + 4 * q); sha[ks][q] = *(const f32x4*)(mr + 32 * ks + 4 * q); sca[ks][q] = *(const f32x4*)(mr + 1024 + 32 * ks + 4 * q); }
        f32x4 acc[NT];
#pragma unroll
        for (int nt = 0; nt < NT; ++nt) acc[nt] = (f32x4){0.f, 0.f, 0.f, 0.f};
#pragma unroll
        for (int ks = 0; ks < 4; ++ks) {
            float hv[8];
#pragma unroll
            for (int q = 0; q < 2; ++q)
#pragma unroll
                for (int i = 0; i < 4; ++i) hv[4 * q + i] = xa[ks][q][i] * (sca[ks][q][i] + 1.0f) + sha[ks][q][i];
            bf16x8 ahi, alo; split8(hv, ahi, alo);
            *(bf16x8*)(HB + (size_t)row * D + 128 * wave + 32 * ks + 8 * g) = ahi;
#pragma unroll
            for (int nt = 0; nt < NT; ++nt) { acc[nt] = mma(ahi, bhi[nt][ks], acc[nt]); acc[nt] = mma(ahi, blo[nt][ks], acc[nt]); acc[nt] = mma(alo, bhi[nt][ks], acc[nt]); }
        }
        __syncthreads();
#pragma unroll
        for (int nt = 0; nt < NT; ++nt)
#pragma unroll
            for (int r = 0; r < 4; ++r) part[(wave * 16 + 4 * g + r) * NG + 16 * nt + c16] = acc[nt][r];
        __syncthreads();
        for (int i = tid; i < 16 * NG; i += 512) { float sum = 0.f;
#pragma unroll
            for (int w8 = 0; w8 < 8; ++w8) sum += part[w8 * 16 * NG + i];
            GL[(size_t)r0 * NG + i] = sum; }
    }
}

__device__ __forceinline__ void ln_row(const float* sr, float* xr, const bf16* yrow, const float* mr, const float* lnw, const float* lnb, bf16* hrow, int lane, int dry, bool active) {
    f32x4 v[4]; float s = 0.f;
#pragma unroll
    for (int j = 0; j < 4; ++j) { const int c = 4 * lane + 256 * j; const f32x4 x = *(const f32x4*)(sr + c), g1 = *(const f32x4*)(mr + 2048 + c); const v2u yw = *(const v2u*)(yrow + c);
        v[j][0] = DN_ALPHA * x[0] + g1[0] * bflo(yw.x); v[j][1] = DN_ALPHA * x[1] + g1[1] * bfhi(yw.x); v[j][2] = DN_ALPHA * x[2] + g1[2] * bflo(yw.y); v[j][3] = DN_ALPHA * x[3] + g1[3] * bfhi(yw.y);
        s += (v[j][0] + v[j][1]) + (v[j][2] + v[j][3]); }
    const float mean = wave_sum(s) * (1.f / D); float s2 = 0.f;
#pragma unroll
    for (int j = 0; j < 4; ++j) { v[j] = v[j] - mean; s2 += (v[j][0] * v[j][0] + v[j][1] * v[j][1]) + (v[j][2] * v[j][2] + v[j][3] * v[j][3]); }
    const float rstd = 1.f / sqrtf(wave_sum(s2) * (1.f / D) + LN_EPS);
    if (active) {
#pragma unroll
    for (int j = 0; j < 4; ++j) { const int c = 4 * lane + 256 * j; const f32x4 w = *(const f32x4*)(lnw + c), bb = *(const f32x4*)(lnb + c);
        const f32x4 x1 = v[j] * rstd * w + bb; if (!dry) *(f32x4*)(xr + c) = x1;
        const f32x4 sh = *(const f32x4*)(mr + 3072 + c), sc = *(const f32x4*)(mr + 4096 + c); const f32x4 hp = x1 * (sc + 1.0f) + sh;
        v2u o; o.x = pk2(hp[0], hp[1]); o.y = pk2(hp[2], hp[3]); if (!dry) *(v2u*)(hrow + c) = o; }
    }
}
__device__ __forceinline__ void ln_phase(const float* slat, const float* sctx, float* lat, float* ctx, const bf16* Y, const float* mod, const float* lnw, const float* lnb, bf16* HB, int gw, int NGW, int lane, int dry, bool lat_only) {
    const int nrows = lat_only ? NB * SEQ : TT;
    for (int i0 = gw; i0 < nrows; i0 += 2 * NGW) {
        const int i1 = i0 + NGW; const bool has1 = i1 < nrows; const int r0 = map_row(i0, lat_only), r1c = map_row(has1 ? i1 : i0, lat_only);
        const int b0 = r0 / PB, p0 = r0 - b0 * PB, b1 = r1c / PB, p1 = r1c - b1 * PB;
        ln_row(srow_c(slat, sctx, r0), srow(lat, ctx, r0), Y + (size_t)r0 * D, mod + (size_t)(p0 < LC ? 8 : b0) * 6144, lnw, lnb, HB + (size_t)r0 * D, lane, dry, true);
        ln_row(srow_c(slat, sctx, r1c), srow(lat, ctx, r1c), Y + (size_t)r1c * D, mod + (size_t)(p1 < LC ? 8 : b1) * 6144, lnw, lnb, HB + (size_t)r1c * D, lane, dry, has1);
    }
}

constexpr int AT_LD = 72;
__device__ __forceinline__ bf16x8 frag_tr_perm(const LAS bf16* t, int ld, int r0, int c0, int lane) {
    const int g = lane >> 4, q = (lane & 15) >> 2, p = lane & 3;
    const LAS bf16* a = t + (r0 + 4 * g + q) * ld + c0 + 4 * p;
    const s16x4 lo = __builtin_amdgcn_ds_read_tr16_b64_v4i16((LAS s16x4*)a);
    const s16x4 hi = __builtin_amdgcn_ds_read_tr16_b64_v4i16((LAS s16x4*)(a + 16 * ld));
    return (bf16x8){lo[0], lo[1], lo[2], lo[3], hi[0], hi[1], hi[2], hi[3]};
}
__device__ __forceinline__ void attn_phase(const bf16* P, bf16* CAT, const float* sink, const float* ropetab, LAS unsigned char* lds, unsigned* qctr, int vcu, int G, int wave, int lane, int tid) {
    LAS bf16* Kt = (LAS bf16*)lds;
    LAS bf16* Vt = (LAS bf16*)(lds + 9216);
    LAS bf16* Qw = (LAS bf16*)(lds + 18432 + wave * 4608);
    const int g = lane >> 4, c16 = lane & 15;
    volatile LAS int* qslot = (volatile LAS int*)(lds + MISC_OFF) + 12;
    for (;;) {
        if (tid == 0) *qslot = (int)__hip_atomic_fetch_add(qctr, 1u, __ATOMIC_RELAXED, __HIP_MEMORY_SCOPE_AGENT);
        __syncthreads();
        const int item = *qslot;
        if (item >= 1024 + 64) break;
        const bool is_ctx = item >= 1024;
        int b, hk, nb;
        if (!is_ctx) { b = item >> 7; hk = (item >> 6) & 1; nb = item & 63; } else { const int it = item - 1024; b = it >> 3; hk = (it >> 2) & 1; nb = it & 3; }
        const int head = hk * 4 + (wave >> 1);
        const int qrow0 = b * PB + (is_ctx ? 0 : LC) + nb * 64 + (wave & 1) * 32;
        const int qlat0 = nb * 64 + (wave & 1) * 32;
        __syncthreads();
#pragma unroll
        for (int i = 0; i < 4; ++i) { const int cidx = lane + 64 * i, rr = cidx >> 3, ch = cidx & 7;
            const v4u raw = *(const v4u*)(P + (size_t)(qrow0 + rr) * N_AB + 2048 + head * 64 + ch * 8); v4u o = raw;
            if (!is_ctx) { const int tl = qlat0 + rr; const int pos = (ch < 4) ? (tl >> 6) : (tl & 63); const float* tb = ropetab + (size_t)(pos * 16 + (ch & 3) * 4) * 2;
                const unsigned wv[4] = {raw.x, raw.y, raw.z, raw.w}; unsigned ov[4];
#pragma unroll
                for (int k = 0; k < 4; ++k) { const float x1 = bflo(wv[k]), x2 = bfhi(wv[k]), c = tb[2 * k], s = tb[2 * k + 1]; ov[k] = pk2(x1 * c - x2 * s, x1 * s + x2 * c); }
                o.x = ov[0]; o.y = ov[1]; o.z = ov[2]; o.w = ov[3]; }
            *(LAS v4u*)(Qw + rr * AT_LD + ch * 8) = o; }
        LDS_FENCE();
        bf16x8 qf[2][2];
#pragma unroll
        for (int mt = 0; mt < 2; ++mt)
#pragma unroll
            for (int ks = 0; ks < 2; ++ks) qf[mt][ks] = frag_row(Qw, AT_LD, 16 * mt, 32 * ks, lane);
        LDS_FENCE();
        f32x4 o[2][4]; float mrun[2], lrun[2];
        const float sk = sink[head];
#pragma unroll
        for (int qt = 0; qt < 2; ++qt) { mrun[qt] = sk; lrun[qt] = 1.f; }
#pragma unroll
        for (int qt = 0; qt < 2; ++qt)
#pragma unroll
            for (int nt = 0; nt < 4; ++nt) o[qt][nt] = (f32x4){0.f, 0.f, 0.f, 0.f};
        const int nkt = is_ctx ? 4 : 9;
        const int srr = tid >> 3, sch = tid & 7;
        int kt = 0; f32x2 trope[4];
#pragma unroll
        for (int i = 0; i < 4; ++i) trope[i] = (f32x2){1.f, 0.f};
        v4u kraw = *(const v4u*)(P + (size_t)(b * PB + srr) * N_AB + 2560 + hk * 64 + sch * 8), vraw = *(const v4u*)(P + (size_t)(b * PB + srr) * N_AB + 2688 + hk * 64 + sch * 8);
        while (kt < nkt) {
            const int kp0 = nb * 64 - 128 + 64 * (kt - 4);
            int kn = kt + 1;
            while (kn < nkt && kn >= 4 && ((nb * 64 - 128 + 64 * (kn - 4)) < 0 || (nb * 64 - 128 + 64 * (kn - 4)) >= SEQ)) ++kn;
            __syncthreads();
            { v4u o = kraw;
              if (kt >= 4) { const unsigned wv[4] = {kraw.x, kraw.y, kraw.z, kraw.w}; unsigned ov[4];
#pragma unroll
                  for (int i = 0; i < 4; ++i) { const float x1 = bflo(wv[i]), x2 = bfhi(wv[i]), c = trope[i][0], sn = trope[i][1]; ov[i] = pk2(x1 * c - x2 * sn, x1 * sn + x2 * c); }
                  o.x = ov[0]; o.y = ov[1]; o.z = ov[2]; o.w = ov[3]; }
              *(LAS v4u*)(Kt + srr * AT_LD + sch * 8) = o; *(LAS v4u*)(Vt + srr * AT_LD + sch * 8) = vraw; }
            if (kn < nkt) { const int kpn = nb * 64 - 128 + 64 * (kn - 4); const int krn = b * PB + (kn < 4 ? 64 * kn : LC + kpn);
                kraw = *(const v4u*)(P + (size_t)(krn + srr) * N_AB + 2560 + hk * 64 + sch * 8); vraw = *(const v4u*)(P + (size_t)(krn + srr) * N_AB + 2688 + hk * 64 + sch * 8);
                if (kn >= 4) { const int tl = kpn + srr; const int pos = (sch < 4) ? (tl >> 6) : (tl & 63); const f32x2* tb = (const f32x2*)(ropetab + (size_t)(pos * 16 + (sch & 3) * 4) * 2);
#pragma unroll
                    for (int i = 0; i < 4; ++i) trope[i] = tb[i]; } }
            __syncthreads();
            const bool need_mask = (kt == 4) || (kt == 8);
            bf16x8 kf[4][2];
#pragma unroll
            for (int km = 0; km < 4; ++km)
#pragma unroll
                for (int ks = 0; ks < 2; ++ks) kf[km][ks] = frag_row(Kt, AT_LD, 16 * km, 32 * ks, lane);
            bf16x8 pa[2][2];
#pragma unroll
            for (int qt = 0; qt < 2; ++qt) {
                f32x4 st[4];
#pragma unroll
                for (int km = 0; km < 4; ++km) { st[km] = (f32x4){0.f, 0.f, 0.f, 0.f};
#pragma unroll
                    for (int ks = 0; ks < 2; ++ks) st[km] = mma(kf[km][ks], qf[qt][ks], st[km]); }
                if (need_mask) {
#pragma unroll
                    for (int km = 0; km < 4; ++km)
#pragma unroll
                        for (int r = 0; r < 4; ++r) { const int dq = (kp0 + 16 * km + 4 * g + r) - (qlat0 + 16 * qt + c16); if (dq > 128 || dq < -128) st[km][r] = -3.0e38f; } }
                float mx = fmaxf(fmaxf(fmaxf(st[0][0], st[0][1]), fmaxf(st[0][2], st[0][3])), fmaxf(fmaxf(st[1][0], st[1][1]), fmaxf(st[1][2], st[1][3])));
                mx = fmaxf(mx, fmaxf(fmaxf(fmaxf(st[2][0], st[2][1]), fmaxf(st[2][2], st[2][3])), fmaxf(fmaxf(st[3][0], st[3][1]), fmaxf(st[3][2], st[3][3]))));
                mx = fmaxf(mx, __shfl_xor(mx, 16)); mx = fmaxf(mx, __shfl_xor(mx, 32));
                const float mnew = fmaxf(mrun[qt], mx), alpha = __expf(mrun[qt] - mnew);
                float ps = 0.f;
#pragma unroll
                for (int km = 0; km < 4; ++km)
#pragma unroll
                    for (int r = 0; r < 4; ++r) { const float pv = __expf(st[km][r] - mnew); st[km][r] = pv; ps += pv; }
                ps += __shfl_xor(ps, 16); ps += __shfl_xor(ps, 32);
                lrun[qt] = lrun[qt] * alpha + ps; mrun[qt] = mnew;
#pragma unroll
                for (int ks2 = 0; ks2 < 2; ++ks2) { const unsigned w0 = pk2(st[2 * ks2][0], st[2 * ks2][1]), w1 = pk2(st[2 * ks2][2], st[2 * ks2][3]), w2 = pk2(st[2 * ks2 + 1][0], st[2 * ks2 + 1][1]), w3 = pk2(st[2 * ks2 + 1][2], st[2 * ks2 + 1][3]);
                    const v4u wv = (v4u){w0, w1, w2, w3}; pa[qt][ks2] = __builtin_bit_cast(bf16x8, wv); }
#pragma unroll
                for (int r = 0; r < 4; ++r) { const float ar = __shfl(alpha, (lane & 48) + 4 * g + r);
#pragma unroll
                    for (int nt = 0; nt < 4; ++nt) o[qt][nt][r] *= ar; }
            }
#pragma unroll
            for (int ks2 = 0; ks2 < 2; ++ks2) {
                bf16x8 vf[4];
#pragma unroll
                for (int nt = 0; nt < 4; ++nt) vf[nt] = frag_tr_perm(Vt, AT_LD, 32 * ks2, 16 * nt, lane);
#pragma unroll
                for (int qt = 0; qt < 2; ++qt)
#pragma unroll
                    for (int nt = 0; nt < 4; ++nt) o[qt][nt] = mma(pa[qt][ks2], vf[nt], o[qt][nt]); }
            LDS_FENCE();
            kt = kn;
        }
#pragma unroll
        for (int qt = 0; qt < 2; ++qt)
#pragma unroll
            for (int r = 0; r < 4; ++r) { const float inv = 1.f / __shfl(lrun[qt], (lane & 48) + 4 * g + r); bf16* orow = CAT + (size_t)(qrow0 + 16 * qt + 4 * g + r) * D + 512 + head * 64;
#pragma unroll
                for (int nt = 0; nt < 4; ++nt) orow[16 * nt + c16] = (bf16)f2bf(o[qt][nt][r] * inv); }
    }
}

__device__ __forceinline__ float wave_prefix_sum(float v) {
    v += __builtin_bit_cast(float, __builtin_amdgcn_update_dpp(0, __builtin_bit_cast(int, v), 0x111, 0xf, 0xf, true)); v += __builtin_bit_cast(float, __builtin_amdgcn_update_dpp(0, __builtin_bit_cast(int, v), 0x112, 0xf, 0xf, true));
    v += __builtin_bit_cast(float, __builtin_amdgcn_update_dpp(0, __builtin_bit_cast(int, v), 0x114, 0xf, 0xf, true)); v += __builtin_bit_cast(float, __builtin_amdgcn_update_dpp(0, __builtin_bit_cast(int, v), 0x118, 0xf, 0xf, true));
    v += __builtin_bit_cast(float, __builtin_amdgcn_update_dpp(0, __builtin_bit_cast(int, v), 0x142, 0xa, 0xf, false)); v += __builtin_bit_cast(float, __builtin_amdgcn_update_dpp(0, __builtin_bit_cast(int, v), 0x143, 0xc, 0xf, false));
    return v;
}
__device__ __forceinline__ float wave_prefix_max(float v) {
    const int ninf = (int)0xff800000u;
    v = fmaxf(v, __builtin_bit_cast(float, __builtin_amdgcn_update_dpp(ninf, __builtin_bit_cast(int, v), 0x111, 0xf, 0xf, false))); v = fmaxf(v, __builtin_bit_cast(float, __builtin_amdgcn_update_dpp(ninf, __builtin_bit_cast(int, v), 0x112, 0xf, 0xf, false)));
    v = fmaxf(v, __builtin_bit_cast(float, __builtin_amdgcn_update_dpp(ninf, __builtin_bit_cast(int, v), 0x114, 0xf, 0xf, false))); v = fmaxf(v, __builtin_bit_cast(float, __builtin_amdgcn_update_dpp(ninf, __builtin_bit_cast(int, v), 0x118, 0xf, 0xf, false)));
    v = fmaxf(v, __builtin_bit_cast(float, __builtin_amdgcn_update_dpp(ninf, __builtin_bit_cast(int, v), 0x142, 0xa, 0xf, false))); v = fmaxf(v, __builtin_bit_cast(float, __builtin_amdgcn_update_dpp(ninf, __builtin_bit_cast(int, v), 0x143, 0xc, 0xf, false)));
    return v;
}
__device__ __forceinline__ void mlstm_gate_scan(const float* GL  , const float* gate_b  , unsigned char* ws, int gw, int NGW, int lane) {
    float* BQ = (float*)(ws + WS_BQ); float* CQ = (float*)(ws + WS_CQ); float* EM = (float*)(ws + WS_EM); float* AI = (float*)(ws + WS_AI);
    float* AST = (float*)(ws + WS_AST); float* CL = (float*)(ws + WS_CL);
    for (int chain = gw; chain < 64; chain += NGW) {
        const int dir = chain >> 5, b = (chain >> 2) & 7, h = chain & 3;
        const float bi = gate_b[dir * 8 + h], bfg = gate_b[dir * 8 + 4 + h];
        float m_st = 0.f;
        float gi_n, gf_n;
        { const int j0 = dir == 0 ? 0 : 3; const int p0 = j0 * 64 + (dir == 0 ? lane : 63 - lane); const float* gr = GL + (size_t)(b * PB + p0) * 16 + dir * 8; gi_n = gr[h]; gf_n = gr[4 + h]; }
        for (int sc = 0; sc < NCH; ++sc) {
            const int j = dir == 0 ? sc : (sc < 4 ? 3 - sc : 71 - sc);
            const int p = j * 64 + (dir == 0 ? lane : 63 - lane);
            const float li = gi_n + bi, lf = logsigmoidf_(gf_n + bfg);
            if (sc + 1 < NCH) { const int sn = sc + 1; const int jn = dir == 0 ? sn : (sn < 4 ? 3 - sn : 71 - sn); const int pn = jn * 64 + (dir == 0 ? lane : 63 - lane);
                const float* gr = GL + (size_t)(b * PB + pn) * 16 + dir * 8; gi_n = gr[h]; gf_n = gr[4 + h]; }
            const float cum = wave_prefix_sum(lf);
            const float bb = li - cum; const float pm = wave_prefix_max(bb);
            const float c = fmaxf(m_st, pm);
            const size_t ti = (size_t)chain * PB + p;
            BQ[ti] = bb; CQ[ti] = c; EM[ti] = __expf(-(cum + c)); AI[ti] = __expf(m_st - c);
            const float cl = __builtin_bit_cast(float, __builtin_amdgcn_readlane(__builtin_bit_cast(int, c), 63)), tot = __builtin_bit_cast(float, __builtin_amdgcn_readlane(__builtin_bit_cast(int, cum), 63));
            if (lane == 0) { CL[chain * NCH + j] = cl; AST[chain * NCH + j] = __expf(m_st - cl); }
            m_st = tot + cl;
        }
    }
}


__device__ __forceinline__ float logsig_fast(float x) { return fminf(x, 0.f) - __logf(1.f + __expf(-fabsf(x))); }
__device__ __forceinline__ void gla_prep(bf16* P, bf16* QKR, const float* LOW  , const float* gate_up  , const float* gate_b  , unsigned char* ws,
                                         LAS unsigned char* lds, int vcu, int G, int tid, int dry) {
    float* ET = (float*)(ws + WS_ET);
    LAS float* lowt = (LAS float*)lds;
    LAS bf16* qs = (LAS bf16*)(lds + 8192);
    LAS bf16* ks = (LAS bf16*)(lds + 24576);
    LAS float* LA = (LAS float*)(lds + 40960);
    LAS float* HT = (LAS float*)(lds + 106496);
    const int dc = tid & 255, dir = dc >> 7, ch = dc & 127, half = tid >> 8;
    for (int item = vcu; item < NB * NCH * 4; item += G) {
        const int b = item / (NCH * 4), j = (item >> 2) % NCH, h = item & 3;
        const int row0 = b * PB + j * 64, c = h * 128 + ch;
        __syncthreads();
        for (int i = tid; i < 64 * 32; i += 512) lowt[i] = LOW[(size_t)row0 * 32 + i];
#pragma unroll
        for (int i = 0; i < 2; ++i) { const int cidx = tid + 512 * i, rr = cidx >> 4, c8 = cidx & 15; const bf16* src = P + (size_t)(row0 + rr) * N_C + h * 128 + c8 * 8;
            *(LAS v4u*)(qs + rr * 128 + c8 * 8) = *(const v4u*)src; *(LAS v4u*)(ks + rr * 128 + c8 * 8) = *(const v4u*)(src + 512); }
        float gu[16];
#pragma unroll
        for (int k = 0; k < 16; ++k) gu[k] = gate_up[(size_t)(dir * 16 + k) * 512 + c];
        const float gb = gate_b[dir * 512 + c];
        __syncthreads();
        float hsum = 0.f;
#pragma unroll 4
        for (int i = 0; i < 32; ++i) { const int t = half * 32 + i; float x = gb;
#pragma unroll
            for (int k = 0; k < 16; ++k) x += lowt[t * 32 + dir * 16 + k] * gu[k];
            const float la = logsig_fast(x) * (1.f / 16.f); LA[t * 256 + dc] = la; hsum += la; }
        HT[half * 256 + dc] = hsum;
        __syncthreads();
        float cum = (dir == 0) ? (half == 1 ? HT[dc] : 0.f) : (half == 0 ? HT[256 + dc] : 0.f);
#pragma unroll 4
        for (int i = 0; i < 32; ++i) { const int t = half * 32 + (dir == 0 ? i : 31 - i);
            cum += LA[t * 256 + dc];
            const float e = __expf(cum), ei = __expf(-cum);
            const size_t ro = (size_t)(row0 + t) * N_C;
            const float qv = bf2f(qs[t * 128 + ch]), kv = bf2f(ks[t * 128 + ch]);
            if (dir == 0) { if (!dry) { P[ro + c] = (bf16)f2bf(qv * e); P[ro + 512 + c] = (bf16)f2bf(kv * ei); } }
            else { QKR[(size_t)(row0 + t) * 1024 + c] = (bf16)f2bf(qv * e); QKR[(size_t)(row0 + t) * 1024 + 512 + c] = (bf16)f2bf(kv * ei); } }
        if (half == 0) ET[((size_t)((dir * 8 + b) * 4 + h) * NCH + j) * 128 + ch] = __expf(HT[dc] + HT[256 + dc]);
    }
}


__device__ __forceinline__ unsigned f2sort(float f) { const unsigned u = __builtin_bit_cast(unsigned, f); return (u & 0x80000000u) ? ~u : (u | 0x80000000u); }
__device__ __forceinline__ float sort2f(unsigned s) { const unsigned u = (s & 0x80000000u) ? (s & 0x7fffffffu) : ~s; return __builtin_bit_cast(float, u); }
template <int CTRL> __device__ __forceinline__ unsigned dppmov_u(unsigned x) { return (unsigned)__builtin_amdgcn_mov_dpp((int)x, CTRL, 0xf, 0xf, true); }
__device__ __forceinline__ unsigned gmax16(unsigned x) { unsigned y;
    y = dppmov_u<0xB1>(x); x = x > y ? x : y; y = dppmov_u<0x4E>(x); x = x > y ? x : y; y = dppmov_u<0x141>(x); x = x > y ? x : y; y = dppmov_u<0x128>(x); x = x > y ? x : y; return x; }
__device__ __forceinline__ float gsum16(float x) {
    x += __builtin_bit_cast(float, dppmov_u<0xB1>(__builtin_bit_cast(unsigned, x))); x += __builtin_bit_cast(float, dppmov_u<0x4E>(__builtin_bit_cast(unsigned, x)));
    x += __builtin_bit_cast(float, dppmov_u<0x141>(__builtin_bit_cast(unsigned, x))); x += __builtin_bit_cast(float, dppmov_u<0x128>(__builtin_bit_cast(unsigned, x))); return x; }
#define CSWAP(a, b) do { const unsigned hi_ = (a) > (b) ? (a) : (b), lo_ = (a) > (b) ? (b) : (a); (a) = hi_; (b) = lo_; } while (0)
__device__ __forceinline__ void peer_route(const bf16* Q, const bf16* KEYS, int* EID, float* GWT, int gw, int NGW, int lane, bool lat_only) {
    const int g = lane >> 4, c16 = lane & 15, gbase = lane & 48;
    const int nwi = (lat_only ? NB * SEQ / 16 : TT / 16) * 8;
    const unsigned tw = (c16 == 0 ? 0x03020100u : (c16 == 1 ? 0x07060504u : (c16 == 2 ? 0x0b0a0908u : (c16 == 3 ? 0x0f0e0d0cu : (c16 == 4 ? 0x13121110u : (c16 == 5 ? 0x17161514u : (c16 == 6 ? 0x23222120u : (c16 == 7 ? 0x32313024u : (c16 == 8 ? 0x42414033u : (c16 == 9 ? 0x61605150u : (c16 == 10 ? 0x90807170u : (c16 == 11 ? 0xd0c0b0a0u : (c16 == 12 ? 0xfffff0e0u : 0xffffffffu)))))))))))));
    for (int wi = gw; wi < nwi; wi += NGW) {
        const int t0 = map_row((wi >> 3) * 16, lat_only), head = wi & 7;
        unsigned tops[2][4];
#pragma unroll
        for (int p = 0; p < 2; ++p) {
            const bf16* qrow = Q + (size_t)(t0 + c16) * 2048 + head * 256 + p * 128 + 8 * g;
            bf16x8 qf[4];
#pragma unroll
            for (int ks = 0; ks < 4; ++ks) qf[ks] = *(const bf16x8*)(qrow + 32 * ks);
            const bf16* kb = KEYS + (size_t)(head * 2 + p) * 128 * 128 + 8 * lane;
            unsigned key[8][4];
#pragma unroll
            for (int nt = 0; nt < 8; ++nt) { f32x4 s = (f32x4){0.f, 0.f, 0.f, 0.f};
#pragma unroll
                for (int ks = 0; ks < 4; ++ks) s = mma(qf[ks], *(const bf16x8*)(kb + (nt * 4 + ks) * 512), s);
#pragma unroll
                for (int r = 0; r < 4; ++r) key[nt][r] = (f2sort(s[r]) & ~127u) | (unsigned)(127 - (16 * nt + c16)); }
            unsigned kk[4][8];
#pragma unroll
            for (int r = 0; r < 4; ++r) {
#pragma unroll
                for (int nt = 0; nt < 8; ++nt) kk[r][nt] = key[nt][r];
                CSWAP(kk[r][0], kk[r][1]); CSWAP(kk[r][2], kk[r][3]); CSWAP(kk[r][4], kk[r][5]); CSWAP(kk[r][6], kk[r][7]); CSWAP(kk[r][0], kk[r][2]); CSWAP(kk[r][1], kk[r][3]); CSWAP(kk[r][4], kk[r][6]); CSWAP(kk[r][5], kk[r][7]);
                CSWAP(kk[r][1], kk[r][2]); CSWAP(kk[r][5], kk[r][6]); CSWAP(kk[r][0], kk[r][4]); CSWAP(kk[r][1], kk[r][5]); CSWAP(kk[r][2], kk[r][6]); CSWAP(kk[r][3], kk[r][7]); CSWAP(kk[r][2], kk[r][4]); CSWAP(kk[r][3], kk[r][5]);
                CSWAP(kk[r][1], kk[r][2]); CSWAP(kk[r][3], kk[r][4]); CSWAP(kk[r][5], kk[r][6]); }
            unsigned tt[4] = {0u, 0u, 0u, 0u};
#pragma unroll 2
            for (int rd = 0; rd < 16; ++rd) {
#pragma unroll
                for (int r = 0; r < 4; ++r) { const unsigned m = gmax16(kk[r][0]); const bool w = (kk[r][0] == m);
#pragma unroll
                    for (int q = 0; q < 7; ++q) kk[r][q] = w ? kk[r][q + 1] : kk[r][q];
                    kk[r][7] = w ? 0u : kk[r][7];
                    tt[r] = (c16 == rd) ? m : tt[r]; } }
#pragma unroll
            for (int r = 0; r < 4; ++r) tops[p][r] = tt[r];
        }
        unsigned res[4]; unsigned kq[4][4];
#pragma unroll
        for (int r = 0; r < 4; ++r) { res[r] = 0u;
#pragma unroll
            for (int sl = 0; sl < 4; ++sl) { const unsigned byte = (tw >> (8 * sl)) & 255u; const int ii = (int)(byte >> 4), jj = (int)(byte & 15u);
                const float a = sort2f((unsigned)__shfl((int)tops[0][r], gbase + ii) & ~127u), bq = sort2f((unsigned)__shfl((int)tops[1][r], gbase + jj) & ~127u);
                kq[r][sl] = byte == 255u ? 0u : ((f2sort(a + bq) & ~255u) | (unsigned)((15 - ii) << 4) | (unsigned)(15 - jj)); }
            CSWAP(kq[r][0], kq[r][1]); CSWAP(kq[r][2], kq[r][3]); CSWAP(kq[r][0], kq[r][2]); CSWAP(kq[r][1], kq[r][3]); CSWAP(kq[r][1], kq[r][2]); }
#pragma unroll 2
        for (int rd = 0; rd < 16; ++rd) {
#pragma unroll
            for (int r = 0; r < 4; ++r) { const unsigned m = gmax16(kq[r][0]); const bool w = (kq[r][0] == m);
                kq[r][0] = w ? kq[r][1] : kq[r][0]; kq[r][1] = w ? kq[r][2] : kq[r][1]; kq[r][2] = w ? kq[r][3] : kq[r][2]; kq[r][3] = w ? 0u : kq[r][3];
                res[r] = (c16 == rd) ? m : res[r]; } }
#pragma unroll
        for (int r = 0; r < 4; ++r) {
            const float val = sort2f(res[r] & ~255u); const int ii = 15 - (int)((res[r] >> 4) & 15u), jj = 15 - (int)(res[r] & 15u);
            const float mx = __shfl(val, gbase);
            const float ex = __expf(val - mx), sum = gsum16(ex);
            const unsigned i0 = 127u - ((unsigned)__shfl((int)tops[0][r], gbase + ii) & 127u), i1 = 127u - ((unsigned)__shfl((int)tops[1][r], gbase + jj) & 127u);
            const size_t o = (size_t)(t0 + 4 * g + r) * 128 + head * 16 + c16;
            EID[o] = (int)(i0 * 128u + i1); GWT[o] = ex / sum;
        }
    }
}

__device__ __forceinline__ void unpack8(const v4u w, float* o) { o[0] = bflo(w.x); o[1] = bfhi(w.x); o[2] = bflo(w.y); o[3] = bfhi(w.y); o[4] = bflo(w.z); o[5] = bfhi(w.z); o[6] = bflo(w.w); o[7] = bfhi(w.w); }
typedef int v8i __attribute__((ext_vector_type(8)));
constexpr int P1_PAIR = 1040, P1_BUF = 8 * P1_PAIR, P1_HQ = 2 * P1_BUF, P1_DOTS = P1_HQ, P1_WAVE_LDS = 19968;
__device__ __forceinline__ int p1_pair(int m) { return m < 4 ? m : (m < 12 ? m - 4 : m - 8); }
__device__ __forceinline__ int p1_exp(int m) { return m < 4 ? 2 * m : (m < 12 ? 2 * (m - 4) + 1 : 2 * (m - 8)); }
__device__ __forceinline__ void peer_pass1(const bf16* HB, const int* EID, const float* GWT, const unsigned char* U4, const float* SUi, const float* SVi, float* COEF,
                                           LAS unsigned char* lds, int wave, int gw, int NGW, int lane, bool lat_only) {
    LAS unsigned char* wl = lds + wave * P1_WAVE_LDS;
    LAS float* dots = (LAS float*)(wl + P1_DOTS);
    const int n = lane & 15, g = lane >> 4;
    const int nrows = lat_only ? NB * SEQ : TT;
    const unsigned aoff = (unsigned)(p1_pair(n) * P1_PAIR + ((n >= 4 && n < 12) ? 512 : 0) + 128 * g);
    const unsigned boff = (unsigned)(P1_HQ + (n < 6 ? 512 * n : 0) + 128 * g);
    const float wn = n == 0 ? 1.f : (n == 1 ? 0.25f : (n == 2 ? 0.0625f : (n == 3 ? 0.015625f : (n == 4 ? 0.00390625f : (n == 5 ? 0.0009765625f : 0.f)))));
    int ri = gw;
    if (ri >= nrows) return;
    int r = map_row(ri, lat_only);
    v4u hn0 = *(const v4u*)(HB + (size_t)r * D + 16 * lane), hn1 = *(const v4u*)(HB + (size_t)r * D + 16 * lane + 8);
    int eidAn = EID[(size_t)r * 128 + lane], eidBn = EID[(size_t)r * 128 + 64 + lane];
#define P1_DMA(src_e, base_, bufo_) do { _Pragma("unroll") for (int p_ = 0; p_ < 8; ++p_) { \
        const int ia_ = __builtin_amdgcn_readlane((src_e), (base_) + 2 * p_), ib_ = __builtin_amdgcn_readlane((src_e), (base_) + 2 * p_ + 1); const int id_ = lane < 32 ? ia_ : ib_; \
        __builtin_amdgcn_global_load_lds((const unsigned*)(U4 + (size_t)id_ * 512 + 16 * (lane & 31)), (LAS unsigned*)(wl + (bufo_) + p_ * P1_PAIR), 16, 0, 0); } } while (0)
    P1_DMA(eidAn, 0, 0); P1_DMA(eidAn, 16, P1_BUF);
    for (; ri < nrows; ri += NGW) {
        r = map_row(ri, lat_only);
        const int eidA = eidAn, eidB = eidBn;
        { float h[16]; unpack8(hn0, h); unpack8(hn1, h + 8);
#pragma unroll
          for (int part = 0; part < 6; ++part) {
              unsigned w[2];
#pragma unroll
              for (int d = 0; d < 2; ++d) { unsigned t = 0u;
                  t = __builtin_amdgcn_cvt_scalef32_pk_fp4_f32(t, h[8 * d], h[8 * d + 1], 1.0f, 0); t = __builtin_amdgcn_cvt_scalef32_pk_fp4_f32(t, h[8 * d + 2], h[8 * d + 3], 1.0f, 1);
                  t = __builtin_amdgcn_cvt_scalef32_pk_fp4_f32(t, h[8 * d + 4], h[8 * d + 5], 1.0f, 2); t = __builtin_amdgcn_cvt_scalef32_pk_fp4_f32(t, h[8 * d + 6], h[8 * d + 7], 1.0f, 3);
                  w[d] = t; }
              *(LAS v2u*)(wl + P1_HQ + 512 * part + 8 * lane) = (v2u){w[0], w[1]};
              if (part < 5) {
#pragma unroll
                  for (int d = 0; d < 2; ++d) {
                      const f32x2 q0 = __builtin_amdgcn_cvt_scalef32_pk_f32_fp4(w[d], 1.0f, 0), q1 = __builtin_amdgcn_cvt_scalef32_pk_f32_fp4(w[d], 1.0f, 1);
                      const f32x2 q2 = __builtin_amdgcn_cvt_scalef32_pk_f32_fp4(w[d], 1.0f, 2), q3 = __builtin_amdgcn_cvt_scalef32_pk_f32_fp4(w[d], 1.0f, 3);
                      h[8 * d] = (h[8 * d] - q0[0]) * 4.f; h[8 * d + 1] = (h[8 * d + 1] - q0[1]) * 4.f; h[8 * d + 2] = (h[8 * d + 2] - q1[0]) * 4.f; h[8 * d + 3] = (h[8 * d + 3] - q1[1]) * 4.f;
                      h[8 * d + 4] = (h[8 * d + 4] - q2[0]) * 4.f; h[8 * d + 5] = (h[8 * d + 5] - q2[1]) * 4.f; h[8 * d + 6] = (h[8 * d + 6] - q3[0]) * 4.f; h[8 * d + 7] = (h[8 * d + 7] - q3[1]) * 4.f; } } } }
        const float gwtA = GWT[(size_t)r * 128 + lane], gwtB = GWT[(size_t)r * 128 + 64 + lane];
        const float suA = SUi[eidA], suB = SUi[eidB], svA = SVi[eidA], svB = SVi[eidB];
        const int rin = ri + NGW; const bool more = rin < nrows; const int rn = map_row(more ? rin : ri, lat_only);
        hn0 = *(const v4u*)(HB + (size_t)rn * D + 16 * lane); hn1 = *(const v4u*)(HB + (size_t)rn * D + 16 * lane + 8);
        eidAn = EID[(size_t)rn * 128 + lane]; eidBn = EID[(size_t)rn * 128 + 64 + lane];
        LDS_FENCE();
        v4u bw[8];
#pragma unroll
        for (int c = 0; c < 8; ++c) bw[c] = *(LAS const v4u*)(wl + boff + 16 * c);
#pragma unroll 1
        for (int G = 0; G < 8; ++G) {
            if (G < 7 || more) asm volatile("s_waitcnt vmcnt(8)" ::: "memory"); else asm volatile("s_waitcnt vmcnt(0)" ::: "memory");
            const unsigned bufo = (G & 1) ? (unsigned)P1_BUF : 0u;
            v4u aw[8];
#pragma unroll
            for (int c = 0; c < 8; ++c) aw[c] = *(LAS const v4u*)(wl + bufo + aoff + 16 * c);
            asm volatile("s_waitcnt lgkmcnt(0)" ::: "memory");
            { const int srcsel = G < 2 ? eidA : (G < 6 ? eidB : eidAn); const int base = 16 * ((G + 2) & 3);
              if (G < 6 || more) { if (G & 1) P1_DMA(srcsel, base, P1_BUF); else P1_DMA(srcsel, base, 0); } }
            f32x4 acc = (f32x4){0.f, 0.f, 0.f, 0.f};
#pragma unroll
            for (int c = 0; c < 8; ++c) {
                const v8i A = (v8i){(int)aw[c].x, (int)aw[c].y, (int)aw[c].z, (int)aw[c].w, 0, 0, 0, 0};
                const v8i Bv = (v8i){(int)bw[c].x, (int)bw[c].y, (int)bw[c].z, (int)bw[c].w, 0, 0, 0, 0};
                acc = __builtin_amdgcn_mfma_scale_f32_16x16x128_f8f6f4(A, Bv, acc, 4, 4, 0, 0, 0, 0); }
            f32x4 dv;
#pragma unroll
            for (int k = 0; k < 4; ++k) dv[k] = gsum16(acc[k] * wn);
            if (n == 0) { LAS float* dp = dots + 16 * G + p1_exp(4 * g); dp[0] = dv[0]; dp[2] = dv[1]; dp[4] = dv[2]; dp[6] = dv[3]; }
        }
        LDS_FENCE();
        { const float dot = dots[lane] * suA; COEF[(size_t)r * 128 + lane] = gwtA * 0.5f * dot * (1.f + erff(dot * 0.70710678118f)) * svA; }
        { const float dot = dots[64 + lane] * suB; COEF[(size_t)r * 128 + 64 + lane] = gwtB * 0.5f * dot * (1.f + erff(dot * 0.70710678118f)) * svB; }
    }
#undef P1_DMA
}
constexpr int P2_CPART = 16384, P2_CSTAGE = P2_CPART + 256, P2_FSTAGE = P2_CSTAGE + 512;
typedef int v2i __attribute__((ext_vector_type(2)));
template <bool USE_PEER>
__device__ __forceinline__ void peer_expert(const float* COEF, const int* EID, const unsigned char* V4,
                                            float* lat, float* ctx, const float* mod, const float* lnw, const float* lnb, LAS unsigned char* lds, int wave, int gw, int NGW, int lane, int dry, bool lat_only) {
    LAS unsigned char* wl = lds + wave * P1_WAVE_LDS;
    LAS float* cstage = (LAS float*)(wl + P2_CSTAGE); LAS float* fstage = (LAS float*)(wl + P2_FSTAGE);
    const int c = lane & 15, kb = lane >> 4, drow = lane >> 3, dpos = lane & 7, fk = (c >> 1) & 7;
    const unsigned trbase = (unsigned)((32 * kb + c) * 128);
    const int nrows = lat_only ? NB * SEQ : TT;
    int ri = gw;
    if (ri >= nrows) return;
    unsigned roff[16];
#define P2_ROFF(row_) do { _Pragma("unroll") for (int i_ = 0; i_ < 16; ++i_) roff[i_] = (unsigned)EID[(size_t)(row_) * 128 + 8 * i_ + drow] * 512u + 16u * (unsigned)(dpos ^ ((4 * i_ + (drow >> 1)) & 7)); } while (0)
    P2_ROFF(map_row(ri, lat_only));
#define P2_DMA(cqo_) do { _Pragma("unroll") for (int i_ = 0; i_ < 16; ++i_) \
        __builtin_amdgcn_global_load_lds((const unsigned*)(V4 + (size_t)(roff[i_] + (cqo_))), (LAS unsigned*)(wl + 1024 * i_), 16, 0, 0); } while (0)
    if (USE_PEER) P2_DMA(0u);
    for (; ri < nrows; ri += NGW) {
        const int r = map_row(ri, lat_only);
        const int b = r / PB, p = r - b * PB; float* xr = srow(lat, ctx, r); const float* mr = mod + (size_t)(p < LC ? 8 : b) * 6144;
        float f[16];
#pragma unroll
        for (int i = 0; i < 16; ++i) f[i] = 0.f;
        if (USE_PEER) {
        const int rin = ri + NGW; const bool more = rin < nrows; const int rn = map_row(more ? rin : ri, lat_only);
        const float cA = COEF[(size_t)r * 128 + lane], cB = COEF[(size_t)r * 128 + 64 + lane];
        float cm = fmaxf(fabsf(cA), fabsf(cB));
        cm = fmaxf(cm, dppmov_f<0xB1>(cm)); cm = fmaxf(cm, dppmov_f<0x4E>(cm)); cm = fmaxf(cm, dppmov_f<0x141>(cm)); cm = fmaxf(cm, dppmov_f<0x128>(cm)); cm = fmaxf(cm, __shfl_xor(cm, 16)); cm = fmaxf(cm, __shfl_xor(cm, 32));
        const float sc = cm > 0.f ? 6.0f / cm : 1.f, isc = cm > 0.f ? cm * (1.f / 6.0f) : 1.f;
        cstage[lane] = cA * sc; cstage[64 + lane] = cB * sc;
        LDS_FENCE();
        if (lane < 16) {
            float h[8]; { const f32x4 x0 = *(LAS const f32x4*)(cstage + 8 * lane), x1 = *(LAS const f32x4*)(cstage + 8 * lane + 4); h[0] = x0[0]; h[1] = x0[1]; h[2] = x0[2]; h[3] = x0[3]; h[4] = x1[0]; h[5] = x1[1]; h[6] = x1[2]; h[7] = x1[3]; }
#pragma unroll
            for (int part = 0; part < 4; ++part) {
                unsigned t = 0u;
                t = __builtin_amdgcn_cvt_scalef32_pk_fp4_f32(t, h[0], h[1], 1.0f, 0); t = __builtin_amdgcn_cvt_scalef32_pk_fp4_f32(t, h[2], h[3], 1.0f, 1);
                t = __builtin_amdgcn_cvt_scalef32_pk_fp4_f32(t, h[4], h[5], 1.0f, 2); t = __builtin_amdgcn_cvt_scalef32_pk_fp4_f32(t, h[6], h[7], 1.0f, 3);
                *(LAS unsigned*)(wl + P2_CPART + 64 * part + 4 * lane) = t;
                if (part < 3) { const f32x2 q0 = __builtin_amdgcn_cvt_scalef32_pk_f32_fp4(t, 1.0f, 0), q1 = __builtin_amdgcn_cvt_scalef32_pk_f32_fp4(t, 1.0f, 1), q2 = __builtin_amdgcn_cvt_scalef32_pk_f32_fp4(t, 1.0f, 2), q3 = __builtin_amdgcn_cvt_scalef32_pk_f32_fp4(t, 1.0f, 3);
                    h[0] = (h[0] - q0[0]) * 4.f; h[1] = (h[1] - q0[1]) * 4.f; h[2] = (h[2] - q1[0]) * 4.f; h[3] = (h[3] - q1[1]) * 4.f; h[4] = (h[4] - q2[0]) * 4.f; h[5] = (h[5] - q2[1]) * 4.f; h[6] = (h[6] - q3[0]) * 4.f; h[7] = (h[7] - q3[1]) * 4.f; } } }
        LDS_FENCE();
        v4u aw = (v4u){0u, 0u, 0u, 0u};
        if (c < 4) aw = *(LAS const v4u*)(wl + P2_CPART + 64 * c + 16 * kb);
        const v8i A = (v8i){(int)aw.x, (int)aw.y, (int)aw.z, (int)aw.w, 0, 0, 0, 0};
#pragma unroll 1
        for (int cq = 0; cq < 4; ++cq) {
            asm volatile("s_waitcnt vmcnt(0)" ::: "memory");
#define P2_TILES(t0_) do { v2i r1[8], r2[8]; \
            _Pragma("unroll") for (int t = 0; t < 8; ++t) { const unsigned a = trbase + 16u * (unsigned)((((t0_) + t) >> 1) ^ fk) + 8u * (unsigned)(t & 1); \
                r1[t] = __builtin_amdgcn_ds_read_tr4_b64_v2i32((LAS v2i*)(wl + a)); r2[t] = __builtin_amdgcn_ds_read_tr4_b64_v2i32((LAS v2i*)(wl + a + 2048)); } \
            if ((t0_) == 8) { asm volatile("s_waitcnt lgkmcnt(0)" ::: "memory");     \
                if (cq < 3) { P2_DMA(128u * (unsigned)(cq + 1)); if (cq == 2 && more) P2_ROFF(rn); } else if (more) P2_DMA(0u); } \
            _Pragma("unroll") for (int t = 0; t < 8; ++t) { \
                const v8i Bv = (v8i){r1[t].x, r1[t].y, r2[t].x, r2[t].y, 0, 0, 0, 0}; \
                const f32x4 d = __builtin_amdgcn_mfma_scale_f32_16x16x128_f8f6f4(A, Bv, (f32x4){0.f, 0.f, 0.f, 0.f}, 4, 4, 0, 0, 0, 0); \
                const float fv = (d[0] + 0.25f * d[1] + 0.0625f * d[2] + 0.015625f * d[3]) * isc; \
                if (kb == 0) fstage[16 * ((t0_) + t) + c] = fv; } } while (0)
            P2_TILES(0); P2_TILES(8);
#undef P2_TILES
            LDS_FENCE();
            const f32x4 fq = *(LAS const f32x4*)(fstage + 4 * lane);
            if (cq == 0) { f[0] = fq[0]; f[1] = fq[1]; f[2] = fq[2]; f[3] = fq[3]; } else if (cq == 1) { f[4] = fq[0]; f[5] = fq[1]; f[6] = fq[2]; f[7] = fq[3]; }
            else if (cq == 2) { f[8] = fq[0]; f[9] = fq[1]; f[10] = fq[2]; f[11] = fq[3]; } else { f[12] = fq[0]; f[13] = fq[1]; f[14] = fq[2]; f[15] = fq[3]; }
        }
        }
        float v[16]; float s = 0.f;
#pragma unroll
        for (int q = 0; q < 4; ++q) { const int cc = 256 * q + 4 * lane; const f32x4 x1 = *(const f32x4*)(xr + cc), g2 = *(const f32x4*)(mr + 5120 + cc);
#pragma unroll
            for (int i = 0; i < 4; ++i) { v[4 * q + i] = DN_ALPHA * x1[i] + g2[i] * f[4 * q + i]; s += v[4 * q + i]; } }
        const float mean = wave_sum(s) * (1.f / D); float s2 = 0.f;
#pragma unroll
        for (int i = 0; i < 16; ++i) { v[i] -= mean; s2 += v[i] * v[i]; }
        const float rstd = 1.f / sqrtf(wave_sum(s2) * (1.f / D) + LN_EPS);
#pragma unroll
        for (int q = 0; q < 4; ++q) { const int cc = 256 * q + 4 * lane; const f32x4 w = *(const f32x4*)(lnw + cc), bb2 = *(const f32x4*)(lnb + cc); f32x4 o;
#pragma unroll
            for (int i = 0; i < 4; ++i) o[i] = v[4 * q + i] * rstd * w[i] + bb2[i];
            if (!dry) *(f32x4*)(xr + cc) = o; }
    }
#undef P2_DMA
#undef P2_ROFF
}

__device__ __forceinline__ bf16* od_row_base(unsigned char* ws, int dir, int b) {
    if (dir == 0) return (bf16*)(ws + WS_ST) + (size_t)b * SEQ * 1024;
    return b < 7 ? (bf16*)(ws + WS_ST + 64 * MiB) + (size_t)b * SEQ * 1024 : (bf16*)(ws + WS_XC);
}
__device__ __forceinline__ void gla_fused_scan(const bf16* P, const bf16* QKR, unsigned char* ws, LAS unsigned char* lds, int vcu, int G, int wave, int lane, int tid, int dry) {
    const float* ET = (const float*)(ws + WS_ET);
    LAS bf16* Qt = (LAS bf16*)lds;
    LAS bf16* Kt = (LAS bf16*)(lds + 34816);
    LAS bf16* Vt = (LAS bf16*)(lds + 69632);
    LAS bf16* SL = (LAS bf16*)(lds + 88064);
    LAS bf16* Pw = (LAS bf16*)(lds + 122880 + wave * 2304);
    const int g = lane >> 4, c16 = lane & 15, mt = wave & 3, cw = wave >> 2;
    for (int item = vcu; item < 256; item += G) {
        const int dir = item >> 7, b = (item >> 4) & 7, h = (item >> 2) & 3, eb = item & 3;
        const bf16* qsrc = dir == 0 ? P + h * 128 : QKR + h * 128; const int qld = dir == 0 ? N_C : 1024;
        const bf16* vsrc = P + 1024 + h * 256 + 64 * eb;
        const float* etp = ET + ((size_t)((dir * 8 + b) * 4 + h) * NCH) * 128 + 16 * wave + c16;
        bf16* odb = od_row_base(ws, dir, b) + h * 256 + 64 * eb;
        f32x4 acc[4];
#pragma unroll
        for (int et = 0; et < 4; ++et) acc[et] = (f32x4){0.f, 0.f, 0.f, 0.f};
        v4u qreg[2][2], kreg[2][2], vreg[2]; float etn[2];
#define GLA_JOF(sc_) (dir == 0 ? (sc_) : ((sc_) < 4 ? 3 - (sc_) : 71 - (sc_)))
#define GLA_PREFETCH(sc0_) do { _Pragma("unroll") for (int u = 0; u < 2; ++u) { const int jj = GLA_JOF((sc0_) + u); const int row0 = b * PB + jj * 64; \
            _Pragma("unroll") for (int i = 0; i < 2; ++i) { const int cidx = tid + 512 * i, rr = cidx >> 4, ch = cidx & 15; const bf16* sp = qsrc + (size_t)(row0 + rr) * qld + ch * 8; qreg[u][i] = *(const v4u*)sp; kreg[u][i] = *(const v4u*)(sp + 512); } \
            vreg[u] = *(const v4u*)(vsrc + (size_t)(row0 + (tid >> 3)) * N_C + (tid & 7) * 8); etn[u] = etp[(size_t)jj * 128]; } } while (0)
        GLA_PREFETCH(0);
        unsigned opk[8]; int ojc = -1;
#pragma unroll
        for (int i = 0; i < 8; ++i) opk[i] = 0u;
        for (int sc = 0; sc < NCH; sc += 2) {
            const int ja = GLA_JOF(sc), jb = GLA_JOF(sc + 1);
            __syncthreads();
            if (ojc >= 4 && !dry) {
#pragma unroll
                for (int nt = 0; nt < 4; ++nt) { bf16* orow = odb + (size_t)((ojc - 4) * 64 + 16 * mt + 4 * g) * 1024 + 16 * nt + c16;
#pragma unroll
                    for (int r = 0; r < 4; ++r) orow[(size_t)r * 1024] = (bf16)((opk[2 * nt + (r >> 1)] >> (16 * (r & 1))) & 0xffffu); } }
#pragma unroll
            for (int u = 0; u < 2; ++u) {
#pragma unroll
                for (int i = 0; i < 2; ++i) { const int cidx = tid + 512 * i, rr = cidx >> 4, ch = cidx & 15; *(LAS v4u*)(Qt + u * 8704 + rr * 136 + ch * 8) = qreg[u][i]; *(LAS v4u*)(Kt + u * 8704 + rr * 136 + ch * 8) = kreg[u][i]; }
                *(LAS v4u*)(Vt + u * 4608 + (tid >> 3) * 72 + (tid & 7) * 8) = vreg[u]; }
#pragma unroll
            for (int et = 0; et < 4; ++et)
#pragma unroll
                for (int r = 0; r < 4; ++r) SL[(16 * et + 4 * g + r) * 136 + 16 * wave + c16] = (bf16)f2bf(acc[et][r]);
            const float et_a = etn[0], et_b = etn[1];
            if (sc + 2 < NCH) GLA_PREFETCH(sc + 2);
            __syncthreads();
#pragma unroll
            for (int ks = 0; ks < 2; ++ks) { const bf16x8 kb = frag_tr(Kt, 136, 32 * ks, 16 * wave, lane);
#pragma unroll
                for (int et = 0; et < 4; ++et) acc[et] = mma(frag_tr(Vt, 72, 32 * ks, 16 * et, lane), kb, acc[et]); }
#pragma unroll
            for (int et = 0; et < 4; ++et) { acc[et] = acc[et] * et_a;
#pragma unroll
                for (int r = 0; r < 4; ++r) SL[8704 + (16 * et + 4 * g + r) * 136 + 16 * wave + c16] = (bf16)f2bf(acc[et][r]); }
            __syncthreads();
            const int jc = cw == 0 ? ja : jb;
            ojc = jc;
            if (jc >= 4) {
                const LAS bf16* Qc = Qt + cw * 8704; const LAS bf16* Kc = Kt + cw * 8704; const LAS bf16* Vc = Vt + cw * 4608; const LAS bf16* Sc = SL + cw * 8704;
                bf16x8 qf[4];
#pragma unroll
                for (int ks = 0; ks < 4; ++ks) qf[ks] = frag_row(Qc, 136, 16 * mt, 32 * ks, lane);
                bf16x8 pa[2];
                { f32x4 st[4];
#pragma unroll
                  for (int ns = 0; ns < 4; ++ns) { st[ns] = (f32x4){0.f, 0.f, 0.f, 0.f};
#pragma unroll
                      for (int ks = 0; ks < 4; ++ks) st[ns] = mma(frag_row(Kc, 136, 16 * ns, 32 * ks, lane), qf[ks], st[ns]);
#pragma unroll
                      for (int r = 0; r < 4; ++r) { const int sidx = 16 * ns + 4 * g + r, t = 16 * mt + c16; const bool ok = dir == 0 ? (sidx <= t) : (sidx >= t); st[ns][r] = ok ? st[ns][r] : 0.f; } }
#pragma unroll
                  for (int ks2 = 0; ks2 < 2; ++ks2) { const v4u wv = (v4u){pk2(st[2 * ks2][0], st[2 * ks2][1]), pk2(st[2 * ks2][2], st[2 * ks2][3]), pk2(st[2 * ks2 + 1][0], st[2 * ks2 + 1][1]), pk2(st[2 * ks2 + 1][2], st[2 * ks2 + 1][3])};
                      pa[ks2] = __builtin_bit_cast(bf16x8, wv); } }
#pragma unroll
                for (int nt = 0; nt < 4; ++nt) { f32x4 a = (f32x4){0.f, 0.f, 0.f, 0.f};
#pragma unroll
                    for (int ks = 0; ks < 4; ++ks) a = mma(qf[ks], frag_row(Sc, 136, 16 * nt, 32 * ks, lane), a);
                    a = mma(pa[0], frag_tr_perm(Vc, 72, 0, 16 * nt, lane), a); a = mma(pa[1], frag_tr_perm(Vc, 72, 32, 16 * nt, lane), a);
                    opk[2 * nt] = pk2(a[0], a[1]); opk[2 * nt + 1] = pk2(a[2], a[3]); }
                LDS_FENCE();
            }
#pragma unroll
            for (int ks = 0; ks < 2; ++ks) { const bf16x8 kb = frag_tr(Kt + 8704, 136, 32 * ks, 16 * wave, lane);
#pragma unroll
                for (int et = 0; et < 4; ++et) acc[et] = mma(frag_tr(Vt + 4608, 72, 32 * ks, 16 * et, lane), kb, acc[et]); }
#pragma unroll
            for (int et = 0; et < 4; ++et) acc[et] = acc[et] * et_b;
        }
        if (ojc >= 4 && !dry) {
#pragma unroll
            for (int nt = 0; nt < 4; ++nt) { bf16* orow = odb + (size_t)((ojc - 4) * 64 + 16 * mt + 4 * g) * 1024 + 16 * nt + c16;
#pragma unroll
                for (int r = 0; r < 4; ++r) orow[(size_t)r * 1024] = (bf16)((opk[2 * nt + (r >> 1)] >> (16 * (r & 1))) & 0xffffu); } }
#undef GLA_PREFETCH
#undef GLA_JOF
    }
}
__device__ __forceinline__ void gla_merge(bf16* P, const float* norm_w, unsigned char* ws, int gw, int NGW, int lane, int dry) {
    for (int i = gw; i < NB * SEQ; i += NGW) {
        const int b = i >> 12, lp = i & 4095; const size_t r = (size_t)b * PB + LC + lp;
        const bf16* of = od_row_base(ws, 0, b) + (size_t)lp * 1024 + 16 * lane; const bf16* orv = od_row_base(ws, 1, b) + (size_t)lp * 1024 + 16 * lane;
        bf16* grow = P + r * N_C + 2048 + 16 * lane;
        float x[16], y[16], gg[16];
        unpack8(*(const v4u*)of, x); unpack8(*(const v4u*)(of + 8), x + 8); unpack8(*(const v4u*)orv, y); unpack8(*(const v4u*)(orv + 8), y + 8);
        unpack8(*(const v4u*)grow, gg); unpack8(*(const v4u*)(grow + 8), gg + 8);
        float ss = 0.f;
#pragma unroll
        for (int k = 0; k < 16; ++k) { x[k] += y[k]; ss += x[k] * x[k]; }
        ss = gsum16(ss);
        const float rn = 1.f / sqrtf(ss * (1.f / 256.f) + LN_EPS);
        unsigned ow[8];
#pragma unroll
        for (int k = 0; k < 8; ++k) { const float4 dummy = make_float4(0.f, 0.f, 0.f, 0.f); (void)dummy;
            const float a = x[2 * k] * rn * norm_w[16 * lane + 2 * k] * siluf_(gg[2 * k]), c = x[2 * k + 1] * rn * norm_w[16 * lane + 2 * k + 1] * siluf_(gg[2 * k + 1]); ow[k] = pk2(a, c); }
        if (!dry) { v4u o0, o1; o0.x = ow[0]; o0.y = ow[1]; o0.z = ow[2]; o0.w = ow[3]; o1.x = ow[4]; o1.y = ow[5]; o1.z = ow[6]; o1.w = ow[7]; *(v4u*)grow = o0; *(v4u*)(grow + 8) = o1; }
    }
}

__device__ __forceinline__ void mlstm_fused_scan(const bf16* P, unsigned char* ws, LAS unsigned char* lds, int vcu, int G, int wave, int lane, int tid) {
    const float* BQ = (const float*)(ws + WS_BQ); const float* CQ = (const float*)(ws + WS_CQ); const float* EM = (const float*)(ws + WS_EM); const float* AI = (const float*)(ws + WS_AI);
    const float* AST = (const float*)(ws + WS_AST); const float* CL = (const float*)(ws + WS_CL);
    LAS bf16* Qt = (LAS bf16*)lds;
    LAS bf16* Kt = (LAS bf16*)(lds + 17408);
    LAS bf16* Vt = (LAS bf16*)(lds + 34816);
    LAS bf16* Vw = (LAS bf16*)(lds + 41984);
    LAS bf16* CT = (LAS bf16*)(lds + 49152);
    LAS bf16* Pw = (LAS bf16*)(lds + 62208 + wave * 2304);
    const int g = lane >> 4, c16 = lane & 15, mt = wave & 3, hf = wave >> 2;
    const int vrow = tid < 256 ? (tid >> 2) : ((tid - 256) & 63), vch = tid & 3;
    for (int item = vcu; item < 256; item += G) {
        const int dir = item >> 7, b = (item >> 4) & 7, h = (item >> 2) & 3, eb = item & 3;
        const int chain = dir * 32 + b * 4 + h;
        const bf16* qsrc = P + h * 128; const bf16* vsrc = P + 1024 + h * 128 + 32 * eb;
        bf16* odb = (bf16*)(ws + WS_ST) + (size_t)dir * TT * 512 + h * 128 + 32 * eb;
        f32x4 acc[3];
#pragma unroll
        for (int et = 0; et < 3; ++et) acc[et] = (f32x4){0.f, 0.f, 0.f, 0.f};
        v4u qreg[2], kreg[2], vreg; float bqr, cln, astn, cqn; f32x4 bqn[4], ain, emn;
        { const int j0 = dir == 0 ? 0 : 3; const int row0 = b * PB + j0 * 64; const size_t tb = (size_t)chain * PB + j0 * 64;
#pragma unroll
          for (int i = 0; i < 2; ++i) { const int cidx = tid + 512 * i, rr = cidx >> 4, ch = cidx & 15; const bf16* s = qsrc + (size_t)(row0 + rr) * N_AB + ch * 8; qreg[i] = *(const v4u*)s; kreg[i] = *(const v4u*)(s + 512); }
          vreg = *(const v4u*)(vsrc + (size_t)(row0 + vrow) * N_AB + vch * 8); bqr = BQ[tb + vrow]; cln = CL[chain * NCH + j0]; astn = AST[chain * NCH + j0];
#pragma unroll
          for (int k = 0; k < 4; ++k) bqn[k] = *(const f32x4*)(BQ + tb + 16 * k + 4 * g);
          cqn = CQ[tb + 16 * mt + c16]; ain = *(const f32x4*)(AI + tb + 16 * mt + 4 * g); emn = *(const f32x4*)(EM + tb + 16 * mt + 4 * g); }
        for (int sc = 0; sc < NCH; ++sc) {
            const int j = dir == 0 ? sc : (sc < 4 ? 3 - sc : 71 - sc);
            __syncthreads();
#pragma unroll
            for (int i = 0; i < 2; ++i) { const int cidx = tid + 512 * i, rr = cidx >> 4, ch = cidx & 15; *(LAS v4u*)(Qt + rr * 136 + ch * 8) = qreg[i]; *(LAS v4u*)(Kt + rr * 136 + ch * 8) = kreg[i]; }
            { const float wsv = __expf(bqr - cln);
              if (tid < 256) { const v4u raw = vreg; v4u o;
                  o.x = pk2(bflo(raw.x) * wsv, bfhi(raw.x) * wsv); o.y = pk2(bflo(raw.y) * wsv, bfhi(raw.y) * wsv); o.z = pk2(bflo(raw.z) * wsv, bfhi(raw.z) * wsv); o.w = pk2(bflo(raw.w) * wsv, bfhi(raw.w) * wsv);
                  *(LAS v4u*)(Vt + vrow * 56 + vch * 8) = raw; *(LAS v4u*)(Vw + vrow * 56 + vch * 8) = o;
              } else if (tid < 320) { v4u o; o.x = 0x3f80u; o.y = 0u; o.z = 0u; o.w = 0u; *(LAS v4u*)(Vt + vrow * 56 + 32) = o; o.x = f2bf(wsv); *(LAS v4u*)(Vw + vrow * 56 + 32) = o;
                  o.x = 0u; *(LAS v4u*)(Vt + vrow * 56 + 40) = o; *(LAS v4u*)(Vw + vrow * 56 + 40) = o; } }
#pragma unroll
            for (int et = 0; et < 3; ++et)
#pragma unroll
                for (int r = 0; r < 4; ++r) CT[(16 * et + 4 * g + r) * 136 + 16 * wave + c16] = (bf16)f2bf(acc[et][r]);
            const float ast = astn, cqt = cqn; f32x4 bq[4]; const f32x4 ai = ain, em = emn;
#pragma unroll
            for (int k = 0; k < 4; ++k) bq[k] = bqn[k];
            if (sc + 1 < NCH) { const int sn = sc + 1; const int jn = dir == 0 ? sn : (sn < 4 ? 3 - sn : 71 - sn); const int row0 = b * PB + jn * 64; const size_t tb = (size_t)chain * PB + jn * 64;
#pragma unroll
                for (int i = 0; i < 2; ++i) { const int cidx = tid + 512 * i, rr = cidx >> 4, ch = cidx & 15; const bf16* s = qsrc + (size_t)(row0 + rr) * N_AB + ch * 8; qreg[i] = *(const v4u*)s; kreg[i] = *(const v4u*)(s + 512); }
                vreg = *(const v4u*)(vsrc + (size_t)(row0 + vrow) * N_AB + vch * 8); bqr = BQ[tb + vrow]; cln = CL[chain * NCH + jn]; astn = AST[chain * NCH + jn];
#pragma unroll
                for (int k = 0; k < 4; ++k) bqn[k] = *(const f32x4*)(BQ + tb + 16 * k + 4 * g);
                cqn = CQ[tb + 16 * mt + c16]; ain = *(const f32x4*)(AI + tb + 16 * mt + 4 * g); emn = *(const f32x4*)(EM + tb + 16 * mt + 4 * g); }
            __syncthreads();
            bf16x8 qf[4];
#pragma unroll
            for (int ks = 0; ks < 4; ++ks) qf[ks] = frag_row(Qt, 136, 16 * mt, 32 * ks, lane);
            bf16x8 pa[2];
            { f32x4 st[4];
#pragma unroll
              for (int ns = 0; ns < 4; ++ns) { st[ns] = (f32x4){0.f, 0.f, 0.f, 0.f};
#pragma unroll
                  for (int ks = 0; ks < 4; ++ks) st[ns] = mma(frag_row(Kt, 136, 16 * ns, 32 * ks, lane), qf[ks], st[ns]);
#pragma unroll
                  for (int r = 0; r < 4; ++r) { const int sidx = 16 * ns + 4 * g + r, t = 16 * mt + c16; const bool ok = dir == 0 ? (sidx <= t) : (sidx >= t);
                      st[ns][r] = ok ? st[ns][r] * __expf(bq[ns][r] - cqt) : 0.f; } }
#pragma unroll
              for (int ks2 = 0; ks2 < 2; ++ks2) { const v4u wv = (v4u){pk2(st[2 * ks2][0], st[2 * ks2][1]), pk2(st[2 * ks2][2], st[2 * ks2][3]), pk2(st[2 * ks2 + 1][0], st[2 * ks2 + 1][1]), pk2(st[2 * ks2 + 1][2], st[2 * ks2 + 1][3])};
                  pa[ks2] = __builtin_bit_cast(bf16x8, wv); } }
            f32x4 av, ad;
            { f32x4 a = (f32x4){0.f, 0.f, 0.f, 0.f}, d = (f32x4){0.f, 0.f, 0.f, 0.f};
#pragma unroll
              for (int ks = 0; ks < 4; ++ks) { a = mma(qf[ks], frag_row(CT, 136, 16 * hf, 32 * ks, lane), a); d = mma(qf[ks], frag_row(CT, 136, 32, 32 * ks, lane), d); }
#pragma unroll
              for (int r = 0; r < 4; ++r) { a[r] *= ai[r]; d[r] *= ai[r]; }
#pragma unroll
              for (int ks = 0; ks < 2; ++ks) { a = mma(pa[ks], frag_tr_perm(Vt, 56, 32 * ks, 16 * hf, lane), a); d = mma(pa[ks], frag_tr_perm(Vt, 56, 32 * ks, 32, lane), d); }
              av = a; ad = d; }
            { bf16* orow = odb + (size_t)(b * PB + j * 64 + 16 * mt + 4 * g) * 512 + 16 * hf + c16;
#pragma unroll
              for (int r = 0; r < 4; ++r) { const float den = __shfl(ad[r], lane & 48); orow[(size_t)r * 512] = (bf16)f2bf(av[r] / fmaxf(fabsf(den), em[r])); } }
#pragma unroll
            for (int et = 0; et < 3; ++et) acc[et] = acc[et] * ast;
#pragma unroll
            for (int ks = 0; ks < 2; ++ks) { const bf16x8 kb = frag_tr(Kt, 136, 32 * ks, 16 * wave, lane);
#pragma unroll
                for (int et = 0; et < 3; ++et) acc[et] = mma(frag_tr(Vw, 56, 32 * ks, 16 * et, lane), kb, acc[et]); }
        }
    }
}
__device__ __forceinline__ void mlstm_merge(const bf16* P, bf16* CAT, const float* norm_w, unsigned char* ws, int gw, int NGW, int lane) {
    const bf16* OD = (const bf16*)(ws + WS_ST);
    for (int r = gw; r < TT; r += NGW) {
        float x[8], y[8], og[8];
        unpack8(*(const v4u*)(OD + (size_t)r * 512 + 8 * lane), x); unpack8(*(const v4u*)(OD + (size_t)TT * 512 + (size_t)r * 512 + 8 * lane), y);
        unpack8(*(const v4u*)(P + (size_t)r * N_AB + 1536 + 8 * lane), og);
        float ss = 0.f;
#pragma unroll
        for (int k = 0; k < 8; ++k) { x[k] += y[k]; ss += x[k] * x[k]; }
        ss = gsum16(ss);
        const float rn = 1.f / sqrtf(ss * (1.f / 128.f) + LN_EPS);
        unsigned ow[4];
#pragma unroll
        for (int k = 0; k < 4; ++k) ow[k] = pk2(x[2 * k] * rn * norm_w[8 * lane + 2 * k] * sigmoidf_(og[2 * k]), x[2 * k + 1] * rn * norm_w[8 * lane + 2 * k + 1] * sigmoidf_(og[2 * k + 1]));
        v4u o; o.x = ow[0]; o.y = ow[1]; o.z = ow[2]; o.w = ow[3]; *(v4u*)(CAT + (size_t)r * D + 8 * lane) = o;
    }
}

#ifndef PHMASK
#define PHMASK 0xffffffffu
#endif
#define PH(k) ((PHMASK >> (k)) & 1u)
#ifndef REPMASK
#define REPMASK 0u
#endif
#define REPS(k) (1 + (int)((REPMASK >> (k)) & 1u))
#if REPMASK
#define DRYV(k) ({ int d_ = (rep_ + 1 < REPS(k)) ? 1 : 0; asm volatile("" : "+s"(d_)); d_; })
#else
#define DRYV(k) 0
#endif
#ifndef DBG_LEVEL
#define DBG_LEVEL 3
#endif
typedef const __attribute__((address_space(4))) Args* KArgsP;
__device__ __forceinline__ KArgsP kargs() { KArgsP p = (KArgsP)__builtin_amdgcn_kernarg_segment_ptr(); asm volatile("" : "+s"(p)); return p; }
#define WSP(off) (ws + (off))
__global__ void __launch_bounds__(512, 2) fwd_megakernel(Args A_unused) {
    extern __shared__ __attribute__((aligned(16))) unsigned char lds_raw[];
    LAS unsigned char* lds = (LAS unsigned char*)lds_raw;
    const int tid0 = threadIdx.x;
    const int G = gridDim.x; const int bx = blockIdx.x; const int vcu = (G % 8 == 0) ? (bx % 8) * (G / 8) + bx / 8 : bx;
    const int NGW = G * 8;
    volatile LAS unsigned* MISC = (volatile LAS unsigned*)(lds + MISC_OFF);
    if (tid0 < 16) MISC[tid0] = 0u;
    __syncthreads();
    XcdBarrier bar;
    { KArgsP ap = kargs(); bar = xcd_barrier_post((unsigned*)(ap->ws + WS_CTL) + 1024, MISC + 8); }
#define GRID_BAR() xcd_barrier(bar)
#define PROLOG KArgsP ap = kargs(); unsigned char* ws = ap->ws; (void)ws; int tid = tid0; asm volatile("" : "+v"(tid)); const int lane = tid & 63, wave = __builtin_amdgcn_readfirstlane(tid >> 6), gw = vcu * 8 + wave; (void)lane; (void)wave; (void)gw;

    if (PH(0)) for (int rep_ = 0; rep_ < REPS(0); ++rep_) { int tid = tid0; asm volatile("" : "+v"(tid)); const int lane = tid & 63, wave = __builtin_amdgcn_readfirstlane(tid >> 6); Args A; { KArgsP ap = kargs();
#pragma unroll
        for (int i = 0; i < 22; ++i) A.in[i] = ap->in[i];
        A.out = ap->out; A.ws = ap->ws; }
        p0_prologue(A, lds, vcu, G, wave, lane, tid); }
    GRID_BAR();

    if (PH(1)) for (int rep_ = 0; rep_ < REPS(1); ++rep_) { PROLOG h_phase<16>(ap->in[I_X], ap->in[I_CTX], (const float*)WSP(WS_MOD), (bf16*)WSP(WS_HB), (const float*)WSP(WS_WG), (float*)WSP(WS_GL), lds, vcu, G, wave, lane, tid); }
    GRID_BAR();
    if (PH(2)) for (int rep_ = 0; rep_ < REPS(2); ++rep_) { PROLOG pg8::Gemm g{(const bf16*)WSP(WS_HB), (const bf16*)WSP(WS_WAB), TT, N_AB, 1024, 1024, 1024}; pg8::StaticOrder S; S.init(TT, N_AB, G, bx);
      pg8::EpiBf16 E{(bf16*)WSP(WS_P), N_AB}; pg8::gemm_phase<pg8::EpiBf16, pg8::StaticOrder>(lds, g, S, E, tid); }
    GRID_BAR();
#if DBG_LEVEL >= 2
    if (PH(3)) for (int rep_ = 0; rep_ < REPS(3); ++rep_) { PROLOG mlstm_gate_scan((const float*)WSP(WS_GL), ap->in[I_ABGB], ws, gw, NGW, lane); }
    if (PH(4)) for (int rep_ = 0; rep_ < REPS(4); ++rep_) { PROLOG attn_phase((const bf16*)WSP(WS_P), (bf16*)WSP(WS_HB), ap->in[I_ABSINK], (const float*)WSP(WS_ROPE), lds, (unsigned*)WSP(WS_CTL) + 6144 + 64 * rep_, vcu, G, wave, lane, tid); }
    GRID_BAR();
    if (PH(5)) for (int rep_ = 0; rep_ < REPS(5); ++rep_) { PROLOG mlstm_fused_scan((const bf16*)WSP(WS_P), ws, lds, vcu, G, wave, lane, tid); }
    GRID_BAR();
    if (PH(6)) for (int rep_ = 0; rep_ < REPS(6); ++rep_) { PROLOG mlstm_merge((const bf16*)WSP(WS_P), (bf16*)WSP(WS_HB), ap->in[I_ABNW], ws, gw, NGW, lane); }
    GRID_BAR();
#endif
    if (PH(7)) for (int rep_ = 0; rep_ < REPS(7); ++rep_) { PROLOG pg8::Gemm g{(const bf16*)WSP(WS_HB), (const bf16*)WSP(WS_WABO), TT, 1024, 1024, 1024, 1024}; pg8::StaticOrder S; S.init(TT, 1024, G, bx);
      pg8::EpiBf16 E{(bf16*)WSP(WS_P), 1024}; pg8::gemm_phase<pg8::EpiBf16, pg8::StaticOrder>(lds, g, S, E, tid); }
    GRID_BAR();
    if (PH(8)) for (int rep_ = 0; rep_ < REPS(8); ++rep_) { PROLOG ln_phase(ap->in[I_X], ap->in[I_CTX], ap->out, (float*)WSP(WS_XC), (const bf16*)WSP(WS_P), (const float*)WSP(WS_MOD), ap->in[I_LNW], ap->in[I_LNB], (bf16*)WSP(WS_HB), gw, NGW, lane, DRYV(8), false); }
    GRID_BAR();
#if DBG_LEVEL >= 3
    if (PH(9)) for (int rep_ = 0; rep_ < REPS(9); ++rep_) { PROLOG pg8::Gemm g{(const bf16*)WSP(WS_HB), (const bf16*)WSP(WS_WQ0), TT, 2048, 1024, 1024, 1024}; pg8::StaticOrder S; S.init(TT, 2048, G, bx);
      pg8::EpiBf16 E{(bf16*)WSP(WS_P), 2048}; pg8::gemm_phase<pg8::EpiBf16, pg8::StaticOrder>(lds, g, S, E, tid); }
    GRID_BAR();
    if (PH(10)) for (int rep_ = 0; rep_ < REPS(10); ++rep_) { PROLOG peer_route((const bf16*)WSP(WS_P), (const bf16*)WSP(WS_KEYS), (int*)WSP(WS_ST), (float*)WSP(WS_ST + 17 * MiB), gw, NGW, lane, false); }
    GRID_BAR();
#endif
    if (PH(11)) for (int rep_ = 0; rep_ < REPS(22); ++rep_) { PROLOG peer_pass1((const bf16*)WSP(WS_HB), (const int*)WSP(WS_ST), (const float*)WSP(WS_ST + 17 * MiB), WSP(WS_U), (const float*)WSP(WS_SCL), (const float*)WSP(WS_SCL) + 2 * NEXP, (float*)WSP(WS_ST + 34 * MiB), lds, wave, gw, NGW, lane, false); }
    if (PH(11)) for (int rep_ = 0; rep_ < REPS(11); ++rep_) { PROLOG peer_expert<(DBG_LEVEL >= 3)>((const float*)WSP(WS_ST + 34 * MiB), (const int*)WSP(WS_ST), WSP(WS_V),
        ap->out, (float*)WSP(WS_XC), (const float*)WSP(WS_MOD), ap->in[I_LNW] + 1024, ap->in[I_LNB] + 1024, lds, wave, gw, NGW, lane, DRYV(11), false); }
    GRID_BAR();

    if (PH(12)) for (int rep_ = 0; rep_ < REPS(12); ++rep_) { PROLOG h_phase<32>(ap->out, (const float*)WSP(WS_XC), (const float*)WSP(WS_MOD) + 9 * 6144, (bf16*)WSP(WS_HB), (const float*)WSP(WS_WLOW), (float*)WSP(WS_GL), lds, vcu, G, wave, lane, tid);
 }
    GRID_BAR();
    if (PH(13)) for (int rep_ = 0; rep_ < REPS(13); ++rep_) { PROLOG pg8::Gemm g{(const bf16*)WSP(WS_HB), (const bf16*)WSP(WS_WC), TT, N_C, 1024, 1024, 1024}; pg8::StaticOrder S; S.init(TT, N_C, G, bx);
      pg8::EpiBf16 E{(bf16*)WSP(WS_P), N_C}; pg8::gemm_phase<pg8::EpiBf16, pg8::StaticOrder>(lds, g, S, E, tid); }
    GRID_BAR();
#if DBG_LEVEL >= 2
    if (PH(14)) for (int rep_ = 0; rep_ < REPS(14); ++rep_) { PROLOG gla_prep((bf16*)WSP(WS_P), (bf16*)WSP(WS_HB), (const float*)WSP(WS_GL), ap->in[I_GGUP], ap->in[I_GGB], ws, lds, vcu, G, tid, DRYV(14)); }
    GRID_BAR();
    if (PH(15)) for (int rep_ = 0; rep_ < REPS(15); ++rep_) { PROLOG gla_fused_scan((const bf16*)WSP(WS_P), (const bf16*)WSP(WS_HB), ws, lds, vcu, G, wave, lane, tid, DRYV(15)); }
    GRID_BAR();
    if (PH(16)) for (int rep_ = 0; rep_ < REPS(16); ++rep_) { PROLOG gla_merge((bf16*)WSP(WS_P), ap->in[I_GNW], ws, gw, NGW, lane, DRYV(16)); }
    GRID_BAR();
#endif
    if (PH(17)) for (int rep_ = 0; rep_ < REPS(17); ++rep_) { PROLOG pg8::Gemm g{(const bf16*)WSP(WS_P) + 2048, (const bf16*)WSP(WS_WCO), TT, 1024, 1024, N_C, 1024}; pg8::LatOrder S; S.init(NB * SEQ, 1024, G, bx);
      pg8::EpiBf16 E{(bf16*)WSP(WS_HB), 1024}; pg8::gemm_phase<pg8::EpiBf16, pg8::LatOrder>(lds, g, S, E, tid); }
    GRID_BAR();
    if (PH(18)) for (int rep_ = 0; rep_ < REPS(18); ++rep_) { PROLOG ln_phase(ap->out, (const float*)WSP(WS_XC), ap->out, (float*)WSP(WS_XC), (const bf16*)WSP(WS_HB), (const float*)WSP(WS_MOD) + 9 * 6144, ap->in[I_LNW] + 2048, ap->in[I_LNB] + 2048, (bf16*)WSP(WS_HB), gw, NGW, lane, DRYV(18), true); }
    GRID_BAR();
#if DBG_LEVEL >= 3
    if (PH(19)) for (int rep_ = 0; rep_ < REPS(19); ++rep_) { PROLOG pg8::Gemm g{(const bf16*)WSP(WS_HB), (const bf16*)WSP(WS_WQ1), TT, 2048, 1024, 1024, 1024}; pg8::LatOrder S; S.init(NB * SEQ, 2048, G, bx);
      pg8::EpiBf16 E{(bf16*)WSP(WS_P), 2048}; pg8::gemm_phase<pg8::EpiBf16, pg8::LatOrder>(lds, g, S, E, tid); }
    GRID_BAR();
    if (PH(20)) for (int rep_ = 0; rep_ < REPS(20); ++rep_) { PROLOG peer_route((const bf16*)WSP(WS_P), (const bf16*)WSP(WS_KEYS) + (size_t)8 * 2 * 128 * 128, (int*)WSP(WS_ST), (float*)WSP(WS_ST + 17 * MiB), gw, NGW, lane, true); }
    GRID_BAR();
#endif
    if (PH(21)) for (int rep_ = 0; rep_ < REPS(22); ++rep_) { PROLOG peer_pass1((const bf16*)WSP(WS_HB), (const int*)WSP(WS_ST), (const float*)WSP(WS_ST + 17 * MiB), WSP(WS_U) + (size_t)NEXP * 512, (const float*)WSP(WS_SCL) + NEXP, (const float*)WSP(WS_SCL) + 3 * NEXP, (float*)WSP(WS_ST + 34 * MiB), lds, wave, gw, NGW, lane, true); }
    if (PH(21)) for (int rep_ = 0; rep_ < REPS(21); ++rep_) { PROLOG peer_expert<(DBG_LEVEL >= 3)>((const float*)WSP(WS_ST + 34 * MiB), (const int*)WSP(WS_ST), WSP(WS_V) + (size_t)NEXP * 512,
        ap->out, (float*)WSP(WS_XC), (const float*)WSP(WS_MOD) + 9 * 6144, ap->in[I_LNW] + 3072, ap->in[I_LNB] + 3072, lds, wave, gw, NGW, lane, DRYV(21), true); }
}

extern "C" void kernel_launch(void* const* d_in, const int* in_sizes, int n_in, void* d_out, int out_size, void* d_ws, size_t ws_size, hipStream_t stream) {
    static int grid = 0;
    if (grid == 0) {
        if (n_in != 22 || out_size != NB * SEQ * D || ws_size < 512 * MiB) { fprintf(stderr, "kernel_launch: unexpected shapes: n_in %d out %d ws %zu (need %zu)\n", n_in, out_size, ws_size, (size_t)WS_END); grid = -1; return; }
        int dev = 0, cus = 0, per_cu = 0;
        if (hipGetDevice(&dev) != hipSuccess || hipDeviceGetAttribute(&cus, hipDeviceAttributeMultiprocessorCount, dev) != hipSuccess) { grid = -1; return; }
        if (hipFuncSetAttribute((const void*)fwd_megakernel, hipFuncAttributeMaxDynamicSharedMemorySize, LDS_BYTES) != hipSuccess) { fprintf(stderr, "kernel_launch: hipFuncSetAttribute failed\n"); grid = -1; return; }
        if (hipOccupancyMaxActiveBlocksPerMultiprocessor(&per_cu, (const void*)fwd_megakernel, 512, LDS_BYTES) != hipSuccess || per_cu < 1) { fprintf(stderr, "kernel_launch: occupancy query says %d blocks per CU\n", per_cu); }
        (void)hipGetLastError();
        grid = cus;
        fprintf(stderr, "kernel_launch: grid %d, per_cu %d, ws %zu\n", grid, per_cu, ws_size);
    }
    if (grid < 0) return;
    if (hipMemsetAsync((char*)d_ws + WS_CTL, 0, CTL_ZERO_BYTES, stream) != hipSuccess) return;
    Args a{};
    for (int i = 0; i < 22; ++i) a.in[i] = (const float*)d_in[i];
    a.out = (float*)d_out; a.ws = (unsigned char*)d_ws;
    hipLaunchKernelGGL(fwd_megakernel, dim3(grid), dim3(512), LDS_BYTES, stream, a);
}
```

```cpp
#include <hip/hip_runtime.h>
#include <cstdio>
#include <cstdint>

#define GAS __attribute__((address_space(1)))
#define LAS __attribute__((address_space(3)))
typedef unsigned short bf16;
typedef unsigned v4u __attribute__((ext_vector_type(4)));
typedef unsigned v2u __attribute__((ext_vector_type(2)));
typedef float f32x4 __attribute__((ext_vector_type(4)));
typedef float f32x2 __attribute__((ext_vector_type(2)));
typedef short bf16x8 __attribute__((ext_vector_type(8)));
typedef short s16x4 __attribute__((ext_vector_type(4)));
typedef GAS unsigned gu32;
#define RLX_AGENT __ATOMIC_RELAXED, __HIP_MEMORY_SCOPE_AGENT

constexpr int NB = 8, SEQ = 4096, LC = 256, D = 1024;
constexpr int PB = LC + SEQ;
constexpr int TT = NB * PB;
constexpr int NCH = PB / 64;
constexpr int N_AB = 2816;
constexpr int N_C = 3072;
constexpr float LN_EPS = 1e-5f;
constexpr float DN_ALPHA = 1.41421356237f;
constexpr int NEXP = 16384;
__device__ __forceinline__ int map_row(int i, bool lat_only) { return lat_only ? (i >> 12) * 4352 + 256 + (i & 4095) : i; }

constexpr size_t MiB = 1u << 20;
constexpr size_t WS_CTL = 0, CTL_ZERO_BYTES = 64 * 1024;
constexpr size_t WS_MOD = 1 * MiB;
constexpr size_t WS_ROPE = 2 * MiB;
constexpr size_t WS_WG = 2 * MiB + 64 * 1024;
constexpr size_t WS_WLOW = 2 * MiB + 128 * 1024;
constexpr size_t WS_SCL = 3 * MiB;
constexpr size_t WS_BQ = 4 * MiB, WS_CQ = WS_BQ + 1200 * 1024, WS_EM = WS_CQ + 1200 * 1024, WS_AI = WS_EM + 1200 * 1024;
constexpr size_t WS_AST = WS_AI + 1200 * 1024, WS_CL = WS_AST + 32 * 1024;
constexpr size_t WS_ET = 10 * MiB;
constexpr size_t WS_GL = 13 * MiB;
constexpr size_t WS_WAB = 20 * MiB, WS_WABO = 26 * MiB, WS_WC = 28 * MiB, WS_WCO = 34 * MiB, WS_WQ0 = 36 * MiB, WS_WQ1 = 40 * MiB, WS_KEYS = 44 * MiB;
constexpr size_t WS_NST = 45 * MiB;
constexpr size_t WS_XC = 48 * MiB;
constexpr size_t WS_U = 56 * MiB, WS_V = 88 * MiB;
constexpr size_t WS_HB = 120 * MiB;
constexpr size_t WS_P = 188 * MiB;
constexpr size_t WS_ST = 392 * MiB;
constexpr size_t WS_END = 460 * MiB;

constexpr int LDS_BYTES = 163840;
constexpr int MISC_OFF = LDS_BYTES - 64;

typedef __bf16 hwbf2 __attribute__((ext_vector_type(2)));
__device__ __forceinline__ unsigned pk2(float lo, float hi) { const f32x2 v = {lo, hi}; const hwbf2 r = __builtin_convertvector(v, hwbf2); return __builtin_bit_cast(unsigned, r); }
__device__ __forceinline__ unsigned f2bf(float f) { return pk2(f, f) & 0xffffu; }
__device__ __forceinline__ float bflo(unsigned w) { return __builtin_bit_cast(float, w << 16); }
__device__ __forceinline__ float bfhi(unsigned w) { return __builtin_bit_cast(float, w & 0xffff0000u); }
__device__ __forceinline__ float bf2f(bf16 b) { return __builtin_bit_cast(float, (unsigned)b << 16); }
template <int CTRL> __device__ __forceinline__ float dppmov_f(float x) { return __builtin_bit_cast(float, __builtin_amdgcn_mov_dpp(__builtin_bit_cast(int, x), CTRL, 0xf, 0xf, true)); }
__device__ __forceinline__ float wave_sum(float v) {
    v += dppmov_f<0xB1>(v); v += dppmov_f<0x4E>(v); v += dppmov_f<0x141>(v); v += dppmov_f<0x128>(v);
    v += __shfl_xor(v, 16); v += __shfl_xor(v, 32);
    return v;
}
__device__ __forceinline__ float sigmoidf_(float x) { return 1.f / (1.f + __expf(-x)); }
__device__ __forceinline__ float logsigmoidf_(float x) { return fminf(x, 0.f) - log1pf(__expf(-fabsf(x))); }
__device__ __forceinline__ float siluf_(float x) { return x / (1.f + __expf(-x)); }

namespace pg8 {
#define PG8_LAS __attribute__((address_space(3)))
typedef unsigned short bf16_t;
typedef short bf16x8 __attribute__((ext_vector_type(8)));
typedef float f32x4 __attribute__((ext_vector_type(4)));
typedef unsigned u32x4 __attribute__((ext_vector_type(4)));
constexpr int BM = 256, BK = 64, HALF = 128, HTB = HALF * BK * 2  , STAGE_BYTES = 8 * HTB, NXCD = 8, WGM = 8;

__host__ __device__ __forceinline__ int lds_byte(int r, int c) { const int st = (r >> 4) * 2 + (c >> 5), rr = r & 15, cc = c & 31, ob = rr * 64 + cc * 2; return st * 1024 + (ob ^ (((ob >> 9) & 1) << 5)); }
__host__ __device__ __forceinline__ void stage_rc(int b, int& R, int& C) { const int st = b / 1024, sb = b % 1024, swz = sb ^ (((sb >> 9) & 1) << 5); R = (st >> 1) * 16 + swz / 64; C = (st & 1) * 32 + (swz % 64) / 2; }
__host__ __device__ __forceinline__ int perm32(int rho) { const int n = rho >> 4, i = rho & 15; return 8 * (i >> 2) + 4 * n + (i & 3); }

struct Unit { int pm, pn; };
struct Gemm { const bf16_t* A; const bf16_t* Bt; int M, N, K, lda, ldb; };

struct StaticOrder {
    int nM, nN, nwg, G, c;
    __host__ __device__ void init(int M, int N, int G_, int c_) { nM = M / BM; nN = N / BM; nwg = nM * nN; G = G_; c = c_; }
    __host__ __device__ bool next(int i, Unit& u) const {
        const long L = (long)i * G + c; if (L >= nwg) return false;
        int wgid = (int)L; { const int q = nwg / NXCD, r = nwg % NXCD, xcd = wgid % NXCD, off = wgid / NXCD; wgid = (xcd < r ? xcd * (q + 1) : r * (q + 1) + (xcd - r) * q) + off; }
        const int nig = WGM * nN, gid = wgid / nig, fm = gid * WGM, gsz = (nM - fm) < WGM ? (nM - fm) : WGM;
        u.pm = fm + ((wgid % nig) % gsz); u.pn = (wgid % nig) / gsz; return true;
    }
    __device__ __forceinline__ void a_ready(const Unit&) const {}
    __device__ __forceinline__ void done(const Unit&) const {}
};

struct LatOrder : StaticOrder {
    __host__ __device__ bool next(int i, Unit& u) const { if (!StaticOrder::next(i, u)) return false; u.pm = (u.pm >> 4) * 17 + 1 + (u.pm & 15); return true; }
};
struct CtxOrder : StaticOrder {
    __host__ __device__ bool next(int i, Unit& u) const { if (i != 0 || c >= 32) return false; u.pm = (c >> 2) * 17; u.pn = c & 3; return true; }
};
__device__ __forceinline__ unsigned cvt_pk_bf16(float lo, float hi) { unsigned r; asm volatile("v_cvt_pk_bf16_f32 %0, %1, %2" : "=v"(r) : "v"(lo), "v"(hi)); return r; }
struct EpiBf16 {
    static constexpr bool PERM = true, AFTER_DRAIN = false;
    bf16_t* O; int ldc;
    __device__ __forceinline__ void operator()(const f32x4 (&acc)[2][2][4][2], const Unit& u, int wr, int wc, int fr, int fq) const {
        const int row0 = u.pm * BM + wr * 64 + fr; const int col0 = u.pn * BM + wc * 32 + 8 * fq;
#pragma unroll
        for (int ai = 0; ai < 2; ++ai)
#pragma unroll
            for (int m = 0; m < 4; ++m) { bf16_t* rowp = O + (size_t)(row0 + ai * HALF + m * 16) * ldc + col0;
#pragma unroll
                for (int bj = 0; bj < 2; ++bj) { const f32x4 v0 = acc[ai][bj][m][0], v1 = acc[ai][bj][m][1];
                    u32x4 w; w.x = cvt_pk_bf16(v0[0], v0[1]); w.y = cvt_pk_bf16(v0[2], v0[3]); w.z = cvt_pk_bf16(v1[0], v1[1]); w.w = cvt_pk_bf16(v1[2], v1[3]);
                    *(u32x4*)(rowp + bj * HALF) = w; } }
    }
};
struct EpiResid {
    static constexpr bool PERM = false, AFTER_DRAIN = false;
    const float* src_lat; const float* src_ctx; float* dst_lat; float* dst_ctx; const float* gate; float gscale; int dry;
    __device__ __forceinline__ void operator()(const f32x4 (&acc)[2][2][4][2], const Unit& u, int wr, int wc, int fr, int fq) const {
        const int b = u.pm / 17, tb = u.pm - b * 17;
        const float* sbase; float* dbase; const float* gr;
        if (tb == 0) { sbase = src_ctx + (size_t)b * 256 * 1024; dbase = dst_ctx + (size_t)b * 256 * 1024; gr = gate + 8 * 6144; }
        else { sbase = src_lat + ((size_t)b * 4096 + (size_t)(tb - 1) * 256) * 1024; dbase = dst_lat + ((size_t)b * 4096 + (size_t)(tb - 1) * 256) * 1024; gr = gate + b * 6144; }
        const int row0 = wr * 64 + fr, col0 = u.pn * BM + wc * 32 + 4 * fq;
        f32x4 gv[2][2];
#pragma unroll
        for (int bj = 0; bj < 2; ++bj)
#pragma unroll
            for (int n = 0; n < 2; ++n) gv[bj][n] = *(const f32x4*)(gr + col0 + bj * HALF + n * 16) * gscale;
#pragma unroll
        for (int ai = 0; ai < 2; ++ai)
#pragma unroll
            for (int mp = 0; mp < 2; ++mp) {
                f32x4 sv[2][2][2];
#pragma unroll
                for (int mm = 0; mm < 2; ++mm) { const size_t off = (size_t)(row0 + ai * HALF + (2 * mp + mm) * 16) * 1024 + col0;
#pragma unroll
                    for (int bj = 0; bj < 2; ++bj)
#pragma unroll
                        for (int n = 0; n < 2; ++n) sv[mm][bj][n] = __builtin_nontemporal_load((const f32x4*)(sbase + off + bj * HALF + n * 16)); }
                asm volatile("" ::: "memory");
#pragma unroll
                for (int mm = 0; mm < 2; ++mm) { const int m = 2 * mp + mm; const size_t off = (size_t)(row0 + ai * HALF + m * 16) * 1024 + col0;
#pragma unroll
                    for (int bj = 0; bj < 2; ++bj)
#pragma unroll
                        for (int n = 0; n < 2; ++n) { const f32x4 ov = sv[mm][bj][n] * 1.41421356237f + gv[bj][n] * acc[ai][bj][m][n]; if (!dry) *(f32x4*)(dbase + off + bj * HALF + n * 16) = ov; } }
                asm volatile("" ::: "memory");
            }
    }
};

template <class Epi, class Sched>
__device__ __forceinline__ void gemm_phase(PG8_LAS unsigned char* lds, const Gemm g, const Sched& S, const Epi& E, const int tid_in) {
    const int tid = tid_in, wid = __builtin_amdgcn_readfirstlane(tid >> 6), lane = tid & 63, wr = wid >> 2, wc = wid & 3, fr = lane & 15, fq = lane >> 4;
    const int K = g.K, nt = K / BK;
    unsigned voffA[2], voffB[2];
#pragma unroll
    for (int i = 0; i < 2; ++i) { int R, C; stage_rc(tid * 16 + i * 8192, R, C); const int Rb = Epi::PERM ? ((R & ~31) + perm32(R & 31)) : R;
        voffA[i] = (unsigned)(R * g.lda + C) * 2u; voffB[i] = (unsigned)(Rb * g.ldb + C) * 2u; }
    const size_t kstep = (size_t)(BK * 2);
    const size_t hstepA = (size_t)HALF * g.lda * 2, hstepB = (size_t)HALF * g.ldb * 2;
    const size_t tstepA = 2 * hstepA, tstepB = 2 * hstepB;
    const unsigned ldsw = (unsigned)wid * 1024u;
    const int aoff = lds_byte(wr * 64 + fr, fq * 8), boff = lds_byte(wc * 32 + fr, fq * 8);
#define PG8_SA(b, h) (((b) * 2 + (h)) * HTB)
#define PG8_SB(b, h) ((4 + (b) * 2 + (h)) * HTB)
#define PG8_STAGE(bufoff, gbase, voff) do { _Pragma("unroll") for (int _i = 0; _i < 2; ++_i) \
        __builtin_amdgcn_global_load_lds((const unsigned*)((const char*)(gbase) + (voff)[_i]), (PG8_LAS unsigned*)(lds + (bufoff) + ldsw + _i * 8192), 16, 0, 0); } while (0)
#define PG8_LDA(dst, b, h) do { _Pragma("unroll") for (int m = 0; m < 4; ++m) _Pragma("unroll") for (int k = 0; k < 2; ++k) dst[m][k] = *(const PG8_LAS bf16x8*)(lds + PG8_SA(b, h) + aoff + m * 2048 + k * 1024); } while (0)
#define PG8_LDB(dst, b, h) do { _Pragma("unroll") for (int n = 0; n < 2; ++n) _Pragma("unroll") for (int k = 0; k < 2; ++k) dst[n][k] = *(const PG8_LAS bf16x8*)(lds + PG8_SB(b, h) + boff + n * 2048 + k * 1024); } while (0)
#define PG8_MMA(ai, bj, At, Bt) do { __builtin_amdgcn_s_setprio(1); _Pragma("unroll") for (int m = 0; m < 4; ++m) _Pragma("unroll") for (int n = 0; n < 2; ++n) _Pragma("unroll") for (int k = 0; k < 2; ++k) \
        acc[ai][bj][m][n] = __builtin_amdgcn_mfma_f32_16x16x32_bf16(Bt[n][k], At[m][k], acc[ai][bj][m][n], 0, 0, 0); __builtin_amdgcn_s_setprio(0); } while (0)
#define PG8_WAIT_V(n) asm volatile("s_waitcnt vmcnt(" #n ")" ::: "memory")
#define PG8_WAIT_L(n) asm volatile("s_waitcnt lgkmcnt(" #n ")" ::: "memory")
#define PG8_BAR __builtin_amdgcn_s_barrier()
#define PG8_SCHED __builtin_amdgcn_sched_barrier(0)
    Unit cur, nxt; int ui = 0;
    if (!S.next(0, cur)) return;
    f32x4 acc[2][2][4][2];
#pragma unroll
    for (int a = 0; a < 2; ++a)
#pragma unroll
        for (int b = 0; b < 2; ++b)
#pragma unroll
            for (int m = 0; m < 4; ++m)
#pragma unroll
                for (int n = 0; n < 2; ++n) acc[a][b][m][n] = (f32x4){0.f, 0.f, 0.f, 0.f};
    bf16x8 At[4][2], B0[2][2], B1[2][2];
    const char* cA = (const char*)g.A + (size_t)cur.pm * tstepA; const char* cB = (const char*)g.Bt + (size_t)cur.pn * tstepB;
    S.a_ready(cur);
    PG8_STAGE(PG8_SB(0, 0), cB, voffB); PG8_STAGE(PG8_SA(0, 0), cA, voffA); PG8_STAGE(PG8_SB(0, 1), cB + hstepB, voffB); PG8_STAGE(PG8_SA(0, 1), cA + hstepA, voffA);
    if (wr == 1) PG8_BAR;
    PG8_WAIT_V(4); PG8_BAR;
    PG8_STAGE(PG8_SB(1, 0), cB + kstep, voffB); PG8_STAGE(PG8_SA(1, 0), cA + kstep, voffA); PG8_STAGE(PG8_SB(1, 1), cB + hstepB + kstep, voffB);
    PG8_WAIT_V(6); PG8_BAR;
    for (;;) {
        const bool has_next = S.next(ui + 1, nxt);
        const char* nA = has_next ? (const char*)g.A + (size_t)nxt.pm * tstepA : cA; const char* nB = has_next ? (const char*)g.Bt + (size_t)nxt.pn * tstepB : cB;
        for (int t = 0; t < nt; t += 2) {
            const bool last = (t == nt - 2);
            const char* a1 = cA + (size_t)(t + 1) * kstep;
            const char* a2 = last ? nA : cA + (size_t)(t + 2) * kstep; const char* b2 = last ? nB : cB + (size_t)(t + 2) * kstep;
            const char* a3 = a2 + kstep; const char* b3 = b2 + kstep;
            if (last && has_next) S.a_ready(nxt);
            PG8_LDB(B0, 0, 0); PG8_SCHED; PG8_LDA(At, 0, 0); PG8_STAGE(PG8_SA(1, 1), a1 + hstepA, voffA);
            PG8_WAIT_L(8); PG8_BAR; PG8_WAIT_L(0); PG8_MMA(0, 0, At, B0); PG8_BAR; PG8_SCHED;
            PG8_LDB(B1, 0, 1); PG8_STAGE(PG8_SB(0, 0), b2, voffB);
            PG8_BAR; PG8_WAIT_L(0); PG8_MMA(0, 1, At, B1); PG8_BAR;
            PG8_LDA(At, 0, 1); PG8_STAGE(PG8_SA(0, 0), a2, voffA);
            PG8_BAR; PG8_WAIT_L(0); PG8_MMA(1, 0, At, B0); PG8_BAR; PG8_SCHED;
            PG8_STAGE(PG8_SB(0, 1), b2 + hstepB, voffB);
            PG8_WAIT_V(6); PG8_BAR; PG8_MMA(1, 1, At, B1); PG8_BAR;
            PG8_LDB(B0, 1, 0); PG8_SCHED; PG8_LDA(At, 1, 0); PG8_STAGE(PG8_SA(0, 1), a2 + hstepA, voffA);
            PG8_WAIT_L(8); PG8_BAR; PG8_WAIT_L(0); PG8_MMA(0, 0, At, B0); PG8_BAR; PG8_SCHED;
            PG8_LDB(B1, 1, 1); PG8_STAGE(PG8_SB(1, 0), b3, voffB);
            PG8_BAR; PG8_WAIT_L(0); PG8_MMA(0, 1, At, B1); PG8_BAR;
            PG8_LDA(At, 1, 1); PG8_STAGE(PG8_SA(1, 0), a3, voffA);
            PG8_BAR; PG8_WAIT_L(0); PG8_MMA(1, 0, At, B0); PG8_BAR; PG8_SCHED;
            PG8_STAGE(PG8_SB(1, 1), b3 + hstepB, voffB);
            PG8_WAIT_V(6); PG8_BAR; PG8_MMA(1, 1, At, B1); PG8_BAR;
        }
        if constexpr (!Epi::AFTER_DRAIN) { E(acc, cur, wr, wc, fr, fq); S.done(cur); }
        if (!has_next) break;
#pragma unroll
        for (int a = 0; a < 2; ++a)
#pragma unroll
            for (int b = 0; b < 2; ++b)
#pragma unroll
                for (int m = 0; m < 4; ++m)
#pragma unroll
                    for (int n = 0; n < 2; ++n) acc[a][b][m][n] = (f32x4){0.f, 0.f, 0.f, 0.f};
        cur = nxt; cA = nA; cB = nB; ++ui;
    }
    PG8_WAIT_V(0);
    if (wr == 0) PG8_BAR;
    PG8_BAR;
    if constexpr (Epi::AFTER_DRAIN) { E.fused(acc, cur, wr, wc, fr, fq, lds, wid, lane); S.done(cur); }
#undef PG8_SA
#undef PG8_SB
#undef PG8_STAGE
#undef PG8_LDA
#undef PG8_LDB
#undef PG8_MMA
#undef PG8_WAIT_V
#undef PG8_WAIT_L
#undef PG8_BAR
#undef PG8_SCHED
}
}

#define XB_TMO      128
#define XB_XCNT(j)  (256  + 64 * (j))
#define XB_XSUB(j)  (1280 + 64 * (j))
#define XB_XGEN(j)  (2304 + 64 * (j))
#define XB_TOP      3328
#define XB_TOPGEN   3392
#define XCD_BAR_WORDS 3456
#define XB_SPIN_CAP (1u << 18)

__device__ __forceinline__ unsigned xb_ld(unsigned* p)              { return __hip_atomic_load(p, __ATOMIC_RELAXED, __HIP_MEMORY_SCOPE_AGENT); }
__device__ __forceinline__ unsigned xb_add(unsigned* p, unsigned v) { return __hip_atomic_fetch_add(p, v, __ATOMIC_RELAXED, __HIP_MEMORY_SCOPE_AGENT); }
__device__ __forceinline__ unsigned xb_xcc_id() { return (unsigned)__builtin_amdgcn_s_getreg((3 << 11) | 20) & 0xFu; }
#define XB_SPIN(cond, bar) do { unsigned _sp = 0; while (cond) { __builtin_amdgcn_s_sleep(1); \
    if ((++_sp & 255u) == 0u) { if (xb_ld(&(bar)[XB_TMO])) break; if (_sp > XB_SPIN_CAP) { atomicAdd(&(bar)[XB_TMO], 1u); break; } } } } while (0)

struct XcdBarrier {
    unsigned* bar; unsigned x;
    volatile LAS unsigned* st;
};

__device__ __forceinline__ XcdBarrier xcd_barrier_post(unsigned* bar, volatile LAS unsigned* st) {
    XcdBarrier b; b.bar = bar; b.x = xb_xcc_id(); b.st = st;
    if (threadIdx.x == 0) (void)xb_add(&bar[XB_XCNT(b.x)], 1u);
    return b;
}
__device__ __forceinline__ void xcd_barrier_complete(unsigned* bar, unsigned x, unsigned& nloc, unsigned& nx) {
    const unsigned G = gridDim.x * gridDim.y * gridDim.z;
    unsigned sum, cnt, mine, sp = 0u;
    for (;;) {
        sum = 0u; cnt = 0u; mine = 0u;
#pragma unroll
        for (unsigned j = 0; j < 16; ++j) { const unsigned c = xb_ld(&bar[XB_XCNT(j)]); sum += c; cnt += (c > 0u) ? 1u : 0u; mine = (j == x) ? c : mine; }
        if (sum == G) break;
        __builtin_amdgcn_s_sleep(1);
        if ((++sp & 255u) == 0u) { if (xb_ld(&bar[XB_TMO])) break; if (sp > XB_SPIN_CAP) { atomicAdd(&bar[XB_TMO], 1u); break; } }
    }
    nloc = mine > 0u ? mine : 1u; nx = cnt > 0u ? cnt : 1u;
}

__device__ __forceinline__ void xcd_barrier(const XcdBarrier& b) {
    asm volatile("s_waitcnt vmcnt(0)" ::: "memory");
    __syncthreads();
    if (threadIdx.x == 0) {
        unsigned* bar = b.bar;
        __builtin_amdgcn_s_waitcnt(0);
        unsigned nloc = b.st[0], nx = b.st[1];
        if (nloc == 0u) { xcd_barrier_complete(bar, b.x, nloc, nx); b.st[0] = nloc; b.st[1] = nx; }
        const unsigned old = xb_add(&bar[XB_XSUB(b.x)], 1u);
        const unsigned gen = old / nloc;
        if (old + 1u == (gen + 1u) * nloc) {
            __builtin_amdgcn_fence(__ATOMIC_RELEASE, "agent");
            asm volatile("s_waitcnt vmcnt(0)" ::: "memory");
            const unsigned og = xb_add(&bar[XB_TOP], 1u);
            const unsigned tg = og / nx;
            if (og + 1u == (tg + 1u) * nx) xb_add(&bar[XB_TOPGEN], 1u);
            else XB_SPIN(xb_ld(&bar[XB_TOPGEN]) == tg, bar);
            __builtin_amdgcn_fence(__ATOMIC_ACQUIRE, "agent");
            xb_add(&bar[XB_XGEN(b.x)], 1u);
            asm volatile("s_waitcnt vmcnt(0)" ::: "memory");
        } else {
            XB_SPIN(xb_ld(&bar[XB_XGEN(b.x)]) == gen, bar);
            __builtin_amdgcn_fence(__ATOMIC_ACQUIRE, "agent");
            asm volatile("s_waitcnt vmcnt(0)" ::: "memory");
        }
    }
    __syncthreads();
}


__device__ __forceinline__ f32x4 mma(bf16x8 a, bf16x8 b, f32x4 c) { return __builtin_amdgcn_mfma_f32_16x16x32_bf16(a, b, c, 0, 0, 0); }
__device__ __forceinline__ bf16x8 frag_row(const LAS bf16* t, int ld, int r0, int c0, int lane) {
    return *(const LAS bf16x8*)(t + (r0 + (lane & 15)) * ld + c0 + 8 * (lane >> 4));
}
__device__ __forceinline__ bf16x8 frag_tr(const LAS bf16* t, int ld, int r0, int c0, int lane) {
    const int g = lane >> 4, q = (lane & 15) >> 2, p = lane & 3;
    const LAS bf16* a = t + (r0 + 8 * g + q) * ld + c0 + 4 * p;
    const s16x4 lo = __builtin_amdgcn_ds_read_tr16_b64_v4i16((LAS s16x4*)a);
    const s16x4 hi = __builtin_amdgcn_ds_read_tr16_b64_v4i16((LAS s16x4*)(a + 4 * ld));
    return (bf16x8){lo[0], lo[1], lo[2], lo[3], hi[0], hi[1], hi[2], hi[3]};
}
#define LDS_FENCE() do { asm volatile("s_waitcnt lgkmcnt(0)" ::: "memory"); __builtin_amdgcn_wave_barrier(); } while (0)

struct Args {
    const float* in[22]; float* out; unsigned char* ws;
};
enum { I_X = 0, I_C, I_CTX, I_CCTX, I_WMOD, I_BMOD, I_LNW, I_LNB, I_ABWIN, I_ABGB, I_ABNW, I_ABSINK, I_ABWOUT, I_GWIN, I_GGUP, I_GGB, I_GNW, I_GWOUT, I_PWQ, I_PKEYS, I_PU, I_PV };

__device__ __forceinline__ const float* srow_c(const float* lat, const float* ctx, int r) { const int b = r / PB, p = r - b * PB; return p < LC ? ctx + (size_t)(b * LC + p) * D : lat + (size_t)(b * SEQ + p - LC) * D; }
__device__ __forceinline__ float* srow(float* lat, float* ctx, int r) { const int b = r / PB, p = r - b * PB; return p < LC ? ctx + (size_t)(b * LC + p) * D : lat + (size_t)(b * SEQ + p - LC) * D; }

__device__ __forceinline__ void p0_transpose_item(const float* W, int K, int ldw, int c0, int ncols, bf16* WT, int row_off, LAS float* scr, int item, int lane,
                                                  int s0lo, int s0hi, float s0, int s1lo, int s1hi, float s1) {
    const int nblk = ncols / 32, kb = item / nblk, nb = item % nblk, k0 = 64 * kb, n0 = 32 * nb;
#pragma unroll 8
    for (int i = 0; i < 32; ++i) { const int kk = 2 * i + (lane >> 5); scr[kk * 33 + (lane & 31)] = W[(size_t)(k0 + kk) * ldw + c0 + n0 + (lane & 31)]; }
    asm volatile("s_waitcnt lgkmcnt(0)" ::: "memory");
    const int c = lane & 7;
#pragma unroll
    for (int j = 0; j < 4; ++j) { const int n = (lane >> 3) + 8 * j; const LAS float* s = scr + (8 * c) * 33 + n;
        const int dr = row_off + n0 + n; float sc = 1.f; if (dr >= s0lo && dr < s0hi) sc = s0; if (dr >= s1lo && dr < s1hi) sc = s1;
        v4u o; o.x = pk2(s[0 * 33] * sc, s[1 * 33] * sc); o.y = pk2(s[2 * 33] * sc, s[3 * 33] * sc); o.z = pk2(s[4 * 33] * sc, s[5 * 33] * sc); o.w = pk2(s[6 * 33] * sc, s[7 * 33] * sc);
        *(v4u*)(WT + (size_t)dr * K + k0 + 8 * c) = o; }
    asm volatile("s_waitcnt lgkmcnt(0)" ::: "memory");
}
__device__ __forceinline__ void cvt_f32_bf16(const float* src, bf16* dst, size_t n, int gtid, int gthreads) {
    const size_t nch = n / 8;
    for (size_t i = gtid; i < nch; i += gthreads) { const f32x4 a = *(const f32x4*)(src + i * 8), b = *(const f32x4*)(src + i * 8 + 4);
        v4u o; o.x = pk2(a[0], a[1]); o.y = pk2(a[2], a[3]); o.z = pk2(b[0], b[1]); o.w = pk2(b[2], b[3]); *(v4u*)(dst + i * 8) = o; }
}
__device__ __forceinline__ void cvt_rows_fp4(const float* src, unsigned char* dst, float* inv, int nrows, int gw, int NGW, int lane) {
    const int hl = lane & 31, hh = lane >> 5;
    for (int r2 = gw; r2 < nrows / 2; r2 += NGW) {
        const int r = 2 * r2 + hh; const float* sp = src + (size_t)r * 1024 + 32 * hl;
        f32x4 x[8]; float m = 0.f;
#pragma unroll
        for (int q = 0; q < 8; ++q) { x[q] = *(const f32x4*)(sp + 4 * q); m = fmaxf(m, fmaxf(fmaxf(fabsf(x[q][0]), fabsf(x[q][1])), fmaxf(fabsf(x[q][2]), fabsf(x[q][3])))); }
        m = fmaxf(m, dppmov_f<0xB1>(m)); m = fmaxf(m, dppmov_f<0x4E>(m)); m = fmaxf(m, dppmov_f<0x141>(m)); m = fmaxf(m, dppmov_f<0x128>(m)); m = fmaxf(m, __shfl_xor(m, 16));
        const float sc = m > 0.f ? 6.0f / m : 1.f;
        unsigned w[4];
#pragma unroll
        for (int d = 0; d < 4; ++d) { unsigned t = 0u;
            t = __builtin_amdgcn_cvt_scalef32_pk_fp4_f32(t, x[2 * d][0] * sc, x[2 * d][1] * sc, 1.0f, 0); t = __builtin_amdgcn_cvt_scalef32_pk_fp4_f32(t, x[2 * d][2] * sc, x[2 * d][3] * sc, 1.0f, 1);
            t = __builtin_amdgcn_cvt_scalef32_pk_fp4_f32(t, x[2 * d + 1][0] * sc, x[2 * d + 1][1] * sc, 1.0f, 2); t = __builtin_amdgcn_cvt_scalef32_pk_fp4_f32(t, x[2 * d + 1][2] * sc, x[2 * d + 1][3] * sc, 1.0f, 3);
            w[d] = t; }
        *(v4u*)(dst + (size_t)r * 512 + 16 * hl) = (v4u){w[0], w[1], w[2], w[3]};
        if (hl == 0) inv[r] = m > 0.f ? m / 6.0f : 1.f;
    }
}
__device__ __forceinline__ void p0_prologue(const Args& A, LAS unsigned char* lds, int vcu, int G, int wave, int lane, int tid) {
    unsigned char* ws = A.ws;
    const int gw = vcu * 8 + wave, NGW = G * 8, gtid = vcu * 512 + tid, gthreads = G * 512;
    LAS float* sil = (LAS float*)lds;
    for (int i = tid; i < 9 * 1024; i += 512) { const float v = i < 8192 ? A.in[I_C][i] : A.in[I_CCTX][i - 8192]; sil[i] = siluf_(v); }
    __syncthreads();
    float* MOD = (float*)(ws + WS_MOD);
    LAS float* part = (LAS float*)(lds + 40960);
    for (int it = vcu; it < 2 * 96; it += G) {
        const int l = it / 96, n = (it % 96) * 64 + lane; const float* wm = A.in[I_WMOD] + (size_t)l * 1024 * 6144 + (size_t)(128 * wave) * 6144 + n;
        float acc[9];
#pragma unroll
        for (int r = 0; r < 9; ++r) acc[r] = 0.f;
#pragma unroll 32
        for (int k = 0; k < 128; ++k) { const float w = wm[(size_t)k * 6144];
#pragma unroll
            for (int r = 0; r < 9; ++r) acc[r] += sil[r * 1024 + 128 * wave + k] * w; }
        __syncthreads();
#pragma unroll
        for (int r = 0; r < 9; ++r) part[(wave * 9 + r) * 64 + lane] = acc[r];
        __syncthreads();
        for (int i = tid; i < 9 * 64; i += 512) { float sum = 0.f;
#pragma unroll
            for (int w8 = 0; w8 < 8; ++w8) sum += part[w8 * 576 + i];
            const int r = i >> 6, c = (it % 96) * 64 + (i & 63); MOD[(size_t)(l * 9 + r) * 6144 + c] = sum + A.in[I_BMOD][l * 6144 + c]; }
    }
    __syncthreads();
    LAS float* scr = (LAS float*)(lds + 40960 + wave * 8704);
    constexpr int I_AB1 = 16 * 64, I_AB2 = 16 * 24, I_ABO = 16 * 32, I_C1 = 16 * 96, I_CO = 16 * 32, I_Q = 16 * 64;
    constexpr int NITEMS = I_AB1 + I_AB2 + I_ABO + I_C1 + I_CO + 2 * I_Q;
    const float rs128 = 0.08838834764831845f;
    for (int it = gw; it < NITEMS; it += NGW) {
        int r = it;
        if (r < I_AB1) { p0_transpose_item(A.in[I_ABWIN], 1024, 2832, 0, 2048, (bf16*)(ws + WS_WAB), 0, scr, r, lane, 512, 1024, rs128, 0, 0, 1.f); continue; } r -= I_AB1;
        if (r < I_AB2) { p0_transpose_item(A.in[I_ABWIN], 1024, 2832, 2064, 768, (bf16*)(ws + WS_WAB), 2048, scr, r, lane, 2048, 2560, 0.125f * 1.44269504089f, 0, 0, 1.f); continue; }     r -= I_AB2;
        if (r < I_ABO) { p0_transpose_item(A.in[I_ABWOUT], 1024, 1024, 0, 1024, (bf16*)(ws + WS_WABO), 0, scr, r, lane, 0, 0, 1.f, 0, 0, 1.f); continue; } r -= I_ABO;
        if (r < I_C1) { p0_transpose_item(A.in[I_GWIN], 1024, 3104, 0, 3072, (bf16*)(ws + WS_WC), 0, scr, r, lane, 0, 512, rs128, 0, 0, 1.f); continue; } r -= I_C1;
        if (r < I_CO) { p0_transpose_item(A.in[I_GWOUT], 1024, 1024, 0, 1024, (bf16*)(ws + WS_WCO), 0, scr, r, lane, 0, 0, 1.f, 0, 0, 1.f); continue; } r -= I_CO;
        if (r < I_Q) { p0_transpose_item(A.in[I_PWQ], 1024, 2048, 0, 2048, (bf16*)(ws + WS_WQ0), 0, scr, r, lane, 0, 0, 1.f, 0, 0, 1.f); continue; } r -= I_Q;
        p0_transpose_item(A.in[I_PWQ] + (size_t)1024 * 2048, 1024, 2048, 0, 2048, (bf16*)(ws + WS_WQ1), 0, scr, r, lane, 0, 0, 1.f, 0, 0, 1.f);
    }
    for (int i = gtid; i < 16 * 1024; i += gthreads) { const int g = i >> 10, k = i & 1023; ((float*)(ws + WS_WG))[i] = A.in[I_ABWIN][(size_t)k * 2832 + 2048 + g]; }
    for (int i = gtid; i < 32 * 1024; i += gthreads) { const int g = i >> 10, k = i & 1023; ((float*)(ws + WS_WLOW))[i] = A.in[I_GWIN][(size_t)k * 3104 + 3072 + g]; }
    for (int i = gtid; i < 64 * 16; i += gthreads) { const int pos = i >> 4, f = i & 15; const float inv = powf(10000.f, -(float)f / 16.f); const float ang = (float)pos * inv;
        ((float*)(ws + WS_ROPE))[2 * i] = cosf(ang); ((float*)(ws + WS_ROPE))[2 * i + 1] = sinf(ang); }
    for (int i = gtid; i < 2 * 8 * 2 * 128 * 16; i += gthreads) { const int mat = i >> 11, n = (i >> 4) & 127, kc = i & 15;
        const f32x4 a = *(const f32x4*)(A.in[I_PKEYS] + (size_t)i * 8), b = *(const f32x4*)(A.in[I_PKEYS] + (size_t)i * 8 + 4);
        v4u o; o.x = pk2(a[0], a[1]); o.y = pk2(a[2], a[3]); o.z = pk2(b[0], b[1]); o.w = pk2(b[2], b[3]);
        *(v4u*)((bf16*)(ws + WS_KEYS) + ((size_t)mat * 2048 + (size_t)(((n >> 4) * 4 + (kc >> 2)) * 64 + 16 * (kc & 3) + (n & 15))) * 8) = o; }
    cvt_rows_fp4(A.in[I_PU], ws + WS_U, (float*)(ws + WS_SCL), 2 * NEXP, gw, NGW, lane);
    cvt_rows_fp4(A.in[I_PV], ws + WS_V, (float*)(ws + WS_SCL) + 2 * NEXP, 2 * NEXP, gw, NGW, lane);
}

__device__ __forceinline__ void split8(const float* v, bf16x8& hi, bf16x8& lo) {
#pragma unroll
    for (int j = 0; j < 8; ++j) { const unsigned h = f2bf(v[j]); const float hf = __builtin_bit_cast(float, h << 16); hi[j] = (short)h; lo[j] = (short)f2bf(v[j] - hf); }
}
template <int NG>
__device__ __forceinline__ void h_phase(const float* lat, const float* ctx, const float* mod  , bf16* HB, const float* WGT, float* GL, LAS unsigned char* lds, int vcu, int G, int wave, int lane, int tid) {
    constexpr int NT = NG / 16;
    LAS float* part = (LAS float*)lds;
    const int g = lane >> 4, c16 = lane & 15;
    bf16x8 bhi[NT][4], blo[NT][4];
#pragma unroll
    for (int nt = 0; nt < NT; ++nt)
#pragma unroll
        for (int ks = 0; ks < 4; ++ks) { const float* wp = WGT + (size_t)(16 * nt + c16) * 1024 + 128 * wave + 32 * ks + 8 * g;
            const f32x4 w0 = *(const f32x4*)wp, w1 = *(const f32x4*)(wp + 4); const float wv[8] = {w0[0], w0[1], w0[2], w0[3], w1[0], w1[1], w1[2], w1[3]}; split8(wv, bhi[nt][ks], blo[nt][ks]); }
    for (int tile = vcu; tile < TT / 16; tile += G) {
        const int r0 = tile * 16, b = r0 / PB, p0 = r0 - b * PB; const float* mr = mod + (size_t)(p0 < LC ? 8 : b) * 6144 + 128 * wave + 8 * g;
        const int row = r0 + c16; const float* xr = srow_c(lat, ctx, row) + 128 * wave + 8 * g;
        f32x4 xa[4][2], sha[4][2], sca[4][2];
#pragma unroll
        for (int ks = 0; ks < 4; ++ks)
#pragma unroll
            for (int q = 0; q < 2; ++q) { xa[ks][q] = *(const f32x4*)(xr + 32 * ks + 4 * q); sha[ks][q] = *(const f32x4*)(mr + 32 * ks + 4 * q); sca[ks][q] = *(const f32x4*)(mr + 1024 + 32 * ks + 4 * q); }
        f32x4 acc[NT];
#pragma unroll
        for (int nt = 0; nt < NT; ++nt) acc[nt] = (f32x4){0.f, 0.f, 0.f, 0.f};
#pragma unroll
        for (int ks = 0; ks < 4; ++ks) {
            float hv[8];
#pragma unroll
            for (int q = 0; q < 2; ++q)
#pragma unroll
                for (int i = 0; i < 4; ++i) hv[4 * q + i] = xa[ks][q][i] * (sca[ks][q][i] + 1.0f) + sha[ks][q][i];
            bf16x8 ahi, alo; split8(hv, ahi, alo);
            *(bf16x8*)(HB + (size_t)row * D + 128 * wave + 32 * ks + 8 * g) = ahi;
#pragma unroll
            for (int nt = 0; nt < NT; ++nt) { acc[nt] = mma(ahi, bhi[nt][ks], acc[nt]); acc[nt] = mma(ahi, blo[nt][ks], acc[nt]); acc[nt] = mma(alo, bhi[nt][ks], acc[nt]); }
        }
        __syncthreads();
#pragma unroll
        for (int nt = 0; nt < NT; ++nt)
#pragma unroll
            for (int r = 0; r < 4; ++r) part[(wave * 16 + 4 * g + r) * NG + 16 * nt + c16] = acc[nt][r];
        __syncthreads();
        for (int i = tid; i < 16 * NG; i += 512) { float sum = 0.f;
#pragma unroll
            for (int w8 = 0; w8 < 8; ++w8) sum += part[w8 * 16 * NG + i];
            GL[(size_t)r0 * NG + i] = sum; }
    }
}

__device__ __forceinline__ void ln_row(const float* sr, float* xr, const bf16* yrow, const f32x4* g1v, const f32x4* shv, const f32x4* scv, const f32x4* lw, const f32x4* lb, bf16* hrow, int lane, int dry, bool active) {
    f32x4 v[4]; float s = 0.f;
#pragma unroll
    for (int j = 0; j < 4; ++j) { const int c = 4 * lane + 256 * j; const f32x4 x = *(const f32x4*)(sr + c), g1 = g1v[j]; const v2u yw = *(const v2u*)(yrow + c);
        v[j][0] = DN_ALPHA * x[0] + g1[0] * bflo(yw.x); v[j][1] = DN_ALPHA * x[1] + g1[1] * bfhi(yw.x); v[j][2] = DN_ALPHA * x[2] + g1[2] * bflo(yw.y); v[j][3] = DN_ALPHA * x[3] + g1[3] * bfhi(yw.y);
        s += (v[j][0] + v[j][1]) + (v[j][2] + v[j][3]); }
    const float mean = wave_sum(s) * (1.f / D); float s2 = 0.f;
#pragma unroll
    for (int j = 0; j < 4; ++j) { v[j] = v[j] - mean; s2 += (v[j][0] * v[j][0] + v[j][1] * v[j][1]) + (v[j][2] * v[j][2] + v[j][3] * v[j][3]); }
    const float rstd = 1.f / sqrtf(wave_sum(s2) * (1.f / D) + LN_EPS);
    if (active) {
#pragma unroll
    for (int j = 0; j < 4; ++j) { const int c = 4 * lane + 256 * j; const f32x4 w = lw[j], bb = lb[j];
        const f32x4 x1 = v[j] * rstd * w + bb; if (!dry) *(f32x4*)(xr + c) = x1;
        const f32x4 hp = x1 * (scv[j] + 1.0f) + shv[j];
        v2u o; o.x = pk2(hp[0], hp[1]); o.y = pk2(hp[2], hp[3]); if (!dry) *(v2u*)(hrow + c) = o; }
    }
}
__device__ __forceinline__ int map_row3(int i, int mode) { return mode == 1 ? (i >> 12) * 4352 + 256 + (i & 4095) : mode == 2 ? (i >> 8) * 4352 + (i & 255) : i; }
__device__ __forceinline__ void ln_phase(const float* slat, const float* sctx, float* lat, float* ctx, const bf16* Y, const float* mod, const float* lnw, const float* lnb, bf16* HB, int gw, int NGW, int lane, int dry, int lat_only, int ibeg = -1, int iend = 0) {
    const int nrows = lat_only == 1 ? NB * SEQ : lat_only == 2 ? NB * LC : TT;
    if (ibeg < 0) { const int rpw = (nrows + NGW - 1) / NGW; ibeg = gw * rpw; iend = ibeg + rpw < nrows ? ibeg + rpw : nrows; }
    f32x4 lw[4], lb[4], g1v[4], shv[4], scv[4];
#pragma unroll
    for (int j = 0; j < 4; ++j) { lw[j] = *(const f32x4*)(lnw + 4 * lane + 256 * j); lb[j] = *(const f32x4*)(lnb + 4 * lane + 256 * j); g1v[j] = shv[j] = scv[j] = (f32x4){0.f, 0.f, 0.f, 0.f}; }
    int mcur = -1;
    for (int i0 = ibeg; i0 < iend; ) {
        const int r0 = map_row3(i0, lat_only), b0 = r0 / PB, p0 = r0 - b0 * PB, m0 = p0 < LC ? 8 : b0;
        int r1c = r0; bool has1 = false;
        if (i0 + 1 < iend) { const int r1 = map_row3(i0 + 1, lat_only), b1 = r1 / PB, p1 = r1 - b1 * PB; if ((p1 < LC ? 8 : b1) == m0) { has1 = true; r1c = r1; } }
        if (m0 != mcur) { const float* mr = mod + (size_t)m0 * 6144;
#pragma unroll
            for (int j = 0; j < 4; ++j) { const int c = 4 * lane + 256 * j; g1v[j] = *(const f32x4*)(mr + 2048 + c); shv[j] = *(const f32x4*)(mr + 3072 + c); scv[j] = *(const f32x4*)(mr + 4096 + c); }
            mcur = m0; }
        ln_row(srow_c(slat, sctx, r0), srow(lat, ctx, r0), Y + (size_t)r0 * D, g1v, shv, scv, lw, lb, HB + (size_t)r0 * D, lane, dry, true);
        ln_row(srow_c(slat, sctx, r1c), srow(lat, ctx, r1c), Y + (size_t)r1c * D, g1v, shv, scv, lw, lb, HB + (size_t)r1c * D, lane, dry, has1);
        i0 += has1 ? 2 : 1;
    }
}

constexpr int AT_LD = 72;
__device__ __forceinline__ bf16x8 frag_tr_perm(const LAS bf16* t, int ld, int r0, int c0, int lane) {
    const int g = lane >> 4, q = (lane & 15) >> 2, p = lane & 3;
    const LAS bf16* a = t + (r0 + 4 * g + q) * ld + c0 + 4 * p;
    const s16x4 lo = __builtin_amdgcn_ds_read_tr16_b64_v4i16((LAS s16x4*)a);
    const s16x4 hi = __builtin_amdgcn_ds_read_tr16_b64_v4i16((LAS s16x4*)(a + 16 * ld));
    return (bf16x8){lo[0], lo[1], lo[2], lo[3], hi[0], hi[1], hi[2], hi[3]};
}
__device__ __forceinline__ void attn_phase(const bf16* P, bf16* CAT, const float* sink, const float* ropetab, LAS unsigned char* lds, unsigned* qctr, int vcu, int G, int wave, int lane, int tid) {
    LAS bf16* Qw = (LAS bf16*)(lds + 18432 + wave * 4608);
    const int g = lane >> 4, c16 = lane & 15;
    volatile LAS int* qslot = (volatile LAS int*)(lds + MISC_OFF) + 12;
    for (;;) {
        if (tid == 0) *qslot = (int)__hip_atomic_fetch_add(qctr, 1u, __ATOMIC_RELAXED, __HIP_MEMORY_SCOPE_AGENT);
        __syncthreads();
        const int item = *qslot;
        if (item >= 1024 + 64) break;
        const bool is_ctx = item >= 1024;
        int b, hk, nb;
        if (!is_ctx) { b = item >> 7; hk = (item >> 6) & 1; nb = item & 63; } else { const int it = item - 1024; b = it >> 3; hk = (it >> 2) & 1; nb = it & 3; }
        const int head = hk * 4 + (wave >> 1);
        const int qrow0 = b * PB + (is_ctx ? 0 : LC) + nb * 64 + (wave & 1) * 32;
        const int qlat0 = nb * 64 + (wave & 1) * 32;
        __syncthreads();
#pragma unroll
        for (int i = 0; i < 4; ++i) { const int cidx = lane + 64 * i, rr = cidx >> 3, ch = cidx & 7;
            const v4u raw = *(const v4u*)(P + (size_t)(qrow0 + rr) * N_AB + 2048 + head * 64 + ch * 8); v4u o = raw;
            if (!is_ctx) { const int tl = qlat0 + rr; const int pos = (ch < 4) ? (tl >> 6) : (tl & 63); const float* tb = ropetab + (size_t)(pos * 16 + (ch & 3) * 4) * 2;
                const unsigned wv[4] = {raw.x, raw.y, raw.z, raw.w}; unsigned ov[4];
#pragma unroll
                for (int k = 0; k < 4; ++k) { const float x1 = bflo(wv[k]), x2 = bfhi(wv[k]), c = tb[2 * k], s = tb[2 * k + 1]; ov[k] = pk2(x1 * c - x2 * s, x1 * s + x2 * c); }
                o.x = ov[0]; o.y = ov[1]; o.z = ov[2]; o.w = ov[3]; }
            *(LAS v4u*)(Qw + rr * AT_LD + ch * 8) = o; }
        LDS_FENCE();
        bf16x8 qf[2][2];
#pragma unroll
        for (int mt = 0; mt < 2; ++mt)
#pragma unroll
            for (int ks = 0; ks < 2; ++ks) qf[mt][ks] = frag_row(Qw, AT_LD, 16 * mt, 32 * ks, lane);
        LDS_FENCE();
        f32x4 o[2][4]; float mrun[2], lrun[2];
        const float sk = sink[head] * 1.44269504089f;
#pragma unroll
        for (int qt = 0; qt < 2; ++qt) { mrun[qt] = sk; lrun[qt] = 1.f; }
#pragma unroll
        for (int qt = 0; qt < 2; ++qt)
#pragma unroll
            for (int nt = 0; nt < 4; ++nt) o[qt][nt] = (f32x4){0.f, 0.f, 0.f, 0.f};
        const int nkt = is_ctx ? 4 : 9;
        const int srr = tid >> 3, sch = tid & 7;
        int kt = 0; f32x2 trope[4];
#pragma unroll
        for (int i = 0; i < 4; ++i) trope[i] = (f32x2){1.f, 0.f};
        v4u kraw = *(const v4u*)(P + (size_t)(b * PB + srr) * N_AB + 2560 + hk * 64 + sch * 8), vraw = *(const v4u*)(P + (size_t)(b * PB + srr) * N_AB + 2688 + hk * 64 + sch * 8);
#define AT_NEXT(k_) ({ int n_ = (k_) + 1; while (n_ < nkt && n_ >= 4 && ((nb * 64 - 128 + 64 * (n_ - 4)) < 0 || (nb * 64 - 128 + 64 * (n_ - 4)) >= SEQ)) ++n_; n_; })
#define AT_STAGE(kk_, bo_) do { v4u o_ = kraw; \
            if ((kk_) >= 4) { const unsigned wv_[4] = {kraw.x, kraw.y, kraw.z, kraw.w}; unsigned ov_[4]; \
                _Pragma("unroll") for (int i = 0; i < 4; ++i) { const float x1 = bflo(wv_[i]), x2 = bfhi(wv_[i]), c = trope[i][0], sn = trope[i][1]; ov_[i] = pk2(x1 * c - x2 * sn, x1 * sn + x2 * c); } \
                o_.x = ov_[0]; o_.y = ov_[1]; o_.z = ov_[2]; o_.w = ov_[3]; } \
            *(LAS v4u*)(lds + (bo_) + (srr * AT_LD + sch * 8) * 2) = o_; *(LAS v4u*)(lds + (bo_) + 9216 + (srr * AT_LD + sch * 8) * 2) = vraw; } while (0)
#define AT_FETCH(kk_) do { const int kpn_ = nb * 64 - 128 + 64 * ((kk_) - 4); const int krn_ = b * PB + ((kk_) < 4 ? 64 * (kk_) : LC + kpn_); \
            kraw = *(const v4u*)(P + (size_t)(krn_ + srr) * N_AB + 2560 + hk * 64 + sch * 8); vraw = *(const v4u*)(P + (size_t)(krn_ + srr) * N_AB + 2688 + hk * 64 + sch * 8); \
            if ((kk_) >= 4) { const int tl_ = kpn_ + srr; const int pos_ = (sch < 4) ? (tl_ >> 6) : (tl_ & 63); const f32x2* tb_ = (const f32x2*)(ropetab + (size_t)(pos_ * 16 + (sch & 3) * 4) * 2); \
                _Pragma("unroll") for (int i = 0; i < 4; ++i) trope[i] = tb_[i]; } } while (0)
        AT_STAGE(0, 0);
        int kn = AT_NEXT(0);
        if (kn < nkt) AT_FETCH(kn);
        unsigned cur = 0u;
        while (kt < nkt) {
            const int kp0 = nb * 64 - 128 + 64 * (kt - 4);
            __syncthreads();
            const int kn2 = kn < nkt ? AT_NEXT(kn) : nkt;
            if (kn < nkt) { AT_STAGE(kn, cur ? 0u : 55296u); if (kn2 < nkt) AT_FETCH(kn2); }
            LAS bf16* Kt = (LAS bf16*)(lds + (cur ? 55296u : 0u)); LAS bf16* Vt = Kt + 4608;
            const bool need_mask = (kt == 4) || (kt == 8);
            bf16x8 kf[4][2];
#pragma unroll
            for (int km = 0; km < 4; ++km)
#pragma unroll
                for (int ks = 0; ks < 2; ++ks) kf[km][ks] = frag_row(Kt, AT_LD, 16 * km, 32 * ks, lane);
            bf16x8 pa[2][2];
#pragma unroll
            for (int qt = 0; qt < 2; ++qt) {
                f32x4 st[4];
#pragma unroll
                for (int km = 0; km < 4; ++km) { st[km] = (f32x4){0.f, 0.f, 0.f, 0.f};
#pragma unroll
                    for (int ks = 0; ks < 2; ++ks) st[km] = mma(kf[km][ks], qf[qt][ks], st[km]); }
                if (need_mask) {
#pragma unroll
                    for (int km = 0; km < 4; ++km)
#pragma unroll
                        for (int r = 0; r < 4; ++r) { const int dq = (kp0 + 16 * km + 4 * g + r) - (qlat0 + 16 * qt + c16); if (dq > 128 || dq < -128) st[km][r] = -3.0e38f; } }
                float mx = fmaxf(fmaxf(fmaxf(st[0][0], st[0][1]), fmaxf(st[0][2], st[0][3])), fmaxf(fmaxf(st[1][0], st[1][1]), fmaxf(st[1][2], st[1][3])));
                mx = fmaxf(mx, fmaxf(fmaxf(fmaxf(st[2][0], st[2][1]), fmaxf(st[2][2], st[2][3])), fmaxf(fmaxf(st[3][0], st[3][1]), fmaxf(st[3][2], st[3][3]))));
                mx = fmaxf(mx, __shfl_xor(mx, 16)); mx = fmaxf(mx, __shfl_xor(mx, 32));
                const float mnew = fmaxf(mrun[qt], mx), alpha = __builtin_amdgcn_exp2f(mrun[qt] - mnew);
                float ps = 0.f;
#pragma unroll
                for (int km = 0; km < 4; ++km)
#pragma unroll
                    for (int r = 0; r < 4; ++r) { const float pv = __builtin_amdgcn_exp2f(st[km][r] - mnew); st[km][r] = pv; ps += pv; }
                ps += __shfl_xor(ps, 16); ps += __shfl_xor(ps, 32);
                lrun[qt] = lrun[qt] * alpha + ps; mrun[qt] = mnew;
#pragma unroll
                for (int ks2 = 0; ks2 < 2; ++ks2) { const unsigned w0 = pk2(st[2 * ks2][0], st[2 * ks2][1]), w1 = pk2(st[2 * ks2][2], st[2 * ks2][3]), w2 = pk2(st[2 * ks2 + 1][0], st[2 * ks2 + 1][1]), w3 = pk2(st[2 * ks2 + 1][2], st[2 * ks2 + 1][3]);
                    const v4u wv = (v4u){w0, w1, w2, w3}; pa[qt][ks2] = __builtin_bit_cast(bf16x8, wv); }
                if (__builtin_amdgcn_ballot_w64(alpha != 1.f) != 0ull) {
#pragma unroll
                for (int r = 0; r < 4; ++r) { const float ar = __shfl(alpha, (lane & 48) + 4 * g + r);
#pragma unroll
                    for (int nt = 0; nt < 4; ++nt) o[qt][nt][r] *= ar; } }
            }
#pragma unroll
            for (int ks2 = 0; ks2 < 2; ++ks2) {
                bf16x8 vf[4];
#pragma unroll
                for (int nt = 0; nt < 4; ++nt) vf[nt] = frag_tr_perm(Vt, AT_LD, 32 * ks2, 16 * nt, lane);
#pragma unroll
                for (int qt = 0; qt < 2; ++qt)
#pragma unroll
                    for (int nt = 0; nt < 4; ++nt) o[qt][nt] = mma(pa[qt][ks2], vf[nt], o[qt][nt]); }
            LDS_FENCE();
            kt = kn; kn = kn2; cur ^= 1u;
        }
#undef AT_NEXT
#undef AT_STAGE
#undef AT_FETCH
#pragma unroll
        for (int qt = 0; qt < 2; ++qt)
#pragma unroll
            for (int r = 0; r < 4; ++r) { const float inv = 1.f / __shfl(lrun[qt], (lane & 48) + 4 * g + r); bf16* orow = CAT + (size_t)(qrow0 + 16 * qt + 4 * g + r) * D + 512 + head * 64;
#pragma unroll
                for (int nt = 0; nt < 4; ++nt) orow[16 * nt + c16] = (bf16)f2bf(o[qt][nt][r] * inv); }
    }
}

__device__ __forceinline__ float wave_prefix_sum(float v) {
    v += __builtin_bit_cast(float, __builtin_amdgcn_update_dpp(0, __builtin_bit_cast(int, v), 0x111, 0xf, 0xf, true)); v += __builtin_bit_cast(float, __builtin_amdgcn_update_dpp(0, __builtin_bit_cast(int, v), 0x112, 0xf, 0xf, true));
    v += __builtin_bit_cast(float, __builtin_amdgcn_update_dpp(0, __builtin_bit_cast(int, v), 0x114, 0xf, 0xf, true)); v += __builtin_bit_cast(float, __builtin_amdgcn_update_dpp(0, __builtin_bit_cast(int, v), 0x118, 0xf, 0xf, true));
    v += __builtin_bit_cast(float, __builtin_amdgcn_update_dpp(0, __builtin_bit_cast(int, v), 0x142, 0xa, 0xf, false)); v += __builtin_bit_cast(float, __builtin_amdgcn_update_dpp(0, __builtin_bit_cast(int, v), 0x143, 0xc, 0xf, false));
    return v;
}
__device__ __forceinline__ float wave_prefix_max(float v) {
    const int ninf = (int)0xff800000u;
    v = fmaxf(v, __builtin_bit_cast(float, __builtin_amdgcn_update_dpp(ninf, __builtin_bit_cast(int, v), 0x111, 0xf, 0xf, false))); v = fmaxf(v, __builtin_bit_cast(float, __builtin_amdgcn_update_dpp(ninf, __builtin_bit_cast(int, v), 0x112, 0xf, 0xf, false)));
    v = fmaxf(v, __builtin_bit_cast(float, __builtin_amdgcn_update_dpp(ninf, __builtin_bit_cast(int, v), 0x114, 0xf, 0xf, false))); v = fmaxf(v, __builtin_bit_cast(float, __builtin_amdgcn_update_dpp(ninf, __builtin_bit_cast(int, v), 0x118, 0xf, 0xf, false)));
    v = fmaxf(v, __builtin_bit_cast(float, __builtin_amdgcn_update_dpp(ninf, __builtin_bit_cast(int, v), 0x142, 0xa, 0xf, false))); v = fmaxf(v, __builtin_bit_cast(float, __builtin_amdgcn_update_dpp(ninf, __builtin_bit_cast(int, v), 0x143, 0xc, 0xf, false)));
    return v;
}
__device__ __forceinline__ void mlstm_gate_scan(const float* GL  , const float* gate_b  , unsigned char* ws, int gw, int NGW, int lane) {
    float* BQ = (float*)(ws + WS_BQ); float* CQ = (float*)(ws + WS_CQ); float* EM = (float*)(ws + WS_EM); float* AI = (float*)(ws + WS_AI);
    float* AST = (float*)(ws + WS_AST); float* CL = (float*)(ws + WS_CL);
    for (int chain = gw; chain < 64; chain += NGW) {
        const int dir = chain >> 5, b = (chain >> 2) & 7, h = chain & 3;
        const float bi = gate_b[dir * 8 + h], bfg = gate_b[dir * 8 + 4 + h];
        float m_st = 0.f;
        float gi_q[4], gf_q[4];
#define MGS_LOAD(sn_, k_) do { const int jn_ = dir == 0 ? (sn_) : ((sn_) < 4 ? 3 - (sn_) : 71 - (sn_)); const int pn_ = jn_ * 64 + (dir == 0 ? lane : 63 - lane); \
            const float* gr_ = GL + (size_t)(b * PB + pn_) * 16 + dir * 8; gi_q[k_] = gr_[h]; gf_q[k_] = gr_[4 + h]; } while (0)
        MGS_LOAD(0, 0); MGS_LOAD(1, 1); MGS_LOAD(2, 2); MGS_LOAD(3, 3);
#pragma unroll 1
        for (int sc4 = 0; sc4 < NCH; sc4 += 4) {
#pragma unroll
            for (int k = 0; k < 4; ++k) {
                const int sc = sc4 + k;
                const int j = dir == 0 ? sc : (sc < 4 ? 3 - sc : 71 - sc);
                const int p = j * 64 + (dir == 0 ? lane : 63 - lane);
                const float li = gi_q[k] + bi, lf = logsigmoidf_(gf_q[k] + bfg);
                if (sc + 4 < NCH) MGS_LOAD(sc + 4, k);
                const float cum = wave_prefix_sum(lf);
                const float bb = li - cum; const float pm = wave_prefix_max(bb);
                const float c = fmaxf(m_st, pm);
                const size_t ti = (size_t)chain * PB + p;
                BQ[ti] = bb; CQ[ti] = c; EM[ti] = __expf(-(cum + c)); AI[ti] = __expf(m_st - c);
                const float cl = __builtin_bit_cast(float, __builtin_amdgcn_readlane(__builtin_bit_cast(int, c), 63)), tot = __builtin_bit_cast(float, __builtin_amdgcn_readlane(__builtin_bit_cast(int, cum), 63));
                if (lane == 0) { CL[chain * NCH + j] = cl; AST[chain * NCH + j] = __expf(m_st - cl); }
                m_st = tot + cl;
            }
        }
#undef MGS_LOAD
    }
}


__device__ __forceinline__ float logsig_fast(float x) { return fminf(x, 0.f) - __logf(1.f + __expf(-fabsf(x))); }
__device__ __forceinline__ void gla_prep(bf16* P, bf16* QKR, const float* LOW  , const float* gate_up  , const float* gate_b  , unsigned char* ws,
                                         LAS unsigned char* lds, int vcu, int G, int tid, int dry) {
    float* ET = (float*)(ws + WS_ET);
    LAS float* lowt = (LAS float*)lds;
    LAS bf16* qs = (LAS bf16*)(lds + 8192);
    LAS bf16* ks = (LAS bf16*)(lds + 24576);
    LAS float* LA = (LAS float*)(lds + 40960);
    LAS float* HT = (LAS float*)(lds + 106496);
    const int dc = tid & 255, dir = dc >> 7, ch = dc & 127, half = tid >> 8;
    float gu[16], gb = 0.f; int hcur = -1;
#pragma unroll
    for (int k = 0; k < 16; ++k) gu[k] = 0.f;
    for (int item = vcu; item < NB * NCH * 4; item += G) {
        const int b = item / (NCH * 4), j = (item >> 2) % NCH, h = item & 3;
        const int row0 = b * PB + j * 64, c = h * 128 + ch;
        __syncthreads();
        for (int i = tid; i < 64 * 32; i += 512) lowt[i] = LOW[(size_t)row0 * 32 + i];
#pragma unroll
        for (int i = 0; i < 2; ++i) { const int cidx = tid + 512 * i, rr = cidx >> 4, c8 = cidx & 15; const bf16* src = P + (size_t)(row0 + rr) * N_C + h * 128 + c8 * 8;
            *(LAS v4u*)(qs + rr * 128 + c8 * 8) = *(const v4u*)src; *(LAS v4u*)(ks + rr * 128 + c8 * 8) = *(const v4u*)(src + 512); }
        if (h != hcur) {
#pragma unroll
            for (int k = 0; k < 16; ++k) gu[k] = gate_up[(size_t)(dir * 16 + k) * 512 + c];
            gb = gate_b[dir * 512 + c]; hcur = h; }
        __syncthreads();
        float hsum = 0.f;
#pragma unroll 4
        for (int i = 0; i < 32; ++i) { const int t = half * 32 + i; float x = gb;
#pragma unroll
            for (int k = 0; k < 16; ++k) x += lowt[t * 32 + dir * 16 + k] * gu[k];
            const float la = logsig_fast(x) * (1.f / 16.f); LA[t * 256 + dc] = la; hsum += la; }
        HT[half * 256 + dc] = hsum;
        __syncthreads();
        float cum = (dir == 0) ? (half == 1 ? HT[dc] : 0.f) : (half == 0 ? HT[256 + dc] : 0.f);
#pragma unroll 4
        for (int i = 0; i < 32; ++i) { const int t = half * 32 + (dir == 0 ? i : 31 - i);
            cum += LA[t * 256 + dc];
            const float e = __expf(cum), ei = __expf(-cum);
            const size_t ro = (size_t)(row0 + t) * N_C;
            const float qv = bf2f(qs[t * 128 + ch]), kv = bf2f(ks[t * 128 + ch]);
            if (dir == 0) { if (!dry) { P[ro + c] = (bf16)f2bf(qv * e); P[ro + 512 + c] = (bf16)f2bf(kv * ei); } }
            else { QKR[(size_t)(row0 + t) * 1024 + c] = (bf16)f2bf(qv * e); QKR[(size_t)(row0 + t) * 1024 + 512 + c] = (bf16)f2bf(kv * ei); } }
        if (half == 0) ET[((size_t)((dir * 8 + b) * 4 + h) * NCH + j) * 128 + ch] = __expf(HT[dc] + HT[256 + dc]);
    }
}


__device__ __forceinline__ unsigned f2sort(float f) { const unsigned u = __builtin_bit_cast(unsigned, f); return (u & 0x80000000u) ? ~u : (u | 0x80000000u); }
__device__ __forceinline__ float sort2f(unsigned s) { const unsigned u = (s & 0x80000000u) ? (s & 0x7fffffffu) : ~s; return __builtin_bit_cast(float, u); }
template <int CTRL> __device__ __forceinline__ unsigned dppmov_u(unsigned x) { return (unsigned)__builtin_amdgcn_mov_dpp((int)x, CTRL, 0xf, 0xf, true); }
__device__ __forceinline__ unsigned gmax16(unsigned x) { unsigned y;
    y = dppmov_u<0xB1>(x); x = x > y ? x : y; y = dppmov_u<0x4E>(x); x = x > y ? x : y; y = dppmov_u<0x141>(x); x = x > y ? x : y; y = dppmov_u<0x128>(x); x = x > y ? x : y; return x; }
__device__ __forceinline__ float gsum16(float x) {
    x += __builtin_bit_cast(float, dppmov_u<0xB1>(__builtin_bit_cast(unsigned, x))); x += __builtin_bit_cast(float, dppmov_u<0x4E>(__builtin_bit_cast(unsigned, x)));
    x += __builtin_bit_cast(float, dppmov_u<0x141>(__builtin_bit_cast(unsigned, x))); x += __builtin_bit_cast(float, dppmov_u<0x128>(__builtin_bit_cast(unsigned, x))); return x; }
#define CSWAP(a, b) do { const unsigned hi_ = (a) > (b) ? (a) : (b), lo_ = (a) > (b) ? (b) : (a); (a) = hi_; (b) = lo_; } while (0)
__device__ __forceinline__ void peer_route(const bf16* Q, const bf16* KEYS, int* EID, float* GWT, LAS unsigned char* lds, int vcu, int G, int wave, int tid, int lane, bool lat_only) {
    const int g = lane >> 4, c16 = lane & 15, gbase = lane & 48;
    const int head = vcu & 7, ntb = lat_only ? NB * SEQ / 16 : TT / 16, cgrp = G >> 3;
    { const v4u* ksrc = (const v4u*)(KEYS + (size_t)head * 2 * 128 * 128);
#pragma unroll
      for (int i = 0; i < 8; ++i) *(LAS v4u*)(lds + (size_t)(tid + 512 * i) * 16) = ksrc[tid + 512 * i];
      __syncthreads(); }
    LAS unsigned* wk = (LAS unsigned*)(lds + 65536 + wave * 9216) + lane;
#pragma unroll
    for (int r = 0; r < 4; ++r) wk[(r * 9 + 8) * 64] = 0u;
    const unsigned tw = (c16 == 0 ? 0x03020100u : (c16 == 1 ? 0x07060504u : (c16 == 2 ? 0x0b0a0908u : (c16 == 3 ? 0x0f0e0d0cu : (c16 == 4 ? 0x13121110u : (c16 == 5 ? 0x17161514u : (c16 == 6 ? 0x23222120u : (c16 == 7 ? 0x32313024u : (c16 == 8 ? 0x42414033u : (c16 == 9 ? 0x61605150u : (c16 == 10 ? 0x90807170u : (c16 == 11 ? 0xd0c0b0a0u : (c16 == 12 ? 0xfffff0e0u : 0xffffffffu)))))))))))));
    for (int tb = (vcu >> 3) + cgrp * wave; tb < ntb; tb += cgrp * 8) {
        const int t0 = map_row(tb * 16, lat_only);
        unsigned tops[2][4];
#pragma unroll
        for (int p = 0; p < 2; ++p) {
            const bf16* qrow = Q + (size_t)(t0 + c16) * 2048 + head * 256 + p * 128 + 8 * g;
            bf16x8 qf[4];
#pragma unroll
            for (int ks = 0; ks < 4; ++ks) qf[ks] = *(const bf16x8*)(qrow + 32 * ks);
            unsigned kbo = (unsigned)(p * 32768 + 16 * lane); asm volatile("" : "+v"(kbo));
            LAS const unsigned char* kb = lds + kbo;
            unsigned key[8][4];
#pragma unroll
            for (int nt = 0; nt < 8; ++nt) { f32x4 s = (f32x4){0.f, 0.f, 0.f, 0.f};
#pragma unroll
                for (int ks = 0; ks < 4; ++ks) s = mma(qf[ks], *(LAS const bf16x8*)(kb + (nt * 4 + ks) * 1024), s);
#pragma unroll
                for (int r = 0; r < 4; ++r) key[nt][r] = (f2sort(s[r]) & ~127u) | (unsigned)(127 - (16 * nt + c16)); }
            unsigned kk[4][8];
#pragma unroll
            for (int r = 0; r < 4; ++r) {
#pragma unroll
                for (int nt = 0; nt < 8; ++nt) kk[r][nt] = key[nt][r];
                CSWAP(kk[r][0], kk[r][1]); CSWAP(kk[r][2], kk[r][3]); CSWAP(kk[r][4], kk[r][5]); CSWAP(kk[r][6], kk[r][7]); CSWAP(kk[r][0], kk[r][2]); CSWAP(kk[r][1], kk[r][3]); CSWAP(kk[r][4], kk[r][6]); CSWAP(kk[r][5], kk[r][7]);
                CSWAP(kk[r][1], kk[r][2]); CSWAP(kk[r][5], kk[r][6]); CSWAP(kk[r][0], kk[r][4]); CSWAP(kk[r][1], kk[r][5]); CSWAP(kk[r][2], kk[r][6]); CSWAP(kk[r][3], kk[r][7]); CSWAP(kk[r][2], kk[r][4]); CSWAP(kk[r][3], kk[r][5]);
                CSWAP(kk[r][1], kk[r][2]); CSWAP(kk[r][3], kk[r][4]); CSWAP(kk[r][5], kk[r][6]); }
            unsigned tt[4] = {0u, 0u, 0u, 0u}, hd[4]; int cnt[4];
#pragma unroll
            for (int r = 0; r < 4; ++r) { hd[r] = kk[r][0]; cnt[r] = 0;
#pragma unroll
                for (int q = 0; q < 8; ++q) wk[(r * 9 + q) * 64] = kk[r][q]; }
            LDS_FENCE();
#pragma unroll 2
            for (int rd = 0; rd < 16; ++rd) {
#pragma unroll
                for (int r = 0; r < 4; ++r) { const unsigned m = gmax16(hd[r]); cnt[r] += (hd[r] == m) ? 1 : 0;
                    hd[r] = wk[(r * 9 + cnt[r]) * 64];
                    tt[r] = (c16 == rd) ? m : tt[r]; } }
#pragma unroll
            for (int r = 0; r < 4; ++r) tops[p][r] = tt[r];
        }
        unsigned res[4]; unsigned kq[4][4];
#pragma unroll
        for (int r = 0; r < 4; ++r) { res[r] = 0u;
#pragma unroll
            for (int sl = 0; sl < 4; ++sl) { const unsigned byte = (tw >> (8 * sl)) & 255u; const int ii = (int)(byte >> 4), jj = (int)(byte & 15u);
                const float a = sort2f((unsigned)__shfl((int)tops[0][r], gbase + ii) & ~127u), bq = sort2f((unsigned)__shfl((int)tops[1][r], gbase + jj) & ~127u);
                kq[r][sl] = byte == 255u ? 0u : ((f2sort(a + bq) & ~255u) | (unsigned)((15 - ii) << 4) | (unsigned)(15 - jj)); }
            CSWAP(kq[r][0], kq[r][1]); CSWAP(kq[r][2], kq[r][3]); CSWAP(kq[r][0], kq[r][2]); CSWAP(kq[r][1], kq[r][3]); CSWAP(kq[r][1], kq[r][2]); }
        unsigned hq[4]; int cq4[4];
#pragma unroll
        for (int r = 0; r < 4; ++r) { hq[r] = kq[r][0]; cq4[r] = 0;
#pragma unroll
            for (int sl = 0; sl < 4; ++sl) wk[(r * 9 + sl) * 64] = kq[r][sl];
            wk[(r * 9 + 4) * 64] = 0u; }
        LDS_FENCE();
#pragma unroll 2
        for (int rd = 0; rd < 16; ++rd) {
#pragma unroll
            for (int r = 0; r < 4; ++r) { const unsigned m = gmax16(hq[r]); cq4[r] += (hq[r] == m) ? 1 : 0;
                hq[r] = wk[(r * 9 + cq4[r]) * 64];
                res[r] = (c16 == rd) ? m : res[r]; } }
#pragma unroll
        for (int r = 0; r < 4; ++r) {
            const float val = sort2f(res[r] & ~255u); const int ii = 15 - (int)((res[r] >> 4) & 15u), jj = 15 - (int)(res[r] & 15u);
            const float mx = __shfl(val, gbase);
            const float ex = __expf(val - mx), sum = gsum16(ex);
            const unsigned i0 = 127u - ((unsigned)__shfl((int)tops[0][r], gbase + ii) & 127u), i1 = 127u - ((unsigned)__shfl((int)tops[1][r], gbase + jj) & 127u);
            const size_t o = (size_t)(t0 + 4 * g + r) * 128 + head * 16 + c16;
            EID[o] = (int)(i0 * 128u + i1); GWT[o] = ex / sum;
        }
    }
}

__device__ __forceinline__ void unpack8(const v4u w, float* o) { o[0] = bflo(w.x); o[1] = bfhi(w.x); o[2] = bflo(w.y); o[3] = bfhi(w.y); o[4] = bflo(w.z); o[5] = bfhi(w.z); o[6] = bflo(w.w); o[7] = bfhi(w.w); }
typedef int v8i __attribute__((ext_vector_type(8)));
constexpr int P1_PAIR = 1040, P1_BUF = 8 * P1_PAIR, P1_HQ = 2 * P1_BUF, P1_DOTS = P1_HQ, P1_WAVE_LDS = 19968;
__device__ __forceinline__ int p1_pair(int m) { return m < 4 ? m : (m < 12 ? m - 4 : m - 8); }
__device__ __forceinline__ int p1_exp(int m) { return m < 4 ? 2 * m : (m < 12 ? 2 * (m - 4) + 1 : 2 * (m - 8)); }
__device__ __forceinline__ void peer_pass1(const bf16* HB, const int* EID, const float* GWT, const unsigned char* U4, const float* SUi, const float* SVi, float* COEF,
                                           LAS unsigned char* lds, int wave, int gw, int NGW, int lane, bool lat_only) {
    LAS unsigned char* wl = lds + wave * P1_WAVE_LDS;
    LAS float* dots = (LAS float*)(wl + P1_DOTS);
    const int n = lane & 15, g = lane >> 4;
    const int nrows = lat_only ? NB * SEQ : TT;
    const unsigned aoff = (unsigned)(p1_pair(n) * P1_PAIR + ((n >= 4 && n < 12) ? 512 : 0) + 128 * g);
    const unsigned boff = (unsigned)(P1_HQ + (n < 6 ? 512 * n : 0) + 128 * g);
    const float wn = n == 0 ? 1.f : (n == 1 ? 0.25f : (n == 2 ? 0.0625f : (n == 3 ? 0.015625f : (n == 4 ? 0.00390625f : (n == 5 ? 0.0009765625f : 0.f)))));
    int ri = gw;
    if (ri >= nrows) return;
    int r = map_row(ri, lat_only);
    v4u hn0 = *(const v4u*)(HB + (size_t)r * D + 16 * lane), hn1 = *(const v4u*)(HB + (size_t)r * D + 16 * lane + 8);
    int eidAn = EID[(size_t)r * 128 + lane], eidBn = EID[(size_t)r * 128 + 64 + lane];
#define P1_DMA(src_e, base_, bufo_) do { _Pragma("unroll") for (int p_ = 0; p_ < 8; ++p_) { \
        const int ia_ = __builtin_amdgcn_readlane((src_e), (base_) + 2 * p_), ib_ = __builtin_amdgcn_readlane((src_e), (base_) + 2 * p_ + 1); const int id_ = lane < 32 ? ia_ : ib_; \
        __builtin_amdgcn_global_load_lds((const unsigned*)(U4 + (size_t)id_ * 512 + 16 * (lane & 31)), (LAS unsigned*)(wl + (bufo_) + p_ * P1_PAIR), 16, 0, 0); } } while (0)
    P1_DMA(eidAn, 0, 0); P1_DMA(eidAn, 16, P1_BUF);
    for (; ri < nrows; ri += NGW) {
        r = map_row(ri, lat_only);
        const int eidA = eidAn, eidB = eidBn;
        { float h[16]; unpack8(hn0, h); unpack8(hn1, h + 8);
#pragma unroll
          for (int part = 0; part < 6; ++part) {
              unsigned w[2];
#pragma unroll
              for (int d = 0; d < 2; ++d) { unsigned t = 0u;
                  t = __builtin_amdgcn_cvt_scalef32_pk_fp4_f32(t, h[8 * d], h[8 * d + 1], 1.0f, 0); t = __builtin_amdgcn_cvt_scalef32_pk_fp4_f32(t, h[8 * d + 2], h[8 * d + 3], 1.0f, 1);
                  t = __builtin_amdgcn_cvt_scalef32_pk_fp4_f32(t, h[8 * d + 4], h[8 * d + 5], 1.0f, 2); t = __builtin_amdgcn_cvt_scalef32_pk_fp4_f32(t, h[8 * d + 6], h[8 * d + 7], 1.0f, 3);
                  w[d] = t; }
              *(LAS v2u*)(wl + P1_HQ + 512 * part + 8 * lane) = (v2u){w[0], w[1]};
              if (part < 5) {
#pragma unroll
                  for (int d = 0; d < 2; ++d) {
                      const f32x2 q0 = __builtin_amdgcn_cvt_scalef32_pk_f32_fp4(w[d], 1.0f, 0), q1 = __builtin_amdgcn_cvt_scalef32_pk_f32_fp4(w[d], 1.0f, 1);
                      const f32x2 q2 = __builtin_amdgcn_cvt_scalef32_pk_f32_fp4(w[d], 1.0f, 2), q3 = __builtin_amdgcn_cvt_scalef32_pk_f32_fp4(w[d], 1.0f, 3);
                      h[8 * d] = (h[8 * d] - q0[0]) * 4.f; h[8 * d + 1] = (h[8 * d + 1] - q0[1]) * 4.f; h[8 * d + 2] = (h[8 * d + 2] - q1[0]) * 4.f; h[8 * d + 3] = (h[8 * d + 3] - q1[1]) * 4.f;
                      h[8 * d + 4] = (h[8 * d + 4] - q2[0]) * 4.f; h[8 * d + 5] = (h[8 * d + 5] - q2[1]) * 4.f; h[8 * d + 6] = (h[8 * d + 6] - q3[0]) * 4.f; h[8 * d + 7] = (h[8 * d + 7] - q3[1]) * 4.f; } } } }
        const float gwtA = GWT[(size_t)r * 128 + lane], gwtB = GWT[(size_t)r * 128 + 64 + lane];
        const float suA = SUi[eidA], suB = SUi[eidB], svA = SVi[eidA], svB = SVi[eidB];
        const int rin = ri + NGW; const bool more = rin < nrows; const int rn = map_row(more ? rin : ri, lat_only);
        hn0 = *(const v4u*)(HB + (size_t)rn * D + 16 * lane); hn1 = *(const v4u*)(HB + (size_t)rn * D + 16 * lane + 8);
        eidAn = EID[(size_t)rn * 128 + lane]; eidBn = EID[(size_t)rn * 128 + 64 + lane];
        LDS_FENCE();
        v4u bw[8];
#pragma unroll
        for (int c = 0; c < 8; ++c) bw[c] = *(LAS const v4u*)(wl + boff + 16 * c);
#pragma unroll 1
        for (int G = 0; G < 8; ++G) {
            if (G < 7 || more) asm volatile("s_waitcnt vmcnt(8)" ::: "memory"); else asm volatile("s_waitcnt vmcnt(0)" ::: "memory");
            const unsigned bufo = (G & 1) ? (unsigned)P1_BUF : 0u;
            v4u aw[8];
#pragma unroll
            for (int c = 0; c < 8; ++c) aw[c] = *(LAS const v4u*)(wl + bufo + aoff + 16 * c);
            asm volatile("s_waitcnt lgkmcnt(0)" ::: "memory");
            { const int srcsel = G < 2 ? eidA : (G < 6 ? eidB : eidAn); const int base = 16 * ((G + 2) & 3);
              if (G < 6 || more) { if (G & 1) P1_DMA(srcsel, base, P1_BUF); else P1_DMA(srcsel, base, 0); } }
            f32x4 acc = (f32x4){0.f, 0.f, 0.f, 0.f};
#pragma unroll
            for (int c = 0; c < 8; ++c) {
                const v8i A = (v8i){(int)aw[c].x, (int)aw[c].y, (int)aw[c].z, (int)aw[c].w, 0, 0, 0, 0};
                const v8i Bv = (v8i){(int)bw[c].x, (int)bw[c].y, (int)bw[c].z, (int)bw[c].w, 0, 0, 0, 0};
                acc = __builtin_amdgcn_mfma_scale_f32_16x16x128_f8f6f4(A, Bv, acc, 4, 4, 0, 0, 0, 0); }
            f32x4 dv;
#pragma unroll
            for (int k = 0; k < 4; ++k) dv[k] = gsum16(acc[k] * wn);
            if (n == 0) { LAS float* dp = dots + 16 * G + p1_exp(4 * g); dp[0] = dv[0]; dp[2] = dv[1]; dp[4] = dv[2]; dp[6] = dv[3]; }
        }
        LDS_FENCE();
        { const float dot = dots[lane] * suA; COEF[(size_t)r * 128 + lane] = gwtA * 0.5f * dot * (1.f + erff(dot * 0.70710678118f)) * svA; }
        { const float dot = dots[64 + lane] * suB; COEF[(size_t)r * 128 + 64 + lane] = gwtB * 0.5f * dot * (1.f + erff(dot * 0.70710678118f)) * svB; }
    }
#undef P1_DMA
}
constexpr int P2_INSTR = 1040, P2_CPART = 16 * P2_INSTR, P2_CSTAGE = P2_CPART + 256, P2_FSTAGE = P2_CSTAGE + 512;
typedef int v2i __attribute__((ext_vector_type(2)));
template <bool USE_PEER>
__device__ __forceinline__ void peer_expert_tail(const float* COEF, const int* EID, const unsigned char* V4,
                                            float* lat, float* ctx, const float* mod, const float* lnw, const float* lnb, LAS unsigned char* lds, int wave, int gw, int NGW, int lane, int dry, bool lat_only, int k0) {
    LAS unsigned char* wl = lds + wave * P1_WAVE_LDS;
    LAS float* cstage = (LAS float*)(wl + P2_CSTAGE); LAS float* fstage = (LAS float*)(wl + P2_FSTAGE);
    const int c = lane & 15, kb = lane >> 4, drow = lane >> 3, dpos = lane & 7;
    const unsigned trbase = (unsigned)(c * P2_INSTR + 256 * kb);
    LAS float* fdst = kb == 0 ? fstage + c : (LAS float*)(wl + P2_FSTAGE + 1024) + lane;
    const int nrows = lat_only ? NB * SEQ : TT;
    int ri = gw + k0 * NGW;
    if (ri >= nrows) return;
    unsigned roff[16];
#define P2_ROFF(row_) do { _Pragma("unroll") for (int i_ = 0; i_ < 16; ++i_) roff[i_] = (unsigned)EID[(size_t)(row_) * 128 + 16 * drow + i_] * 512u + 16u * (unsigned)dpos; } while (0)
    P2_ROFF(map_row(ri, lat_only));
#define P2_DMA(cqo_) do { _Pragma("unroll") for (int i_ = 0; i_ < 16; ++i_) \
        __builtin_amdgcn_global_load_lds((const unsigned*)(V4 + (size_t)(roff[i_] + (cqo_))), (LAS unsigned*)(wl + P2_INSTR * i_), 16, 0, 0); } while (0)
    if (USE_PEER) P2_DMA(0u);
    for (; ri < nrows; ri += NGW) {
        const int r = map_row(ri, lat_only);
        const int b = r / PB, p = r - b * PB; float* xr = srow(lat, ctx, r); const float* mr = mod + (size_t)(p < LC ? 8 : b) * 6144;
        float f[16];
#pragma unroll
        for (int i = 0; i < 16; ++i) f[i] = 0.f;
        if (USE_PEER) {
        const int rin = ri + NGW; const bool more = rin < nrows; const int rn = map_row(more ? rin : ri, lat_only);
        const float cA = COEF[(size_t)r * 128 + lane], cB = COEF[(size_t)r * 128 + 64 + lane];
        float cm = fmaxf(fabsf(cA), fabsf(cB));
        cm = fmaxf(cm, dppmov_f<0xB1>(cm)); cm = fmaxf(cm, dppmov_f<0x4E>(cm)); cm = fmaxf(cm, dppmov_f<0x141>(cm)); cm = fmaxf(cm, dppmov_f<0x128>(cm)); cm = fmaxf(cm, __shfl_xor(cm, 16)); cm = fmaxf(cm, __shfl_xor(cm, 32));
        const float sc = cm > 0.f ? 6.0f / cm : 1.f, isc = cm > 0.f ? cm * (1.f / 6.0f) : 1.f;
        cstage[lane] = cA * sc; cstage[64 + lane] = cB * sc;
        LDS_FENCE();
        if (lane < 16) {
            float h[8]; { const f32x4 x0 = *(LAS const f32x4*)(cstage + 8 * lane), x1 = *(LAS const f32x4*)(cstage + 8 * lane + 4); h[0] = x0[0]; h[1] = x0[1]; h[2] = x0[2]; h[3] = x0[3]; h[4] = x1[0]; h[5] = x1[1]; h[6] = x1[2]; h[7] = x1[3]; }
#pragma unroll
            for (int part = 0; part < 4; ++part) {
                unsigned t = 0u;
                t = __builtin_amdgcn_cvt_scalef32_pk_fp4_f32(t, h[0], h[1], 1.0f, 0); t = __builtin_amdgcn_cvt_scalef32_pk_fp4_f32(t, h[2], h[3], 1.0f, 1);
                t = __builtin_amdgcn_cvt_scalef32_pk_fp4_f32(t, h[4], h[5], 1.0f, 2); t = __builtin_amdgcn_cvt_scalef32_pk_fp4_f32(t, h[6], h[7], 1.0f, 3);
                *(LAS unsigned*)(wl + P2_CPART + 64 * part + 4 * lane) = t;
                if (part < 3) { const f32x2 q0 = __builtin_amdgcn_cvt_scalef32_pk_f32_fp4(t, 1.0f, 0), q1 = __builtin_amdgcn_cvt_scalef32_pk_f32_fp4(t, 1.0f, 1), q2 = __builtin_amdgcn_cvt_scalef32_pk_f32_fp4(t, 1.0f, 2), q3 = __builtin_amdgcn_cvt_scalef32_pk_f32_fp4(t, 1.0f, 3);
                    h[0] = (h[0] - q0[0]) * 4.f; h[1] = (h[1] - q0[1]) * 4.f; h[2] = (h[2] - q1[0]) * 4.f; h[3] = (h[3] - q1[1]) * 4.f; h[4] = (h[4] - q2[0]) * 4.f; h[5] = (h[5] - q2[1]) * 4.f; h[6] = (h[6] - q3[0]) * 4.f; h[7] = (h[7] - q3[1]) * 4.f; } } }
        LDS_FENCE();
        v4u aw = (v4u){0u, 0u, 0u, 0u};
        if (c < 4) aw = *(LAS const v4u*)(wl + P2_CPART + 64 * c + 16 * kb);
        const v8i A = (v8i){(int)aw.x, (int)aw.y, (int)aw.z, (int)aw.w, 0, 0, 0, 0};
#pragma unroll 1
        for (int cq = 0; cq < 4; ++cq) {
            asm volatile("s_waitcnt vmcnt(0)" ::: "memory");
#define P2_TILES(t0_) do { v2i r1[8], r2[8]; \
            _Pragma("unroll") for (int t = 0; t < 8; ++t) { const unsigned a = trbase + 8u * (unsigned)((t0_) + t); \
                r1[t] = __builtin_amdgcn_ds_read_tr4_b64_v2i32((LAS v2i*)(wl + a)); r2[t] = __builtin_amdgcn_ds_read_tr4_b64_v2i32((LAS v2i*)(wl + a + 128)); } \
            if ((t0_) == 8) { asm volatile("s_waitcnt lgkmcnt(0)" ::: "memory");     \
                if (cq < 3) { P2_DMA(128u * (unsigned)(cq + 1)); if (cq == 2 && more) P2_ROFF(rn); } else if (more) P2_DMA(0u); } \
            f32x4 dq[8]; \
            _Pragma("unroll") for (int t = 0; t < 8; ++t) { \
                const v8i Bv = (v8i){r1[t].x, r1[t].y, r2[t].x, r2[t].y, 0, 0, 0, 0}; \
                dq[t] = __builtin_amdgcn_mfma_scale_f32_16x16x128_f8f6f4(A, Bv, (f32x4){0.f, 0.f, 0.f, 0.f}, 4, 4, 0, 0, 0, 0); } \
            __builtin_amdgcn_sched_barrier(0);     \
            _Pragma("unroll") for (int t = 0; t < 8; ++t) { \
                const float fv = (dq[t][0] + 0.25f * dq[t][1] + 0.0625f * dq[t][2] + 0.015625f * dq[t][3]) * isc; \
                fdst[16 * ((t0_) + t)] = fv; } } while (0)
            P2_TILES(0); P2_TILES(8);
#undef P2_TILES
            LDS_FENCE();
            const f32x4 fq = *(LAS const f32x4*)(fstage + 4 * lane);
            if (cq == 0) { f[0] = fq[0]; f[1] = fq[1]; f[2] = fq[2]; f[3] = fq[3]; } else if (cq == 1) { f[4] = fq[0]; f[5] = fq[1]; f[6] = fq[2]; f[7] = fq[3]; }
            else if (cq == 2) { f[8] = fq[0]; f[9] = fq[1]; f[10] = fq[2]; f[11] = fq[3]; } else { f[12] = fq[0]; f[13] = fq[1]; f[14] = fq[2]; f[15] = fq[3]; }
        }
        }
        float v[16]; float s = 0.f;
#pragma unroll
        for (int q = 0; q < 4; ++q) { const int cc = 256 * q + 4 * lane; const f32x4 x1 = *(const f32x4*)(xr + cc), g2 = *(const f32x4*)(mr + 5120 + cc);
#pragma unroll
            for (int i = 0; i < 4; ++i) { v[4 * q + i] = DN_ALPHA * x1[i] + g2[i] * f[4 * q + i]; s += v[4 * q + i]; } }
        const float mean = wave_sum(s) * (1.f / D); float s2 = 0.f;
#pragma unroll
        for (int i = 0; i < 16; ++i) { v[i] -= mean; s2 += v[i] * v[i]; }
        const float rstd = 1.f / sqrtf(wave_sum(s2) * (1.f / D) + LN_EPS);
#pragma unroll
        for (int q = 0; q < 4; ++q) { const int cc = 256 * q + 4 * lane; const f32x4 w = *(const f32x4*)(lnw + cc), bb2 = *(const f32x4*)(lnb + cc); f32x4 o;
#pragma unroll
            for (int i = 0; i < 4; ++i) o[i] = v[4 * q + i] * rstd * w[i] + bb2[i];
            if (!dry) *(f32x4*)(xr + cc) = o; }
    }
#undef P2_DMA
#undef P2_ROFF
}


#define P2B_ROW(n_) map_row(gw + (4 * ((n_) >> 4) + ((n_) & 3)) * NGW, lat_only)
#define P2B_ROFF(n_) do { const int row_ = P2B_ROW(n_); _Pragma("unroll") for (int i_ = 0; i_ < 16; ++i_) roff[i_] = (unsigned)EID[(size_t)row_ * 128 + 16 * drow + i_] * 512u + 16u * (unsigned)dpos; } while (0)
#define P2B_DMA(n_) do { const unsigned cqo_ = 128u * (unsigned)(((n_) >> 2) & 3); _Pragma("unroll") for (int i_ = 0; i_ < 16; ++i_) \
        __builtin_amdgcn_global_load_lds((const unsigned*)(V4 + (size_t)(roff[i_] + cqo_)), (LAS unsigned*)(wl + P2_INSTR * i_), 16, 0, 0); } while (0)
#define P2B_HALF(T_, t0_) do { v2i r1[8], r2[8]; \
        _Pragma("unroll") for (int t = 0; t < 8; ++t) { const unsigned a = trbase + 8u * (unsigned)((t0_) + t); \
            r1[t] = __builtin_amdgcn_ds_read_tr4_b64_v2i32((LAS v2i*)(wl + a)); r2[t] = __builtin_amdgcn_ds_read_tr4_b64_v2i32((LAS v2i*)(wl + a + 128)); } \
        if ((t0_) == 8) { asm volatile("s_waitcnt lgkmcnt(0)" ::: "memory"); \
            if (nstep + 1 < nsteps) { P2B_DMA(nstep + 1); if (nstep + 2 < nsteps) P2B_ROFF(nstep + 2); } } \
        f32x4 dq[8]; \
        _Pragma("unroll") for (int t = 0; t < 8; ++t) { \
            const v8i Bv = (v8i){r1[t].x, r1[t].y, r2[t].x, r2[t].y, 0, 0, 0, 0}; \
            dq[t] = __builtin_amdgcn_mfma_scale_f32_16x16x128_f8f6f4(Ab[T_], Bv, (f32x4){0.f, 0.f, 0.f, 0.f}, 4, 4, 0, 0, 0, 0); } \
        __builtin_amdgcn_sched_barrier(0); \
        _Pragma("unroll") for (int t = 0; t < 8; ++t) { \
            const float fv = (dq[t][0] + 0.25f * dq[t][1] + 0.0625f * dq[t][2] + 0.015625f * dq[t][3]) * iscb[T_]; \
            fdst[16 * ((t0_) + t)] = fv; } } while (0)
#define P2B_STEP(T_, CQ_) do { const int nstep = 16 * bi + 4 * (CQ_) + (T_); \
        asm volatile("s_waitcnt vmcnt(0)" ::: "memory"); \
          \
        f32x4 x1e[4], g2e[4]; float* xre = nullptr; \
        if ((CQ_) == 3) { const int r_ = P2B_ROW(16 * bi + (T_)); const int b_ = r_ / PB, p_ = r_ - b_ * PB; xre = srow(lat, ctx, r_); const float* mr_ = mod + (size_t)(p_ < LC ? 8 : b_) * 6144; \
            _Pragma("unroll") for (int q = 0; q < 4; ++q) { x1e[q] = *(const f32x4*)(xre + 256 * q + 4 * lane); g2e[q] = *(const f32x4*)(mr_ + 5120 + 256 * q + 4 * lane); } } \
        P2B_HALF(T_, 0); P2B_HALF(T_, 8); \
        LDS_FENCE(); \
        { const f32x4 fq = *(LAS const f32x4*)(fstage + 4 * lane); fb[T_][4 * (CQ_)] = fq[0]; fb[T_][4 * (CQ_) + 1] = fq[1]; fb[T_][4 * (CQ_) + 2] = fq[2]; fb[T_][4 * (CQ_) + 3] = fq[3]; } \
        if ((CQ_) == 3) {     \
            float v[16]; float s_ = 0.f; \
            _Pragma("unroll") for (int q = 0; q < 4; ++q) { _Pragma("unroll") for (int i = 0; i < 4; ++i) { v[4 * q + i] = DN_ALPHA * x1e[q][i] + g2e[q][i] * fb[T_][4 * q + i]; s_ += v[4 * q + i]; } } \
            const float mean = wave_sum(s_) * (1.f / D); float s2 = 0.f; \
            _Pragma("unroll") for (int i = 0; i < 16; ++i) { v[i] -= mean; s2 += v[i] * v[i]; } \
            const float rstd = 1.f / sqrtf(wave_sum(s2) * (1.f / D) + LN_EPS); \
            _Pragma("unroll") for (int q = 0; q < 4; ++q) { f32x4 o; _Pragma("unroll") for (int i = 0; i < 4; ++i) o[i] = v[4 * q + i] * rstd * lw[q][i] + lb[q][i]; \
                if (!dry) *(f32x4*)(xre + 256 * q + 4 * lane) = o; } } } while (0)
template <bool USE_PEER>
__device__ __forceinline__ void peer_expert(const float* COEF, const int* EID, const unsigned char* V4,
                                            float* lat, float* ctx, const float* mod, const float* lnw, const float* lnb, LAS unsigned char* lds, int wave, int gw, int NGW, int lane, int dry, bool lat_only) {
    const int nrows = lat_only ? NB * SEQ : TT;
    const int ntok = gw < nrows ? (nrows - gw + NGW - 1) / NGW : 0, nbatch = USE_PEER ? ntok >> 2 : 0, nsteps = 16 * nbatch;
    if (nbatch > 0) {
        f32x4 lw[4], lb[4];
#pragma unroll
        for (int q = 0; q < 4; ++q) { lw[q] = *(const f32x4*)(lnw + 256 * q + 4 * lane); lb[q] = *(const f32x4*)(lnb + 256 * q + 4 * lane); }
        LAS unsigned char* wl = lds + wave * P1_WAVE_LDS;
        LAS float* cstage = (LAS float*)(wl + P2_CSTAGE); LAS float* fstage = (LAS float*)(wl + P2_FSTAGE);
        const int c = lane & 15, kb = lane >> 4, drow = lane >> 3, dpos = lane & 7;
        const unsigned trbase = (unsigned)(c * P2_INSTR + 256 * kb);
        LAS float* fdst = kb == 0 ? fstage + c : (LAS float*)(wl + P2_FSTAGE + 1024) + lane;
        unsigned roff[16];
        P2B_ROFF(0); P2B_DMA(0); if (1 < nsteps) P2B_ROFF(1);
#pragma unroll 1
        for (int bi = 0; bi < nbatch; ++bi) {
            v8i Ab[4]; float iscb[4];
#pragma unroll
            for (int T = 0; T < 4; ++T) {
                const int r = P2B_ROW(16 * bi + T);
                const float cA = COEF[(size_t)r * 128 + lane], cB = COEF[(size_t)r * 128 + 64 + lane];
                float cm = fmaxf(fabsf(cA), fabsf(cB));
                cm = fmaxf(cm, dppmov_f<0xB1>(cm)); cm = fmaxf(cm, dppmov_f<0x4E>(cm)); cm = fmaxf(cm, dppmov_f<0x141>(cm)); cm = fmaxf(cm, dppmov_f<0x128>(cm)); cm = fmaxf(cm, __shfl_xor(cm, 16)); cm = fmaxf(cm, __shfl_xor(cm, 32));
                const float sc = cm > 0.f ? 6.0f / cm : 1.f; iscb[T] = cm > 0.f ? cm * (1.f / 6.0f) : 1.f;
                cstage[lane] = cA * sc; cstage[64 + lane] = cB * sc;
                LDS_FENCE();
                if (lane < 16) {
                    float h[8]; { const f32x4 x0 = *(LAS const f32x4*)(cstage + 8 * lane), x1 = *(LAS const f32x4*)(cstage + 8 * lane + 4); h[0] = x0[0]; h[1] = x0[1]; h[2] = x0[2]; h[3] = x0[3]; h[4] = x1[0]; h[5] = x1[1]; h[6] = x1[2]; h[7] = x1[3]; }
#pragma unroll
                    for (int part = 0; part < 4; ++part) {
                        unsigned t = 0u;
                        t = __builtin_amdgcn_cvt_scalef32_pk_fp4_f32(t, h[0], h[1], 1.0f, 0); t = __builtin_amdgcn_cvt_scalef32_pk_fp4_f32(t, h[2], h[3], 1.0f, 1);
                        t = __builtin_amdgcn_cvt_scalef32_pk_fp4_f32(t, h[4], h[5], 1.0f, 2); t = __builtin_amdgcn_cvt_scalef32_pk_fp4_f32(t, h[6], h[7], 1.0f, 3);
                        *(LAS unsigned*)(wl + P2_CPART + 64 * part + 4 * lane) = t;
                        if (part < 3) { const f32x2 q0 = __builtin_amdgcn_cvt_scalef32_pk_f32_fp4(t, 1.0f, 0), q1 = __builtin_amdgcn_cvt_scalef32_pk_f32_fp4(t, 1.0f, 1), q2 = __builtin_amdgcn_cvt_scalef32_pk_f32_fp4(t, 1.0f, 2), q3 = __builtin_amdgcn_cvt_scalef32_pk_f32_fp4(t, 1.0f, 3);
                            h[0] = (h[0] - q0[0]) * 4.f; h[1] = (h[1] - q0[1]) * 4.f; h[2] = (h[2] - q1[0]) * 4.f; h[3] = (h[3] - q1[1]) * 4.f; h[4] = (h[4] - q2[0]) * 4.f; h[5] = (h[5] - q2[1]) * 4.f; h[6] = (h[6] - q3[0]) * 4.f; h[7] = (h[7] - q3[1]) * 4.f; } } }
                LDS_FENCE();
                v4u aw = (v4u){0u, 0u, 0u, 0u};
                if (c < 4) aw = *(LAS const v4u*)(wl + P2_CPART + 64 * c + 16 * kb);
                Ab[T] = (v8i){(int)aw.x, (int)aw.y, (int)aw.z, (int)aw.w, 0, 0, 0, 0};
                LDS_FENCE();
            }
            float fb[4][16];
            P2B_STEP(0, 0); P2B_STEP(1, 0); P2B_STEP(2, 0); P2B_STEP(3, 0);
            P2B_STEP(0, 1); P2B_STEP(1, 1); P2B_STEP(2, 1); P2B_STEP(3, 1);
            P2B_STEP(0, 2); P2B_STEP(1, 2); P2B_STEP(2, 2); P2B_STEP(3, 2);
            P2B_STEP(0, 3); P2B_STEP(1, 3); P2B_STEP(2, 3); P2B_STEP(3, 3);
        }
    }
    peer_expert_tail<USE_PEER>(COEF, EID, V4, lat, ctx, mod, lnw, lnb, lds, wave, gw, NGW, lane, dry, lat_only, 4 * nbatch);
}
#undef P2B_STEP
#undef P2B_HALF
#undef P2B_DMA
#undef P2B_ROFF
#undef P2B_ROW

__device__ __forceinline__ bf16* od_row_base(unsigned char* ws, int dir, int b) {
    if (dir == 0) return (bf16*)(ws + WS_ST) + (size_t)b * SEQ * 1024;
    return b < 7 ? (bf16*)(ws + WS_ST + 64 * MiB) + (size_t)b * SEQ * 1024 : (bf16*)(ws + WS_XC);
}
__device__ __forceinline__ void gla_fused_scan(const bf16* P, const bf16* QKR, unsigned char* ws, LAS unsigned char* lds, int vcu, int G, int wave, int lane, int tid, int dry) {
    const float* ET = (const float*)(ws + WS_ET);
    LAS bf16* Qt = (LAS bf16*)lds;
    LAS bf16* Kt = (LAS bf16*)(lds + 34816);
    LAS bf16* Vt = (LAS bf16*)(lds + 69632);
    LAS bf16* SL = (LAS bf16*)(lds + 88064);
    LAS bf16* Pw = (LAS bf16*)(lds + 124928 + wave * 2304);
    const int g = lane >> 4, c16 = lane & 15, mt = wave & 3, cw = wave >> 2;
    for (int item = vcu; item < 256; item += G) {
        const int dir = item >> 7, b = (item >> 4) & 7, h = (item >> 2) & 3, eb = item & 3;
        const bf16* qsrc = dir == 0 ? P + h * 128 : QKR + h * 128; const int qld = dir == 0 ? N_C : 1024;
        const bf16* vsrc = P + 1024 + h * 256 + 64 * eb;
        const float* etp = ET + ((size_t)((dir * 8 + b) * 4 + h) * NCH) * 128 + 16 * wave + c16;
        bf16* odb = od_row_base(ws, dir, b) + h * 256 + 64 * eb;
        f32x4 acc[4];
#pragma unroll
        for (int et = 0; et < 4; ++et) acc[et] = (f32x4){0.f, 0.f, 0.f, 0.f};
        v4u qreg[2][2], kreg[2][2], vreg[2]; float etn[2];
#define GLA_JOF(sc_) (dir == 0 ? (sc_) : ((sc_) < 4 ? 3 - (sc_) : 71 - (sc_)))
#define GLA_PREFETCH(sc0_) do { _Pragma("unroll") for (int u = 0; u < 2; ++u) { const int jj = GLA_JOF((sc0_) + u); const int row0 = b * PB + jj * 64; \
            _Pragma("unroll") for (int i = 0; i < 2; ++i) { const int cidx = tid + 512 * i, rr = cidx >> 4, ch = cidx & 15; const bf16* sp = qsrc + (size_t)(row0 + rr) * qld + ch * 8; qreg[u][i] = *(const v4u*)sp; kreg[u][i] = *(const v4u*)(sp + 512); } \
            vreg[u] = *(const v4u*)(vsrc + (size_t)(row0 + (tid >> 3)) * N_C + (tid & 7) * 8); etn[u] = etp[(size_t)jj * 128]; } } while (0)
        GLA_PREFETCH(0);
        unsigned opk[8]; int ojc = -1;
#pragma unroll
        for (int i = 0; i < 8; ++i) opk[i] = 0u;
        for (int sc = 0; sc < NCH; sc += 2) {
            const int ja = GLA_JOF(sc), jb = GLA_JOF(sc + 1);
            __syncthreads();
            if (ojc >= 4 && !dry) {
#pragma unroll
                for (int nt = 0; nt < 4; ++nt) { bf16* orow = odb + (size_t)((ojc - 4) * 64 + 16 * mt + 4 * g) * 1024 + 16 * nt + c16;
#pragma unroll
                    for (int r = 0; r < 4; ++r) orow[(size_t)r * 1024] = (bf16)((opk[2 * nt + (r >> 1)] >> (16 * (r & 1))) & 0xffffu); } }
#pragma unroll
            for (int u = 0; u < 2; ++u) {
#pragma unroll
                for (int i = 0; i < 2; ++i) { const int cidx = tid + 512 * i, rr = cidx >> 4, ch = cidx & 15; *(LAS v4u*)(Qt + u * 8704 + rr * 136 + ch * 8) = qreg[u][i]; *(LAS v4u*)(Kt + u * 8704 + rr * 136 + ch * 8) = kreg[u][i]; }
                *(LAS v4u*)(Vt + u * 4608 + (tid >> 3) * 72 + (tid & 7) * 8) = vreg[u]; }
#pragma unroll
            for (int et = 0; et < 4; ++et) *(LAS v2u*)(SL + (16 * wave + c16) * 72 + 16 * et + 4 * g) = (v2u){pk2(acc[et][0], acc[et][1]), pk2(acc[et][2], acc[et][3])};
            const float et_a = etn[0], et_b = etn[1];
            if (sc + 2 < NCH) GLA_PREFETCH(sc + 2);
            __syncthreads();
#pragma unroll
            for (int ks = 0; ks < 2; ++ks) { const bf16x8 kb = frag_tr(Kt, 136, 32 * ks, 16 * wave, lane);
#pragma unroll
                for (int et = 0; et < 4; ++et) acc[et] = mma(frag_tr(Vt, 72, 32 * ks, 16 * et, lane), kb, acc[et]); }
#pragma unroll
            for (int et = 0; et < 4; ++et) { acc[et] = acc[et] * et_a;
                *(LAS v2u*)(SL + 9216 + (16 * wave + c16) * 72 + 16 * et + 4 * g) = (v2u){pk2(acc[et][0], acc[et][1]), pk2(acc[et][2], acc[et][3])}; }
            __syncthreads();
            const int jc = cw == 0 ? ja : jb;
            ojc = jc;
            if (jc >= 4) {
                const LAS bf16* Qc = Qt + cw * 8704; const LAS bf16* Kc = Kt + cw * 8704; const LAS bf16* Vc = Vt + cw * 4608; const LAS bf16* Sc = SL + cw * 9216;
                bf16x8 qf[4];
#pragma unroll
                for (int ks = 0; ks < 4; ++ks) qf[ks] = frag_row(Qc, 136, 16 * mt, 32 * ks, lane);
                bf16x8 pa[2];
                { f32x4 st[4];
#pragma unroll
                  for (int ns = 0; ns < 4; ++ns) { st[ns] = (f32x4){0.f, 0.f, 0.f, 0.f};
#pragma unroll
                      for (int ks = 0; ks < 4; ++ks) st[ns] = mma(frag_row(Kc, 136, 16 * ns, 32 * ks, lane), qf[ks], st[ns]);
#pragma unroll
                      for (int r = 0; r < 4; ++r) { const int sidx = 16 * ns + 4 * g + r, t = 16 * mt + c16; const bool ok = dir == 0 ? (sidx <= t) : (sidx >= t); st[ns][r] = ok ? st[ns][r] : 0.f; } }
#pragma unroll
                  for (int ks2 = 0; ks2 < 2; ++ks2) { const v4u wv = (v4u){pk2(st[2 * ks2][0], st[2 * ks2][1]), pk2(st[2 * ks2][2], st[2 * ks2][3]), pk2(st[2 * ks2 + 1][0], st[2 * ks2 + 1][1]), pk2(st[2 * ks2 + 1][2], st[2 * ks2 + 1][3])};
                      pa[ks2] = __builtin_bit_cast(bf16x8, wv); } }
#pragma unroll
                for (int nt = 0; nt < 4; ++nt) { f32x4 a = (f32x4){0.f, 0.f, 0.f, 0.f};
#pragma unroll
                    for (int ks = 0; ks < 4; ++ks) a = mma(qf[ks], frag_tr(Sc, 72, 32 * ks, 16 * nt, lane), a);
                    a = mma(pa[0], frag_tr_perm(Vc, 72, 0, 16 * nt, lane), a); a = mma(pa[1], frag_tr_perm(Vc, 72, 32, 16 * nt, lane), a);
                    opk[2 * nt] = pk2(a[0], a[1]); opk[2 * nt + 1] = pk2(a[2], a[3]); }
                LDS_FENCE();
            }
#pragma unroll
            for (int ks = 0; ks < 2; ++ks) { const bf16x8 kb = frag_tr(Kt + 8704, 136, 32 * ks, 16 * wave, lane);
#pragma unroll
                for (int et = 0; et < 4; ++et) acc[et] = mma(frag_tr(Vt + 4608, 72, 32 * ks, 16 * et, lane), kb, acc[et]); }
#pragma unroll
            for (int et = 0; et < 4; ++et) acc[et] = acc[et] * et_b;
        }
        if (ojc >= 4 && !dry) {
#pragma unroll
            for (int nt = 0; nt < 4; ++nt) { bf16* orow = odb + (size_t)((ojc - 4) * 64 + 16 * mt + 4 * g) * 1024 + 16 * nt + c16;
#pragma unroll
                for (int r = 0; r < 4; ++r) orow[(size_t)r * 1024] = (bf16)((opk[2 * nt + (r >> 1)] >> (16 * (r & 1))) & 0xffffu); } }
#undef GLA_PREFETCH
#undef GLA_JOF
    }
}
__device__ __forceinline__ void gla_merge(bf16* P, const float* norm_w, unsigned char* ws, int gw, int NGW, int lane, int dry) {
    float nw[16];
#pragma unroll
    for (int k = 0; k < 16; ++k) nw[k] = norm_w[16 * lane + k];
    for (int i = gw; i < NB * SEQ; i += NGW) {
        const int b = i >> 12, lp = i & 4095; const size_t r = (size_t)b * PB + LC + lp;
        const bf16* of = od_row_base(ws, 0, b) + (size_t)lp * 1024 + 16 * lane; const bf16* orv = od_row_base(ws, 1, b) + (size_t)lp * 1024 + 16 * lane;
        bf16* grow = P + r * N_C + 2048 + 16 * lane;
        float x[16], y[16], gg[16];
        unpack8(*(const v4u*)of, x); unpack8(*(const v4u*)(of + 8), x + 8); unpack8(*(const v4u*)orv, y); unpack8(*(const v4u*)(orv + 8), y + 8);
        unpack8(*(const v4u*)grow, gg); unpack8(*(const v4u*)(grow + 8), gg + 8);
        float ss = 0.f;
#pragma unroll
        for (int k = 0; k < 16; ++k) { x[k] += y[k]; ss += x[k] * x[k]; }
        ss = gsum16(ss);
        const float rn = 1.f / sqrtf(ss * (1.f / 256.f) + LN_EPS);
        unsigned ow[8];
#pragma unroll
        for (int k = 0; k < 8; ++k) { const float4 dummy = make_float4(0.f, 0.f, 0.f, 0.f); (void)dummy;
            const float a = x[2 * k] * rn * nw[2 * k] * siluf_(gg[2 * k]), c = x[2 * k + 1] * rn * nw[2 * k + 1] * siluf_(gg[2 * k + 1]); ow[k] = pk2(a, c); }
        if (!dry) { v4u o0, o1; o0.x = ow[0]; o0.y = ow[1]; o0.z = ow[2]; o0.w = ow[3]; o1.x = ow[4]; o1.y = ow[5]; o1.z = ow[6]; o1.w = ow[7]; *(v4u*)grow = o0; *(v4u*)(grow + 8) = o1; }
    }
}

__device__ __forceinline__ void mlstm_fused_scan(const bf16* P, unsigned char* ws, LAS unsigned char* lds, int vcu, int G, int wave, int lane, int tid) {
    const float* BQ = (const float*)(ws + WS_BQ); const float* CQ = (const float*)(ws + WS_CQ); const float* EM = (const float*)(ws + WS_EM); const float* AI = (const float*)(ws + WS_AI);
    const float* AST = (const float*)(ws + WS_AST); const float* CL = (const float*)(ws + WS_CL);
    LAS bf16* Qt = (LAS bf16*)lds;
    LAS bf16* Kt = (LAS bf16*)(lds + 17408);
    LAS bf16* Vt = (LAS bf16*)(lds + 34816);
    LAS bf16* Vw = (LAS bf16*)(lds + 41984);
    LAS bf16* CT = (LAS bf16*)(lds + 49152);
    LAS bf16* Pw = (LAS bf16*)(lds + 62208 + wave * 2304);
    const int g = lane >> 4, c16 = lane & 15, mt = wave & 3, hf = wave >> 2;
    const int vrow = tid < 256 ? (tid >> 2) : ((tid - 256) & 63), vch = tid & 3;
    for (int item = vcu; item < 256; item += G) {
        const int dir = item >> 7, b = (item >> 4) & 7, h = (item >> 2) & 3, eb = item & 3;
        const int chain = dir * 32 + b * 4 + h;
        const bf16* qsrc = P + h * 128; const bf16* vsrc = P + 1024 + h * 128 + 32 * eb;
        bf16* odb = (bf16*)(ws + WS_ST) + (size_t)dir * TT * 512 + h * 128 + 32 * eb;
        f32x4 acc[3];
#pragma unroll
        for (int et = 0; et < 3; ++et) acc[et] = (f32x4){0.f, 0.f, 0.f, 0.f};
        LAS float* gs = (LAS float*)(lds + 81920);
#define MGS_J(sn_) (dir == 0 ? (sn_) : ((sn_) < 4 ? 3 - (sn_) : 71 - (sn_)))
#define MGS_VAL(jj_) ({ float v_ = 0.f; const size_t tb_ = (size_t)chain * PB + (size_t)(jj_) * 64; \
            if (tid < 256) { const float* ap_ = tid < 64 ? BQ : (tid < 128 ? CQ : (tid < 192 ? AI : EM)); v_ = ap_[tb_ + (tid & 63)]; } \
            else if (tid == 256) v_ = CL[chain * NCH + (jj_)]; else if (tid == 257) v_ = AST[chain * NCH + (jj_)]; v_; })
        v4u qreg[2], kreg[2], vreg; float gpre;
        __syncthreads();
        { const int j0 = MGS_J(0); const int row0 = b * PB + j0 * 64;
#pragma unroll
          for (int i = 0; i < 2; ++i) { const int cidx = tid + 512 * i, rr = cidx >> 4, ch = cidx & 15; const bf16* s = qsrc + (size_t)(row0 + rr) * N_AB + ch * 8; qreg[i] = *(const v4u*)s; kreg[i] = *(const v4u*)(s + 512); }
          vreg = *(const v4u*)(vsrc + (size_t)(row0 + vrow) * N_AB + vch * 8);
          const float g0 = MGS_VAL(j0); if (tid < 258) gs[tid] = g0;
          gpre = MGS_VAL(MGS_J(1)); }
        for (int sc = 0; sc < NCH; ++sc) {
            const int j = dir == 0 ? sc : (sc < 4 ? 3 - sc : 71 - sc);
            __syncthreads();
#pragma unroll
            for (int i = 0; i < 2; ++i) { const int cidx = tid + 512 * i, rr = cidx >> 4, ch = cidx & 15; *(LAS v4u*)(Qt + rr * 136 + ch * 8) = qreg[i]; *(LAS v4u*)(Kt + rr * 136 + ch * 8) = kreg[i]; }
            const LAS float* gc = gs + (sc & 1) * 264;
            { const float wsv = __expf(gc[vrow] - gc[256]);
              if (tid < 256) { const v4u raw = vreg; v4u o;
                  o.x = pk2(bflo(raw.x) * wsv, bfhi(raw.x) * wsv); o.y = pk2(bflo(raw.y) * wsv, bfhi(raw.y) * wsv); o.z = pk2(bflo(raw.z) * wsv, bfhi(raw.z) * wsv); o.w = pk2(bflo(raw.w) * wsv, bfhi(raw.w) * wsv);
                  *(LAS v4u*)(Vt + vrow * 56 + vch * 8) = raw; *(LAS v4u*)(Vw + vrow * 56 + vch * 8) = o;
              } else if (tid < 320) { v4u o; o.x = 0x3f80u; o.y = 0u; o.z = 0u; o.w = 0u; *(LAS v4u*)(Vt + vrow * 56 + 32) = o; o.x = f2bf(wsv); *(LAS v4u*)(Vw + vrow * 56 + 32) = o;
                  o.x = 0u; *(LAS v4u*)(Vt + vrow * 56 + 40) = o; *(LAS v4u*)(Vw + vrow * 56 + 40) = o; } }
#pragma unroll
            for (int et = 0; et < 3; ++et) *(LAS v2u*)(CT + (16 * wave + c16) * 56 + 16 * et + 4 * g) = (v2u){pk2(acc[et][0], acc[et][1]), pk2(acc[et][2], acc[et][3])};
            const float ast = gc[257], cqt = gc[64 + 16 * mt + c16]; f32x4 bq[4]; const f32x4 ai = *(LAS const f32x4*)(gc + 128 + 16 * mt + 4 * g), em = *(LAS const f32x4*)(gc + 192 + 16 * mt + 4 * g);
#pragma unroll
            for (int k = 0; k < 4; ++k) bq[k] = *(LAS const f32x4*)(gc + 16 * k + 4 * g);
            if (tid < 258) gs[((sc + 1) & 1) * 264 + tid] = gpre;
            if (sc + 2 < NCH) gpre = MGS_VAL(MGS_J(sc + 2));
            if (sc + 1 < NCH) { const int jn = MGS_J(sc + 1); const int row0 = b * PB + jn * 64;
#pragma unroll
                for (int i = 0; i < 2; ++i) { const int cidx = tid + 512 * i, rr = cidx >> 4, ch = cidx & 15; const bf16* s = qsrc + (size_t)(row0 + rr) * N_AB + ch * 8; qreg[i] = *(const v4u*)s; kreg[i] = *(const v4u*)(s + 512); }
                vreg = *(const v4u*)(vsrc + (size_t)(row0 + vrow) * N_AB + vch * 8); }
            __syncthreads();
            bf16x8 qf[4];
#pragma unroll
            for (int ks = 0; ks < 4; ++ks) qf[ks] = frag_row(Qt, 136, 16 * mt, 32 * ks, lane);
            bf16x8 pa[2];
            { f32x4 st[4];
#pragma unroll
              for (int ns = 0; ns < 4; ++ns) { st[ns] = (f32x4){0.f, 0.f, 0.f, 0.f};
#pragma unroll
                  for (int ks = 0; ks < 4; ++ks) st[ns] = mma(frag_row(Kt, 136, 16 * ns, 32 * ks, lane), qf[ks], st[ns]);
#pragma unroll
                  for (int r = 0; r < 4; ++r) { const int sidx = 16 * ns + 4 * g + r, t = 16 * mt + c16; const bool ok = dir == 0 ? (sidx <= t) : (sidx >= t);
                      st[ns][r] = ok ? st[ns][r] * __expf(bq[ns][r] - cqt) : 0.f; } }
#pragma unroll
              for (int ks2 = 0; ks2 < 2; ++ks2) { const v4u wv = (v4u){pk2(st[2 * ks2][0], st[2 * ks2][1]), pk2(st[2 * ks2][2], st[2 * ks2][3]), pk2(st[2 * ks2 + 1][0], st[2 * ks2 + 1][1]), pk2(st[2 * ks2 + 1][2], st[2 * ks2 + 1][3])};
                  pa[ks2] = __builtin_bit_cast(bf16x8, wv); } }
            f32x4 av, ad;
            { f32x4 a = (f32x4){0.f, 0.f, 0.f, 0.f}, d = (f32x4){0.f, 0.f, 0.f, 0.f};
#pragma unroll
              for (int ks = 0; ks < 4; ++ks) { a = mma(qf[ks], frag_tr(CT, 56, 32 * ks, 16 * hf, lane), a); d = mma(qf[ks], frag_tr(CT, 56, 32 * ks, 32, lane), d); }
#pragma unroll
              for (int r = 0; r < 4; ++r) { a[r] *= ai[r]; d[r] *= ai[r]; }
#pragma unroll
              for (int ks = 0; ks < 2; ++ks) { a = mma(pa[ks], frag_tr_perm(Vt, 56, 32 * ks, 16 * hf, lane), a); d = mma(pa[ks], frag_tr_perm(Vt, 56, 32 * ks, 32, lane), d); }
              av = a; ad = d; }
            { bf16* orow = odb + (size_t)(b * PB + j * 64 + 16 * mt + 4 * g) * 512 + 16 * hf + c16;
#pragma unroll
              for (int r = 0; r < 4; ++r) { const float den = __shfl(ad[r], lane & 48); orow[(size_t)r * 512] = (bf16)f2bf(av[r] / fmaxf(fabsf(den), em[r])); } }
#pragma unroll
            for (int et = 0; et < 3; ++et) acc[et] = acc[et] * ast;
#pragma unroll
            for (int ks = 0; ks < 2; ++ks) { const bf16x8 kb = frag_tr(Kt, 136, 32 * ks, 16 * wave, lane);
#pragma unroll
                for (int et = 0; et < 3; ++et) acc[et] = mma(frag_tr(Vw, 56, 32 * ks, 16 * et, lane), kb, acc[et]); }
        }
    }
}
__device__ __forceinline__ void mlstm_merge(const bf16* P, bf16* CAT, const float* norm_w, unsigned char* ws, int gw, int NGW, int lane) {
    const bf16* OD = (const bf16*)(ws + WS_ST);
    float nw[8];
#pragma unroll
    for (int k = 0; k < 8; ++k) nw[k] = norm_w[8 * lane + k];
    for (int r = gw; r < TT; r += NGW) {
        float x[8], y[8], og[8];
        unpack8(*(const v4u*)(OD + (size_t)r * 512 + 8 * lane), x); unpack8(*(const v4u*)(OD + (size_t)TT * 512 + (size_t)r * 512 + 8 * lane), y);
        unpack8(*(const v4u*)(P + (size_t)r * N_AB + 1536 + 8 * lane), og);
        float ss = 0.f;
#pragma unroll
        for (int k = 0; k < 8; ++k) { x[k] += y[k]; ss += x[k] * x[k]; }
        ss = gsum16(ss);
        const float rn = 1.f / sqrtf(ss * (1.f / 128.f) + LN_EPS);
        unsigned ow[4];
#pragma unroll
        for (int k = 0; k < 4; ++k) ow[k] = pk2(x[2 * k] * rn * nw[2 * k] * sigmoidf_(og[2 * k]), x[2 * k + 1] * rn * nw[2 * k + 1] * sigmoidf_(og[2 * k + 1]));
        v4u o; o.x = ow[0]; o.y = ow[1]; o.z = ow[2]; o.w = ow[3]; *(v4u*)(CAT + (size_t)r * D + 8 * lane) = o;
    }
}

#ifndef PHMASK
#define PHMASK 0xffffffffu
#endif
#define PH(k) ((PHMASK >> (k)) & 1u)
#ifndef REPMASK
#define REPMASK 0u
#endif
#define REPS(k) (1 + (int)((REPMASK >> (k)) & 1u))
#if REPMASK
#define DRYV(k) ({ int d_ = (rep_ + 1 < REPS(k)) ? 1 : 0; asm volatile("" : "+s"(d_)); d_; })
#else
#define DRYV(k) 0
#endif
#ifndef DBG_LEVEL
#define DBG_LEVEL 3
#endif
typedef const __attribute__((address_space(4))) Args* KArgsP;
__device__ __forceinline__ KArgsP kargs() { KArgsP p = (KArgsP)__builtin_amdgcn_kernarg_segment_ptr(); asm volatile("" : "+s"(p)); return p; }
#define WSP(off) (ws + (off))
__global__ void __launch_bounds__(512, 2) fwd_megakernel(Args A_unused) {
    extern __shared__ __attribute__((aligned(16))) unsigned char lds_raw[];
    LAS unsigned char* lds = (LAS unsigned char*)lds_raw;
    const int tid0 = threadIdx.x;
    const int G = gridDim.x; const int bx = blockIdx.x; const int vcu = (G % 8 == 0) ? (bx % 8) * (G / 8) + bx / 8 : bx;
    const int NGW = G * 8;
    volatile LAS unsigned* MISC = (volatile LAS unsigned*)(lds + MISC_OFF);
    if (tid0 < 16) MISC[tid0] = 0u;
    __syncthreads();
    XcdBarrier bar;
    { KArgsP ap = kargs(); bar = xcd_barrier_post((unsigned*)(ap->ws + WS_CTL) + 1024, MISC + 8); }
#define GRID_BAR() xcd_barrier(bar)
#define PROLOG KArgsP ap = kargs(); unsigned char* ws = ap->ws; (void)ws; int tid = tid0; asm volatile("" : "+v"(tid)); const int lane = tid & 63, wave = __builtin_amdgcn_readfirstlane(tid >> 6), gw = vcu * 8 + wave; (void)lane; (void)wave; (void)gw;

    if (PH(0)) for (int rep_ = 0; rep_ < REPS(0); ++rep_) { int tid = tid0; asm volatile("" : "+v"(tid)); const int lane = tid & 63, wave = __builtin_amdgcn_readfirstlane(tid >> 6); Args A; { KArgsP ap = kargs();
#pragma unroll
        for (int i = 0; i < 22; ++i) A.in[i] = ap->in[i];
        A.out = ap->out; A.ws = ap->ws; }
        p0_prologue(A, lds, vcu, G, wave, lane, tid); }
    GRID_BAR();

    if (PH(1)) for (int rep_ = 0; rep_ < REPS(1); ++rep_) { PROLOG h_phase<16>(ap->in[I_X], ap->in[I_CTX], (const float*)WSP(WS_MOD), (bf16*)WSP(WS_HB), (const float*)WSP(WS_WG), (float*)WSP(WS_GL), lds, vcu, G, wave, lane, tid); }
    GRID_BAR();
    if (PH(2)) for (int rep_ = 0; rep_ < REPS(2); ++rep_) { PROLOG pg8::Gemm g{(const bf16*)WSP(WS_HB), (const bf16*)WSP(WS_WAB), TT, N_AB, 1024, 1024, 1024}; pg8::StaticOrder S; S.init(TT, N_AB, G, bx);
      pg8::EpiBf16 E{(bf16*)WSP(WS_P), N_AB}; pg8::gemm_phase<pg8::EpiBf16, pg8::StaticOrder>(lds, g, S, E, tid); }
    GRID_BAR();
#if DBG_LEVEL >= 2
    if (PH(3)) for (int rep_ = 0; rep_ < REPS(3); ++rep_) { PROLOG mlstm_gate_scan((const float*)WSP(WS_GL), ap->in[I_ABGB], ws, gw, NGW, lane); }
    if (PH(4)) for (int rep_ = 0; rep_ < REPS(4); ++rep_) { PROLOG attn_phase((const bf16*)WSP(WS_P), (bf16*)WSP(WS_HB), ap->in[I_ABSINK], (const float*)WSP(WS_ROPE), lds, (unsigned*)WSP(WS_CTL) + 6144 + 64 * rep_, vcu, G, wave, lane, tid); }
    GRID_BAR();
    if (PH(5)) for (int rep_ = 0; rep_ < REPS(5); ++rep_) { PROLOG mlstm_fused_scan((const bf16*)WSP(WS_P), ws, lds, vcu, G, wave, lane, tid); }
    GRID_BAR();
    if (PH(6)) for (int rep_ = 0; rep_ < REPS(6); ++rep_) { PROLOG mlstm_merge((const bf16*)WSP(WS_P), (bf16*)WSP(WS_HB), ap->in[I_ABNW], ws, gw, NGW, lane); }
    GRID_BAR();
#endif
    if (PH(7)) for (int rep_ = 0; rep_ < REPS(7); ++rep_) { PROLOG pg8::Gemm g{(const bf16*)WSP(WS_HB), (const bf16*)WSP(WS_WABO), TT, 1024, 1024, 1024, 1024}; pg8::LatOrder S; S.init(NB * SEQ, 1024, G, bx);
      pg8::EpiBf16 E{(bf16*)WSP(WS_P), 1024}; pg8::gemm_phase<pg8::EpiBf16, pg8::LatOrder>(lds, g, S, E, tid); }
    GRID_BAR();
    if (PH(7)) for (int rep_ = 0; rep_ < REPS(7); ++rep_) { PROLOG pg8::Gemm g{(const bf16*)WSP(WS_HB), (const bf16*)WSP(WS_WABO), TT, 1024, 1024, 1024, 1024}; pg8::CtxOrder S; S.init(TT, 1024, G, bx);
      pg8::EpiBf16 E{(bf16*)WSP(WS_P), 1024}; pg8::gemm_phase<pg8::EpiBf16, pg8::CtxOrder>(lds, g, S, E, tid); }
    if (PH(8)) for (int rep_ = 0; rep_ < REPS(8); ++rep_) { PROLOG
      int ib = -1, ie = 0; if (G == 256) { if (bx < 32) { ib = (bx * 8 + wave) * 9; ie = ib + 9; } else { ib = 2304 + ((bx - 32) * 8 + wave) * 17; ie = ib + 17; } }
      ln_phase(ap->in[I_X], ap->in[I_CTX], ap->out, (float*)WSP(WS_XC), (const bf16*)WSP(WS_P), (const float*)WSP(WS_MOD), ap->in[I_LNW], ap->in[I_LNB], (bf16*)WSP(WS_HB), gw, NGW, lane, DRYV(8), 1, ib, ie); }
    GRID_BAR();
    if (PH(8)) for (int rep_ = 0; rep_ < REPS(8); ++rep_) { PROLOG ln_phase(ap->in[I_X], ap->in[I_CTX], ap->out, (float*)WSP(WS_XC), (const bf16*)WSP(WS_P), (const float*)WSP(WS_MOD), ap->in[I_LNW], ap->in[I_LNB], (bf16*)WSP(WS_HB), gw, NGW, lane, DRYV(8), 2); }
    GRID_BAR();
#if DBG_LEVEL >= 3
    if (PH(9)) for (int rep_ = 0; rep_ < REPS(9); ++rep_) { PROLOG pg8::Gemm g{(const bf16*)WSP(WS_HB), (const bf16*)WSP(WS_WQ0), TT, 2048, 1024, 1024, 1024}; pg8::StaticOrder S; S.init(TT, 2048, G, bx);
      pg8::EpiBf16 E{(bf16*)WSP(WS_P), 2048}; pg8::gemm_phase<pg8::EpiBf16, pg8::StaticOrder>(lds, g, S, E, tid); }
    GRID_BAR();
    if (PH(10)) for (int rep_ = 0; rep_ < REPS(10); ++rep_) { PROLOG peer_route((const bf16*)WSP(WS_P), (const bf16*)WSP(WS_KEYS), (int*)WSP(WS_ST), (float*)WSP(WS_ST + 17 * MiB), lds, vcu, G, wave, tid, lane, false); }
    GRID_BAR();
#endif
    if (PH(11)) for (int rep_ = 0; rep_ < REPS(22); ++rep_) { PROLOG peer_pass1((const bf16*)WSP(WS_HB), (const int*)WSP(WS_ST), (const float*)WSP(WS_ST + 17 * MiB), WSP(WS_U), (const float*)WSP(WS_SCL), (const float*)WSP(WS_SCL) + 2 * NEXP, (float*)WSP(WS_ST + 34 * MiB), lds, wave, gw, NGW, lane, false); }
    if (PH(11)) for (int rep_ = 0; rep_ < REPS(11); ++rep_) { PROLOG peer_expert<(DBG_LEVEL >= 3)>((const float*)WSP(WS_ST + 34 * MiB), (const int*)WSP(WS_ST), WSP(WS_V),
        ap->out, (float*)WSP(WS_XC), (const float*)WSP(WS_MOD), ap->in[I_LNW] + 1024, ap->in[I_LNB] + 1024, lds, wave, gw, NGW, lane, DRYV(11), false); }
    GRID_BAR();

    if (PH(12)) for (int rep_ = 0; rep_ < REPS(12); ++rep_) { PROLOG h_phase<32>(ap->out, (const float*)WSP(WS_XC), (const float*)WSP(WS_MOD) + 9 * 6144, (bf16*)WSP(WS_HB), (const float*)WSP(WS_WLOW), (float*)WSP(WS_GL), lds, vcu, G, wave, lane, tid);
 }
    GRID_BAR();
    if (PH(13)) for (int rep_ = 0; rep_ < REPS(13); ++rep_) { PROLOG pg8::Gemm g{(const bf16*)WSP(WS_HB), (const bf16*)WSP(WS_WC), TT, N_C, 1024, 1024, 1024}; pg8::StaticOrder S; S.init(TT, N_C, G, bx);
      pg8::EpiBf16 E{(bf16*)WSP(WS_P), N_C}; pg8::gemm_phase<pg8::EpiBf16, pg8::StaticOrder>(lds, g, S, E, tid); }
    GRID_BAR();
#if DBG_LEVEL >= 2
    if (PH(14)) for (int rep_ = 0; rep_ < REPS(14); ++rep_) { PROLOG gla_prep((bf16*)WSP(WS_P), (bf16*)WSP(WS_HB), (const float*)WSP(WS_GL), ap->in[I_GGUP], ap->in[I_GGB], ws, lds, vcu, G, tid, DRYV(14)); }
    GRID_BAR();
    if (PH(15)) for (int rep_ = 0; rep_ < REPS(15); ++rep_) { PROLOG gla_fused_scan((const bf16*)WSP(WS_P), (const bf16*)WSP(WS_HB), ws, lds, vcu, G, wave, lane, tid, DRYV(15)); }
    GRID_BAR();
    if (PH(16)) for (int rep_ = 0; rep_ < REPS(16); ++rep_) { PROLOG gla_merge((bf16*)WSP(WS_P), ap->in[I_GNW], ws, gw, NGW, lane, DRYV(16)); }
    GRID_BAR();
#endif
    if (PH(17)) for (int rep_ = 0; rep_ < REPS(17); ++rep_) { PROLOG pg8::Gemm g{(const bf16*)WSP(WS_P) + 2048, (const bf16*)WSP(WS_WCO), TT, 1024, 1024, N_C, 1024}; pg8::LatOrder S; S.init(NB * SEQ, 1024, G, bx);
      pg8::EpiBf16 E{(bf16*)WSP(WS_HB), 1024}; pg8::gemm_phase<pg8::EpiBf16, pg8::LatOrder>(lds, g, S, E, tid); }
    GRID_BAR();
    if (PH(18)) for (int rep_ = 0; rep_ < REPS(18); ++rep_) { PROLOG ln_phase(ap->out, (const float*)WSP(WS_XC), ap->out, (float*)WSP(WS_XC), (const bf16*)WSP(WS_HB), (const float*)WSP(WS_MOD) + 9 * 6144, ap->in[I_LNW] + 2048, ap->in[I_LNB] + 2048, (bf16*)WSP(WS_HB), gw, NGW, lane, DRYV(18), 1); }
    GRID_BAR();
#if DBG_LEVEL >= 3
    if (PH(19)) for (int rep_ = 0; rep_ < REPS(19); ++rep_) { PROLOG pg8::Gemm g{(const bf16*)WSP(WS_HB), (const bf16*)WSP(WS_WQ1), TT, 2048, 1024, 1024, 1024}; pg8::LatOrder S; S.init(NB * SEQ, 2048, G, bx);
      pg8::EpiBf16 E{(bf16*)WSP(WS_P), 2048}; pg8::gemm_phase<pg8::EpiBf16, pg8::LatOrder>(lds, g, S, E, tid); }
    GRID_BAR();
    if (PH(20)) for (int rep_ = 0; rep_ < REPS(20); ++rep_) { PROLOG peer_route((const bf16*)WSP(WS_P), (const bf16*)WSP(WS_KEYS) + (size_t)8 * 2 * 128 * 128, (int*)WSP(WS_ST), (float*)WSP(WS_ST + 17 * MiB), lds, vcu, G, wave, tid, lane, true); }
    GRID_BAR();
#endif
    if (PH(21)) for (int rep_ = 0; rep_ < REPS(22); ++rep_) { PROLOG peer_pass1((const bf16*)WSP(WS_HB), (const int*)WSP(WS_ST), (const float*)WSP(WS_ST + 17 * MiB), WSP(WS_U) + (size_t)NEXP * 512, (const float*)WSP(WS_SCL) + NEXP, (const float*)WSP(WS_SCL) + 3 * NEXP, (float*)WSP(WS_ST + 34 * MiB), lds, wave, gw, NGW, lane, true); }
    if (PH(21)) for (int rep_ = 0; rep_ < REPS(21); ++rep_) { PROLOG peer_expert<(DBG_LEVEL >= 3)>((const float*)WSP(WS_ST + 34 * MiB), (const int*)WSP(WS_ST), WSP(WS_V) + (size_t)NEXP * 512,
        ap->out, (float*)WSP(WS_XC), (const float*)WSP(WS_MOD) + 9 * 6144, ap->in[I_LNW] + 3072, ap->in[I_LNB] + 3072, lds, wave, gw, NGW, lane, DRYV(21), true); }
}

extern "C" void kernel_launch(void* const* d_in, const int* in_sizes, int n_in, void* d_out, int out_size, void* d_ws, size_t ws_size, hipStream_t stream) {
    static int grid = 0;
    if (grid == 0) {
        if (n_in != 22 || out_size != NB * SEQ * D || ws_size < 512 * MiB) { fprintf(stderr, "kernel_launch: unexpected shapes: n_in %d out %d ws %zu (need %zu)\n", n_in, out_size, ws_size, (size_t)WS_END); grid = -1; return; }
        int dev = 0, cus = 0, per_cu = 0;
        if (hipGetDevice(&dev) != hipSuccess || hipDeviceGetAttribute(&cus, hipDeviceAttributeMultiprocessorCount, dev) != hipSuccess) { grid = -1; return; }
        if (hipFuncSetAttribute((const void*)fwd_megakernel, hipFuncAttributeMaxDynamicSharedMemorySize, LDS_BYTES) != hipSuccess) { fprintf(stderr, "kernel_launch: hipFuncSetAttribute failed\n"); grid = -1; return; }
        if (hipOccupancyMaxActiveBlocksPerMultiprocessor(&per_cu, (const void*)fwd_megakernel, 512, LDS_BYTES) != hipSuccess || per_cu < 1) { fprintf(stderr, "kernel_launch: occupancy query says %d blocks per CU\n", per_cu); }
        (void)hipGetLastError();
        grid = cus;
        fprintf(stderr, "kernel_launch: grid %d, per_cu %d, ws %zu\n", grid, per_cu, ws_size);
    }
    if (grid < 0) return;
    if (hipMemsetAsync((char*)d_ws + WS_CTL, 0, CTL_ZERO_BYTES, stream) != hipSuccess) return;
    Args a{};
    for (int i = 0; i < 22; ++i) a.in[i] = (const float*)d_in[i];
    a.out = (float*)d_out; a.ws = (unsigned char*)d_ws;
    hipLaunchKernelGGL(fwd_megakernel, dim3(grid), dim3(512), LDS_BYTES, stream, a);
}
```
